# Optimizing an MI355X kernel written in HIP

```python
import jax, jax.numpy as jnp
from jax import lax
import numpy as np

D_MODEL = 2048
BATCH = 1
SEQ = 8192
DEPTH = 2

GRID_W = 64
PLE_DIM = 256
HG_HEADS = 8
HG_DK = 128
HG_DV = 128
HG_W = HG_HEADS * HG_DK
HG_CHUNK = 64
NA_HEADS = 8
NA_HD = 128
NA_W = NA_HEADS * NA_HD
NA_KH = 8
NA_KW = 16
N_IN = 5 * HG_W + 4 * NA_W + 2 * D_MODEL
EPS = 1e-6
NEG = -1e30
F_MIN = 1e-6

kernel_name = "hybrid_hgrn2_natten_gated_encoder"

_SPLITS = [HG_W, 2 * HG_W, 3 * HG_W, 4 * HG_W, 5 * HG_W,
           5 * HG_W + NA_W, 5 * HG_W + 2 * NA_W, 5 * HG_W + 3 * NA_W,
           5 * HG_W + 4 * NA_W, 5 * HG_W + 4 * NA_W + D_MODEL]


def _rms(x, g):
    xf = x.astype(jnp.float32)
    y = xf * lax.rsqrt(jnp.mean(xf * xf, axis=-1, keepdims=True) + EPS)
    return (y * g.astype(jnp.float32)).astype(x.dtype)


def _gla_scan(q, k, v, logf):
    B, S, H, dk = q.shape
    C = HG_CHUNK
    n = S // C

    def to_chunks(a):
        return a.astype(jnp.float32).reshape(B, n, C, H, a.shape[-1]).transpose(1, 0, 3, 2, 4)

    qc, kc, vc, gc = to_chunks(q), to_chunks(k), to_chunks(v), to_chunks(logf)
    tri = jnp.tril(jnp.ones((C, C), dtype=bool))

    def step(state, xs):
        qb, kb, vb, gb = xs
        b = jnp.cumsum(gb, axis=-2)
        o_inter = jnp.einsum('bhtk,bhkv->bhtv', qb * jnp.exp(b), state)
        diff = b[:, :, :, None, :] - b[:, :, None, :, :]
        decay = jnp.exp(jnp.where(tri[:, :, None], diff, NEG))
        att = jnp.einsum('bhtk,bhsk,bhtsk->bhts', qb, kb, decay)
        o_intra = jnp.einsum('bhts,bhsv->bhtv', att, vb)
        b_last = b[:, :, -1:, :]
        new_state = state * jnp.exp(b_last[:, :, 0, :, None]) + jnp.einsum(
            'bhsk,bhsv->bhkv', kb * jnp.exp(b_last - b), vb)
        return new_state, o_inter + o_intra

    s0 = jnp.zeros((B, H, dk, v.shape[-1]), jnp.float32)
    _, out = lax.scan(step, s0, (qc, kc, vc, gc))
    return out.transpose(1, 0, 3, 2, 4).reshape(B, S, H, v.shape[-1])


def _hgrn2_bidir(q_raw, i_raw, z_fwd, z_bwd, lb_fwd, lb_bwd):
    B, S, _ = q_raw.shape
    q = jax.nn.silu(q_raw).reshape(B, S, HG_HEADS, HG_DK)
    v = i_raw.reshape(B, S, HG_HEADS, HG_DV)

    def gates(z, lb):
        z = z.astype(jnp.float32).reshape(B, S, HG_HEADS, HG_DK)
        lb = lb.reshape(HG_HEADS, HG_DK)
        f = lb + (1.0 - lb) * jax.nn.sigmoid(z)
        logf = jnp.log(jnp.maximum(f, F_MIN))
        k = (1.0 - lb) * jax.nn.sigmoid(-z)
        return k, logf

    kf, gf = gates(z_fwd, lb_fwd)
    kb, gb = gates(z_bwd, lb_bwd)
    o_f = _gla_scan(q, kf, v, gf)
    rev = lambda a: jnp.flip(a, axis=1)
    o_b = rev(_gla_scan(rev(q), rev(kb), rev(v), rev(gb)))
    return o_f + o_b


def _neighbourhood_attention(q, k, v, rpb):
    B, S, H, hd = q.shape
    rows = S // GRID_W
    kh = min(NA_KH, rows)
    kw = NA_KW
    r = jnp.arange(rows)
    r_start = jnp.clip(r - kh // 2, 0, rows - kh)
    ridx = r_start[:, None] + jnp.arange(kh)[None, :]
    c = jnp.arange(GRID_W)
    c_start = jnp.clip(c - kw // 2, 0, GRID_W - kw)
    col_in = (c[None, :] >= c_start[:, None]) & (c[None, :] < c_start[:, None] + kw)

    qg = q.reshape(B, rows, GRID_W, H, hd)
    kg = k.reshape(B, rows, GRID_W, H, hd)[:, ridx]
    vg = v.reshape(B, rows, GRID_W, H, hd)[:, ridx]

    s = jnp.einsum('brqhd,brakhd->brhqak', qg, kg).astype(jnp.float32) * (hd ** -0.5)
    row_off = ridx - r[:, None] + (NA_KH - 1)
    col_off = jnp.clip(c[None, :] - c[:, None] + (NA_KW - 1), 0, 2 * NA_KW - 2)
    bias = rpb.astype(jnp.float32)[:, row_off[:, None, :, None], col_off[None, :, None, :]]
    bias = bias.transpose(1, 0, 2, 3, 4)
    s = jnp.where(col_in[None, None, None, :, None, :], s + bias[None], NEG)
    pr = jax.nn.softmax(s.reshape(B, rows, H, GRID_W, kh * GRID_W), axis=-1).reshape(s.shape)
    o = jnp.einsum('brhqak,brakhd->brqhd', pr.astype(v.dtype), vg)
    return o.reshape(B, S, H * hd)


def setup_inputs(seed: int = 0) -> dict:
    key = jax.random.key(seed)
    ks = jax.random.split(key, 16)
    n = jax.random.normal
    f32 = jnp.float32
    return {
        "x": n(ks[0], (BATCH, SEQ, D_MODEL), f32),
        "p": n(ks[1], (DEPTH, BATCH, SEQ, PLE_DIM), f32),
        "norm_g": 1.0 + 0.02 * n(ks[2], (DEPTH, D_MODEL), f32),
        "w_in": n(ks[3], (DEPTH, D_MODEL, N_IN), f32) * D_MODEL ** -0.5,
        "hgrn_lb": n(ks[4], (DEPTH, 2, HG_W), f32),
        "hgrn_onorm": 1.0 + 0.02 * n(ks[5], (DEPTH, HG_DV), f32),
        "na_qnorm": 1.0 + 0.02 * n(ks[6], (DEPTH, NA_HD), f32),
        "na_knorm": 1.0 + 0.02 * n(ks[7], (DEPTH, NA_HD), f32),
        "na_rpb": 0.02 * n(ks[8], (DEPTH, NA_HEADS, 2 * NA_KH - 1, 2 * NA_KW - 1), f32),
        "w_branch_a": n(ks[9], (DEPTH, HG_W, D_MODEL), f32) * HG_W ** -0.5,
        "w_branch_b": n(ks[10], (DEPTH, NA_W, D_MODEL), f32) * NA_W ** -0.5,
        "w_out": n(ks[11], (DEPTH, D_MODEL, D_MODEL), f32) * D_MODEL ** -0.5,
        "ple_norm": 1.0 + 0.02 * n(ks[12], (DEPTH, D_MODEL), f32),
        "w_ple_gate": n(ks[13], (DEPTH, D_MODEL, D_MODEL), f32) * D_MODEL ** -0.5,
        "w_ple": n(ks[14], (DEPTH, PLE_DIM, D_MODEL), f32) * PLE_DIM ** -0.5,
    }


def reference(x, p, norm_g, w_in, hgrn_lb, hgrn_onorm, na_qnorm, na_knorm, na_rpb,
              w_branch_a, w_branch_b, w_out, ple_norm, w_ple_gate, w_ple):
    B, S, _ = x.shape
    lbp = jax.nn.softmax(hgrn_lb.astype(jnp.float32), axis=0)
    lower = jnp.cumsum(lbp, axis=0) - lbp[0:1]

    for i in range(DEPTH):
        h = _rms(x, norm_g[i])
        u = h @ w_in[i]
        (hq, hi, hf_fwd, hf_bwd, hgate, nq, nk, nv, ngate, m_a, m_b) = jnp.split(u, _SPLITS, axis=-1)

        oa = _hgrn2_bidir(hq, hi, hf_fwd, hf_bwd, lower[i, 0], lower[i, 1])
        oa = _rms(oa, hgrn_onorm[i]).reshape(B, S, HG_W).astype(x.dtype)
        ya = (oa * jax.nn.silu(hgate)) @ w_branch_a[i]

        q = _rms(nq.reshape(B, S, NA_HEADS, NA_HD), na_qnorm[i])
        k = _rms(nk.reshape(B, S, NA_HEADS, NA_HD), na_knorm[i])
        v = nv.reshape(B, S, NA_HEADS, NA_HD)
        ob = _neighbourhood_attention(q, k, v, na_rpb[i])
        yb = (ob * jax.nn.silu(ngate)) @ w_branch_b[i]

        y = jax.nn.sigmoid(m_a) * ya + jax.nn.sigmoid(m_b) * yb
        x = x + y @ w_out[i]

        g = jax.nn.sigmoid(_rms(x, ple_norm[i]) @ w_ple_gate[i])
        x = x + (p[i] @ w_ple[i]) * g
    return x
```

```cpp
#include <hip/hip_runtime.h>
#include <cstdio>
#include <cstdint>

#ifndef MK_ALIGN
#define MK_ALIGN false
#endif
#ifndef MK_SP2
#define MK_SP2 false
#endif
#ifndef MK_ENDFLUSH
#define MK_ENDFLUSH 1
#endif
#ifndef MK_MULTI
#define MK_MULTI 1
#endif

#define LAS __attribute__((address_space(3)))
typedef unsigned short bf16_t;
typedef short bf16x8 __attribute__((ext_vector_type(8)));
typedef float f32x4 __attribute__((ext_vector_type(4)));
typedef float f32x2 __attribute__((ext_vector_type(2)));
typedef unsigned u32x4 __attribute__((ext_vector_type(4)));
typedef unsigned u32x2 __attribute__((ext_vector_type(2)));

constexpr int SEQ = 8192, DM = 2048, NIN = 13312, HW = 1024, PLE = 256;
constexpr float EPS = 1e-6f;
constexpr int NPHASE = 15;

constexpr size_t MiB = 1u << 20;
constexpr size_t WS_CTL = 0, CTL_ZERO_BYTES = 1 * MiB;
constexpr size_t WS_LOWER = 1 * MiB;
constexpr size_t WS_SSQ = 1 * MiB + 64 * 1024;
constexpr size_t WS_DD = 2 * MiB;
constexpr size_t WS_EE = 3 * MiB;
constexpr size_t WS_WIN = 4 * MiB;
constexpr size_t WS_WA = 108 * MiB;
constexpr size_t WS_WB = 116 * MiB;
constexpr size_t WS_WO = 124 * MiB;
constexpr size_t WS_WG = 140 * MiB;
constexpr size_t WS_WP = 156 * MiB;
constexpr size_t WS_PB = 158 * MiB;
constexpr size_t WS_XGA = 166 * MiB;
constexpr size_t WS_XGB = 198 * MiB;
constexpr size_t WS_QH = 230 * MiB;
constexpr size_t WS_VH = 246 * MiB;
constexpr size_t WS_KF = 262 * MiB;
constexpr size_t WS_KB = 278 * MiB;
constexpr size_t WS_HG = 294 * MiB;
constexpr size_t WS_NQ = 310 * MiB;
constexpr size_t WS_NK = 326 * MiB;
constexpr size_t WS_VT = 342 * MiB;
constexpr size_t WS_NG = 358 * MiB;
constexpr size_t WS_OA = 374 * MiB;
constexpr size_t WS_OB = 390 * MiB;
constexpr size_t WS_GF = 406 * MiB;
constexpr size_t WS_GB = 438 * MiB;
constexpr size_t WS_MA = 470 * MiB;
constexpr size_t WS_MB = 502 * MiB;
constexpr size_t WS_LT = 534 * MiB;
constexpr size_t WS_SP = 662 * MiB;
constexpr size_t WS_END = 726 * MiB;
constexpr size_t WS_T = WS_LT;
constexpr size_t WS_PL = WS_LT + 64 * MiB;
constexpr size_t WS_Y = WS_SP;
constexpr size_t WS_X1 = WS_GF;

constexpr int LDS_BYTES = 147456;
constexpr int LDS_MISC_OFF = 131072;

typedef __bf16 bf16x2_t __attribute__((ext_vector_type(2)));
__device__ __forceinline__ unsigned cvt_pk_bf16(float lo, float hi) { bf16x2_t v = {(__bf16)lo, (__bf16)hi}; return __builtin_bit_cast(unsigned, v); }
__device__ __forceinline__ float bf2f(unsigned short b) { return __uint_as_float(((unsigned)b) << 16); }
__device__ __forceinline__ float bflo(unsigned w) { return __uint_as_float(w << 16); }
__device__ __forceinline__ float bfhi(unsigned w) { return __uint_as_float(w & 0xffff0000u); }
__device__ __forceinline__ unsigned short f2bf1(float f) { return (unsigned short)(cvt_pk_bf16(f, 0.f) & 0xffffu); }
__device__ __forceinline__ float fast_rcp(float x) { return __builtin_amdgcn_rcpf(x); }
__device__ __forceinline__ float sigmoid_f(float x) { return fast_rcp(1.f + __expf(-x)); }
__device__ __forceinline__ float silu_f(float x) { return x * sigmoid_f(x); }

__device__ __forceinline__ int opaque_tid() { int t = threadIdx.x; asm volatile("" : "+v"(t)); return t; }
__device__ __forceinline__ unsigned char* opaque_ptr(unsigned char* p) { asm volatile("" : "+s"(p)); return p; }
__device__ __forceinline__ int opaque_bid() { int b = blockIdx.x; asm volatile("" : "+s"(b)); return b; }
namespace pg8 {
#define PG8_LAS __attribute__((address_space(3)))
constexpr int BM = 256, BK = 64, HALF = 128, HTB = HALF * BK * 2, STAGE_BYTES = 8 * HTB, NXCD = 8, WGM = 8;
__host__ __device__ __forceinline__ int lds_byte(int r, int c) { const int st = (r >> 4) * 2 + (c >> 5), rr = r & 15, cc = c & 31, ob = rr * 64 + cc * 2; return st * 1024 + (ob ^ (((ob >> 9) & 1) << 5)); }
__host__ __device__ __forceinline__ void stage_rc(int b, int& R, int& C) { const int st = b / 1024, sb = b % 1024, swz = sb ^ (((sb >> 9) & 1) << 5); R = (st >> 1) * 16 + swz / 64; C = (st & 1) * 32 + (swz % 64) / 2; }
__host__ __device__ __forceinline__ int perm32(int rho) { const int n = rho >> 4, i = rho & 15; return 8 * (i >> 2) + 4 * n + (i & 3); }

struct Unit { int pm, pn; };
struct Gemm { const bf16_t* A; const bf16_t* Bt; int M, N, K; };

struct StaticOrder {
    int nM, nN, nwg, G, c;
    __host__ __device__ void init(int M, int N, int G_, int c_) { nM = M / BM; nN = N / BM; nwg = nM * nN; G = G_; c = c_; }
    __host__ __device__ bool next(int i, Unit& u) const {
        const long L = (long)i * G + c; if (L >= nwg) return false;
        int wgid = (int)L; { const int q = nwg / NXCD, r = nwg % NXCD, xcd = wgid % NXCD, off = wgid / NXCD; wgid = (xcd < r ? xcd * (q + 1) : r * (q + 1) + (xcd - r) * q) + off; }
        const int nig = WGM * nN, gid = wgid / nig, fm = gid * WGM, gsz = (nM - fm) < WGM ? (nM - fm) : WGM;
        u.pm = fm + ((wgid % nig) % gsz); u.pn = (wgid % nig) / gsz; return true;
    }
    __device__ __forceinline__ void a_ready(const Unit&) const {}
    __device__ __forceinline__ void done(const Unit&) const {}
};

template <class Epi, class Sched, bool ALIGN_EPI = MK_ALIGN, bool SP2 = MK_SP2>
__device__ __forceinline__ void gemm_phase(PG8_LAS unsigned char* lds, const Gemm g, const Sched& S, const Epi& E) {
    const int tid = opaque_tid(), wid = __builtin_amdgcn_readfirstlane(tid >> 6), lane = tid & 63, wr = wid >> 2, wc = wid & 3, fr = lane & 15, fq = lane >> 4;
    const int K = g.K, nt = K / BK;
    unsigned voffA[2], voffB[2];
#pragma unroll
    for (int i = 0; i < 2; ++i) { int R, C; stage_rc(tid * 16 + i * 8192, R, C); const int Rb = Epi::PERM ? ((R & ~31) + perm32(R & 31)) : R;
        voffA[i] = (unsigned)(R * K + C) * 2u; voffB[i] = (unsigned)(Rb * K + C) * 2u; }
    const size_t kstep = (size_t)(BK * 2);
    const size_t hstep = (size_t)HALF * K * 2;
    const size_t tstep = 2 * hstep;
    const unsigned ldsw = (unsigned)wid * 1024u;
    const int aoff = lds_byte(wr * 64 + fr, fq * 8), boff = lds_byte(wc * 32 + fr, fq * 8);
#define PG8_SA(b, h) (((b) * 2 + (h)) * HTB)
#define PG8_SB(b, h) ((4 + (b) * 2 + (h)) * HTB)
#define PG8_STAGE(bufoff, gbase, voff) do { _Pragma("unroll") for (int _i = 0; _i < 2; ++_i) \
        __builtin_amdgcn_global_load_lds((const unsigned*)((const char*)(gbase) + (voff)[_i]), (PG8_LAS unsigned*)(lds + (bufoff) + ldsw + _i * 8192), 16, 0, 0); } while (0)
#define PG8_LDA(dst, b, h) do { _Pragma("unroll") for (int m = 0; m < 4; ++m) _Pragma("unroll") for (int k = 0; k < 2; ++k) dst[m][k] = *(const PG8_LAS bf16x8*)(lds + PG8_SA(b, h) + aoff + m * 2048 + k * 1024); } while (0)
#define PG8_LDB(dst, b, h) do { _Pragma("unroll") for (int n = 0; n < 2; ++n) _Pragma("unroll") for (int k = 0; k < 2; ++k) dst[n][k] = *(const PG8_LAS bf16x8*)(lds + PG8_SB(b, h) + boff + n * 2048 + k * 1024); } while (0)
#define PG8_MMA(ai, bj, At, Bt) do { __builtin_amdgcn_s_setprio(1); _Pragma("unroll") for (int m = 0; m < 4; ++m) _Pragma("unroll") for (int n = 0; n < 2; ++n) _Pragma("unroll") for (int k = 0; k < 2; ++k) \
        acc[ai][bj][m][n] = __builtin_amdgcn_mfma_f32_16x16x32_bf16(Bt[n][k], At[m][k], acc[ai][bj][m][n], 0, 0, 0); __builtin_amdgcn_s_setprio(0); } while (0)
#define PG8_WAIT_V(n) asm volatile("s_waitcnt vmcnt(" #n ")" ::: "memory")
#define PG8_WAIT_L(n) asm volatile("s_waitcnt lgkmcnt(" #n ")" ::: "memory")
#define PG8_BAR __builtin_amdgcn_s_barrier()
#define PG8_SCHED __builtin_amdgcn_sched_barrier(0)
    Unit cur, nxt; int ui = 0;
    if (!S.next(0, cur)) return;
    f32x4 acc[2][2][4][2];
#pragma unroll
    for (int a = 0; a < 2; ++a)
#pragma unroll
        for (int b = 0; b < 2; ++b)
#pragma unroll
            for (int m = 0; m < 4; ++m)
#pragma unroll
                for (int n = 0; n < 2; ++n) acc[a][b][m][n] = (f32x4){0.f, 0.f, 0.f, 0.f};
    bf16x8 At[4][2], B0[2][2], B1[2][2];
    const char* cA = (const char*)g.A + (size_t)cur.pm * tstep; const char* cB = (const char*)g.Bt + (size_t)cur.pn * tstep;
    S.a_ready(cur);
    if constexpr (SP2) {
        PG8_STAGE(PG8_SB(0, 0), cB, voffB); PG8_STAGE(PG8_SB(0, 1), cB + hstep, voffB); PG8_STAGE(PG8_SA(0, 0), cA, voffA); PG8_STAGE(PG8_SA(0, 1), cA + hstep, voffA);
        if (wr == 1) PG8_BAR;
        PG8_WAIT_V(2); PG8_BAR;
        PG8_STAGE(PG8_SB(1, 0), cB + kstep, voffB); PG8_STAGE(PG8_SA(1, 0), cA + kstep, voffA); PG8_STAGE(PG8_SB(1, 1), cB + hstep + kstep, voffB);
        PG8_WAIT_V(6); PG8_BAR;
    } else {
        PG8_STAGE(PG8_SB(0, 0), cB, voffB); PG8_STAGE(PG8_SA(0, 0), cA, voffA); PG8_STAGE(PG8_SB(0, 1), cB + hstep, voffB); PG8_STAGE(PG8_SA(0, 1), cA + hstep, voffA);
        if (wr == 1) PG8_BAR;
        PG8_WAIT_V(4); PG8_BAR;
        PG8_STAGE(PG8_SB(1, 0), cB + kstep, voffB); PG8_STAGE(PG8_SA(1, 0), cA + kstep, voffA); PG8_STAGE(PG8_SB(1, 1), cB + hstep + kstep, voffB);
        PG8_WAIT_V(6); PG8_BAR;
    }
    for (;;) {
        const bool has_next = S.next(ui + 1, nxt);
        const char* nA = has_next ? (const char*)g.A + (size_t)nxt.pm * tstep : cA; const char* nB = has_next ? (const char*)g.Bt + (size_t)nxt.pn * tstep : cB;
        for (int t = 0; t < nt; t += 2) {
            const bool last = (t == nt - 2);
            const char* a1 = cA + (size_t)(t + 1) * kstep;
            const char* a2 = last ? nA : cA + (size_t)(t + 2) * kstep; const char* b2 = last ? nB : cB + (size_t)(t + 2) * kstep;
            const char* a3 = a2 + kstep; const char* b3 = b2 + kstep;
            if (last && has_next) S.a_ready(nxt);
            if constexpr (SP2) {
            PG8_LDB(B0, 0, 0); PG8_LDB(B1, 0, 1); PG8_SCHED; PG8_LDA(At, 0, 0); PG8_STAGE(PG8_SA(1, 1), a1 + hstep, voffA);
            PG8_WAIT_V(8); PG8_WAIT_L(0); PG8_BAR; PG8_MMA(0, 0, At, B0); PG8_MMA(0, 1, At, B1); PG8_BAR; PG8_SCHED;
            PG8_LDA(At, 0, 1); PG8_STAGE(PG8_SB(0, 0), b2, voffB); PG8_STAGE(PG8_SB(0, 1), b2 + hstep, voffB); PG8_STAGE(PG8_SA(0, 0), a2, voffA);
            PG8_WAIT_V(8); PG8_WAIT_L(0); PG8_BAR; PG8_MMA(1, 0, At, B0); PG8_MMA(1, 1, At, B1); PG8_BAR; PG8_SCHED;
            PG8_LDB(B0, 1, 0); PG8_LDB(B1, 1, 1); PG8_SCHED; PG8_LDA(At, 1, 0); PG8_STAGE(PG8_SA(0, 1), a2 + hstep, voffA);
            PG8_WAIT_V(8); PG8_WAIT_L(0); PG8_BAR; PG8_MMA(0, 0, At, B0); PG8_MMA(0, 1, At, B1); PG8_BAR; PG8_SCHED;
            PG8_LDA(At, 1, 1); PG8_STAGE(PG8_SB(1, 0), b3, voffB); PG8_STAGE(PG8_SB(1, 1), b3 + hstep, voffB); PG8_STAGE(PG8_SA(1, 0), a3, voffA);
            PG8_WAIT_V(8); PG8_WAIT_L(0); PG8_BAR; PG8_MMA(1, 0, At, B0); PG8_MMA(1, 1, At, B1); PG8_BAR; PG8_SCHED;
            } else {
            PG8_LDB(B0, 0, 0); PG8_SCHED; PG8_LDA(At, 0, 0); PG8_STAGE(PG8_SA(1, 1), a1 + hstep, voffA);
            PG8_WAIT_L(8); PG8_BAR; PG8_WAIT_L(0); PG8_MMA(0, 0, At, B0); PG8_BAR; PG8_SCHED;
            PG8_LDB(B1, 0, 1); PG8_STAGE(PG8_SB(0, 0), b2, voffB);
            PG8_BAR; PG8_WAIT_L(0); PG8_MMA(0, 1, At, B1); PG8_BAR;
            PG8_LDA(At, 0, 1); PG8_STAGE(PG8_SA(0, 0), a2, voffA);
            PG8_BAR; PG8_WAIT_L(0); PG8_MMA(1, 0, At, B0); PG8_BAR; PG8_SCHED;
            PG8_STAGE(PG8_SB(0, 1), b2 + hstep, voffB);
            PG8_WAIT_V(6); PG8_BAR; PG8_MMA(1, 1, At, B1); PG8_BAR;
            PG8_LDB(B0, 1, 0); PG8_SCHED; PG8_LDA(At, 1, 0); PG8_STAGE(PG8_SA(0, 1), a2 + hstep, voffA);
            PG8_WAIT_L(8); PG8_BAR; PG8_WAIT_L(0); PG8_MMA(0, 0, At, B0); PG8_BAR; PG8_SCHED;
            PG8_LDB(B1, 1, 1); PG8_STAGE(PG8_SB(1, 0), b3, voffB);
            PG8_BAR; PG8_WAIT_L(0); PG8_MMA(0, 1, At, B1); PG8_BAR;
            PG8_LDA(At, 1, 1); PG8_STAGE(PG8_SA(1, 0), a3, voffA);
            PG8_BAR; PG8_WAIT_L(0); PG8_MMA(1, 0, At, B0); PG8_BAR; PG8_SCHED;
            PG8_STAGE(PG8_SB(1, 1), b3 + hstep, voffB);
            PG8_WAIT_V(6); PG8_BAR; PG8_MMA(1, 1, At, B1); PG8_BAR;
            }
        }
        if constexpr (ALIGN_EPI) { if (wr == 0) PG8_BAR; }
        E(acc, cur, wr, wc, fr, fq);
        if (!has_next) break;
#pragma unroll
        for (int a = 0; a < 2; ++a)
#pragma unroll
            for (int b = 0; b < 2; ++b)
#pragma unroll
                for (int m = 0; m < 4; ++m)
#pragma unroll
                    for (int n = 0; n < 2; ++n) acc[a][b][m][n] = (f32x4){0.f, 0.f, 0.f, 0.f};
        cur = nxt; cA = nA; cB = nB; ++ui;
        if constexpr (ALIGN_EPI) { if (wr == 1) PG8_BAR; }
    }
    PG8_WAIT_V(0);
    if constexpr (!ALIGN_EPI) { if (wr == 0) PG8_BAR; }
    PG8_BAR;
#undef PG8_SA
#undef PG8_SB
#undef PG8_STAGE
#undef PG8_LDA
#undef PG8_LDB
#undef PG8_MMA
#undef PG8_WAIT_V
#undef PG8_WAIT_L
#undef PG8_BAR
#undef PG8_SCHED
}
}

typedef f32x4 AccT[2][2][4][2];

__device__ __forceinline__ void store8_bf16(bf16_t* p, const float (&v)[8]) {
    u32x4 w; w.x = cvt_pk_bf16(v[0], v[1]); w.y = cvt_pk_bf16(v[2], v[3]); w.z = cvt_pk_bf16(v[4], v[5]); w.w = cvt_pk_bf16(v[6], v[7]);
    *(u32x4*)p = w;
}
__device__ __forceinline__ void load8_bf16(const bf16_t* p, float (&v)[8]) {
    const u32x4 w = *(const u32x4*)p;
    v[0] = bflo(w.x); v[1] = bfhi(w.x); v[2] = bflo(w.y); v[3] = bfhi(w.y); v[4] = bflo(w.z); v[5] = bfhi(w.z); v[6] = bflo(w.w); v[7] = bfhi(w.w);
}
__device__ __forceinline__ void store8_f32(float* p, const float (&v)[8]) {
    *(f32x4*)p = (f32x4){v[0], v[1], v[2], v[3]}; *(f32x4*)(p + 4) = (f32x4){v[4], v[5], v[6], v[7]};
}
__device__ __forceinline__ void load8_f32(const float* p, float (&v)[8]) {
    const f32x4 a = *(const f32x4*)p, b = *(const f32x4*)(p + 4);
    v[0] = a[0]; v[1] = a[1]; v[2] = a[2]; v[3] = a[3]; v[4] = b[0]; v[5] = b[1]; v[6] = b[2]; v[7] = b[3];
}
__device__ __forceinline__ void acc8(const AccT& acc, int ai, int bj, int m, float (&v)[8]) {
    const f32x4 a = acc[ai][bj][m][0], b = acc[ai][bj][m][1];
    v[0] = a[0]; v[1] = a[1]; v[2] = a[2]; v[3] = a[3]; v[4] = b[0]; v[5] = b[1]; v[6] = b[2]; v[7] = b[3];
}

template <int ACT> __device__ __forceinline__ void epi_plain(const AccT& acc, const float* ssq, bf16_t* dst, int ld, int row0, int c0) {
#pragma unroll
    for (int ai = 0; ai < 2; ++ai)
#pragma unroll
        for (int m = 0; m < 4; ++m) {
            const int row = row0 + ai * 128 + m * 16; const float rs = rsqrtf(ssq[row] * (1.0f / DM) + EPS);
#pragma unroll
            for (int bj = 0; bj < 2; ++bj) { float v[8]; acc8(acc, ai, bj, m, v);
#pragma unroll
                for (int e = 0; e < 8; ++e) { float z = v[e] * rs; if (ACT == 1) z = silu_f(z); if (ACT == 2) z = sigmoid_f(z); v[e] = z; }
                store8_bf16(dst + (size_t)row * ld + c0 + bj * 128, v); }
            asm volatile("" ::: "memory");
        }
}
struct EpiInProj {
    static constexpr bool PERM = true;
    const float* ssq; const float* lower; unsigned char* ws;
    __device__ __forceinline__ void operator()(const AccT& acc, const pg8::Unit& u, int wr, int wc, int fr, int fq) const {
        const int colt = u.pn * 256, seg = colt >> 10;
        const int row0 = u.pm * 256 + wr * 64 + fr;
        const int cin = wc * 32 + 8 * fq;
        const int cseg = (colt & 1023) + cin;
        if (seg == 2 || seg == 3) {
            const int dir = seg - 2;
            float* G = (float*)(ws + (dir ? WS_GB : WS_GF)); bf16_t* KK = (bf16_t*)(ws + (dir ? WS_KB : WS_KF));
#pragma unroll
            for (int bj = 0; bj < 2; ++bj) {
                const int c = cseg + bj * 128; float lb[8]; load8_f32(lower + dir * 1024 + c, lb);
#pragma unroll
                for (int ai = 0; ai < 2; ++ai)
#pragma unroll
                    for (int m = 0; m < 4; ++m) {
                        const int row = row0 + ai * 128 + m * 16; const float rs = rsqrtf(ssq[row] * (1.0f / DM) + EPS);
                        float v[8], lg[8], kk[8]; acc8(acc, ai, bj, m, v);
#pragma unroll
                        for (int e = 0; e < 8; ++e) { const float z = v[e] * rs; const float sg = sigmoid_f(z); const float f = lb[e] + (1.f - lb[e]) * sg;
                            lg[e] = __logf(fmaxf(f, 1e-6f)); kk[e] = (1.f - lb[e]) * fast_rcp(1.f + __expf(z)); }
                        store8_f32(G + (size_t)row * HW + c, lg); store8_bf16(KK + (size_t)row * HW + c, kk);
                        asm volatile("" ::: "memory");
                    }
            }
        } else if (seg == 7) {
            bf16_t* VT = (bf16_t*)(ws + WS_VT);
#pragma unroll
            for (int ai = 0; ai < 2; ++ai)
#pragma unroll
                for (int m = 0; m < 4; ++m) {
                    const int row = row0 + ai * 128 + m * 16; const float rs = rsqrtf(ssq[row] * (1.0f / DM) + EPS);
#pragma unroll
                    for (int bj = 0; bj < 2; ++bj) { float v[8]; acc8(acc, ai, bj, m, v); const int c = cseg + bj * 128;
#pragma unroll
                        for (int e = 0; e < 8; ++e) VT[(size_t)(c + e) * SEQ + row] = f2bf1(v[e] * rs); }
                }
        } else if (seg == 0) epi_plain<1>(acc, ssq, (bf16_t*)(ws + WS_QH), HW, row0, cseg);
        else if (seg == 1) epi_plain<0>(acc, ssq, (bf16_t*)(ws + WS_VH), HW, row0, cseg);
        else if (seg == 4) epi_plain<1>(acc, ssq, (bf16_t*)(ws + WS_HG), HW, row0, cseg);
        else if (seg == 5) epi_plain<0>(acc, ssq, (bf16_t*)(ws + WS_NQ), HW, row0, cseg);
        else if (seg == 6) epi_plain<0>(acc, ssq, (bf16_t*)(ws + WS_NK), HW, row0, cseg);
        else if (seg == 8) epi_plain<1>(acc, ssq, (bf16_t*)(ws + WS_NG), HW, row0, cseg);
        else if (seg < 11) epi_plain<2>(acc, ssq, (bf16_t*)(ws + WS_MA), DM, row0, colt - 9216 + cin);
        else epi_plain<2>(acc, ssq, (bf16_t*)(ws + WS_MB), DM, row0, colt - 11264 + cin);
    }
};

struct EpiBrA {
    static constexpr bool PERM = true;
    const bf16_t* MA; float* T;
    __device__ __forceinline__ void operator()(const AccT& acc, const pg8::Unit& u, int wr, int wc, int fr, int fq) const {
        const int row0 = u.pm * 256 + wr * 64 + fr, c0 = u.pn * 256 + wc * 32 + 8 * fq;
#pragma unroll
        for (int ai = 0; ai < 2; ++ai)
#pragma unroll
            for (int m = 0; m < 4; ++m) { const int row = row0 + ai * 128 + m * 16;
#pragma unroll
                for (int bj = 0; bj < 2; ++bj) { const size_t off = (size_t)row * DM + c0 + bj * 128; float v[8], g[8]; acc8(acc, ai, bj, m, v); load8_bf16(MA + off, g);
#pragma unroll
                    for (int e = 0; e < 8; ++e) v[e] *= g[e];
                    store8_f32(T + off, v); } asm volatile("" ::: "memory"); }
    }
};
struct EpiBrB {
    static constexpr bool PERM = true;
    const bf16_t* MB; const float* T; bf16_t* Y;
    __device__ __forceinline__ void operator()(const AccT& acc, const pg8::Unit& u, int wr, int wc, int fr, int fq) const {
        const int row0 = u.pm * 256 + wr * 64 + fr, c0 = u.pn * 256 + wc * 32 + 8 * fq;
#pragma unroll
        for (int ai = 0; ai < 2; ++ai)
#pragma unroll
            for (int m = 0; m < 4; ++m) { const int row = row0 + ai * 128 + m * 16;
#pragma unroll
                for (int bj = 0; bj < 2; ++bj) { const size_t off = (size_t)row * DM + c0 + bj * 128; float v[8], g[8], t[8]; acc8(acc, ai, bj, m, v); load8_bf16(MB + off, g); load8_f32(T + off, t);
#pragma unroll
                    for (int e = 0; e < 8; ++e) v[e] = t[e] + v[e] * g[e];
                    store8_bf16(Y + off, v); } asm volatile("" ::: "memory"); }
    }
};
struct EpiWout {
    static constexpr bool PERM = true;
    const float* xin; float* X1; bf16_t* XG; const float* gnorm; float* ssq_out;
    __device__ __forceinline__ void operator()(const AccT& acc, const pg8::Unit& u, int wr, int wc, int fr, int fq) const {
        const int row0 = u.pm * 256 + wr * 64 + fr, c0 = u.pn * 256 + wc * 32 + 8 * fq;
#pragma unroll
        for (int ai = 0; ai < 2; ++ai)
#pragma unroll
            for (int m = 0; m < 4; ++m) { const int row = row0 + ai * 128 + m * 16; float s = 0.f;
#pragma unroll
                for (int bj = 0; bj < 2; ++bj) { const size_t off = (size_t)row * DM + c0 + bj * 128; float v[8], xi[8], gn[8]; acc8(acc, ai, bj, m, v); load8_f32(xin + off, xi); load8_f32(gnorm + c0 + bj * 128, gn);
#pragma unroll
                    for (int e = 0; e < 8; ++e) { v[e] += xi[e]; s += v[e] * v[e]; }
                    store8_f32(X1 + off, v);
#pragma unroll
                    for (int e = 0; e < 8; ++e) v[e] *= gn[e];
                    store8_bf16(XG + off, v); }
                s += __shfl_xor(s, 16); s += __shfl_xor(s, 32);
                if (fq == 0) atomicAdd(ssq_out + row, s);
                asm volatile("" ::: "memory"); }
    }
};
struct EpiPL {
    static constexpr bool PERM = true;
    float* PL;
    __device__ __forceinline__ void operator()(const AccT& acc, const pg8::Unit& u, int wr, int wc, int fr, int fq) const {
        const int row0 = u.pm * 256 + wr * 64 + fr, c0 = u.pn * 256 + wc * 32 + 8 * fq;
#pragma unroll
        for (int ai = 0; ai < 2; ++ai)
#pragma unroll
            for (int m = 0; m < 4; ++m) { const int row = row0 + ai * 128 + m * 16;
#pragma unroll
                for (int bj = 0; bj < 2; ++bj) { float v[8]; acc8(acc, ai, bj, m, v); store8_f32(PL + (size_t)row * DM + c0 + bj * 128, v); } asm volatile("" ::: "memory"); }
    }
};
struct EpiGate {
    static constexpr bool PERM = true;
    const float* ssq1; const float* X1; const float* PL; float* xout; bf16_t* XG; const float* gnorm; float* ssq_next; int has_next;
    __device__ __forceinline__ void operator()(const AccT& acc, const pg8::Unit& u, int wr, int wc, int fr, int fq) const {
        const int row0 = u.pm * 256 + wr * 64 + fr, c0 = u.pn * 256 + wc * 32 + 8 * fq;
#pragma unroll
        for (int ai = 0; ai < 2; ++ai)
#pragma unroll
            for (int m = 0; m < 4; ++m) { const int row = row0 + ai * 128 + m * 16; const float rs = rsqrtf(ssq1[row] * (1.0f / DM) + EPS); float s = 0.f;
#pragma unroll
                for (int bj = 0; bj < 2; ++bj) { const size_t off = (size_t)row * DM + c0 + bj * 128; float v[8], x1[8], pl[8]; acc8(acc, ai, bj, m, v); load8_f32(X1 + off, x1); load8_f32(PL + off, pl);
#pragma unroll
                    for (int e = 0; e < 8; ++e) { const float g = sigmoid_f(v[e] * rs); v[e] = x1[e] + pl[e] * g; s += v[e] * v[e]; }
                    store8_f32(xout + off, v);
                    if (has_next) { float gn[8]; load8_f32(gnorm + c0 + bj * 128, gn);
#pragma unroll
                        for (int e = 0; e < 8; ++e) v[e] *= gn[e];
                        store8_bf16(XG + off, v); }
                    asm volatile("" ::: "memory"); }
                if (has_next) { s += __shfl_xor(s, 16); s += __shfl_xor(s, 32); if (fq == 0) atomicAdd(ssq_next + row, s); } }
    }
};

#define XB_TMO      128
#define XB_XCNT(j)  (256  + 64 * (j))
#define XB_XSUB(j)  (1280 + 64 * (j))
#define XB_XGEN(j)  (2304 + 64 * (j))
#define XB_TOP      3328
#define XB_TOPGEN   3392
#define XCD_BAR_WORDS 3456
#define XB_SPIN_CAP (1u << 18)
__device__ __forceinline__ unsigned xb_ld(unsigned* p)              { return __hip_atomic_load(p, __ATOMIC_RELAXED, __HIP_MEMORY_SCOPE_AGENT); }
__device__ __forceinline__ unsigned xb_add(unsigned* p, unsigned v) { return __hip_atomic_fetch_add(p, v, __ATOMIC_RELAXED, __HIP_MEMORY_SCOPE_AGENT); }
__device__ __forceinline__ unsigned xb_xcc_id() { return (unsigned)__builtin_amdgcn_s_getreg((3 << 11) | 20) & 0xFu; }
#define XB_SPIN(cond, bar) do { unsigned _sp = 0; while (cond) { __builtin_amdgcn_s_sleep(1); \
    if ((++_sp & 255u) == 0u) { if (xb_ld(&(bar)[XB_TMO])) break; if (_sp > XB_SPIN_CAP) { atomicAdd(&(bar)[XB_TMO], 1u); break; } } } } while (0)
struct XcdBarrier { unsigned* bar; unsigned x; volatile LAS unsigned* st; };
__device__ __forceinline__ XcdBarrier xcd_barrier_post(unsigned* bar, volatile LAS unsigned* st) {
    XcdBarrier b; b.bar = bar; b.x = xb_xcc_id(); b.st = st;
    if (threadIdx.x == 0) (void)xb_add(&bar[XB_XCNT(b.x)], 1u);
    return b;
}
__device__ __forceinline__ void xcd_barrier_complete(unsigned* bar, unsigned x, unsigned& nloc, unsigned& nx) {
    const unsigned G = gridDim.x * gridDim.y * gridDim.z;
    unsigned sum, cnt, mine, sp = 0u;
    for (;;) {
        sum = 0u; cnt = 0u; mine = 0u;
#pragma unroll
        for (unsigned j = 0; j < 16; ++j) { const unsigned c = xb_ld(&bar[XB_XCNT(j)]); sum += c; cnt += (c > 0u) ? 1u : 0u; mine = (j == x) ? c : mine; }
        if (sum == G) break;
        __builtin_amdgcn_s_sleep(1);
        if ((++sp & 255u) == 0u) { if (xb_ld(&bar[XB_TMO])) break; if (sp > XB_SPIN_CAP) { atomicAdd(&bar[XB_TMO], 1u); break; } }
    }
    nloc = mine > 0u ? mine : 1u; nx = cnt > 0u ? cnt : 1u;
}
__device__ __forceinline__ void xcd_barrier(const XcdBarrier& b) {
    asm volatile("s_waitcnt vmcnt(0)" ::: "memory");
    __syncthreads();
    if (threadIdx.x == 0) {
        unsigned* bar = b.bar;
        __builtin_amdgcn_s_waitcnt(0);
        unsigned nloc = b.st[0], nx = b.st[1];
        if (nloc == 0u) { xcd_barrier_complete(bar, b.x, nloc, nx); b.st[0] = nloc; b.st[1] = nx; }
        const unsigned old = xb_add(&bar[XB_XSUB(b.x)], 1u);
        const unsigned gen = old / nloc;
        if (old + 1u == (gen + 1u) * nloc) {
            __builtin_amdgcn_fence(__ATOMIC_RELEASE, "agent");
            asm volatile("s_waitcnt vmcnt(0)" ::: "memory");
            const unsigned og = xb_add(&bar[XB_TOP], 1u);
            const unsigned tg = og / nx;
            if (og + 1u == (tg + 1u) * nx) xb_add(&bar[XB_TOPGEN], 1u);
            else XB_SPIN(xb_ld(&bar[XB_TOPGEN]) == tg, bar);
            __builtin_amdgcn_fence(__ATOMIC_ACQUIRE, "agent");
            xb_add(&bar[XB_XGEN(b.x)], 1u);
            asm volatile("s_waitcnt vmcnt(0)" ::: "memory");
        } else {
            XB_SPIN(xb_ld(&bar[XB_XGEN(b.x)]) == gen, bar);
            __builtin_amdgcn_fence(__ATOMIC_ACQUIRE, "agent");
            asm volatile("s_waitcnt vmcnt(0)" ::: "memory");
        }
    }
    __syncthreads();
}

struct Args { const float* in[15]; float* out; unsigned char* ws; int ph_lo, ph_hi; };

__device__ __forceinline__ void transpose_convert(const float* __restrict__ W, bf16_t* __restrict__ WT, int K, int N, LAS float* tile, int rot) {
    const int tid = threadIdx.x, nb = gridDim.x; const int bid = (int)((blockIdx.x + (unsigned)rot) % (unsigned)nb);
    const int nkt = K / 64, ntile = nkt * (N / 64);
    for (int t = bid; t < ntile; t += nb) {
        const int tk = t % nkt, tn = t / nkt;
        const float* src = W + (size_t)(tk * 64) * N + tn * 64;
#pragma unroll
        for (int i = 0; i < 2; ++i) { const int idx = tid + i * 512; const int k = idx >> 4, c4 = idx & 15; const f32x4 v = *(const f32x4*)(src + (size_t)k * N + c4 * 4);
            LAS float* d = tile + k * 65 + c4 * 4; d[0] = v[0]; d[1] = v[1]; d[2] = v[2]; d[3] = v[3]; }
        __syncthreads();
        { const int n = tid >> 3, kq = tid & 7; float v[8];
#pragma unroll
          for (int j = 0; j < 8; ++j) v[j] = tile[(kq * 8 + j) * 65 + n];
          store8_bf16(WT + (size_t)(tn * 64 + n) * K + tk * 64 + kq * 8, v); }
        __syncthreads();
    }
}

__device__ __forceinline__ void p0_prologue(const Args& a, LAS unsigned char* lds) {
    unsigned char* ws = a.ws;
    const int tid = threadIdx.x, bid = blockIdx.x, nb = gridDim.x, gtid = bid * 512 + tid, gsz = nb * 512;
    {
        float* LOWER = (float*)(ws + WS_LOWER); const float* lbp = a.in[4];
        for (int i = gtid; i < 2048; i += gsz) { const float a0 = lbp[i], a1 = lbp[2048 + i]; LOWER[i] = 0.f; LOWER[2048 + i] = 1.f / (1.f + expf(a0 - a1)); }
        float* SSQ = (float*)(ws + WS_SSQ);
        for (int i = gtid; i < 3 * SEQ; i += gsz) SSQ[SEQ + i] = 0.f;
    }
    {
        const float* x = a.in[0]; const float* g0 = a.in[2]; bf16_t* XG = (bf16_t*)(ws + WS_XGA); float* SSQ = (float*)(ws + WS_SSQ);
        const int lane = tid & 63, gw = gtid >> 6, nw = gsz >> 6;
        for (int row = gw; row < SEQ; row += nw) {
            const f32x4* xr = (const f32x4*)(x + (size_t)row * DM); float s = 0.f;
#pragma unroll
            for (int j = 0; j < 8; ++j) { const f32x4 v = xr[j * 64 + lane]; const f32x4 g = ((const f32x4*)g0)[j * 64 + lane];
                s += v[0] * v[0] + v[1] * v[1] + v[2] * v[2] + v[3] * v[3];
                u32x2 w; w.x = cvt_pk_bf16(v[0] * g[0], v[1] * g[1]); w.y = cvt_pk_bf16(v[2] * g[2], v[3] * g[3]);
                *(u32x2*)(XG + (size_t)row * DM + (j * 64 + lane) * 4) = w; }
#pragma unroll
            for (int o = 32; o >= 1; o >>= 1) s += __shfl_xor(s, o);
            if (lane == 0) SSQ[row] = s;
        }
    }
    {
        const f32x4* p = (const f32x4*)a.in[1]; bf16_t* PB = (bf16_t*)(ws + WS_PB);
        for (int i = gtid; i < 2 * SEQ * PLE / 4; i += gsz) { const f32x4 v = p[i]; u32x2 w; w.x = cvt_pk_bf16(v[0], v[1]); w.y = cvt_pk_bf16(v[2], v[3]); *(u32x2*)(PB + (size_t)i * 4) = w; }
    }
    LAS float* tile = (LAS float*)lds;
    for (int l = 0; l < 2; ++l) {
        transpose_convert(a.in[3] + (size_t)l * DM * NIN, (bf16_t*)(ws + WS_WIN) + (size_t)l * NIN * DM, DM, NIN, tile, 0);
        transpose_convert(a.in[9] + (size_t)l * HW * DM, (bf16_t*)(ws + WS_WA) + (size_t)l * DM * HW, HW, DM, tile, 0);
        transpose_convert(a.in[10] + (size_t)l * HW * DM, (bf16_t*)(ws + WS_WB) + (size_t)l * DM * HW, HW, DM, tile, 0);
        transpose_convert(a.in[11] + (size_t)l * DM * DM, (bf16_t*)(ws + WS_WO) + (size_t)l * DM * DM, DM, DM, tile, 0);
        transpose_convert(a.in[13] + (size_t)l * DM * DM, (bf16_t*)(ws + WS_WG) + (size_t)l * DM * DM, DM, DM, tile, 0);
        transpose_convert(a.in[14] + (size_t)l * PLE * DM, (bf16_t*)(ws + WS_WP) + (size_t)l * DM * PLE, PLE, DM, tile, 128);
    }
}

constexpr int HP_ROWB = 272;
constexpr int HT_ROWB = 144;

__device__ __forceinline__ void hg_cumsum(const float* __restrict__ G, int tok0, int colg, int seg, int kc, int dir, LAS float* SEGS, float (&b)[16], float& bref, float& blast) {
    float gv[16];
#pragma unroll
    for (int i = 0; i < 16; ++i) gv[i] = G[(size_t)(tok0 + 16 * seg + i) * HW + colg];
    float c = 0.f;
#pragma unroll
    for (int i = 0; i < 16; ++i) { c += gv[i]; b[i] = c; }
    const float tot = c;
    if (dir) {
#pragma unroll
        for (int i = 0; i < 16; ++i) b[i] = tot - b[i] + gv[i];
    }
    SEGS[seg * 128 + kc] = tot;
    __syncthreads();
    const float t0 = SEGS[kc], t1 = SEGS[128 + kc], t2 = SEGS[256 + kc], t3 = SEGS[384 + kc];
    float off;
    if (!dir) { off = (seg > 0 ? t0 : 0.f) + (seg > 1 ? t1 : 0.f) + (seg > 2 ? t2 : 0.f); bref = t0 + t1; }
    else      { off = (seg < 3 ? t3 : 0.f) + (seg < 2 ? t2 : 0.f) + (seg < 1 ? t1 : 0.f); bref = t2 + t3; }
    blast = (t0 + t1) + (t2 + t3);
#pragma unroll
    for (int i = 0; i < 16; ++i) b[i] += off;
}

__device__ __forceinline__ void h1_phase(const Args& a, LAS unsigned char* lds) {
    unsigned char* ws = opaque_ptr(a.ws);
    const int tid = opaque_tid(), lane = tid & 63, w = __builtin_amdgcn_readfirstlane(tid >> 6), fr = lane & 15, fq = lane >> 4;
    const int kc = tid & 127, seg = tid >> 7;
    LAS float* SEGS = (LAS float*)lds; LAS float* SC = (LAS float*)(lds + 2048);
    LAS unsigned char* KpT = lds + 4096; LAS unsigned char* Vt = lds + 4096 + 128 * HT_ROWB;
    const bf16_t* VH = (const bf16_t*)(ws + WS_VH);
    float* LT = (float*)(ws + WS_LT); float* DD = (float*)(ws + WS_DD); float* EE = (float*)(ws + WS_EE);
    for (int item = blockIdx.x; item < 2048; item += gridDim.x) {
        const int d = item >> 10, h = (item >> 7) & 7, cs = item & 127, n = d ? 127 - cs : cs;
        const int tok0 = 64 * n, colg = h * 128 + kc;
        const float* G = (const float*)(ws + (d ? WS_GB : WS_GF)); const bf16_t* KK = (const bf16_t*)(ws + (d ? WS_KB : WS_KF));
        float b[16], bref, blast;
        hg_cumsum(G, tok0, colg, seg, kc, d, SEGS, b, bref, blast);
        {
            unsigned kw[8], vw[8];
#pragma unroll
            for (int i = 0; i < 16; i += 2) {
                const size_t o0 = (size_t)(tok0 + 16 * seg + i) * HW + colg, o1 = o0 + HW;
                const float k0 = bf2f(KK[o0]) * __expf(fminf(bref - b[i], 80.f)), k1 = bf2f(KK[o1]) * __expf(fminf(bref - b[i + 1], 80.f));
                kw[i >> 1] = cvt_pk_bf16(k0, k1);
                vw[i >> 1] = (unsigned)VH[o0] | ((unsigned)VH[o1] << 16);
            }
            LAS u32x4* kd = (LAS u32x4*)(KpT + kc * HT_ROWB + seg * 32); kd[0] = (u32x4){kw[0], kw[1], kw[2], kw[3]}; kd[1] = (u32x4){kw[4], kw[5], kw[6], kw[7]};
            LAS u32x4* vd = (LAS u32x4*)(Vt + kc * HT_ROWB + seg * 32); vd[0] = (u32x4){vw[0], vw[1], vw[2], vw[3]}; vd[1] = (u32x4){vw[4], vw[5], vw[6], vw[7]};
            if (seg == 0) { SC[kc] = __expf(blast - bref); DD[(size_t)item * 128 + kc] = __expf(blast); EE[(size_t)item * 128 + kc] = __expf(bref); }
        }
        __syncthreads();
        {
            const int vt = w;
            bf16x8 af[2];
#pragma unroll
            for (int ks = 0; ks < 2; ++ks) af[ks] = *(const LAS bf16x8*)(Vt + (16 * vt + fr) * HT_ROWB + (32 * ks + 8 * fq) * 2);
            float* dst = LT + (size_t)item * 16384;
#pragma unroll
            for (int kt = 0; kt < 8; ++kt) {
                f32x4 acc = (f32x4){0.f, 0.f, 0.f, 0.f};
#pragma unroll
                for (int ks = 0; ks < 2; ++ks) { const bf16x8 bfr = *(const LAS bf16x8*)(KpT + (16 * kt + fr) * HT_ROWB + (32 * ks + 8 * fq) * 2);
                    acc = __builtin_amdgcn_mfma_f32_16x16x32_bf16(af[ks], bfr, acc, 0, 0, 0); }
                const float sc = SC[16 * kt + fr];
#pragma unroll
                for (int r = 0; r < 4; ++r) dst[(16 * vt + 4 * fq + r) * 128 + 16 * kt + fr] = acc[r] * sc;
            }
        }
        __syncthreads();
    }
}

__device__ __forceinline__ void h2_phase(const Args& a) {
    unsigned char* ws = opaque_ptr(a.ws);
    const int tid = opaque_tid();
    const float* LT = (const float*)(ws + WS_LT); const float* DD = (const float*)(ws + WS_DD); const float* EE = (const float*)(ws + WS_EE);
    bf16_t* SP = (bf16_t*)(ws + WS_SP);
    for (int u = blockIdx.x; u < 256; u += gridDim.x) {
        const int chain = u >> 4, sub = u & 15;
        const int v = 8 * sub + (tid >> 6), k = 2 * (tid & 63);
        const size_t ibase = (size_t)chain * 128;
        float s0 = 0.f, s1 = 0.f;
        for (int cs0 = 0; cs0 < 128; cs0 += 8) {
            f32x2 lt[8], dd[8], ee[8];
#pragma unroll
            for (int j = 0; j < 8; ++j) { const size_t it = ibase + cs0 + j;
                lt[j] = *(const f32x2*)(LT + it * 16384 + v * 128 + k); dd[j] = *(const f32x2*)(DD + it * 128 + k); ee[j] = *(const f32x2*)(EE + it * 128 + k); }
#pragma unroll
            for (int j = 0; j < 8; ++j) { const size_t it = ibase + cs0 + j;
                *(unsigned*)(SP + it * 16384 + v * 128 + k) = cvt_pk_bf16(s0 * ee[j][0], s1 * ee[j][1]);
                s0 = dd[j][0] * s0 + lt[j][0]; s1 = dd[j][1] * s1 + lt[j][1]; }
        }
    }
}

__device__ __forceinline__ void h3_phase(const Args& a, int layer, LAS unsigned char* lds) {
    unsigned char* ws = opaque_ptr(a.ws);
    const int tid = opaque_tid(), lane = tid & 63, w = __builtin_amdgcn_readfirstlane(tid >> 6), fr = lane & 15, fq = lane >> 4;
    const int kc = tid & 127, seg = tid >> 7;
    LAS float* SEGS = (LAS float*)lds; LAS float* SSQP = (LAS float*)(lds + 2048);
    LAS unsigned char* Qp = lds + 4096; LAS unsigned char* Kp = Qp + 64 * HP_ROWB; LAS unsigned char* Vt = Kp + 64 * HP_ROWB; LAS unsigned char* Ab = Vt + 128 * HT_ROWB;
    const bf16_t* QH = (const bf16_t*)(ws + WS_QH); const bf16_t* VH = (const bf16_t*)(ws + WS_VH); const bf16_t* HG = (const bf16_t*)(ws + WS_HG);
    const bf16_t* SP = (const bf16_t*)(ws + WS_SP); bf16_t* OA = (bf16_t*)(ws + WS_OA);
    const float* onorm = a.in[5] + layer * 128;
    for (int item = blockIdx.x; item < 1024; item += gridDim.x) {
        const int n = item >> 3, h = item & 7;
        const int tok0 = 64 * n, colg = h * 128 + kc;
        f32x4 o[4];
#pragma unroll
        for (int j = 0; j < 4; ++j) o[j] = (f32x4){0.f, 0.f, 0.f, 0.f};
        for (int d = 0; d < 2; ++d) {
            const int cs = d ? 127 - n : n; const size_t sitem = (size_t)((d * 8 + h) * 128 + cs);
            const float* G = (const float*)(ws + (d ? WS_GB : WS_GF)); const bf16_t* KK = (const bf16_t*)(ws + (d ? WS_KB : WS_KF));
            float b[16], bref, blast;
            hg_cumsum(G, tok0, colg, seg, kc, d, SEGS, b, bref, blast);
            {
                unsigned vw[8];
#pragma unroll
                for (int i = 0; i < 16; i += 2) {
                    const size_t o0 = (size_t)(tok0 + 16 * seg + i) * HW + colg, o1 = o0 + HW;
                    const float e0 = fminf(b[i] - bref, 80.f), e1 = fminf(b[i + 1] - bref, 80.f);
                    const float q0 = bf2f(QH[o0]) * __expf(e0), q1 = bf2f(QH[o1]) * __expf(e1);
                    const float k0 = bf2f(KK[o0]) * __expf(fminf(-(b[i] - bref), 80.f)), k1 = bf2f(KK[o1]) * __expf(fminf(-(b[i + 1] - bref), 80.f));
                    *(LAS unsigned short*)(Qp + (16 * seg + i) * HP_ROWB + kc * 2) = f2bf1(q0);
                    *(LAS unsigned short*)(Qp + (16 * seg + i + 1) * HP_ROWB + kc * 2) = f2bf1(q1);
                    *(LAS unsigned short*)(Kp + (16 * seg + i) * HP_ROWB + kc * 2) = f2bf1(k0);
                    *(LAS unsigned short*)(Kp + (16 * seg + i + 1) * HP_ROWB + kc * 2) = f2bf1(k1);
                    vw[i >> 1] = (unsigned)VH[o0] | ((unsigned)VH[o1] << 16);
                }
                LAS u32x4* vd = (LAS u32x4*)(Vt + kc * HT_ROWB + seg * 32); vd[0] = (u32x4){vw[0], vw[1], vw[2], vw[3]}; vd[1] = (u32x4){vw[4], vw[5], vw[6], vw[7]};
            }
            __syncthreads();
            {
                const int rt = w >> 1;
#pragma unroll
                for (int tt = 0; tt < 2; ++tt) {
                    const int st = 2 * (w & 1) + tt;
                    const bool need = d ? (st >= rt) : (st <= rt);
                    f32x4 acc = (f32x4){0.f, 0.f, 0.f, 0.f};
                    if (need) {
#pragma unroll
                        for (int ks = 0; ks < 4; ++ks) {
                            const bf16x8 af = *(const LAS bf16x8*)(Qp + (16 * rt + fr) * HP_ROWB + (32 * ks + 8 * fq) * 2);
                            const bf16x8 bfr = *(const LAS bf16x8*)(Kp + (16 * st + fr) * HP_ROWB + (32 * ks + 8 * fq) * 2);
                            acc = __builtin_amdgcn_mfma_f32_16x16x32_bf16(af, bfr, acc, 0, 0, 0);
                        }
                    }
                    const int s_ = 16 * st + fr;
#pragma unroll
                    for (int r = 0; r < 4; ++r) { const int r_ = 16 * rt + 4 * fq + r; const bool ok = need && (d ? (s_ >= r_) : (s_ <= r_));
                        *(LAS unsigned short*)(Ab + r_ * HT_ROWB + s_ * 2) = f2bf1(ok ? acc[r] : 0.f); }
                }
            }
            __syncthreads();
            {
                const int rt = w & 3;
                bf16x8 aa[2], aq[4];
#pragma unroll
                for (int ks = 0; ks < 2; ++ks) aa[ks] = *(const LAS bf16x8*)(Ab + (16 * rt + fr) * HT_ROWB + (32 * ks + 8 * fq) * 2);
#pragma unroll
                for (int ks = 0; ks < 4; ++ks) aq[ks] = *(const LAS bf16x8*)(Qp + (16 * rt + fr) * HP_ROWB + (32 * ks + 8 * fq) * 2);
                const bf16_t* spb = SP + sitem * 16384;
#pragma unroll
                for (int j = 0; j < 4; ++j) {
                    const int vt = 4 * (w >> 2) + j;
#pragma unroll
                    for (int ks = 0; ks < 2; ++ks) { const bf16x8 bfr = *(const LAS bf16x8*)(Vt + (16 * vt + fr) * HT_ROWB + (32 * ks + 8 * fq) * 2);
                        o[j] = __builtin_amdgcn_mfma_f32_16x16x32_bf16(aa[ks], bfr, o[j], 0, 0, 0); }
#pragma unroll
                    for (int ks = 0; ks < 4; ++ks) { const bf16x8 bfr = *(const bf16x8*)(spb + (16 * vt + fr) * 128 + 32 * ks + 8 * fq);
                        o[j] = __builtin_amdgcn_mfma_f32_16x16x32_bf16(aq[ks], bfr, o[j], 0, 0, 0); }
                }
            }
            __syncthreads();
        }
        {
            const int rt = w & 3;
            float pr[4];
#pragma unroll
            for (int r = 0; r < 4; ++r) { float s = 0.f;
#pragma unroll
                for (int j = 0; j < 4; ++j) s += o[j][r] * o[j][r];
                s += __shfl_xor(s, 1); s += __shfl_xor(s, 2); s += __shfl_xor(s, 4); s += __shfl_xor(s, 8); pr[r] = s; }
            if (fr == 0) {
#pragma unroll
                for (int r = 0; r < 4; ++r) SSQP[(w >> 2) * 64 + 16 * rt + 4 * fq + r] = pr[r]; }
            __syncthreads();
#pragma unroll
            for (int r = 0; r < 4; ++r) {
                const int row = 16 * rt + 4 * fq + r; const float rs = rsqrtf((SSQP[row] + SSQP[64 + row]) * (1.0f / 128.f) + EPS);
#pragma unroll
                for (int j = 0; j < 4; ++j) { const int v = 16 * (4 * (w >> 2) + j) + fr; const size_t off = (size_t)(tok0 + row) * HW + h * 128 + v;
                    OA[off] = f2bf1(o[j][r] * rs * onorm[v] * bf2f(HG[off])); }
            }
            __syncthreads();
        }
    }
}

__device__ __forceinline__ void natten_phase(const Args& a, int layer, LAS unsigned char* lds) {
    unsigned char* ws = opaque_ptr(a.ws);
    const int tid = opaque_tid(), lane = tid & 63, w = __builtin_amdgcn_readfirstlane(tid >> 6), fr = lane & 15, fq = lane >> 4;
    LAS float* RP = (LAS float*)lds;
    const bf16_t* NQ = (const bf16_t*)(ws + WS_NQ); const bf16_t* NK = (const bf16_t*)(ws + WS_NK); const bf16_t* VT = (const bf16_t*)(ws + WS_VT);
    const bf16_t* NG = (const bf16_t*)(ws + WS_NG); bf16_t* OB = (bf16_t*)(ws + WS_OB);
    const float* gq = a.in[6] + layer * 128; const float* gk = a.in[7] + layer * 128; const float* rpb = a.in[8] + (size_t)layer * 8 * 465;
    for (int it = blockIdx.x; it < 512; it += gridDim.x) {
        const int r = it >> 2, hp = it & 3, h = 2 * hp + (w >> 2), j = w & 3;
        for (int i = tid; i < 930; i += 512) RP[i] = rpb[(size_t)(2 * hp) * 465 + i];
        __syncthreads();
        const int r_start = min(max(r - 4, 0), 120);
        const int c0k = (j == 0) ? 0 : (j == 1) ? 8 : (j == 2) ? 24 : 32;
        const int cq = 16 * j + fr, tq = 64 * r + cq;
        const int cstart = min(max(cq - 8, 0), 48);
        bf16x8 qf[4];
        {
            float qv[4][8]; float ss = 0.f;
#pragma unroll
            for (int ks = 0; ks < 4; ++ks) { load8_bf16(NQ + (size_t)tq * HW + h * 128 + 32 * ks + 8 * fq, qv[ks]);
#pragma unroll
                for (int e = 0; e < 8; ++e) ss += qv[ks][e] * qv[ks][e]; }
            ss += __shfl_xor(ss, 16); ss += __shfl_xor(ss, 32);
            const float rq = rsqrtf(ss * (1.0f / 128.f) + EPS) * 0.08838834764831845f;
#pragma unroll
            for (int ks = 0; ks < 4; ++ks) { float g1[8], g2[8]; load8_f32(gq + 32 * ks + 8 * fq, g1); load8_f32(gk + 32 * ks + 8 * fq, g2);
                u32x4 wv;
                wv.x = cvt_pk_bf16(qv[ks][0] * rq * g1[0] * g2[0], qv[ks][1] * rq * g1[1] * g2[1]); wv.y = cvt_pk_bf16(qv[ks][2] * rq * g1[2] * g2[2], qv[ks][3] * rq * g1[3] * g2[3]);
                wv.z = cvt_pk_bf16(qv[ks][4] * rq * g1[4] * g2[4], qv[ks][5] * rq * g1[5] * g2[5]); wv.w = cvt_pk_bf16(qv[ks][6] * rq * g1[6] * g2[6], qv[ks][7] * rq * g1[7] * g2[7]);
                qf[ks] = __builtin_bit_cast(bf16x8, wv); }
        }
        float s[8][2][4];
        float mx = -3.0e38f;
#pragma unroll
        for (int aa = 0; aa < 8; ++aa) {
            const int kr = r_start + aa, row_off = kr - r + 7;
#pragma unroll
            for (int kt = 0; kt < 2; ++kt) {
                const int tk = 64 * kr + c0k + 16 * kt + fr;
                bf16x8 kf[4]; float ssk = 0.f;
#pragma unroll
                for (int ks = 0; ks < 4; ++ks) { const u32x4 wv = *(const u32x4*)(NK + (size_t)tk * HW + h * 128 + 32 * ks + 8 * fq); kf[ks] = __builtin_bit_cast(bf16x8, wv);
                    ssk += bflo(wv.x) * bflo(wv.x) + bfhi(wv.x) * bfhi(wv.x) + bflo(wv.y) * bflo(wv.y) + bfhi(wv.y) * bfhi(wv.y)
                         + bflo(wv.z) * bflo(wv.z) + bfhi(wv.z) * bfhi(wv.z) + bflo(wv.w) * bflo(wv.w) + bfhi(wv.w) * bfhi(wv.w); }
                ssk += __shfl_xor(ssk, 16); ssk += __shfl_xor(ssk, 32);
                const float rk = rsqrtf(ssk * (1.0f / 128.f) + EPS);
                f32x4 acc = (f32x4){0.f, 0.f, 0.f, 0.f};
#pragma unroll
                for (int ks = 0; ks < 4; ++ks) acc = __builtin_amdgcn_mfma_f32_16x16x32_bf16(kf[ks], qf[ks], acc, 0, 0, 0);
#pragma unroll
                for (int rg = 0; rg < 4; ++rg) {
                    const int ki = 4 * fq + rg; const float rki = __shfl(rk, ki);
                    const int kcl = c0k + 16 * kt + ki; const bool valid = (kcl >= cstart) && (kcl < cstart + 16);
                    const int co = min(max(kcl - cq + 15, 0), 30);
                    const float bias = RP[(w >> 2) * 465 + row_off * 31 + co];
                    const float sv = valid ? (acc[rg] * rki + bias) : -1.0e30f;
                    s[aa][kt][rg] = sv; mx = fmaxf(mx, sv);
                }
            }
        }
        mx = fmaxf(mx, __shfl_xor(mx, 16)); mx = fmaxf(mx, __shfl_xor(mx, 32));
        float l = 0.f;
#pragma unroll
        for (int aa = 0; aa < 8; ++aa)
#pragma unroll
            for (int kt = 0; kt < 2; ++kt)
#pragma unroll
                for (int rg = 0; rg < 4; ++rg) { const float p = __expf(s[aa][kt][rg] - mx); s[aa][kt][rg] = p; l += p; }
        l += __shfl_xor(l, 16); l += __shfl_xor(l, 32);
        f32x4 o[8];
#pragma unroll
        for (int dt = 0; dt < 8; ++dt) o[dt] = (f32x4){0.f, 0.f, 0.f, 0.f};
#pragma unroll
        for (int aa = 0; aa < 8; ++aa) {
            u32x4 pw; pw.x = cvt_pk_bf16(s[aa][0][0], s[aa][0][1]); pw.y = cvt_pk_bf16(s[aa][0][2], s[aa][0][3]); pw.z = cvt_pk_bf16(s[aa][1][0], s[aa][1][1]); pw.w = cvt_pk_bf16(s[aa][1][2], s[aa][1][3]);
            const bf16x8 pb = __builtin_bit_cast(bf16x8, pw);
            const int tkb = 64 * (r_start + aa) + c0k + 4 * fq;
#pragma unroll
            for (int dt = 0; dt < 8; ++dt) {
                const bf16_t* vp = VT + (size_t)(h * 128 + 16 * dt + fr) * SEQ + tkb;
                const u32x2 v0 = *(const u32x2*)vp, v1 = *(const u32x2*)(vp + 16);
                const u32x4 vw = (u32x4){v0.x, v0.y, v1.x, v1.y};
                o[dt] = __builtin_amdgcn_mfma_f32_16x16x32_bf16(__builtin_bit_cast(bf16x8, vw), pb, o[dt], 0, 0, 0);
            }
        }
        const float inv = 1.0f / l;
#pragma unroll
        for (int dt = 0; dt < 8; ++dt) {
            const size_t off = (size_t)tq * HW + h * 128 + 16 * dt + 4 * fq;
            const u32x2 gw = *(const u32x2*)(NG + off);
            u32x2 ow; ow.x = cvt_pk_bf16(o[dt][0] * inv * bflo(gw.x), o[dt][1] * inv * bfhi(gw.x)); ow.y = cvt_pk_bf16(o[dt][2] * inv * bflo(gw.y), o[dt][3] * inv * bfhi(gw.y));
            *(u32x2*)(OB + off) = ow;
        }
        __syncthreads();
    }
}

__global__ void __launch_bounds__(512, 2) mk_fwd(Args a) {
    extern __shared__ __attribute__((aligned(16))) unsigned char lds_raw[];
    LAS unsigned char* lds = (LAS unsigned char*)lds_raw;
    volatile LAS unsigned* MISC = (volatile LAS unsigned*)(lds + LDS_MISC_OFF);
    unsigned char* ws = a.ws;
    if (threadIdx.x < 64) MISC[threadIdx.x] = 0u;
    __syncthreads();
    XcdBarrier bar; bar.bar = (unsigned*)(ws + WS_CTL) + 4096; bar.x = 0; bar.st = nullptr;
    const int lo = a.ph_lo, hi = a.ph_hi;
    if (hi - lo > 1) bar = xcd_barrier_post((unsigned*)(ws + WS_CTL) + 4096, MISC + 8);
#ifndef DIAG_MASK
#define DIAG_MASK 0x1ff
#endif
#define DM_(b) ((DIAG_MASK >> (b)) & 1)
#define IN(k) (lo <= (k) && (k) < hi)
#define SEAM(k) do { if (IN(k) && IN((k) + 1)) xcd_barrier(bar); } while (0)
    const int G = gridDim.x, c = blockIdx.x;

    if (DM_(0) && IN(0)) { p0_prologue(a, lds); }
    SEAM(0);
    for (int l = 0; l < 2; ++l) {
        const int pb = 1 + 7 * l;
        if (DM_(1) && IN(pb + 0)) {
            unsigned char* ws = opaque_ptr(a.ws); bf16_t* XGA = (bf16_t*)(ws + WS_XGA); float* SSQ = (float*)(ws + WS_SSQ);
            pg8::Gemm g{XGA, (const bf16_t*)(ws + WS_WIN) + (size_t)l * NIN * DM, SEQ, NIN, DM}; pg8::StaticOrder S; S.init(SEQ, NIN, G, c);
            EpiInProj E{SSQ + (2 * l) * SEQ, (const float*)(ws + WS_LOWER) + l * 2048, ws};
            pg8::gemm_phase<EpiInProj, pg8::StaticOrder>(lds, g, S, E);
        }
        SEAM(pb + 0);
        if (IN(pb + 1)) { if (DM_(2)) h1_phase(a, lds); if (DM_(8)) natten_phase(a, l, lds); }
        SEAM(pb + 1);
        if (DM_(3) && IN(pb + 2)) { h2_phase(a); }
        SEAM(pb + 2);
        if (DM_(4) && IN(pb + 3)) { h3_phase(a, l, lds); }
        SEAM(pb + 3);
        if (DM_(5) && IN(pb + 4)) {
            unsigned char* ws = opaque_ptr(a.ws);
            pg8::StaticOrder S; S.init(SEQ, DM, G, c);
            { pg8::Gemm g{(const bf16_t*)(ws + WS_OA), (const bf16_t*)(ws + WS_WA) + (size_t)l * DM * HW, SEQ, DM, HW};
              EpiBrA E{(const bf16_t*)(ws + WS_MA), (float*)(ws + WS_T)};
              pg8::gemm_phase<EpiBrA, pg8::StaticOrder>(lds, g, S, E); }
            { pg8::Gemm g{(const bf16_t*)(ws + WS_OB), (const bf16_t*)(ws + WS_WB) + (size_t)l * DM * HW, SEQ, DM, HW};
              EpiBrB E{(const bf16_t*)(ws + WS_MB), (const float*)(ws + WS_T), (bf16_t*)(ws + WS_Y)};
              pg8::gemm_phase<EpiBrB, pg8::StaticOrder>(lds, g, S, E); }
        }
        SEAM(pb + 4);
        if (DM_(6) && IN(pb + 5)) {
            unsigned char* ws = opaque_ptr(a.ws); bf16_t* XGB = (bf16_t*)(ws + WS_XGB); float* SSQ = (float*)(ws + WS_SSQ);
            pg8::Gemm g{(const bf16_t*)(ws + WS_Y), (const bf16_t*)(ws + WS_WO) + (size_t)l * DM * DM, SEQ, DM, DM}; pg8::StaticOrder S; S.init(SEQ, DM, G, c);
            EpiWout E{l == 0 ? a.in[0] : (const float*)a.out, (float*)(ws + WS_X1), XGB, a.in[12] + l * DM, SSQ + (2 * l + 1) * SEQ};
            pg8::gemm_phase<EpiWout, pg8::StaticOrder>(lds, g, S, E);
        }
        SEAM(pb + 5);
        if (DM_(7) && IN(pb + 6)) {
            unsigned char* ws = opaque_ptr(a.ws); bf16_t* XGA = (bf16_t*)(ws + WS_XGA); bf16_t* XGB = (bf16_t*)(ws + WS_XGB); float* SSQ = (float*)(ws + WS_SSQ);
            pg8::StaticOrder S; S.init(SEQ, DM, G, c);
            { pg8::Gemm g{(const bf16_t*)(ws + WS_PB) + (size_t)l * SEQ * PLE, (const bf16_t*)(ws + WS_WP) + (size_t)l * DM * PLE, SEQ, DM, PLE};
              EpiPL E{(float*)(ws + WS_PL)};
              pg8::gemm_phase<EpiPL, pg8::StaticOrder>(lds, g, S, E); }
            { pg8::Gemm g{XGB, (const bf16_t*)(ws + WS_WG) + (size_t)l * DM * DM, SEQ, DM, DM};
              EpiGate E{SSQ + (2 * l + 1) * SEQ, (const float*)(ws + WS_X1), (const float*)(ws + WS_PL), a.out, XGA, a.in[2] + (l + 1 < 2 ? (l + 1) * DM : 0), SSQ + (2 * l + 2 < 4 ? 2 * l + 2 : 0) * SEQ, l == 0 ? 1 : 0};
              pg8::gemm_phase<EpiGate, pg8::StaticOrder>(lds, g, S, E); }
        }
        SEAM(pb + 6);
    }
#undef IN
#undef SEAM
#if MK_ENDFLUSH
    asm volatile("s_waitcnt vmcnt(0)" ::: "memory");
    __builtin_amdgcn_fence(__ATOMIC_RELEASE, "agent");
    asm volatile("s_waitcnt vmcnt(0)" ::: "memory");
#endif
}


#ifndef MK_DIAG
#define MK_DIAG 0
#define MK_HOLE_BUF WS_MB
#define MK_HOLE_LD DM
#define MK_HOLE_MODE 0
#endif
#if MK_DIAG
__global__ void ck_sum(const void* p, size_t n, int kind, double* slot) {
    double s0 = 0.0, s1 = 0.0;
    for (size_t i = (size_t)blockIdx.x * blockDim.x + threadIdx.x; i < n; i += (size_t)gridDim.x * blockDim.x) {
        float v = kind ? bf2f(((const bf16_t*)p)[i]) : ((const float*)p)[i];
        if (!(v == v)) v = 12345.0f;
        const float wgt = (float)((int)((i * 2654435761ull >> 16) & 255) - 128);
        s0 += fabsf(v); s1 += (double)v * wgt;
    }
    for (int o = 32; o >= 1; o >>= 1) { s0 += __shfl_xor(s0, o); s1 += __shfl_xor(s1, o); }
    if ((threadIdx.x & 63) == 0) { atomicAdd(slot, s0); atomicAdd(slot + 1, s1); }
}
__global__ void ck_final(const double* sums, float* out, size_t n, int nslots) {
    int first = -1;
    for (int i = 0; i < nslots; ++i) { const double a0 = sums[2 * i], a1 = sums[2 * i + 1], b0 = sums[2 * (nslots + i)], b1 = sums[2 * (nslots + i) + 1];
        const bool bad = fabs(a0 - b0) > 1e-5 * (fabs(a0) + fabs(b0)) + 1e-30 || fabs(a1 - b1) > 1e-4 * (fabs(a0) + fabs(b0)) + 1e-30;
        if (bad) { first = i; break; } }
    const float val = first < 0 ? 0.f : 100.f * (float)(first + 1);
    for (size_t i = (size_t)blockIdx.x * blockDim.x + threadIdx.x; i < n; i += (size_t)gridDim.x * blockDim.x) out[i] = val;
}
__global__ void ck_holes(const bf16_t* p, size_t n, unsigned long long* res) {
    unsigned long long cnt = 0, mn = ~0ull;
    for (size_t i = (size_t)blockIdx.x * blockDim.x + threadIdx.x; i < n; i += (size_t)gridDim.x * blockDim.x) if (p[i] == 0xFFFFu) { ++cnt; if (i < mn) mn = i; }
    if (cnt) { atomicAdd(res, cnt); atomicMin(res + 1, mn); }
}
__global__ void ck_holes_final(const unsigned long long* res, float* out, size_t n, int mode) {
    const float val = mode == 0 ? (float)((double)res[0] / 65536.0 * 100.0) : mode == 1 ? (float)((res[1] == ~0ull ? 0 : (res[1] / 2048) ) ) + 100.f : (float)((res[1] == ~0ull ? 0 : (res[1] % 2048))) + 100.f;
    for (size_t i = (size_t)blockIdx.x * blockDim.x + threadIdx.x; i < n; i += (size_t)gridDim.x * blockDim.x) out[i] = val;
}
__global__ void ck_diff(const bf16_t* p, const bf16_t* q, size_t n, unsigned long long* res) {
    unsigned long long cnt = 0, mn = ~0ull, big = 0;
    for (size_t i = (size_t)blockIdx.x * blockDim.x + threadIdx.x; i < n; i += (size_t)gridDim.x * blockDim.x) if (p[i] != q[i]) { ++cnt; if (i < mn) mn = i; const float a = bf2f(p[i]), b = bf2f(q[i]); if (fabsf(a - b) > 0.02f * (fabsf(a) + fabsf(b))) ++big; }
    if (cnt) { atomicAdd(res, cnt); atomicMin(res + 1, mn); atomicAdd(res + 2, big); }
}
__global__ void ck_diff_final(const unsigned long long* res, float* out, size_t n, int ld) {
    const unsigned long long cnt = res[0], big = res[2];
    const float c2 = 100.f * (1.f + floorf(log2f(1.f + (float)cnt)));
    const float c1 = 1.0e6f * (1.f + floorf(log2f(1.f + (float)big)));
    for (size_t i = (size_t)blockIdx.x * blockDim.x + threadIdx.x; i < n; i += (size_t)gridDim.x * blockDim.x) out[i] = (i == 0) ? c1 : c2;
}

__device__ __forceinline__ unsigned hsh(unsigned x) { x ^= x >> 16; x *= 0x7feb352du; x ^= x >> 15; x *= 0x846ca68bu; x ^= x >> 16; return x; }
__device__ __forceinline__ float bfr(float f) { return bf2f(f2bf1(f)); }
__device__ __forceinline__ void err_max(unsigned* res, float got, float expv) { float e = fabsf(got - expv) / (0.02f + 0.02f * fabsf(expv)); if (!(e == e)) e = 1e9f; atomicMax(res, __float_as_uint(e)); }
__device__ __forceinline__ float wave_sum(float s) { for (int o = 32; o >= 1; o >>= 1) s += __shfl_xor(s, o); return s; }
__global__ void chk_inproj(const float* x, const float* g0, const float* win, const float* lbp, const unsigned char* ws, unsigned* res, int nsamp) {
    const int lane = threadIdx.x & 63, wv = (blockIdx.x * blockDim.x + threadIdx.x) >> 6, nw = (gridDim.x * blockDim.x) >> 6;
    for (int s = wv; s < nsamp; s += nw) {
        const int row = hsh(2 * s + 1) % SEQ, col = hsh(2 * s + 2) % NIN;
        float ss = 0.f, dot = 0.f;
        for (int k = lane; k < DM; k += 64) { const float xv = x[(size_t)row * DM + k]; ss += xv * xv; dot += bfr(xv * g0[k]) * bfr(win[(size_t)k * NIN + col]); }
        ss = wave_sum(ss); dot = wave_sum(dot);
        const float u = dot * rsqrtf(ss / DM + EPS);
        if (lane == 0) {
            const int seg = col >> 10, c = col & 1023; const size_t o1 = (size_t)row * HW + c;
            const float sg = 1.f / (1.f + expf(-u)), si = u * sg;
            if (seg == 0) err_max(res, bf2f(((const bf16_t*)(ws + WS_QH))[o1]), si);
            else if (seg == 1) err_max(res, bf2f(((const bf16_t*)(ws + WS_VH))[o1]), u);
            else if (seg == 2 || seg == 3) { const int dir = seg - 2; const float a0 = lbp[dir * 1024 + c], a1 = lbp[2048 + dir * 1024 + c]; const float lb = 0.f * (a0 + a1);
                const float f = lb + (1.f - lb) * sg; err_max(res + 1, ((const float*)(ws + (dir ? WS_GB : WS_GF)))[o1], logf(fmaxf(f, 1e-6f)));
                err_max(res + 1, bf2f(((const bf16_t*)(ws + (dir ? WS_KB : WS_KF)))[o1]), (1.f - lb) * (1.f - sg)); }
            else if (seg == 4) err_max(res, bf2f(((const bf16_t*)(ws + WS_HG))[o1]), si);
            else if (seg == 5) err_max(res, bf2f(((const bf16_t*)(ws + WS_NQ))[o1]), u);
            else if (seg == 6) err_max(res, bf2f(((const bf16_t*)(ws + WS_NK))[o1]), u);
            else if (seg == 7) err_max(res + 2, bf2f(((const bf16_t*)(ws + WS_VT))[(size_t)c * SEQ + row]), u);
            else if (seg == 8) err_max(res, bf2f(((const bf16_t*)(ws + WS_NG))[o1]), si);
            else if (seg < 11) err_max(res + 3, bf2f(((const bf16_t*)(ws + WS_MA))[(size_t)row * DM + col - 9216]), sg);
            else err_max(res + 9, bf2f(((const bf16_t*)(ws + WS_MB))[(size_t)row * DM + col - 11264]), sg);
        }
    }
}
__global__ void chk_natten(const unsigned char* ws, const float* gq, const float* gk, const float* rpb, unsigned* res, int nsamp) {
    const int lane = threadIdx.x & 63, wv = (blockIdx.x * blockDim.x + threadIdx.x) >> 6, nw = (gridDim.x * blockDim.x) >> 6;
    const bf16_t* NQ = (const bf16_t*)(ws + WS_NQ); const bf16_t* NK = (const bf16_t*)(ws + WS_NK); const bf16_t* VT = (const bf16_t*)(ws + WS_VT); const bf16_t* NG = (const bf16_t*)(ws + WS_NG); const bf16_t* OB = (const bf16_t*)(ws + WS_OB);
    for (int s = wv; s < nsamp; s += nw) {
        const int t = hsh(3 * s + 7) % SEQ, h = hsh(3 * s + 8) % 8; const int r = t >> 6, c = t & 63;
        const int rs0 = min(max(r - 4, 0), 120), cs0 = min(max(c - 8, 0), 48);
        float q0 = bf2f(NQ[(size_t)t * HW + h * 128 + lane]), q1 = bf2f(NQ[(size_t)t * HW + h * 128 + 64 + lane]);
        const float rq = rsqrtf(wave_sum(q0 * q0 + q1 * q1) / 128.f + EPS); q0 *= rq * gq[lane]; q1 *= rq * gq[64 + lane];
        float mx = -1e30f;
        float o0 = 0.f, o1 = 0.f, l = 0.f;
        for (int pass = 0; pass < 2; ++pass) {
            for (int a = 0; a < 8; ++a) for (int j = 0; j < 16; ++j) {
                const int kr = rs0 + a, kc = cs0 + j, tk = kr * 64 + kc;
                float k0 = bf2f(NK[(size_t)tk * HW + h * 128 + lane]), k1 = bf2f(NK[(size_t)tk * HW + h * 128 + 64 + lane]);
                const float rk = rsqrtf(wave_sum(k0 * k0 + k1 * k1) / 128.f + EPS);
                const float d = wave_sum(q0 * k0 * rk * gk[lane] + q1 * k1 * rk * gk[64 + lane]) * 0.08838834764831845f + rpb[(size_t)h * 465 + (kr - r + 7) * 31 + (kc - c + 15)];
                if (pass == 0) mx = fmaxf(mx, d);
                else { const float p = expf(d - mx); l += p; o0 += p * bf2f(VT[(size_t)(h * 128 + lane) * SEQ + tk]); o1 += p * bf2f(VT[(size_t)(h * 128 + 64 + lane) * SEQ + tk]); }
            }
        }
        const size_t ob = (size_t)t * HW + h * 128;
        err_max(res, bf2f(OB[ob + lane]), o0 / l * bf2f(NG[ob + lane])); err_max(res, bf2f(OB[ob + 64 + lane]), o1 / l * bf2f(NG[ob + 64 + lane]));
    }
}
__global__ void chk_hgrn_scan(const unsigned char* ws, float* OREF, int h0) {
    __shared__ float qs[128], ks[128], fs[128], vs[128], part[4][128];
    const int tid = threadIdx.x, v = tid & 127, kq = tid >> 7; const int h = h0 + (blockIdx.x >> 1), d = blockIdx.x & 1;
    const bf16_t* QH = (const bf16_t*)(ws + WS_QH); const bf16_t* VH = (const bf16_t*)(ws + WS_VH); const bf16_t* KK = (const bf16_t*)(ws + (d ? WS_KB : WS_KF)); const float* G = (const float*)(ws + (d ? WS_GB : WS_GF));
    float S[32];
#pragma unroll
    for (int i = 0; i < 32; ++i) S[i] = 0.f;
    float* out = OREF + (size_t)blockIdx.x * SEQ * 128;
    for (int step = 0; step < SEQ; ++step) {
        const int t = d ? SEQ - 1 - step : step;
        if (tid < 128) { qs[tid] = bf2f(QH[(size_t)t * HW + h * 128 + tid]); ks[tid] = bf2f(KK[(size_t)t * HW + h * 128 + tid]); fs[tid] = expf(G[(size_t)t * HW + h * 128 + tid]); vs[tid] = bf2f(VH[(size_t)t * HW + h * 128 + tid]); }
        __syncthreads();
        float p = 0.f; const float vv = vs[v];
#pragma unroll
        for (int i = 0; i < 32; ++i) { const int k = 32 * kq + i; S[i] = fs[k] * S[i] + ks[k] * vv; p += S[i] * qs[k]; }
        part[kq][v] = p;
        __syncthreads();
        if (tid < 128) out[(size_t)t * 128 + tid] = part[0][tid] + part[1][tid] + part[2][tid] + part[3][tid];
    }
}
__global__ void chk_hgrn_out(const unsigned char* ws, const float* OREF, const float* onorm, unsigned* res, int h0, int nh) {
    const int lane = threadIdx.x & 63, wv = (blockIdx.x * blockDim.x + threadIdx.x) >> 6, nw = (gridDim.x * blockDim.x) >> 6;
    const bf16_t* HG = (const bf16_t*)(ws + WS_HG); const bf16_t* OA = (const bf16_t*)(ws + WS_OA);
    for (int s = wv; s < nh * SEQ; s += nw) {
        const int hh = s / SEQ, t = s % SEQ, h = h0 + hh;
        const float* of = OREF + ((size_t)(2 * hh) * SEQ + t) * 128; const float* ob = OREF + ((size_t)(2 * hh + 1) * SEQ + t) * 128;
        const float a0 = of[lane] + ob[lane], a1 = of[64 + lane] + ob[64 + lane];
        const float rs = rsqrtf(wave_sum(a0 * a0 + a1 * a1) / 128.f + EPS);
        const size_t o = (size_t)t * HW + h * 128;
        err_max(res, bf2f(OA[o + lane]), a0 * rs * onorm[lane] * bf2f(HG[o + lane])); err_max(res, bf2f(OA[o + 64 + lane]), a1 * rs * onorm[64 + lane] * bf2f(HG[o + 64 + lane]));
    }
}
__global__ void chk_branch(const unsigned char* ws, const float* wa, const float* wb, unsigned* res, int nsamp) {
    const int lane = threadIdx.x & 63, wv = (blockIdx.x * blockDim.x + threadIdx.x) >> 6, nw = (gridDim.x * blockDim.x) >> 6;
    const bf16_t* OA = (const bf16_t*)(ws + WS_OA); const bf16_t* OB = (const bf16_t*)(ws + WS_OB); const bf16_t* MA = (const bf16_t*)(ws + WS_MA); const bf16_t* MB = (const bf16_t*)(ws + WS_MB); const bf16_t* Y = (const bf16_t*)(ws + WS_Y);
    for (int s = wv; s < nsamp; s += nw) {
        const int row = hsh(5 * s + 1) % SEQ, col = hsh(5 * s + 2) % DM; float da = 0.f, db = 0.f;
        for (int k = lane; k < HW; k += 64) { da += bf2f(OA[(size_t)row * HW + k]) * bfr(wa[(size_t)k * DM + col]); db += bf2f(OB[(size_t)row * HW + k]) * bfr(wb[(size_t)k * DM + col]); }
        da = wave_sum(da); db = wave_sum(db);
        if (lane == 0) err_max(res, bf2f(Y[(size_t)row * DM + col]), bf2f(MA[(size_t)row * DM + col]) * da + bf2f(MB[(size_t)row * DM + col]) * db);
    }
}
__global__ void chk_wout(const unsigned char* ws, const float* xin, const float* wo, unsigned* res, int nsamp) {
    const int lane = threadIdx.x & 63, wv = (blockIdx.x * blockDim.x + threadIdx.x) >> 6, nw = (gridDim.x * blockDim.x) >> 6;
    const bf16_t* Y = (const bf16_t*)(ws + WS_Y); const float* X1 = (const float*)(ws + WS_X1);
    for (int s = wv; s < nsamp; s += nw) {
        const int row = hsh(7 * s + 1) % SEQ, col = hsh(7 * s + 2) % DM; float d = 0.f;
        for (int k = lane; k < DM; k += 64) d += bf2f(Y[(size_t)row * DM + k]) * bfr(wo[(size_t)k * DM + col]);
        d = wave_sum(d);
        if (lane == 0) err_max(res, X1[(size_t)row * DM + col], xin[(size_t)row * DM + col] + d);
    }
}
__global__ void chk_gate(const unsigned char* ws, const float* out, const float* p, const float* wp, const float* wg, const float* pn, unsigned* res, int nsamp) {
    const int lane = threadIdx.x & 63, wv = (blockIdx.x * blockDim.x + threadIdx.x) >> 6, nw = (gridDim.x * blockDim.x) >> 6;
    const float* X1 = (const float*)(ws + WS_X1);
    for (int s = wv; s < nsamp; s += nw) {
        const int row = hsh(9 * s + 1) % SEQ, col = hsh(9 * s + 2) % DM; float d = 0.f, ss = 0.f, pl = 0.f;
        for (int k = lane; k < DM; k += 64) { const float xv = X1[(size_t)row * DM + k]; ss += xv * xv; d += bfr(xv * pn[k]) * bfr(wg[(size_t)k * DM + col]); }
        for (int k = lane; k < PLE; k += 64) pl += bfr(p[(size_t)row * PLE + k]) * bfr(wp[(size_t)k * DM + col]);
        d = wave_sum(d); ss = wave_sum(ss); pl = wave_sum(pl);
        if (lane == 0) { const float g = 1.f / (1.f + expf(-d * rsqrtf(ss / DM + EPS))); err_max(res, out[(size_t)row * DM + col], X1[(size_t)row * DM + col] + pl * g); }
    }
}
__global__ void chk_final(const unsigned* res, float* out, size_t n, int nres) {
    int first = -1; for (int i = 0; i < nres; ++i) if (__uint_as_float(res[i]) > 1.0f) { first = i; break; }
    float bucket = 0.f; if (first >= 0) { const float e = __uint_as_float(res[first]); bucket = fminf(fmaxf(floorf(log10f(e)) + 1.f, 0.f), 9.f); }
    const float val = first < 0 ? 0.f : 100.f * (float)(first + 1) + 10.f * bucket;
    for (size_t i = (size_t)blockIdx.x * blockDim.x + threadIdx.x; i < n; i += (size_t)gridDim.x * blockDim.x) out[i] = val;
}

__global__ void ck_big(const bf16_t* p, size_t n, unsigned long long* res) {
    unsigned long long c0 = 0, c2 = 0, c4 = 0; float mxv = 0.f;
    for (size_t i = (size_t)blockIdx.x * blockDim.x + threadIdx.x; i < n; i += (size_t)gridDim.x * blockDim.x) { const float v = bf2f(p[i]);
        if (!(fabsf(v) <= 3.0e38f)) ++c0; else if (fabsf(v) > 1.01f || v < -0.01f) { ++c2; mxv = fmaxf(mxv, fabsf(v)); if (v < 0.f) ++c4; } }
    if (c0 | c2) { atomicAdd(res, c0); atomicAdd(res + 2, c2); atomicAdd(res + 4, c4); atomicMax((unsigned*)(res + 3), __float_as_uint(mxv)); }
}
__global__ void ck_big_final(const unsigned long long* res, float* out, size_t n, int ld) {
    const float mxv = __uint_as_float((unsigned)res[3]);
    const float c1 = 1.0e4f * (1.f + floorf(log2f(1.f + (float)res[0])));
    const float negf = res[2] ? (float)res[4] / (float)res[2] : 0.f;
    const float c2 = 1000.f * (1.f + floorf(negf * 3.99f)) + 100.f * fminf(fmaxf(floorf(log10f(fmaxf(mxv, 1e-9f))) + 2.f, 0.f), 9.f);
    for (size_t i = (size_t)blockIdx.x * blockDim.x + threadIdx.x; i < n; i += (size_t)gridDim.x * blockDim.x) out[i] = (i == 0) ? c1 : c2;
}
struct CkBuf { int phase; int idx; size_t off; size_t n; int kind; };
#endif

extern "C" void kernel_launch(void* const* d_in, const int* in_sizes, int n_in, void* d_out, int out_size, void* d_ws, size_t ws_size, hipStream_t stream) {
    static int grid = 0;
    if (grid == 0) {
        if (n_in != 15 || out_size != SEQ * DM || ws_size < WS_END) { fprintf(stderr, "kernel_launch: unexpected problem (n_in %d, out %d, ws %zu)\n", n_in, out_size, ws_size); grid = -1; return; }
        int dev = 0, cus = 0;
        if (hipGetDevice(&dev) != hipSuccess || hipDeviceGetAttribute(&cus, hipDeviceAttributeMultiprocessorCount, dev) != hipSuccess) { grid = -1; return; }
        if (hipFuncSetAttribute((const void*)mk_fwd, hipFuncAttributeMaxDynamicSharedMemorySize, LDS_BYTES) != hipSuccess) { fprintf(stderr, "kernel_launch: hipFuncSetAttribute failed\n"); grid = -1; return; }
        int per_cu = 0;
        if (hipOccupancyMaxActiveBlocksPerMultiprocessor(&per_cu, (const void*)mk_fwd, 512, LDS_BYTES) != hipSuccess || per_cu < 1) fprintf(stderr, "kernel_launch: occupancy query says %d\n", per_cu);
        (void)hipGetLastError();
        grid = cus;
    }
    if (grid < 0) return;
    (void)hipMemsetAsync((char*)d_ws + WS_CTL, 0, CTL_ZERO_BYTES, stream);
    Args a{};
    for (int i = 0; i < 15; ++i) a.in[i] = (const float*)d_in[i];
    a.out = (float*)d_out; a.ws = (unsigned char*)d_ws;
#if MK_DIAG == 5
    {
        unsigned long long* res = (unsigned long long*)((char*)d_ws + 65536);
        (void)hipMemsetAsync((char*)d_ws + 65536 + 8, 0xFF, 8, stream);
        for (int ph = 0; ph < 2; ++ph) { a.ph_lo = ph; a.ph_hi = ph + 1; hipLaunchKernelGGL(mk_fwd, dim3(grid), dim3(512), LDS_BYTES, stream, a); }
        hipLaunchKernelGGL(ck_big, dim3(1024), dim3(256), 0, stream, (const bf16_t*)((char*)d_ws + WS_MA), (size_t)SEQ * DM, res);
        hipLaunchKernelGGL(ck_big_final, dim3(1024), dim3(256), 0, stream, (const unsigned long long*)res, (float*)d_out, (size_t)SEQ * DM, DM);
    }
#elif MK_DIAG == 4
    {
        unsigned* res = (unsigned*)((char*)d_ws + 65536);
        float* OREF = (float*)((char*)d_ws + 728 * MiB);
        const unsigned char* wsc = (const unsigned char*)d_ws;
        const float* const* in = a.in;
        for (int ph = 0; ph < NPHASE; ++ph) {
            a.ph_lo = ph; a.ph_hi = ph + 1; hipLaunchKernelGGL(mk_fwd, dim3(grid), dim3(512), LDS_BYTES, stream, a);
            if (ph == 1) hipLaunchKernelGGL(chk_inproj, dim3(512), dim3(256), 0, stream, in[0], in[2], in[3], in[4], wsc, res + 0, 32768);
            if (ph == 2) hipLaunchKernelGGL(chk_natten, dim3(256), dim3(256), 0, stream, wsc, in[6], in[7], in[8], res + 4, 1024);
            if (ph == 4) { hipLaunchKernelGGL(chk_hgrn_scan, dim3(4), dim3(512), 0, stream, wsc, OREF, 2);
                           hipLaunchKernelGGL(chk_hgrn_out, dim3(512), dim3(256), 0, stream, wsc, (const float*)OREF, in[5], res + 5, 2, 2); }
            if (ph == 5) hipLaunchKernelGGL(chk_branch, dim3(512), dim3(256), 0, stream, wsc, in[9], in[10], res + 6, 8192);
            if (ph == 6) hipLaunchKernelGGL(chk_wout, dim3(512), dim3(256), 0, stream, wsc, in[0], in[11], res + 7, 8192);
            if (ph == 7) hipLaunchKernelGGL(chk_gate, dim3(512), dim3(256), 0, stream, wsc, (const float*)d_out, in[1], in[14], in[13], in[12], res + 8, 8192);
        }
        hipLaunchKernelGGL(chk_final, dim3(1024), dim3(256), 0, stream, (const unsigned*)res, (float*)d_out, (size_t)SEQ * DM, 10);
    }
#elif MK_DIAG == 3
    {
        unsigned long long* res = (unsigned long long*)((char*)d_ws + 65536);
        bf16_t* SAVE = (bf16_t*)((char*)d_ws + 728 * MiB);
        (void)hipMemsetAsync((char*)d_ws + MiB, 0xAA, WS_END - MiB, stream);
        (void)hipMemsetAsync((char*)d_ws + 65536 + 8, 0xFF, 8, stream);
        for (int ph = 0; ph < 2; ++ph) { a.ph_lo = ph; a.ph_hi = ph + 1; hipLaunchKernelGGL(mk_fwd, dim3(grid), dim3(512), LDS_BYTES, stream, a); }
        (void)hipMemcpyAsync(SAVE, (char*)d_ws + MK_HOLE_BUF, (size_t)SEQ * MK_HOLE_LD * 2, hipMemcpyDeviceToDevice, stream);
        a.ph_lo = 1; a.ph_hi = 2; hipLaunchKernelGGL(mk_fwd, dim3(grid), dim3(512), LDS_BYTES, stream, a);
        hipLaunchKernelGGL(ck_diff, dim3(1024), dim3(256), 0, stream, (const bf16_t*)((char*)d_ws + MK_HOLE_BUF), (const bf16_t*)SAVE, (size_t)SEQ * MK_HOLE_LD, res);
        hipLaunchKernelGGL(ck_diff_final, dim3(1024), dim3(256), 0, stream, (const unsigned long long*)res, (float*)d_out, (size_t)SEQ * DM, MK_HOLE_LD);
    }
#elif MK_DIAG == 2
    {
        unsigned long long* res = (unsigned long long*)((char*)d_ws + 65536);
        (void)hipMemsetAsync((char*)d_ws + MiB, 0xAA, WS_END - MiB, stream);
        (void)hipMemsetAsync((char*)d_ws + 65536 + 8, 0xFF, 8, stream);
        a.ph_lo = 0; a.ph_hi = 1; hipLaunchKernelGGL(mk_fwd, dim3(grid), dim3(512), LDS_BYTES, stream, a);
        (void)hipMemsetAsync((char*)d_ws + MK_HOLE_BUF, 0xFF, (size_t)SEQ * MK_HOLE_LD * 2, stream);
        a.ph_lo = 1; a.ph_hi = 2; hipLaunchKernelGGL(mk_fwd, dim3(grid), dim3(512), LDS_BYTES, stream, a);
        hipLaunchKernelGGL(ck_holes, dim3(1024), dim3(256), 0, stream, (const bf16_t*)((char*)d_ws + MK_HOLE_BUF), (size_t)SEQ * MK_HOLE_LD, res);
        hipLaunchKernelGGL(ck_holes_final, dim3(1024), dim3(256), 0, stream, (const unsigned long long*)res, (float*)d_out, (size_t)SEQ * DM, MK_HOLE_MODE);
    }
#elif MK_DIAG
    {
        static const CkBuf B0[] = {
            {0, 0, WS_LOWER, 4096, 0}, {0, 1, WS_SSQ, 8192, 0}, {0, 2, WS_XGA, (size_t)SEQ * DM, 1}, {0, 3, WS_PB, (size_t)2 * SEQ * PLE, 1}, {0, 4, WS_WIN, (size_t)2 * NIN * DM, 1},
            {0, 5, WS_WA, (size_t)2 * DM * HW, 1}, {0, 6, WS_WB, (size_t)2 * DM * HW, 1}, {0, 7, WS_WO, (size_t)2 * DM * DM, 1}, {0, 8, WS_WG, (size_t)2 * DM * DM, 1}, {0, 9, WS_WP, (size_t)2 * DM * PLE, 1} };
        static const CkBuf BL[] = {
            {0, 10, WS_QH, (size_t)SEQ * HW, 1}, {0, 11, WS_VH, (size_t)SEQ * HW, 1}, {0, 12, WS_KF, (size_t)SEQ * HW, 1}, {0, 13, WS_KB, (size_t)SEQ * HW, 1}, {0, 14, WS_HG, (size_t)SEQ * HW, 1},
            {0, 15, WS_NQ, (size_t)SEQ * HW, 1}, {0, 16, WS_NK, (size_t)SEQ * HW, 1}, {0, 17, WS_VT, (size_t)SEQ * HW, 1}, {0, 18, WS_NG, (size_t)SEQ * HW, 1}, {0, 19, WS_GF, (size_t)SEQ * HW, 0},
            {0, 20, WS_GB, (size_t)SEQ * HW, 0}, {0, 21, WS_MA, (size_t)SEQ * DM, 1}, {0, 22, WS_MB, (size_t)SEQ * DM, 1},
            {1, 23, WS_LT, (size_t)2048 * 16384, 0}, {1, 24, WS_DD, (size_t)2048 * 128, 0}, {1, 25, WS_EE, (size_t)2048 * 128, 0}, {1, 26, WS_OB, (size_t)SEQ * HW, 1},
            {2, 27, WS_SP, (size_t)2048 * 16384, 1}, {3, 28, WS_OA, (size_t)SEQ * HW, 1}, {4, 29, WS_T, (size_t)SEQ * DM, 0}, {4, 30, WS_Y, (size_t)SEQ * DM, 1},
            {5, 31, WS_X1, (size_t)SEQ * DM, 0}, {5, 32, WS_XGB, (size_t)SEQ * DM, 1}, {6, 34, WS_PL, (size_t)SEQ * DM, 0}, {6, 35, (size_t)-1, (size_t)SEQ * DM, 0} };
        const int NS = 80;
        double* sums = (double*)((char*)d_ws + 65536);
        (void)hipMemsetAsync((char*)d_ws + MiB, 0xAA, WS_END - MiB, stream);
        for (int run = 0; run < 2; ++run) {
            (void)hipMemsetAsync((char*)d_ws + WS_CTL, 0, 32768, stream);
            for (int ph = 0; ph < NPHASE; ++ph) {
                a.ph_lo = ph; a.ph_hi = ph + 1; hipLaunchKernelGGL(mk_fwd, dim3(grid), dim3(512), LDS_BYTES, stream, a);
                if (ph == 0) { for (const CkBuf& b : B0) hipLaunchKernelGGL(ck_sum, dim3(1024), dim3(256), 0, stream, (const void*)((char*)d_ws + b.off), b.n, b.kind, sums + 2 * (run * NS + b.idx)); }
                else { const int l = (ph - 1) / 7, k = (ph - 1) % 7;
                    for (const CkBuf& b : BL) if (b.phase == k) hipLaunchKernelGGL(ck_sum, dim3(1024), dim3(256), 0, stream, b.off == (size_t)-1 ? (const void*)d_out : (const void*)((char*)d_ws + b.off), b.n, b.kind, sums + 2 * (run * NS + b.idx + 40 * l)); }
            }
        }
        hipLaunchKernelGGL(ck_final, dim3(1024), dim3(256), 0, stream, (const double*)sums, (float*)d_out, (size_t)SEQ * DM, NS);
    }
#elif MK_MULTI
    for (int ph = 0; ph < NPHASE; ++ph) { a.ph_lo = ph; a.ph_hi = ph + 1; hipLaunchKernelGGL(mk_fwd, dim3(grid), dim3(512), LDS_BYTES, stream, a); }
#else
    a.ph_lo = 0; a.ph_hi = NPHASE; hipLaunchKernelGGL(mk_fwd, dim3(grid), dim3(512), LDS_BYTES, stream, a);
#endif
}
```

```cpp
#include <hip/hip_runtime.h>
#include <cstdio>
#include <cstdint>

#ifndef MK_ALIGN
#define MK_ALIGN false
#endif
#ifndef MK_SP2
#define MK_SP2 false
#endif
#ifndef MK_ENDFLUSH
#define MK_ENDFLUSH 0
#endif
#ifndef MK_MULTI
#define MK_MULTI 0
#endif

#define LAS __attribute__((address_space(3)))
typedef unsigned short bf16_t;
typedef short bf16x8 __attribute__((ext_vector_type(8)));
typedef float f32x4 __attribute__((ext_vector_type(4)));
typedef float f32x2 __attribute__((ext_vector_type(2)));
typedef unsigned u32x4 __attribute__((ext_vector_type(4)));
typedef unsigned u32x2 __attribute__((ext_vector_type(2)));

constexpr int SEQ = 8192, DM = 2048, NIN = 13312, HW = 1024, PLE = 256;
constexpr float EPS = 1e-6f;
constexpr int NPHASE = 15;

constexpr size_t MiB = 1u << 20;
constexpr size_t WS_CTL = 0, CTL_ZERO_BYTES = 1 * MiB;
constexpr size_t WS_LOWER = 1 * MiB;
constexpr size_t WS_SSQ = 1 * MiB + 64 * 1024;
constexpr size_t WS_DD = 2 * MiB;
constexpr size_t WS_EE = 3 * MiB;
constexpr size_t WS_WIN = 4 * MiB;
constexpr size_t WS_WA = 108 * MiB;
constexpr size_t WS_WB = 116 * MiB;
constexpr size_t WS_WO = 124 * MiB;
constexpr size_t WS_WG = 140 * MiB;
constexpr size_t WS_WP = 156 * MiB;
constexpr size_t WS_PB = 158 * MiB;
constexpr size_t WS_XGA = 166 * MiB;
constexpr size_t WS_XGB = 198 * MiB;
constexpr size_t WS_QH = 230 * MiB;
constexpr size_t WS_VH = 246 * MiB;
constexpr size_t WS_KF = 262 * MiB;
constexpr size_t WS_KB = 278 * MiB;
constexpr size_t WS_HG = 294 * MiB;
constexpr size_t WS_NQ = 310 * MiB;
constexpr size_t WS_NK = 326 * MiB;
constexpr size_t WS_VT = 342 * MiB;
constexpr size_t WS_NG = 358 * MiB;
constexpr size_t WS_OA = 374 * MiB;
constexpr size_t WS_OB = 390 * MiB;
constexpr size_t WS_GF = 406 * MiB;
constexpr size_t WS_GB = 438 * MiB;
constexpr size_t WS_MA = 470 * MiB;
constexpr size_t WS_MB = 502 * MiB;
constexpr size_t WS_LT = 534 * MiB;
constexpr size_t WS_SP = 662 * MiB;
constexpr size_t WS_END = 726 * MiB;
constexpr size_t WS_T = WS_LT;
constexpr size_t WS_PL = WS_LT + 64 * MiB;
constexpr size_t WS_Y = WS_SP;
constexpr size_t WS_X1 = WS_GF;

constexpr int LDS_BYTES = 147456;
constexpr int LDS_MISC_OFF = 131072;

typedef __bf16 bf16x2_t __attribute__((ext_vector_type(2)));
__device__ __forceinline__ unsigned cvt_pk_bf16(float lo, float hi) { bf16x2_t v = {(__bf16)lo, (__bf16)hi}; return __builtin_bit_cast(unsigned, v); }
__device__ __forceinline__ float bf2f(unsigned short b) { return __uint_as_float(((unsigned)b) << 16); }
__device__ __forceinline__ float bflo(unsigned w) { return __uint_as_float(w << 16); }
__device__ __forceinline__ float bfhi(unsigned w) { return __uint_as_float(w & 0xffff0000u); }
__device__ __forceinline__ unsigned short f2bf1(float f) { return (unsigned short)(cvt_pk_bf16(f, 0.f) & 0xffffu); }
__device__ __forceinline__ float fast_rcp(float x) { return __builtin_amdgcn_rcpf(x); }
__device__ __forceinline__ float sigmoid_f(float x) { return fast_rcp(1.f + __expf(-x)); }
__device__ __forceinline__ float silu_f(float x) { return x * sigmoid_f(x); }

__device__ __forceinline__ int opaque_tid() { int t = threadIdx.x; asm volatile("" : "+v"(t)); return t; }
__device__ __forceinline__ unsigned char* opaque_ptr(unsigned char* p) { asm volatile("" : "+s"(p)); return p; }
__device__ __forceinline__ int opaque_bid() { int b = blockIdx.x; asm volatile("" : "+s"(b)); return b; }
namespace pg8 {
#define PG8_LAS __attribute__((address_space(3)))
constexpr int BM = 256, BK = 64, HALF = 128, HTB = HALF * BK * 2, STAGE_BYTES = 8 * HTB, NXCD = 8, WGM = 8;
__host__ __device__ __forceinline__ int lds_byte(int r, int c) { const int st = (r >> 4) * 2 + (c >> 5), rr = r & 15, cc = c & 31, ob = rr * 64 + cc * 2; return st * 1024 + (ob ^ (((ob >> 9) & 1) << 5)); }
__host__ __device__ __forceinline__ void stage_rc(int b, int& R, int& C) { const int st = b / 1024, sb = b % 1024, swz = sb ^ (((sb >> 9) & 1) << 5); R = (st >> 1) * 16 + swz / 64; C = (st & 1) * 32 + (swz % 64) / 2; }
__host__ __device__ __forceinline__ int perm32(int rho) { const int n = rho >> 4, i = rho & 15; return 8 * (i >> 2) + 4 * n + (i & 3); }

struct Unit { int pm, pn; };
struct Gemm { const bf16_t* A; const bf16_t* Bt; int M, N, K; };

struct StaticOrder {
    int nM, nN, nwg, G, c;
    __host__ __device__ void init(int M, int N, int G_, int c_) { nM = M / BM; nN = N / BM; nwg = nM * nN; G = G_; c = c_; }
    __host__ __device__ bool next(int i, Unit& u) const {
        const long L = (long)i * G + c; if (L >= nwg) return false;
        int wgid = (int)L; { const int q = nwg / NXCD, r = nwg % NXCD, xcd = wgid % NXCD, off = wgid / NXCD; wgid = (xcd < r ? xcd * (q + 1) : r * (q + 1) + (xcd - r) * q) + off; }
        const int nig = WGM * nN, gid = wgid / nig, fm = gid * WGM, gsz = (nM - fm) < WGM ? (nM - fm) : WGM;
        u.pm = fm + ((wgid % nig) % gsz); u.pn = (wgid % nig) / gsz; return true;
    }
    __device__ __forceinline__ void a_ready(const Unit&) const {}
    __device__ __forceinline__ void done(const Unit&) const {}
};

template <class Epi, class Sched, bool ALIGN_EPI = MK_ALIGN, bool SP2 = MK_SP2>
__device__ __forceinline__ void gemm_phase(PG8_LAS unsigned char* lds, const Gemm g, const Sched& S, const Epi& E) {
    const int tid = opaque_tid(), wid = __builtin_amdgcn_readfirstlane(tid >> 6), lane = tid & 63, wr = wid >> 2, wc = wid & 3, fr = lane & 15, fq = lane >> 4;
    const int K = g.K, nt = K / BK;
    unsigned voffA[2], voffB[2];
#pragma unroll
    for (int i = 0; i < 2; ++i) { int R, C; stage_rc(tid * 16 + i * 8192, R, C); const int Rb = Epi::PERM ? ((R & ~31) + perm32(R & 31)) : R;
        voffA[i] = (unsigned)(R * K + C) * 2u; voffB[i] = (unsigned)(Rb * K + C) * 2u; }
    const size_t kstep = (size_t)(BK * 2);
    const size_t hstep = (size_t)HALF * K * 2;
    const size_t tstep = 2 * hstep;
    const unsigned ldsw = (unsigned)wid * 1024u;
    const int aoff = lds_byte(wr * 64 + fr, fq * 8), boff = lds_byte(wc * 32 + fr, fq * 8);
#define PG8_SA(b, h) (((b) * 2 + (h)) * HTB)
#define PG8_SB(b, h) ((4 + (b) * 2 + (h)) * HTB)
#define PG8_STAGE(bufoff, gbase, voff) do { _Pragma("unroll") for (int _i = 0; _i < 2; ++_i) \
        __builtin_amdgcn_global_load_lds((const unsigned*)((const char*)(gbase) + (voff)[_i]), (PG8_LAS unsigned*)(lds + (bufoff) + ldsw + _i * 8192), 16, 0, 0); } while (0)
#define PG8_LDA(dst, b, h) do { _Pragma("unroll") for (int m = 0; m < 4; ++m) _Pragma("unroll") for (int k = 0; k < 2; ++k) dst[m][k] = *(const PG8_LAS bf16x8*)(lds + PG8_SA(b, h) + aoff + m * 2048 + k * 1024); } while (0)
#define PG8_LDB(dst, b, h) do { _Pragma("unroll") for (int n = 0; n < 2; ++n) _Pragma("unroll") for (int k = 0; k < 2; ++k) dst[n][k] = *(const PG8_LAS bf16x8*)(lds + PG8_SB(b, h) + boff + n * 2048 + k * 1024); } while (0)
#define PG8_MMA(ai, bj, At, Bt) do { __builtin_amdgcn_s_setprio(1); _Pragma("unroll") for (int m = 0; m < 4; ++m) _Pragma("unroll") for (int n = 0; n < 2; ++n) _Pragma("unroll") for (int k = 0; k < 2; ++k) \
        acc[ai][bj][m][n] = __builtin_amdgcn_mfma_f32_16x16x32_bf16(Bt[n][k], At[m][k], acc[ai][bj][m][n], 0, 0, 0); __builtin_amdgcn_s_setprio(0); } while (0)
#define PG8_WAIT_V(n) asm volatile("s_waitcnt vmcnt(" #n ")" ::: "memory")
#define PG8_WAIT_L(n) asm volatile("s_waitcnt lgkmcnt(" #n ")" ::: "memory")
#define PG8_BAR __builtin_amdgcn_s_barrier()
#define PG8_SCHED __builtin_amdgcn_sched_barrier(0)
    Unit cur, nxt; int ui = 0;
    if (!S.next(0, cur)) return;
    f32x4 acc[2][2][4][2];
#pragma unroll
    for (int a = 0; a < 2; ++a)
#pragma unroll
        for (int b = 0; b < 2; ++b)
#pragma unroll
            for (int m = 0; m < 4; ++m)
#pragma unroll
                for (int n = 0; n < 2; ++n) acc[a][b][m][n] = (f32x4){0.f, 0.f, 0.f, 0.f};
    bf16x8 At[4][2], B0[2][2], B1[2][2];
    const char* cA = (const char*)g.A + (size_t)cur.pm * tstep; const char* cB = (const char*)g.Bt + (size_t)cur.pn * tstep;
    S.a_ready(cur);
    if constexpr (SP2) {
        PG8_STAGE(PG8_SB(0, 0), cB, voffB); PG8_STAGE(PG8_SB(0, 1), cB + hstep, voffB); PG8_STAGE(PG8_SA(0, 0), cA, voffA); PG8_STAGE(PG8_SA(0, 1), cA + hstep, voffA);
        if (wr == 1) PG8_BAR;
        PG8_WAIT_V(2); PG8_BAR;
        PG8_STAGE(PG8_SB(1, 0), cB + kstep, voffB); PG8_STAGE(PG8_SA(1, 0), cA + kstep, voffA); PG8_STAGE(PG8_SB(1, 1), cB + hstep + kstep, voffB);
        PG8_WAIT_V(6); PG8_BAR;
    } else {
        PG8_STAGE(PG8_SB(0, 0), cB, voffB); PG8_STAGE(PG8_SA(0, 0), cA, voffA); PG8_STAGE(PG8_SB(0, 1), cB + hstep, voffB); PG8_STAGE(PG8_SA(0, 1), cA + hstep, voffA);
        if (wr == 1) PG8_BAR;
        PG8_WAIT_V(4); PG8_BAR;
        PG8_STAGE(PG8_SB(1, 0), cB + kstep, voffB); PG8_STAGE(PG8_SA(1, 0), cA + kstep, voffA); PG8_STAGE(PG8_SB(1, 1), cB + hstep + kstep, voffB);
        PG8_WAIT_V(6); PG8_BAR;
    }
    for (;;) {
        const bool has_next = S.next(ui + 1, nxt);
        const char* nA = has_next ? (const char*)g.A + (size_t)nxt.pm * tstep : cA; const char* nB = has_next ? (const char*)g.Bt + (size_t)nxt.pn * tstep : cB;
        for (int t = 0; t < nt; t += 2) {
            const bool last = (t == nt - 2);
            const char* a1 = cA + (size_t)(t + 1) * kstep;
            const char* a2 = last ? nA : cA + (size_t)(t + 2) * kstep; const char* b2 = last ? nB : cB + (size_t)(t + 2) * kstep;
            const char* a3 = a2 + kstep; const char* b3 = b2 + kstep;
            if (last && has_next) S.a_ready(nxt);
            if constexpr (SP2) {
            PG8_LDB(B0, 0, 0); PG8_LDB(B1, 0, 1); PG8_SCHED; PG8_LDA(At, 0, 0); PG8_STAGE(PG8_SA(1, 1), a1 + hstep, voffA);
            PG8_WAIT_V(8); PG8_WAIT_L(0); PG8_BAR; PG8_MMA(0, 0, At, B0); PG8_MMA(0, 1, At, B1); PG8_BAR; PG8_SCHED;
            PG8_LDA(At, 0, 1); PG8_STAGE(PG8_SB(0, 0), b2, voffB); PG8_STAGE(PG8_SB(0, 1), b2 + hstep, voffB); PG8_STAGE(PG8_SA(0, 0), a2, voffA);
            PG8_WAIT_V(8); PG8_WAIT_L(0); PG8_BAR; PG8_MMA(1, 0, At, B0); PG8_MMA(1, 1, At, B1); PG8_BAR; PG8_SCHED;
            PG8_LDB(B0, 1, 0); PG8_LDB(B1, 1, 1); PG8_SCHED; PG8_LDA(At, 1, 0); PG8_STAGE(PG8_SA(0, 1), a2 + hstep, voffA);
            PG8_WAIT_V(8); PG8_WAIT_L(0); PG8_BAR; PG8_MMA(0, 0, At, B0); PG8_MMA(0, 1, At, B1); PG8_BAR; PG8_SCHED;
            PG8_LDA(At, 1, 1); PG8_STAGE(PG8_SB(1, 0), b3, voffB); PG8_STAGE(PG8_SB(1, 1), b3 + hstep, voffB); PG8_STAGE(PG8_SA(1, 0), a3, voffA);
            PG8_WAIT_V(8); PG8_WAIT_L(0); PG8_BAR; PG8_MMA(1, 0, At, B0); PG8_MMA(1, 1, At, B1); PG8_BAR; PG8_SCHED;
            } else {
            PG8_LDB(B0, 0, 0); PG8_SCHED; PG8_LDA(At, 0, 0); PG8_STAGE(PG8_SA(1, 1), a1 + hstep, voffA);
            PG8_WAIT_L(8); PG8_BAR; PG8_WAIT_L(0); PG8_MMA(0, 0, At, B0); PG8_BAR; PG8_SCHED;
            PG8_LDB(B1, 0, 1); PG8_STAGE(PG8_SB(0, 0), b2, voffB);
            PG8_BAR; PG8_WAIT_L(0); PG8_MMA(0, 1, At, B1); PG8_BAR;
            PG8_LDA(At, 0, 1); PG8_STAGE(PG8_SA(0, 0), a2, voffA);
            PG8_BAR; PG8_WAIT_L(0); PG8_MMA(1, 0, At, B0); PG8_BAR; PG8_SCHED;
            PG8_STAGE(PG8_SB(0, 1), b2 + hstep, voffB);
            PG8_WAIT_V(6); PG8_BAR; PG8_MMA(1, 1, At, B1); PG8_BAR;
            PG8_LDB(B0, 1, 0); PG8_SCHED; PG8_LDA(At, 1, 0); PG8_STAGE(PG8_SA(0, 1), a2 + hstep, voffA);
            PG8_WAIT_L(8); PG8_BAR; PG8_WAIT_L(0); PG8_MMA(0, 0, At, B0); PG8_BAR; PG8_SCHED;
            PG8_LDB(B1, 1, 1); PG8_STAGE(PG8_SB(1, 0), b3, voffB);
            PG8_BAR; PG8_WAIT_L(0); PG8_MMA(0, 1, At, B1); PG8_BAR;
            PG8_LDA(At, 1, 1); PG8_STAGE(PG8_SA(1, 0), a3, voffA);
            PG8_BAR; PG8_WAIT_L(0); PG8_MMA(1, 0, At, B0); PG8_BAR; PG8_SCHED;
            PG8_STAGE(PG8_SB(1, 1), b3 + hstep, voffB);
            PG8_WAIT_V(6); PG8_BAR; PG8_MMA(1, 1, At, B1); PG8_BAR;
            }
        }
        if constexpr (ALIGN_EPI) { if (wr == 0) PG8_BAR; }
        E(acc, cur, wr, wc, fr, fq);
        if (!has_next) break;
#pragma unroll
        for (int a = 0; a < 2; ++a)
#pragma unroll
            for (int b = 0; b < 2; ++b)
#pragma unroll
                for (int m = 0; m < 4; ++m)
#pragma unroll
                    for (int n = 0; n < 2; ++n) acc[a][b][m][n] = (f32x4){0.f, 0.f, 0.f, 0.f};
        cur = nxt; cA = nA; cB = nB; ++ui;
        if constexpr (ALIGN_EPI) { if (wr == 1) PG8_BAR; }
    }
    PG8_WAIT_V(0);
    if constexpr (!ALIGN_EPI) { if (wr == 0) PG8_BAR; }
    PG8_BAR;
#undef PG8_SA
#undef PG8_SB
#undef PG8_STAGE
#undef PG8_LDA
#undef PG8_LDB
#undef PG8_MMA
#undef PG8_WAIT_V
#undef PG8_WAIT_L
#undef PG8_BAR
#undef PG8_SCHED
}
}

typedef f32x4 AccT[2][2][4][2];

__device__ __forceinline__ void store8_bf16(bf16_t* p, const float (&v)[8]) {
    u32x4 w; w.x = cvt_pk_bf16(v[0], v[1]); w.y = cvt_pk_bf16(v[2], v[3]); w.z = cvt_pk_bf16(v[4], v[5]); w.w = cvt_pk_bf16(v[6], v[7]);
    *(u32x4*)p = w;
}
__device__ __forceinline__ void load8_bf16(const bf16_t* p, float (&v)[8]) {
    const u32x4 w = *(const u32x4*)p;
    v[0] = bflo(w.x); v[1] = bfhi(w.x); v[2] = bflo(w.y); v[3] = bfhi(w.y); v[4] = bflo(w.z); v[5] = bfhi(w.z); v[6] = bflo(w.w); v[7] = bfhi(w.w);
}
__device__ __forceinline__ void store8_f32(float* p, const float (&v)[8]) {
    *(f32x4*)p = (f32x4){v[0], v[1], v[2], v[3]}; *(f32x4*)(p + 4) = (f32x4){v[4], v[5], v[6], v[7]};
}
__device__ __forceinline__ void load8_f32(const float* p, float (&v)[8]) {
    const f32x4 a = *(const f32x4*)p, b = *(const f32x4*)(p + 4);
    v[0] = a[0]; v[1] = a[1]; v[2] = a[2]; v[3] = a[3]; v[4] = b[0]; v[5] = b[1]; v[6] = b[2]; v[7] = b[3];
}
__device__ __forceinline__ void acc8(const AccT& acc, int ai, int bj, int m, float (&v)[8]) {
    const f32x4 a = acc[ai][bj][m][0], b = acc[ai][bj][m][1];
    v[0] = a[0]; v[1] = a[1]; v[2] = a[2]; v[3] = a[3]; v[4] = b[0]; v[5] = b[1]; v[6] = b[2]; v[7] = b[3];
}

template <int ACT> __device__ __forceinline__ void epi_plain(const AccT& acc, const float* ssq, bf16_t* dst, int ld, int row0, int c0) {
#pragma unroll
    for (int ai = 0; ai < 2; ++ai)
#pragma unroll
        for (int m = 0; m < 4; ++m) {
            const int row = row0 + ai * 128 + m * 16; const float rs = rsqrtf(ssq[row] * (1.0f / DM) + EPS);
#pragma unroll
            for (int bj = 0; bj < 2; ++bj) { float v[8]; acc8(acc, ai, bj, m, v);
#pragma unroll
                for (int e = 0; e < 8; ++e) { float z = v[e] * rs; if (ACT == 1) z = silu_f(z); if (ACT == 2) z = sigmoid_f(z); v[e] = z; }
                store8_bf16(dst + (size_t)row * ld + c0 + bj * 128, v); }
            asm volatile("" ::: "memory");
        }
}
struct EpiInProj {
    static constexpr bool PERM = true;
    const float* ssq; const float* lower; unsigned char* ws;
    __device__ __forceinline__ void operator()(const AccT& acc, const pg8::Unit& u, int wr, int wc, int fr, int fq) const {
        const int colt = u.pn * 256, seg = colt >> 10;
        const int row0 = u.pm * 256 + wr * 64 + fr;
        const int cin = wc * 32 + 8 * fq;
        const int cseg = (colt & 1023) + cin;
        if (seg == 2 || seg == 3) {
            const int dir = seg - 2;
            float* G = (float*)(ws + (dir ? WS_GB : WS_GF)); bf16_t* KK = (bf16_t*)(ws + (dir ? WS_KB : WS_KF));
#pragma unroll
            for (int bj = 0; bj < 2; ++bj) {
                const int c = cseg + bj * 128; float lb[8]; load8_f32(lower + dir * 1024 + c, lb);
#pragma unroll
                for (int ai = 0; ai < 2; ++ai)
#pragma unroll
                    for (int m = 0; m < 4; ++m) {
                        const int row = row0 + ai * 128 + m * 16; const float rs = rsqrtf(ssq[row] * (1.0f / DM) + EPS);
                        float v[8], lg[8], kk[8]; acc8(acc, ai, bj, m, v);
#pragma unroll
                        for (int e = 0; e < 8; ++e) { const float z = v[e] * rs; const float sg = sigmoid_f(z); const float f = lb[e] + (1.f - lb[e]) * sg;
                            lg[e] = __logf(fmaxf(f, 1e-6f)); kk[e] = (1.f - lb[e]) * fast_rcp(1.f + __expf(z)); }
                        store8_f32(G + (size_t)row * HW + c, lg); store8_bf16(KK + (size_t)row * HW + c, kk);
                        asm volatile("" ::: "memory");
                    }
            }
        } else if (seg == 7) {
            bf16_t* VT = (bf16_t*)(ws + WS_VT);
#pragma unroll
            for (int ai = 0; ai < 2; ++ai)
#pragma unroll
                for (int m = 0; m < 4; ++m) {
                    const int row = row0 + ai * 128 + m * 16; const float rs = rsqrtf(ssq[row] * (1.0f / DM) + EPS);
#pragma unroll
                    for (int bj = 0; bj < 2; ++bj) { float v[8]; acc8(acc, ai, bj, m, v); const int c = cseg + bj * 128;
#pragma unroll
                        for (int e = 0; e < 8; ++e) VT[(size_t)(c + e) * SEQ + row] = f2bf1(v[e] * rs); }
                }
        } else if (seg == 0) epi_plain<1>(acc, ssq, (bf16_t*)(ws + WS_QH), HW, row0, cseg);
        else if (seg == 1) epi_plain<0>(acc, ssq, (bf16_t*)(ws + WS_VH), HW, row0, cseg);
        else if (seg == 4) epi_plain<1>(acc, ssq, (bf16_t*)(ws + WS_HG), HW, row0, cseg);
        else if (seg == 5) epi_plain<0>(acc, ssq, (bf16_t*)(ws + WS_NQ), HW, row0, cseg);
        else if (seg == 6) epi_plain<0>(acc, ssq, (bf16_t*)(ws + WS_NK), HW, row0, cseg);
        else if (seg == 8) epi_plain<1>(acc, ssq, (bf16_t*)(ws + WS_NG), HW, row0, cseg);
        else if (seg < 11) epi_plain<2>(acc, ssq, (bf16_t*)(ws + WS_MA), DM, row0, colt - 9216 + cin);
        else epi_plain<2>(acc, ssq, (bf16_t*)(ws + WS_MB), DM, row0, colt - 11264 + cin);
    }
};

struct EpiBrA {
    static constexpr bool PERM = true;
    const bf16_t* MA; float* T;
    __device__ __forceinline__ void operator()(const AccT& acc, const pg8::Unit& u, int wr, int wc, int fr, int fq) const {
        const int row0 = u.pm * 256 + wr * 64 + fr, c0 = u.pn * 256 + wc * 32 + 8 * fq;
#pragma unroll
        for (int ai = 0; ai < 2; ++ai)
#pragma unroll
            for (int m = 0; m < 4; ++m) { const int row = row0 + ai * 128 + m * 16;
#pragma unroll
                for (int bj = 0; bj < 2; ++bj) { const size_t off = (size_t)row * DM + c0 + bj * 128; float v[8], g[8]; acc8(acc, ai, bj, m, v); load8_bf16(MA + off, g);
#pragma unroll
                    for (int e = 0; e < 8; ++e) v[e] *= g[e];
                    store8_f32(T + off, v); } asm volatile("" ::: "memory"); }
    }
};
struct EpiBrB {
    static constexpr bool PERM = true;
    const bf16_t* MB; const float* T; bf16_t* Y;
    __device__ __forceinline__ void operator()(const AccT& acc, const pg8::Unit& u, int wr, int wc, int fr, int fq) const {
        const int row0 = u.pm * 256 + wr * 64 + fr, c0 = u.pn * 256 + wc * 32 + 8 * fq;
#pragma unroll
        for (int ai = 0; ai < 2; ++ai)
#pragma unroll
            for (int m = 0; m < 4; ++m) { const int row = row0 + ai * 128 + m * 16;
#pragma unroll
                for (int bj = 0; bj < 2; ++bj) { const size_t off = (size_t)row * DM + c0 + bj * 128; float v[8], g[8], t[8]; acc8(acc, ai, bj, m, v); load8_bf16(MB + off, g); load8_f32(T + off, t);
#pragma unroll
                    for (int e = 0; e < 8; ++e) v[e] = t[e] + v[e] * g[e];
                    store8_bf16(Y + off, v); } asm volatile("" ::: "memory"); }
    }
};
struct EpiWout {
    static constexpr bool PERM = true;
    const float* xin; float* X1; bf16_t* XG; const float* gnorm; float* ssq_out;
    __device__ __forceinline__ void operator()(const AccT& acc, const pg8::Unit& u, int wr, int wc, int fr, int fq) const {
        const int row0 = u.pm * 256 + wr * 64 + fr, c0 = u.pn * 256 + wc * 32 + 8 * fq;
#pragma unroll
        for (int ai = 0; ai < 2; ++ai)
#pragma unroll
            for (int m = 0; m < 4; ++m) { const int row = row0 + ai * 128 + m * 16; float s = 0.f;
#pragma unroll
                for (int bj = 0; bj < 2; ++bj) { const size_t off = (size_t)row * DM + c0 + bj * 128; float v[8], xi[8], gn[8]; acc8(acc, ai, bj, m, v); load8_f32(xin + off, xi); load8_f32(gnorm + c0 + bj * 128, gn);
#pragma unroll
                    for (int e = 0; e < 8; ++e) { v[e] += xi[e]; s += v[e] * v[e]; }
                    store8_f32(X1 + off, v);
#pragma unroll
                    for (int e = 0; e < 8; ++e) v[e] *= gn[e];
                    store8_bf16(XG + off, v); }
                s += __shfl_xor(s, 16); s += __shfl_xor(s, 32);
                if (fq == 0) atomicAdd(ssq_out + row, s);
                asm volatile("" ::: "memory"); }
    }
};
struct EpiPL {
    static constexpr bool PERM = true;
    float* PL;
    __device__ __forceinline__ void operator()(const AccT& acc, const pg8::Unit& u, int wr, int wc, int fr, int fq) const {
        const int row0 = u.pm * 256 + wr * 64 + fr, c0 = u.pn * 256 + wc * 32 + 8 * fq;
#pragma unroll
        for (int ai = 0; ai < 2; ++ai)
#pragma unroll
            for (int m = 0; m < 4; ++m) { const int row = row0 + ai * 128 + m * 16;
#pragma unroll
                for (int bj = 0; bj < 2; ++bj) { float v[8]; acc8(acc, ai, bj, m, v); store8_f32(PL + (size_t)row * DM + c0 + bj * 128, v); } asm volatile("" ::: "memory"); }
    }
};
struct EpiGate {
    static constexpr bool PERM = true;
    const float* ssq1; const float* X1; const float* PL; float* xout; bf16_t* XG; const float* gnorm; float* ssq_next; int has_next;
    __device__ __forceinline__ void operator()(const AccT& acc, const pg8::Unit& u, int wr, int wc, int fr, int fq) const {
        const int row0 = u.pm * 256 + wr * 64 + fr, c0 = u.pn * 256 + wc * 32 + 8 * fq;
#pragma unroll
        for (int ai = 0; ai < 2; ++ai)
#pragma unroll
            for (int m = 0; m < 4; ++m) { const int row = row0 + ai * 128 + m * 16; const float rs = rsqrtf(ssq1[row] * (1.0f / DM) + EPS); float s = 0.f;
#pragma unroll
                for (int bj = 0; bj < 2; ++bj) { const size_t off = (size_t)row * DM + c0 + bj * 128; float v[8], x1[8], pl[8]; acc8(acc, ai, bj, m, v); load8_f32(X1 + off, x1); load8_f32(PL + off, pl);
#pragma unroll
                    for (int e = 0; e < 8; ++e) { const float g = sigmoid_f(v[e] * rs); v[e] = x1[e] + pl[e] * g; s += v[e] * v[e]; }
                    store8_f32(xout + off, v);
                    if (has_next) { float gn[8]; load8_f32(gnorm + c0 + bj * 128, gn);
#pragma unroll
                        for (int e = 0; e < 8; ++e) v[e] *= gn[e];
                        store8_bf16(XG + off, v); }
                    asm volatile("" ::: "memory"); }
                if (has_next) { s += __shfl_xor(s, 16); s += __shfl_xor(s, 32); if (fq == 0) atomicAdd(ssq_next + row, s); } }
    }
};

#define XB_TMO      128
#define XB_XCNT(j)  (256  + 64 * (j))
#define XB_XSUB(j)  (1280 + 64 * (j))
#define XB_XGEN(j)  (2304 + 64 * (j))
#define XB_TOP      3328
#define XB_TOPGEN   3392
#define XCD_BAR_WORDS 3456
#define XB_SPIN_CAP (1u << 18)
__device__ __forceinline__ unsigned xb_ld(unsigned* p)              { return __hip_atomic_load(p, __ATOMIC_RELAXED, __HIP_MEMORY_SCOPE_AGENT); }
__device__ __forceinline__ unsigned xb_add(unsigned* p, unsigned v) { return __hip_atomic_fetch_add(p, v, __ATOMIC_RELAXED, __HIP_MEMORY_SCOPE_AGENT); }
__device__ __forceinline__ unsigned xb_xcc_id() { return (unsigned)__builtin_amdgcn_s_getreg((3 << 11) | 20) & 0xFu; }
#define XB_SPIN(cond, bar) do { unsigned _sp = 0; while (cond) { __builtin_amdgcn_s_sleep(1); \
    if ((++_sp & 255u) == 0u) { if (xb_ld(&(bar)[XB_TMO])) break; if (_sp > XB_SPIN_CAP) { atomicAdd(&(bar)[XB_TMO], 1u); break; } } } } while (0)
struct XcdBarrier { unsigned* bar; unsigned x; volatile LAS unsigned* st; };
__device__ __forceinline__ XcdBarrier xcd_barrier_post(unsigned* bar, volatile LAS unsigned* st) {
    XcdBarrier b; b.bar = bar; b.x = xb_xcc_id(); b.st = st;
    if (threadIdx.x == 0) (void)xb_add(&bar[XB_XCNT(b.x)], 1u);
    return b;
}
__device__ __forceinline__ void xcd_barrier_complete(unsigned* bar, unsigned x, unsigned& nloc, unsigned& nx) {
    const unsigned G = gridDim.x * gridDim.y * gridDim.z;
    unsigned sum, cnt, mine, sp = 0u;
    for (;;) {
        sum = 0u; cnt = 0u; mine = 0u;
#pragma unroll
        for (unsigned j = 0; j < 16; ++j) { const unsigned c = xb_ld(&bar[XB_XCNT(j)]); sum += c; cnt += (c > 0u) ? 1u : 0u; mine = (j == x) ? c : mine; }
        if (sum == G) break;
        __builtin_amdgcn_s_sleep(1);
        if ((++sp & 255u) == 0u) { if (xb_ld(&bar[XB_TMO])) break; if (sp > XB_SPIN_CAP) { atomicAdd(&bar[XB_TMO], 1u); break; } }
    }
    nloc = mine > 0u ? mine : 1u; nx = cnt > 0u ? cnt : 1u;
}
__device__ __forceinline__ void xcd_barrier(const XcdBarrier& b) {
    asm volatile("s_waitcnt vmcnt(0)" ::: "memory");
    __syncthreads();
    if (threadIdx.x == 0) {
        unsigned* bar = b.bar;
        __builtin_amdgcn_s_waitcnt(0);
        unsigned nloc = b.st[0], nx = b.st[1];
        if (nloc == 0u) { xcd_barrier_complete(bar, b.x, nloc, nx); b.st[0] = nloc; b.st[1] = nx; }
        const unsigned old = xb_add(&bar[XB_XSUB(b.x)], 1u);
        const unsigned gen = old / nloc;
        if (old + 1u == (gen + 1u) * nloc) {
            __builtin_amdgcn_fence(__ATOMIC_RELEASE, "agent");
            asm volatile("s_waitcnt vmcnt(0)" ::: "memory");
            const unsigned og = xb_add(&bar[XB_TOP], 1u);
            const unsigned tg = og / nx;
            if (og + 1u == (tg + 1u) * nx) xb_add(&bar[XB_TOPGEN], 1u);
            else XB_SPIN(xb_ld(&bar[XB_TOPGEN]) == tg, bar);
            __builtin_amdgcn_fence(__ATOMIC_ACQUIRE, "agent");
            xb_add(&bar[XB_XGEN(b.x)], 1u);
            asm volatile("s_waitcnt vmcnt(0)" ::: "memory");
        } else {
            XB_SPIN(xb_ld(&bar[XB_XGEN(b.x)]) == gen, bar);
            __builtin_amdgcn_fence(__ATOMIC_ACQUIRE, "agent");
            asm volatile("s_waitcnt vmcnt(0)" ::: "memory");
        }
    }
    __syncthreads();
}

struct Args { const float* in[15]; float* out; unsigned char* ws; int ph_lo, ph_hi; };

__device__ __forceinline__ void transpose_convert(const float* __restrict__ W, bf16_t* __restrict__ WT, int K, int N, LAS float* tile, int rot) {
    const int tid = threadIdx.x, nb = gridDim.x; const int bid = (int)((blockIdx.x + (unsigned)rot) % (unsigned)nb);
    const int nkt = K / 64, ntile = nkt * (N / 64);
    for (int t = bid; t < ntile; t += nb) {
        const int tk = t % nkt, tn = t / nkt;
        const float* src = W + (size_t)(tk * 64) * N + tn * 64;
#pragma unroll
        for (int i = 0; i < 2; ++i) { const int idx = tid + i * 512; const int k = idx >> 4, c4 = idx & 15; const f32x4 v = *(const f32x4*)(src + (size_t)k * N + c4 * 4);
            LAS float* d = tile + k * 65 + c4 * 4; d[0] = v[0]; d[1] = v[1]; d[2] = v[2]; d[3] = v[3]; }
        __syncthreads();
        { const int n = tid >> 3, kq = tid & 7; float v[8];
#pragma unroll
          for (int j = 0; j < 8; ++j) v[j] = tile[(kq * 8 + j) * 65 + n];
          store8_bf16(WT + (size_t)(tn * 64 + n) * K + tk * 64 + kq * 8, v); }
        __syncthreads();
    }
}

__device__ __forceinline__ void p0_prologue(const Args& a, LAS unsigned char* lds) {
    unsigned char* ws = a.ws;
    const int tid = threadIdx.x, bid = blockIdx.x, nb = gridDim.x, gtid = bid * 512 + tid, gsz = nb * 512;
    {
        float* LOWER = (float*)(ws + WS_LOWER); const float* lbp = a.in[4];
        for (int i = gtid; i < 2048; i += gsz) { const float a0 = lbp[i], a1 = lbp[2048 + i]; LOWER[i] = 0.f; LOWER[2048 + i] = 1.f / (1.f + expf(a0 - a1)); }
        float* SSQ = (float*)(ws + WS_SSQ);
        for (int i = gtid; i < 3 * SEQ; i += gsz) SSQ[SEQ + i] = 0.f;
    }
    {
        const float* x = a.in[0]; const float* g0 = a.in[2]; bf16_t* XG = (bf16_t*)(ws + WS_XGA); float* SSQ = (float*)(ws + WS_SSQ);
        const int lane = tid & 63, gw = gtid >> 6, nw = gsz >> 6;
        for (int row = gw; row < SEQ; row += nw) {
            const f32x4* xr = (const f32x4*)(x + (size_t)row * DM); float s = 0.f;
#pragma unroll
            for (int j = 0; j < 8; ++j) { const f32x4 v = xr[j * 64 + lane]; const f32x4 g = ((const f32x4*)g0)[j * 64 + lane];
                s += v[0] * v[0] + v[1] * v[1] + v[2] * v[2] + v[3] * v[3];
                u32x2 w; w.x = cvt_pk_bf16(v[0] * g[0], v[1] * g[1]); w.y = cvt_pk_bf16(v[2] * g[2], v[3] * g[3]);
                *(u32x2*)(XG + (size_t)row * DM + (j * 64 + lane) * 4) = w; }
#pragma unroll
            for (int o = 32; o >= 1; o >>= 1) s += __shfl_xor(s, o);
            if (lane == 0) SSQ[row] = s;
        }
    }
    {
        const f32x4* p = (const f32x4*)a.in[1]; bf16_t* PB = (bf16_t*)(ws + WS_PB);
        for (int i = gtid; i < 2 * SEQ * PLE / 4; i += gsz) { const f32x4 v = p[i]; u32x2 w; w.x = cvt_pk_bf16(v[0], v[1]); w.y = cvt_pk_bf16(v[2], v[3]); *(u32x2*)(PB + (size_t)i * 4) = w; }
    }
    LAS float* tile = (LAS float*)lds;
    for (int l = 0; l < 2; ++l) {
        transpose_convert(a.in[3] + (size_t)l * DM * NIN, (bf16_t*)(ws + WS_WIN) + (size_t)l * NIN * DM, DM, NIN, tile, 0);
        transpose_convert(a.in[9] + (size_t)l * HW * DM, (bf16_t*)(ws + WS_WA) + (size_t)l * DM * HW, HW, DM, tile, 0);
        transpose_convert(a.in[10] + (size_t)l * HW * DM, (bf16_t*)(ws + WS_WB) + (size_t)l * DM * HW, HW, DM, tile, 0);
        transpose_convert(a.in[11] + (size_t)l * DM * DM, (bf16_t*)(ws + WS_WO) + (size_t)l * DM * DM, DM, DM, tile, 0);
        transpose_convert(a.in[13] + (size_t)l * DM * DM, (bf16_t*)(ws + WS_WG) + (size_t)l * DM * DM, DM, DM, tile, 0);
        transpose_convert(a.in[14] + (size_t)l * PLE * DM, (bf16_t*)(ws + WS_WP) + (size_t)l * DM * PLE, PLE, DM, tile, 128);
    }
}

constexpr int HP_ROWB = 272;
constexpr int HT_ROWB = 144;

__device__ __forceinline__ void hg_cumsum(const float* __restrict__ G, int tok0, int colg, int seg, int kc, int dir, LAS float* SEGS, float (&b)[16], float& bref, float& blast) {
    float gv[16];
#pragma unroll
    for (int i = 0; i < 16; ++i) gv[i] = G[(size_t)(tok0 + 16 * seg + i) * HW + colg];
    float c = 0.f;
#pragma unroll
    for (int i = 0; i < 16; ++i) { c += gv[i]; b[i] = c; }
    const float tot = c;
    if (dir) {
#pragma unroll
        for (int i = 0; i < 16; ++i) b[i] = tot - b[i] + gv[i];
    }
    SEGS[seg * 128 + kc] = tot;
    __syncthreads();
    const float t0 = SEGS[kc], t1 = SEGS[128 + kc], t2 = SEGS[256 + kc], t3 = SEGS[384 + kc];
    float off;
    if (!dir) { off = (seg > 0 ? t0 : 0.f) + (seg > 1 ? t1 : 0.f) + (seg > 2 ? t2 : 0.f); bref = t0 + t1; }
    else      { off = (seg < 3 ? t3 : 0.f) + (seg < 2 ? t2 : 0.f) + (seg < 1 ? t1 : 0.f); bref = t2 + t3; }
    blast = (t0 + t1) + (t2 + t3);
#pragma unroll
    for (int i = 0; i < 16; ++i) b[i] += off;
}

__device__ __forceinline__ void h1_phase(const Args& a, LAS unsigned char* lds) {
    unsigned char* ws = opaque_ptr(a.ws);
    const int tid = opaque_tid(), lane = tid & 63, w = __builtin_amdgcn_readfirstlane(tid >> 6), fr = lane & 15, fq = lane >> 4;
    const int kc = tid & 127, seg = tid >> 7;
    LAS float* SEGS = (LAS float*)lds; LAS float* SC = (LAS float*)(lds + 2048);
    LAS unsigned char* KpT = lds + 4096; LAS unsigned char* Vt = lds + 4096 + 128 * HT_ROWB;
    const bf16_t* VH = (const bf16_t*)(ws + WS_VH);
    float* LT = (float*)(ws + WS_LT); float* DD = (float*)(ws + WS_DD); float* EE = (float*)(ws + WS_EE);
    for (int item = blockIdx.x; item < 2048; item += gridDim.x) {
        const int d = item >> 10, h = (item >> 7) & 7, cs = item & 127, n = d ? 127 - cs : cs;
        const int tok0 = 64 * n, colg = h * 128 + kc;
        const float* G = (const float*)(ws + (d ? WS_GB : WS_GF)); const bf16_t* KK = (const bf16_t*)(ws + (d ? WS_KB : WS_KF));
        float b[16], bref, blast;
        hg_cumsum(G, tok0, colg, seg, kc, d, SEGS, b, bref, blast);
        {
            unsigned kw[8], vw[8];
#pragma unroll
            for (int i = 0; i < 16; i += 2) {
                const size_t o0 = (size_t)(tok0 + 16 * seg + i) * HW + colg, o1 = o0 + HW;
                const float k0 = bf2f(KK[o0]) * __expf(fminf(bref - b[i], 80.f)), k1 = bf2f(KK[o1]) * __expf(fminf(bref - b[i + 1], 80.f));
                kw[i >> 1] = cvt_pk_bf16(k0, k1);
                vw[i >> 1] = (unsigned)VH[o0] | ((unsigned)VH[o1] << 16);
            }
            LAS u32x4* kd = (LAS u32x4*)(KpT + kc * HT_ROWB + seg * 32); kd[0] = (u32x4){kw[0], kw[1], kw[2], kw[3]}; kd[1] = (u32x4){kw[4], kw[5], kw[6], kw[7]};
            LAS u32x4* vd = (LAS u32x4*)(Vt + kc * HT_ROWB + seg * 32); vd[0] = (u32x4){vw[0], vw[1], vw[2], vw[3]}; vd[1] = (u32x4){vw[4], vw[5], vw[6], vw[7]};
            if (seg == 0) { SC[kc] = __expf(blast - bref); DD[(size_t)item * 128 + kc] = __expf(blast); EE[(size_t)item * 128 + kc] = __expf(bref); }
        }
        __syncthreads();
        {
            const int vt = w;
            bf16x8 af[2];
#pragma unroll
            for (int ks = 0; ks < 2; ++ks) af[ks] = *(const LAS bf16x8*)(Vt + (16 * vt + fr) * HT_ROWB + (32 * ks + 8 * fq) * 2);
            float* dst = LT + (size_t)item * 16384;
#pragma unroll
            for (int kt = 0; kt < 8; ++kt) {
                f32x4 acc = (f32x4){0.f, 0.f, 0.f, 0.f};
#pragma unroll
                for (int ks = 0; ks < 2; ++ks) { const bf16x8 bfr = *(const LAS bf16x8*)(KpT + (16 * kt + fr) * HT_ROWB + (32 * ks + 8 * fq) * 2);
                    acc = __builtin_amdgcn_mfma_f32_16x16x32_bf16(af[ks], bfr, acc, 0, 0, 0); }
                const float sc = SC[16 * kt + fr];
#pragma unroll
                for (int r = 0; r < 4; ++r) dst[(16 * vt + 4 * fq + r) * 128 + 16 * kt + fr] = acc[r] * sc;
            }
        }
        __syncthreads();
    }
}

__device__ __forceinline__ void h2_phase(const Args& a) {
    unsigned char* ws = opaque_ptr(a.ws);
    const int tid = opaque_tid();
    const float* LT = (const float*)(ws + WS_LT); const float* DD = (const float*)(ws + WS_DD); const float* EE = (const float*)(ws + WS_EE);
    bf16_t* SP = (bf16_t*)(ws + WS_SP);
    for (int u = blockIdx.x; u < 256; u += gridDim.x) {
        const int chain = u >> 4, sub = u & 15;
        const int v = 8 * sub + (tid >> 6), k = 2 * (tid & 63);
        const size_t ibase = (size_t)chain * 128;
        float s0 = 0.f, s1 = 0.f;
        for (int cs0 = 0; cs0 < 128; cs0 += 8) {
            f32x2 lt[8], dd[8], ee[8];
#pragma unroll
            for (int j = 0; j < 8; ++j) { const size_t it = ibase + cs0 + j;
                lt[j] = *(const f32x2*)(LT + it * 16384 + v * 128 + k); dd[j] = *(const f32x2*)(DD + it * 128 + k); ee[j] = *(const f32x2*)(EE + it * 128 + k); }
#pragma unroll
            for (int j = 0; j < 8; ++j) { const size_t it = ibase + cs0 + j;
                *(unsigned*)(SP + it * 16384 + v * 128 + k) = cvt_pk_bf16(s0 * ee[j][0], s1 * ee[j][1]);
                s0 = dd[j][0] * s0 + lt[j][0]; s1 = dd[j][1] * s1 + lt[j][1]; }
        }
    }
}

__device__ __forceinline__ void h3_phase(const Args& a, int layer, LAS unsigned char* lds) {
    unsigned char* ws = opaque_ptr(a.ws);
    const int tid = opaque_tid(), lane = tid & 63, w = __builtin_amdgcn_readfirstlane(tid >> 6), fr = lane & 15, fq = lane >> 4;
    const int kc = tid & 127, seg = tid >> 7;
    LAS float* SEGS = (LAS float*)lds; LAS float* SSQP = (LAS float*)(lds + 2048);
    LAS unsigned char* Qp = lds + 4096; LAS unsigned char* Kp = Qp + 64 * HP_ROWB; LAS unsigned char* Vt = Kp + 64 * HP_ROWB; LAS unsigned char* Ab = Vt + 128 * HT_ROWB;
    const bf16_t* QH = (const bf16_t*)(ws + WS_QH); const bf16_t* VH = (const bf16_t*)(ws + WS_VH); const bf16_t* HG = (const bf16_t*)(ws + WS_HG);
    const bf16_t* SP = (const bf16_t*)(ws + WS_SP); bf16_t* OA = (bf16_t*)(ws + WS_OA);
    const float* onorm = a.in[5] + layer * 128;
    for (int item = blockIdx.x; item < 1024; item += gridDim.x) {
        const int n = item >> 3, h = item & 7;
        const int tok0 = 64 * n, colg = h * 128 + kc;
        f32x4 o[4];
#pragma unroll
        for (int j = 0; j < 4; ++j) o[j] = (f32x4){0.f, 0.f, 0.f, 0.f};
        for (int d = 0; d < 2; ++d) {
            const int cs = d ? 127 - n : n; const size_t sitem = (size_t)((d * 8 + h) * 128 + cs);
            const float* G = (const float*)(ws + (d ? WS_GB : WS_GF)); const bf16_t* KK = (const bf16_t*)(ws + (d ? WS_KB : WS_KF));
            float b[16], bref, blast;
            hg_cumsum(G, tok0, colg, seg, kc, d, SEGS, b, bref, blast);
            {
                unsigned vw[8];
#pragma unroll
                for (int i = 0; i < 16; i += 2) {
                    const size_t o0 = (size_t)(tok0 + 16 * seg + i) * HW + colg, o1 = o0 + HW;
                    const float e0 = fminf(b[i] - bref, 80.f), e1 = fminf(b[i + 1] - bref, 80.f);
                    const float q0 = bf2f(QH[o0]) * __expf(e0), q1 = bf2f(QH[o1]) * __expf(e1);
                    const float k0 = bf2f(KK[o0]) * __expf(fminf(-(b[i] - bref), 80.f)), k1 = bf2f(KK[o1]) * __expf(fminf(-(b[i + 1] - bref), 80.f));
                    *(LAS unsigned short*)(Qp + (16 * seg + i) * HP_ROWB + kc * 2) = f2bf1(q0);
                    *(LAS unsigned short*)(Qp + (16 * seg + i + 1) * HP_ROWB + kc * 2) = f2bf1(q1);
                    *(LAS unsigned short*)(Kp + (16 * seg + i) * HP_ROWB + kc * 2) = f2bf1(k0);
                    *(LAS unsigned short*)(Kp + (16 * seg + i + 1) * HP_ROWB + kc * 2) = f2bf1(k1);
                    vw[i >> 1] = (unsigned)VH[o0] | ((unsigned)VH[o1] << 16);
                }
                LAS u32x4* vd = (LAS u32x4*)(Vt + kc * HT_ROWB + seg * 32); vd[0] = (u32x4){vw[0], vw[1], vw[2], vw[3]}; vd[1] = (u32x4){vw[4], vw[5], vw[6], vw[7]};
            }
            __syncthreads();
            {
                const int rt = w >> 1;
#pragma unroll
                for (int tt = 0; tt < 2; ++tt) {
                    const int st = 2 * (w & 1) + tt;
                    const bool need = d ? (st >= rt) : (st <= rt);
                    f32x4 acc = (f32x4){0.f, 0.f, 0.f, 0.f};
                    if (need) {
#pragma unroll
                        for (int ks = 0; ks < 4; ++ks) {
                            const bf16x8 af = *(const LAS bf16x8*)(Qp + (16 * rt + fr) * HP_ROWB + (32 * ks + 8 * fq) * 2);
                            const bf16x8 bfr = *(const LAS bf16x8*)(Kp + (16 * st + fr) * HP_ROWB + (32 * ks + 8 * fq) * 2);
                            acc = __builtin_amdgcn_mfma_f32_16x16x32_bf16(af, bfr, acc, 0, 0, 0);
                        }
                    }
                    const int s_ = 16 * st + fr;
#pragma unroll
                    for (int r = 0; r < 4; ++r) { const int r_ = 16 * rt + 4 * fq + r; const bool ok = need && (d ? (s_ >= r_) : (s_ <= r_));
                        *(LAS unsigned short*)(Ab + r_ * HT_ROWB + s_ * 2) = f2bf1(ok ? acc[r] : 0.f); }
                }
            }
            __syncthreads();
            {
                const int rt = w & 3;
                bf16x8 aa[2], aq[4];
#pragma unroll
                for (int ks = 0; ks < 2; ++ks) aa[ks] = *(const LAS bf16x8*)(Ab + (16 * rt + fr) * HT_ROWB + (32 * ks + 8 * fq) * 2);
#pragma unroll
                for (int ks = 0; ks < 4; ++ks) aq[ks] = *(const LAS bf16x8*)(Qp + (16 * rt + fr) * HP_ROWB + (32 * ks + 8 * fq) * 2);
                const bf16_t* spb = SP + sitem * 16384;
#pragma unroll
                for (int j = 0; j < 4; ++j) {
                    const int vt = 4 * (w >> 2) + j;
#pragma unroll
                    for (int ks = 0; ks < 2; ++ks) { const bf16x8 bfr = *(const LAS bf16x8*)(Vt + (16 * vt + fr) * HT_ROWB + (32 * ks + 8 * fq) * 2);
                        o[j] = __builtin_amdgcn_mfma_f32_16x16x32_bf16(aa[ks], bfr, o[j], 0, 0, 0); }
#pragma unroll
                    for (int ks = 0; ks < 4; ++ks) { const bf16x8 bfr = *(const bf16x8*)(spb + (16 * vt + fr) * 128 + 32 * ks + 8 * fq);
                        o[j] = __builtin_amdgcn_mfma_f32_16x16x32_bf16(aq[ks], bfr, o[j], 0, 0, 0); }
                }
            }
            __syncthreads();
        }
        {
            const int rt = w & 3;
            float pr[4];
#pragma unroll
            for (int r = 0; r < 4; ++r) { float s = 0.f;
#pragma unroll
                for (int j = 0; j < 4; ++j) s += o[j][r] * o[j][r];
                s += __shfl_xor(s, 1); s += __shfl_xor(s, 2); s += __shfl_xor(s, 4); s += __shfl_xor(s, 8); pr[r] = s; }
            if (fr == 0) {
#pragma unroll
                for (int r = 0; r < 4; ++r) SSQP[(w >> 2) * 64 + 16 * rt + 4 * fq + r] = pr[r]; }
            __syncthreads();
#pragma unroll
            for (int r = 0; r < 4; ++r) {
                const int row = 16 * rt + 4 * fq + r; const float rs = rsqrtf((SSQP[row] + SSQP[64 + row]) * (1.0f / 128.f) + EPS);
#pragma unroll
                for (int j = 0; j < 4; ++j) { const int v = 16 * (4 * (w >> 2) + j) + fr; const size_t off = (size_t)(tok0 + row) * HW + h * 128 + v;
                    OA[off] = f2bf1(o[j][r] * rs * onorm[v] * bf2f(HG[off])); }
            }
            __syncthreads();
        }
    }
}

__device__ __forceinline__ void natten_phase(const Args& a, int layer, LAS unsigned char* lds) {
    unsigned char* ws = opaque_ptr(a.ws);
    const int tid = opaque_tid(), lane = tid & 63, w = __builtin_amdgcn_readfirstlane(tid >> 6), fr = lane & 15, fq = lane >> 4;
    LAS float* RP = (LAS float*)lds;
    const bf16_t* NQ = (const bf16_t*)(ws + WS_NQ); const bf16_t* NK = (const bf16_t*)(ws + WS_NK); const bf16_t* VT = (const bf16_t*)(ws + WS_VT);
    const bf16_t* NG = (const bf16_t*)(ws + WS_NG); bf16_t* OB = (bf16_t*)(ws + WS_OB);
    const float* gq = a.in[6] + layer * 128; const float* gk = a.in[7] + layer * 128; const float* rpb = a.in[8] + (size_t)layer * 8 * 465;
    for (int it = blockIdx.x; it < 512; it += gridDim.x) {
        const int r = it >> 2, hp = it & 3, h = 2 * hp + (w >> 2), j = w & 3;
        for (int i = tid; i < 930; i += 512) RP[i] = rpb[(size_t)(2 * hp) * 465 + i];
        __syncthreads();
        const int r_start = min(max(r - 4, 0), 120);
        const int c0k = (j == 0) ? 0 : (j == 1) ? 8 : (j == 2) ? 24 : 32;
        const int cq = 16 * j + fr, tq = 64 * r + cq;
        const int cstart = min(max(cq - 8, 0), 48);
        bf16x8 qf[4];
        {
            float qv[4][8]; float ss = 0.f;
#pragma unroll
            for (int ks = 0; ks < 4; ++ks) { load8_bf16(NQ + (size_t)tq * HW + h * 128 + 32 * ks + 8 * fq, qv[ks]);
#pragma unroll
                for (int e = 0; e < 8; ++e) ss += qv[ks][e] * qv[ks][e]; }
            ss += __shfl_xor(ss, 16); ss += __shfl_xor(ss, 32);
            const float rq = rsqrtf(ss * (1.0f / 128.f) + EPS) * 0.08838834764831845f;
#pragma unroll
            for (int ks = 0; ks < 4; ++ks) { float g1[8], g2[8]; load8_f32(gq + 32 * ks + 8 * fq, g1); load8_f32(gk + 32 * ks + 8 * fq, g2);
                u32x4 wv;
                wv.x = cvt_pk_bf16(qv[ks][0] * rq * g1[0] * g2[0], qv[ks][1] * rq * g1[1] * g2[1]); wv.y = cvt_pk_bf16(qv[ks][2] * rq * g1[2] * g2[2], qv[ks][3] * rq * g1[3] * g2[3]);
                wv.z = cvt_pk_bf16(qv[ks][4] * rq * g1[4] * g2[4], qv[ks][5] * rq * g1[5] * g2[5]); wv.w = cvt_pk_bf16(qv[ks][6] * rq * g1[6] * g2[6], qv[ks][7] * rq * g1[7] * g2[7]);
                qf[ks] = __builtin_bit_cast(bf16x8, wv); }
        }
        float s[8][2][4];
        float mx = -3.0e38f;
#pragma unroll
        for (int aa = 0; aa < 8; ++aa) {
            const int kr = r_start + aa, row_off = kr - r + 7;
#pragma unroll
            for (int kt = 0; kt < 2; ++kt) {
                const int tk = 64 * kr + c0k + 16 * kt + fr;
                bf16x8 kf[4]; float ssk = 0.f;
#pragma unroll
                for (int ks = 0; ks < 4; ++ks) { const u32x4 wv = *(const u32x4*)(NK + (size_t)tk * HW + h * 128 + 32 * ks + 8 * fq); kf[ks] = __builtin_bit_cast(bf16x8, wv);
                    ssk += bflo(wv.x) * bflo(wv.x) + bfhi(wv.x) * bfhi(wv.x) + bflo(wv.y) * bflo(wv.y) + bfhi(wv.y) * bfhi(wv.y)
                         + bflo(wv.z) * bflo(wv.z) + bfhi(wv.z) * bfhi(wv.z) + bflo(wv.w) * bflo(wv.w) + bfhi(wv.w) * bfhi(wv.w); }
                ssk += __shfl_xor(ssk, 16); ssk += __shfl_xor(ssk, 32);
                const float rk = rsqrtf(ssk * (1.0f / 128.f) + EPS);
                f32x4 acc = (f32x4){0.f, 0.f, 0.f, 0.f};
#pragma unroll
                for (int ks = 0; ks < 4; ++ks) acc = __builtin_amdgcn_mfma_f32_16x16x32_bf16(kf[ks], qf[ks], acc, 0, 0, 0);
#pragma unroll
                for (int rg = 0; rg < 4; ++rg) {
                    const int ki = 4 * fq + rg; const float rki = __shfl(rk, ki);
                    const int kcl = c0k + 16 * kt + ki; const bool valid = (kcl >= cstart) && (kcl < cstart + 16);
                    const int co = min(max(kcl - cq + 15, 0), 30);
                    const float bias = RP[(w >> 2) * 465 + row_off * 31 + co];
                    const float sv = valid ? (acc[rg] * rki + bias) : -1.0e30f;
                    s[aa][kt][rg] = sv; mx = fmaxf(mx, sv);
                }
            }
        }
        mx = fmaxf(mx, __shfl_xor(mx, 16)); mx = fmaxf(mx, __shfl_xor(mx, 32));
        float l = 0.f;
#pragma unroll
        for (int aa = 0; aa < 8; ++aa)
#pragma unroll
            for (int kt = 0; kt < 2; ++kt)
#pragma unroll
                for (int rg = 0; rg < 4; ++rg) { const float p = __expf(s[aa][kt][rg] - mx); s[aa][kt][rg] = p; l += p; }
        l += __shfl_xor(l, 16); l += __shfl_xor(l, 32);
        f32x4 o[8];
#pragma unroll
        for (int dt = 0; dt < 8; ++dt) o[dt] = (f32x4){0.f, 0.f, 0.f, 0.f};
#pragma unroll
        for (int aa = 0; aa < 8; ++aa) {
            u32x4 pw; pw.x = cvt_pk_bf16(s[aa][0][0], s[aa][0][1]); pw.y = cvt_pk_bf16(s[aa][0][2], s[aa][0][3]); pw.z = cvt_pk_bf16(s[aa][1][0], s[aa][1][1]); pw.w = cvt_pk_bf16(s[aa][1][2], s[aa][1][3]);
            const bf16x8 pb = __builtin_bit_cast(bf16x8, pw);
            const int tkb = 64 * (r_start + aa) + c0k + 4 * fq;
#pragma unroll
            for (int dt = 0; dt < 8; ++dt) {
                const bf16_t* vp = VT + (size_t)(h * 128 + 16 * dt + fr) * SEQ + tkb;
                const u32x2 v0 = *(const u32x2*)vp, v1 = *(const u32x2*)(vp + 16);
                const u32x4 vw = (u32x4){v0.x, v0.y, v1.x, v1.y};
                o[dt] = __builtin_amdgcn_mfma_f32_16x16x32_bf16(__builtin_bit_cast(bf16x8, vw), pb, o[dt], 0, 0, 0);
            }
        }
        const float inv = 1.0f / l;
#pragma unroll
        for (int dt = 0; dt < 8; ++dt) {
            const size_t off = (size_t)tq * HW + h * 128 + 16 * dt + 4 * fq;
            const u32x2 gw = *(const u32x2*)(NG + off);
            u32x2 ow; ow.x = cvt_pk_bf16(o[dt][0] * inv * bflo(gw.x), o[dt][1] * inv * bfhi(gw.x)); ow.y = cvt_pk_bf16(o[dt][2] * inv * bflo(gw.y), o[dt][3] * inv * bfhi(gw.y));
            *(u32x2*)(OB + off) = ow;
        }
        __syncthreads();
    }
}

__global__ void __launch_bounds__(512, 2) mk_fwd(Args a) {
    extern __shared__ __attribute__((aligned(16))) unsigned char lds_raw[];
    LAS unsigned char* lds = (LAS unsigned char*)lds_raw;
    volatile LAS unsigned* MISC = (volatile LAS unsigned*)(lds + LDS_MISC_OFF);
    unsigned char* ws = a.ws;
    if (threadIdx.x < 64) MISC[threadIdx.x] = 0u;
    __syncthreads();
    XcdBarrier bar; bar.bar = (unsigned*)(ws + WS_CTL) + 4096; bar.x = 0; bar.st = nullptr;
    const int lo = a.ph_lo, hi = a.ph_hi;
    if (hi - lo > 1) bar = xcd_barrier_post((unsigned*)(ws + WS_CTL) + 4096, MISC + 8);
#ifndef DIAG_MASK
#define DIAG_MASK 0x1ff
#endif
#define DM_(b) ((DIAG_MASK >> (b)) & 1)
#define IN(k) (lo <= (k) && (k) < hi)
#define SEAM(k) do { if (IN(k) && IN((k) + 1)) xcd_barrier(bar); } while (0)
    const int G = gridDim.x, c = blockIdx.x;

    if (DM_(0) && IN(0)) { p0_prologue(a, lds); }
    SEAM(0);
    for (int l = 0; l < 2; ++l) {
        const int pb = 1 + 7 * l;
        if (DM_(1) && IN(pb + 0)) {
            unsigned char* ws = opaque_ptr(a.ws); bf16_t* XGA = (bf16_t*)(ws + WS_XGA); float* SSQ = (float*)(ws + WS_SSQ);
            pg8::Gemm g{XGA, (const bf16_t*)(ws + WS_WIN) + (size_t)l * NIN * DM, SEQ, NIN, DM}; pg8::StaticOrder S; S.init(SEQ, NIN, G, c);
            EpiInProj E{SSQ + (2 * l) * SEQ, (const float*)(ws + WS_LOWER) + l * 2048, ws};
            pg8::gemm_phase<EpiInProj, pg8::StaticOrder>(lds, g, S, E);
        }
        SEAM(pb + 0);
        if (IN(pb + 1)) { if (DM_(2)) h1_phase(a, lds); if (DM_(8)) natten_phase(a, l, lds); }
        SEAM(pb + 1);
        if (DM_(3) && IN(pb + 2)) { h2_phase(a); }
        SEAM(pb + 2);
        if (DM_(4) && IN(pb + 3)) { h3_phase(a, l, lds); }
        SEAM(pb + 3);
        if (DM_(5) && IN(pb + 4)) {
            unsigned char* ws = opaque_ptr(a.ws);
            pg8::StaticOrder S; S.init(SEQ, DM, G, c);
            { pg8::Gemm g{(const bf16_t*)(ws + WS_OA), (const bf16_t*)(ws + WS_WA) + (size_t)l * DM * HW, SEQ, DM, HW};
              EpiBrA E{(const bf16_t*)(ws + WS_MA), (float*)(ws + WS_T)};
              pg8::gemm_phase<EpiBrA, pg8::StaticOrder>(lds, g, S, E); }
            { pg8::Gemm g{(const bf16_t*)(ws + WS_OB), (const bf16_t*)(ws + WS_WB) + (size_t)l * DM * HW, SEQ, DM, HW};
              EpiBrB E{(const bf16_t*)(ws + WS_MB), (const float*)(ws + WS_T), (bf16_t*)(ws + WS_Y)};
              pg8::gemm_phase<EpiBrB, pg8::StaticOrder>(lds, g, S, E); }
        }
        SEAM(pb + 4);
        if (DM_(6) && IN(pb + 5)) {
            unsigned char* ws = opaque_ptr(a.ws); bf16_t* XGB = (bf16_t*)(ws + WS_XGB); float* SSQ = (float*)(ws + WS_SSQ);
            pg8::Gemm g{(const bf16_t*)(ws + WS_Y), (const bf16_t*)(ws + WS_WO) + (size_t)l * DM * DM, SEQ, DM, DM}; pg8::StaticOrder S; S.init(SEQ, DM, G, c);
            EpiWout E{l == 0 ? a.in[0] : (const float*)a.out, (float*)(ws + WS_X1), XGB, a.in[12] + l * DM, SSQ + (2 * l + 1) * SEQ};
            pg8::gemm_phase<EpiWout, pg8::StaticOrder>(lds, g, S, E);
        }
        SEAM(pb + 5);
        if (DM_(7) && IN(pb + 6)) {
            unsigned char* ws = opaque_ptr(a.ws); bf16_t* XGA = (bf16_t*)(ws + WS_XGA); bf16_t* XGB = (bf16_t*)(ws + WS_XGB); float* SSQ = (float*)(ws + WS_SSQ);
            pg8::StaticOrder S; S.init(SEQ, DM, G, c);
            { pg8::Gemm g{(const bf16_t*)(ws + WS_PB) + (size_t)l * SEQ * PLE, (const bf16_t*)(ws + WS_WP) + (size_t)l * DM * PLE, SEQ, DM, PLE};
              EpiPL E{(float*)(ws + WS_PL)};
              pg8::gemm_phase<EpiPL, pg8::StaticOrder>(lds, g, S, E); }
            { pg8::Gemm g{XGB, (const bf16_t*)(ws + WS_WG) + (size_t)l * DM * DM, SEQ, DM, DM};
              EpiGate E{SSQ + (2 * l + 1) * SEQ, (const float*)(ws + WS_X1), (const float*)(ws + WS_PL), a.out, XGA, a.in[2] + (l + 1 < 2 ? (l + 1) * DM : 0), SSQ + (2 * l + 2 < 4 ? 2 * l + 2 : 0) * SEQ, l == 0 ? 1 : 0};
              pg8::gemm_phase<EpiGate, pg8::StaticOrder>(lds, g, S, E); }
        }
        SEAM(pb + 6);
    }
#undef IN
#undef SEAM
#if MK_ENDFLUSH
    asm volatile("s_waitcnt vmcnt(0)" ::: "memory");
    __builtin_amdgcn_fence(__ATOMIC_RELEASE, "agent");
    asm volatile("s_waitcnt vmcnt(0)" ::: "memory");
#endif
}


#ifndef MK_DIAG
#define MK_DIAG 0
#define MK_HOLE_BUF WS_MB
#define MK_HOLE_LD DM
#define MK_HOLE_MODE 0
#endif
#if MK_DIAG
__global__ void ck_sum(const void* p, size_t n, int kind, double* slot) {
    double s0 = 0.0, s1 = 0.0;
    for (size_t i = (size_t)blockIdx.x * blockDim.x + threadIdx.x; i < n; i += (size_t)gridDim.x * blockDim.x) {
        float v = kind ? bf2f(((const bf16_t*)p)[i]) : ((const float*)p)[i];
        if (!(v == v)) v = 12345.0f;
        const float wgt = (float)((int)((i * 2654435761ull >> 16) & 255) - 128);
        s0 += fabsf(v); s1 += (double)v * wgt;
    }
    for (int o = 32; o >= 1; o >>= 1) { s0 += __shfl_xor(s0, o); s1 += __shfl_xor(s1, o); }
    if ((threadIdx.x & 63) == 0) { atomicAdd(slot, s0); atomicAdd(slot + 1, s1); }
}
__global__ void ck_final(const double* sums, float* out, size_t n, int nslots) {
    int first = -1;
    for (int i = 0; i < nslots; ++i) { const double a0 = sums[2 * i], a1 = sums[2 * i + 1], b0 = sums[2 * (nslots + i)], b1 = sums[2 * (nslots + i) + 1];
        const bool bad = fabs(a0 - b0) > 1e-5 * (fabs(a0) + fabs(b0)) + 1e-30 || fabs(a1 - b1) > 1e-4 * (fabs(a0) + fabs(b0)) + 1e-30;
        if (bad) { first = i; break; } }
    const float val = first < 0 ? 0.f : 100.f * (float)(first + 1);
    for (size_t i = (size_t)blockIdx.x * blockDim.x + threadIdx.x; i < n; i += (size_t)gridDim.x * blockDim.x) out[i] = val;
}
__global__ void ck_holes(const bf16_t* p, size_t n, unsigned long long* res) {
    unsigned long long cnt = 0, mn = ~0ull;
    for (size_t i = (size_t)blockIdx.x * blockDim.x + threadIdx.x; i < n; i += (size_t)gridDim.x * blockDim.x) if (p[i] == 0xFFFFu) { ++cnt; if (i < mn) mn = i; }
    if (cnt) { atomicAdd(res, cnt); atomicMin(res + 1, mn); }
}
__global__ void ck_holes_final(const unsigned long long* res, float* out, size_t n, int mode) {
    const float val = mode == 0 ? (float)((double)res[0] / 65536.0 * 100.0) : mode == 1 ? (float)((res[1] == ~0ull ? 0 : (res[1] / 2048) ) ) + 100.f : (float)((res[1] == ~0ull ? 0 : (res[1] % 2048))) + 100.f;
    for (size_t i = (size_t)blockIdx.x * blockDim.x + threadIdx.x; i < n; i += (size_t)gridDim.x * blockDim.x) out[i] = val;
}
__global__ void ck_diff(const bf16_t* p, const bf16_t* q, size_t n, unsigned long long* res) {
    unsigned long long cnt = 0, mn = ~0ull, big = 0;
    for (size_t i = (size_t)blockIdx.x * blockDim.x + threadIdx.x; i < n; i += (size_t)gridDim.x * blockDim.x) if (p[i] != q[i]) { ++cnt; if (i < mn) mn = i; const float a = bf2f(p[i]), b = bf2f(q[i]); if (fabsf(a - b) > 0.02f * (fabsf(a) + fabsf(b))) ++big; }
    if (cnt) { atomicAdd(res, cnt); atomicMin(res + 1, mn); atomicAdd(res + 2, big); }
}
__global__ void ck_diff_final(const unsigned long long* res, float* out, size_t n, int ld) {
    const unsigned long long cnt = res[0], big = res[2];
    const float c2 = 100.f * (1.f + floorf(log2f(1.f + (float)cnt)));
    const float c1 = 1.0e6f * (1.f + floorf(log2f(1.f + (float)big)));
    for (size_t i = (size_t)blockIdx.x * blockDim.x + threadIdx.x; i < n; i += (size_t)gridDim.x * blockDim.x) out[i] = (i == 0) ? c1 : c2;
}

__device__ __forceinline__ unsigned hsh(unsigned x) { x ^= x >> 16; x *= 0x7feb352du; x ^= x >> 15; x *= 0x846ca68bu; x ^= x >> 16; return x; }
__device__ __forceinline__ float bfr(float f) { return bf2f(f2bf1(f)); }
__device__ __forceinline__ void err_max(unsigned* res, float got, float expv) { float e = fabsf(got - expv) / (0.02f + 0.02f * fabsf(expv)); if (!(e == e)) e = 1e9f; atomicMax(res, __float_as_uint(e)); }
__device__ __forceinline__ float wave_sum(float s) { for (int o = 32; o >= 1; o >>= 1) s += __shfl_xor(s, o); return s; }
__global__ void chk_inproj(const float* x, const float* g0, const float* win, const float* lbp, const unsigned char* ws, unsigned* res, int nsamp) {
    const int lane = threadIdx.x & 63, wv = (blockIdx.x * blockDim.x + threadIdx.x) >> 6, nw = (gridDim.x * blockDim.x) >> 6;
    for (int s = wv; s < nsamp; s += nw) {
        const int row = hsh(2 * s + 1) % SEQ, col = hsh(2 * s + 2) % NIN;
        float ss = 0.f, dot = 0.f;
        for (int k = lane; k < DM; k += 64) { const float xv = x[(size_t)row * DM + k]; ss += xv * xv; dot += bfr(xv * g0[k]) * bfr(win[(size_t)k * NIN + col]); }
        ss = wave_sum(ss); dot = wave_sum(dot);
        const float u = dot * rsqrtf(ss / DM + EPS);
        if (lane == 0) {
            const int seg = col >> 10, c = col & 1023; const size_t o1 = (size_t)row * HW + c;
            const float sg = 1.f / (1.f + expf(-u)), si = u * sg;
            if (seg == 0) err_max(res, bf2f(((const bf16_t*)(ws + WS_QH))[o1]), si);
            else if (seg == 1) err_max(res, bf2f(((const bf16_t*)(ws + WS_VH))[o1]), u);
            else if (seg == 2 || seg == 3) { const int dir = seg - 2; const float a0 = lbp[dir * 1024 + c], a1 = lbp[2048 + dir * 1024 + c]; const float lb = 0.f * (a0 + a1);
                const float f = lb + (1.f - lb) * sg; err_max(res + 1, ((const float*)(ws + (dir ? WS_GB : WS_GF)))[o1], logf(fmaxf(f, 1e-6f)));
                err_max(res + 1, bf2f(((const bf16_t*)(ws + (dir ? WS_KB : WS_KF)))[o1]), (1.f - lb) * (1.f - sg)); }
            else if (seg == 4) err_max(res, bf2f(((const bf16_t*)(ws + WS_HG))[o1]), si);
            else if (seg == 5) err_max(res, bf2f(((const bf16_t*)(ws + WS_NQ))[o1]), u);
            else if (seg == 6) err_max(res, bf2f(((const bf16_t*)(ws + WS_NK))[o1]), u);
            else if (seg == 7) err_max(res + 2, bf2f(((const bf16_t*)(ws + WS_VT))[(size_t)c * SEQ + row]), u);
            else if (seg == 8) err_max(res, bf2f(((const bf16_t*)(ws + WS_NG))[o1]), si);
            else if (seg < 11) err_max(res + 3, bf2f(((const bf16_t*)(ws + WS_MA))[(size_t)row * DM + col - 9216]), sg);
            else err_max(res + 9, bf2f(((const bf16_t*)(ws + WS_MB))[(size_t)row * DM + col - 11264]), sg);
        }
    }
}
__global__ void chk_natten(const unsigned char* ws, const float* gq, const float* gk, const float* rpb, unsigned* res, int nsamp) {
    const int lane = threadIdx.x & 63, wv = (blockIdx.x * blockDim.x + threadIdx.x) >> 6, nw = (gridDim.x * blockDim.x) >> 6;
    const bf16_t* NQ = (const bf16_t*)(ws + WS_NQ); const bf16_t* NK = (const bf16_t*)(ws + WS_NK); const bf16_t* VT = (const bf16_t*)(ws + WS_VT); const bf16_t* NG = (const bf16_t*)(ws + WS_NG); const bf16_t* OB = (const bf16_t*)(ws + WS_OB);
    for (int s = wv; s < nsamp; s += nw) {
        const int t = hsh(3 * s + 7) % SEQ, h = hsh(3 * s + 8) % 8; const int r = t >> 6, c = t & 63;
        const int rs0 = min(max(r - 4, 0), 120), cs0 = min(max(c - 8, 0), 48);
        float q0 = bf2f(NQ[(size_t)t * HW + h * 128 + lane]), q1 = bf2f(NQ[(size_t)t * HW + h * 128 + 64 + lane]);
        const float rq = rsqrtf(wave_sum(q0 * q0 + q1 * q1) / 128.f + EPS); q0 *= rq * gq[lane]; q1 *= rq * gq[64 + lane];
        float mx = -1e30f;
        float o0 = 0.f, o1 = 0.f, l = 0.f;
        for (int pass = 0; pass < 2; ++pass) {
            for (int a = 0; a < 8; ++a) for (int j = 0; j < 16; ++j) {
                const int kr = rs0 + a, kc = cs0 + j, tk = kr * 64 + kc;
                float k0 = bf2f(NK[(size_t)tk * HW + h * 128 + lane]), k1 = bf2f(NK[(size_t)tk * HW + h * 128 + 64 + lane]);
                const float rk = rsqrtf(wave_sum(k0 * k0 + k1 * k1) / 128.f + EPS);
                const float d = wave_sum(q0 * k0 * rk * gk[lane] + q1 * k1 * rk * gk[64 + lane]) * 0.08838834764831845f + rpb[(size_t)h * 465 + (kr - r + 7) * 31 + (kc - c + 15)];
                if (pass == 0) mx = fmaxf(mx, d);
                else { const float p = expf(d - mx); l += p; o0 += p * bf2f(VT[(size_t)(h * 128 + lane) * SEQ + tk]); o1 += p * bf2f(VT[(size_t)(h * 128 + 64 + lane) * SEQ + tk]); }
            }
        }
        const size_t ob = (size_t)t * HW + h * 128;
        err_max(res, bf2f(OB[ob + lane]), o0 / l * bf2f(NG[ob + lane])); err_max(res, bf2f(OB[ob + 64 + lane]), o1 / l * bf2f(NG[ob + 64 + lane]));
    }
}
__global__ void chk_hgrn_scan(const unsigned char* ws, float* OREF, int h0) {
    __shared__ float qs[128], ks[128], fs[128], vs[128], part[4][128];
    const int tid = threadIdx.x, v = tid & 127, kq = tid >> 7; const int h = h0 + (blockIdx.x >> 1), d = blockIdx.x & 1;
    const bf16_t* QH = (const bf16_t*)(ws + WS_QH); const bf16_t* VH = (const bf16_t*)(ws + WS_VH); const bf16_t* KK = (const bf16_t*)(ws + (d ? WS_KB : WS_KF)); const float* G = (const float*)(ws + (d ? WS_GB : WS_GF));
    float S[32];
#pragma unroll
    for (int i = 0; i < 32; ++i) S[i] = 0.f;
    float* out = OREF + (size_t)blockIdx.x * SEQ * 128;
    for (int step = 0; step < SEQ; ++step) {
        const int t = d ? SEQ - 1 - step : step;
        if (tid < 128) { qs[tid] = bf2f(QH[(size_t)t * HW + h * 128 + tid]); ks[tid] = bf2f(KK[(size_t)t * HW + h * 128 + tid]); fs[tid] = expf(G[(size_t)t * HW + h * 128 + tid]); vs[tid] = bf2f(VH[(size_t)t * HW + h * 128 + tid]); }
        __syncthreads();
        float p = 0.f; const float vv = vs[v];
#pragma unroll
        for (int i = 0; i < 32; ++i) { const int k = 32 * kq + i; S[i] = fs[k] * S[i] + ks[k] * vv; p += S[i] * qs[k]; }
        part[kq][v] = p;
        __syncthreads();
        if (tid < 128) out[(size_t)t * 128 + tid] = part[0][tid] + part[1][tid] + part[2][tid] + part[3][tid];
    }
}
__global__ void chk_hgrn_out(const unsigned char* ws, const float* OREF, const float* onorm, unsigned* res, int h0, int nh) {
    const int lane = threadIdx.x & 63, wv = (blockIdx.x * blockDim.x + threadIdx.x) >> 6, nw = (gridDim.x * blockDim.x) >> 6;
    const bf16_t* HG = (const bf16_t*)(ws + WS_HG); const bf16_t* OA = (const bf16_t*)(ws + WS_OA);
    for (int s = wv; s < nh * SEQ; s += nw) {
        const int hh = s / SEQ, t = s % SEQ, h = h0 + hh;
        const float* of = OREF + ((size_t)(2 * hh) * SEQ + t) * 128; const float* ob = OREF + ((size_t)(2 * hh + 1) * SEQ + t) * 128;
        const float a0 = of[lane] + ob[lane], a1 = of[64 + lane] + ob[64 + lane];
        const float rs = rsqrtf(wave_sum(a0 * a0 + a1 * a1) / 128.f + EPS);
        const size_t o = (size_t)t * HW + h * 128;
        err_max(res, bf2f(OA[o + lane]), a0 * rs * onorm[lane] * bf2f(HG[o + lane])); err_max(res, bf2f(OA[o + 64 + lane]), a1 * rs * onorm[64 + lane] * bf2f(HG[o + 64 + lane]));
    }
}
__global__ void chk_branch(const unsigned char* ws, const float* wa, const float* wb, unsigned* res, int nsamp) {
    const int lane = threadIdx.x & 63, wv = (blockIdx.x * blockDim.x + threadIdx.x) >> 6, nw = (gridDim.x * blockDim.x) >> 6;
    const bf16_t* OA = (const bf16_t*)(ws + WS_OA); const bf16_t* OB = (const bf16_t*)(ws + WS_OB); const bf16_t* MA = (const bf16_t*)(ws + WS_MA); const bf16_t* MB = (const bf16_t*)(ws + WS_MB); const bf16_t* Y = (const bf16_t*)(ws + WS_Y);
    for (int s = wv; s < nsamp; s += nw) {
        const int row = hsh(5 * s + 1) % SEQ, col = hsh(5 * s + 2) % DM; float da = 0.f, db = 0.f;
        for (int k = lane; k < HW; k += 64) { da += bf2f(OA[(size_t)row * HW + k]) * bfr(wa[(size_t)k * DM + col]); db += bf2f(OB[(size_t)row * HW + k]) * bfr(wb[(size_t)k * DM + col]); }
        da = wave_sum(da); db = wave_sum(db);
        if (lane == 0) err_max(res, bf2f(Y[(size_t)row * DM + col]), bf2f(MA[(size_t)row * DM + col]) * da + bf2f(MB[(size_t)row * DM + col]) * db);
    }
}
__global__ void chk_wout(const unsigned char* ws, const float* xin, const float* wo, unsigned* res, int nsamp) {
    const int lane = threadIdx.x & 63, wv = (blockIdx.x * blockDim.x + threadIdx.x) >> 6, nw = (gridDim.x * blockDim.x) >> 6;
    const bf16_t* Y = (const bf16_t*)(ws + WS_Y); const float* X1 = (const float*)(ws + WS_X1);
    for (int s = wv; s < nsamp; s += nw) {
        const int row = hsh(7 * s + 1) % SEQ, col = hsh(7 * s + 2) % DM; float d = 0.f;
        for (int k = lane; k < DM; k += 64) d += bf2f(Y[(size_t)row * DM + k]) * bfr(wo[(size_t)k * DM + col]);
        d = wave_sum(d);
        if (lane == 0) err_max(res, X1[(size_t)row * DM + col], xin[(size_t)row * DM + col] + d);
    }
}
__global__ void chk_gate(const unsigned char* ws, const float* out, const float* p, const float* wp, const float* wg, const float* pn, unsigned* res, int nsamp) {
    const int lane = threadIdx.x & 63, wv = (blockIdx.x * blockDim.x + threadIdx.x) >> 6, nw = (gridDim.x * blockDim.x) >> 6;
    const float* X1 = (const float*)(ws + WS_X1);
    for (int s = wv; s < nsamp; s += nw) {
        const int row = hsh(9 * s + 1) % SEQ, col = hsh(9 * s + 2) % DM; float d = 0.f, ss = 0.f, pl = 0.f;
        for (int k = lane; k < DM; k += 64) { const float xv = X1[(size_t)row * DM + k]; ss += xv * xv; d += bfr(xv * pn[k]) * bfr(wg[(size_t)k * DM + col]); }
        for (int k = lane; k < PLE; k += 64) pl += bfr(p[(size_t)row * PLE + k]) * bfr(wp[(size_t)k * DM + col]);
        d = wave_sum(d); ss = wave_sum(ss); pl = wave_sum(pl);
        if (lane == 0) { const float g = 1.f / (1.f + expf(-d * rsqrtf(ss / DM + EPS))); err_max(res, out[(size_t)row * DM + col], X1[(size_t)row * DM + col] + pl * g); }
    }
}
__global__ void chk_final(const unsigned* res, float* out, size_t n, int nres) {
    int first = -1; for (int i = 0; i < nres; ++i) if (__uint_as_float(res[i]) > 1.0f) { first = i; break; }
    float bucket = 0.f; if (first >= 0) { const float e = __uint_as_float(res[first]); bucket = fminf(fmaxf(floorf(log10f(e)) + 1.f, 0.f), 9.f); }
    const float val = first < 0 ? 0.f : 100.f * (float)(first + 1) + 10.f * bucket;
    for (size_t i = (size_t)blockIdx.x * blockDim.x + threadIdx.x; i < n; i += (size_t)gridDim.x * blockDim.x) out[i] = val;
}

__global__ void ck_big(const bf16_t* p, size_t n, unsigned long long* res) {
    unsigned long long c0 = 0, c2 = 0, c4 = 0; float mxv = 0.f;
    for (size_t i = (size_t)blockIdx.x * blockDim.x + threadIdx.x; i < n; i += (size_t)gridDim.x * blockDim.x) { const float v = bf2f(p[i]);
        if (!(fabsf(v) <= 3.0e38f)) ++c0; else if (fabsf(v) > 1.01f || v < -0.01f) { ++c2; mxv = fmaxf(mxv, fabsf(v)); if (v < 0.f) ++c4; } }
    if (c0 | c2) { atomicAdd(res, c0); atomicAdd(res + 2, c2); atomicAdd(res + 4, c4); atomicMax((unsigned*)(res + 3), __float_as_uint(mxv)); }
}
__global__ void ck_big_final(const unsigned long long* res, float* out, size_t n, int ld) {
    const float mxv = __uint_as_float((unsigned)res[3]);
    const float c1 = 1.0e4f * (1.f + floorf(log2f(1.f + (float)res[0])));
    const float negf = res[2] ? (float)res[4] / (float)res[2] : 0.f;
    const float c2 = 1000.f * (1.f + floorf(negf * 3.99f)) + 100.f * fminf(fmaxf(floorf(log10f(fmaxf(mxv, 1e-9f))) + 2.f, 0.f), 9.f);
    for (size_t i = (size_t)blockIdx.x * blockDim.x + threadIdx.x; i < n; i += (size_t)gridDim.x * blockDim.x) out[i] = (i == 0) ? c1 : c2;
}
struct CkBuf { int phase; int idx; size_t off; size_t n; int kind; };
#endif

extern "C" void kernel_launch(void* const* d_in, const int* in_sizes, int n_in, void* d_out, int out_size, void* d_ws, size_t ws_size, hipStream_t stream) {
    static int grid = 0;
    if (grid == 0) {
        if (n_in != 15 || out_size != SEQ * DM || ws_size < WS_END) { fprintf(stderr, "kernel_launch: unexpected problem (n_in %d, out %d, ws %zu)\n", n_in, out_size, ws_size); grid = -1; return; }
        int dev = 0, cus = 0;
        if (hipGetDevice(&dev) != hipSuccess || hipDeviceGetAttribute(&cus, hipDeviceAttributeMultiprocessorCount, dev) != hipSuccess) { grid = -1; return; }
        if (hipFuncSetAttribute((const void*)mk_fwd, hipFuncAttributeMaxDynamicSharedMemorySize, LDS_BYTES) != hipSuccess) { fprintf(stderr, "kernel_launch: hipFuncSetAttribute failed\n"); grid = -1; return; }
        int per_cu = 0;
        if (hipOccupancyMaxActiveBlocksPerMultiprocessor(&per_cu, (const void*)mk_fwd, 512, LDS_BYTES) != hipSuccess || per_cu < 1) fprintf(stderr, "kernel_launch: occupancy query says %d\n", per_cu);
        (void)hipGetLastError();
        grid = cus;
    }
    if (grid < 0) return;
    (void)hipMemsetAsync((char*)d_ws + WS_CTL, 0, CTL_ZERO_BYTES, stream);
    Args a{};
    for (int i = 0; i < 15; ++i) a.in[i] = (const float*)d_in[i];
    a.out = (float*)d_out; a.ws = (unsigned char*)d_ws;
#if MK_DIAG == 5
    {
        unsigned long long* res = (unsigned long long*)((char*)d_ws + 65536);
        (void)hipMemsetAsync((char*)d_ws + 65536 + 8, 0xFF, 8, stream);
        for (int ph = 0; ph < 2; ++ph) { a.ph_lo = ph; a.ph_hi = ph + 1; hipLaunchKernelGGL(mk_fwd, dim3(grid), dim3(512), LDS_BYTES, stream, a); }
        hipLaunchKernelGGL(ck_big, dim3(1024), dim3(256), 0, stream, (const bf16_t*)((char*)d_ws + WS_MA), (size_t)SEQ * DM, res);
        hipLaunchKernelGGL(ck_big_final, dim3(1024), dim3(256), 0, stream, (const unsigned long long*)res, (float*)d_out, (size_t)SEQ * DM, DM);
    }
#elif MK_DIAG == 4
    {
        unsigned* res = (unsigned*)((char*)d_ws + 65536);
        float* OREF = (float*)((char*)d_ws + 728 * MiB);
        const unsigned char* wsc = (const unsigned char*)d_ws;
        const float* const* in = a.in;
        for (int ph = 0; ph < NPHASE; ++ph) {
            a.ph_lo = ph; a.ph_hi = ph + 1; hipLaunchKernelGGL(mk_fwd, dim3(grid), dim3(512), LDS_BYTES, stream, a);
            if (ph == 1) hipLaunchKernelGGL(chk_inproj, dim3(512), dim3(256), 0, stream, in[0], in[2], in[3], in[4], wsc, res + 0, 32768);
            if (ph == 2) hipLaunchKernelGGL(chk_natten, dim3(256), dim3(256), 0, stream, wsc, in[6], in[7], in[8], res + 4, 1024);
            if (ph == 4) { hipLaunchKernelGGL(chk_hgrn_scan, dim3(4), dim3(512), 0, stream, wsc, OREF, 2);
                           hipLaunchKernelGGL(chk_hgrn_out, dim3(512), dim3(256), 0, stream, wsc, (const float*)OREF, in[5], res + 5, 2, 2); }
            if (ph == 5) hipLaunchKernelGGL(chk_branch, dim3(512), dim3(256), 0, stream, wsc, in[9], in[10], res + 6, 8192);
            if (ph == 6) hipLaunchKernelGGL(chk_wout, dim3(512), dim3(256), 0, stream, wsc, in[0], in[11], res + 7, 8192);
            if (ph == 7) hipLaunchKernelGGL(chk_gate, dim3(512), dim3(256), 0, stream, wsc, (const float*)d_out, in[1], in[14], in[13], in[12], res + 8, 8192);
        }
        hipLaunchKernelGGL(chk_final, dim3(1024), dim3(256), 0, stream, (const unsigned*)res, (float*)d_out, (size_t)SEQ * DM, 10);
    }
#elif MK_DIAG == 3
    {
        unsigned long long* res = (unsigned long long*)((char*)d_ws + 65536);
        bf16_t* SAVE = (bf16_t*)((char*)d_ws + 728 * MiB);
        (void)hipMemsetAsync((char*)d_ws + MiB, 0xAA, WS_END - MiB, stream);
        (void)hipMemsetAsync((char*)d_ws + 65536 + 8, 0xFF, 8, stream);
        for (int ph = 0; ph < 2; ++ph) { a.ph_lo = ph; a.ph_hi = ph + 1; hipLaunchKernelGGL(mk_fwd, dim3(grid), dim3(512), LDS_BYTES, stream, a); }
        (void)hipMemcpyAsync(SAVE, (char*)d_ws + MK_HOLE_BUF, (size_t)SEQ * MK_HOLE_LD * 2, hipMemcpyDeviceToDevice, stream);
        a.ph_lo = 1; a.ph_hi = 2; hipLaunchKernelGGL(mk_fwd, dim3(grid), dim3(512), LDS_BYTES, stream, a);
        hipLaunchKernelGGL(ck_diff, dim3(1024), dim3(256), 0, stream, (const bf16_t*)((char*)d_ws + MK_HOLE_BUF), (const bf16_t*)SAVE, (size_t)SEQ * MK_HOLE_LD, res);
        hipLaunchKernelGGL(ck_diff_final, dim3(1024), dim3(256), 0, stream, (const unsigned long long*)res, (float*)d_out, (size_t)SEQ * DM, MK_HOLE_LD);
    }
#elif MK_DIAG == 2
    {
        unsigned long long* res = (unsigned long long*)((char*)d_ws + 65536);
        (void)hipMemsetAsync((char*)d_ws + MiB, 0xAA, WS_END - MiB, stream);
        (void)hipMemsetAsync((char*)d_ws + 65536 + 8, 0xFF, 8, stream);
        a.ph_lo = 0; a.ph_hi = 1; hipLaunchKernelGGL(mk_fwd, dim3(grid), dim3(512), LDS_BYTES, stream, a);
        (void)hipMemsetAsync((char*)d_ws + MK_HOLE_BUF, 0xFF, (size_t)SEQ * MK_HOLE_LD * 2, stream);
        a.ph_lo = 1; a.ph_hi = 2; hipLaunchKernelGGL(mk_fwd, dim3(grid), dim3(512), LDS_BYTES, stream, a);
        hipLaunchKernelGGL(ck_holes, dim3(1024), dim3(256), 0, stream, (const bf16_t*)((char*)d_ws + MK_HOLE_BUF), (size_t)SEQ * MK_HOLE_LD, res);
        hipLaunchKernelGGL(ck_holes_final, dim3(1024), dim3(256), 0, stream, (const unsigned long long*)res, (float*)d_out, (size_t)SEQ * DM, MK_HOLE_MODE);
    }
#elif MK_DIAG
    {
        static const CkBuf B0[] = {
            {0, 0, WS_LOWER, 4096, 0}, {0, 1, WS_SSQ, 8192, 0}, {0, 2, WS_XGA, (size_t)SEQ * DM, 1}, {0, 3, WS_PB, (size_t)2 * SEQ * PLE, 1}, {0, 4, WS_WIN, (size_t)2 * NIN * DM, 1},
            {0, 5, WS_WA, (size_t)2 * DM * HW, 1}, {0, 6, WS_WB, (size_t)2 * DM * HW, 1}, {0, 7, WS_WO, (size_t)2 * DM * DM, 1}, {0, 8, WS_WG, (size_t)2 * DM * DM, 1}, {0, 9, WS_WP, (size_t)2 * DM * PLE, 1} };
        static const CkBuf BL[] = {
            {0, 10, WS_QH, (size_t)SEQ * HW, 1}, {0, 11, WS_VH, (size_t)SEQ * HW, 1}, {0, 12, WS_KF, (size_t)SEQ * HW, 1}, {0, 13, WS_KB, (size_t)SEQ * HW, 1}, {0, 14, WS_HG, (size_t)SEQ * HW, 1},
            {0, 15, WS_NQ, (size_t)SEQ * HW, 1}, {0, 16, WS_NK, (size_t)SEQ * HW, 1}, {0, 17, WS_VT, (size_t)SEQ * HW, 1}, {0, 18, WS_NG, (size_t)SEQ * HW, 1}, {0, 19, WS_GF, (size_t)SEQ * HW, 0},
            {0, 20, WS_GB, (size_t)SEQ * HW, 0}, {0, 21, WS_MA, (size_t)SEQ * DM, 1}, {0, 22, WS_MB, (size_t)SEQ * DM, 1},
            {1, 23, WS_LT, (size_t)2048 * 16384, 0}, {1, 24, WS_DD, (size_t)2048 * 128, 0}, {1, 25, WS_EE, (size_t)2048 * 128, 0}, {1, 26, WS_OB, (size_t)SEQ * HW, 1},
            {2, 27, WS_SP, (size_t)2048 * 16384, 1}, {3, 28, WS_OA, (size_t)SEQ * HW, 1}, {4, 29, WS_T, (size_t)SEQ * DM, 0}, {4, 30, WS_Y, (size_t)SEQ * DM, 1},
            {5, 31, WS_X1, (size_t)SEQ * DM, 0}, {5, 32, WS_XGB, (size_t)SEQ * DM, 1}, {6, 34, WS_PL, (size_t)SEQ * DM, 0}, {6, 35, (size_t)-1, (size_t)SEQ * DM, 0} };
        const int NS = 80;
        double* sums = (double*)((char*)d_ws + 65536);
        (void)hipMemsetAsync((char*)d_ws + MiB, 0xAA, WS_END - MiB, stream);
        for (int run = 0; run < 2; ++run) {
            (void)hipMemsetAsync((char*)d_ws + WS_CTL, 0, 32768, stream);
            for (int ph = 0; ph < NPHASE; ++ph) {
                a.ph_lo = ph; a.ph_hi = ph + 1; hipLaunchKernelGGL(mk_fwd, dim3(grid), dim3(512), LDS_BYTES, stream, a);
                if (ph == 0) { for (const CkBuf& b : B0) hipLaunchKernelGGL(ck_sum, dim3(1024), dim3(256), 0, stream, (const void*)((char*)d_ws + b.off), b.n, b.kind, sums + 2 * (run * NS + b.idx)); }
                else { const int l = (ph - 1) / 7, k = (ph - 1) % 7;
                    for (const CkBuf& b : BL) if (b.phase == k) hipLaunchKernelGGL(ck_sum, dim3(1024), dim3(256), 0, stream, b.off == (size_t)-1 ? (const void*)d_out : (const void*)((char*)d_ws + b.off), b.n, b.kind, sums + 2 * (run * NS + b.idx + 40 * l)); }
            }
        }
        hipLaunchKernelGGL(ck_final, dim3(1024), dim3(256), 0, stream, (const double*)sums, (float*)d_out, (size_t)SEQ * DM, NS);
    }
#elif MK_MULTI
    for (int ph = 0; ph < NPHASE; ++ph) { a.ph_lo = ph; a.ph_hi = ph + 1; hipLaunchKernelGGL(mk_fwd, dim3(grid), dim3(512), LDS_BYTES, stream, a); }
#else
    a.ph_lo = 0; a.ph_hi = NPHASE; hipLaunchKernelGGL(mk_fwd, dim3(grid), dim3(512), LDS_BYTES, stream, a);
#endif
}
```

```cpp
#include <hip/hip_runtime.h>
#include <cstdio>
#include <cstdint>

#ifndef MK_ALIGN
#define MK_ALIGN true
#endif
#ifndef MK_SP2
#define MK_SP2 true
#endif
#ifndef MK_TS
#define MK_TS 0
#endif
#ifndef MK_TS_A
#define MK_TS_A 0
#define MK_TS_B 1
#endif
#ifndef MK_REP_PHASE
#define MK_REP_PHASE -1
#endif
#ifndef MK_REP_N
#define MK_REP_N 3
#endif
#ifndef MK_ENDFLUSH
#define MK_ENDFLUSH 0
#endif
#ifndef MK_MULTI
#define MK_MULTI 0
#endif

#define LAS __attribute__((address_space(3)))
typedef unsigned short bf16_t;
typedef short bf16x8 __attribute__((ext_vector_type(8)));
typedef float f32x4 __attribute__((ext_vector_type(4)));
typedef float f32x2 __attribute__((ext_vector_type(2)));
typedef unsigned u32x4 __attribute__((ext_vector_type(4)));
typedef unsigned u32x2 __attribute__((ext_vector_type(2)));

constexpr int SEQ = 8192, DM = 2048, NIN = 13312, HW = 1024, PLE = 256;
constexpr float EPS = 1e-6f;
constexpr int NPHASE = 15;

constexpr size_t MiB = 1u << 20;
constexpr size_t WS_CTL = 0, CTL_ZERO_BYTES = 1 * MiB;
constexpr size_t WS_LOWER = 1 * MiB;
constexpr size_t WS_SSQ = 1 * MiB + 64 * 1024;
constexpr size_t WS_DD = 2 * MiB;
constexpr size_t WS_EE = 3 * MiB;
constexpr size_t WS_WIN = 4 * MiB;
constexpr size_t WS_WA = 108 * MiB;
constexpr size_t WS_WB = 116 * MiB;
constexpr size_t WS_WO = 124 * MiB;
constexpr size_t WS_WG = 140 * MiB;
constexpr size_t WS_WP = 156 * MiB;
constexpr size_t WS_PB = 158 * MiB;
constexpr size_t WS_XGA = 166 * MiB;
constexpr size_t WS_XGB = 198 * MiB;
constexpr size_t WS_QH = 230 * MiB;
constexpr size_t WS_VH = 246 * MiB;
constexpr size_t WS_KF = 262 * MiB;
constexpr size_t WS_KB = 278 * MiB;
constexpr size_t WS_HG = 294 * MiB;
constexpr size_t WS_NQ = 310 * MiB;
constexpr size_t WS_NK = 326 * MiB;
constexpr size_t WS_VT = 342 * MiB;
constexpr size_t WS_NG = 358 * MiB;
constexpr size_t WS_OA = 374 * MiB;
constexpr size_t WS_OB = 390 * MiB;
constexpr size_t WS_GF = 406 * MiB;
constexpr size_t WS_GB = 438 * MiB;
constexpr size_t WS_MA = 470 * MiB;
constexpr size_t WS_MB = 502 * MiB;
constexpr size_t WS_LT = 534 * MiB;
constexpr size_t WS_SP = 662 * MiB;
constexpr size_t WS_END = 726 * MiB;
constexpr size_t WS_T = WS_LT;
constexpr size_t WS_PL = WS_LT + 64 * MiB;
constexpr size_t WS_Y = WS_SP;
constexpr size_t WS_X1 = WS_GF;

constexpr int LDS_BYTES = 147456;
constexpr int LDS_MISC_OFF = 131072;

typedef __bf16 bf16x2_t __attribute__((ext_vector_type(2)));
__device__ __forceinline__ unsigned cvt_pk_bf16(float lo, float hi) { bf16x2_t v = {(__bf16)lo, (__bf16)hi}; return __builtin_bit_cast(unsigned, v); }
__device__ __forceinline__ float bf2f(unsigned short b) { return __uint_as_float(((unsigned)b) << 16); }
__device__ __forceinline__ float bflo(unsigned w) { return __uint_as_float(w << 16); }
__device__ __forceinline__ float bfhi(unsigned w) { return __uint_as_float(w & 0xffff0000u); }
__device__ __forceinline__ unsigned short f2bf1(float f) { return (unsigned short)(cvt_pk_bf16(f, 0.f) & 0xffffu); }
__device__ __forceinline__ float fast_rcp(float x) { return __builtin_amdgcn_rcpf(x); }
__device__ __forceinline__ float sigmoid_f(float x) { return fast_rcp(1.f + __expf(-x)); }
__device__ __forceinline__ float silu_f(float x) { return x * sigmoid_f(x); }

__device__ __forceinline__ int opaque_tid() { int t = threadIdx.x; asm volatile("" : "+v"(t)); return t; }
__device__ __forceinline__ unsigned char* opaque_ptr(unsigned char* p) { asm volatile("" : "+s"(p)); return p; }
__device__ __forceinline__ int opaque_bid() { int b = blockIdx.x; asm volatile("" : "+s"(b)); return b; }
namespace pg8 {
#define PG8_LAS __attribute__((address_space(3)))
constexpr int BM = 256, BK = 64, HALF = 128, HTB = HALF * BK * 2, STAGE_BYTES = 8 * HTB, NXCD = 8, WGM = 8;
__host__ __device__ __forceinline__ int lds_byte(int r, int c) { const int st = (r >> 4) * 2 + (c >> 5), rr = r & 15, cc = c & 31, ob = rr * 64 + cc * 2; return st * 1024 + (ob ^ (((ob >> 9) & 1) << 5)); }
__host__ __device__ __forceinline__ void stage_rc(int b, int& R, int& C) { const int st = b / 1024, sb = b % 1024, swz = sb ^ (((sb >> 9) & 1) << 5); R = (st >> 1) * 16 + swz / 64; C = (st & 1) * 32 + (swz % 64) / 2; }
__host__ __device__ __forceinline__ int perm32(int rho) { const int n = rho >> 4, i = rho & 15; return 8 * (i >> 2) + 4 * n + (i & 3); }

struct Unit { int pm, pn; };
struct Gemm { const bf16_t* A; const bf16_t* Bt; int M, N, K; };

struct StaticOrder {
    int nM, nN, nwg, G, c;
    __host__ __device__ void init(int M, int N, int G_, int c_) { nM = M / BM; nN = N / BM; nwg = nM * nN; G = G_; c = c_; }
    __host__ __device__ bool next(int i, Unit& u) const {
        const long L = (long)i * G + c; if (L >= nwg) return false;
        int wgid = (int)L; { const int q = nwg / NXCD, r = nwg % NXCD, xcd = wgid % NXCD, off = wgid / NXCD; wgid = (xcd < r ? xcd * (q + 1) : r * (q + 1) + (xcd - r) * q) + off; }
        const int nig = WGM * nN, gid = wgid / nig, fm = gid * WGM, gsz = (nM - fm) < WGM ? (nM - fm) : WGM;
        u.pm = fm + ((wgid % nig) % gsz); u.pn = (wgid % nig) / gsz; return true;
    }
    __device__ __forceinline__ void a_ready(const Unit&) const {}
    __device__ __forceinline__ void done(const Unit&) const {}
};

template <class Epi, class Sched, bool ALIGN_EPI = MK_ALIGN, bool SP2 = MK_SP2>
__device__ __forceinline__ void gemm_phase(PG8_LAS unsigned char* lds, const Gemm g, const Sched& S, const Epi& E) {
    const int tid = opaque_tid(), wid = __builtin_amdgcn_readfirstlane(tid >> 6), lane = tid & 63, wr = wid >> 2, wc = wid & 3, fr = lane & 15, fq = lane >> 4;
    const int K = g.K, nt = K / BK;
    unsigned voffA[2], voffB[2];
#pragma unroll
    for (int i = 0; i < 2; ++i) { int R, C; stage_rc(tid * 16 + i * 8192, R, C); const int Rb = Epi::PERM ? ((R & ~31) + perm32(R & 31)) : R;
        voffA[i] = (unsigned)(R * K + C) * 2u; voffB[i] = (unsigned)(Rb * K + C) * 2u; }
    const size_t kstep = (size_t)(BK * 2);
    const size_t hstep = (size_t)HALF * K * 2;
    const size_t tstep = 2 * hstep;
    const unsigned ldsw = (unsigned)wid * 1024u;
    const int aoff = lds_byte(wr * 64 + fr, fq * 8), boff = lds_byte(wc * 32 + fr, fq * 8);
#define PG8_SA(b, h) (((b) * 2 + (h)) * HTB)
#define PG8_SB(b, h) ((4 + (b) * 2 + (h)) * HTB)
#define PG8_STAGE(bufoff, gbase, voff) do { _Pragma("unroll") for (int _i = 0; _i < 2; ++_i) \
        __builtin_amdgcn_global_load_lds((const unsigned*)((const char*)(gbase) + (voff)[_i]), (PG8_LAS unsigned*)(lds + (bufoff) + ldsw + _i * 8192), 16, 0, 0); } while (0)
#define PG8_LDA(dst, b, h) do { _Pragma("unroll") for (int m = 0; m < 4; ++m) _Pragma("unroll") for (int k = 0; k < 2; ++k) dst[m][k] = *(const PG8_LAS bf16x8*)(lds + PG8_SA(b, h) + aoff + m * 2048 + k * 1024); } while (0)
#define PG8_LDB(dst, b, h) do { _Pragma("unroll") for (int n = 0; n < 2; ++n) _Pragma("unroll") for (int k = 0; k < 2; ++k) dst[n][k] = *(const PG8_LAS bf16x8*)(lds + PG8_SB(b, h) + boff + n * 2048 + k * 1024); } while (0)
#define PG8_MMA(ai, bj, At, Bt) do { __builtin_amdgcn_s_setprio(1); _Pragma("unroll") for (int m = 0; m < 4; ++m) _Pragma("unroll") for (int n = 0; n < 2; ++n) _Pragma("unroll") for (int k = 0; k < 2; ++k) \
        acc[ai][bj][m][n] = __builtin_amdgcn_mfma_f32_16x16x32_bf16(Bt[n][k], At[m][k], acc[ai][bj][m][n], 0, 0, 0); __builtin_amdgcn_s_setprio(0); } while (0)
#define PG8_WAIT_V(n) asm volatile("s_waitcnt vmcnt(" #n ")" ::: "memory")
#define PG8_WAIT_L(n) asm volatile("s_waitcnt lgkmcnt(" #n ")" ::: "memory")
#define PG8_BAR __builtin_amdgcn_s_barrier()
#define PG8_SCHED __builtin_amdgcn_sched_barrier(0)
    Unit cur, nxt; int ui = 0;
    if (!S.next(0, cur)) return;
    f32x4 acc[2][2][4][2];
#pragma unroll
    for (int a = 0; a < 2; ++a)
#pragma unroll
        for (int b = 0; b < 2; ++b)
#pragma unroll
            for (int m = 0; m < 4; ++m)
#pragma unroll
                for (int n = 0; n < 2; ++n) acc[a][b][m][n] = (f32x4){0.f, 0.f, 0.f, 0.f};
    bf16x8 At[4][2], B0[2][2], B1[2][2];
    const char* cA = (const char*)g.A + (size_t)cur.pm * tstep; const char* cB = (const char*)g.Bt + (size_t)cur.pn * tstep;
    S.a_ready(cur);
    if constexpr (SP2) {
        PG8_STAGE(PG8_SB(0, 0), cB, voffB); PG8_STAGE(PG8_SB(0, 1), cB + hstep, voffB); PG8_STAGE(PG8_SA(0, 0), cA, voffA); PG8_STAGE(PG8_SA(0, 1), cA + hstep, voffA);
        if (wr == 1) PG8_BAR;
        PG8_WAIT_V(2); PG8_BAR;
        PG8_STAGE(PG8_SB(1, 0), cB + kstep, voffB); PG8_STAGE(PG8_SA(1, 0), cA + kstep, voffA); PG8_STAGE(PG8_SB(1, 1), cB + hstep + kstep, voffB);
        PG8_WAIT_V(6); PG8_BAR;
    } else {
        PG8_STAGE(PG8_SB(0, 0), cB, voffB); PG8_STAGE(PG8_SA(0, 0), cA, voffA); PG8_STAGE(PG8_SB(0, 1), cB + hstep, voffB); PG8_STAGE(PG8_SA(0, 1), cA + hstep, voffA);
        if (wr == 1) PG8_BAR;
        PG8_WAIT_V(4); PG8_BAR;
        PG8_STAGE(PG8_SB(1, 0), cB + kstep, voffB); PG8_STAGE(PG8_SA(1, 0), cA + kstep, voffA); PG8_STAGE(PG8_SB(1, 1), cB + hstep + kstep, voffB);
        PG8_WAIT_V(6); PG8_BAR;
    }
    for (;;) {
        const bool has_next = S.next(ui + 1, nxt);
        const char* nA = has_next ? (const char*)g.A + (size_t)nxt.pm * tstep : cA; const char* nB = has_next ? (const char*)g.Bt + (size_t)nxt.pn * tstep : cB;
        for (int t = 0; t < nt; t += 2) {
            const bool last = (t == nt - 2);
            const char* a1 = cA + (size_t)(t + 1) * kstep;
            const char* a2 = last ? nA : cA + (size_t)(t + 2) * kstep; const char* b2 = last ? nB : cB + (size_t)(t + 2) * kstep;
            const char* a3 = a2 + kstep; const char* b3 = b2 + kstep;
            if (last && has_next) S.a_ready(nxt);
            if constexpr (SP2) {
            PG8_LDB(B0, 0, 0); PG8_LDB(B1, 0, 1); PG8_SCHED; PG8_LDA(At, 0, 0); PG8_STAGE(PG8_SA(1, 1), a1 + hstep, voffA);
            PG8_WAIT_V(8); PG8_WAIT_L(0); PG8_BAR; PG8_MMA(0, 0, At, B0); PG8_MMA(0, 1, At, B1); PG8_BAR; PG8_SCHED;
            PG8_LDA(At, 0, 1); PG8_STAGE(PG8_SB(0, 0), b2, voffB); PG8_STAGE(PG8_SB(0, 1), b2 + hstep, voffB); PG8_STAGE(PG8_SA(0, 0), a2, voffA);
            PG8_WAIT_V(8); PG8_WAIT_L(0); PG8_BAR; PG8_MMA(1, 0, At, B0); PG8_MMA(1, 1, At, B1); PG8_BAR; PG8_SCHED;
            PG8_LDB(B0, 1, 0); PG8_LDB(B1, 1, 1); PG8_SCHED; PG8_LDA(At, 1, 0); PG8_STAGE(PG8_SA(0, 1), a2 + hstep, voffA);
            PG8_WAIT_V(8); PG8_WAIT_L(0); PG8_BAR; PG8_MMA(0, 0, At, B0); PG8_MMA(0, 1, At, B1); PG8_BAR; PG8_SCHED;
            PG8_LDA(At, 1, 1); PG8_STAGE(PG8_SB(1, 0), b3, voffB); PG8_STAGE(PG8_SB(1, 1), b3 + hstep, voffB); PG8_STAGE(PG8_SA(1, 0), a3, voffA);
            PG8_WAIT_V(8); PG8_WAIT_L(0); PG8_BAR; PG8_MMA(1, 0, At, B0); PG8_MMA(1, 1, At, B1); PG8_BAR; PG8_SCHED;
            } else {
            PG8_LDB(B0, 0, 0); PG8_SCHED; PG8_LDA(At, 0, 0); PG8_STAGE(PG8_SA(1, 1), a1 + hstep, voffA);
            PG8_WAIT_L(8); PG8_BAR; PG8_WAIT_L(0); PG8_MMA(0, 0, At, B0); PG8_BAR; PG8_SCHED;
            PG8_LDB(B1, 0, 1); PG8_STAGE(PG8_SB(0, 0), b2, voffB);
            PG8_BAR; PG8_WAIT_L(0); PG8_MMA(0, 1, At, B1); PG8_BAR;
            PG8_LDA(At, 0, 1); PG8_STAGE(PG8_SA(0, 0), a2, voffA);
            PG8_BAR; PG8_WAIT_L(0); PG8_MMA(1, 0, At, B0); PG8_BAR; PG8_SCHED;
            PG8_STAGE(PG8_SB(0, 1), b2 + hstep, voffB);
            PG8_WAIT_V(6); PG8_BAR; PG8_MMA(1, 1, At, B1); PG8_BAR;
            PG8_LDB(B0, 1, 0); PG8_SCHED; PG8_LDA(At, 1, 0); PG8_STAGE(PG8_SA(0, 1), a2 + hstep, voffA);
            PG8_WAIT_L(8); PG8_BAR; PG8_WAIT_L(0); PG8_MMA(0, 0, At, B0); PG8_BAR; PG8_SCHED;
            PG8_LDB(B1, 1, 1); PG8_STAGE(PG8_SB(1, 0), b3, voffB);
            PG8_BAR; PG8_WAIT_L(0); PG8_MMA(0, 1, At, B1); PG8_BAR;
            PG8_LDA(At, 1, 1); PG8_STAGE(PG8_SA(1, 0), a3, voffA);
            PG8_BAR; PG8_WAIT_L(0); PG8_MMA(1, 0, At, B0); PG8_BAR; PG8_SCHED;
            PG8_STAGE(PG8_SB(1, 1), b3 + hstep, voffB);
            PG8_WAIT_V(6); PG8_BAR; PG8_MMA(1, 1, At, B1); PG8_BAR;
            }
        }
        if constexpr (ALIGN_EPI) { if (wr == 0) PG8_BAR; }
        E(acc, cur, wr, wc, fr, fq);
        if (!has_next) break;
#pragma unroll
        for (int a = 0; a < 2; ++a)
#pragma unroll
            for (int b = 0; b < 2; ++b)
#pragma unroll
                for (int m = 0; m < 4; ++m)
#pragma unroll
                    for (int n = 0; n < 2; ++n) acc[a][b][m][n] = (f32x4){0.f, 0.f, 0.f, 0.f};
        cur = nxt; cA = nA; cB = nB; ++ui;
        if constexpr (ALIGN_EPI) { if (wr == 1) PG8_BAR; }
    }
    PG8_WAIT_V(0);
    if constexpr (!ALIGN_EPI) { if (wr == 0) PG8_BAR; }
    PG8_BAR;
#undef PG8_SA
#undef PG8_SB
#undef PG8_STAGE
#undef PG8_LDA
#undef PG8_LDB
#undef PG8_MMA
#undef PG8_WAIT_V
#undef PG8_WAIT_L
#undef PG8_BAR
#undef PG8_SCHED
}
}

typedef f32x4 AccT[2][2][4][2];

__device__ __forceinline__ void store8_bf16(bf16_t* p, const float (&v)[8]) {
    u32x4 w; w.x = cvt_pk_bf16(v[0], v[1]); w.y = cvt_pk_bf16(v[2], v[3]); w.z = cvt_pk_bf16(v[4], v[5]); w.w = cvt_pk_bf16(v[6], v[7]);
    *(u32x4*)p = w;
}
__device__ __forceinline__ void load8_bf16(const bf16_t* p, float (&v)[8]) {
    const u32x4 w = *(const u32x4*)p;
    v[0] = bflo(w.x); v[1] = bfhi(w.x); v[2] = bflo(w.y); v[3] = bfhi(w.y); v[4] = bflo(w.z); v[5] = bfhi(w.z); v[6] = bflo(w.w); v[7] = bfhi(w.w);
}
__device__ __forceinline__ void store8_f32(float* p, const float (&v)[8]) {
    *(f32x4*)p = (f32x4){v[0], v[1], v[2], v[3]}; *(f32x4*)(p + 4) = (f32x4){v[4], v[5], v[6], v[7]};
}
__device__ __forceinline__ void load8_f32(const float* p, float (&v)[8]) {
    const f32x4 a = *(const f32x4*)p, b = *(const f32x4*)(p + 4);
    v[0] = a[0]; v[1] = a[1]; v[2] = a[2]; v[3] = a[3]; v[4] = b[0]; v[5] = b[1]; v[6] = b[2]; v[7] = b[3];
}
__device__ __forceinline__ void acc8(const AccT& acc, int ai, int bj, int m, float (&v)[8]) {
    const f32x4 a = acc[ai][bj][m][0], b = acc[ai][bj][m][1];
    v[0] = a[0]; v[1] = a[1]; v[2] = a[2]; v[3] = a[3]; v[4] = b[0]; v[5] = b[1]; v[6] = b[2]; v[7] = b[3];
}

template <int ACT> __device__ __forceinline__ void epi_plain(const AccT& acc, const float* ssq, bf16_t* dst, int ld, int row0, int c0) {
#pragma unroll
    for (int ai = 0; ai < 2; ++ai)
#pragma unroll
        for (int m = 0; m < 4; ++m) {
            const int row = row0 + ai * 128 + m * 16; const float rs = rsqrtf(ssq[row] * (1.0f / DM) + EPS);
#pragma unroll
            for (int bj = 0; bj < 2; ++bj) { float v[8]; acc8(acc, ai, bj, m, v);
#pragma unroll
                for (int e = 0; e < 8; ++e) { float z = v[e] * rs; if (ACT == 1) z = silu_f(z); if (ACT == 2) z = sigmoid_f(z); v[e] = z; }
                store8_bf16(dst + (size_t)row * ld + c0 + bj * 128, v); }
            asm volatile("" ::: "memory");
        }
}
struct EpiInProj {
    static constexpr bool PERM = true;
    const float* ssq; const float* lower; unsigned char* ws;
    __device__ __forceinline__ void operator()(const AccT& acc, const pg8::Unit& u, int wr, int wc, int fr, int fq) const {
        const int colt = u.pn * 256, seg = colt >> 10;
        const int row0 = u.pm * 256 + wr * 64 + fr;
        const int cin = wc * 32 + 8 * fq;
        const int cseg = (colt & 1023) + cin;
        if (seg == 2 || seg == 3) {
            const int dir = seg - 2;
            float* G = (float*)(ws + (dir ? WS_GB : WS_GF)); bf16_t* KK = (bf16_t*)(ws + (dir ? WS_KB : WS_KF));
#pragma unroll
            for (int bj = 0; bj < 2; ++bj) {
                const int c = cseg + bj * 128; float lb[8]; load8_f32(lower + dir * 1024 + c, lb);
#pragma unroll
                for (int ai = 0; ai < 2; ++ai)
#pragma unroll
                    for (int m = 0; m < 4; ++m) {
                        const int row = row0 + ai * 128 + m * 16; const float rs = rsqrtf(ssq[row] * (1.0f / DM) + EPS);
                        float v[8], lg[8], kk[8]; acc8(acc, ai, bj, m, v);
#pragma unroll
                        for (int e = 0; e < 8; ++e) { const float z = v[e] * rs; const float sg = sigmoid_f(z); const float f = lb[e] + (1.f - lb[e]) * sg;
                            lg[e] = __logf(fmaxf(f, 1e-6f)); kk[e] = (1.f - lb[e]) * fast_rcp(1.f + __expf(z)); }
                        store8_f32(G + (size_t)row * HW + c, lg); store8_bf16(KK + (size_t)row * HW + c, kk);
                        asm volatile("" ::: "memory");
                    }
            }
        } else if (seg == 7) {
            bf16_t* VT = (bf16_t*)(ws + WS_VT);
#pragma unroll
            for (int ai = 0; ai < 2; ++ai)
#pragma unroll
                for (int m = 0; m < 4; ++m) {
                    const int row = row0 + ai * 128 + m * 16; const float rs = rsqrtf(ssq[row] * (1.0f / DM) + EPS);
#pragma unroll
                    for (int bj = 0; bj < 2; ++bj) { float v[8]; acc8(acc, ai, bj, m, v); const int c = cseg + bj * 128;
#pragma unroll
                        for (int e = 0; e < 8; ++e) VT[(size_t)(c + e) * SEQ + row] = f2bf1(v[e] * rs); }
                }
        } else if (seg == 0) epi_plain<1>(acc, ssq, (bf16_t*)(ws + WS_QH), HW, row0, cseg);
        else if (seg == 1) epi_plain<0>(acc, ssq, (bf16_t*)(ws + WS_VH), HW, row0, cseg);
        else if (seg == 4) epi_plain<1>(acc, ssq, (bf16_t*)(ws + WS_HG), HW, row0, cseg);
        else if (seg == 5) epi_plain<0>(acc, ssq, (bf16_t*)(ws + WS_NQ), HW, row0, cseg);
        else if (seg == 6) epi_plain<0>(acc, ssq, (bf16_t*)(ws + WS_NK), HW, row0, cseg);
        else if (seg == 8) epi_plain<1>(acc, ssq, (bf16_t*)(ws + WS_NG), HW, row0, cseg);
        else if (seg < 11) epi_plain<2>(acc, ssq, (bf16_t*)(ws + WS_MA), DM, row0, colt - 9216 + cin);
        else epi_plain<2>(acc, ssq, (bf16_t*)(ws + WS_MB), DM, row0, colt - 11264 + cin);
    }
};

struct EpiBrA {
    static constexpr bool PERM = true;
    const bf16_t* MA; float* T;
    __device__ __forceinline__ void operator()(const AccT& acc, const pg8::Unit& u, int wr, int wc, int fr, int fq) const {
        const int row0 = u.pm * 256 + wr * 64 + fr, c0 = u.pn * 256 + wc * 32 + 8 * fq;
#pragma unroll
        for (int ai = 0; ai < 2; ++ai)
#pragma unroll
            for (int m = 0; m < 4; ++m) { const int row = row0 + ai * 128 + m * 16;
#pragma unroll
                for (int bj = 0; bj < 2; ++bj) { const size_t off = (size_t)row * DM + c0 + bj * 128; float v[8], g[8]; acc8(acc, ai, bj, m, v); load8_bf16(MA + off, g);
#pragma unroll
                    for (int e = 0; e < 8; ++e) v[e] *= g[e];
                    store8_f32(T + off, v); } asm volatile("" ::: "memory"); }
    }
};
struct EpiBrB {
    static constexpr bool PERM = true;
    const bf16_t* MB; const float* T; bf16_t* Y;
    __device__ __forceinline__ void operator()(const AccT& acc, const pg8::Unit& u, int wr, int wc, int fr, int fq) const {
        const int row0 = u.pm * 256 + wr * 64 + fr, c0 = u.pn * 256 + wc * 32 + 8 * fq;
#pragma unroll
        for (int ai = 0; ai < 2; ++ai)
#pragma unroll
            for (int m = 0; m < 4; ++m) { const int row = row0 + ai * 128 + m * 16;
#pragma unroll
                for (int bj = 0; bj < 2; ++bj) { const size_t off = (size_t)row * DM + c0 + bj * 128; float v[8], g[8], t[8]; acc8(acc, ai, bj, m, v); load8_bf16(MB + off, g); load8_f32(T + off, t);
#pragma unroll
                    for (int e = 0; e < 8; ++e) v[e] = t[e] + v[e] * g[e];
                    store8_bf16(Y + off, v); } asm volatile("" ::: "memory"); }
    }
};
struct EpiWout {
    static constexpr bool PERM = true;
    const float* xin; float* X1; bf16_t* XG; const float* gnorm; float* ssq_out;
    __device__ __forceinline__ void operator()(const AccT& acc, const pg8::Unit& u, int wr, int wc, int fr, int fq) const {
        const int row0 = u.pm * 256 + wr * 64 + fr, c0 = u.pn * 256 + wc * 32 + 8 * fq;
#pragma unroll
        for (int ai = 0; ai < 2; ++ai)
#pragma unroll
            for (int m = 0; m < 4; ++m) { const int row = row0 + ai * 128 + m * 16; float s = 0.f;
#pragma unroll
                for (int bj = 0; bj < 2; ++bj) { const size_t off = (size_t)row * DM + c0 + bj * 128; float v[8], xi[8], gn[8]; acc8(acc, ai, bj, m, v); load8_f32(xin + off, xi); load8_f32(gnorm + c0 + bj * 128, gn);
#pragma unroll
                    for (int e = 0; e < 8; ++e) { v[e] += xi[e]; s += v[e] * v[e]; }
                    store8_f32(X1 + off, v);
#pragma unroll
                    for (int e = 0; e < 8; ++e) v[e] *= gn[e];
                    store8_bf16(XG + off, v); }
                s += __shfl_xor(s, 16); s += __shfl_xor(s, 32);
                if (fq == 0) atomicAdd(ssq_out + row, s);
                asm volatile("" ::: "memory"); }
    }
};
struct EpiPL {
    static constexpr bool PERM = true;
    float* PL;
    __device__ __forceinline__ void operator()(const AccT& acc, const pg8::Unit& u, int wr, int wc, int fr, int fq) const {
        const int row0 = u.pm * 256 + wr * 64 + fr, c0 = u.pn * 256 + wc * 32 + 8 * fq;
#pragma unroll
        for (int ai = 0; ai < 2; ++ai)
#pragma unroll
            for (int m = 0; m < 4; ++m) { const int row = row0 + ai * 128 + m * 16;
#pragma unroll
                for (int bj = 0; bj < 2; ++bj) { float v[8]; acc8(acc, ai, bj, m, v); store8_f32(PL + (size_t)row * DM + c0 + bj * 128, v); } asm volatile("" ::: "memory"); }
    }
};
struct EpiGate {
    static constexpr bool PERM = true;
    const float* ssq1; const float* X1; const float* PL; float* xout; bf16_t* XG; const float* gnorm; float* ssq_next; int has_next;
    __device__ __forceinline__ void operator()(const AccT& acc, const pg8::Unit& u, int wr, int wc, int fr, int fq) const {
        const int row0 = u.pm * 256 + wr * 64 + fr, c0 = u.pn * 256 + wc * 32 + 8 * fq;
#pragma unroll
        for (int ai = 0; ai < 2; ++ai)
#pragma unroll
            for (int m = 0; m < 4; ++m) { const int row = row0 + ai * 128 + m * 16; const float rs = rsqrtf(ssq1[row] * (1.0f / DM) + EPS); float s = 0.f;
#pragma unroll
                for (int bj = 0; bj < 2; ++bj) { const size_t off = (size_t)row * DM + c0 + bj * 128; float v[8], x1[8], pl[8]; acc8(acc, ai, bj, m, v); load8_f32(X1 + off, x1); load8_f32(PL + off, pl);
#pragma unroll
                    for (int e = 0; e < 8; ++e) { const float g = sigmoid_f(v[e] * rs); v[e] = x1[e] + pl[e] * g; s += v[e] * v[e]; }
                    store8_f32(xout + off, v);
                    if (has_next) { float gn[8]; load8_f32(gnorm + c0 + bj * 128, gn);
#pragma unroll
                        for (int e = 0; e < 8; ++e) v[e] *= gn[e];
                        store8_bf16(XG + off, v); }
                    asm volatile("" ::: "memory"); }
                if (has_next) { s += __shfl_xor(s, 16); s += __shfl_xor(s, 32); if (fq == 0) atomicAdd(ssq_next + row, s); } }
    }
};

#define XB_TMO      128
#define XB_XCNT(j)  (256  + 64 * (j))
#define XB_XSUB(j)  (1280 + 64 * (j))
#define XB_XGEN(j)  (2304 + 64 * (j))
#define XB_TOP      3328
#define XB_TOPGEN   3392
#define XCD_BAR_WORDS 3456
#define XB_SPIN_CAP (1u << 18)
__device__ __forceinline__ unsigned xb_ld(unsigned* p)              { return __hip_atomic_load(p, __ATOMIC_RELAXED, __HIP_MEMORY_SCOPE_AGENT); }
__device__ __forceinline__ unsigned xb_add(unsigned* p, unsigned v) { return __hip_atomic_fetch_add(p, v, __ATOMIC_RELAXED, __HIP_MEMORY_SCOPE_AGENT); }
__device__ __forceinline__ unsigned xb_xcc_id() { return (unsigned)__builtin_amdgcn_s_getreg((3 << 11) | 20) & 0xFu; }
#define XB_SPIN(cond, bar) do { unsigned _sp = 0; while (cond) { __builtin_amdgcn_s_sleep(1); \
    if ((++_sp & 255u) == 0u) { if (xb_ld(&(bar)[XB_TMO])) break; if (_sp > XB_SPIN_CAP) { atomicAdd(&(bar)[XB_TMO], 1u); break; } } } } while (0)
struct XcdBarrier { unsigned* bar; unsigned x; volatile LAS unsigned* st; };
__device__ __forceinline__ XcdBarrier xcd_barrier_post(unsigned* bar, volatile LAS unsigned* st) {
    XcdBarrier b; b.bar = bar; b.x = xb_xcc_id(); b.st = st;
    if (threadIdx.x == 0) (void)xb_add(&bar[XB_XCNT(b.x)], 1u);
    return b;
}
__device__ __forceinline__ void xcd_barrier_complete(unsigned* bar, unsigned x, unsigned& nloc, unsigned& nx) {
    const unsigned G = gridDim.x * gridDim.y * gridDim.z;
    unsigned sum, cnt, mine, sp = 0u;
    for (;;) {
        sum = 0u; cnt = 0u; mine = 0u;
#pragma unroll
        for (unsigned j = 0; j < 16; ++j) { const unsigned c = xb_ld(&bar[XB_XCNT(j)]); sum += c; cnt += (c > 0u) ? 1u : 0u; mine = (j == x) ? c : mine; }
        if (sum == G) break;
        __builtin_amdgcn_s_sleep(1);
        if ((++sp & 255u) == 0u) { if (xb_ld(&bar[XB_TMO])) break; if (sp > XB_SPIN_CAP) { atomicAdd(&bar[XB_TMO], 1u); break; } }
    }
    nloc = mine > 0u ? mine : 1u; nx = cnt > 0u ? cnt : 1u;
}
__device__ __forceinline__ void xcd_barrier(const XcdBarrier& b) {
    asm volatile("s_waitcnt vmcnt(0)" ::: "memory");
    __syncthreads();
    if (threadIdx.x == 0) {
        unsigned* bar = b.bar;
        __builtin_amdgcn_s_waitcnt(0);
        unsigned nloc = b.st[0], nx = b.st[1];
        if (nloc == 0u) { xcd_barrier_complete(bar, b.x, nloc, nx); b.st[0] = nloc; b.st[1] = nx; }
        const unsigned old = xb_add(&bar[XB_XSUB(b.x)], 1u);
        const unsigned gen = old / nloc;
        if (old + 1u == (gen + 1u) * nloc) {
            __builtin_amdgcn_fence(__ATOMIC_RELEASE, "agent");
            asm volatile("s_waitcnt vmcnt(0)" ::: "memory");
            const unsigned og = xb_add(&bar[XB_TOP], 1u);
            const unsigned tg = og / nx;
            if (og + 1u == (tg + 1u) * nx) xb_add(&bar[XB_TOPGEN], 1u);
            else XB_SPIN(xb_ld(&bar[XB_TOPGEN]) == tg, bar);
            __builtin_amdgcn_fence(__ATOMIC_ACQUIRE, "agent");
            xb_add(&bar[XB_XGEN(b.x)], 1u);
            asm volatile("s_waitcnt vmcnt(0)" ::: "memory");
        } else {
            XB_SPIN(xb_ld(&bar[XB_XGEN(b.x)]) == gen, bar);
            __builtin_amdgcn_fence(__ATOMIC_ACQUIRE, "agent");
            asm volatile("s_waitcnt vmcnt(0)" ::: "memory");
        }
    }
    __syncthreads();
}

struct Args { const float* in[15]; float* out; unsigned char* ws; int ph_lo, ph_hi; };

__device__ __forceinline__ void transpose_convert(const float* __restrict__ W, bf16_t* __restrict__ WT, int K, int N, LAS float* tile, int rot) {
    const int tid = threadIdx.x, nb = gridDim.x; const int bid = (int)((blockIdx.x + (unsigned)rot) % (unsigned)nb);
    const int nkt = K / 64, ntile = nkt * (N / 64);
    for (int t = bid; t < ntile; t += nb) {
        const int tk = t % nkt, tn = t / nkt;
        const float* src = W + (size_t)(tk * 64) * N + tn * 64;
#pragma unroll
        for (int i = 0; i < 2; ++i) { const int idx = tid + i * 512; const int k = idx >> 4, c4 = idx & 15; const f32x4 v = *(const f32x4*)(src + (size_t)k * N + c4 * 4);
            LAS float* d = tile + k * 65 + c4 * 4; d[0] = v[0]; d[1] = v[1]; d[2] = v[2]; d[3] = v[3]; }
        __syncthreads();
        { const int n = tid >> 3, kq = tid & 7; float v[8];
#pragma unroll
          for (int j = 0; j < 8; ++j) v[j] = tile[(kq * 8 + j) * 65 + n];
          store8_bf16(WT + (size_t)(tn * 64 + n) * K + tk * 64 + kq * 8, v); }
        __syncthreads();
    }
}

__device__ __forceinline__ void p0_prologue(const Args& a, LAS unsigned char* lds) {
    unsigned char* ws = a.ws;
    const int tid = threadIdx.x, bid = blockIdx.x, nb = gridDim.x, gtid = bid * 512 + tid, gsz = nb * 512;
    {
        float* LOWER = (float*)(ws + WS_LOWER); const float* lbp = a.in[4];
        for (int i = gtid; i < 2048; i += gsz) { const float a0 = lbp[i], a1 = lbp[2048 + i]; LOWER[i] = 0.f; LOWER[2048 + i] = 1.f / (1.f + expf(a0 - a1)); }
        float* SSQ = (float*)(ws + WS_SSQ);
        for (int i = gtid; i < 3 * SEQ; i += gsz) SSQ[SEQ + i] = 0.f;
    }
    {
        const float* x = a.in[0]; const float* g0 = a.in[2]; bf16_t* XG = (bf16_t*)(ws + WS_XGA); float* SSQ = (float*)(ws + WS_SSQ);
        const int lane = tid & 63, gw = gtid >> 6, nw = gsz >> 6;
        for (int row = gw; row < SEQ; row += nw) {
            const f32x4* xr = (const f32x4*)(x + (size_t)row * DM); float s = 0.f;
#pragma unroll
            for (int j = 0; j < 8; ++j) { const f32x4 v = xr[j * 64 + lane]; const f32x4 g = ((const f32x4*)g0)[j * 64 + lane];
                s += v[0] * v[0] + v[1] * v[1] + v[2] * v[2] + v[3] * v[3];
                u32x2 w; w.x = cvt_pk_bf16(v[0] * g[0], v[1] * g[1]); w.y = cvt_pk_bf16(v[2] * g[2], v[3] * g[3]);
                *(u32x2*)(XG + (size_t)row * DM + (j * 64 + lane) * 4) = w; }
#pragma unroll
            for (int o = 32; o >= 1; o >>= 1) s += __shfl_xor(s, o);
            if (lane == 0) SSQ[row] = s;
        }
    }
    {
        const f32x4* p = (const f32x4*)a.in[1]; bf16_t* PB = (bf16_t*)(ws + WS_PB);
        for (int i = gtid; i < 2 * SEQ * PLE / 4; i += gsz) { const f32x4 v = p[i]; u32x2 w; w.x = cvt_pk_bf16(v[0], v[1]); w.y = cvt_pk_bf16(v[2], v[3]); *(u32x2*)(PB + (size_t)i * 4) = w; }
    }
    LAS float* tile = (LAS float*)lds;
    for (int l = 0; l < 2; ++l) {
        transpose_convert(a.in[3] + (size_t)l * DM * NIN, (bf16_t*)(ws + WS_WIN) + (size_t)l * NIN * DM, DM, NIN, tile, 0);
        transpose_convert(a.in[9] + (size_t)l * HW * DM, (bf16_t*)(ws + WS_WA) + (size_t)l * DM * HW, HW, DM, tile, 0);
        transpose_convert(a.in[10] + (size_t)l * HW * DM, (bf16_t*)(ws + WS_WB) + (size_t)l * DM * HW, HW, DM, tile, 0);
        transpose_convert(a.in[11] + (size_t)l * DM * DM, (bf16_t*)(ws + WS_WO) + (size_t)l * DM * DM, DM, DM, tile, 0);
        transpose_convert(a.in[13] + (size_t)l * DM * DM, (bf16_t*)(ws + WS_WG) + (size_t)l * DM * DM, DM, DM, tile, 0);
        transpose_convert(a.in[14] + (size_t)l * PLE * DM, (bf16_t*)(ws + WS_WP) + (size_t)l * DM * PLE, PLE, DM, tile, 128);
    }
}

constexpr int HP_ROWB = 272;
constexpr int HT_ROWB = 144;

__device__ __forceinline__ void hg_cumsum(const float* __restrict__ G, int tok0, int colg, int seg, int kc, int dir, LAS float* SEGS, float (&b)[16], float& bref, float& blast) {
    float gv[16];
#pragma unroll
    for (int i = 0; i < 16; ++i) gv[i] = G[(size_t)(tok0 + 16 * seg + i) * HW + colg];
    float c = 0.f;
#pragma unroll
    for (int i = 0; i < 16; ++i) { c += gv[i]; b[i] = c; }
    const float tot = c;
    if (dir) {
#pragma unroll
        for (int i = 0; i < 16; ++i) b[i] = tot - b[i] + gv[i];
    }
    SEGS[seg * 128 + kc] = tot;
    __syncthreads();
    const float t0 = SEGS[kc], t1 = SEGS[128 + kc], t2 = SEGS[256 + kc], t3 = SEGS[384 + kc];
    float off;
    if (!dir) { off = (seg > 0 ? t0 : 0.f) + (seg > 1 ? t1 : 0.f) + (seg > 2 ? t2 : 0.f); bref = t0 + t1; }
    else      { off = (seg < 3 ? t3 : 0.f) + (seg < 2 ? t2 : 0.f) + (seg < 1 ? t1 : 0.f); bref = t2 + t3; }
    blast = (t0 + t1) + (t2 + t3);
#pragma unroll
    for (int i = 0; i < 16; ++i) b[i] += off;
}

__device__ __forceinline__ void h1_phase(const Args& a, LAS unsigned char* lds) {
    unsigned char* ws = opaque_ptr(a.ws);
    const int tid = opaque_tid(), lane = tid & 63, w = __builtin_amdgcn_readfirstlane(tid >> 6), fr = lane & 15, fq = lane >> 4;
    const int kc = tid & 127, seg = tid >> 7;
    LAS float* SEGS = (LAS float*)lds; LAS float* SC = (LAS float*)(lds + 2048);
    LAS unsigned char* KpT = lds + 4096; LAS unsigned char* Vt = lds + 4096 + 128 * HT_ROWB;
    const bf16_t* VH = (const bf16_t*)(ws + WS_VH);
    float* LT = (float*)(ws + WS_LT); float* DD = (float*)(ws + WS_DD); float* EE = (float*)(ws + WS_EE);
    for (int item = blockIdx.x; item < 2048; item += gridDim.x) {
        const int d = item >> 10, h = (item >> 7) & 7, cs = item & 127, n = d ? 127 - cs : cs;
        const int tok0 = 64 * n, colg = h * 128 + kc;
        const float* G = (const float*)(ws + (d ? WS_GB : WS_GF)); const bf16_t* KK = (const bf16_t*)(ws + (d ? WS_KB : WS_KF));
        float b[16], bref, blast;
        hg_cumsum(G, tok0, colg, seg, kc, d, SEGS, b, bref, blast);
        {
            unsigned kw[8], vw[8];
#pragma unroll
            for (int i = 0; i < 16; i += 2) {
                const size_t o0 = (size_t)(tok0 + 16 * seg + i) * HW + colg, o1 = o0 + HW;
                const float k0 = bf2f(KK[o0]) * __expf(fminf(bref - b[i], 80.f)), k1 = bf2f(KK[o1]) * __expf(fminf(bref - b[i + 1], 80.f));
                kw[i >> 1] = cvt_pk_bf16(k0, k1);
                vw[i >> 1] = (unsigned)VH[o0] | ((unsigned)VH[o1] << 16);
            }
            LAS u32x4* kd = (LAS u32x4*)(KpT + kc * HT_ROWB + seg * 32); kd[0] = (u32x4){kw[0], kw[1], kw[2], kw[3]}; kd[1] = (u32x4){kw[4], kw[5], kw[6], kw[7]};
            LAS u32x4* vd = (LAS u32x4*)(Vt + kc * HT_ROWB + seg * 32); vd[0] = (u32x4){vw[0], vw[1], vw[2], vw[3]}; vd[1] = (u32x4){vw[4], vw[5], vw[6], vw[7]};
            if (seg == 0) { SC[kc] = __expf(blast - bref); DD[(size_t)item * 128 + kc] = __expf(blast); EE[(size_t)item * 128 + kc] = __expf(bref); }
        }
        __syncthreads();
        {
            const int vt = w;
            bf16x8 af[2];
#pragma unroll
            for (int ks = 0; ks < 2; ++ks) af[ks] = *(const LAS bf16x8*)(Vt + (16 * vt + fr) * HT_ROWB + (32 * ks + 8 * fq) * 2);
            float* dst = LT + (size_t)item * 16384;
#pragma unroll
            for (int kt = 0; kt < 8; ++kt) {
                f32x4 acc = (f32x4){0.f, 0.f, 0.f, 0.f};
#pragma unroll
                for (int ks = 0; ks < 2; ++ks) { const bf16x8 bfr = *(const LAS bf16x8*)(KpT + (16 * kt + fr) * HT_ROWB + (32 * ks + 8 * fq) * 2);
                    acc = __builtin_amdgcn_mfma_f32_16x16x32_bf16(af[ks], bfr, acc, 0, 0, 0); }
                const float sc = SC[16 * kt + fr];
#pragma unroll
                for (int r = 0; r < 4; ++r) dst[(16 * vt + 4 * fq + r) * 128 + 16 * kt + fr] = acc[r] * sc;
            }
        }
        __syncthreads();
    }
}

__device__ __forceinline__ void h2_phase(const Args& a) {
    unsigned char* ws = opaque_ptr(a.ws);
    const int tid = opaque_tid();
    const float* LT = (const float*)(ws + WS_LT); const float* DD = (const float*)(ws + WS_DD); const float* EE = (const float*)(ws + WS_EE);
    bf16_t* SP = (bf16_t*)(ws + WS_SP);
    for (int u = blockIdx.x; u < 256; u += gridDim.x) {
        const int chain = u >> 4, sub = u & 15;
        const int v = 8 * sub + (tid >> 6), k = 2 * (tid & 63);
        const size_t ibase = (size_t)chain * 128;
        float s0 = 0.f, s1 = 0.f;
        for (int cs0 = 0; cs0 < 128; cs0 += 8) {
            f32x2 lt[8], dd[8], ee[8];
#pragma unroll
            for (int j = 0; j < 8; ++j) { const size_t it = ibase + cs0 + j;
                lt[j] = *(const f32x2*)(LT + it * 16384 + v * 128 + k); dd[j] = *(const f32x2*)(DD + it * 128 + k); ee[j] = *(const f32x2*)(EE + it * 128 + k); }
#pragma unroll
            for (int j = 0; j < 8; ++j) { const size_t it = ibase + cs0 + j;
                *(unsigned*)(SP + it * 16384 + v * 128 + k) = cvt_pk_bf16(s0 * ee[j][0], s1 * ee[j][1]);
                s0 = dd[j][0] * s0 + lt[j][0]; s1 = dd[j][1] * s1 + lt[j][1]; }
        }
    }
}

__device__ __forceinline__ void h3_phase(const Args& a, int layer, LAS unsigned char* lds) {
    unsigned char* ws = opaque_ptr(a.ws);
    const int tid = opaque_tid(), lane = tid & 63, w = __builtin_amdgcn_readfirstlane(tid >> 6), fr = lane & 15, fq = lane >> 4;
    const int kc = tid & 127, seg = tid >> 7;
    LAS float* SEGS = (LAS float*)lds; LAS float* SSQP = (LAS float*)(lds + 2048);
    LAS unsigned char* Qp = lds + 4096; LAS unsigned char* Kp = Qp + 64 * HP_ROWB; LAS unsigned char* Vt = Kp + 64 * HP_ROWB; LAS unsigned char* Ab = Vt + 128 * HT_ROWB;
    const bf16_t* QH = (const bf16_t*)(ws + WS_QH); const bf16_t* VH = (const bf16_t*)(ws + WS_VH); const bf16_t* HG = (const bf16_t*)(ws + WS_HG);
    const bf16_t* SP = (const bf16_t*)(ws + WS_SP); bf16_t* OA = (bf16_t*)(ws + WS_OA);
    const float* onorm = a.in[5] + layer * 128;
    for (int item = blockIdx.x; item < 1024; item += gridDim.x) {
        const int n = item >> 3, h = item & 7;
        const int tok0 = 64 * n, colg = h * 128 + kc;
        f32x4 o[4];
#pragma unroll
        for (int j = 0; j < 4; ++j) o[j] = (f32x4){0.f, 0.f, 0.f, 0.f};
        for (int d = 0; d < 2; ++d) {
            const int cs = d ? 127 - n : n; const size_t sitem = (size_t)((d * 8 + h) * 128 + cs);
            const float* G = (const float*)(ws + (d ? WS_GB : WS_GF)); const bf16_t* KK = (const bf16_t*)(ws + (d ? WS_KB : WS_KF));
            float b[16], bref, blast;
            hg_cumsum(G, tok0, colg, seg, kc, d, SEGS, b, bref, blast);
            {
                unsigned vw[8];
#pragma unroll
                for (int i = 0; i < 16; i += 2) {
                    const size_t o0 = (size_t)(tok0 + 16 * seg + i) * HW + colg, o1 = o0 + HW;
                    const float e0 = fminf(b[i] - bref, 80.f), e1 = fminf(b[i + 1] - bref, 80.f);
                    const float q0 = bf2f(QH[o0]) * __expf(e0), q1 = bf2f(QH[o1]) * __expf(e1);
                    const float k0 = bf2f(KK[o0]) * __expf(fminf(-(b[i] - bref), 80.f)), k1 = bf2f(KK[o1]) * __expf(fminf(-(b[i + 1] - bref), 80.f));
                    *(LAS unsigned short*)(Qp + (16 * seg + i) * HP_ROWB + kc * 2) = f2bf1(q0);
                    *(LAS unsigned short*)(Qp + (16 * seg + i + 1) * HP_ROWB + kc * 2) = f2bf1(q1);
                    *(LAS unsigned short*)(Kp + (16 * seg + i) * HP_ROWB + kc * 2) = f2bf1(k0);
                    *(LAS unsigned short*)(Kp + (16 * seg + i + 1) * HP_ROWB + kc * 2) = f2bf1(k1);
                    vw[i >> 1] = (unsigned)VH[o0] | ((unsigned)VH[o1] << 16);
                }
                LAS u32x4* vd = (LAS u32x4*)(Vt + kc * HT_ROWB + seg * 32); vd[0] = (u32x4){vw[0], vw[1], vw[2], vw[3]}; vd[1] = (u32x4){vw[4], vw[5], vw[6], vw[7]};
            }
            __syncthreads();
            {
                const int rt = w >> 1;
#pragma unroll
                for (int tt = 0; tt < 2; ++tt) {
                    const int st = 2 * (w & 1) + tt;
                    const bool need = d ? (st >= rt) : (st <= rt);
                    f32x4 acc = (f32x4){0.f, 0.f, 0.f, 0.f};
                    if (need) {
#pragma unroll
                        for (int ks = 0; ks < 4; ++ks) {
                            const bf16x8 af = *(const LAS bf16x8*)(Qp + (16 * rt + fr) * HP_ROWB + (32 * ks + 8 * fq) * 2);
                            const bf16x8 bfr = *(const LAS bf16x8*)(Kp + (16 * st + fr) * HP_ROWB + (32 * ks + 8 * fq) * 2);
                            acc = __builtin_amdgcn_mfma_f32_16x16x32_bf16(af, bfr, acc, 0, 0, 0);
                        }
                    }
                    const int s_ = 16 * st + fr;
#pragma unroll
                    for (int r = 0; r < 4; ++r) { const int r_ = 16 * rt + 4 * fq + r; const bool ok = need && (d ? (s_ >= r_) : (s_ <= r_));
                        *(LAS unsigned short*)(Ab + r_ * HT_ROWB + s_ * 2) = f2bf1(ok ? acc[r] : 0.f); }
                }
            }
            __syncthreads();
            {
                const int rt = w & 3;
                bf16x8 aa[2], aq[4];
#pragma unroll
                for (int ks = 0; ks < 2; ++ks) aa[ks] = *(const LAS bf16x8*)(Ab + (16 * rt + fr) * HT_ROWB + (32 * ks + 8 * fq) * 2);
#pragma unroll
                for (int ks = 0; ks < 4; ++ks) aq[ks] = *(const LAS bf16x8*)(Qp + (16 * rt + fr) * HP_ROWB + (32 * ks + 8 * fq) * 2);
                const bf16_t* spb = SP + sitem * 16384;
#pragma unroll
                for (int j = 0; j < 4; ++j) {
                    const int vt = 4 * (w >> 2) + j;
#pragma unroll
                    for (int ks = 0; ks < 2; ++ks) { const bf16x8 bfr = *(const LAS bf16x8*)(Vt + (16 * vt + fr) * HT_ROWB + (32 * ks + 8 * fq) * 2);
                        o[j] = __builtin_amdgcn_mfma_f32_16x16x32_bf16(aa[ks], bfr, o[j], 0, 0, 0); }
#pragma unroll
                    for (int ks = 0; ks < 4; ++ks) { const bf16x8 bfr = *(const bf16x8*)(spb + (16 * vt + fr) * 128 + 32 * ks + 8 * fq);
                        o[j] = __builtin_amdgcn_mfma_f32_16x16x32_bf16(aq[ks], bfr, o[j], 0, 0, 0); }
                }
            }
            __syncthreads();
        }
        {
            const int rt = w & 3;
            float pr[4];
#pragma unroll
            for (int r = 0; r < 4; ++r) { float s = 0.f;
#pragma unroll
                for (int j = 0; j < 4; ++j) s += o[j][r] * o[j][r];
                s += __shfl_xor(s, 1); s += __shfl_xor(s, 2); s += __shfl_xor(s, 4); s += __shfl_xor(s, 8); pr[r] = s; }
            if (fr == 0) {
#pragma unroll
                for (int r = 0; r < 4; ++r) SSQP[(w >> 2) * 64 + 16 * rt + 4 * fq + r] = pr[r]; }
            __syncthreads();
#pragma unroll
            for (int r = 0; r < 4; ++r) {
                const int row = 16 * rt + 4 * fq + r; const float rs = rsqrtf((SSQP[row] + SSQP[64 + row]) * (1.0f / 128.f) + EPS);
#pragma unroll
                for (int j = 0; j < 4; ++j) { const int v = 16 * (4 * (w >> 2) + j) + fr; const size_t off = (size_t)(tok0 + row) * HW + h * 128 + v;
                    OA[off] = f2bf1(o[j][r] * rs * onorm[v] * bf2f(HG[off])); }
            }
            __syncthreads();
        }
    }
}

__device__ __forceinline__ void natten_phase(const Args& a, int layer, LAS unsigned char* lds) {
    unsigned char* ws = opaque_ptr(a.ws);
    const int tid = opaque_tid(), lane = tid & 63, w = __builtin_amdgcn_readfirstlane(tid >> 6), fr = lane & 15, fq = lane >> 4;
    LAS float* RP = (LAS float*)lds;
    const bf16_t* NQ = (const bf16_t*)(ws + WS_NQ); const bf16_t* NK = (const bf16_t*)(ws + WS_NK); const bf16_t* VT = (const bf16_t*)(ws + WS_VT);
    const bf16_t* NG = (const bf16_t*)(ws + WS_NG); bf16_t* OB = (bf16_t*)(ws + WS_OB);
    const float* gq = a.in[6] + layer * 128; const float* gk = a.in[7] + layer * 128; const float* rpb = a.in[8] + (size_t)layer * 8 * 465;
    for (int it = blockIdx.x; it < 512; it += gridDim.x) {
        const int r = it >> 2, hp = it & 3, h = 2 * hp + (w >> 2), j = w & 3;
        for (int i = tid; i < 930; i += 512) RP[i] = rpb[(size_t)(2 * hp) * 465 + i];
        __syncthreads();
        const int r_start = min(max(r - 4, 0), 120);
        const int c0k = (j == 0) ? 0 : (j == 1) ? 8 : (j == 2) ? 24 : 32;
        const int cq = 16 * j + fr, tq = 64 * r + cq;
        const int cstart = min(max(cq - 8, 0), 48);
        bf16x8 qf[4];
        {
            float qv[4][8]; float ss = 0.f;
#pragma unroll
            for (int ks = 0; ks < 4; ++ks) { load8_bf16(NQ + (size_t)tq * HW + h * 128 + 32 * ks + 8 * fq, qv[ks]);
#pragma unroll
                for (int e = 0; e < 8; ++e) ss += qv[ks][e] * qv[ks][e]; }
            ss += __shfl_xor(ss, 16); ss += __shfl_xor(ss, 32);
            const float rq = rsqrtf(ss * (1.0f / 128.f) + EPS) * 0.08838834764831845f;
#pragma unroll
            for (int ks = 0; ks < 4; ++ks) { float g1[8], g2[8]; load8_f32(gq + 32 * ks + 8 * fq, g1); load8_f32(gk + 32 * ks + 8 * fq, g2);
                u32x4 wv;
                wv.x = cvt_pk_bf16(qv[ks][0] * rq * g1[0] * g2[0], qv[ks][1] * rq * g1[1] * g2[1]); wv.y = cvt_pk_bf16(qv[ks][2] * rq * g1[2] * g2[2], qv[ks][3] * rq * g1[3] * g2[3]);
                wv.z = cvt_pk_bf16(qv[ks][4] * rq * g1[4] * g2[4], qv[ks][5] * rq * g1[5] * g2[5]); wv.w = cvt_pk_bf16(qv[ks][6] * rq * g1[6] * g2[6], qv[ks][7] * rq * g1[7] * g2[7]);
                qf[ks] = __builtin_bit_cast(bf16x8, wv); }
        }
        float s[8][2][4];
        float mx = -3.0e38f;
#pragma unroll
        for (int aa = 0; aa < 8; ++aa) {
            const int kr = r_start + aa, row_off = kr - r + 7;
#pragma unroll
            for (int kt = 0; kt < 2; ++kt) {
                const int tk = 64 * kr + c0k + 16 * kt + fr;
                bf16x8 kf[4]; float ssk = 0.f;
#pragma unroll
                for (int ks = 0; ks < 4; ++ks) { const u32x4 wv = *(const u32x4*)(NK + (size_t)tk * HW + h * 128 + 32 * ks + 8 * fq); kf[ks] = __builtin_bit_cast(bf16x8, wv);
                    ssk += bflo(wv.x) * bflo(wv.x) + bfhi(wv.x) * bfhi(wv.x) + bflo(wv.y) * bflo(wv.y) + bfhi(wv.y) * bfhi(wv.y)
                         + bflo(wv.z) * bflo(wv.z) + bfhi(wv.z) * bfhi(wv.z) + bflo(wv.w) * bflo(wv.w) + bfhi(wv.w) * bfhi(wv.w); }
                ssk += __shfl_xor(ssk, 16); ssk += __shfl_xor(ssk, 32);
                const float rk = rsqrtf(ssk * (1.0f / 128.f) + EPS);
                f32x4 acc = (f32x4){0.f, 0.f, 0.f, 0.f};
#pragma unroll
                for (int ks = 0; ks < 4; ++ks) acc = __builtin_amdgcn_mfma_f32_16x16x32_bf16(kf[ks], qf[ks], acc, 0, 0, 0);
#pragma unroll
                for (int rg = 0; rg < 4; ++rg) {
                    const int ki = 4 * fq + rg; const float rki = __shfl(rk, ki);
                    const int kcl = c0k + 16 * kt + ki; const bool valid = (kcl >= cstart) && (kcl < cstart + 16);
                    const int co = min(max(kcl - cq + 15, 0), 30);
                    const float bias = RP[(w >> 2) * 465 + row_off * 31 + co];
                    const float sv = valid ? (acc[rg] * rki + bias) : -1.0e30f;
                    s[aa][kt][rg] = sv; mx = fmaxf(mx, sv);
                }
            }
        }
        mx = fmaxf(mx, __shfl_xor(mx, 16)); mx = fmaxf(mx, __shfl_xor(mx, 32));
        float l = 0.f;
#pragma unroll
        for (int aa = 0; aa < 8; ++aa)
#pragma unroll
            for (int kt = 0; kt < 2; ++kt)
#pragma unroll
                for (int rg = 0; rg < 4; ++rg) { const float p = __expf(s[aa][kt][rg] - mx); s[aa][kt][rg] = p; l += p; }
        l += __shfl_xor(l, 16); l += __shfl_xor(l, 32);
        f32x4 o[8];
#pragma unroll
        for (int dt = 0; dt < 8; ++dt) o[dt] = (f32x4){0.f, 0.f, 0.f, 0.f};
#pragma unroll
        for (int aa = 0; aa < 8; ++aa) {
            u32x4 pw; pw.x = cvt_pk_bf16(s[aa][0][0], s[aa][0][1]); pw.y = cvt_pk_bf16(s[aa][0][2], s[aa][0][3]); pw.z = cvt_pk_bf16(s[aa][1][0], s[aa][1][1]); pw.w = cvt_pk_bf16(s[aa][1][2], s[aa][1][3]);
            const bf16x8 pb = __builtin_bit_cast(bf16x8, pw);
            const int tkb = 64 * (r_start + aa) + c0k + 4 * fq;
#pragma unroll
            for (int dt = 0; dt < 8; ++dt) {
                const bf16_t* vp = VT + (size_t)(h * 128 + 16 * dt + fr) * SEQ + tkb;
                const u32x2 v0 = *(const u32x2*)vp, v1 = *(const u32x2*)(vp + 16);
                const u32x4 vw = (u32x4){v0.x, v0.y, v1.x, v1.y};
                o[dt] = __builtin_amdgcn_mfma_f32_16x16x32_bf16(__builtin_bit_cast(bf16x8, vw), pb, o[dt], 0, 0, 0);
            }
        }
        const float inv = 1.0f / l;
#pragma unroll
        for (int dt = 0; dt < 8; ++dt) {
            const size_t off = (size_t)tq * HW + h * 128 + 16 * dt + 4 * fq;
            const u32x2 gw = *(const u32x2*)(NG + off);
            u32x2 ow; ow.x = cvt_pk_bf16(o[dt][0] * inv * bflo(gw.x), o[dt][1] * inv * bfhi(gw.x)); ow.y = cvt_pk_bf16(o[dt][2] * inv * bflo(gw.y), o[dt][3] * inv * bfhi(gw.y));
            *(u32x2*)(OB + off) = ow;
        }
        __syncthreads();
    }
}

__global__ void __launch_bounds__(512, 2) mk_fwd(Args a) {
    extern __shared__ __attribute__((aligned(16))) unsigned char lds_raw[];
    LAS unsigned char* lds = (LAS unsigned char*)lds_raw;
    volatile LAS unsigned* MISC = (volatile LAS unsigned*)(lds + LDS_MISC_OFF);
    unsigned char* ws = a.ws;
    if (threadIdx.x < 64) MISC[threadIdx.x] = 0u;
    __syncthreads();
    XcdBarrier bar; bar.bar = (unsigned*)(ws + WS_CTL) + 4096; bar.x = 0; bar.st = nullptr;
    const int lo = a.ph_lo, hi = a.ph_hi;
    if (hi - lo > 1) bar = xcd_barrier_post((unsigned*)(ws + WS_CTL) + 4096, MISC + 8);
#ifndef DIAG_MASK
#define DIAG_MASK 0x1ff
#endif
#define DM_(b) ((DIAG_MASK >> (b)) & 1)
#define IN(k) (lo <= (k) && (k) < hi)
#if MK_TS
    unsigned long long* TS = (unsigned long long*)(ws + 131072);
#define STAMP(k) do { if (blockIdx.x == 0 && threadIdx.x == 0) TS[k] = __builtin_amdgcn_s_memrealtime(); } while (0)
#define SEAM(k) do { if (IN(k) && (IN((k) + 1) || (k) == NPHASE - 1)) xcd_barrier(bar); STAMP((k) + 1); } while (0)
    STAMP(0);
#else
#define SEAM(k) do { if (IN(k) && IN((k) + 1)) xcd_barrier(bar); } while (0)
#endif
    const int G = gridDim.x, c = blockIdx.x;

    if (DM_(0) && IN(0)) { for (int rep = 0; rep < (MK_REP_PHASE == 0 ? MK_REP_N : 1); ++rep) { if (rep) xcd_barrier(bar); p0_prologue(a, lds); } }
    SEAM(0);
    for (int l = 0; l < 2; ++l) {
        const int pb = 1 + 7 * l;
        for (int rep = 0; rep < (MK_REP_PHASE == pb + 0 ? MK_REP_N : 1); ++rep) { if (rep) xcd_barrier(bar);
        if (DM_(1) && IN(pb + 0)) {
            unsigned char* ws = opaque_ptr(a.ws); bf16_t* XGA = (bf16_t*)(ws + WS_XGA); float* SSQ = (float*)(ws + WS_SSQ);
            pg8::Gemm g{XGA, (const bf16_t*)(ws + WS_WIN) + (size_t)l * NIN * DM, SEQ, NIN, DM}; pg8::StaticOrder S; S.init(SEQ, NIN, G, c);
            EpiInProj E{SSQ + (2 * l) * SEQ, (const float*)(ws + WS_LOWER) + l * 2048, ws};
            pg8::gemm_phase<EpiInProj, pg8::StaticOrder>(lds, g, S, E);
        } }
        SEAM(pb + 0);
        if (IN(pb + 1)) { for (int rep = 0; rep < (MK_REP_PHASE == pb + 1 ? MK_REP_N : 1); ++rep) { if (rep) xcd_barrier(bar); if (DM_(2)) h1_phase(a, lds); }
            for (int rep = 0; rep < (MK_REP_PHASE == pb + 101 ? MK_REP_N : 1); ++rep) { if (rep) xcd_barrier(bar); if (DM_(8)) natten_phase(a, l, lds); } }
        SEAM(pb + 1);
        if (DM_(3) && IN(pb + 2)) { for (int rep = 0; rep < (MK_REP_PHASE == pb + 2 ? MK_REP_N : 1); ++rep) { if (rep) xcd_barrier(bar); h2_phase(a); } }
        SEAM(pb + 2);
        if (DM_(4) && IN(pb + 3)) { for (int rep = 0; rep < (MK_REP_PHASE == pb + 3 ? MK_REP_N : 1); ++rep) { if (rep) xcd_barrier(bar); h3_phase(a, l, lds); } }
        SEAM(pb + 3);
        for (int rep = 0; rep < (MK_REP_PHASE == pb + 4 ? MK_REP_N : 1); ++rep) { if (rep) xcd_barrier(bar);
        if (DM_(5) && IN(pb + 4)) {
            unsigned char* ws = opaque_ptr(a.ws);
            pg8::StaticOrder S; S.init(SEQ, DM, G, c);
            { pg8::Gemm g{(const bf16_t*)(ws + WS_OA), (const bf16_t*)(ws + WS_WA) + (size_t)l * DM * HW, SEQ, DM, HW};
              EpiBrA E{(const bf16_t*)(ws + WS_MA), (float*)(ws + WS_T)};
              pg8::gemm_phase<EpiBrA, pg8::StaticOrder>(lds, g, S, E); }
            { pg8::Gemm g{(const bf16_t*)(ws + WS_OB), (const bf16_t*)(ws + WS_WB) + (size_t)l * DM * HW, SEQ, DM, HW};
              EpiBrB E{(const bf16_t*)(ws + WS_MB), (const float*)(ws + WS_T), (bf16_t*)(ws + WS_Y)};
              pg8::gemm_phase<EpiBrB, pg8::StaticOrder>(lds, g, S, E); }
        } }
        SEAM(pb + 4);
        for (int rep = 0; rep < (MK_REP_PHASE == pb + 5 ? MK_REP_N : 1); ++rep) { if (rep) xcd_barrier(bar);
        if (DM_(6) && IN(pb + 5)) {
            unsigned char* ws = opaque_ptr(a.ws); bf16_t* XGB = (bf16_t*)(ws + WS_XGB); float* SSQ = (float*)(ws + WS_SSQ);
            pg8::Gemm g{(const bf16_t*)(ws + WS_Y), (const bf16_t*)(ws + WS_WO) + (size_t)l * DM * DM, SEQ, DM, DM}; pg8::StaticOrder S; S.init(SEQ, DM, G, c);
            EpiWout E{l == 0 ? a.in[0] : (const float*)a.out, (float*)(ws + WS_X1), XGB, a.in[12] + l * DM, rep ? (float*)(ws + 262144) : SSQ + (2 * l + 1) * SEQ};
            pg8::gemm_phase<EpiWout, pg8::StaticOrder>(lds, g, S, E);
        } }
        SEAM(pb + 5);
        for (int rep = 0; rep < (MK_REP_PHASE == pb + 6 ? MK_REP_N : 1); ++rep) { if (rep) xcd_barrier(bar);
        if (DM_(7) && IN(pb + 6)) {
            unsigned char* ws = opaque_ptr(a.ws); bf16_t* XGA = (bf16_t*)(ws + WS_XGA); bf16_t* XGB = (bf16_t*)(ws + WS_XGB); float* SSQ = (float*)(ws + WS_SSQ);
            pg8::StaticOrder S; S.init(SEQ, DM, G, c);
            { pg8::Gemm g{(const bf16_t*)(ws + WS_PB) + (size_t)l * SEQ * PLE, (const bf16_t*)(ws + WS_WP) + (size_t)l * DM * PLE, SEQ, DM, PLE};
              EpiPL E{(float*)(ws + WS_PL)};
              pg8::gemm_phase<EpiPL, pg8::StaticOrder>(lds, g, S, E); }
            { pg8::Gemm g{XGB, (const bf16_t*)(ws + WS_WG) + (size_t)l * DM * DM, SEQ, DM, DM};
              EpiGate E{SSQ + (2 * l + 1) * SEQ, (const float*)(ws + WS_X1), (const float*)(ws + WS_PL), a.out, XGA, a.in[2] + (l + 1 < 2 ? (l + 1) * DM : 0), rep ? (float*)(ws + 262144) : SSQ + (2 * l + 2 < 4 ? 2 * l + 2 : 0) * SEQ, l == 0 ? 1 : 0};
              pg8::gemm_phase<EpiGate, pg8::StaticOrder>(lds, g, S, E); }
        } }
        SEAM(pb + 6);
    }
#if MK_TS
    if (blockIdx.x == 0) {
        const float dA = (float)(TS[MK_TS_A + 1] - TS[MK_TS_A]) * 0.01f, dB = (float)(TS[MK_TS_B + 1] - TS[MK_TS_B]) * 0.01f;
        for (int i = threadIdx.x; i < 1000000; i += 512) a.out[i] += (i == 0) ? 10.f * dA : 0.3f * dB;
    }
#endif
#undef IN
#undef SEAM
#if MK_ENDFLUSH
    asm volatile("s_waitcnt vmcnt(0)" ::: "memory");
    __builtin_amdgcn_fence(__ATOMIC_RELEASE, "agent");
    asm volatile("s_waitcnt vmcnt(0)" ::: "memory");
#endif
}


#ifndef MK_DIAG
#define MK_DIAG 0
#define MK_HOLE_BUF WS_MB
#define MK_HOLE_LD DM
#define MK_HOLE_MODE 0
#endif
#if MK_DIAG
__global__ void ck_sum(const void* p, size_t n, int kind, double* slot) {
    double s0 = 0.0, s1 = 0.0;
    for (size_t i = (size_t)blockIdx.x * blockDim.x + threadIdx.x; i < n; i += (size_t)gridDim.x * blockDim.x) {
        float v = kind ? bf2f(((const bf16_t*)p)[i]) : ((const float*)p)[i];
        if (!(v == v)) v = 12345.0f;
        const float wgt = (float)((int)((i * 2654435761ull >> 16) & 255) - 128);
        s0 += fabsf(v); s1 += (double)v * wgt;
    }
    for (int o = 32; o >= 1; o >>= 1) { s0 += __shfl_xor(s0, o); s1 += __shfl_xor(s1, o); }
    if ((threadIdx.x & 63) == 0) { atomicAdd(slot, s0); atomicAdd(slot + 1, s1); }
}
__global__ void ck_final(const double* sums, float* out, size_t n, int nslots) {
    int first = -1;
    for (int i = 0; i < nslots; ++i) { const double a0 = sums[2 * i], a1 = sums[2 * i + 1], b0 = sums[2 * (nslots + i)], b1 = sums[2 * (nslots + i) + 1];
        const bool bad = fabs(a0 - b0) > 1e-5 * (fabs(a0) + fabs(b0)) + 1e-30 || fabs(a1 - b1) > 1e-4 * (fabs(a0) + fabs(b0)) + 1e-30;
        if (bad) { first = i; break; } }
    const float val = first < 0 ? 0.f : 100.f * (float)(first + 1);
    for (size_t i = (size_t)blockIdx.x * blockDim.x + threadIdx.x; i < n; i += (size_t)gridDim.x * blockDim.x) out[i] = val;
}
__global__ void ck_holes(const bf16_t* p, size_t n, unsigned long long* res) {
    unsigned long long cnt = 0, mn = ~0ull;
    for (size_t i = (size_t)blockIdx.x * blockDim.x + threadIdx.x; i < n; i += (size_t)gridDim.x * blockDim.x) if (p[i] == 0xFFFFu) { ++cnt; if (i < mn) mn = i; }
    if (cnt) { atomicAdd(res, cnt); atomicMin(res + 1, mn); }
}
__global__ void ck_holes_final(const unsigned long long* res, float* out, size_t n, int mode) {
    const float val = mode == 0 ? (float)((double)res[0] / 65536.0 * 100.0) : mode == 1 ? (float)((res[1] == ~0ull ? 0 : (res[1] / 2048) ) ) + 100.f : (float)((res[1] == ~0ull ? 0 : (res[1] % 2048))) + 100.f;
    for (size_t i = (size_t)blockIdx.x * blockDim.x + threadIdx.x; i < n; i += (size_t)gridDim.x * blockDim.x) out[i] = val;
}
__global__ void ck_diff(const bf16_t* p, const bf16_t* q, size_t n, unsigned long long* res) {
    unsigned long long cnt = 0, mn = ~0ull, big = 0;
    for (size_t i = (size_t)blockIdx.x * blockDim.x + threadIdx.x; i < n; i += (size_t)gridDim.x * blockDim.x) if (p[i] != q[i]) { ++cnt; if (i < mn) mn = i; const float a = bf2f(p[i]), b = bf2f(q[i]); if (fabsf(a - b) > 0.02f * (fabsf(a) + fabsf(b))) ++big; }
    if (cnt) { atomicAdd(res, cnt); atomicMin(res + 1, mn); atomicAdd(res + 2, big); }
}
__global__ void ck_diff_final(const unsigned long long* res, float* out, size_t n, int ld) {
    const unsigned long long cnt = res[0], big = res[2];
    const float c2 = 100.f * (1.f + floorf(log2f(1.f + (float)cnt)));
    const float c1 = 1.0e6f * (1.f + floorf(log2f(1.f + (float)big)));
    for (size_t i = (size_t)blockIdx.x * blockDim.x + threadIdx.x; i < n; i += (size_t)gridDim.x * blockDim.x) out[i] = (i == 0) ? c1 : c2;
}

__device__ __forceinline__ unsigned hsh(unsigned x) { x ^= x >> 16; x *= 0x7feb352du; x ^= x >> 15; x *= 0x846ca68bu; x ^= x >> 16; return x; }
__device__ __forceinline__ float bfr(float f) { return bf2f(f2bf1(f)); }
__device__ __forceinline__ void err_max(unsigned* res, float got, float expv) { float e = fabsf(got - expv) / (0.02f + 0.02f * fabsf(expv)); if (!(e == e)) e = 1e9f; atomicMax(res, __float_as_uint(e)); }
__device__ __forceinline__ float wave_sum(float s) { for (int o = 32; o >= 1; o >>= 1) s += __shfl_xor(s, o); return s; }
__global__ void chk_inproj(const float* x, const float* g0, const float* win, const float* lbp, const unsigned char* ws, unsigned* res, int nsamp) {
    const int lane = threadIdx.x & 63, wv = (blockIdx.x * blockDim.x + threadIdx.x) >> 6, nw = (gridDim.x * blockDim.x) >> 6;
    for (int s = wv; s < nsamp; s += nw) {
        const int row = hsh(2 * s + 1) % SEQ, col = hsh(2 * s + 2) % NIN;
        float ss = 0.f, dot = 0.f;
        for (int k = lane; k < DM; k += 64) { const float xv = x[(size_t)row * DM + k]; ss += xv * xv; dot += bfr(xv * g0[k]) * bfr(win[(size_t)k * NIN + col]); }
        ss = wave_sum(ss); dot = wave_sum(dot);
        const float u = dot * rsqrtf(ss / DM + EPS);
        if (lane == 0) {
            const int seg = col >> 10, c = col & 1023; const size_t o1 = (size_t)row * HW + c;
            const float sg = 1.f / (1.f + expf(-u)), si = u * sg;
            if (seg == 0) err_max(res, bf2f(((const bf16_t*)(ws + WS_QH))[o1]), si);
            else if (seg == 1) err_max(res, bf2f(((const bf16_t*)(ws + WS_VH))[o1]), u);
            else if (seg == 2 || seg == 3) { const int dir = seg - 2; const float a0 = lbp[dir * 1024 + c], a1 = lbp[2048 + dir * 1024 + c]; const float lb = 0.f * (a0 + a1);
                const float f = lb + (1.f - lb) * sg; err_max(res + 1, ((const float*)(ws + (dir ? WS_GB : WS_GF)))[o1], logf(fmaxf(f, 1e-6f)));
                err_max(res + 1, bf2f(((const bf16_t*)(ws + (dir ? WS_KB : WS_KF)))[o1]), (1.f - lb) * (1.f - sg)); }
            else if (seg == 4) err_max(res, bf2f(((const bf16_t*)(ws + WS_HG))[o1]), si);
            else if (seg == 5) err_max(res, bf2f(((const bf16_t*)(ws + WS_NQ))[o1]), u);
            else if (seg == 6) err_max(res, bf2f(((const bf16_t*)(ws + WS_NK))[o1]), u);
            else if (seg == 7) err_max(res + 2, bf2f(((const bf16_t*)(ws + WS_VT))[(size_t)c * SEQ + row]), u);
            else if (seg == 8) err_max(res, bf2f(((const bf16_t*)(ws + WS_NG))[o1]), si);
            else if (seg < 11) err_max(res + 3, bf2f(((const bf16_t*)(ws + WS_MA))[(size_t)row * DM + col - 9216]), sg);
            else err_max(res + 9, bf2f(((const bf16_t*)(ws + WS_MB))[(size_t)row * DM + col - 11264]), sg);
        }
    }
}
__global__ void chk_natten(const unsigned char* ws, const float* gq, const float* gk, const float* rpb, unsigned* res, int nsamp) {
    const int lane = threadIdx.x & 63, wv = (blockIdx.x * blockDim.x + threadIdx.x) >> 6, nw = (gridDim.x * blockDim.x) >> 6;
    const bf16_t* NQ = (const bf16_t*)(ws + WS_NQ); const bf16_t* NK = (const bf16_t*)(ws + WS_NK); const bf16_t* VT = (const bf16_t*)(ws + WS_VT); const bf16_t* NG = (const bf16_t*)(ws + WS_NG); const bf16_t* OB = (const bf16_t*)(ws + WS_OB);
    for (int s = wv; s < nsamp; s += nw) {
        const int t = hsh(3 * s + 7) % SEQ, h = hsh(3 * s + 8) % 8; const int r = t >> 6, c = t & 63;
        const int rs0 = min(max(r - 4, 0), 120), cs0 = min(max(c - 8, 0), 48);
        float q0 = bf2f(NQ[(size_t)t * HW + h * 128 + lane]), q1 = bf2f(NQ[(size_t)t * HW + h * 128 + 64 + lane]);
        const float rq = rsqrtf(wave_sum(q0 * q0 + q1 * q1) / 128.f + EPS); q0 *= rq * gq[lane]; q1 *= rq * gq[64 + lane];
        float mx = -1e30f;
        float o0 = 0.f, o1 = 0.f, l = 0.f;
        for (int pass = 0; pass < 2; ++pass) {
            for (int a = 0; a < 8; ++a) for (int j = 0; j < 16; ++j) {
                const int kr = rs0 + a, kc = cs0 + j, tk = kr * 64 + kc;
                float k0 = bf2f(NK[(size_t)tk * HW + h * 128 + lane]), k1 = bf2f(NK[(size_t)tk * HW + h * 128 + 64 + lane]);
                const float rk = rsqrtf(wave_sum(k0 * k0 + k1 * k1) / 128.f + EPS);
                const float d = wave_sum(q0 * k0 * rk * gk[lane] + q1 * k1 * rk * gk[64 + lane]) * 0.08838834764831845f + rpb[(size_t)h * 465 + (kr - r + 7) * 31 + (kc - c + 15)];
                if (pass == 0) mx = fmaxf(mx, d);
                else { const float p = expf(d - mx); l += p; o0 += p * bf2f(VT[(size_t)(h * 128 + lane) * SEQ + tk]); o1 += p * bf2f(VT[(size_t)(h * 128 + 64 + lane) * SEQ + tk]); }
            }
        }
        const size_t ob = (size_t)t * HW + h * 128;
        err_max(res, bf2f(OB[ob + lane]), o0 / l * bf2f(NG[ob + lane])); err_max(res, bf2f(OB[ob + 64 + lane]), o1 / l * bf2f(NG[ob + 64 + lane]));
    }
}
__global__ void chk_hgrn_scan(const unsigned char* ws, float* OREF, int h0) {
    __shared__ float qs[128], ks[128], fs[128], vs[128], part[4][128];
    const int tid = threadIdx.x, v = tid & 127, kq = tid >> 7; const int h = h0 + (blockIdx.x >> 1), d = blockIdx.x & 1;
    const bf16_t* QH = (const bf16_t*)(ws + WS_QH); const bf16_t* VH = (const bf16_t*)(ws + WS_VH); const bf16_t* KK = (const bf16_t*)(ws + (d ? WS_KB : WS_KF)); const float* G = (const float*)(ws + (d ? WS_GB : WS_GF));
    float S[32];
#pragma unroll
    for (int i = 0; i < 32; ++i) S[i] = 0.f;
    float* out = OREF + (size_t)blockIdx.x * SEQ * 128;
    for (int step = 0; step < SEQ; ++step) {
        const int t = d ? SEQ - 1 - step : step;
        if (tid < 128) { qs[tid] = bf2f(QH[(size_t)t * HW + h * 128 + tid]); ks[tid] = bf2f(KK[(size_t)t * HW + h * 128 + tid]); fs[tid] = expf(G[(size_t)t * HW + h * 128 + tid]); vs[tid] = bf2f(VH[(size_t)t * HW + h * 128 + tid]); }
        __syncthreads();
        float p = 0.f; const float vv = vs[v];
#pragma unroll
        for (int i = 0; i < 32; ++i) { const int k = 32 * kq + i; S[i] = fs[k] * S[i] + ks[k] * vv; p += S[i] * qs[k]; }
        part[kq][v] = p;
        __syncthreads();
        if (tid < 128) out[(size_t)t * 128 + tid] = part[0][tid] + part[1][tid] + part[2][tid] + part[3][tid];
    }
}
__global__ void chk_hgrn_out(const unsigned char* ws, const float* OREF, const float* onorm, unsigned* res, int h0, int nh) {
    const int lane = threadIdx.x & 63, wv = (blockIdx.x * blockDim.x + threadIdx.x) >> 6, nw = (gridDim.x * blockDim.x) >> 6;
    const bf16_t* HG = (const bf16_t*)(ws + WS_HG); const bf16_t* OA = (const bf16_t*)(ws + WS_OA);
    for (int s = wv; s < nh * SEQ; s += nw) {
        const int hh = s / SEQ, t = s % SEQ, h = h0 + hh;
        const float* of = OREF + ((size_t)(2 * hh) * SEQ + t) * 128; const float* ob = OREF + ((size_t)(2 * hh + 1) * SEQ + t) * 128;
        const float a0 = of[lane] + ob[lane], a1 = of[64 + lane] + ob[64 + lane];
        const float rs = rsqrtf(wave_sum(a0 * a0 + a1 * a1) / 128.f + EPS);
        const size_t o = (size_t)t * HW + h * 128;
        err_max(res, bf2f(OA[o + lane]), a0 * rs * onorm[lane] * bf2f(HG[o + lane])); err_max(res, bf2f(OA[o + 64 + lane]), a1 * rs * onorm[64 + lane] * bf2f(HG[o + 64 + lane]));
    }
}
__global__ void chk_branch(const unsigned char* ws, const float* wa, const float* wb, unsigned* res, int nsamp) {
    const int lane = threadIdx.x & 63, wv = (blockIdx.x * blockDim.x + threadIdx.x) >> 6, nw = (gridDim.x * blockDim.x) >> 6;
    const bf16_t* OA = (const bf16_t*)(ws + WS_OA); const bf16_t* OB = (const bf16_t*)(ws + WS_OB); const bf16_t* MA = (const bf16_t*)(ws + WS_MA); const bf16_t* MB = (const bf16_t*)(ws + WS_MB); const bf16_t* Y = (const bf16_t*)(ws + WS_Y);
    for (int s = wv; s < nsamp; s += nw) {
        const int row = hsh(5 * s + 1) % SEQ, col = hsh(5 * s + 2) % DM; float da = 0.f, db = 0.f;
        for (int k = lane; k < HW; k += 64) { da += bf2f(OA[(size_t)row * HW + k]) * bfr(wa[(size_t)k * DM + col]); db += bf2f(OB[(size_t)row * HW + k]) * bfr(wb[(size_t)k * DM + col]); }
        da = wave_sum(da); db = wave_sum(db);
        if (lane == 0) err_max(res, bf2f(Y[(size_t)row * DM + col]), bf2f(MA[(size_t)row * DM + col]) * da + bf2f(MB[(size_t)row * DM + col]) * db);
    }
}
__global__ void chk_wout(const unsigned char* ws, const float* xin, const float* wo, unsigned* res, int nsamp) {
    const int lane = threadIdx.x & 63, wv = (blockIdx.x * blockDim.x + threadIdx.x) >> 6, nw = (gridDim.x * blockDim.x) >> 6;
    const bf16_t* Y = (const bf16_t*)(ws + WS_Y); const float* X1 = (const float*)(ws + WS_X1);
    for (int s = wv; s < nsamp; s += nw) {
        const int row = hsh(7 * s + 1) % SEQ, col = hsh(7 * s + 2) % DM; float d = 0.f;
        for (int k = lane; k < DM; k += 64) d += bf2f(Y[(size_t)row * DM + k]) * bfr(wo[(size_t)k * DM + col]);
        d = wave_sum(d);
        if (lane == 0) err_max(res, X1[(size_t)row * DM + col], xin[(size_t)row * DM + col] + d);
    }
}
__global__ void chk_gate(const unsigned char* ws, const float* out, const float* p, const float* wp, const float* wg, const float* pn, unsigned* res, int nsamp) {
    const int lane = threadIdx.x & 63, wv = (blockIdx.x * blockDim.x + threadIdx.x) >> 6, nw = (gridDim.x * blockDim.x) >> 6;
    const float* X1 = (const float*)(ws + WS_X1);
    for (int s = wv; s < nsamp; s += nw) {
        const int row = hsh(9 * s + 1) % SEQ, col = hsh(9 * s + 2) % DM; float d = 0.f, ss = 0.f, pl = 0.f;
        for (int k = lane; k < DM; k += 64) { const float xv = X1[(size_t)row * DM + k]; ss += xv * xv; d += bfr(xv * pn[k]) * bfr(wg[(size_t)k * DM + col]); }
        for (int k = lane; k < PLE; k += 64) pl += bfr(p[(size_t)row * PLE + k]) * bfr(wp[(size_t)k * DM + col]);
        d = wave_sum(d); ss = wave_sum(ss); pl = wave_sum(pl);
        if (lane == 0) { const float g = 1.f / (1.f + expf(-d * rsqrtf(ss / DM + EPS))); err_max(res, out[(size_t)row * DM + col], X1[(size_t)row * DM + col] + pl * g); }
    }
}
__global__ void chk_final(const unsigned* res, float* out, size_t n, int nres) {
    int first = -1; for (int i = 0; i < nres; ++i) if (__uint_as_float(res[i]) > 1.0f) { first = i; break; }
    float bucket = 0.f; if (first >= 0) { const float e = __uint_as_float(res[first]); bucket = fminf(fmaxf(floorf(log10f(e)) + 1.f, 0.f), 9.f); }
    const float val = first < 0 ? 0.f : 100.f * (float)(first + 1) + 10.f * bucket;
    for (size_t i = (size_t)blockIdx.x * blockDim.x + threadIdx.x; i < n; i += (size_t)gridDim.x * blockDim.x) out[i] = val;
}

__global__ void ck_big(const bf16_t* p, size_t n, unsigned long long* res) {
    unsigned long long c0 = 0, c2 = 0, c4 = 0; float mxv = 0.f;
    for (size_t i = (size_t)blockIdx.x * blockDim.x + threadIdx.x; i < n; i += (size_t)gridDim.x * blockDim.x) { const float v = bf2f(p[i]);
        if (!(fabsf(v) <= 3.0e38f)) ++c0; else if (fabsf(v) > 1.01f || v < -0.01f) { ++c2; mxv = fmaxf(mxv, fabsf(v)); if (v < 0.f) ++c4; } }
    if (c0 | c2) { atomicAdd(res, c0); atomicAdd(res + 2, c2); atomicAdd(res + 4, c4); atomicMax((unsigned*)(res + 3), __float_as_uint(mxv)); }
}
__global__ void ck_big_final(const unsigned long long* res, float* out, size_t n, int ld) {
    const float mxv = __uint_as_float((unsigned)res[3]);
    const float c1 = 1.0e4f * (1.f + floorf(log2f(1.f + (float)res[0])));
    const float negf = res[2] ? (float)res[4] / (float)res[2] : 0.f;
    const float c2 = 1000.f * (1.f + floorf(negf * 3.99f)) + 100.f * fminf(fmaxf(floorf(log10f(fmaxf(mxv, 1e-9f))) + 2.f, 0.f), 9.f);
    for (size_t i = (size_t)blockIdx.x * blockDim.x + threadIdx.x; i < n; i += (size_t)gridDim.x * blockDim.x) out[i] = (i == 0) ? c1 : c2;
}
struct CkBuf { int phase; int idx; size_t off; size_t n; int kind; };
#endif

extern "C" void kernel_launch(void* const* d_in, const int* in_sizes, int n_in, void* d_out, int out_size, void* d_ws, size_t ws_size, hipStream_t stream) {
    static int grid = 0;
    if (grid == 0) {
        if (n_in != 15 || out_size != SEQ * DM || ws_size < WS_END) { fprintf(stderr, "kernel_launch: unexpected problem (n_in %d, out %d, ws %zu)\n", n_in, out_size, ws_size); grid = -1; return; }
        int dev = 0, cus = 0;
        if (hipGetDevice(&dev) != hipSuccess || hipDeviceGetAttribute(&cus, hipDeviceAttributeMultiprocessorCount, dev) != hipSuccess) { grid = -1; return; }
        if (hipFuncSetAttribute((const void*)mk_fwd, hipFuncAttributeMaxDynamicSharedMemorySize, LDS_BYTES) != hipSuccess) { fprintf(stderr, "kernel_launch: hipFuncSetAttribute failed\n"); grid = -1; return; }
        int per_cu = 0;
        if (hipOccupancyMaxActiveBlocksPerMultiprocessor(&per_cu, (const void*)mk_fwd, 512, LDS_BYTES) != hipSuccess || per_cu < 1) fprintf(stderr, "kernel_launch: occupancy query says %d\n", per_cu);
        (void)hipGetLastError();
        grid = cus;
    }
    if (grid < 0) return;
    (void)hipMemsetAsync((char*)d_ws + WS_CTL, 0, CTL_ZERO_BYTES, stream);
    Args a{};
    for (int i = 0; i < 15; ++i) a.in[i] = (const float*)d_in[i];
    a.out = (float*)d_out; a.ws = (unsigned char*)d_ws;
#if MK_DIAG == 5
    {
        unsigned long long* res = (unsigned long long*)((char*)d_ws + 65536);
        (void)hipMemsetAsync((char*)d_ws + 65536 + 8, 0xFF, 8, stream);
        for (int ph = 0; ph < 2; ++ph) { a.ph_lo = ph; a.ph_hi = ph + 1; hipLaunchKernelGGL(mk_fwd, dim3(grid), dim3(512), LDS_BYTES, stream, a); }
        hipLaunchKernelGGL(ck_big, dim3(1024), dim3(256), 0, stream, (const bf16_t*)((char*)d_ws + WS_MA), (size_t)SEQ * DM, res);
        hipLaunchKernelGGL(ck_big_final, dim3(1024), dim3(256), 0, stream, (const unsigned long long*)res, (float*)d_out, (size_t)SEQ * DM, DM);
    }
#elif MK_DIAG == 4
    {
        unsigned* res = (unsigned*)((char*)d_ws + 65536);
        float* OREF = (float*)((char*)d_ws + 728 * MiB);
        const unsigned char* wsc = (const unsigned char*)d_ws;
        const float* const* in = a.in;
        for (int ph = 0; ph < NPHASE; ++ph) {
            a.ph_lo = ph; a.ph_hi = ph + 1; hipLaunchKernelGGL(mk_fwd, dim3(grid), dim3(512), LDS_BYTES, stream, a);
            if (ph == 1) hipLaunchKernelGGL(chk_inproj, dim3(512), dim3(256), 0, stream, in[0], in[2], in[3], in[4], wsc, res + 0, 32768);
            if (ph == 2) hipLaunchKernelGGL(chk_natten, dim3(256), dim3(256), 0, stream, wsc, in[6], in[7], in[8], res + 4, 1024);
            if (ph == 4) { hipLaunchKernelGGL(chk_hgrn_scan, dim3(4), dim3(512), 0, stream, wsc, OREF, 2);
                           hipLaunchKernelGGL(chk_hgrn_out, dim3(512), dim3(256), 0, stream, wsc, (const float*)OREF, in[5], res + 5, 2, 2); }
            if (ph == 5) hipLaunchKernelGGL(chk_branch, dim3(512), dim3(256), 0, stream, wsc, in[9], in[10], res + 6, 8192);
            if (ph == 6) hipLaunchKernelGGL(chk_wout, dim3(512), dim3(256), 0, stream, wsc, in[0], in[11], res + 7, 8192);
            if (ph == 7) hipLaunchKernelGGL(chk_gate, dim3(512), dim3(256), 0, stream, wsc, (const float*)d_out, in[1], in[14], in[13], in[12], res + 8, 8192);
        }
        hipLaunchKernelGGL(chk_final, dim3(1024), dim3(256), 0, stream, (const unsigned*)res, (float*)d_out, (size_t)SEQ * DM, 10);
    }
#elif MK_DIAG == 3
    {
        unsigned long long* res = (unsigned long long*)((char*)d_ws + 65536);
        bf16_t* SAVE = (bf16_t*)((char*)d_ws + 728 * MiB);
        (void)hipMemsetAsync((char*)d_ws + MiB, 0xAA, WS_END - MiB, stream);
        (void)hipMemsetAsync((char*)d_ws + 65536 + 8, 0xFF, 8, stream);
        for (int ph = 0; ph < 2; ++ph) { a.ph_lo = ph; a.ph_hi = ph + 1; hipLaunchKernelGGL(mk_fwd, dim3(grid), dim3(512), LDS_BYTES, stream, a); }
        (void)hipMemcpyAsync(SAVE, (char*)d_ws + MK_HOLE_BUF, (size_t)SEQ * MK_HOLE_LD * 2, hipMemcpyDeviceToDevice, stream);
        a.ph_lo = 1; a.ph_hi = 2; hipLaunchKernelGGL(mk_fwd, dim3(grid), dim3(512), LDS_BYTES, stream, a);
        hipLaunchKernelGGL(ck_diff, dim3(1024), dim3(256), 0, stream, (const bf16_t*)((char*)d_ws + MK_HOLE_BUF), (const bf16_t*)SAVE, (size_t)SEQ * MK_HOLE_LD, res);
        hipLaunchKernelGGL(ck_diff_final, dim3(1024), dim3(256), 0, stream, (const unsigned long long*)res, (float*)d_out, (size_t)SEQ * DM, MK_HOLE_LD);
    }
#elif MK_DIAG == 2
    {
        unsigned long long* res = (unsigned long long*)((char*)d_ws + 65536);
        (void)hipMemsetAsync((char*)d_ws + MiB, 0xAA, WS_END - MiB, stream);
        (void)hipMemsetAsync((char*)d_ws + 65536 + 8, 0xFF, 8, stream);
        a.ph_lo = 0; a.ph_hi = 1; hipLaunchKernelGGL(mk_fwd, dim3(grid), dim3(512), LDS_BYTES, stream, a);
        (void)hipMemsetAsync((char*)d_ws + MK_HOLE_BUF, 0xFF, (size_t)SEQ * MK_HOLE_LD * 2, stream);
        a.ph_lo = 1; a.ph_hi = 2; hipLaunchKernelGGL(mk_fwd, dim3(grid), dim3(512), LDS_BYTES, stream, a);
        hipLaunchKernelGGL(ck_holes, dim3(1024), dim3(256), 0, stream, (const bf16_t*)((char*)d_ws + MK_HOLE_BUF), (size_t)SEQ * MK_HOLE_LD, res);
        hipLaunchKernelGGL(ck_holes_final, dim3(1024), dim3(256), 0, stream, (const unsigned long long*)res, (float*)d_out, (size_t)SEQ * DM, MK_HOLE_MODE);
    }
#elif MK_DIAG
    {
        static const CkBuf B0[] = {
            {0, 0, WS_LOWER, 4096, 0}, {0, 1, WS_SSQ, 8192, 0}, {0, 2, WS_XGA, (size_t)SEQ * DM, 1}, {0, 3, WS_PB, (size_t)2 * SEQ * PLE, 1}, {0, 4, WS_WIN, (size_t)2 * NIN * DM, 1},
            {0, 5, WS_WA, (size_t)2 * DM * HW, 1}, {0, 6, WS_WB, (size_t)2 * DM * HW, 1}, {0, 7, WS_WO, (size_t)2 * DM * DM, 1}, {0, 8, WS_WG, (size_t)2 * DM * DM, 1}, {0, 9, WS_WP, (size_t)2 * DM * PLE, 1} };
        static const CkBuf BL[] = {
            {0, 10, WS_QH, (size_t)SEQ * HW, 1}, {0, 11, WS_VH, (size_t)SEQ * HW, 1}, {0, 12, WS_KF, (size_t)SEQ * HW, 1}, {0, 13, WS_KB, (size_t)SEQ * HW, 1}, {0, 14, WS_HG, (size_t)SEQ * HW, 1},
            {0, 15, WS_NQ, (size_t)SEQ * HW, 1}, {0, 16, WS_NK, (size_t)SEQ * HW, 1}, {0, 17, WS_VT, (size_t)SEQ * HW, 1}, {0, 18, WS_NG, (size_t)SEQ * HW, 1}, {0, 19, WS_GF, (size_t)SEQ * HW, 0},
            {0, 20, WS_GB, (size_t)SEQ * HW, 0}, {0, 21, WS_MA, (size_t)SEQ * DM, 1}, {0, 22, WS_MB, (size_t)SEQ * DM, 1},
            {1, 23, WS_LT, (size_t)2048 * 16384, 0}, {1, 24, WS_DD, (size_t)2048 * 128, 0}, {1, 25, WS_EE, (size_t)2048 * 128, 0}, {1, 26, WS_OB, (size_t)SEQ * HW, 1},
            {2, 27, WS_SP, (size_t)2048 * 16384, 1}, {3, 28, WS_OA, (size_t)SEQ * HW, 1}, {4, 29, WS_T, (size_t)SEQ * DM, 0}, {4, 30, WS_Y, (size_t)SEQ * DM, 1},
            {5, 31, WS_X1, (size_t)SEQ * DM, 0}, {5, 32, WS_XGB, (size_t)SEQ * DM, 1}, {6, 34, WS_PL, (size_t)SEQ * DM, 0}, {6, 35, (size_t)-1, (size_t)SEQ * DM, 0} };
        const int NS = 80;
        double* sums = (double*)((char*)d_ws + 65536);
        (void)hipMemsetAsync((char*)d_ws + MiB, 0xAA, WS_END - MiB, stream);
        for (int run = 0; run < 2; ++run) {
            (void)hipMemsetAsync((char*)d_ws + WS_CTL, 0, 32768, stream);
            for (int ph = 0; ph < NPHASE; ++ph) {
                a.ph_lo = ph; a.ph_hi = ph + 1; hipLaunchKernelGGL(mk_fwd, dim3(grid), dim3(512), LDS_BYTES, stream, a);
                if (ph == 0) { for (const CkBuf& b : B0) hipLaunchKernelGGL(ck_sum, dim3(1024), dim3(256), 0, stream, (const void*)((char*)d_ws + b.off), b.n, b.kind, sums + 2 * (run * NS + b.idx)); }
                else { const int l = (ph - 1) / 7, k = (ph - 1) % 7;
                    for (const CkBuf& b : BL) if (b.phase == k) hipLaunchKernelGGL(ck_sum, dim3(1024), dim3(256), 0, stream, b.off == (size_t)-1 ? (const void*)d_out : (const void*)((char*)d_ws + b.off), b.n, b.kind, sums + 2 * (run * NS + b.idx + 40 * l)); }
            }
        }
        hipLaunchKernelGGL(ck_final, dim3(1024), dim3(256), 0, stream, (const double*)sums, (float*)d_out, (size_t)SEQ * DM, NS);
    }
#elif MK_MULTI
    for (int ph = 0; ph < NPHASE; ++ph) { a.ph_lo = ph; a.ph_hi = ph + 1; hipLaunchKernelGGL(mk_fwd, dim3(grid), dim3(512), LDS_BYTES, stream, a); }
#else
    a.ph_lo = 0; a.ph_hi = NPHASE; hipLaunchKernelGGL(mk_fwd, dim3(grid), dim3(512), LDS_BYTES, stream, a);
#endif
}
```

```cpp
#include <hip/hip_runtime.h>
#include <cstdio>
#include <cstdint>

#ifndef MK_ALIGN
#define MK_ALIGN true
#endif
#ifndef MK_SP2
#define MK_SP2 true
#endif
#ifndef MK_TS
#define MK_TS 0
#endif
#ifndef MK_TS_A
#define MK_TS_A 0
#define MK_TS_B 1
#endif
#ifndef MK_REP_PHASE
#define MK_REP_PHASE -1
#endif
#ifndef MK_REP_DUMMY
#define MK_REP_DUMMY 0
#endif
#ifndef MK_REP_N
#define MK_REP_N 3
#endif
#ifndef MK_ENDFLUSH
#define MK_ENDFLUSH 0
#endif
#ifndef MK_MULTI
#define MK_MULTI 0
#endif

#define LAS __attribute__((address_space(3)))
typedef unsigned short bf16_t;
typedef short bf16x8 __attribute__((ext_vector_type(8)));
typedef float f32x4 __attribute__((ext_vector_type(4)));
typedef float f32x2 __attribute__((ext_vector_type(2)));
typedef unsigned u32x4 __attribute__((ext_vector_type(4)));
typedef unsigned u32x2 __attribute__((ext_vector_type(2)));

constexpr int SEQ = 8192, DM = 2048, NIN = 13312, HW = 1024, PLE = 256;
constexpr float EPS = 1e-6f;
constexpr int NPHASE = 15;

constexpr size_t MiB = 1u << 20;
constexpr size_t WS_CTL = 0, CTL_ZERO_BYTES = 1 * MiB;
constexpr size_t WS_LOWER = 1 * MiB;
constexpr size_t WS_SSQ = 1 * MiB + 64 * 1024;
constexpr size_t WS_DD = 2 * MiB;
constexpr size_t WS_EE = 3 * MiB;
constexpr size_t WS_WIN = 4 * MiB;
constexpr size_t WS_WA = 108 * MiB;
constexpr size_t WS_WB = 116 * MiB;
constexpr size_t WS_WO = 124 * MiB;
constexpr size_t WS_WG = 140 * MiB;
constexpr size_t WS_WP = 156 * MiB;
constexpr size_t WS_PB = 158 * MiB;
constexpr size_t WS_XGA = 166 * MiB;
constexpr size_t WS_XGB = 198 * MiB;
constexpr size_t WS_QH = 230 * MiB;
constexpr size_t WS_VH = 246 * MiB;
constexpr size_t WS_KF = 262 * MiB;
constexpr size_t WS_KB = 278 * MiB;
constexpr size_t WS_HG = 294 * MiB;
constexpr size_t WS_NQ = 310 * MiB;
constexpr size_t WS_NK = 326 * MiB;
constexpr size_t WS_VT = 342 * MiB;
constexpr size_t WS_NG = 358 * MiB;
constexpr size_t WS_OA = 374 * MiB;
constexpr size_t WS_OB = 390 * MiB;
constexpr size_t WS_GF = 406 * MiB;
constexpr size_t WS_GB = 438 * MiB;
constexpr size_t WS_MA = 470 * MiB;
constexpr size_t WS_MB = 502 * MiB;
constexpr size_t WS_LT = 534 * MiB;
constexpr size_t WS_SP = 662 * MiB;
constexpr size_t WS_END = 726 * MiB;
constexpr size_t WS_T = WS_LT;
constexpr size_t WS_PL = WS_LT + 64 * MiB;
constexpr size_t WS_Y = WS_SP;
constexpr size_t WS_X1 = WS_GF;

constexpr int LDS_BYTES = 147456;
constexpr int LDS_MISC_OFF = 131072;

typedef __bf16 bf16x2_t __attribute__((ext_vector_type(2)));
__device__ __forceinline__ unsigned cvt_pk_bf16(float lo, float hi) { bf16x2_t v = {(__bf16)lo, (__bf16)hi}; return __builtin_bit_cast(unsigned, v); }
__device__ __forceinline__ float bf2f(unsigned short b) { return __uint_as_float(((unsigned)b) << 16); }
__device__ __forceinline__ float bflo(unsigned w) { return __uint_as_float(w << 16); }
__device__ __forceinline__ float bfhi(unsigned w) { return __uint_as_float(w & 0xffff0000u); }
__device__ __forceinline__ unsigned short f2bf1(float f) { return (unsigned short)(cvt_pk_bf16(f, 0.f) & 0xffffu); }
__device__ __forceinline__ float fast_rcp(float x) { return __builtin_amdgcn_rcpf(x); }
__device__ __forceinline__ float sigmoid_f(float x) { return fast_rcp(1.f + __expf(-x)); }
__device__ __forceinline__ float silu_f(float x) { return x * sigmoid_f(x); }

__device__ __forceinline__ int opaque_tid(int wid_s) { asm volatile("" : "+s"(wid_s)); int t = wid_s * 64 + (int)__builtin_amdgcn_mbcnt_hi(~0u, __builtin_amdgcn_mbcnt_lo(~0u, 0u)); asm volatile("" : "+v"(t)); return t; }
__device__ __forceinline__ unsigned char* opaque_ptr(unsigned char* p) { asm volatile("" : "+s"(p)); return p; }
__device__ __forceinline__ int opaque_bid() { int b = blockIdx.x; asm volatile("" : "+s"(b)); return b; }
namespace pg8 {
#define PG8_LAS __attribute__((address_space(3)))
constexpr int BM = 256, BK = 64, HALF = 128, HTB = HALF * BK * 2, STAGE_BYTES = 8 * HTB, NXCD = 8, WGM = 8;
__host__ __device__ __forceinline__ int lds_byte(int r, int c) { const int st = (r >> 4) * 2 + (c >> 5), rr = r & 15, cc = c & 31, ob = rr * 64 + cc * 2; return st * 1024 + (ob ^ (((ob >> 9) & 1) << 5)); }
__host__ __device__ __forceinline__ void stage_rc(int b, int& R, int& C) { const int st = b / 1024, sb = b % 1024, swz = sb ^ (((sb >> 9) & 1) << 5); R = (st >> 1) * 16 + swz / 64; C = (st & 1) * 32 + (swz % 64) / 2; }
__host__ __device__ __forceinline__ int perm32(int rho) { const int n = rho >> 4, i = rho & 15; return 8 * (i >> 2) + 4 * n + (i & 3); }

struct Unit { int pm, pn; };
struct Gemm { const bf16_t* A; const bf16_t* Bt; int M, N, K; };

struct StaticOrder {
    int nM, nN, nwg, G, c;
    __host__ __device__ void init(int M, int N, int G_, int c_) { nM = M / BM; nN = N / BM; nwg = nM * nN; G = G_; c = c_; }
    __host__ __device__ bool next(int i, Unit& u) const {
        const long L = (long)i * G + c; if (L >= nwg) return false;
        int wgid = (int)L; { const int q = nwg / NXCD, r = nwg % NXCD, xcd = wgid % NXCD, off = wgid / NXCD; wgid = (xcd < r ? xcd * (q + 1) : r * (q + 1) + (xcd - r) * q) + off; }
        const int nig = WGM * nN, gid = wgid / nig, fm = gid * WGM, gsz = (nM - fm) < WGM ? (nM - fm) : WGM;
        u.pm = fm + ((wgid % nig) % gsz); u.pn = (wgid % nig) / gsz; return true;
    }
    __device__ __forceinline__ void a_ready(const Unit&) const {}
    __device__ __forceinline__ void done(const Unit&) const {}
};

template <class Epi, class Sched, bool ALIGN_EPI = MK_ALIGN, bool SP2 = MK_SP2>
__device__ __forceinline__ void gemm_phase(PG8_LAS unsigned char* lds, const Gemm g, const Sched& S, const Epi& E, int wid_s) {
    const int tid = opaque_tid(wid_s), wid = __builtin_amdgcn_readfirstlane(tid >> 6), lane = tid & 63, wr = wid >> 2, wc = wid & 3, fr = lane & 15, fq = lane >> 4;
    const int K = g.K, nt = K / BK;
    unsigned voffA[2], voffB[2];
#pragma unroll
    for (int i = 0; i < 2; ++i) { int R, C; stage_rc(tid * 16 + i * 8192, R, C); const int Rb = Epi::PERM ? ((R & ~31) + perm32(R & 31)) : R;
        voffA[i] = (unsigned)(R * K + C) * 2u; voffB[i] = (unsigned)(Rb * K + C) * 2u; }
    const size_t kstep = (size_t)(BK * 2);
    const size_t hstep = (size_t)HALF * K * 2;
    const size_t tstep = 2 * hstep;
    const unsigned ldsw = (unsigned)wid * 1024u;
    const int aoff = lds_byte(wr * 64 + fr, fq * 8), boff = lds_byte(wc * 32 + fr, fq * 8);
#define PG8_SA(b, h) (((b) * 2 + (h)) * HTB)
#define PG8_SB(b, h) ((4 + (b) * 2 + (h)) * HTB)
#define PG8_STAGE(bufoff, gbase, voff) do { _Pragma("unroll") for (int _i = 0; _i < 2; ++_i) \
        __builtin_amdgcn_global_load_lds((const unsigned*)((const char*)(gbase) + (voff)[_i]), (PG8_LAS unsigned*)(lds + (bufoff) + ldsw + _i * 8192), 16, 0, 0); } while (0)
#define PG8_LDA(dst, b, h) do { _Pragma("unroll") for (int m = 0; m < 4; ++m) _Pragma("unroll") for (int k = 0; k < 2; ++k) dst[m][k] = *(const PG8_LAS bf16x8*)(lds + PG8_SA(b, h) + aoff + m * 2048 + k * 1024); } while (0)
#define PG8_LDB(dst, b, h) do { _Pragma("unroll") for (int n = 0; n < 2; ++n) _Pragma("unroll") for (int k = 0; k < 2; ++k) dst[n][k] = *(const PG8_LAS bf16x8*)(lds + PG8_SB(b, h) + boff + n * 2048 + k * 1024); } while (0)
#define PG8_MMA(ai, bj, At, Bt) do { __builtin_amdgcn_s_setprio(1); _Pragma("unroll") for (int m = 0; m < 4; ++m) _Pragma("unroll") for (int n = 0; n < 2; ++n) _Pragma("unroll") for (int k = 0; k < 2; ++k) \
        acc[ai][bj][m][n] = __builtin_amdgcn_mfma_f32_16x16x32_bf16(Bt[n][k], At[m][k], acc[ai][bj][m][n], 0, 0, 0); __builtin_amdgcn_s_setprio(0); } while (0)
#define PG8_WAIT_V(n) asm volatile("s_waitcnt vmcnt(" #n ")" ::: "memory")
#define PG8_WAIT_L(n) asm volatile("s_waitcnt lgkmcnt(" #n ")" ::: "memory")
#define PG8_BAR __builtin_amdgcn_s_barrier()
#define PG8_SCHED __builtin_amdgcn_sched_barrier(0)
    Unit cur, nxt; int ui = 0;
    if (!S.next(0, cur)) return;
    f32x4 acc[2][2][4][2];
#pragma unroll
    for (int a = 0; a < 2; ++a)
#pragma unroll
        for (int b = 0; b < 2; ++b)
#pragma unroll
            for (int m = 0; m < 4; ++m)
#pragma unroll
                for (int n = 0; n < 2; ++n) acc[a][b][m][n] = (f32x4){0.f, 0.f, 0.f, 0.f};
    bf16x8 At[4][2], B0[2][2], B1[2][2];
    const char* cA = (const char*)g.A + (size_t)cur.pm * tstep; const char* cB = (const char*)g.Bt + (size_t)cur.pn * tstep;
    S.a_ready(cur);
    if constexpr (SP2) {
        PG8_STAGE(PG8_SB(0, 0), cB, voffB); PG8_STAGE(PG8_SB(0, 1), cB + hstep, voffB); PG8_STAGE(PG8_SA(0, 0), cA, voffA); PG8_STAGE(PG8_SA(0, 1), cA + hstep, voffA);
        if (wr == 1) PG8_BAR;
        PG8_WAIT_V(2); PG8_BAR;
        PG8_STAGE(PG8_SB(1, 0), cB + kstep, voffB); PG8_STAGE(PG8_SA(1, 0), cA + kstep, voffA); PG8_STAGE(PG8_SB(1, 1), cB + hstep + kstep, voffB);
        PG8_WAIT_V(6); PG8_BAR;
    } else {
        PG8_STAGE(PG8_SB(0, 0), cB, voffB); PG8_STAGE(PG8_SA(0, 0), cA, voffA); PG8_STAGE(PG8_SB(0, 1), cB + hstep, voffB); PG8_STAGE(PG8_SA(0, 1), cA + hstep, voffA);
        if (wr == 1) PG8_BAR;
        PG8_WAIT_V(4); PG8_BAR;
        PG8_STAGE(PG8_SB(1, 0), cB + kstep, voffB); PG8_STAGE(PG8_SA(1, 0), cA + kstep, voffA); PG8_STAGE(PG8_SB(1, 1), cB + hstep + kstep, voffB);
        PG8_WAIT_V(6); PG8_BAR;
    }
    for (;;) {
        const bool has_next = S.next(ui + 1, nxt);
        const char* nA = has_next ? (const char*)g.A + (size_t)nxt.pm * tstep : cA; const char* nB = has_next ? (const char*)g.Bt + (size_t)nxt.pn * tstep : cB;
        for (int t = 0; t < nt; t += 2) {
            const bool last = (t == nt - 2);
            const char* a1 = cA + (size_t)(t + 1) * kstep;
            const char* a2 = last ? nA : cA + (size_t)(t + 2) * kstep; const char* b2 = last ? nB : cB + (size_t)(t + 2) * kstep;
            const char* a3 = a2 + kstep; const char* b3 = b2 + kstep;
            if (last && has_next) S.a_ready(nxt);
            if constexpr (SP2) {
            PG8_LDB(B0, 0, 0); PG8_LDB(B1, 0, 1); PG8_SCHED; PG8_LDA(At, 0, 0); PG8_STAGE(PG8_SA(1, 1), a1 + hstep, voffA);
            PG8_WAIT_V(8); PG8_WAIT_L(0); PG8_BAR; PG8_MMA(0, 0, At, B0); PG8_MMA(0, 1, At, B1); PG8_BAR; PG8_SCHED;
            PG8_LDA(At, 0, 1); PG8_STAGE(PG8_SB(0, 0), b2, voffB); PG8_STAGE(PG8_SB(0, 1), b2 + hstep, voffB); PG8_STAGE(PG8_SA(0, 0), a2, voffA);
            PG8_WAIT_V(8); PG8_WAIT_L(0); PG8_BAR; PG8_MMA(1, 0, At, B0); PG8_MMA(1, 1, At, B1); PG8_BAR; PG8_SCHED;
            PG8_LDB(B0, 1, 0); PG8_LDB(B1, 1, 1); PG8_SCHED; PG8_LDA(At, 1, 0); PG8_STAGE(PG8_SA(0, 1), a2 + hstep, voffA);
            PG8_WAIT_V(8); PG8_WAIT_L(0); PG8_BAR; PG8_MMA(0, 0, At, B0); PG8_MMA(0, 1, At, B1); PG8_BAR; PG8_SCHED;
            PG8_LDA(At, 1, 1); PG8_STAGE(PG8_SB(1, 0), b3, voffB); PG8_STAGE(PG8_SB(1, 1), b3 + hstep, voffB); PG8_STAGE(PG8_SA(1, 0), a3, voffA);
            PG8_WAIT_V(8); PG8_WAIT_L(0); PG8_BAR; PG8_MMA(1, 0, At, B0); PG8_MMA(1, 1, At, B1); PG8_BAR; PG8_SCHED;
            } else {
            PG8_LDB(B0, 0, 0); PG8_SCHED; PG8_LDA(At, 0, 0); PG8_STAGE(PG8_SA(1, 1), a1 + hstep, voffA);
            PG8_WAIT_L(8); PG8_BAR; PG8_WAIT_L(0); PG8_MMA(0, 0, At, B0); PG8_BAR; PG8_SCHED;
            PG8_LDB(B1, 0, 1); PG8_STAGE(PG8_SB(0, 0), b2, voffB);
            PG8_BAR; PG8_WAIT_L(0); PG8_MMA(0, 1, At, B1); PG8_BAR;
            PG8_LDA(At, 0, 1); PG8_STAGE(PG8_SA(0, 0), a2, voffA);
            PG8_BAR; PG8_WAIT_L(0); PG8_MMA(1, 0, At, B0); PG8_BAR; PG8_SCHED;
            PG8_STAGE(PG8_SB(0, 1), b2 + hstep, voffB);
            PG8_WAIT_V(6); PG8_BAR; PG8_MMA(1, 1, At, B1); PG8_BAR;
            PG8_LDB(B0, 1, 0); PG8_SCHED; PG8_LDA(At, 1, 0); PG8_STAGE(PG8_SA(0, 1), a2 + hstep, voffA);
            PG8_WAIT_L(8); PG8_BAR; PG8_WAIT_L(0); PG8_MMA(0, 0, At, B0); PG8_BAR; PG8_SCHED;
            PG8_LDB(B1, 1, 1); PG8_STAGE(PG8_SB(1, 0), b3, voffB);
            PG8_BAR; PG8_WAIT_L(0); PG8_MMA(0, 1, At, B1); PG8_BAR;
            PG8_LDA(At, 1, 1); PG8_STAGE(PG8_SA(1, 0), a3, voffA);
            PG8_BAR; PG8_WAIT_L(0); PG8_MMA(1, 0, At, B0); PG8_BAR; PG8_SCHED;
            PG8_STAGE(PG8_SB(1, 1), b3 + hstep, voffB);
            PG8_WAIT_V(6); PG8_BAR; PG8_MMA(1, 1, At, B1); PG8_BAR;
            }
        }
        if constexpr (ALIGN_EPI) { if (wr == 0) PG8_BAR; }
        E(acc, cur, wr, wc, fr, fq);
        if (!has_next) break;
#pragma unroll
        for (int a = 0; a < 2; ++a)
#pragma unroll
            for (int b = 0; b < 2; ++b)
#pragma unroll
                for (int m = 0; m < 4; ++m)
#pragma unroll
                    for (int n = 0; n < 2; ++n) acc[a][b][m][n] = (f32x4){0.f, 0.f, 0.f, 0.f};
        cur = nxt; cA = nA; cB = nB; ++ui;
        if constexpr (ALIGN_EPI) { if (wr == 1) PG8_BAR; }
    }
    PG8_WAIT_V(0);
    if constexpr (!ALIGN_EPI) { if (wr == 0) PG8_BAR; }
    PG8_BAR;
#undef PG8_SA
#undef PG8_SB
#undef PG8_STAGE
#undef PG8_LDA
#undef PG8_LDB
#undef PG8_MMA
#undef PG8_WAIT_V
#undef PG8_WAIT_L
#undef PG8_BAR
#undef PG8_SCHED
}
}

typedef f32x4 AccT[2][2][4][2];

#define GAS __attribute__((address_space(1)))
__device__ __forceinline__ void store8_bf16(bf16_t* p, const float (&v)[8]) {
    u32x4 w; w.x = cvt_pk_bf16(v[0], v[1]); w.y = cvt_pk_bf16(v[2], v[3]); w.z = cvt_pk_bf16(v[4], v[5]); w.w = cvt_pk_bf16(v[6], v[7]);
    *(GAS u32x4*)p = w;
}
__device__ __forceinline__ void cvt8_bf16(const u32x4 w, float (&v)[8]) {
    v[0] = bflo(w.x); v[1] = bfhi(w.x); v[2] = bflo(w.y); v[3] = bfhi(w.y); v[4] = bflo(w.z); v[5] = bfhi(w.z); v[6] = bflo(w.w); v[7] = bfhi(w.w);
}
__device__ __forceinline__ u32x4 ldg16(const void* p) { return *(const GAS u32x4*)p; }
__device__ __forceinline__ f32x4 ldgf4(const float* p) { return *(const GAS f32x4*)p; }
__device__ __forceinline__ float ldgf(const float* p) { return *(const GAS float*)p; }
__device__ __forceinline__ void load8_bf16(const bf16_t* p, float (&v)[8]) { cvt8_bf16(ldg16(p), v); }
__device__ __forceinline__ void store8_f32(float* p, const float (&v)[8]) {
    *(GAS f32x4*)p = (f32x4){v[0], v[1], v[2], v[3]}; *(GAS f32x4*)(p + 4) = (f32x4){v[4], v[5], v[6], v[7]};
}
__device__ __forceinline__ void load8_f32(const float* p, float (&v)[8]) {
    const f32x4 a = ldgf4(p), b = ldgf4(p + 4);
    v[0] = a[0]; v[1] = a[1]; v[2] = a[2]; v[3] = a[3]; v[4] = b[0]; v[5] = b[1]; v[6] = b[2]; v[7] = b[3];
}
__device__ __forceinline__ void acc8(const AccT& acc, int ai, int bj, int m, float (&v)[8]) {
    const f32x4 a = acc[ai][bj][m][0], b = acc[ai][bj][m][1];
    v[0] = a[0]; v[1] = a[1]; v[2] = a[2]; v[3] = a[3]; v[4] = b[0]; v[5] = b[1]; v[6] = b[2]; v[7] = b[3];
}
#define EPI_FENCE() asm volatile("" ::: "memory")
__device__ __forceinline__ void load_rs8(const float* ssq, int row0, float (&rs)[8]) {
#pragma unroll
    for (int i = 0; i < 8; ++i) rs[i] = ldgf(ssq + row0 + (i >> 2) * 128 + (i & 3) * 16);
#pragma unroll
    for (int i = 0; i < 8; ++i) rs[i] = rsqrtf(rs[i] * (1.0f / DM) + EPS);
}

template <int ACT> __device__ __forceinline__ void epi_plain(const AccT& acc, const float (&rs)[8], bf16_t* dst, int ld, int row0, int c0) {
#pragma unroll
    for (int ai = 0; ai < 2; ++ai)
#pragma unroll
        for (int m = 0; m < 4; ++m) {
            const int row = row0 + ai * 128 + m * 16; const float r = rs[ai * 4 + m];
#pragma unroll
            for (int bj = 0; bj < 2; ++bj) { float v[8]; acc8(acc, ai, bj, m, v);
#pragma unroll
                for (int e = 0; e < 8; ++e) { float z = v[e] * r; if (ACT == 1) z = silu_f(z); if (ACT == 2) z = sigmoid_f(z); v[e] = z; }
                store8_bf16(dst + (size_t)row * ld + c0 + bj * 128, v); }
        }
}
struct EpiInProj {
    static constexpr bool PERM = true;
    const float* ssq; const float* lower; unsigned char* ws;
    __device__ __forceinline__ void operator()(const AccT& acc, const pg8::Unit& u, int wr, int wc, int fr, int fq) const {
        const int colt = u.pn * 256, seg = colt >> 10;
        const int row0 = u.pm * 256 + wr * 64 + fr;
        const int cin = wc * 32 + 8 * fq;
        const int cseg = (colt & 1023) + cin;
        float rs[8]; load_rs8(ssq, row0, rs);
        if (seg == 2 || seg == 3) {
            const int dir = seg - 2;
            float* G = (float*)(ws + (dir ? WS_GB : WS_GF)); bf16_t* KK = (bf16_t*)(ws + (dir ? WS_KB : WS_KF));
#pragma unroll
            for (int bj = 0; bj < 2; ++bj) {
                const int c = cseg + bj * 128; float lb[8]; load8_f32(lower + dir * 1024 + c, lb);
#pragma unroll
                for (int ai = 0; ai < 2; ++ai)
#pragma unroll
                    for (int m = 0; m < 4; ++m) {
                        const int row = row0 + ai * 128 + m * 16; const float r = rs[ai * 4 + m];
                        float v[8], lg[8], kk[8]; acc8(acc, ai, bj, m, v);
#pragma unroll
                        for (int e = 0; e < 8; ++e) { const float z = v[e] * r; const float sg = sigmoid_f(z); const float f = lb[e] + (1.f - lb[e]) * sg;
                            lg[e] = __logf(fmaxf(f, 1e-6f)); kk[e] = (1.f - lb[e]) * fast_rcp(1.f + __expf(z)); }
                        store8_f32(G + (size_t)row * HW + c, lg); store8_bf16(KK + (size_t)row * HW + c, kk);
                    }
            }
        } else if (seg == 7) {
            bf16_t* VT = (bf16_t*)(ws + WS_VT);
#pragma unroll
            for (int ai = 0; ai < 2; ++ai)
#pragma unroll
                for (int m = 0; m < 4; ++m) {
                    const int row = row0 + ai * 128 + m * 16; const float r = rs[ai * 4 + m];
#pragma unroll
                    for (int bj = 0; bj < 2; ++bj) { float v[8]; acc8(acc, ai, bj, m, v); const int c = cseg + bj * 128;
#pragma unroll
                        for (int e = 0; e < 8; ++e) *(GAS bf16_t*)(VT + (size_t)(c + e) * SEQ + row) = f2bf1(v[e] * r); }
                }
        } else if (seg == 0) epi_plain<1>(acc, rs, (bf16_t*)(ws + WS_QH), HW, row0, cseg);
        else if (seg == 1) epi_plain<0>(acc, rs, (bf16_t*)(ws + WS_VH), HW, row0, cseg);
        else if (seg == 4) epi_plain<1>(acc, rs, (bf16_t*)(ws + WS_HG), HW, row0, cseg);
        else if (seg == 5) epi_plain<0>(acc, rs, (bf16_t*)(ws + WS_NQ), HW, row0, cseg);
        else if (seg == 6) epi_plain<0>(acc, rs, (bf16_t*)(ws + WS_NK), HW, row0, cseg);
        else if (seg == 8) epi_plain<1>(acc, rs, (bf16_t*)(ws + WS_NG), HW, row0, cseg);
        else if (seg < 11) epi_plain<2>(acc, rs, (bf16_t*)(ws + WS_MA), DM, row0, colt - 9216 + cin);
        else epi_plain<2>(acc, rs, (bf16_t*)(ws + WS_MB), DM, row0, colt - 11264 + cin);
    }
};

#define EPI_IT(it, ai, m, bj) const int ai = (it) >> 3, m = ((it) >> 1) & 3, bj = (it) & 1
struct EpiBrA {
    static constexpr bool PERM = true;
    const bf16_t* MA; float* T;
    __device__ __forceinline__ void operator()(const AccT& acc, const pg8::Unit& u, int wr, int wc, int fr, int fq) const {
        const int row0 = u.pm * 256 + wr * 64 + fr, c0 = u.pn * 256 + wc * 32 + 8 * fq;
        u32x4 g[2];
        g[0] = ldg16(MA + (size_t)row0 * DM + c0);
#pragma unroll
        for (int it = 0; it < 16; ++it) { EPI_IT(it, ai, m, bj);
            const size_t off = (size_t)(row0 + ai * 128 + m * 16) * DM + c0 + bj * 128;
            if (it + 1 < 16) { EPI_IT(it + 1, ai2, m2, bj2); g[(it + 1) & 1] = ldg16(MA + (size_t)(row0 + ai2 * 128 + m2 * 16) * DM + c0 + bj2 * 128); }
            float v[8], gg[8]; acc8(acc, ai, bj, m, v); cvt8_bf16(g[it & 1], gg);
#pragma unroll
            for (int e = 0; e < 8; ++e) v[e] *= gg[e];
            store8_f32(T + off, v); EPI_FENCE(); }
    }
};
struct EpiBrB {
    static constexpr bool PERM = true;
    const bf16_t* MB; const float* T; bf16_t* Y;
    __device__ __forceinline__ void operator()(const AccT& acc, const pg8::Unit& u, int wr, int wc, int fr, int fq) const {
        const int row0 = u.pm * 256 + wr * 64 + fr, c0 = u.pn * 256 + wc * 32 + 8 * fq;
        u32x4 g[2]; f32x4 t0[2], t1[2];
        { const size_t o = (size_t)row0 * DM + c0; g[0] = ldg16(MB + o); t0[0] = ldgf4(T + o); t1[0] = ldgf4(T + o + 4); }
#pragma unroll
        for (int it = 0; it < 16; ++it) { EPI_IT(it, ai, m, bj);
            const size_t off = (size_t)(row0 + ai * 128 + m * 16) * DM + c0 + bj * 128;
            if (it + 1 < 16) { EPI_IT(it + 1, ai2, m2, bj2); const size_t o = (size_t)(row0 + ai2 * 128 + m2 * 16) * DM + c0 + bj2 * 128; const int b = (it + 1) & 1;
                g[b] = ldg16(MB + o); t0[b] = ldgf4(T + o); t1[b] = ldgf4(T + o + 4); }
            float v[8], gg[8]; acc8(acc, ai, bj, m, v); cvt8_bf16(g[it & 1], gg); const f32x4 ta = t0[it & 1], tb = t1[it & 1];
#pragma unroll
            for (int e = 0; e < 8; ++e) v[e] = (e < 4 ? ta[e & 3] : tb[e & 3]) + v[e] * gg[e];
            store8_bf16(Y + off, v); EPI_FENCE(); }
    }
};
struct EpiWout {
    static constexpr bool PERM = true;
    const float* xin; float* X1; bf16_t* XG; const float* gnorm; float* ssq_out;
    __device__ __forceinline__ void operator()(const AccT& acc, const pg8::Unit& u, int wr, int wc, int fr, int fq) const {
        const int row0 = u.pm * 256 + wr * 64 + fr, c0 = u.pn * 256 + wc * 32 + 8 * fq;
        float gn[2][8]; load8_f32(gnorm + c0, gn[0]); load8_f32(gnorm + c0 + 128, gn[1]);
        f32x4 x0[2], x1[2];
        { const size_t o = (size_t)row0 * DM + c0; x0[0] = ldgf4(xin + o); x1[0] = ldgf4(xin + o + 4); }
        float s = 0.f;
#pragma unroll
        for (int it = 0; it < 16; ++it) { EPI_IT(it, ai, m, bj);
            const int row = row0 + ai * 128 + m * 16; const size_t off = (size_t)row * DM + c0 + bj * 128;
            if (it + 1 < 16) { EPI_IT(it + 1, ai2, m2, bj2); const size_t o = (size_t)(row0 + ai2 * 128 + m2 * 16) * DM + c0 + bj2 * 128; const int b = (it + 1) & 1;
                x0[b] = ldgf4(xin + o); x1[b] = ldgf4(xin + o + 4); }
            float v[8]; acc8(acc, ai, bj, m, v); const f32x4 xa = x0[it & 1], xb = x1[it & 1];
#pragma unroll
            for (int e = 0; e < 8; ++e) { v[e] += (e < 4 ? xa[e & 3] : xb[e & 3]); s += v[e] * v[e]; }
            store8_f32(X1 + off, v);
#pragma unroll
            for (int e = 0; e < 8; ++e) v[e] *= gn[bj][e];
            store8_bf16(XG + off, v);
            if (bj == 1) { s += __shfl_xor(s, 16); s += __shfl_xor(s, 32); if (fq == 0) atomicAdd(ssq_out + row, s); s = 0.f; }
            EPI_FENCE(); }
    }
};
struct EpiDummy {
    static constexpr bool PERM = true;
    bf16_t* D;
    __device__ __forceinline__ void operator()(const AccT& acc, const pg8::Unit& u, int wr, int wc, int fr, int fq) const {
        const int row0 = u.pm * 256 + wr * 64 + fr, c0 = (u.pn & 3) * 256 + wc * 32 + 8 * fq;
#pragma unroll
        for (int ai = 0; ai < 2; ++ai)
#pragma unroll
            for (int m = 0; m < 4; ++m) { const int row = row0 + ai * 128 + m * 16;
#pragma unroll
                for (int bj = 0; bj < 2; ++bj) { float v[8]; acc8(acc, ai, bj, m, v); store8_bf16(D + (size_t)row * HW + c0 + bj * 128, v); } }
    }
};
struct EpiPL {
    static constexpr bool PERM = true;
    float* PL;
    __device__ __forceinline__ void operator()(const AccT& acc, const pg8::Unit& u, int wr, int wc, int fr, int fq) const {
        const int row0 = u.pm * 256 + wr * 64 + fr, c0 = u.pn * 256 + wc * 32 + 8 * fq;
#pragma unroll
        for (int ai = 0; ai < 2; ++ai)
#pragma unroll
            for (int m = 0; m < 4; ++m) { const int row = row0 + ai * 128 + m * 16;
#pragma unroll
                for (int bj = 0; bj < 2; ++bj) { float v[8]; acc8(acc, ai, bj, m, v); store8_f32(PL + (size_t)row * DM + c0 + bj * 128, v); } }
    }
};
struct EpiGate {
    static constexpr bool PERM = true;
    const float* ssq1; const float* X1; const float* PL; float* xout; bf16_t* XG; const float* gnorm; float* ssq_next; int has_next;
    __device__ __forceinline__ void operator()(const AccT& acc, const pg8::Unit& u, int wr, int wc, int fr, int fq) const {
        const int row0 = u.pm * 256 + wr * 64 + fr, c0 = u.pn * 256 + wc * 32 + 8 * fq;
        float gn[2][8];
        if (has_next) { load8_f32(gnorm + c0, gn[0]); load8_f32(gnorm + c0 + 128, gn[1]); }
        else {
#pragma unroll
            for (int e = 0; e < 8; ++e) { gn[0][e] = 0.f; gn[1][e] = 0.f; } }
        f32x4 x0[2], x1[2], p0[2], p1[2]; float sq[2];
        { const size_t o = (size_t)row0 * DM + c0; x0[0] = ldgf4(X1 + o); x1[0] = ldgf4(X1 + o + 4); p0[0] = ldgf4(PL + o); p1[0] = ldgf4(PL + o + 4); sq[0] = ldgf(ssq1 + row0); }
        float s = 0.f;
#pragma unroll
        for (int it = 0; it < 16; ++it) { EPI_IT(it, ai, m, bj);
            const int row = row0 + ai * 128 + m * 16; const size_t off = (size_t)row * DM + c0 + bj * 128;
            if (it + 1 < 16) { EPI_IT(it + 1, ai2, m2, bj2); const int rown = row0 + ai2 * 128 + m2 * 16; const size_t o = (size_t)rown * DM + c0 + bj2 * 128; const int b = (it + 1) & 1;
                x0[b] = ldgf4(X1 + o); x1[b] = ldgf4(X1 + o + 4); p0[b] = ldgf4(PL + o); p1[b] = ldgf4(PL + o + 4); sq[b] = ldgf(ssq1 + rown); }
            const float r = rsqrtf(sq[it & 1] * (1.0f / DM) + EPS);
            float v[8]; acc8(acc, ai, bj, m, v); const f32x4 xa = x0[it & 1], xb = x1[it & 1], pa = p0[it & 1], pb = p1[it & 1];
#pragma unroll
            for (int e = 0; e < 8; ++e) { const float g = sigmoid_f(v[e] * r); v[e] = (e < 4 ? xa[e & 3] : xb[e & 3]) + (e < 4 ? pa[e & 3] : pb[e & 3]) * g; s += v[e] * v[e]; }
            store8_f32(xout + off, v);
            if (has_next) {
#pragma unroll
                for (int e = 0; e < 8; ++e) v[e] *= gn[bj][e];
                store8_bf16(XG + off, v);
                if (bj == 1) { s += __shfl_xor(s, 16); s += __shfl_xor(s, 32); if (fq == 0) atomicAdd(ssq_next + row, s); s = 0.f; } }
            EPI_FENCE(); }
    }
};

#define XB_TMO      128
#define XB_XCNT(j)  (256  + 64 * (j))
#define XB_XSUB(j)  (1280 + 64 * (j))
#define XB_XGEN(j)  (2304 + 64 * (j))
#define XB_TOP      3328
#define XB_TOPGEN   3392
#define XCD_BAR_WORDS 3456
#define XB_SPIN_CAP (1u << 18)
__device__ __forceinline__ unsigned xb_ld(unsigned* p)              { return __hip_atomic_load(p, __ATOMIC_RELAXED, __HIP_MEMORY_SCOPE_AGENT); }
__device__ __forceinline__ unsigned xb_add(unsigned* p, unsigned v) { return __hip_atomic_fetch_add(p, v, __ATOMIC_RELAXED, __HIP_MEMORY_SCOPE_AGENT); }
__device__ __forceinline__ unsigned xb_xcc_id() { return (unsigned)__builtin_amdgcn_s_getreg((3 << 11) | 20) & 0xFu; }
#define XB_SPIN(cond, bar) do { unsigned _sp = 0; while (cond) { __builtin_amdgcn_s_sleep(1); \
    if ((++_sp & 255u) == 0u) { if (xb_ld(&(bar)[XB_TMO])) break; if (_sp > XB_SPIN_CAP) { atomicAdd(&(bar)[XB_TMO], 1u); break; } } } } while (0)
struct XcdBarrier { unsigned* bar; unsigned x; volatile LAS unsigned* st; };
__device__ __forceinline__ XcdBarrier xcd_barrier_post(unsigned* bar, volatile LAS unsigned* st) {
    XcdBarrier b; b.bar = bar; b.x = xb_xcc_id(); b.st = st;
    if (threadIdx.x == 0) (void)xb_add(&bar[XB_XCNT(b.x)], 1u);
    return b;
}
__device__ __forceinline__ void xcd_barrier_complete(unsigned* bar, unsigned x, unsigned& nloc, unsigned& nx) {
    const unsigned G = gridDim.x * gridDim.y * gridDim.z;
    unsigned sum, cnt, mine, sp = 0u;
    for (;;) {
        sum = 0u; cnt = 0u; mine = 0u;
#pragma unroll
        for (unsigned j = 0; j < 16; ++j) { const unsigned c = xb_ld(&bar[XB_XCNT(j)]); sum += c; cnt += (c > 0u) ? 1u : 0u; mine = (j == x) ? c : mine; }
        if (sum == G) break;
        __builtin_amdgcn_s_sleep(1);
        if ((++sp & 255u) == 0u) { if (xb_ld(&bar[XB_TMO])) break; if (sp > XB_SPIN_CAP) { atomicAdd(&bar[XB_TMO], 1u); break; } }
    }
    nloc = mine > 0u ? mine : 1u; nx = cnt > 0u ? cnt : 1u;
}
__device__ __forceinline__ void xcd_barrier(const XcdBarrier& b) {
    asm volatile("s_waitcnt vmcnt(0)" ::: "memory");
    __syncthreads();
    if (threadIdx.x == 0) {
        unsigned* bar = b.bar;
        __builtin_amdgcn_s_waitcnt(0);
        unsigned nloc = b.st[0], nx = b.st[1];
        if (nloc == 0u) { xcd_barrier_complete(bar, b.x, nloc, nx); b.st[0] = nloc; b.st[1] = nx; }
        const unsigned old = xb_add(&bar[XB_XSUB(b.x)], 1u);
        const unsigned gen = old / nloc;
        if (old + 1u == (gen + 1u) * nloc) {
            __builtin_amdgcn_fence(__ATOMIC_RELEASE, "agent");
            asm volatile("s_waitcnt vmcnt(0)" ::: "memory");
            const unsigned og = xb_add(&bar[XB_TOP], 1u);
            const unsigned tg = og / nx;
            if (og + 1u == (tg + 1u) * nx) xb_add(&bar[XB_TOPGEN], 1u);
            else XB_SPIN(xb_ld(&bar[XB_TOPGEN]) == tg, bar);
            __builtin_amdgcn_fence(__ATOMIC_ACQUIRE, "agent");
            xb_add(&bar[XB_XGEN(b.x)], 1u);
            asm volatile("s_waitcnt vmcnt(0)" ::: "memory");
        } else {
            XB_SPIN(xb_ld(&bar[XB_XGEN(b.x)]) == gen, bar);
            __builtin_amdgcn_fence(__ATOMIC_ACQUIRE, "agent");
            asm volatile("s_waitcnt vmcnt(0)" ::: "memory");
        }
    }
    __syncthreads();
}

struct Args { const float* in[15]; float* out; unsigned char* ws; int ph_lo, ph_hi; };

__device__ __forceinline__ void transpose_convert(const float* __restrict__ W, bf16_t* __restrict__ WT, int K, int N, LAS float* tile, int rot) {
    const int tid = threadIdx.x, nb = gridDim.x; const int bid = (int)((blockIdx.x + (unsigned)rot) % (unsigned)nb);
    const int nkt = K / 64, ntile = nkt * (N / 64);
    for (int t = bid; t < ntile; t += nb) {
        const int tk = t % nkt, tn = t / nkt;
        const float* src = W + (size_t)(tk * 64) * N + tn * 64;
#pragma unroll
        for (int i = 0; i < 2; ++i) { const int idx = tid + i * 512; const int k = idx >> 4, c4 = idx & 15; const f32x4 v = *(const f32x4*)(src + (size_t)k * N + c4 * 4);
            LAS float* d = tile + k * 65 + c4 * 4; d[0] = v[0]; d[1] = v[1]; d[2] = v[2]; d[3] = v[3]; }
        __syncthreads();
        { const int n = tid >> 3, kq = tid & 7; float v[8];
#pragma unroll
          for (int j = 0; j < 8; ++j) v[j] = tile[(kq * 8 + j) * 65 + n];
          store8_bf16(WT + (size_t)(tn * 64 + n) * K + tk * 64 + kq * 8, v); }
        __syncthreads();
    }
}

__device__ __forceinline__ void p0_prologue(const Args& a, LAS unsigned char* lds) {
    unsigned char* ws = a.ws;
    const int tid = threadIdx.x, bid = blockIdx.x, nb = gridDim.x, gtid = bid * 512 + tid, gsz = nb * 512;
    {
        float* LOWER = (float*)(ws + WS_LOWER); const float* lbp = a.in[4];
        for (int i = gtid; i < 2048; i += gsz) { const float a0 = lbp[i], a1 = lbp[2048 + i]; LOWER[i] = 0.f; LOWER[2048 + i] = 1.f / (1.f + expf(a0 - a1)); }
        float* SSQ = (float*)(ws + WS_SSQ);
        for (int i = gtid; i < 3 * SEQ; i += gsz) SSQ[SEQ + i] = 0.f;
    }
    {
        const float* x = a.in[0]; const float* g0 = a.in[2]; bf16_t* XG = (bf16_t*)(ws + WS_XGA); float* SSQ = (float*)(ws + WS_SSQ);
        const int lane = tid & 63, gw = gtid >> 6, nw = gsz >> 6;
        for (int row = gw; row < SEQ; row += nw) {
            const f32x4* xr = (const f32x4*)(x + (size_t)row * DM); float s = 0.f;
#pragma unroll
            for (int j = 0; j < 8; ++j) { const f32x4 v = xr[j * 64 + lane]; const f32x4 g = ((const f32x4*)g0)[j * 64 + lane];
                s += v[0] * v[0] + v[1] * v[1] + v[2] * v[2] + v[3] * v[3];
                u32x2 w; w.x = cvt_pk_bf16(v[0] * g[0], v[1] * g[1]); w.y = cvt_pk_bf16(v[2] * g[2], v[3] * g[3]);
                *(u32x2*)(XG + (size_t)row * DM + (j * 64 + lane) * 4) = w; }
#pragma unroll
            for (int o = 32; o >= 1; o >>= 1) s += __shfl_xor(s, o);
            if (lane == 0) SSQ[row] = s;
        }
    }
    {
        const f32x4* p = (const f32x4*)a.in[1]; bf16_t* PB = (bf16_t*)(ws + WS_PB);
        for (int i = gtid; i < 2 * SEQ * PLE / 4; i += gsz) { const f32x4 v = p[i]; u32x2 w; w.x = cvt_pk_bf16(v[0], v[1]); w.y = cvt_pk_bf16(v[2], v[3]); *(u32x2*)(PB + (size_t)i * 4) = w; }
    }
    LAS float* tile = (LAS float*)lds;
    for (int l = 0; l < 2; ++l) {
        transpose_convert(a.in[3] + (size_t)l * DM * NIN, (bf16_t*)(ws + WS_WIN) + (size_t)l * NIN * DM, DM, NIN, tile, 0);
        transpose_convert(a.in[9] + (size_t)l * HW * DM, (bf16_t*)(ws + WS_WA) + (size_t)l * DM * HW, HW, DM, tile, 0);
        transpose_convert(a.in[10] + (size_t)l * HW * DM, (bf16_t*)(ws + WS_WB) + (size_t)l * DM * HW, HW, DM, tile, 0);
        transpose_convert(a.in[11] + (size_t)l * DM * DM, (bf16_t*)(ws + WS_WO) + (size_t)l * DM * DM, DM, DM, tile, 0);
        transpose_convert(a.in[13] + (size_t)l * DM * DM, (bf16_t*)(ws + WS_WG) + (size_t)l * DM * DM, DM, DM, tile, 0);
        transpose_convert(a.in[14] + (size_t)l * PLE * DM, (bf16_t*)(ws + WS_WP) + (size_t)l * DM * PLE, PLE, DM, tile, 128);
    }
}

constexpr int HP_ROWB = 272;
constexpr int HT_ROWB = 144;

__device__ __forceinline__ void hg_cumsum(const float* __restrict__ G, int tok0, int colg, int seg, int kc, int dir, LAS float* SEGS, float (&b)[16], float& bref, float& blast) {
    float gv[16];
#pragma unroll
    for (int i = 0; i < 16; ++i) gv[i] = G[(size_t)(tok0 + 16 * seg + i) * HW + colg];
    float c = 0.f;
#pragma unroll
    for (int i = 0; i < 16; ++i) { c += gv[i]; b[i] = c; }
    const float tot = c;
    if (dir) {
#pragma unroll
        for (int i = 0; i < 16; ++i) b[i] = tot - b[i] + gv[i];
    }
    SEGS[seg * 128 + kc] = tot;
    __syncthreads();
    const float t0 = SEGS[kc], t1 = SEGS[128 + kc], t2 = SEGS[256 + kc], t3 = SEGS[384 + kc];
    float off;
    if (!dir) { off = (seg > 0 ? t0 : 0.f) + (seg > 1 ? t1 : 0.f) + (seg > 2 ? t2 : 0.f); bref = t0 + t1; }
    else      { off = (seg < 3 ? t3 : 0.f) + (seg < 2 ? t2 : 0.f) + (seg < 1 ? t1 : 0.f); bref = t2 + t3; }
    blast = (t0 + t1) + (t2 + t3);
#pragma unroll
    for (int i = 0; i < 16; ++i) b[i] += off;
}

__device__ __forceinline__ void h1_phase(const Args& a, LAS unsigned char* lds, int wid_s) {
    unsigned char* ws = opaque_ptr(a.ws);
    const int tid = opaque_tid(wid_s), lane = tid & 63, w = __builtin_amdgcn_readfirstlane(tid >> 6), fr = lane & 15, fq = lane >> 4;
    const int kc = tid & 127, seg = tid >> 7;
    LAS float* SEGS = (LAS float*)lds; LAS float* SC = (LAS float*)(lds + 2048);
    LAS unsigned char* KpT = lds + 4096; LAS unsigned char* Vt = lds + 4096 + 128 * HT_ROWB;
    const bf16_t* VH = (const bf16_t*)(ws + WS_VH);
    float* LT = (float*)(ws + WS_LT); float* DD = (float*)(ws + WS_DD); float* EE = (float*)(ws + WS_EE);
    for (int item = blockIdx.x; item < 2048; item += gridDim.x) {
        const int d = item >> 10, h = (item >> 7) & 7, cs = item & 127, n = d ? 127 - cs : cs;
        const int tok0 = 64 * n, colg = h * 128 + kc;
        const float* G = (const float*)(ws + (d ? WS_GB : WS_GF)); const bf16_t* KK = (const bf16_t*)(ws + (d ? WS_KB : WS_KF));
        float b[16], bref, blast;
        hg_cumsum(G, tok0, colg, seg, kc, d, SEGS, b, bref, blast);
        {
            unsigned kw[8], vw[8];
#pragma unroll
            for (int i = 0; i < 16; i += 2) {
                const size_t o0 = (size_t)(tok0 + 16 * seg + i) * HW + colg, o1 = o0 + HW;
                const float k0 = bf2f(KK[o0]) * __expf(fminf(bref - b[i], 80.f)), k1 = bf2f(KK[o1]) * __expf(fminf(bref - b[i + 1], 80.f));
                kw[i >> 1] = cvt_pk_bf16(k0, k1);
                vw[i >> 1] = (unsigned)VH[o0] | ((unsigned)VH[o1] << 16);
            }
            LAS u32x4* kd = (LAS u32x4*)(KpT + kc * HT_ROWB + seg * 32); kd[0] = (u32x4){kw[0], kw[1], kw[2], kw[3]}; kd[1] = (u32x4){kw[4], kw[5], kw[6], kw[7]};
            LAS u32x4* vd = (LAS u32x4*)(Vt + kc * HT_ROWB + seg * 32); vd[0] = (u32x4){vw[0], vw[1], vw[2], vw[3]}; vd[1] = (u32x4){vw[4], vw[5], vw[6], vw[7]};
            if (seg == 0) { SC[kc] = __expf(blast - bref); DD[(size_t)item * 128 + kc] = __expf(blast); EE[(size_t)item * 128 + kc] = __expf(bref); }
        }
        __syncthreads();
        {
            const int vt = w;
            bf16x8 af[2];
#pragma unroll
            for (int ks = 0; ks < 2; ++ks) af[ks] = *(const LAS bf16x8*)(Vt + (16 * vt + fr) * HT_ROWB + (32 * ks + 8 * fq) * 2);
            float* dst = LT + (size_t)item * 16384;
#pragma unroll
            for (int kt = 0; kt < 8; ++kt) {
                f32x4 acc = (f32x4){0.f, 0.f, 0.f, 0.f};
#pragma unroll
                for (int ks = 0; ks < 2; ++ks) { const bf16x8 bfr = *(const LAS bf16x8*)(KpT + (16 * kt + fr) * HT_ROWB + (32 * ks + 8 * fq) * 2);
                    acc = __builtin_amdgcn_mfma_f32_16x16x32_bf16(af[ks], bfr, acc, 0, 0, 0); }
                const float sc = SC[16 * kt + fr];
#pragma unroll
                for (int r = 0; r < 4; ++r) dst[(16 * vt + 4 * fq + r) * 128 + 16 * kt + fr] = acc[r] * sc;
            }
        }
        __syncthreads();
    }
}

__device__ __forceinline__ void h2_phase(const Args& a, int wid_s) {
    unsigned char* ws = opaque_ptr(a.ws);
    const int tid = opaque_tid(wid_s);
    const float* LT = (const float*)(ws + WS_LT); const float* DD = (const float*)(ws + WS_DD); const float* EE = (const float*)(ws + WS_EE);
    bf16_t* SP = (bf16_t*)(ws + WS_SP);
    for (int u = blockIdx.x; u < 256; u += gridDim.x) {
        const int chain = u >> 4, sub = u & 15;
        const int v = 8 * sub + (tid >> 6), k = 2 * (tid & 63);
        const size_t ibase = (size_t)chain * 128;
        float s0 = 0.f, s1 = 0.f;
        for (int cs0 = 0; cs0 < 128; cs0 += 8) {
            f32x2 lt[8], dd[8], ee[8];
#pragma unroll
            for (int j = 0; j < 8; ++j) { const size_t it = ibase + cs0 + j;
                lt[j] = *(const f32x2*)(LT + it * 16384 + v * 128 + k); dd[j] = *(const f32x2*)(DD + it * 128 + k); ee[j] = *(const f32x2*)(EE + it * 128 + k); }
#pragma unroll
            for (int j = 0; j < 8; ++j) { const size_t it = ibase + cs0 + j;
                *(unsigned*)(SP + it * 16384 + v * 128 + k) = cvt_pk_bf16(s0 * ee[j][0], s1 * ee[j][1]);
                s0 = dd[j][0] * s0 + lt[j][0]; s1 = dd[j][1] * s1 + lt[j][1]; }
        }
    }
}

__device__ __forceinline__ void h3_phase(const Args& a, int layer, LAS unsigned char* lds, int wid_s) {
    unsigned char* ws = opaque_ptr(a.ws);
    const int tid = opaque_tid(wid_s), lane = tid & 63, w = __builtin_amdgcn_readfirstlane(tid >> 6), fr = lane & 15, fq = lane >> 4;
    const int kc = tid & 127, seg = tid >> 7;
    LAS float* SEGS = (LAS float*)lds; LAS float* SSQP = (LAS float*)(lds + 2048);
    LAS unsigned char* Qp = lds + 4096; LAS unsigned char* Kp = Qp + 64 * HP_ROWB; LAS unsigned char* Vt = Kp + 64 * HP_ROWB; LAS unsigned char* Ab = Vt + 128 * HT_ROWB;
    const bf16_t* QH = (const bf16_t*)(ws + WS_QH); const bf16_t* VH = (const bf16_t*)(ws + WS_VH); const bf16_t* HG = (const bf16_t*)(ws + WS_HG);
    const bf16_t* SP = (const bf16_t*)(ws + WS_SP); bf16_t* OA = (bf16_t*)(ws + WS_OA);
    const float* onorm = a.in[5] + layer * 128;
    for (int item = blockIdx.x; item < 1024; item += gridDim.x) {
        const int n = item >> 3, h = item & 7;
        const int tok0 = 64 * n, colg = h * 128 + kc;
        f32x4 o[4];
#pragma unroll
        for (int j = 0; j < 4; ++j) o[j] = (f32x4){0.f, 0.f, 0.f, 0.f};
        for (int d = 0; d < 2; ++d) {
            const int cs = d ? 127 - n : n; const size_t sitem = (size_t)((d * 8 + h) * 128 + cs);
            const float* G = (const float*)(ws + (d ? WS_GB : WS_GF)); const bf16_t* KK = (const bf16_t*)(ws + (d ? WS_KB : WS_KF));
            float b[16], bref, blast;
            hg_cumsum(G, tok0, colg, seg, kc, d, SEGS, b, bref, blast);
            {
                unsigned vw[8];
#pragma unroll
                for (int i = 0; i < 16; i += 2) {
                    const size_t o0 = (size_t)(tok0 + 16 * seg + i) * HW + colg, o1 = o0 + HW;
                    const float e0 = fminf(b[i] - bref, 80.f), e1 = fminf(b[i + 1] - bref, 80.f);
                    const float q0 = bf2f(QH[o0]) * __expf(e0), q1 = bf2f(QH[o1]) * __expf(e1);
                    const float k0 = bf2f(KK[o0]) * __expf(fminf(-(b[i] - bref), 80.f)), k1 = bf2f(KK[o1]) * __expf(fminf(-(b[i + 1] - bref), 80.f));
                    *(LAS unsigned short*)(Qp + (16 * seg + i) * HP_ROWB + kc * 2) = f2bf1(q0);
                    *(LAS unsigned short*)(Qp + (16 * seg + i + 1) * HP_ROWB + kc * 2) = f2bf1(q1);
                    *(LAS unsigned short*)(Kp + (16 * seg + i) * HP_ROWB + kc * 2) = f2bf1(k0);
                    *(LAS unsigned short*)(Kp + (16 * seg + i + 1) * HP_ROWB + kc * 2) = f2bf1(k1);
                    vw[i >> 1] = (unsigned)VH[o0] | ((unsigned)VH[o1] << 16);
                }
                LAS u32x4* vd = (LAS u32x4*)(Vt + kc * HT_ROWB + seg * 32); vd[0] = (u32x4){vw[0], vw[1], vw[2], vw[3]}; vd[1] = (u32x4){vw[4], vw[5], vw[6], vw[7]};
            }
            __syncthreads();
            {
                const int rt = w >> 1;
#pragma unroll
                for (int tt = 0; tt < 2; ++tt) {
                    const int st = 2 * (w & 1) + tt;
                    const bool need = d ? (st >= rt) : (st <= rt);
                    f32x4 acc = (f32x4){0.f, 0.f, 0.f, 0.f};
                    if (need) {
#pragma unroll
                        for (int ks = 0; ks < 4; ++ks) {
                            const bf16x8 af = *(const LAS bf16x8*)(Qp + (16 * rt + fr) * HP_ROWB + (32 * ks + 8 * fq) * 2);
                            const bf16x8 bfr = *(const LAS bf16x8*)(Kp + (16 * st + fr) * HP_ROWB + (32 * ks + 8 * fq) * 2);
                            acc = __builtin_amdgcn_mfma_f32_16x16x32_bf16(af, bfr, acc, 0, 0, 0);
                        }
                    }
                    const int s_ = 16 * st + fr;
#pragma unroll
                    for (int r = 0; r < 4; ++r) { const int r_ = 16 * rt + 4 * fq + r; const bool ok = need && (d ? (s_ >= r_) : (s_ <= r_));
                        *(LAS unsigned short*)(Ab + r_ * HT_ROWB + s_ * 2) = f2bf1(ok ? acc[r] : 0.f); }
                }
            }
            __syncthreads();
            {
                const int rt = w & 3;
                bf16x8 aa[2], aq[4];
#pragma unroll
                for (int ks = 0; ks < 2; ++ks) aa[ks] = *(const LAS bf16x8*)(Ab + (16 * rt + fr) * HT_ROWB + (32 * ks + 8 * fq) * 2);
#pragma unroll
                for (int ks = 0; ks < 4; ++ks) aq[ks] = *(const LAS bf16x8*)(Qp + (16 * rt + fr) * HP_ROWB + (32 * ks + 8 * fq) * 2);
                const bf16_t* spb = SP + sitem * 16384;
#pragma unroll
                for (int j = 0; j < 4; ++j) {
                    const int vt = 4 * (w >> 2) + j;
#pragma unroll
                    for (int ks = 0; ks < 2; ++ks) { const bf16x8 bfr = *(const LAS bf16x8*)(Vt + (16 * vt + fr) * HT_ROWB + (32 * ks + 8 * fq) * 2);
                        o[j] = __builtin_amdgcn_mfma_f32_16x16x32_bf16(aa[ks], bfr, o[j], 0, 0, 0); }
#pragma unroll
                    for (int ks = 0; ks < 4; ++ks) { const bf16x8 bfr = *(const bf16x8*)(spb + (16 * vt + fr) * 128 + 32 * ks + 8 * fq);
                        o[j] = __builtin_amdgcn_mfma_f32_16x16x32_bf16(aq[ks], bfr, o[j], 0, 0, 0); }
                }
            }
            __syncthreads();
        }
        {
            const int rt = w & 3;
            float pr[4];
#pragma unroll
            for (int r = 0; r < 4; ++r) { float s = 0.f;
#pragma unroll
                for (int j = 0; j < 4; ++j) s += o[j][r] * o[j][r];
                s += __shfl_xor(s, 1); s += __shfl_xor(s, 2); s += __shfl_xor(s, 4); s += __shfl_xor(s, 8); pr[r] = s; }
            if (fr == 0) {
#pragma unroll
                for (int r = 0; r < 4; ++r) SSQP[(w >> 2) * 64 + 16 * rt + 4 * fq + r] = pr[r]; }
            __syncthreads();
#pragma unroll
            for (int r = 0; r < 4; ++r) {
                const int row = 16 * rt + 4 * fq + r; const float rs = rsqrtf((SSQP[row] + SSQP[64 + row]) * (1.0f / 128.f) + EPS);
#pragma unroll
                for (int j = 0; j < 4; ++j) { const int v = 16 * (4 * (w >> 2) + j) + fr; const size_t off = (size_t)(tok0 + row) * HW + h * 128 + v;
                    OA[off] = f2bf1(o[j][r] * rs * onorm[v] * bf2f(HG[off])); }
            }
            __syncthreads();
        }
    }
}

constexpr int NAT_NB = 36864, NAT_KH = 64 * 272, NAT_VH = 128 * 144;
__device__ __forceinline__ void natten_phase(const Args& a, int layer, LAS unsigned char* lds, int wid_s) {
    unsigned char* ws = opaque_ptr(a.ws);
    const int tid = opaque_tid(wid_s), lane = tid & 63, w = __builtin_amdgcn_readfirstlane(tid >> 6), fr = lane & 15, fq = lane >> 4;
    LAS float* RP = (LAS float*)(lds + 2 * NAT_NB);
    const bf16_t* NQ = (const bf16_t*)(ws + WS_NQ); const bf16_t* NK = (const bf16_t*)(ws + WS_NK); const bf16_t* VT = (const bf16_t*)(ws + WS_VT);
    const bf16_t* NG = (const bf16_t*)(ws + WS_NG); bf16_t* OB = (bf16_t*)(ws + WS_OB);
    const float* gq = a.in[6] + layer * 128; const float* gk = a.in[7] + layer * 128; const float* rpb = a.in[8] + (size_t)layer * 8 * 465;
    for (int it = blockIdx.x; it < 512; it += gridDim.x) {
        const int r = it >> 2, hp = it & 3, hw = w >> 2, h = 2 * hp + hw, j = w & 3;
        const int r_start = min(max(r - 4, 0), 120);
        const bf16_t* ksrc[4]; const bf16_t* vsrc[4]; int kdst[4], vdst[4];
#pragma unroll
        for (int i = 0; i < 4; ++i) { const int q = tid + 512 * i, hd = q >> 10;
            { const int key = (q >> 4) & 63, ch = q & 15; ksrc[i] = NK + (size_t)(64 * r_start + key) * HW + (2 * hp + hd) * 128 + ch * 8; kdst[i] = hd * NAT_KH + key * 272 + ch * 16; }
            { const int d = (q >> 3) & 127, ch = q & 7; vsrc[i] = VT + (size_t)((2 * hp + hd) * 128 + d) * SEQ + 64 * r_start + ch * 8; vdst[i] = hd * NAT_VH + d * 144 + ch * 16; } }
        u32x4 R0[4], R1[4];
#define NAT_LOAD(st, R) do { _Pragma("unroll") for (int i = 0; i < 4; ++i) R[i] = ((st) < 8) ? ldg16(ksrc[i] + (size_t)(st) * 64 * HW) : ldg16(vsrc[i] + ((st) - 8) * 64); } while (0)
#define NAT_WRITE(st, R) do { _Pragma("unroll") for (int i = 0; i < 4; ++i) *(LAS u32x4*)(lds + ((st) & 1) * NAT_NB + (((st) < 8) ? kdst[i] : vdst[i])) = R[i]; } while (0)
        NAT_LOAD(0, R0); NAT_LOAD(1, R1);
        for (int i = tid; i < 930; i += 512) RP[i] = ldgf(rpb + (size_t)(2 * hp) * 465 + i);
        const int c0k = (j == 0) ? 0 : (j == 1) ? 8 : (j == 2) ? 24 : 32;
        const int cq = 16 * j + fr, tq = 64 * r + cq;
        const int cstart = min(max(cq - 8, 0), 48);
        bf16x8 qf[4];
        {
            float qv[4][8]; float ss = 0.f;
#pragma unroll
            for (int ks = 0; ks < 4; ++ks) { load8_bf16(NQ + (size_t)tq * HW + h * 128 + 32 * ks + 8 * fq, qv[ks]);
#pragma unroll
                for (int e = 0; e < 8; ++e) ss += qv[ks][e] * qv[ks][e]; }
            ss += __shfl_xor(ss, 16); ss += __shfl_xor(ss, 32);
            const float rq = rsqrtf(ss * (1.0f / 128.f) + EPS) * 0.08838834764831845f;
#pragma unroll
            for (int ks = 0; ks < 4; ++ks) { float g1[8], g2[8]; load8_f32(gq + 32 * ks + 8 * fq, g1); load8_f32(gk + 32 * ks + 8 * fq, g2);
                u32x4 wv;
                wv.x = cvt_pk_bf16(qv[ks][0] * rq * g1[0] * g2[0], qv[ks][1] * rq * g1[1] * g2[1]); wv.y = cvt_pk_bf16(qv[ks][2] * rq * g1[2] * g2[2], qv[ks][3] * rq * g1[3] * g2[3]);
                wv.z = cvt_pk_bf16(qv[ks][4] * rq * g1[4] * g2[4], qv[ks][5] * rq * g1[5] * g2[5]); wv.w = cvt_pk_bf16(qv[ks][6] * rq * g1[6] * g2[6], qv[ks][7] * rq * g1[7] * g2[7]);
                qf[ks] = __builtin_bit_cast(bf16x8, wv); }
        }
        NAT_WRITE(0, R0);
        __syncthreads();
        float s[8][2][4];
        float mx = -3.0e38f, l = 0.f;
        f32x4 o[8];
#pragma unroll
        for (int dt = 0; dt < 8; ++dt) o[dt] = (f32x4){0.f, 0.f, 0.f, 0.f};
#pragma unroll
        for (int st = 0; st < 16; ++st) {
            if (st + 2 < 16) { if (st & 1) NAT_LOAD(st + 2, R1); else NAT_LOAD(st + 2, R0); }
            LAS unsigned char* buf = lds + (st & 1) * NAT_NB;
            if (st < 8) {
                const int aa = st, kr = r_start + aa, row_off = kr - r + 7;
#pragma unroll
                for (int kt = 0; kt < 2; ++kt) {
                    bf16x8 kf[4]; float ssk = 0.f;
#pragma unroll
                    for (int ks = 0; ks < 4; ++ks) { const u32x4 wv = *(const LAS u32x4*)(buf + hw * NAT_KH + (c0k + 16 * kt + fr) * 272 + (32 * ks + 8 * fq) * 2); kf[ks] = __builtin_bit_cast(bf16x8, wv);
                        ssk += bflo(wv.x) * bflo(wv.x) + bfhi(wv.x) * bfhi(wv.x) + bflo(wv.y) * bflo(wv.y) + bfhi(wv.y) * bfhi(wv.y)
                             + bflo(wv.z) * bflo(wv.z) + bfhi(wv.z) * bfhi(wv.z) + bflo(wv.w) * bflo(wv.w) + bfhi(wv.w) * bfhi(wv.w); }
                    ssk += __shfl_xor(ssk, 16); ssk += __shfl_xor(ssk, 32);
                    const float rk = rsqrtf(ssk * (1.0f / 128.f) + EPS);
                    f32x4 acc = (f32x4){0.f, 0.f, 0.f, 0.f};
#pragma unroll
                    for (int ks = 0; ks < 4; ++ks) acc = __builtin_amdgcn_mfma_f32_16x16x32_bf16(kf[ks], qf[ks], acc, 0, 0, 0);
#pragma unroll
                    for (int rg = 0; rg < 4; ++rg) {
                        const int ki = 4 * fq + rg; const float rki = __shfl(rk, ki);
                        const int kcl = c0k + 16 * kt + ki; const bool valid = (kcl >= cstart) && (kcl < cstart + 16);
                        const int co = min(max(kcl - cq + 15, 0), 30);
                        const float bias = RP[hw * 465 + row_off * 31 + co];
                        const float sv = valid ? (acc[rg] * rki + bias) : -1.0e30f;
                        s[aa][kt][rg] = sv; mx = fmaxf(mx, sv);
                    }
                }
                if (st == 7) {
                    mx = fmaxf(mx, __shfl_xor(mx, 16)); mx = fmaxf(mx, __shfl_xor(mx, 32));
#pragma unroll
                    for (int a2 = 0; a2 < 8; ++a2)
#pragma unroll
                        for (int kt = 0; kt < 2; ++kt)
#pragma unroll
                            for (int rg = 0; rg < 4; ++rg) { const float p = __expf(s[a2][kt][rg] - mx); s[a2][kt][rg] = p; l += p; }
                    l += __shfl_xor(l, 16); l += __shfl_xor(l, 32);
                }
            } else {
                const int aa = st - 8;
                u32x4 pw; pw.x = cvt_pk_bf16(s[aa][0][0], s[aa][0][1]); pw.y = cvt_pk_bf16(s[aa][0][2], s[aa][0][3]); pw.z = cvt_pk_bf16(s[aa][1][0], s[aa][1][1]); pw.w = cvt_pk_bf16(s[aa][1][2], s[aa][1][3]);
                const bf16x8 pb = __builtin_bit_cast(bf16x8, pw);
#pragma unroll
                for (int dt = 0; dt < 8; ++dt) {
                    const LAS unsigned char* vp = buf + hw * NAT_VH + (16 * dt + fr) * 144 + (c0k + 4 * fq) * 2;
                    const u32x2 v0 = *(const LAS u32x2*)vp, v1 = *(const LAS u32x2*)(vp + 32);
                    const u32x4 vw = (u32x4){v0.x, v0.y, v1.x, v1.y};
                    o[dt] = __builtin_amdgcn_mfma_f32_16x16x32_bf16(__builtin_bit_cast(bf16x8, vw), pb, o[dt], 0, 0, 0);
                }
            }
            if (st + 1 < 16) { if (st & 1) NAT_WRITE(st + 1, R0); else NAT_WRITE(st + 1, R1); }
            __syncthreads();
        }
        const float inv = 1.0f / l;
#pragma unroll
        for (int dt = 0; dt < 8; ++dt) {
            const size_t off = (size_t)tq * HW + h * 128 + 16 * dt + 4 * fq;
            const u32x2 gw = *(const GAS u32x2*)(NG + off);
            u32x2 ow; ow.x = cvt_pk_bf16(o[dt][0] * inv * bflo(gw.x), o[dt][1] * inv * bfhi(gw.x)); ow.y = cvt_pk_bf16(o[dt][2] * inv * bflo(gw.y), o[dt][3] * inv * bfhi(gw.y));
            *(GAS u32x2*)(OB + off) = ow;
        }
#undef NAT_LOAD
#undef NAT_WRITE
    }
}

__global__ void __launch_bounds__(512, 2) mk_fwd(Args a) {
    extern __shared__ __attribute__((aligned(16))) unsigned char lds_raw[];
    LAS unsigned char* lds = (LAS unsigned char*)lds_raw;
    volatile LAS unsigned* MISC = (volatile LAS unsigned*)(lds + LDS_MISC_OFF);
    unsigned char* ws = a.ws;
    const int wid_s = __builtin_amdgcn_readfirstlane(threadIdx.x >> 6);
    if (threadIdx.x < 64) MISC[threadIdx.x] = 0u;
    __syncthreads();
    XcdBarrier bar; bar.bar = (unsigned*)(ws + WS_CTL) + 4096; bar.x = 0; bar.st = nullptr;
    const int lo = a.ph_lo, hi = a.ph_hi;
    if (hi - lo > 1) bar = xcd_barrier_post((unsigned*)(ws + WS_CTL) + 4096, MISC + 8);
#ifndef DIAG_MASK
#define DIAG_MASK 0x1ff
#endif
#define DM_(b) ((DIAG_MASK >> (b)) & 1)
#define IN(k) (lo <= (k) && (k) < hi)
#if MK_TS
    unsigned long long* TS = (unsigned long long*)(ws + 131072);
#define STAMP(k) do { if (blockIdx.x == 0 && threadIdx.x == 0) TS[k] = __builtin_amdgcn_s_memrealtime(); } while (0)
#define SEAM(k) do { if (IN(k) && (IN((k) + 1) || (k) == NPHASE - 1)) xcd_barrier(bar); STAMP((k) + 1); } while (0)
    STAMP(0);
#else
#define SEAM(k) do { if (IN(k) && IN((k) + 1)) xcd_barrier(bar); } while (0)
#endif
    const int G = gridDim.x, c = blockIdx.x;

    if (DM_(0) && IN(0)) { for (int rep = 0; rep < (MK_REP_PHASE == 0 ? MK_REP_N : 1); ++rep) { if (rep) xcd_barrier(bar); p0_prologue(a, lds); } }
    SEAM(0);
    for (int l = 0; l < 2; ++l) {
        const int pb = 1 + 7 * l;
        for (int rep = 0; rep < (MK_REP_PHASE == pb + 0 ? MK_REP_N : 1); ++rep) { if (rep) xcd_barrier(bar);
        if (DM_(1) && IN(pb + 0)) {
            unsigned char* ws = opaque_ptr(a.ws); bf16_t* XGA = (bf16_t*)(ws + WS_XGA); float* SSQ = (float*)(ws + WS_SSQ);
            pg8::Gemm g{XGA, (const bf16_t*)(ws + WS_WIN) + (size_t)l * NIN * DM, SEQ, NIN, DM}; pg8::StaticOrder S; S.init(SEQ, NIN, G, c);
            EpiInProj E{SSQ + (2 * l) * SEQ, (const float*)(ws + WS_LOWER) + l * 2048, ws};
            if (MK_REP_DUMMY && rep) { EpiDummy ED{(bf16_t*)(ws + WS_LT)}; pg8::gemm_phase<EpiDummy, pg8::StaticOrder>(lds, g, S, ED, wid_s); } else
            pg8::gemm_phase<EpiInProj, pg8::StaticOrder>(lds, g, S, E, wid_s);
        } }
        SEAM(pb + 0);
        if (IN(pb + 1)) { for (int rep = 0; rep < (MK_REP_PHASE == pb + 1 ? MK_REP_N : 1); ++rep) { if (rep) xcd_barrier(bar); if (DM_(2)) h1_phase(a, lds, wid_s); }
            for (int rep = 0; rep < (MK_REP_PHASE == pb + 101 ? MK_REP_N : 1); ++rep) { if (rep) xcd_barrier(bar); if (DM_(8)) natten_phase(a, l, lds, wid_s); } }
        SEAM(pb + 1);
        if (DM_(3) && IN(pb + 2)) { for (int rep = 0; rep < (MK_REP_PHASE == pb + 2 ? MK_REP_N : 1); ++rep) { if (rep) xcd_barrier(bar); h2_phase(a, wid_s); } }
        SEAM(pb + 2);
        if (DM_(4) && IN(pb + 3)) { for (int rep = 0; rep < (MK_REP_PHASE == pb + 3 ? MK_REP_N : 1); ++rep) { if (rep) xcd_barrier(bar); h3_phase(a, l, lds, wid_s); } }
        SEAM(pb + 3);
        for (int rep = 0; rep < (MK_REP_PHASE == pb + 4 ? MK_REP_N : 1); ++rep) { if (rep) xcd_barrier(bar);
        if (DM_(5) && IN(pb + 4)) {
            unsigned char* ws = opaque_ptr(a.ws);
            pg8::StaticOrder S; S.init(SEQ, DM, G, c);
            { pg8::Gemm g{(const bf16_t*)(ws + WS_OA), (const bf16_t*)(ws + WS_WA) + (size_t)l * DM * HW, SEQ, DM, HW};
              EpiBrA E{(const bf16_t*)(ws + WS_MA), (float*)(ws + WS_T)};
              pg8::gemm_phase<EpiBrA, pg8::StaticOrder>(lds, g, S, E, wid_s); }
            { pg8::Gemm g{(const bf16_t*)(ws + WS_OB), (const bf16_t*)(ws + WS_WB) + (size_t)l * DM * HW, SEQ, DM, HW};
              EpiBrB E{(const bf16_t*)(ws + WS_MB), (const float*)(ws + WS_T), (bf16_t*)(ws + WS_Y)};
              pg8::gemm_phase<EpiBrB, pg8::StaticOrder>(lds, g, S, E, wid_s); }
        } }
        SEAM(pb + 4);
        for (int rep = 0; rep < (MK_REP_PHASE == pb + 5 ? MK_REP_N : 1); ++rep) { if (rep) xcd_barrier(bar);
        if (DM_(6) && IN(pb + 5)) {
            unsigned char* ws = opaque_ptr(a.ws); bf16_t* XGB = (bf16_t*)(ws + WS_XGB); float* SSQ = (float*)(ws + WS_SSQ);
            pg8::Gemm g{(const bf16_t*)(ws + WS_Y), (const bf16_t*)(ws + WS_WO) + (size_t)l * DM * DM, SEQ, DM, DM}; pg8::StaticOrder S; S.init(SEQ, DM, G, c);
            EpiWout E{l == 0 ? a.in[0] : (const float*)a.out, (float*)(ws + WS_X1), XGB, a.in[12] + l * DM, rep ? (float*)(ws + 262144) : SSQ + (2 * l + 1) * SEQ};
            if (MK_REP_DUMMY && rep) { EpiDummy ED{(bf16_t*)(ws + WS_LT)}; pg8::gemm_phase<EpiDummy, pg8::StaticOrder>(lds, g, S, ED, wid_s); } else
            pg8::gemm_phase<EpiWout, pg8::StaticOrder>(lds, g, S, E, wid_s);
        } }
        SEAM(pb + 5);
        for (int rep = 0; rep < (MK_REP_PHASE == pb + 6 ? MK_REP_N : 1); ++rep) { if (rep) xcd_barrier(bar);
        if (DM_(7) && IN(pb + 6)) {
            unsigned char* ws = opaque_ptr(a.ws); bf16_t* XGA = (bf16_t*)(ws + WS_XGA); bf16_t* XGB = (bf16_t*)(ws + WS_XGB); float* SSQ = (float*)(ws + WS_SSQ);
            pg8::StaticOrder S; S.init(SEQ, DM, G, c);
            { pg8::Gemm g{(const bf16_t*)(ws + WS_PB) + (size_t)l * SEQ * PLE, (const bf16_t*)(ws + WS_WP) + (size_t)l * DM * PLE, SEQ, DM, PLE};
              EpiPL E{(float*)(ws + WS_PL)};
              pg8::gemm_phase<EpiPL, pg8::StaticOrder>(lds, g, S, E, wid_s); }
            { pg8::Gemm g{XGB, (const bf16_t*)(ws + WS_WG) + (size_t)l * DM * DM, SEQ, DM, DM};
              EpiGate E{SSQ + (2 * l + 1) * SEQ, (const float*)(ws + WS_X1), (const float*)(ws + WS_PL), a.out, XGA, a.in[2] + (l + 1 < 2 ? (l + 1) * DM : 0), rep ? (float*)(ws + 262144) : SSQ + (2 * l + 2 < 4 ? 2 * l + 2 : 0) * SEQ, l == 0 ? 1 : 0};
              pg8::gemm_phase<EpiGate, pg8::StaticOrder>(lds, g, S, E, wid_s); }
        } }
        SEAM(pb + 6);
    }
#if MK_TS
    if (blockIdx.x == 0) {
        const float dA = (float)(TS[MK_TS_A + 1] - TS[MK_TS_A]) * 0.01f, dB = (float)(TS[MK_TS_B + 1] - TS[MK_TS_B]) * 0.01f;
        for (int i = threadIdx.x; i < 1000000; i += 512) a.out[i] += (i == 0) ? 10.f * dA : 0.3f * dB;
    }
#endif
#undef IN
#undef SEAM
#if MK_ENDFLUSH
    asm volatile("s_waitcnt vmcnt(0)" ::: "memory");
    __builtin_amdgcn_fence(__ATOMIC_RELEASE, "agent");
    asm volatile("s_waitcnt vmcnt(0)" ::: "memory");
#endif
}


#ifndef MK_DIAG
#define MK_DIAG 0
#define MK_HOLE_BUF WS_MB
#define MK_HOLE_LD DM
#define MK_HOLE_MODE 0
#endif
#if MK_DIAG
__global__ void ck_sum(const void* p, size_t n, int kind, double* slot) {
    double s0 = 0.0, s1 = 0.0;
    for (size_t i = (size_t)blockIdx.x * blockDim.x + threadIdx.x; i < n; i += (size_t)gridDim.x * blockDim.x) {
        float v = kind ? bf2f(((const bf16_t*)p)[i]) : ((const float*)p)[i];
        if (!(v == v)) v = 12345.0f;
        const float wgt = (float)((int)((i * 2654435761ull >> 16) & 255) - 128);
        s0 += fabsf(v); s1 += (double)v * wgt;
    }
    for (int o = 32; o >= 1; o >>= 1) { s0 += __shfl_xor(s0, o); s1 += __shfl_xor(s1, o); }
    if ((threadIdx.x & 63) == 0) { atomicAdd(slot, s0); atomicAdd(slot + 1, s1); }
}
__global__ void ck_final(const double* sums, float* out, size_t n, int nslots) {
    int first = -1;
    for (int i = 0; i < nslots; ++i) { const double a0 = sums[2 * i], a1 = sums[2 * i + 1], b0 = sums[2 * (nslots + i)], b1 = sums[2 * (nslots + i) + 1];
        const bool bad = fabs(a0 - b0) > 1e-5 * (fabs(a0) + fabs(b0)) + 1e-30 || fabs(a1 - b1) > 1e-4 * (fabs(a0) + fabs(b0)) + 1e-30;
        if (bad) { first = i; break; } }
    const float val = first < 0 ? 0.f : 100.f * (float)(first + 1);
    for (size_t i = (size_t)blockIdx.x * blockDim.x + threadIdx.x; i < n; i += (size_t)gridDim.x * blockDim.x) out[i] = val;
}
__global__ void ck_holes(const bf16_t* p, size_t n, unsigned long long* res) {
    unsigned long long cnt = 0, mn = ~0ull;
    for (size_t i = (size_t)blockIdx.x * blockDim.x + threadIdx.x; i < n; i += (size_t)gridDim.x * blockDim.x) if (p[i] == 0xFFFFu) { ++cnt; if (i < mn) mn = i; }
    if (cnt) { atomicAdd(res, cnt); atomicMin(res + 1, mn); }
}
__global__ void ck_holes_final(const unsigned long long* res, float* out, size_t n, int mode) {
    const float val = mode == 0 ? (float)((double)res[0] / 65536.0 * 100.0) : mode == 1 ? (float)((res[1] == ~0ull ? 0 : (res[1] / 2048) ) ) + 100.f : (float)((res[1] == ~0ull ? 0 : (res[1] % 2048))) + 100.f;
    for (size_t i = (size_t)blockIdx.x * blockDim.x + threadIdx.x; i < n; i += (size_t)gridDim.x * blockDim.x) out[i] = val;
}
__global__ void ck_diff(const bf16_t* p, const bf16_t* q, size_t n, unsigned long long* res) {
    unsigned long long cnt = 0, mn = ~0ull, big = 0;
    for (size_t i = (size_t)blockIdx.x * blockDim.x + threadIdx.x; i < n; i += (size_t)gridDim.x * blockDim.x) if (p[i] != q[i]) { ++cnt; if (i < mn) mn = i; const float a = bf2f(p[i]), b = bf2f(q[i]); if (fabsf(a - b) > 0.02f * (fabsf(a) + fabsf(b))) ++big; }
    if (cnt) { atomicAdd(res, cnt); atomicMin(res + 1, mn); atomicAdd(res + 2, big); }
}
__global__ void ck_diff_final(const unsigned long long* res, float* out, size_t n, int ld) {
    const unsigned long long cnt = res[0], big = res[2];
    const float c2 = 100.f * (1.f + floorf(log2f(1.f + (float)cnt)));
    const float c1 = 1.0e6f * (1.f + floorf(log2f(1.f + (float)big)));
    for (size_t i = (size_t)blockIdx.x * blockDim.x + threadIdx.x; i < n; i += (size_t)gridDim.x * blockDim.x) out[i] = (i == 0) ? c1 : c2;
}

__device__ __forceinline__ unsigned hsh(unsigned x) { x ^= x >> 16; x *= 0x7feb352du; x ^= x >> 15; x *= 0x846ca68bu; x ^= x >> 16; return x; }
__device__ __forceinline__ float bfr(float f) { return bf2f(f2bf1(f)); }
__device__ __forceinline__ void err_max(unsigned* res, float got, float expv) { float e = fabsf(got - expv) / (0.02f + 0.02f * fabsf(expv)); if (!(e == e)) e = 1e9f; atomicMax(res, __float_as_uint(e)); }
__device__ __forceinline__ float wave_sum(float s) { for (int o = 32; o >= 1; o >>= 1) s += __shfl_xor(s, o); return s; }
__global__ void chk_inproj(const float* x, const float* g0, const float* win, const float* lbp, const unsigned char* ws, unsigned* res, int nsamp) {
    const int lane = threadIdx.x & 63, wv = (blockIdx.x * blockDim.x + threadIdx.x) >> 6, nw = (gridDim.x * blockDim.x) >> 6;
    for (int s = wv; s < nsamp; s += nw) {
        const int row = hsh(2 * s + 1) % SEQ, col = hsh(2 * s + 2) % NIN;
        float ss = 0.f, dot = 0.f;
        for (int k = lane; k < DM; k += 64) { const float xv = x[(size_t)row * DM + k]; ss += xv * xv; dot += bfr(xv * g0[k]) * bfr(win[(size_t)k * NIN + col]); }
        ss = wave_sum(ss); dot = wave_sum(dot);
        const float u = dot * rsqrtf(ss / DM + EPS);
        if (lane == 0) {
            const int seg = col >> 10, c = col & 1023; const size_t o1 = (size_t)row * HW + c;
            const float sg = 1.f / (1.f + expf(-u)), si = u * sg;
            if (seg == 0) err_max(res, bf2f(((const bf16_t*)(ws + WS_QH))[o1]), si);
            else if (seg == 1) err_max(res, bf2f(((const bf16_t*)(ws + WS_VH))[o1]), u);
            else if (seg == 2 || seg == 3) { const int dir = seg - 2; const float a0 = lbp[dir * 1024 + c], a1 = lbp[2048 + dir * 1024 + c]; const float lb = 0.f * (a0 + a1);
                const float f = lb + (1.f - lb) * sg; err_max(res + 1, ((const float*)(ws + (dir ? WS_GB : WS_GF)))[o1], logf(fmaxf(f, 1e-6f)));
                err_max(res + 1, bf2f(((const bf16_t*)(ws + (dir ? WS_KB : WS_KF)))[o1]), (1.f - lb) * (1.f - sg)); }
            else if (seg == 4) err_max(res, bf2f(((const bf16_t*)(ws + WS_HG))[o1]), si);
            else if (seg == 5) err_max(res, bf2f(((const bf16_t*)(ws + WS_NQ))[o1]), u);
            else if (seg == 6) err_max(res, bf2f(((const bf16_t*)(ws + WS_NK))[o1]), u);
            else if (seg == 7) err_max(res + 2, bf2f(((const bf16_t*)(ws + WS_VT))[(size_t)c * SEQ + row]), u);
            else if (seg == 8) err_max(res, bf2f(((const bf16_t*)(ws + WS_NG))[o1]), si);
            else if (seg < 11) err_max(res + 3, bf2f(((const bf16_t*)(ws + WS_MA))[(size_t)row * DM + col - 9216]), sg);
            else err_max(res + 9, bf2f(((const bf16_t*)(ws + WS_MB))[(size_t)row * DM + col - 11264]), sg);
        }
    }
}
__global__ void chk_natten(const unsigned char* ws, const float* gq, const float* gk, const float* rpb, unsigned* res, int nsamp) {
    const int lane = threadIdx.x & 63, wv = (blockIdx.x * blockDim.x + threadIdx.x) >> 6, nw = (gridDim.x * blockDim.x) >> 6;
    const bf16_t* NQ = (const bf16_t*)(ws + WS_NQ); const bf16_t* NK = (const bf16_t*)(ws + WS_NK); const bf16_t* VT = (const bf16_t*)(ws + WS_VT); const bf16_t* NG = (const bf16_t*)(ws + WS_NG); const bf16_t* OB = (const bf16_t*)(ws + WS_OB);
    for (int s = wv; s < nsamp; s += nw) {
        const int t = hsh(3 * s + 7) % SEQ, h = hsh(3 * s + 8) % 8; const int r = t >> 6, c = t & 63;
        const int rs0 = min(max(r - 4, 0), 120), cs0 = min(max(c - 8, 0), 48);
        float q0 = bf2f(NQ[(size_t)t * HW + h * 128 + lane]), q1 = bf2f(NQ[(size_t)t * HW + h * 128 + 64 + lane]);
        const float rq = rsqrtf(wave_sum(q0 * q0 + q1 * q1) / 128.f + EPS); q0 *= rq * gq[lane]; q1 *= rq * gq[64 + lane];
        float mx = -1e30f;
        float o0 = 0.f, o1 = 0.f, l = 0.f;
        for (int pass = 0; pass < 2; ++pass) {
            for (int a = 0; a < 8; ++a) for (int j = 0; j < 16; ++j) {
                const int kr = rs0 + a, kc = cs0 + j, tk = kr * 64 + kc;
                float k0 = bf2f(NK[(size_t)tk * HW + h * 128 + lane]), k1 = bf2f(NK[(size_t)tk * HW + h * 128 + 64 + lane]);
                const float rk = rsqrtf(wave_sum(k0 * k0 + k1 * k1) / 128.f + EPS);
                const float d = wave_sum(q0 * k0 * rk * gk[lane] + q1 * k1 * rk * gk[64 + lane]) * 0.08838834764831845f + rpb[(size_t)h * 465 + (kr - r + 7) * 31 + (kc - c + 15)];
                if (pass == 0) mx = fmaxf(mx, d);
                else { const float p = expf(d - mx); l += p; o0 += p * bf2f(VT[(size_t)(h * 128 + lane) * SEQ + tk]); o1 += p * bf2f(VT[(size_t)(h * 128 + 64 + lane) * SEQ + tk]); }
            }
        }
        const size_t ob = (size_t)t * HW + h * 128;
        err_max(res, bf2f(OB[ob + lane]), o0 / l * bf2f(NG[ob + lane])); err_max(res, bf2f(OB[ob + 64 + lane]), o1 / l * bf2f(NG[ob + 64 + lane]));
    }
}
__global__ void chk_hgrn_scan(const unsigned char* ws, float* OREF, int h0) {
    __shared__ float qs[128], ks[128], fs[128], vs[128], part[4][128];
    const int tid = threadIdx.x, v = tid & 127, kq = tid >> 7; const int h = h0 + (blockIdx.x >> 1), d = blockIdx.x & 1;
    const bf16_t* QH = (const bf16_t*)(ws + WS_QH); const bf16_t* VH = (const bf16_t*)(ws + WS_VH); const bf16_t* KK = (const bf16_t*)(ws + (d ? WS_KB : WS_KF)); const float* G = (const float*)(ws + (d ? WS_GB : WS_GF));
    float S[32];
#pragma unroll
    for (int i = 0; i < 32; ++i) S[i] = 0.f;
    float* out = OREF + (size_t)blockIdx.x * SEQ * 128;
    for (int step = 0; step < SEQ; ++step) {
        const int t = d ? SEQ - 1 - step : step;
        if (tid < 128) { qs[tid] = bf2f(QH[(size_t)t * HW + h * 128 + tid]); ks[tid] = bf2f(KK[(size_t)t * HW + h * 128 + tid]); fs[tid] = expf(G[(size_t)t * HW + h * 128 + tid]); vs[tid] = bf2f(VH[(size_t)t * HW + h * 128 + tid]); }
        __syncthreads();
        float p = 0.f; const float vv = vs[v];
#pragma unroll
        for (int i = 0; i < 32; ++i) { const int k = 32 * kq + i; S[i] = fs[k] * S[i] + ks[k] * vv; p += S[i] * qs[k]; }
        part[kq][v] = p;
        __syncthreads();
        if (tid < 128) out[(size_t)t * 128 + tid] = part[0][tid] + part[1][tid] + part[2][tid] + part[3][tid];
    }
}
__global__ void chk_hgrn_out(const unsigned char* ws, const float* OREF, const float* onorm, unsigned* res, int h0, int nh) {
    const int lane = threadIdx.x & 63, wv = (blockIdx.x * blockDim.x + threadIdx.x) >> 6, nw = (gridDim.x * blockDim.x) >> 6;
    const bf16_t* HG = (const bf16_t*)(ws + WS_HG); const bf16_t* OA = (const bf16_t*)(ws + WS_OA);
    for (int s = wv; s < nh * SEQ; s += nw) {
        const int hh = s / SEQ, t = s % SEQ, h = h0 + hh;
        const float* of = OREF + ((size_t)(2 * hh) * SEQ + t) * 128; const float* ob = OREF + ((size_t)(2 * hh + 1) * SEQ + t) * 128;
        const float a0 = of[lane] + ob[lane], a1 = of[64 + lane] + ob[64 + lane];
        const float rs = rsqrtf(wave_sum(a0 * a0 + a1 * a1) / 128.f + EPS);
        const size_t o = (size_t)t * HW + h * 128;
        err_max(res, bf2f(OA[o + lane]), a0 * rs * onorm[lane] * bf2f(HG[o + lane])); err_max(res, bf2f(OA[o + 64 + lane]), a1 * rs * onorm[64 + lane] * bf2f(HG[o + 64 + lane]));
    }
}
__global__ void chk_branch(const unsigned char* ws, const float* wa, const float* wb, unsigned* res, int nsamp) {
    const int lane = threadIdx.x & 63, wv = (blockIdx.x * blockDim.x + threadIdx.x) >> 6, nw = (gridDim.x * blockDim.x) >> 6;
    const bf16_t* OA = (const bf16_t*)(ws + WS_OA); const bf16_t* OB = (const bf16_t*)(ws + WS_OB); const bf16_t* MA = (const bf16_t*)(ws + WS_MA); const bf16_t* MB = (const bf16_t*)(ws + WS_MB); const bf16_t* Y = (const bf16_t*)(ws + WS_Y);
    for (int s = wv; s < nsamp; s += nw) {
        const int row = hsh(5 * s + 1) % SEQ, col = hsh(5 * s + 2) % DM; float da = 0.f, db = 0.f;
        for (int k = lane; k < HW; k += 64) { da += bf2f(OA[(size_t)row * HW + k]) * bfr(wa[(size_t)k * DM + col]); db += bf2f(OB[(size_t)row * HW + k]) * bfr(wb[(size_t)k * DM + col]); }
        da = wave_sum(da); db = wave_sum(db);
        if (lane == 0) err_max(res, bf2f(Y[(size_t)row * DM + col]), bf2f(MA[(size_t)row * DM + col]) * da + bf2f(MB[(size_t)row * DM + col]) * db);
    }
}
__global__ void chk_wout(const unsigned char* ws, const float* xin, const float* wo, unsigned* res, int nsamp) {
    const int lane = threadIdx.x & 63, wv = (blockIdx.x * blockDim.x + threadIdx.x) >> 6, nw = (gridDim.x * blockDim.x) >> 6;
    const bf16_t* Y = (const bf16_t*)(ws + WS_Y); const float* X1 = (const float*)(ws + WS_X1);
    for (int s = wv; s < nsamp; s += nw) {
        const int row = hsh(7 * s + 1) % SEQ, col = hsh(7 * s + 2) % DM; float d = 0.f;
        for (int k = lane; k < DM; k += 64) d += bf2f(Y[(size_t)row * DM + k]) * bfr(wo[(size_t)k * DM + col]);
        d = wave_sum(d);
        if (lane == 0) err_max(res, X1[(size_t)row * DM + col], xin[(size_t)row * DM + col] + d);
    }
}
__global__ void chk_gate(const unsigned char* ws, const float* out, const float* p, const float* wp, const float* wg, const float* pn, unsigned* res, int nsamp) {
    const int lane = threadIdx.x & 63, wv = (blockIdx.x * blockDim.x + threadIdx.x) >> 6, nw = (gridDim.x * blockDim.x) >> 6;
    const float* X1 = (const float*)(ws + WS_X1);
    for (int s = wv; s < nsamp; s += nw) {
        const int row = hsh(9 * s + 1) % SEQ, col = hsh(9 * s + 2) % DM; float d = 0.f, ss = 0.f, pl = 0.f;
        for (int k = lane; k < DM; k += 64) { const float xv = X1[(size_t)row * DM + k]; ss += xv * xv; d += bfr(xv * pn[k]) * bfr(wg[(size_t)k * DM + col]); }
        for (int k = lane; k < PLE; k += 64) pl += bfr(p[(size_t)row * PLE + k]) * bfr(wp[(size_t)k * DM + col]);
        d = wave_sum(d); ss = wave_sum(ss); pl = wave_sum(pl);
        if (lane == 0) { const float g = 1.f / (1.f + expf(-d * rsqrtf(ss / DM + EPS))); err_max(res, out[(size_t)row * DM + col], X1[(size_t)row * DM + col] + pl * g); }
    }
}
__global__ void chk_final(const unsigned* res, float* out, size_t n, int nres) {
    int first = -1; for (int i = 0; i < nres; ++i) if (__uint_as_float(res[i]) > 1.0f) { first = i; break; }
    float bucket = 0.f; if (first >= 0) { const float e = __uint_as_float(res[first]); bucket = fminf(fmaxf(floorf(log10f(e)) + 1.f, 0.f), 9.f); }
    const float val = first < 0 ? 0.f : 100.f * (float)(first + 1) + 10.f * bucket;
    for (size_t i = (size_t)blockIdx.x * blockDim.x + threadIdx.x; i < n; i += (size_t)gridDim.x * blockDim.x) out[i] = val;
}

__global__ void ck_big(const bf16_t* p, size_t n, unsigned long long* res) {
    unsigned long long c0 = 0, c2 = 0, c4 = 0; float mxv = 0.f;
    for (size_t i = (size_t)blockIdx.x * blockDim.x + threadIdx.x; i < n; i += (size_t)gridDim.x * blockDim.x) { const float v = bf2f(p[i]);
        if (!(fabsf(v) <= 3.0e38f)) ++c0; else if (fabsf(v) > 1.01f || v < -0.01f) { ++c2; mxv = fmaxf(mxv, fabsf(v)); if (v < 0.f) ++c4; } }
    if (c0 | c2) { atomicAdd(res, c0); atomicAdd(res + 2, c2); atomicAdd(res + 4, c4); atomicMax((unsigned*)(res + 3), __float_as_uint(mxv)); }
}
__global__ void ck_big_final(const unsigned long long* res, float* out, size_t n, int ld) {
    const float mxv = __uint_as_float((unsigned)res[3]);
    const float c1 = 1.0e4f * (1.f + floorf(log2f(1.f + (float)res[0])));
    const float negf = res[2] ? (float)res[4] / (float)res[2] : 0.f;
    const float c2 = 1000.f * (1.f + floorf(negf * 3.99f)) + 100.f * fminf(fmaxf(floorf(log10f(fmaxf(mxv, 1e-9f))) + 2.f, 0.f), 9.f);
    for (size_t i = (size_t)blockIdx.x * blockDim.x + threadIdx.x; i < n; i += (size_t)gridDim.x * blockDim.x) out[i] = (i == 0) ? c1 : c2;
}
struct CkBuf { int phase; int idx; size_t off; size_t n; int kind; };
#endif

extern "C" void kernel_launch(void* const* d_in, const int* in_sizes, int n_in, void* d_out, int out_size, void* d_ws, size_t ws_size, hipStream_t stream) {
    static int grid = 0;
    if (grid == 0) {
        if (n_in != 15 || out_size != SEQ * DM || ws_size < WS_END) { fprintf(stderr, "kernel_launch: unexpected problem (n_in %d, out %d, ws %zu)\n", n_in, out_size, ws_size); grid = -1; return; }
        int dev = 0, cus = 0;
        if (hipGetDevice(&dev) != hipSuccess || hipDeviceGetAttribute(&cus, hipDeviceAttributeMultiprocessorCount, dev) != hipSuccess) { grid = -1; return; }
        if (hipFuncSetAttribute((const void*)mk_fwd, hipFuncAttributeMaxDynamicSharedMemorySize, LDS_BYTES) != hipSuccess) { fprintf(stderr, "kernel_launch: hipFuncSetAttribute failed\n"); grid = -1; return; }
        int per_cu = 0;
        if (hipOccupancyMaxActiveBlocksPerMultiprocessor(&per_cu, (const void*)mk_fwd, 512, LDS_BYTES) != hipSuccess || per_cu < 1) fprintf(stderr, "kernel_launch: occupancy query says %d\n", per_cu);
        (void)hipGetLastError();
        grid = cus;
    }
    if (grid < 0) return;
    (void)hipMemsetAsync((char*)d_ws + WS_CTL, 0, CTL_ZERO_BYTES, stream);
    Args a{};
    for (int i = 0; i < 15; ++i) a.in[i] = (const float*)d_in[i];
    a.out = (float*)d_out; a.ws = (unsigned char*)d_ws;
#if MK_DIAG == 5
    {
        unsigned long long* res = (unsigned long long*)((char*)d_ws + 65536);
        (void)hipMemsetAsync((char*)d_ws + 65536 + 8, 0xFF, 8, stream);
        for (int ph = 0; ph < 2; ++ph) { a.ph_lo = ph; a.ph_hi = ph + 1; hipLaunchKernelGGL(mk_fwd, dim3(grid), dim3(512), LDS_BYTES, stream, a); }
        hipLaunchKernelGGL(ck_big, dim3(1024), dim3(256), 0, stream, (const bf16_t*)((char*)d_ws + WS_MA), (size_t)SEQ * DM, res);
        hipLaunchKernelGGL(ck_big_final, dim3(1024), dim3(256), 0, stream, (const unsigned long long*)res, (float*)d_out, (size_t)SEQ * DM, DM);
    }
#elif MK_DIAG == 4
    {
        unsigned* res = (unsigned*)((char*)d_ws + 65536);
        float* OREF = (float*)((char*)d_ws + 728 * MiB);
        const unsigned char* wsc = (const unsigned char*)d_ws;
        const float* const* in = a.in;
        for (int ph = 0; ph < NPHASE; ++ph) {
            a.ph_lo = ph; a.ph_hi = ph + 1; hipLaunchKernelGGL(mk_fwd, dim3(grid), dim3(512), LDS_BYTES, stream, a);
            if (ph == 1) hipLaunchKernelGGL(chk_inproj, dim3(512), dim3(256), 0, stream, in[0], in[2], in[3], in[4], wsc, res + 0, 32768);
            if (ph == 2) hipLaunchKernelGGL(chk_natten, dim3(256), dim3(256), 0, stream, wsc, in[6], in[7], in[8], res + 4, 1024);
            if (ph == 4) { hipLaunchKernelGGL(chk_hgrn_scan, dim3(4), dim3(512), 0, stream, wsc, OREF, 2);
                           hipLaunchKernelGGL(chk_hgrn_out, dim3(512), dim3(256), 0, stream, wsc, (const float*)OREF, in[5], res + 5, 2, 2); }
            if (ph == 5) hipLaunchKernelGGL(chk_branch, dim3(512), dim3(256), 0, stream, wsc, in[9], in[10], res + 6, 8192);
            if (ph == 6) hipLaunchKernelGGL(chk_wout, dim3(512), dim3(256), 0, stream, wsc, in[0], in[11], res + 7, 8192);
            if (ph == 7) hipLaunchKernelGGL(chk_gate, dim3(512), dim3(256), 0, stream, wsc, (const float*)d_out, in[1], in[14], in[13], in[12], res + 8, 8192);
        }
        hipLaunchKernelGGL(chk_final, dim3(1024), dim3(256), 0, stream, (const unsigned*)res, (float*)d_out, (size_t)SEQ * DM, 10);
    }
#elif MK_DIAG == 3
    {
        unsigned long long* res = (unsigned long long*)((char*)d_ws + 65536);
        bf16_t* SAVE = (bf16_t*)((char*)d_ws + 728 * MiB);
        (void)hipMemsetAsync((char*)d_ws + MiB, 0xAA, WS_END - MiB, stream);
        (void)hipMemsetAsync((char*)d_ws + 65536 + 8, 0xFF, 8, stream);
        for (int ph = 0; ph < 2; ++ph) { a.ph_lo = ph; a.ph_hi = ph + 1; hipLaunchKernelGGL(mk_fwd, dim3(grid), dim3(512), LDS_BYTES, stream, a); }
        (void)hipMemcpyAsync(SAVE, (char*)d_ws + MK_HOLE_BUF, (size_t)SEQ * MK_HOLE_LD * 2, hipMemcpyDeviceToDevice, stream);
        a.ph_lo = 1; a.ph_hi = 2; hipLaunchKernelGGL(mk_fwd, dim3(grid), dim3(512), LDS_BYTES, stream, a);
        hipLaunchKernelGGL(ck_diff, dim3(1024), dim3(256), 0, stream, (const bf16_t*)((char*)d_ws + MK_HOLE_BUF), (const bf16_t*)SAVE, (size_t)SEQ * MK_HOLE_LD, res);
        hipLaunchKernelGGL(ck_diff_final, dim3(1024), dim3(256), 0, stream, (const unsigned long long*)res, (float*)d_out, (size_t)SEQ * DM, MK_HOLE_LD);
    }
#elif MK_DIAG == 2
    {
        unsigned long long* res = (unsigned long long*)((char*)d_ws + 65536);
        (void)hipMemsetAsync((char*)d_ws + MiB, 0xAA, WS_END - MiB, stream);
        (void)hipMemsetAsync((char*)d_ws + 65536 + 8, 0xFF, 8, stream);
        a.ph_lo = 0; a.ph_hi = 1; hipLaunchKernelGGL(mk_fwd, dim3(grid), dim3(512), LDS_BYTES, stream, a);
        (void)hipMemsetAsync((char*)d_ws + MK_HOLE_BUF, 0xFF, (size_t)SEQ * MK_HOLE_LD * 2, stream);
        a.ph_lo = 1; a.ph_hi = 2; hipLaunchKernelGGL(mk_fwd, dim3(grid), dim3(512), LDS_BYTES, stream, a);
        hipLaunchKernelGGL(ck_holes, dim3(1024), dim3(256), 0, stream, (const bf16_t*)((char*)d_ws + MK_HOLE_BUF), (size_t)SEQ * MK_HOLE_LD, res);
        hipLaunchKernelGGL(ck_holes_final, dim3(1024), dim3(256), 0, stream, (const unsigned long long*)res, (float*)d_out, (size_t)SEQ * DM, MK_HOLE_MODE);
    }
#elif MK_DIAG
    {
        static const CkBuf B0[] = {
            {0, 0, WS_LOWER, 4096, 0}, {0, 1, WS_SSQ, 8192, 0}, {0, 2, WS_XGA, (size_t)SEQ * DM, 1}, {0, 3, WS_PB, (size_t)2 * SEQ * PLE, 1}, {0, 4, WS_WIN, (size_t)2 * NIN * DM, 1},
            {0, 5, WS_WA, (size_t)2 * DM * HW, 1}, {0, 6, WS_WB, (size_t)2 * DM * HW, 1}, {0, 7, WS_WO, (size_t)2 * DM * DM, 1}, {0, 8, WS_WG, (size_t)2 * DM * DM, 1}, {0, 9, WS_WP, (size_t)2 * DM * PLE, 1} };
        static const CkBuf BL[] = {
            {0, 10, WS_QH, (size_t)SEQ * HW, 1}, {0, 11, WS_VH, (size_t)SEQ * HW, 1}, {0, 12, WS_KF, (size_t)SEQ * HW, 1}, {0, 13, WS_KB, (size_t)SEQ * HW, 1}, {0, 14, WS_HG, (size_t)SEQ * HW, 1},
            {0, 15, WS_NQ, (size_t)SEQ * HW, 1}, {0, 16, WS_NK, (size_t)SEQ * HW, 1}, {0, 17, WS_VT, (size_t)SEQ * HW, 1}, {0, 18, WS_NG, (size_t)SEQ * HW, 1}, {0, 19, WS_GF, (size_t)SEQ * HW, 0},
            {0, 20, WS_GB, (size_t)SEQ * HW, 0}, {0, 21, WS_MA, (size_t)SEQ * DM, 1}, {0, 22, WS_MB, (size_t)SEQ * DM, 1},
            {1, 23, WS_LT, (size_t)2048 * 16384, 0}, {1, 24, WS_DD, (size_t)2048 * 128, 0}, {1, 25, WS_EE, (size_t)2048 * 128, 0}, {1, 26, WS_OB, (size_t)SEQ * HW, 1},
            {2, 27, WS_SP, (size_t)2048 * 16384, 1}, {3, 28, WS_OA, (size_t)SEQ * HW, 1}, {4, 29, WS_T, (size_t)SEQ * DM, 0}, {4, 30, WS_Y, (size_t)SEQ * DM, 1},
            {5, 31, WS_X1, (size_t)SEQ * DM, 0}, {5, 32, WS_XGB, (size_t)SEQ * DM, 1}, {6, 34, WS_PL, (size_t)SEQ * DM, 0}, {6, 35, (size_t)-1, (size_t)SEQ * DM, 0} };
        const int NS = 80;
        double* sums = (double*)((char*)d_ws + 65536);
        (void)hipMemsetAsync((char*)d_ws + MiB, 0xAA, WS_END - MiB, stream);
        for (int run = 0; run < 2; ++run) {
            (void)hipMemsetAsync((char*)d_ws + WS_CTL, 0, 32768, stream);
            for (int ph = 0; ph < NPHASE; ++ph) {
                a.ph_lo = ph; a.ph_hi = ph + 1; hipLaunchKernelGGL(mk_fwd, dim3(grid), dim3(512), LDS_BYTES, stream, a);
                if (ph == 0) { for (const CkBuf& b : B0) hipLaunchKernelGGL(ck_sum, dim3(1024), dim3(256), 0, stream, (const void*)((char*)d_ws + b.off), b.n, b.kind, sums + 2 * (run * NS + b.idx)); }
                else { const int l = (ph - 1) / 7, k = (ph - 1) % 7;
                    for (const CkBuf& b : BL) if (b.phase == k) hipLaunchKernelGGL(ck_sum, dim3(1024), dim3(256), 0, stream, b.off == (size_t)-1 ? (const void*)d_out : (const void*)((char*)d_ws + b.off), b.n, b.kind, sums + 2 * (run * NS + b.idx + 40 * l)); }
            }
        }
        hipLaunchKernelGGL(ck_final, dim3(1024), dim3(256), 0, stream, (const double*)sums, (float*)d_out, (size_t)SEQ * DM, NS);
    }
#elif MK_MULTI
    for (int ph = 0; ph < NPHASE; ++ph) { a.ph_lo = ph; a.ph_hi = ph + 1; hipLaunchKernelGGL(mk_fwd, dim3(grid), dim3(512), LDS_BYTES, stream, a); }
#else
    a.ph_lo = 0; a.ph_hi = NPHASE; hipLaunchKernelGGL(mk_fwd, dim3(grid), dim3(512), LDS_BYTES, stream, a);
#endif
}
```

```cpp
#include <hip/hip_runtime.h>
#include <cstdio>
#include <cstdint>

#ifndef MK_ALIGN
#define MK_ALIGN true
#endif
#ifndef MK_SP2
#define MK_SP2 true
#endif
#ifndef MK_TS
#define MK_TS 0
#endif
#ifndef MK_TS_A
#define MK_TS_A 0
#define MK_TS_B 1
#endif
#ifndef MK_REP_PHASE
#define MK_REP_PHASE -1
#endif
#ifndef MK_REP_DUMMY
#define MK_REP_DUMMY 0
#endif
#ifndef MK_REP_N
#define MK_REP_N 3
#endif
#ifndef MK_ENDFLUSH
#define MK_ENDFLUSH 0
#endif
#ifndef MK_MULTI
#define MK_MULTI 0
#endif

#define LAS __attribute__((address_space(3)))
typedef unsigned short bf16_t;
typedef short bf16x8 __attribute__((ext_vector_type(8)));
typedef float f32x4 __attribute__((ext_vector_type(4)));
typedef float f32x2 __attribute__((ext_vector_type(2)));
typedef unsigned u32x4 __attribute__((ext_vector_type(4)));
typedef unsigned u32x2 __attribute__((ext_vector_type(2)));

constexpr int SEQ = 8192, DM = 2048, NIN = 13312, HW = 1024, PLE = 256;
constexpr float EPS = 1e-6f;
constexpr int NPHASE = 15;

constexpr size_t MiB = 1u << 20;
constexpr size_t WS_CTL = 0, CTL_ZERO_BYTES = 1 * MiB;
constexpr size_t WS_LOWER = 1 * MiB;
constexpr size_t WS_SSQ = 1 * MiB + 64 * 1024;
constexpr size_t WS_DD = 2 * MiB;
constexpr size_t WS_EE = 3 * MiB;
constexpr size_t WS_WIN = 4 * MiB;
constexpr size_t WS_WA = 108 * MiB;
constexpr size_t WS_WB = 116 * MiB;
constexpr size_t WS_WO = 124 * MiB;
constexpr size_t WS_WG = 140 * MiB;
constexpr size_t WS_WP = 156 * MiB;
constexpr size_t WS_PB = 158 * MiB;
constexpr size_t WS_XGA = 166 * MiB;
constexpr size_t WS_XGB = 198 * MiB;
constexpr size_t WS_QH = 230 * MiB;
constexpr size_t WS_VH = 246 * MiB;
constexpr size_t WS_KF = 262 * MiB;
constexpr size_t WS_KB = 278 * MiB;
constexpr size_t WS_HG = 294 * MiB;
constexpr size_t WS_NQ = 310 * MiB;
constexpr size_t WS_NK = 326 * MiB;
constexpr size_t WS_VT = 342 * MiB;
constexpr size_t WS_NG = 358 * MiB;
constexpr size_t WS_OA = 374 * MiB;
constexpr size_t WS_OB = 390 * MiB;
constexpr size_t WS_GF = 406 * MiB;
constexpr size_t WS_GB = 438 * MiB;
constexpr size_t WS_MA = 470 * MiB;
constexpr size_t WS_MB = 502 * MiB;
constexpr size_t WS_LT = 534 * MiB;
constexpr size_t WS_SP = 662 * MiB;
constexpr size_t WS_END = 726 * MiB;
constexpr size_t WS_T = WS_LT;
constexpr size_t WS_PL = WS_LT + 64 * MiB;
constexpr size_t WS_Y = WS_SP;
constexpr size_t WS_X1 = WS_GF;

constexpr int LDS_BYTES = 147456;
constexpr int LDS_MISC_OFF = 131072;

typedef __bf16 bf16x2_t __attribute__((ext_vector_type(2)));
__device__ __forceinline__ unsigned cvt_pk_bf16(float lo, float hi) { bf16x2_t v = {(__bf16)lo, (__bf16)hi}; return __builtin_bit_cast(unsigned, v); }
__device__ __forceinline__ float bf2f(unsigned short b) { return __uint_as_float(((unsigned)b) << 16); }
__device__ __forceinline__ float bflo(unsigned w) { return __uint_as_float(w << 16); }
__device__ __forceinline__ float bfhi(unsigned w) { return __uint_as_float(w & 0xffff0000u); }
__device__ __forceinline__ unsigned short f2bf1(float f) { return (unsigned short)(cvt_pk_bf16(f, 0.f) & 0xffffu); }
__device__ __forceinline__ float fast_rcp(float x) { return __builtin_amdgcn_rcpf(x); }
__device__ __forceinline__ float sigmoid_f(float x) { return fast_rcp(1.f + __expf(-x)); }
__device__ __forceinline__ float silu_f(float x) { return x * sigmoid_f(x); }

__device__ __forceinline__ int opaque_tid(int wid_s) { asm volatile("" : "+s"(wid_s)); int t = wid_s * 64 + (int)__builtin_amdgcn_mbcnt_hi(~0u, __builtin_amdgcn_mbcnt_lo(~0u, 0u)); asm volatile("" : "+v"(t)); return t; }
__device__ __forceinline__ unsigned char* opaque_ptr(unsigned char* p) { asm volatile("" : "+s"(p)); return p; }
__device__ __forceinline__ int opaque_bid() { int b = blockIdx.x; asm volatile("" : "+s"(b)); return b; }
namespace pg8 {
#define PG8_LAS __attribute__((address_space(3)))
constexpr int BM = 256, BK = 64, HALF = 128, HTB = HALF * BK * 2, STAGE_BYTES = 8 * HTB, NXCD = 8, WGM = 8;
__host__ __device__ __forceinline__ int lds_byte(int r, int c) { const int st = (r >> 4) * 2 + (c >> 5), rr = r & 15, cc = c & 31, ob = rr * 64 + cc * 2; return st * 1024 + (ob ^ (((ob >> 9) & 1) << 5)); }
__host__ __device__ __forceinline__ void stage_rc(int b, int& R, int& C) { const int st = b / 1024, sb = b % 1024, swz = sb ^ (((sb >> 9) & 1) << 5); R = (st >> 1) * 16 + swz / 64; C = (st & 1) * 32 + (swz % 64) / 2; }
__host__ __device__ __forceinline__ int perm32(int rho) { const int n = rho >> 4, i = rho & 15; return 8 * (i >> 2) + 4 * n + (i & 3); }

struct Unit { int pm, pn; };
struct Gemm { const bf16_t* A; const bf16_t* Bt; int M, N, K; };

struct StaticOrder {
    int nM, nN, nwg, G, c;
    __host__ __device__ void init(int M, int N, int G_, int c_) { nM = M / BM; nN = N / BM; nwg = nM * nN; G = G_; c = c_; }
    __host__ __device__ bool next(int i, Unit& u) const {
        const long L = (long)i * G + c; if (L >= nwg) return false;
        int wgid = (int)L; { const int q = nwg / NXCD, r = nwg % NXCD, xcd = wgid % NXCD, off = wgid / NXCD; wgid = (xcd < r ? xcd * (q + 1) : r * (q + 1) + (xcd - r) * q) + off; }
        const int nig = WGM * nN, gid = wgid / nig, fm = gid * WGM, gsz = (nM - fm) < WGM ? (nM - fm) : WGM;
        u.pm = fm + ((wgid % nig) % gsz); u.pn = (wgid % nig) / gsz; return true;
    }
    __device__ __forceinline__ void a_ready(const Unit&) const {}
    __device__ __forceinline__ void done(const Unit&) const {}
};

template <class Epi, class Sched, bool ALIGN_EPI = MK_ALIGN, bool SP2 = MK_SP2>
__device__ __forceinline__ void gemm_phase(PG8_LAS unsigned char* lds, const Gemm g, const Sched& S, const Epi& E, int wid_s) {
    const int tid = opaque_tid(wid_s), wid = __builtin_amdgcn_readfirstlane(tid >> 6), lane = tid & 63, wr = wid >> 2, wc = wid & 3, fr = lane & 15, fq = lane >> 4;
    const int K = g.K, nt = K / BK;
    unsigned voffA[2], voffB[2];
#pragma unroll
    for (int i = 0; i < 2; ++i) { int R, C; stage_rc(tid * 16 + i * 8192, R, C); const int Rb = Epi::PERM ? ((R & ~31) + perm32(R & 31)) : R;
        voffA[i] = (unsigned)(R * K + C) * 2u; voffB[i] = (unsigned)(Rb * K + C) * 2u; }
    const size_t kstep = (size_t)(BK * 2);
    const size_t hstep = (size_t)HALF * K * 2;
    const size_t tstep = 2 * hstep;
    const unsigned ldsw = (unsigned)wid * 1024u;
    const int aoff = lds_byte(wr * 64 + fr, fq * 8), boff = lds_byte(wc * 32 + fr, fq * 8);
#define PG8_SA(b, h) (((b) * 2 + (h)) * HTB)
#define PG8_SB(b, h) ((4 + (b) * 2 + (h)) * HTB)
#define PG8_STAGE(bufoff, gbase, voff) do { _Pragma("unroll") for (int _i = 0; _i < 2; ++_i) \
        __builtin_amdgcn_global_load_lds((const unsigned*)((const char*)(gbase) + (voff)[_i]), (PG8_LAS unsigned*)(lds + (bufoff) + ldsw + _i * 8192), 16, 0, 0); } while (0)
#define PG8_LDA(dst, b, h) do { _Pragma("unroll") for (int m = 0; m < 4; ++m) _Pragma("unroll") for (int k = 0; k < 2; ++k) dst[m][k] = *(const PG8_LAS bf16x8*)(lds + PG8_SA(b, h) + aoff + m * 2048 + k * 1024); } while (0)
#define PG8_LDB(dst, b, h) do { _Pragma("unroll") for (int n = 0; n < 2; ++n) _Pragma("unroll") for (int k = 0; k < 2; ++k) dst[n][k] = *(const PG8_LAS bf16x8*)(lds + PG8_SB(b, h) + boff + n * 2048 + k * 1024); } while (0)
#define PG8_MMA(ai, bj, At, Bt) do { __builtin_amdgcn_s_setprio(1); _Pragma("unroll") for (int m = 0; m < 4; ++m) _Pragma("unroll") for (int n = 0; n < 2; ++n) _Pragma("unroll") for (int k = 0; k < 2; ++k) \
        acc[ai][bj][m][n] = __builtin_amdgcn_mfma_f32_16x16x32_bf16(Bt[n][k], At[m][k], acc[ai][bj][m][n], 0, 0, 0); __builtin_amdgcn_s_setprio(0); } while (0)
#define PG8_WAIT_V(n) asm volatile("s_waitcnt vmcnt(" #n ")" ::: "memory")
#define PG8_WAIT_L(n) asm volatile("s_waitcnt lgkmcnt(" #n ")" ::: "memory")
#define PG8_BAR __builtin_amdgcn_s_barrier()
#define PG8_SCHED __builtin_amdgcn_sched_barrier(0)
    Unit cur, nxt; int ui = 0;
    if (!S.next(0, cur)) return;
    f32x4 acc[2][2][4][2];
#pragma unroll
    for (int a = 0; a < 2; ++a)
#pragma unroll
        for (int b = 0; b < 2; ++b)
#pragma unroll
            for (int m = 0; m < 4; ++m)
#pragma unroll
                for (int n = 0; n < 2; ++n) acc[a][b][m][n] = (f32x4){0.f, 0.f, 0.f, 0.f};
    bf16x8 At[4][2], B0[2][2], B1[2][2];
    const char* cA = (const char*)g.A + (size_t)cur.pm * tstep; const char* cB = (const char*)g.Bt + (size_t)cur.pn * tstep;
    S.a_ready(cur);
    if constexpr (SP2) {
        PG8_STAGE(PG8_SB(0, 0), cB, voffB); PG8_STAGE(PG8_SB(0, 1), cB + hstep, voffB); PG8_STAGE(PG8_SA(0, 0), cA, voffA); PG8_STAGE(PG8_SA(0, 1), cA + hstep, voffA);
        if (wr == 1) PG8_BAR;
        PG8_WAIT_V(2); PG8_BAR;
        PG8_STAGE(PG8_SB(1, 0), cB + kstep, voffB); PG8_STAGE(PG8_SA(1, 0), cA + kstep, voffA); PG8_STAGE(PG8_SB(1, 1), cB + hstep + kstep, voffB);
        PG8_WAIT_V(6); PG8_BAR;
    } else {
        PG8_STAGE(PG8_SB(0, 0), cB, voffB); PG8_STAGE(PG8_SA(0, 0), cA, voffA); PG8_STAGE(PG8_SB(0, 1), cB + hstep, voffB); PG8_STAGE(PG8_SA(0, 1), cA + hstep, voffA);
        if (wr == 1) PG8_BAR;
        PG8_WAIT_V(4); PG8_BAR;
        PG8_STAGE(PG8_SB(1, 0), cB + kstep, voffB); PG8_STAGE(PG8_SA(1, 0), cA + kstep, voffA); PG8_STAGE(PG8_SB(1, 1), cB + hstep + kstep, voffB);
        PG8_WAIT_V(6); PG8_BAR;
    }
    for (;;) {
        const bool has_next = S.next(ui + 1, nxt);
        const char* nA = has_next ? (const char*)g.A + (size_t)nxt.pm * tstep : cA; const char* nB = has_next ? (const char*)g.Bt + (size_t)nxt.pn * tstep : cB;
        for (int t = 0; t < nt; t += 2) {
            const bool last = (t == nt - 2);
            const char* a1 = cA + (size_t)(t + 1) * kstep;
            const char* a2 = last ? nA : cA + (size_t)(t + 2) * kstep; const char* b2 = last ? nB : cB + (size_t)(t + 2) * kstep;
            const char* a3 = a2 + kstep; const char* b3 = b2 + kstep;
            if (last && has_next) S.a_ready(nxt);
            if constexpr (SP2) {
            PG8_LDB(B0, 0, 0); PG8_LDB(B1, 0, 1); PG8_SCHED; PG8_LDA(At, 0, 0); PG8_STAGE(PG8_SA(1, 1), a1 + hstep, voffA);
            PG8_WAIT_V(8); PG8_WAIT_L(0); PG8_BAR; PG8_MMA(0, 0, At, B0); PG8_MMA(0, 1, At, B1); PG8_BAR; PG8_SCHED;
            PG8_LDA(At, 0, 1); PG8_STAGE(PG8_SB(0, 0), b2, voffB); PG8_STAGE(PG8_SB(0, 1), b2 + hstep, voffB); PG8_STAGE(PG8_SA(0, 0), a2, voffA);
            PG8_WAIT_V(8); PG8_WAIT_L(0); PG8_BAR; PG8_MMA(1, 0, At, B0); PG8_MMA(1, 1, At, B1); PG8_BAR; PG8_SCHED;
            PG8_LDB(B0, 1, 0); PG8_LDB(B1, 1, 1); PG8_SCHED; PG8_LDA(At, 1, 0); PG8_STAGE(PG8_SA(0, 1), a2 + hstep, voffA);
            PG8_WAIT_V(8); PG8_WAIT_L(0); PG8_BAR; PG8_MMA(0, 0, At, B0); PG8_MMA(0, 1, At, B1); PG8_BAR; PG8_SCHED;
            PG8_LDA(At, 1, 1); PG8_STAGE(PG8_SB(1, 0), b3, voffB); PG8_STAGE(PG8_SB(1, 1), b3 + hstep, voffB); PG8_STAGE(PG8_SA(1, 0), a3, voffA);
            PG8_WAIT_V(8); PG8_WAIT_L(0); PG8_BAR; PG8_MMA(1, 0, At, B0); PG8_MMA(1, 1, At, B1); PG8_BAR; PG8_SCHED;
            } else {
            PG8_LDB(B0, 0, 0); PG8_SCHED; PG8_LDA(At, 0, 0); PG8_STAGE(PG8_SA(1, 1), a1 + hstep, voffA);
            PG8_WAIT_L(8); PG8_BAR; PG8_WAIT_L(0); PG8_MMA(0, 0, At, B0); PG8_BAR; PG8_SCHED;
            PG8_LDB(B1, 0, 1); PG8_STAGE(PG8_SB(0, 0), b2, voffB);
            PG8_BAR; PG8_WAIT_L(0); PG8_MMA(0, 1, At, B1); PG8_BAR;
            PG8_LDA(At, 0, 1); PG8_STAGE(PG8_SA(0, 0), a2, voffA);
            PG8_BAR; PG8_WAIT_L(0); PG8_MMA(1, 0, At, B0); PG8_BAR; PG8_SCHED;
            PG8_STAGE(PG8_SB(0, 1), b2 + hstep, voffB);
            PG8_WAIT_V(6); PG8_BAR; PG8_MMA(1, 1, At, B1); PG8_BAR;
            PG8_LDB(B0, 1, 0); PG8_SCHED; PG8_LDA(At, 1, 0); PG8_STAGE(PG8_SA(0, 1), a2 + hstep, voffA);
            PG8_WAIT_L(8); PG8_BAR; PG8_WAIT_L(0); PG8_MMA(0, 0, At, B0); PG8_BAR; PG8_SCHED;
            PG8_LDB(B1, 1, 1); PG8_STAGE(PG8_SB(1, 0), b3, voffB);
            PG8_BAR; PG8_WAIT_L(0); PG8_MMA(0, 1, At, B1); PG8_BAR;
            PG8_LDA(At, 1, 1); PG8_STAGE(PG8_SA(1, 0), a3, voffA);
            PG8_BAR; PG8_WAIT_L(0); PG8_MMA(1, 0, At, B0); PG8_BAR; PG8_SCHED;
            PG8_STAGE(PG8_SB(1, 1), b3 + hstep, voffB);
            PG8_WAIT_V(6); PG8_BAR; PG8_MMA(1, 1, At, B1); PG8_BAR;
            }
        }
        if constexpr (ALIGN_EPI) { if (wr == 0) PG8_BAR; }
        E(acc, cur, wr, wc, fr, fq);
        if (!has_next) break;
#pragma unroll
        for (int a = 0; a < 2; ++a)
#pragma unroll
            for (int b = 0; b < 2; ++b)
#pragma unroll
                for (int m = 0; m < 4; ++m)
#pragma unroll
                    for (int n = 0; n < 2; ++n) acc[a][b][m][n] = (f32x4){0.f, 0.f, 0.f, 0.f};
        cur = nxt; cA = nA; cB = nB; ++ui;
        if constexpr (ALIGN_EPI) { if (wr == 1) PG8_BAR; }
    }
    PG8_WAIT_V(0);
    if constexpr (!ALIGN_EPI) { if (wr == 0) PG8_BAR; }
    PG8_BAR;
#undef PG8_SA
#undef PG8_SB
#undef PG8_STAGE
#undef PG8_LDA
#undef PG8_LDB
#undef PG8_MMA
#undef PG8_WAIT_V
#undef PG8_WAIT_L
#undef PG8_BAR
#undef PG8_SCHED
}
}

typedef f32x4 AccT[2][2][4][2];

#define GAS __attribute__((address_space(1)))
__device__ __forceinline__ void store8_bf16(bf16_t* p, const float (&v)[8]) {
    u32x4 w; w.x = cvt_pk_bf16(v[0], v[1]); w.y = cvt_pk_bf16(v[2], v[3]); w.z = cvt_pk_bf16(v[4], v[5]); w.w = cvt_pk_bf16(v[6], v[7]);
    *(GAS u32x4*)p = w;
}
__device__ __forceinline__ void cvt8_bf16(const u32x4 w, float (&v)[8]) {
    v[0] = bflo(w.x); v[1] = bfhi(w.x); v[2] = bflo(w.y); v[3] = bfhi(w.y); v[4] = bflo(w.z); v[5] = bfhi(w.z); v[6] = bflo(w.w); v[7] = bfhi(w.w);
}
__device__ __forceinline__ u32x4 ldg16(const void* p) { return *(const GAS u32x4*)p; }
__device__ __forceinline__ f32x4 ldgf4(const float* p) { return *(const GAS f32x4*)p; }
__device__ __forceinline__ float ldgf(const float* p) { return *(const GAS float*)p; }
__device__ __forceinline__ void load8_bf16(const bf16_t* p, float (&v)[8]) { cvt8_bf16(ldg16(p), v); }
__device__ __forceinline__ void store8_f32(float* p, const float (&v)[8]) {
    *(GAS f32x4*)p = (f32x4){v[0], v[1], v[2], v[3]}; *(GAS f32x4*)(p + 4) = (f32x4){v[4], v[5], v[6], v[7]};
}
__device__ __forceinline__ void load8_f32(const float* p, float (&v)[8]) {
    const f32x4 a = ldgf4(p), b = ldgf4(p + 4);
    v[0] = a[0]; v[1] = a[1]; v[2] = a[2]; v[3] = a[3]; v[4] = b[0]; v[5] = b[1]; v[6] = b[2]; v[7] = b[3];
}
__device__ __forceinline__ void acc8(const AccT& acc, int ai, int bj, int m, float (&v)[8]) {
    const f32x4 a = acc[ai][bj][m][0], b = acc[ai][bj][m][1];
    v[0] = a[0]; v[1] = a[1]; v[2] = a[2]; v[3] = a[3]; v[4] = b[0]; v[5] = b[1]; v[6] = b[2]; v[7] = b[3];
}
#define EPI_FENCE() asm volatile("" ::: "memory")
__device__ __forceinline__ void load_rs8(const float* ssq, int row0, float (&rs)[8]) {
#pragma unroll
    for (int i = 0; i < 8; ++i) rs[i] = ldgf(ssq + row0 + (i >> 2) * 128 + (i & 3) * 16);
#pragma unroll
    for (int i = 0; i < 8; ++i) rs[i] = rsqrtf(rs[i] * (1.0f / DM) + EPS);
}

template <int ACT> __device__ __forceinline__ void epi_plain(const AccT& acc, const float (&rs)[8], bf16_t* dst, int ld, int row0, int c0) {
#pragma unroll
    for (int ai = 0; ai < 2; ++ai)
#pragma unroll
        for (int m = 0; m < 4; ++m) {
            const int row = row0 + ai * 128 + m * 16; const float r = rs[ai * 4 + m];
#pragma unroll
            for (int bj = 0; bj < 2; ++bj) { float v[8]; acc8(acc, ai, bj, m, v);
#pragma unroll
                for (int e = 0; e < 8; ++e) { float z = v[e] * r; if (ACT == 1) z = silu_f(z); if (ACT == 2) z = sigmoid_f(z); v[e] = z; }
                store8_bf16(dst + (size_t)row * ld + c0 + bj * 128, v); }
        }
}
struct EpiInProj {
    static constexpr bool PERM = true;
    const float* ssq; const float* lower; unsigned char* ws;
    __device__ __forceinline__ void operator()(const AccT& acc, const pg8::Unit& u, int wr, int wc, int fr, int fq) const {
        const int colt = u.pn * 256, seg = colt >> 10;
        const int row0 = u.pm * 256 + wr * 64 + fr;
        const int cin = wc * 32 + 8 * fq;
        const int cseg = (colt & 1023) + cin;
        float rs[8]; load_rs8(ssq, row0, rs);
        if (seg == 2 || seg == 3) {
            const int dir = seg - 2;
            float* G = (float*)(ws + (dir ? WS_GB : WS_GF)); bf16_t* KK = (bf16_t*)(ws + (dir ? WS_KB : WS_KF));
#pragma unroll
            for (int bj = 0; bj < 2; ++bj) {
                const int c = cseg + bj * 128; float lb[8]; load8_f32(lower + dir * 1024 + c, lb);
#pragma unroll
                for (int ai = 0; ai < 2; ++ai)
#pragma unroll
                    for (int m = 0; m < 4; ++m) {
                        const int row = row0 + ai * 128 + m * 16; const float r = rs[ai * 4 + m];
                        float v[8], lg[8], kk[8]; acc8(acc, ai, bj, m, v);
#pragma unroll
                        for (int e = 0; e < 8; ++e) { const float z = v[e] * r; const float sg = sigmoid_f(z); const float f = lb[e] + (1.f - lb[e]) * sg;
                            lg[e] = __logf(fmaxf(f, 1e-6f)); kk[e] = (1.f - lb[e]) * fast_rcp(1.f + __expf(z)); }
                        store8_f32(G + (size_t)row * HW + c, lg); store8_bf16(KK + (size_t)row * HW + c, kk);
                    }
            }
        } else if (seg == 7) {
            bf16_t* VT = (bf16_t*)(ws + WS_VT);
#pragma unroll
            for (int ai = 0; ai < 2; ++ai)
#pragma unroll
                for (int m = 0; m < 4; ++m) {
                    const int row = row0 + ai * 128 + m * 16; const float r = rs[ai * 4 + m];
#pragma unroll
                    for (int bj = 0; bj < 2; ++bj) { float v[8]; acc8(acc, ai, bj, m, v); const int c = cseg + bj * 128;
#pragma unroll
                        for (int e = 0; e < 8; ++e) *(GAS bf16_t*)(VT + (size_t)(c + e) * SEQ + row) = f2bf1(v[e] * r); }
                }
        } else if (seg == 0) epi_plain<1>(acc, rs, (bf16_t*)(ws + WS_QH), HW, row0, cseg);
        else if (seg == 1) epi_plain<0>(acc, rs, (bf16_t*)(ws + WS_VH), HW, row0, cseg);
        else if (seg == 4) epi_plain<1>(acc, rs, (bf16_t*)(ws + WS_HG), HW, row0, cseg);
        else if (seg == 5) epi_plain<0>(acc, rs, (bf16_t*)(ws + WS_NQ), HW, row0, cseg);
        else if (seg == 6) epi_plain<0>(acc, rs, (bf16_t*)(ws + WS_NK), HW, row0, cseg);
        else if (seg == 8) epi_plain<1>(acc, rs, (bf16_t*)(ws + WS_NG), HW, row0, cseg);
        else if (seg < 11) epi_plain<2>(acc, rs, (bf16_t*)(ws + WS_MA), DM, row0, colt - 9216 + cin);
        else epi_plain<2>(acc, rs, (bf16_t*)(ws + WS_MB), DM, row0, colt - 11264 + cin);
    }
};

#define EPI_IT(it, ai, m, bj) const int ai = (it) >> 3, m = ((it) >> 1) & 3, bj = (it) & 1
struct EpiBrA {
    static constexpr bool PERM = true;
    const bf16_t* MA; float* T;
    __device__ __forceinline__ void operator()(const AccT& acc, const pg8::Unit& u, int wr, int wc, int fr, int fq) const {
        const int row0 = u.pm * 256 + wr * 64 + fr, c0 = u.pn * 256 + wc * 32 + 8 * fq;
        u32x4 g[2];
        g[0] = ldg16(MA + (size_t)row0 * DM + c0);
#pragma unroll
        for (int it = 0; it < 16; ++it) { EPI_IT(it, ai, m, bj);
            const size_t off = (size_t)(row0 + ai * 128 + m * 16) * DM + c0 + bj * 128;
            if (it + 1 < 16) { EPI_IT(it + 1, ai2, m2, bj2); g[(it + 1) & 1] = ldg16(MA + (size_t)(row0 + ai2 * 128 + m2 * 16) * DM + c0 + bj2 * 128); }
            float v[8], gg[8]; acc8(acc, ai, bj, m, v); cvt8_bf16(g[it & 1], gg);
#pragma unroll
            for (int e = 0; e < 8; ++e) v[e] *= gg[e];
            store8_f32(T + off, v); EPI_FENCE(); }
    }
};
struct EpiBrB {
    static constexpr bool PERM = true;
    const bf16_t* MB; const float* T; bf16_t* Y;
    __device__ __forceinline__ void operator()(const AccT& acc, const pg8::Unit& u, int wr, int wc, int fr, int fq) const {
        const int row0 = u.pm * 256 + wr * 64 + fr, c0 = u.pn * 256 + wc * 32 + 8 * fq;
        u32x4 g[2]; f32x4 t0[2], t1[2];
        { const size_t o = (size_t)row0 * DM + c0; g[0] = ldg16(MB + o); t0[0] = ldgf4(T + o); t1[0] = ldgf4(T + o + 4); }
#pragma unroll
        for (int it = 0; it < 16; ++it) { EPI_IT(it, ai, m, bj);
            const size_t off = (size_t)(row0 + ai * 128 + m * 16) * DM + c0 + bj * 128;
            if (it + 1 < 16) { EPI_IT(it + 1, ai2, m2, bj2); const size_t o = (size_t)(row0 + ai2 * 128 + m2 * 16) * DM + c0 + bj2 * 128; const int b = (it + 1) & 1;
                g[b] = ldg16(MB + o); t0[b] = ldgf4(T + o); t1[b] = ldgf4(T + o + 4); }
            float v[8], gg[8]; acc8(acc, ai, bj, m, v); cvt8_bf16(g[it & 1], gg); const f32x4 ta = t0[it & 1], tb = t1[it & 1];
#pragma unroll
            for (int e = 0; e < 8; ++e) v[e] = (e < 4 ? ta[e & 3] : tb[e & 3]) + v[e] * gg[e];
            store8_bf16(Y + off, v); EPI_FENCE(); }
    }
};
struct EpiWout {
    static constexpr bool PERM = true;
    const float* xin; float* X1; bf16_t* XG; const float* gnorm; float* ssq_out;
    __device__ __forceinline__ void operator()(const AccT& acc, const pg8::Unit& u, int wr, int wc, int fr, int fq) const {
        const int row0 = u.pm * 256 + wr * 64 + fr, c0 = u.pn * 256 + wc * 32 + 8 * fq;
        float gn[2][8]; load8_f32(gnorm + c0, gn[0]); load8_f32(gnorm + c0 + 128, gn[1]);
        f32x4 x0[2], x1[2];
        { const size_t o = (size_t)row0 * DM + c0; x0[0] = ldgf4(xin + o); x1[0] = ldgf4(xin + o + 4); }
        float s = 0.f;
#pragma unroll
        for (int it = 0; it < 16; ++it) { EPI_IT(it, ai, m, bj);
            const int row = row0 + ai * 128 + m * 16; const size_t off = (size_t)row * DM + c0 + bj * 128;
            if (it + 1 < 16) { EPI_IT(it + 1, ai2, m2, bj2); const size_t o = (size_t)(row0 + ai2 * 128 + m2 * 16) * DM + c0 + bj2 * 128; const int b = (it + 1) & 1;
                x0[b] = ldgf4(xin + o); x1[b] = ldgf4(xin + o + 4); }
            float v[8]; acc8(acc, ai, bj, m, v); const f32x4 xa = x0[it & 1], xb = x1[it & 1];
#pragma unroll
            for (int e = 0; e < 8; ++e) { v[e] += (e < 4 ? xa[e & 3] : xb[e & 3]); s += v[e] * v[e]; }
            store8_f32(X1 + off, v);
#pragma unroll
            for (int e = 0; e < 8; ++e) v[e] *= gn[bj][e];
            store8_bf16(XG + off, v);
            if (bj == 1) { s += __shfl_xor(s, 16); s += __shfl_xor(s, 32); if (fq == 0) atomicAdd(ssq_out + row, s); s = 0.f; }
            EPI_FENCE(); }
    }
};
struct EpiDummy {
    static constexpr bool PERM = true;
    bf16_t* D;
    __device__ __forceinline__ void operator()(const AccT& acc, const pg8::Unit& u, int wr, int wc, int fr, int fq) const {
        const int row0 = u.pm * 256 + wr * 64 + fr, c0 = (u.pn & 3) * 256 + wc * 32 + 8 * fq;
#pragma unroll
        for (int ai = 0; ai < 2; ++ai)
#pragma unroll
            for (int m = 0; m < 4; ++m) { const int row = row0 + ai * 128 + m * 16;
#pragma unroll
                for (int bj = 0; bj < 2; ++bj) { float v[8]; acc8(acc, ai, bj, m, v); store8_bf16(D + (size_t)row * HW + c0 + bj * 128, v); } }
    }
};
struct EpiPL {
    static constexpr bool PERM = true;
    float* PL;
    __device__ __forceinline__ void operator()(const AccT& acc, const pg8::Unit& u, int wr, int wc, int fr, int fq) const {
        const int row0 = u.pm * 256 + wr * 64 + fr, c0 = u.pn * 256 + wc * 32 + 8 * fq;
#pragma unroll
        for (int ai = 0; ai < 2; ++ai)
#pragma unroll
            for (int m = 0; m < 4; ++m) { const int row = row0 + ai * 128 + m * 16;
#pragma unroll
                for (int bj = 0; bj < 2; ++bj) { float v[8]; acc8(acc, ai, bj, m, v); store8_f32(PL + (size_t)row * DM + c0 + bj * 128, v); } }
    }
};
struct EpiGate {
    static constexpr bool PERM = true;
    const float* ssq1; const float* X1; const float* PL; float* xout; bf16_t* XG; const float* gnorm; float* ssq_next; int has_next;
    __device__ __forceinline__ void operator()(const AccT& acc, const pg8::Unit& u, int wr, int wc, int fr, int fq) const {
        const int row0 = u.pm * 256 + wr * 64 + fr, c0 = u.pn * 256 + wc * 32 + 8 * fq;
        float gn[2][8];
        if (has_next) { load8_f32(gnorm + c0, gn[0]); load8_f32(gnorm + c0 + 128, gn[1]); }
        else {
#pragma unroll
            for (int e = 0; e < 8; ++e) { gn[0][e] = 0.f; gn[1][e] = 0.f; } }
        f32x4 x0[2], x1[2], p0[2], p1[2]; float sq[2];
        { const size_t o = (size_t)row0 * DM + c0; x0[0] = ldgf4(X1 + o); x1[0] = ldgf4(X1 + o + 4); p0[0] = ldgf4(PL + o); p1[0] = ldgf4(PL + o + 4); sq[0] = ldgf(ssq1 + row0); }
        float s = 0.f;
#pragma unroll
        for (int it = 0; it < 16; ++it) { EPI_IT(it, ai, m, bj);
            const int row = row0 + ai * 128 + m * 16; const size_t off = (size_t)row * DM + c0 + bj * 128;
            if (it + 1 < 16) { EPI_IT(it + 1, ai2, m2, bj2); const int rown = row0 + ai2 * 128 + m2 * 16; const size_t o = (size_t)rown * DM + c0 + bj2 * 128; const int b = (it + 1) & 1;
                x0[b] = ldgf4(X1 + o); x1[b] = ldgf4(X1 + o + 4); p0[b] = ldgf4(PL + o); p1[b] = ldgf4(PL + o + 4); sq[b] = ldgf(ssq1 + rown); }
            const float r = rsqrtf(sq[it & 1] * (1.0f / DM) + EPS);
            float v[8]; acc8(acc, ai, bj, m, v); const f32x4 xa = x0[it & 1], xb = x1[it & 1], pa = p0[it & 1], pb = p1[it & 1];
#pragma unroll
            for (int e = 0; e < 8; ++e) { const float g = sigmoid_f(v[e] * r); v[e] = (e < 4 ? xa[e & 3] : xb[e & 3]) + (e < 4 ? pa[e & 3] : pb[e & 3]) * g; s += v[e] * v[e]; }
            store8_f32(xout + off, v);
            if (has_next) {
#pragma unroll
                for (int e = 0; e < 8; ++e) v[e] *= gn[bj][e];
                store8_bf16(XG + off, v);
                if (bj == 1) { s += __shfl_xor(s, 16); s += __shfl_xor(s, 32); if (fq == 0) atomicAdd(ssq_next + row, s); s = 0.f; } }
            EPI_FENCE(); }
    }
};

#define XB_TMO      128
#define XB_XCNT(j)  (256  + 64 * (j))
#define XB_XSUB(j)  (1280 + 64 * (j))
#define XB_XGEN(j)  (2304 + 64 * (j))
#define XB_TOP      3328
#define XB_TOPGEN   3392
#define XCD_BAR_WORDS 3456
#define XB_SPIN_CAP (1u << 18)
__device__ __forceinline__ unsigned xb_ld(unsigned* p)              { return __hip_atomic_load(p, __ATOMIC_RELAXED, __HIP_MEMORY_SCOPE_AGENT); }
__device__ __forceinline__ unsigned xb_add(unsigned* p, unsigned v) { return __hip_atomic_fetch_add(p, v, __ATOMIC_RELAXED, __HIP_MEMORY_SCOPE_AGENT); }
__device__ __forceinline__ unsigned xb_xcc_id() { return (unsigned)__builtin_amdgcn_s_getreg((3 << 11) | 20) & 0xFu; }
#define XB_SPIN(cond, bar) do { unsigned _sp = 0; while (cond) { __builtin_amdgcn_s_sleep(1); \
    if ((++_sp & 255u) == 0u) { if (xb_ld(&(bar)[XB_TMO])) break; if (_sp > XB_SPIN_CAP) { atomicAdd(&(bar)[XB_TMO], 1u); break; } } } } while (0)
struct XcdBarrier { unsigned* bar; unsigned x; volatile LAS unsigned* st; };
__device__ __forceinline__ XcdBarrier xcd_barrier_post(unsigned* bar, volatile LAS unsigned* st) {
    XcdBarrier b; b.bar = bar; b.x = xb_xcc_id(); b.st = st;
    if (threadIdx.x == 0) (void)xb_add(&bar[XB_XCNT(b.x)], 1u);
    return b;
}
__device__ __forceinline__ void xcd_barrier_complete(unsigned* bar, unsigned x, unsigned& nloc, unsigned& nx) {
    const unsigned G = gridDim.x * gridDim.y * gridDim.z;
    unsigned sum, cnt, mine, sp = 0u;
    for (;;) {
        sum = 0u; cnt = 0u; mine = 0u;
#pragma unroll
        for (unsigned j = 0; j < 16; ++j) { const unsigned c = xb_ld(&bar[XB_XCNT(j)]); sum += c; cnt += (c > 0u) ? 1u : 0u; mine = (j == x) ? c : mine; }
        if (sum == G) break;
        __builtin_amdgcn_s_sleep(1);
        if ((++sp & 255u) == 0u) { if (xb_ld(&bar[XB_TMO])) break; if (sp > XB_SPIN_CAP) { atomicAdd(&bar[XB_TMO], 1u); break; } }
    }
    nloc = mine > 0u ? mine : 1u; nx = cnt > 0u ? cnt : 1u;
}
__device__ __forceinline__ void xcd_barrier(const XcdBarrier& b) {
    asm volatile("s_waitcnt vmcnt(0)" ::: "memory");
    __syncthreads();
    if (threadIdx.x == 0) {
        unsigned* bar = b.bar;
        __builtin_amdgcn_s_waitcnt(0);
        unsigned nloc = b.st[0], nx = b.st[1];
        if (nloc == 0u) { xcd_barrier_complete(bar, b.x, nloc, nx); b.st[0] = nloc; b.st[1] = nx; }
        const unsigned old = xb_add(&bar[XB_XSUB(b.x)], 1u);
        const unsigned gen = old / nloc;
        if (old + 1u == (gen + 1u) * nloc) {
            __builtin_amdgcn_fence(__ATOMIC_RELEASE, "agent");
            asm volatile("s_waitcnt vmcnt(0)" ::: "memory");
            const unsigned og = xb_add(&bar[XB_TOP], 1u);
            const unsigned tg = og / nx;
            if (og + 1u == (tg + 1u) * nx) xb_add(&bar[XB_TOPGEN], 1u);
            else XB_SPIN(xb_ld(&bar[XB_TOPGEN]) == tg, bar);
            __builtin_amdgcn_fence(__ATOMIC_ACQUIRE, "agent");
            xb_add(&bar[XB_XGEN(b.x)], 1u);
            asm volatile("s_waitcnt vmcnt(0)" ::: "memory");
        } else {
            XB_SPIN(xb_ld(&bar[XB_XGEN(b.x)]) == gen, bar);
            __builtin_amdgcn_fence(__ATOMIC_ACQUIRE, "agent");
            asm volatile("s_waitcnt vmcnt(0)" ::: "memory");
        }
    }
    __syncthreads();
}

struct Args { const float* in[15]; float* out; unsigned char* ws; int ph_lo, ph_hi; };

__device__ __forceinline__ void transpose_convert(const float* __restrict__ W, bf16_t* __restrict__ WT, int K, int N, LAS float* tile, int rot) {
    const int tid = threadIdx.x, nb = gridDim.x; const int bid = (int)((blockIdx.x + (unsigned)rot) % (unsigned)nb);
    const int nkt = K / 64, ntile = nkt * (N / 64);
    for (int t = bid; t < ntile; t += nb) {
        const int tk = t % nkt, tn = t / nkt;
        const float* src = W + (size_t)(tk * 64) * N + tn * 64;
#pragma unroll
        for (int i = 0; i < 2; ++i) { const int idx = tid + i * 512; const int k = idx >> 4, c4 = idx & 15; const f32x4 v = *(const f32x4*)(src + (size_t)k * N + c4 * 4);
            LAS float* d = tile + k * 65 + c4 * 4; d[0] = v[0]; d[1] = v[1]; d[2] = v[2]; d[3] = v[3]; }
        __syncthreads();
        { const int n = tid >> 3, kq = tid & 7; float v[8];
#pragma unroll
          for (int j = 0; j < 8; ++j) v[j] = tile[(kq * 8 + j) * 65 + n];
          store8_bf16(WT + (size_t)(tn * 64 + n) * K + tk * 64 + kq * 8, v); }
        __syncthreads();
    }
}

__device__ __forceinline__ void p0_prologue(const Args& a, LAS unsigned char* lds) {
    unsigned char* ws = a.ws;
    const int tid = threadIdx.x, bid = blockIdx.x, nb = gridDim.x, gtid = bid * 512 + tid, gsz = nb * 512;
    {
        float* LOWER = (float*)(ws + WS_LOWER); const float* lbp = a.in[4];
        for (int i = gtid; i < 2048; i += gsz) { const float a0 = lbp[i], a1 = lbp[2048 + i]; LOWER[i] = 0.f; LOWER[2048 + i] = 1.f / (1.f + expf(a0 - a1)); }
        float* SSQ = (float*)(ws + WS_SSQ);
        for (int i = gtid; i < 3 * SEQ; i += gsz) SSQ[SEQ + i] = 0.f;
    }
    {
        const float* x = a.in[0]; const float* g0 = a.in[2]; bf16_t* XG = (bf16_t*)(ws + WS_XGA); float* SSQ = (float*)(ws + WS_SSQ);
        const int lane = tid & 63, gw = gtid >> 6, nw = gsz >> 6;
        for (int row = gw; row < SEQ; row += nw) {
            const f32x4* xr = (const f32x4*)(x + (size_t)row * DM); float s = 0.f;
#pragma unroll
            for (int j = 0; j < 8; ++j) { const f32x4 v = xr[j * 64 + lane]; const f32x4 g = ((const f32x4*)g0)[j * 64 + lane];
                s += v[0] * v[0] + v[1] * v[1] + v[2] * v[2] + v[3] * v[3];
                u32x2 w; w.x = cvt_pk_bf16(v[0] * g[0], v[1] * g[1]); w.y = cvt_pk_bf16(v[2] * g[2], v[3] * g[3]);
                *(u32x2*)(XG + (size_t)row * DM + (j * 64 + lane) * 4) = w; }
#pragma unroll
            for (int o = 32; o >= 1; o >>= 1) s += __shfl_xor(s, o);
            if (lane == 0) SSQ[row] = s;
        }
    }
    {
        const f32x4* p = (const f32x4*)a.in[1]; bf16_t* PB = (bf16_t*)(ws + WS_PB);
        for (int i = gtid; i < 2 * SEQ * PLE / 4; i += gsz) { const f32x4 v = p[i]; u32x2 w; w.x = cvt_pk_bf16(v[0], v[1]); w.y = cvt_pk_bf16(v[2], v[3]); *(u32x2*)(PB + (size_t)i * 4) = w; }
    }
    LAS float* tile = (LAS float*)lds;
    for (int l = 0; l < 2; ++l) {
        transpose_convert(a.in[3] + (size_t)l * DM * NIN, (bf16_t*)(ws + WS_WIN) + (size_t)l * NIN * DM, DM, NIN, tile, 0);
        transpose_convert(a.in[9] + (size_t)l * HW * DM, (bf16_t*)(ws + WS_WA) + (size_t)l * DM * HW, HW, DM, tile, 0);
        transpose_convert(a.in[10] + (size_t)l * HW * DM, (bf16_t*)(ws + WS_WB) + (size_t)l * DM * HW, HW, DM, tile, 0);
        transpose_convert(a.in[11] + (size_t)l * DM * DM, (bf16_t*)(ws + WS_WO) + (size_t)l * DM * DM, DM, DM, tile, 0);
        transpose_convert(a.in[13] + (size_t)l * DM * DM, (bf16_t*)(ws + WS_WG) + (size_t)l * DM * DM, DM, DM, tile, 0);
        transpose_convert(a.in[14] + (size_t)l * PLE * DM, (bf16_t*)(ws + WS_WP) + (size_t)l * DM * PLE, PLE, DM, tile, 128);
    }
}

constexpr int HP_ROWB = 272;
constexpr int HT_ROWB = 144;

__device__ __forceinline__ void hg_cumsum(const float (&gv)[16], int seg, int kc, int dir, LAS float* SEGS, float (&b)[16], float& bref, float& blast) {
    float c = 0.f;
#pragma unroll
    for (int i = 0; i < 16; ++i) { c += gv[i]; b[i] = c; }
    const float tot = c;
    if (dir) {
#pragma unroll
        for (int i = 0; i < 16; ++i) b[i] = tot - b[i] + gv[i];
    }
    SEGS[seg * 128 + kc] = tot;
    __syncthreads();
    const float t0 = SEGS[kc], t1 = SEGS[128 + kc], t2 = SEGS[256 + kc], t3 = SEGS[384 + kc];
    float off;
    if (!dir) { off = (seg > 0 ? t0 : 0.f) + (seg > 1 ? t1 : 0.f) + (seg > 2 ? t2 : 0.f); bref = t0 + t1; }
    else      { off = (seg < 3 ? t3 : 0.f) + (seg < 2 ? t2 : 0.f) + (seg < 1 ? t1 : 0.f); bref = t2 + t3; }
    blast = (t0 + t1) + (t2 + t3);
#pragma unroll
    for (int i = 0; i < 16; ++i) b[i] += off;
}
__device__ __forceinline__ unsigned short ldg_u16(const bf16_t* p) { return *(const GAS bf16_t*)p; }

__device__ __forceinline__ void h1_phase(const Args& a, LAS unsigned char* lds, int wid_s) {
    unsigned char* ws = opaque_ptr(a.ws);
    const int tid = opaque_tid(wid_s), lane = tid & 63, w = __builtin_amdgcn_readfirstlane(tid >> 6), fr = lane & 15, fq = lane >> 4;
    const int kc = tid & 127, seg = tid >> 7;
    LAS float* SEGS = (LAS float*)lds; LAS float* SC = (LAS float*)(lds + 2048);
    LAS unsigned char* KpT = lds + 4096; LAS unsigned char* Vt = lds + 4096 + 128 * HT_ROWB;
    const bf16_t* VH = (const bf16_t*)(ws + WS_VH);
    float* LT = (float*)(ws + WS_LT); float* DD = (float*)(ws + WS_DD); float* EE = (float*)(ws + WS_EE);
    float gv[16]; unsigned short kr_[16], vr_[16];
#define H1_FETCH(item_) do { const int d_ = (item_) >> 10, h_ = ((item_) >> 7) & 7, cs_ = (item_) & 127, n_ = d_ ? 127 - cs_ : cs_; \
        const size_t o_ = (size_t)(64 * n_ + 16 * seg) * HW + h_ * 128 + kc; const float* G_ = (const float*)(ws + (d_ ? WS_GB : WS_GF)) + o_; const bf16_t* K_ = (const bf16_t*)(ws + (d_ ? WS_KB : WS_KF)) + o_; \
        _Pragma("unroll") for (int i = 0; i < 16; ++i) { gv[i] = ldgf(G_ + (size_t)i * HW); kr_[i] = ldg_u16(K_ + (size_t)i * HW); vr_[i] = ldg_u16(VH + o_ + (size_t)i * HW); } } while (0)
    int item = blockIdx.x;
    if (item < 2048) H1_FETCH(item);
    for (; item < 2048; item += gridDim.x) {
        const int d = item >> 10;
        float b[16], bref, blast;
        hg_cumsum(gv, seg, kc, d, SEGS, b, bref, blast);
        {
            unsigned kw[8], vw[8];
#pragma unroll
            for (int i = 0; i < 16; i += 2) {
                const float k0 = bf2f(kr_[i]) * __expf(fminf(bref - b[i], 80.f)), k1 = bf2f(kr_[i + 1]) * __expf(fminf(bref - b[i + 1], 80.f));
                kw[i >> 1] = cvt_pk_bf16(k0, k1);
                vw[i >> 1] = (unsigned)vr_[i] | ((unsigned)vr_[i + 1] << 16);
            }
            LAS u32x4* kd = (LAS u32x4*)(KpT + kc * HT_ROWB + seg * 32); kd[0] = (u32x4){kw[0], kw[1], kw[2], kw[3]}; kd[1] = (u32x4){kw[4], kw[5], kw[6], kw[7]};
            LAS u32x4* vd = (LAS u32x4*)(Vt + kc * HT_ROWB + seg * 32); vd[0] = (u32x4){vw[0], vw[1], vw[2], vw[3]}; vd[1] = (u32x4){vw[4], vw[5], vw[6], vw[7]};
            if (seg == 0) { SC[kc] = __expf(blast - bref); *(GAS float*)(DD + (size_t)item * 128 + kc) = __expf(blast); *(GAS float*)(EE + (size_t)item * 128 + kc) = __expf(bref); }
        }
        if (item + (int)gridDim.x < 2048) H1_FETCH(item + (int)gridDim.x);
        __syncthreads();
        {
            const int vt = w;
            bf16x8 bv[2];
#pragma unroll
            for (int ks = 0; ks < 2; ++ks) bv[ks] = *(const LAS bf16x8*)(Vt + (16 * vt + fr) * HT_ROWB + (32 * ks + 8 * fq) * 2);
            float* dst = LT + (size_t)item * 16384 + (size_t)(16 * vt + fr) * 128 + 4 * fq;
#pragma unroll
            for (int kt = 0; kt < 8; ++kt) {
                f32x4 acc = (f32x4){0.f, 0.f, 0.f, 0.f};
#pragma unroll
                for (int ks = 0; ks < 2; ++ks) { const bf16x8 af = *(const LAS bf16x8*)(KpT + (16 * kt + fr) * HT_ROWB + (32 * ks + 8 * fq) * 2);
                    acc = __builtin_amdgcn_mfma_f32_16x16x32_bf16(af, bv[ks], acc, 0, 0, 0); }
                const f32x4 sc = *(const LAS f32x4*)(SC + 16 * kt + 4 * fq);
                *(GAS f32x4*)(dst + 16 * kt) = acc * sc;
            }
        }
        __syncthreads();
    }
#undef H1_FETCH
}

__device__ __forceinline__ void h2_phase(const Args& a, int wid_s) {
    unsigned char* ws = opaque_ptr(a.ws);
    const int tid = opaque_tid(wid_s);
    const float* LT = (const float*)(ws + WS_LT); const float* DD = (const float*)(ws + WS_DD); const float* EE = (const float*)(ws + WS_EE);
    bf16_t* SP = (bf16_t*)(ws + WS_SP);
    for (int u = blockIdx.x; u < 256; u += gridDim.x) {
        const int chain = u >> 4, sub = u & 15;
        const int v = 8 * sub + (tid >> 6), k = 2 * (tid & 63);
        const size_t ibase = (size_t)chain * 128;
        float s0 = 0.f, s1 = 0.f;
        for (int cs0 = 0; cs0 < 128; cs0 += 8) {
            f32x2 lt[8], dd[8], ee[8];
#pragma unroll
            for (int j = 0; j < 8; ++j) { const size_t it = ibase + cs0 + j;
                lt[j] = *(const f32x2*)(LT + it * 16384 + v * 128 + k); dd[j] = *(const f32x2*)(DD + it * 128 + k); ee[j] = *(const f32x2*)(EE + it * 128 + k); }
#pragma unroll
            for (int j = 0; j < 8; ++j) { const size_t it = ibase + cs0 + j;
                *(unsigned*)(SP + it * 16384 + v * 128 + k) = cvt_pk_bf16(s0 * ee[j][0], s1 * ee[j][1]);
                s0 = dd[j][0] * s0 + lt[j][0]; s1 = dd[j][1] * s1 + lt[j][1]; }
        }
    }
}

__device__ __forceinline__ void h3_phase(const Args& a, int layer, LAS unsigned char* lds, int wid_s) {
    unsigned char* ws = opaque_ptr(a.ws);
    const int tid = opaque_tid(wid_s), lane = tid & 63, w = __builtin_amdgcn_readfirstlane(tid >> 6), fr = lane & 15, fq = lane >> 4;
    const int kc = tid & 127, seg = tid >> 7;
    LAS float* SEGS = (LAS float*)lds; LAS float* SSQP = (LAS float*)(lds + 2048);
    LAS unsigned char* Qp = lds + 4096; LAS unsigned char* Kp = Qp + 64 * HP_ROWB; LAS unsigned char* Vt = Kp + 64 * HP_ROWB; LAS unsigned char* Ab = Vt + 128 * HT_ROWB; LAS unsigned char* SPs = Ab + 64 * HT_ROWB;
    const bf16_t* QH = (const bf16_t*)(ws + WS_QH); const bf16_t* VH = (const bf16_t*)(ws + WS_VH); const bf16_t* HG = (const bf16_t*)(ws + WS_HG);
    const bf16_t* SP = (const bf16_t*)(ws + WS_SP); bf16_t* OA = (bf16_t*)(ws + WS_OA);
    const float* onorm = a.in[5] + layer * 128;
    float gv[16]; unsigned short qr_[16], kr_[16], vr_[16]; u32x4 spr[4];
#define H3_FETCH(item_, d_) do { const int n_ = (item_) >> 3, h_ = (item_) & 7, cs_ = (d_) ? 127 - n_ : n_; \
        const size_t o_ = (size_t)(64 * n_ + 16 * seg) * HW + h_ * 128 + kc; const float* G_ = (const float*)(ws + ((d_) ? WS_GB : WS_GF)) + o_; const bf16_t* K_ = (const bf16_t*)(ws + ((d_) ? WS_KB : WS_KF)) + o_; \
        const bf16_t* S_ = SP + (size_t)(((d_) * 8 + h_) * 128 + cs_) * 16384; \
        _Pragma("unroll") for (int i = 0; i < 16; ++i) { gv[i] = ldgf(G_ + (size_t)i * HW); qr_[i] = ldg_u16(QH + o_ + (size_t)i * HW); kr_[i] = ldg_u16(K_ + (size_t)i * HW); vr_[i] = ldg_u16(VH + o_ + (size_t)i * HW); } \
        _Pragma("unroll") for (int i = 0; i < 4; ++i) { const int q_ = tid + 512 * i; spr[i] = ldg16(S_ + (q_ >> 4) * 128 + (q_ & 15) * 8); } } while (0)
    int item = blockIdx.x;
    if (item < 1024) H3_FETCH(item, 0);
    for (; item < 1024; item += gridDim.x) {
        const int n = item >> 3, h = item & 7;
        const int tok0 = 64 * n;
        const int rt = w & 3, vg = w >> 2;
        f32x4 o[4];
#pragma unroll
        for (int j = 0; j < 4; ++j) o[j] = (f32x4){0.f, 0.f, 0.f, 0.f};
        u32x2 hgr[4];
        for (int d = 0; d < 2; ++d) {
            float b[16], bref, blast;
            hg_cumsum(gv, seg, kc, d, SEGS, b, bref, blast);
            {
                unsigned vw[8];
#pragma unroll
                for (int i = 0; i < 16; i += 2) {
                    const float e0 = b[i] - bref, e1 = b[i + 1] - bref;
                    const float q0 = bf2f(qr_[i]) * __expf(fminf(e0, 80.f)), q1 = bf2f(qr_[i + 1]) * __expf(fminf(e1, 80.f));
                    const float k0 = bf2f(kr_[i]) * __expf(fminf(-e0, 80.f)), k1 = bf2f(kr_[i + 1]) * __expf(fminf(-e1, 80.f));
                    *(LAS unsigned short*)(Qp + (16 * seg + i) * HP_ROWB + kc * 2) = f2bf1(q0);
                    *(LAS unsigned short*)(Qp + (16 * seg + i + 1) * HP_ROWB + kc * 2) = f2bf1(q1);
                    *(LAS unsigned short*)(Kp + (16 * seg + i) * HP_ROWB + kc * 2) = f2bf1(k0);
                    *(LAS unsigned short*)(Kp + (16 * seg + i + 1) * HP_ROWB + kc * 2) = f2bf1(k1);
                    vw[i >> 1] = (unsigned)vr_[i] | ((unsigned)vr_[i + 1] << 16);
                }
                LAS u32x4* vd = (LAS u32x4*)(Vt + kc * HT_ROWB + seg * 32); vd[0] = (u32x4){vw[0], vw[1], vw[2], vw[3]}; vd[1] = (u32x4){vw[4], vw[5], vw[6], vw[7]};
#pragma unroll
                for (int i = 0; i < 4; ++i) { const int q = tid + 512 * i; *(LAS u32x4*)(SPs + (q >> 4) * HP_ROWB + (q & 15) * 16) = spr[i]; }
            }
            if (d == 0) H3_FETCH(item, 1);
            else { if (item + (int)gridDim.x < 1024) H3_FETCH(item + (int)gridDim.x, 0);
#pragma unroll
                for (int j = 0; j < 4; ++j) hgr[j] = *(const GAS u32x2*)(HG + (size_t)(tok0 + 16 * rt + fr) * HW + h * 128 + 16 * (4 * vg + j) + 4 * fq); }
            __syncthreads();
            {
                const int art = w >> 1;
#pragma unroll
                for (int tt = 0; tt < 2; ++tt) {
                    const int st = 2 * (w & 1) + tt;
                    const bool need = d ? (st >= art) : (st <= art);
                    f32x4 acc = (f32x4){0.f, 0.f, 0.f, 0.f};
                    if (need) {
#pragma unroll
                        for (int ks = 0; ks < 4; ++ks) {
                            const bf16x8 af = *(const LAS bf16x8*)(Qp + (16 * art + fr) * HP_ROWB + (32 * ks + 8 * fq) * 2);
                            const bf16x8 bfr = *(const LAS bf16x8*)(Kp + (16 * st + fr) * HP_ROWB + (32 * ks + 8 * fq) * 2);
                            acc = __builtin_amdgcn_mfma_f32_16x16x32_bf16(af, bfr, acc, 0, 0, 0);
                        }
                    }
                    const int s_ = 16 * st + fr;
#pragma unroll
                    for (int r = 0; r < 4; ++r) { const int r_ = 16 * art + 4 * fq + r; const bool ok = need && (d ? (s_ >= r_) : (s_ <= r_));
                        *(LAS unsigned short*)(Ab + r_ * HT_ROWB + s_ * 2) = f2bf1(ok ? acc[r] : 0.f); }
                }
            }
            __syncthreads();
            {
                bf16x8 ab[2], qb[4];
#pragma unroll
                for (int ks = 0; ks < 2; ++ks) ab[ks] = *(const LAS bf16x8*)(Ab + (16 * rt + fr) * HT_ROWB + (32 * ks + 8 * fq) * 2);
#pragma unroll
                for (int ks = 0; ks < 4; ++ks) qb[ks] = *(const LAS bf16x8*)(Qp + (16 * rt + fr) * HP_ROWB + (32 * ks + 8 * fq) * 2);
#pragma unroll
                for (int j = 0; j < 4; ++j) {
                    const int vt = 4 * vg + j;
#pragma unroll
                    for (int ks = 0; ks < 2; ++ks) { const bf16x8 af = *(const LAS bf16x8*)(Vt + (16 * vt + fr) * HT_ROWB + (32 * ks + 8 * fq) * 2);
                        o[j] = __builtin_amdgcn_mfma_f32_16x16x32_bf16(af, ab[ks], o[j], 0, 0, 0); }
#pragma unroll
                    for (int ks = 0; ks < 4; ++ks) { const bf16x8 af = *(const LAS bf16x8*)(SPs + (16 * vt + fr) * HP_ROWB + (32 * ks + 8 * fq) * 2);
                        o[j] = __builtin_amdgcn_mfma_f32_16x16x32_bf16(af, qb[ks], o[j], 0, 0, 0); }
                }
            }
            __syncthreads();
        }
        {
            float s = 0.f;
#pragma unroll
            for (int j = 0; j < 4; ++j) s += o[j][0] * o[j][0] + o[j][1] * o[j][1] + o[j][2] * o[j][2] + o[j][3] * o[j][3];
            s += __shfl_xor(s, 16); s += __shfl_xor(s, 32);
            if (fq == 0) SSQP[vg * 64 + 16 * rt + fr] = s;
            __syncthreads();
            const int row = 16 * rt + fr; const float rs = rsqrtf((SSQP[row] + SSQP[64 + row]) * (1.0f / 128.f) + EPS);
#pragma unroll
            for (int j = 0; j < 4; ++j) { const int v0 = 16 * (4 * vg + j) + 4 * fq; const f32x4 on = ldgf4(onorm + v0);
                u32x2 ow; ow.x = cvt_pk_bf16(o[j][0] * rs * on[0] * bflo(hgr[j].x), o[j][1] * rs * on[1] * bfhi(hgr[j].x)); ow.y = cvt_pk_bf16(o[j][2] * rs * on[2] * bflo(hgr[j].y), o[j][3] * rs * on[3] * bfhi(hgr[j].y));
                *(GAS u32x2*)(OA + (size_t)(tok0 + row) * HW + h * 128 + v0) = ow; }
        }
    }
#undef H3_FETCH
}

constexpr int NAT_NB = 36864, NAT_KH = 64 * 272, NAT_VH = 128 * 144;
__device__ __forceinline__ void natten_phase(const Args& a, int layer, LAS unsigned char* lds, int wid_s) {
    unsigned char* ws = opaque_ptr(a.ws);
    const int tid = opaque_tid(wid_s), lane = tid & 63, w = __builtin_amdgcn_readfirstlane(tid >> 6), fr = lane & 15, fq = lane >> 4;
    LAS float* RP = (LAS float*)(lds + 2 * NAT_NB);
    const bf16_t* NQ = (const bf16_t*)(ws + WS_NQ); const bf16_t* NK = (const bf16_t*)(ws + WS_NK); const bf16_t* VT = (const bf16_t*)(ws + WS_VT);
    const bf16_t* NG = (const bf16_t*)(ws + WS_NG); bf16_t* OB = (bf16_t*)(ws + WS_OB);
    const float* gq = a.in[6] + layer * 128; const float* gk = a.in[7] + layer * 128; const float* rpb = a.in[8] + (size_t)layer * 8 * 465;
    for (int it = blockIdx.x; it < 512; it += gridDim.x) {
        const int r = it >> 2, hp = it & 3, hw = w >> 2, h = 2 * hp + hw, j = w & 3;
        const int r_start = min(max(r - 4, 0), 120);
        const bf16_t* ksrc[4]; const bf16_t* vsrc[4]; int kdst[4], vdst[4];
#pragma unroll
        for (int i = 0; i < 4; ++i) { const int q = tid + 512 * i, hd = q >> 10;
            { const int key = (q >> 4) & 63, ch = q & 15; ksrc[i] = NK + (size_t)(64 * r_start + key) * HW + (2 * hp + hd) * 128 + ch * 8; kdst[i] = hd * NAT_KH + key * 272 + ch * 16; }
            { const int d = (q >> 3) & 127, ch = q & 7; vsrc[i] = VT + (size_t)((2 * hp + hd) * 128 + d) * SEQ + 64 * r_start + ch * 8; vdst[i] = hd * NAT_VH + d * 144 + ch * 16; } }
        u32x4 R0[4], R1[4];
#define NAT_LOAD(st, R) do { _Pragma("unroll") for (int i = 0; i < 4; ++i) R[i] = ((st) < 8) ? ldg16(ksrc[i] + (size_t)(st) * 64 * HW) : ldg16(vsrc[i] + ((st) - 8) * 64); } while (0)
#define NAT_WRITE(st, R) do { _Pragma("unroll") for (int i = 0; i < 4; ++i) *(LAS u32x4*)(lds + ((st) & 1) * NAT_NB + (((st) < 8) ? kdst[i] : vdst[i])) = R[i]; } while (0)
        NAT_LOAD(0, R0); NAT_LOAD(1, R1);
        for (int i = tid; i < 930; i += 512) RP[i] = ldgf(rpb + (size_t)(2 * hp) * 465 + i);
        const int c0k = (j == 0) ? 0 : (j == 1) ? 8 : (j == 2) ? 24 : 32;
        const int cq = 16 * j + fr, tq = 64 * r + cq;
        const int cstart = min(max(cq - 8, 0), 48);
        bf16x8 qf[4];
        {
            float qv[4][8]; float ss = 0.f;
#pragma unroll
            for (int ks = 0; ks < 4; ++ks) { load8_bf16(NQ + (size_t)tq * HW + h * 128 + 32 * ks + 8 * fq, qv[ks]);
#pragma unroll
                for (int e = 0; e < 8; ++e) ss += qv[ks][e] * qv[ks][e]; }
            ss += __shfl_xor(ss, 16); ss += __shfl_xor(ss, 32);
            const float rq = rsqrtf(ss * (1.0f / 128.f) + EPS) * 0.08838834764831845f;
#pragma unroll
            for (int ks = 0; ks < 4; ++ks) { float g1[8], g2[8]; load8_f32(gq + 32 * ks + 8 * fq, g1); load8_f32(gk + 32 * ks + 8 * fq, g2);
                u32x4 wv;
                wv.x = cvt_pk_bf16(qv[ks][0] * rq * g1[0] * g2[0], qv[ks][1] * rq * g1[1] * g2[1]); wv.y = cvt_pk_bf16(qv[ks][2] * rq * g1[2] * g2[2], qv[ks][3] * rq * g1[3] * g2[3]);
                wv.z = cvt_pk_bf16(qv[ks][4] * rq * g1[4] * g2[4], qv[ks][5] * rq * g1[5] * g2[5]); wv.w = cvt_pk_bf16(qv[ks][6] * rq * g1[6] * g2[6], qv[ks][7] * rq * g1[7] * g2[7]);
                qf[ks] = __builtin_bit_cast(bf16x8, wv); }
        }
        NAT_WRITE(0, R0);
        __syncthreads();
        float s[8][2][4];
        float mx = -3.0e38f, l = 0.f;
        f32x4 o[8];
#pragma unroll
        for (int dt = 0; dt < 8; ++dt) o[dt] = (f32x4){0.f, 0.f, 0.f, 0.f};
#pragma unroll
        for (int st = 0; st < 16; ++st) {
            if (st + 2 < 16) { if (st & 1) NAT_LOAD(st + 2, R1); else NAT_LOAD(st + 2, R0); }
            LAS unsigned char* buf = lds + (st & 1) * NAT_NB;
            if (st < 8) {
                const int aa = st, kr = r_start + aa, row_off = kr - r + 7;
#pragma unroll
                for (int kt = 0; kt < 2; ++kt) {
                    bf16x8 kf[4]; float ssk = 0.f;
#pragma unroll
                    for (int ks = 0; ks < 4; ++ks) { const u32x4 wv = *(const LAS u32x4*)(buf + hw * NAT_KH + (c0k + 16 * kt + fr) * 272 + (32 * ks + 8 * fq) * 2); kf[ks] = __builtin_bit_cast(bf16x8, wv);
                        ssk += bflo(wv.x) * bflo(wv.x) + bfhi(wv.x) * bfhi(wv.x) + bflo(wv.y) * bflo(wv.y) + bfhi(wv.y) * bfhi(wv.y)
                             + bflo(wv.z) * bflo(wv.z) + bfhi(wv.z) * bfhi(wv.z) + bflo(wv.w) * bflo(wv.w) + bfhi(wv.w) * bfhi(wv.w); }
                    ssk += __shfl_xor(ssk, 16); ssk += __shfl_xor(ssk, 32);
                    const float rk = rsqrtf(ssk * (1.0f / 128.f) + EPS);
                    f32x4 acc = (f32x4){0.f, 0.f, 0.f, 0.f};
#pragma unroll
                    for (int ks = 0; ks < 4; ++ks) acc = __builtin_amdgcn_mfma_f32_16x16x32_bf16(kf[ks], qf[ks], acc, 0, 0, 0);
#pragma unroll
                    for (int rg = 0; rg < 4; ++rg) {
                        const int ki = 4 * fq + rg; const float rki = __shfl(rk, ki);
                        const int kcl = c0k + 16 * kt + ki; const bool valid = (kcl >= cstart) && (kcl < cstart + 16);
                        const int co = min(max(kcl - cq + 15, 0), 30);
                        const float bias = RP[hw * 465 + row_off * 31 + co];
                        const float sv = valid ? (acc[rg] * rki + bias) : -1.0e30f;
                        s[aa][kt][rg] = sv; mx = fmaxf(mx, sv);
                    }
                }
                if (st == 7) {
                    mx = fmaxf(mx, __shfl_xor(mx, 16)); mx = fmaxf(mx, __shfl_xor(mx, 32));
#pragma unroll
                    for (int a2 = 0; a2 < 8; ++a2)
#pragma unroll
                        for (int kt = 0; kt < 2; ++kt)
#pragma unroll
                            for (int rg = 0; rg < 4; ++rg) { const float p = __expf(s[a2][kt][rg] - mx); s[a2][kt][rg] = p; l += p; }
                    l += __shfl_xor(l, 16); l += __shfl_xor(l, 32);
                }
            } else {
                const int aa = st - 8;
                u32x4 pw; pw.x = cvt_pk_bf16(s[aa][0][0], s[aa][0][1]); pw.y = cvt_pk_bf16(s[aa][0][2], s[aa][0][3]); pw.z = cvt_pk_bf16(s[aa][1][0], s[aa][1][1]); pw.w = cvt_pk_bf16(s[aa][1][2], s[aa][1][3]);
                const bf16x8 pb = __builtin_bit_cast(bf16x8, pw);
#pragma unroll
                for (int dt = 0; dt < 8; ++dt) {
                    const LAS unsigned char* vp = buf + hw * NAT_VH + (16 * dt + fr) * 144 + (c0k + 4 * fq) * 2;
                    const u32x2 v0 = *(const LAS u32x2*)vp, v1 = *(const LAS u32x2*)(vp + 32);
                    const u32x4 vw = (u32x4){v0.x, v0.y, v1.x, v1.y};
                    o[dt] = __builtin_amdgcn_mfma_f32_16x16x32_bf16(__builtin_bit_cast(bf16x8, vw), pb, o[dt], 0, 0, 0);
                }
            }
            if (st + 1 < 16) { if (st & 1) NAT_WRITE(st + 1, R0); else NAT_WRITE(st + 1, R1); }
            __syncthreads();
        }
        const float inv = 1.0f / l;
#pragma unroll
        for (int dt = 0; dt < 8; ++dt) {
            const size_t off = (size_t)tq * HW + h * 128 + 16 * dt + 4 * fq;
            const u32x2 gw = *(const GAS u32x2*)(NG + off);
            u32x2 ow; ow.x = cvt_pk_bf16(o[dt][0] * inv * bflo(gw.x), o[dt][1] * inv * bfhi(gw.x)); ow.y = cvt_pk_bf16(o[dt][2] * inv * bflo(gw.y), o[dt][3] * inv * bfhi(gw.y));
            *(GAS u32x2*)(OB + off) = ow;
        }
#undef NAT_LOAD
#undef NAT_WRITE
    }
}

__global__ void __launch_bounds__(512, 2) mk_fwd(Args a) {
    extern __shared__ __attribute__((aligned(16))) unsigned char lds_raw[];
    LAS unsigned char* lds = (LAS unsigned char*)lds_raw;
    volatile LAS unsigned* MISC = (volatile LAS unsigned*)(lds + LDS_MISC_OFF);
    unsigned char* ws = a.ws;
    const int wid_s = __builtin_amdgcn_readfirstlane(threadIdx.x >> 6);
    if (threadIdx.x < 64) MISC[threadIdx.x] = 0u;
    __syncthreads();
    XcdBarrier bar; bar.bar = (unsigned*)(ws + WS_CTL) + 4096; bar.x = 0; bar.st = nullptr;
    const int lo = a.ph_lo, hi = a.ph_hi;
    if (hi - lo > 1) bar = xcd_barrier_post((unsigned*)(ws + WS_CTL) + 4096, MISC + 8);
#ifndef DIAG_MASK
#define DIAG_MASK 0x1ff
#endif
#define DM_(b) ((DIAG_MASK >> (b)) & 1)
#define IN(k) (lo <= (k) && (k) < hi)
#if MK_TS
    unsigned long long* TS = (unsigned long long*)(ws + 131072);
#define STAMP(k) do { if (blockIdx.x == 0 && threadIdx.x == 0) TS[k] = __builtin_amdgcn_s_memrealtime(); } while (0)
#define SEAM(k) do { if (IN(k) && (IN((k) + 1) || (k) == NPHASE - 1)) xcd_barrier(bar); STAMP((k) + 1); } while (0)
    STAMP(0);
#else
#define SEAM(k) do { if (IN(k) && IN((k) + 1)) xcd_barrier(bar); } while (0)
#endif
    const int G = gridDim.x, c = blockIdx.x;

    if (DM_(0) && IN(0)) { for (int rep = 0; rep < (MK_REP_PHASE == 0 ? MK_REP_N : 1); ++rep) { if (rep) xcd_barrier(bar); p0_prologue(a, lds); } }
    SEAM(0);
    for (int l = 0; l < 2; ++l) {
        const int pb = 1 + 7 * l;
        for (int rep = 0; rep < (MK_REP_PHASE == pb + 0 ? MK_REP_N : 1); ++rep) { if (rep) xcd_barrier(bar);
        if (DM_(1) && IN(pb + 0)) {
            unsigned char* ws = opaque_ptr(a.ws); bf16_t* XGA = (bf16_t*)(ws + WS_XGA); float* SSQ = (float*)(ws + WS_SSQ);
            pg8::Gemm g{XGA, (const bf16_t*)(ws + WS_WIN) + (size_t)l * NIN * DM, SEQ, NIN, DM}; pg8::StaticOrder S; S.init(SEQ, NIN, G, c);
            EpiInProj E{SSQ + (2 * l) * SEQ, (const float*)(ws + WS_LOWER) + l * 2048, ws};
            if (MK_REP_DUMMY && rep) { EpiDummy ED{(bf16_t*)(ws + WS_LT)}; pg8::gemm_phase<EpiDummy, pg8::StaticOrder>(lds, g, S, ED, wid_s); } else
            pg8::gemm_phase<EpiInProj, pg8::StaticOrder>(lds, g, S, E, wid_s);
        } }
        SEAM(pb + 0);
        if (IN(pb + 1)) { for (int rep = 0; rep < (MK_REP_PHASE == pb + 1 ? MK_REP_N : 1); ++rep) { if (rep) xcd_barrier(bar); if (DM_(2)) h1_phase(a, lds, wid_s); }
            for (int rep = 0; rep < (MK_REP_PHASE == pb + 101 ? MK_REP_N : 1); ++rep) { if (rep) xcd_barrier(bar); if (DM_(8)) natten_phase(a, l, lds, wid_s); } }
        SEAM(pb + 1);
        if (DM_(3) && IN(pb + 2)) { for (int rep = 0; rep < (MK_REP_PHASE == pb + 2 ? MK_REP_N : 1); ++rep) { if (rep) xcd_barrier(bar); h2_phase(a, wid_s); } }
        SEAM(pb + 2);
        if (DM_(4) && IN(pb + 3)) { for (int rep = 0; rep < (MK_REP_PHASE == pb + 3 ? MK_REP_N : 1); ++rep) { if (rep) xcd_barrier(bar); h3_phase(a, l, lds, wid_s); } }
        SEAM(pb + 3);
        for (int rep = 0; rep < (MK_REP_PHASE == pb + 4 ? MK_REP_N : 1); ++rep) { if (rep) xcd_barrier(bar);
        if (DM_(5) && IN(pb + 4)) {
            unsigned char* ws = opaque_ptr(a.ws);
            pg8::StaticOrder S; S.init(SEQ, DM, G, c);
            { pg8::Gemm g{(const bf16_t*)(ws + WS_OA), (const bf16_t*)(ws + WS_WA) + (size_t)l * DM * HW, SEQ, DM, HW};
              EpiBrA E{(const bf16_t*)(ws + WS_MA), (float*)(ws + WS_T)};
              pg8::gemm_phase<EpiBrA, pg8::StaticOrder>(lds, g, S, E, wid_s); }
            { pg8::Gemm g{(const bf16_t*)(ws + WS_OB), (const bf16_t*)(ws + WS_WB) + (size_t)l * DM * HW, SEQ, DM, HW};
              EpiBrB E{(const bf16_t*)(ws + WS_MB), (const float*)(ws + WS_T), (bf16_t*)(ws + WS_Y)};
              pg8::gemm_phase<EpiBrB, pg8::StaticOrder>(lds, g, S, E, wid_s); }
        } }
        SEAM(pb + 4);
        for (int rep = 0; rep < (MK_REP_PHASE == pb + 5 ? MK_REP_N : 1); ++rep) { if (rep) xcd_barrier(bar);
        if (DM_(6) && IN(pb + 5)) {
            unsigned char* ws = opaque_ptr(a.ws); bf16_t* XGB = (bf16_t*)(ws + WS_XGB); float* SSQ = (float*)(ws + WS_SSQ);
            pg8::Gemm g{(const bf16_t*)(ws + WS_Y), (const bf16_t*)(ws + WS_WO) + (size_t)l * DM * DM, SEQ, DM, DM}; pg8::StaticOrder S; S.init(SEQ, DM, G, c);
            EpiWout E{l == 0 ? a.in[0] : (const float*)a.out, (float*)(ws + WS_X1), XGB, a.in[12] + l * DM, rep ? (float*)(ws + 262144) : SSQ + (2 * l + 1) * SEQ};
            if (MK_REP_DUMMY && rep) { EpiDummy ED{(bf16_t*)(ws + WS_LT)}; pg8::gemm_phase<EpiDummy, pg8::StaticOrder>(lds, g, S, ED, wid_s); } else
            pg8::gemm_phase<EpiWout, pg8::StaticOrder>(lds, g, S, E, wid_s);
        } }
        SEAM(pb + 5);
        for (int rep = 0; rep < (MK_REP_PHASE == pb + 6 ? MK_REP_N : 1); ++rep) { if (rep) xcd_barrier(bar);
        if (DM_(7) && IN(pb + 6)) {
            unsigned char* ws = opaque_ptr(a.ws); bf16_t* XGA = (bf16_t*)(ws + WS_XGA); bf16_t* XGB = (bf16_t*)(ws + WS_XGB); float* SSQ = (float*)(ws + WS_SSQ);
            pg8::StaticOrder S; S.init(SEQ, DM, G, c);
            { pg8::Gemm g{(const bf16_t*)(ws + WS_PB) + (size_t)l * SEQ * PLE, (const bf16_t*)(ws + WS_WP) + (size_t)l * DM * PLE, SEQ, DM, PLE};
              EpiPL E{(float*)(ws + WS_PL)};
              pg8::gemm_phase<EpiPL, pg8::StaticOrder>(lds, g, S, E, wid_s); }
            { pg8::Gemm g{XGB, (const bf16_t*)(ws + WS_WG) + (size_t)l * DM * DM, SEQ, DM, DM};
              EpiGate E{SSQ + (2 * l + 1) * SEQ, (const float*)(ws + WS_X1), (const float*)(ws + WS_PL), a.out, XGA, a.in[2] + (l + 1 < 2 ? (l + 1) * DM : 0), rep ? (float*)(ws + 262144) : SSQ + (2 * l + 2 < 4 ? 2 * l + 2 : 0) * SEQ, l == 0 ? 1 : 0};
              pg8::gemm_phase<EpiGate, pg8::StaticOrder>(lds, g, S, E, wid_s); }
        } }
        SEAM(pb + 6);
    }
#if MK_TS
    if (blockIdx.x == 0) {
        const float dA = (float)(TS[MK_TS_A + 1] - TS[MK_TS_A]) * 0.01f, dB = (float)(TS[MK_TS_B + 1] - TS[MK_TS_B]) * 0.01f;
        for (int i = threadIdx.x; i < 1000000; i += 512) a.out[i] += (i == 0) ? 10.f * dA : 0.3f * dB;
    }
#endif
#undef IN
#undef SEAM
#if MK_ENDFLUSH
    asm volatile("s_waitcnt vmcnt(0)" ::: "memory");
    __builtin_amdgcn_fence(__ATOMIC_RELEASE, "agent");
    asm volatile("s_waitcnt vmcnt(0)" ::: "memory");
#endif
}


#ifndef MK_DIAG
#define MK_DIAG 0
#define MK_HOLE_BUF WS_MB
#define MK_HOLE_LD DM
#define MK_HOLE_MODE 0
#endif
#if MK_DIAG
__global__ void ck_sum(const void* p, size_t n, int kind, double* slot) {
    double s0 = 0.0, s1 = 0.0;
    for (size_t i = (size_t)blockIdx.x * blockDim.x + threadIdx.x; i < n; i += (size_t)gridDim.x * blockDim.x) {
        float v = kind ? bf2f(((const bf16_t*)p)[i]) : ((const float*)p)[i];
        if (!(v == v)) v = 12345.0f;
        const float wgt = (float)((int)((i * 2654435761ull >> 16) & 255) - 128);
        s0 += fabsf(v); s1 += (double)v * wgt;
    }
    for (int o = 32; o >= 1; o >>= 1) { s0 += __shfl_xor(s0, o); s1 += __shfl_xor(s1, o); }
    if ((threadIdx.x & 63) == 0) { atomicAdd(slot, s0); atomicAdd(slot + 1, s1); }
}
__global__ void ck_final(const double* sums, float* out, size_t n, int nslots) {
    int first = -1;
    for (int i = 0; i < nslots; ++i) { const double a0 = sums[2 * i], a1 = sums[2 * i + 1], b0 = sums[2 * (nslots + i)], b1 = sums[2 * (nslots + i) + 1];
        const bool bad = fabs(a0 - b0) > 1e-5 * (fabs(a0) + fabs(b0)) + 1e-30 || fabs(a1 - b1) > 1e-4 * (fabs(a0) + fabs(b0)) + 1e-30;
        if (bad) { first = i; break; } }
    const float val = first < 0 ? 0.f : 100.f * (float)(first + 1);
    for (size_t i = (size_t)blockIdx.x * blockDim.x + threadIdx.x; i < n; i += (size_t)gridDim.x * blockDim.x) out[i] = val;
}
__global__ void ck_holes(const bf16_t* p, size_t n, unsigned long long* res) {
    unsigned long long cnt = 0, mn = ~0ull;
    for (size_t i = (size_t)blockIdx.x * blockDim.x + threadIdx.x; i < n; i += (size_t)gridDim.x * blockDim.x) if (p[i] == 0xFFFFu) { ++cnt; if (i < mn) mn = i; }
    if (cnt) { atomicAdd(res, cnt); atomicMin(res + 1, mn); }
}
__global__ void ck_holes_final(const unsigned long long* res, float* out, size_t n, int mode) {
    const float val = mode == 0 ? (float)((double)res[0] / 65536.0 * 100.0) : mode == 1 ? (float)((res[1] == ~0ull ? 0 : (res[1] / 2048) ) ) + 100.f : (float)((res[1] == ~0ull ? 0 : (res[1] % 2048))) + 100.f;
    for (size_t i = (size_t)blockIdx.x * blockDim.x + threadIdx.x; i < n; i += (size_t)gridDim.x * blockDim.x) out[i] = val;
}
__global__ void ck_diff(const bf16_t* p, const bf16_t* q, size_t n, unsigned long long* res) {
    unsigned long long cnt = 0, mn = ~0ull, big = 0;
    for (size_t i = (size_t)blockIdx.x * blockDim.x + threadIdx.x; i < n; i += (size_t)gridDim.x * blockDim.x) if (p[i] != q[i]) { ++cnt; if (i < mn) mn = i; const float a = bf2f(p[i]), b = bf2f(q[i]); if (fabsf(a - b) > 0.02f * (fabsf(a) + fabsf(b))) ++big; }
    if (cnt) { atomicAdd(res, cnt); atomicMin(res + 1, mn); atomicAdd(res + 2, big); }
}
__global__ void ck_diff_final(const unsigned long long* res, float* out, size_t n, int ld) {
    const unsigned long long cnt = res[0], big = res[2];
    const float c2 = 100.f * (1.f + floorf(log2f(1.f + (float)cnt)));
    const float c1 = 1.0e6f * (1.f + floorf(log2f(1.f + (float)big)));
    for (size_t i = (size_t)blockIdx.x * blockDim.x + threadIdx.x; i < n; i += (size_t)gridDim.x * blockDim.x) out[i] = (i == 0) ? c1 : c2;
}

__device__ __forceinline__ unsigned hsh(unsigned x) { x ^= x >> 16; x *= 0x7feb352du; x ^= x >> 15; x *= 0x846ca68bu; x ^= x >> 16; return x; }
__device__ __forceinline__ float bfr(float f) { return bf2f(f2bf1(f)); }
__device__ __forceinline__ void err_max(unsigned* res, float got, float expv) { float e = fabsf(got - expv) / (0.02f + 0.02f * fabsf(expv)); if (!(e == e)) e = 1e9f; atomicMax(res, __float_as_uint(e)); }
__device__ __forceinline__ float wave_sum(float s) { for (int o = 32; o >= 1; o >>= 1) s += __shfl_xor(s, o); return s; }
__global__ void chk_inproj(const float* x, const float* g0, const float* win, const float* lbp, const unsigned char* ws, unsigned* res, int nsamp) {
    const int lane = threadIdx.x & 63, wv = (blockIdx.x * blockDim.x + threadIdx.x) >> 6, nw = (gridDim.x * blockDim.x) >> 6;
    for (int s = wv; s < nsamp; s += nw) {
        const int row = hsh(2 * s + 1) % SEQ, col = hsh(2 * s + 2) % NIN;
        float ss = 0.f, dot = 0.f;
        for (int k = lane; k < DM; k += 64) { const float xv = x[(size_t)row * DM + k]; ss += xv * xv; dot += bfr(xv * g0[k]) * bfr(win[(size_t)k * NIN + col]); }
        ss = wave_sum(ss); dot = wave_sum(dot);
        const float u = dot * rsqrtf(ss / DM + EPS);
        if (lane == 0) {
            const int seg = col >> 10, c = col & 1023; const size_t o1 = (size_t)row * HW + c;
            const float sg = 1.f / (1.f + expf(-u)), si = u * sg;
            if (seg == 0) err_max(res, bf2f(((const bf16_t*)(ws + WS_QH))[o1]), si);
            else if (seg == 1) err_max(res, bf2f(((const bf16_t*)(ws + WS_VH))[o1]), u);
            else if (seg == 2 || seg == 3) { const int dir = seg - 2; const float a0 = lbp[dir * 1024 + c], a1 = lbp[2048 + dir * 1024 + c]; const float lb = 0.f * (a0 + a1);
                const float f = lb + (1.f - lb) * sg; err_max(res + 1, ((const float*)(ws + (dir ? WS_GB : WS_GF)))[o1], logf(fmaxf(f, 1e-6f)));
                err_max(res + 1, bf2f(((const bf16_t*)(ws + (dir ? WS_KB : WS_KF)))[o1]), (1.f - lb) * (1.f - sg)); }
            else if (seg == 4) err_max(res, bf2f(((const bf16_t*)(ws + WS_HG))[o1]), si);
            else if (seg == 5) err_max(res, bf2f(((const bf16_t*)(ws + WS_NQ))[o1]), u);
            else if (seg == 6) err_max(res, bf2f(((const bf16_t*)(ws + WS_NK))[o1]), u);
            else if (seg == 7) err_max(res + 2, bf2f(((const bf16_t*)(ws + WS_VT))[(size_t)c * SEQ + row]), u);
            else if (seg == 8) err_max(res, bf2f(((const bf16_t*)(ws + WS_NG))[o1]), si);
            else if (seg < 11) err_max(res + 3, bf2f(((const bf16_t*)(ws + WS_MA))[(size_t)row * DM + col - 9216]), sg);
            else err_max(res + 9, bf2f(((const bf16_t*)(ws + WS_MB))[(size_t)row * DM + col - 11264]), sg);
        }
    }
}
__global__ void chk_natten(const unsigned char* ws, const float* gq, const float* gk, const float* rpb, unsigned* res, int nsamp) {
    const int lane = threadIdx.x & 63, wv = (blockIdx.x * blockDim.x + threadIdx.x) >> 6, nw = (gridDim.x * blockDim.x) >> 6;
    const bf16_t* NQ = (const bf16_t*)(ws + WS_NQ); const bf16_t* NK = (const bf16_t*)(ws + WS_NK); const bf16_t* VT = (const bf16_t*)(ws + WS_VT); const bf16_t* NG = (const bf16_t*)(ws + WS_NG); const bf16_t* OB = (const bf16_t*)(ws + WS_OB);
    for (int s = wv; s < nsamp; s += nw) {
        const int t = hsh(3 * s + 7) % SEQ, h = hsh(3 * s + 8) % 8; const int r = t >> 6, c = t & 63;
        const int rs0 = min(max(r - 4, 0), 120), cs0 = min(max(c - 8, 0), 48);
        float q0 = bf2f(NQ[(size_t)t * HW + h * 128 + lane]), q1 = bf2f(NQ[(size_t)t * HW + h * 128 + 64 + lane]);
        const float rq = rsqrtf(wave_sum(q0 * q0 + q1 * q1) / 128.f + EPS); q0 *= rq * gq[lane]; q1 *= rq * gq[64 + lane];
        float mx = -1e30f;
        float o0 = 0.f, o1 = 0.f, l = 0.f;
        for (int pass = 0; pass < 2; ++pass) {
            for (int a = 0; a < 8; ++a) for (int j = 0; j < 16; ++j) {
                const int kr = rs0 + a, kc = cs0 + j, tk = kr * 64 + kc;
                float k0 = bf2f(NK[(size_t)tk * HW + h * 128 + lane]), k1 = bf2f(NK[(size_t)tk * HW + h * 128 + 64 + lane]);
                const float rk = rsqrtf(wave_sum(k0 * k0 + k1 * k1) / 128.f + EPS);
                const float d = wave_sum(q0 * k0 * rk * gk[lane] + q1 * k1 * rk * gk[64 + lane]) * 0.08838834764831845f + rpb[(size_t)h * 465 + (kr - r + 7) * 31 + (kc - c + 15)];
                if (pass == 0) mx = fmaxf(mx, d);
                else { const float p = expf(d - mx); l += p; o0 += p * bf2f(VT[(size_t)(h * 128 + lane) * SEQ + tk]); o1 += p * bf2f(VT[(size_t)(h * 128 + 64 + lane) * SEQ + tk]); }
            }
        }
        const size_t ob = (size_t)t * HW + h * 128;
        err_max(res, bf2f(OB[ob + lane]), o0 / l * bf2f(NG[ob + lane])); err_max(res, bf2f(OB[ob + 64 + lane]), o1 / l * bf2f(NG[ob + 64 + lane]));
    }
}
__global__ void chk_hgrn_scan(const unsigned char* ws, float* OREF, int h0) {
    __shared__ float qs[128], ks[128], fs[128], vs[128], part[4][128];
    const int tid = threadIdx.x, v = tid & 127, kq = tid >> 7; const int h = h0 + (blockIdx.x >> 1), d = blockIdx.x & 1;
    const bf16_t* QH = (const bf16_t*)(ws + WS_QH); const bf16_t* VH = (const bf16_t*)(ws + WS_VH); const bf16_t* KK = (const bf16_t*)(ws + (d ? WS_KB : WS_KF)); const float* G = (const float*)(ws + (d ? WS_GB : WS_GF));
    float S[32];
#pragma unroll
    for (int i = 0; i < 32; ++i) S[i] = 0.f;
    float* out = OREF + (size_t)blockIdx.x * SEQ * 128;
    for (int step = 0; step < SEQ; ++step) {
        const int t = d ? SEQ - 1 - step : step;
        if (tid < 128) { qs[tid] = bf2f(QH[(size_t)t * HW + h * 128 + tid]); ks[tid] = bf2f(KK[(size_t)t * HW + h * 128 + tid]); fs[tid] = expf(G[(size_t)t * HW + h * 128 + tid]); vs[tid] = bf2f(VH[(size_t)t * HW + h * 128 + tid]); }
        __syncthreads();
        float p = 0.f; const float vv = vs[v];
#pragma unroll
        for (int i = 0; i < 32; ++i) { const int k = 32 * kq + i; S[i] = fs[k] * S[i] + ks[k] * vv; p += S[i] * qs[k]; }
        part[kq][v] = p;
        __syncthreads();
        if (tid < 128) out[(size_t)t * 128 + tid] = part[0][tid] + part[1][tid] + part[2][tid] + part[3][tid];
    }
}
__global__ void chk_hgrn_out(const unsigned char* ws, const float* OREF, const float* onorm, unsigned* res, int h0, int nh) {
    const int lane = threadIdx.x & 63, wv = (blockIdx.x * blockDim.x + threadIdx.x) >> 6, nw = (gridDim.x * blockDim.x) >> 6;
    const bf16_t* HG = (const bf16_t*)(ws + WS_HG); const bf16_t* OA = (const bf16_t*)(ws + WS_OA);
    for (int s = wv; s < nh * SEQ; s += nw) {
        const int hh = s / SEQ, t = s % SEQ, h = h0 + hh;
        const float* of = OREF + ((size_t)(2 * hh) * SEQ + t) * 128; const float* ob = OREF + ((size_t)(2 * hh + 1) * SEQ + t) * 128;
        const float a0 = of[lane] + ob[lane], a1 = of[64 + lane] + ob[64 + lane];
        const float rs = rsqrtf(wave_sum(a0 * a0 + a1 * a1) / 128.f + EPS);
        const size_t o = (size_t)t * HW + h * 128;
        err_max(res, bf2f(OA[o + lane]), a0 * rs * onorm[lane] * bf2f(HG[o + lane])); err_max(res, bf2f(OA[o + 64 + lane]), a1 * rs * onorm[64 + lane] * bf2f(HG[o + 64 + lane]));
    }
}
__global__ void chk_branch(const unsigned char* ws, const float* wa, const float* wb, unsigned* res, int nsamp) {
    const int lane = threadIdx.x & 63, wv = (blockIdx.x * blockDim.x + threadIdx.x) >> 6, nw = (gridDim.x * blockDim.x) >> 6;
    const bf16_t* OA = (const bf16_t*)(ws + WS_OA); const bf16_t* OB = (const bf16_t*)(ws + WS_OB); const bf16_t* MA = (const bf16_t*)(ws + WS_MA); const bf16_t* MB = (const bf16_t*)(ws + WS_MB); const bf16_t* Y = (const bf16_t*)(ws + WS_Y);
    for (int s = wv; s < nsamp; s += nw) {
        const int row = hsh(5 * s + 1) % SEQ, col = hsh(5 * s + 2) % DM; float da = 0.f, db = 0.f;
        for (int k = lane; k < HW; k += 64) { da += bf2f(OA[(size_t)row * HW + k]) * bfr(wa[(size_t)k * DM + col]); db += bf2f(OB[(size_t)row * HW + k]) * bfr(wb[(size_t)k * DM + col]); }
        da = wave_sum(da); db = wave_sum(db);
        if (lane == 0) err_max(res, bf2f(Y[(size_t)row * DM + col]), bf2f(MA[(size_t)row * DM + col]) * da + bf2f(MB[(size_t)row * DM + col]) * db);
    }
}
__global__ void chk_wout(const unsigned char* ws, const float* xin, const float* wo, unsigned* res, int nsamp) {
    const int lane = threadIdx.x & 63, wv = (blockIdx.x * blockDim.x + threadIdx.x) >> 6, nw = (gridDim.x * blockDim.x) >> 6;
    const bf16_t* Y = (const bf16_t*)(ws + WS_Y); const float* X1 = (const float*)(ws + WS_X1);
    for (int s = wv; s < nsamp; s += nw) {
        const int row = hsh(7 * s + 1) % SEQ, col = hsh(7 * s + 2) % DM; float d = 0.f;
        for (int k = lane; k < DM; k += 64) d += bf2f(Y[(size_t)row * DM + k]) * bfr(wo[(size_t)k * DM + col]);
        d = wave_sum(d);
        if (lane == 0) err_max(res, X1[(size_t)row * DM + col], xin[(size_t)row * DM + col] + d);
    }
}
__global__ void chk_gate(const unsigned char* ws, const float* out, const float* p, const float* wp, const float* wg, const float* pn, unsigned* res, int nsamp) {
    const int lane = threadIdx.x & 63, wv = (blockIdx.x * blockDim.x + threadIdx.x) >> 6, nw = (gridDim.x * blockDim.x) >> 6;
    const float* X1 = (const float*)(ws + WS_X1);
    for (int s = wv; s < nsamp; s += nw) {
        const int row = hsh(9 * s + 1) % SEQ, col = hsh(9 * s + 2) % DM; float d = 0.f, ss = 0.f, pl = 0.f;
        for (int k = lane; k < DM; k += 64) { const float xv = X1[(size_t)row * DM + k]; ss += xv * xv; d += bfr(xv * pn[k]) * bfr(wg[(size_t)k * DM + col]); }
        for (int k = lane; k < PLE; k += 64) pl += bfr(p[(size_t)row * PLE + k]) * bfr(wp[(size_t)k * DM + col]);
        d = wave_sum(d); ss = wave_sum(ss); pl = wave_sum(pl);
        if (lane == 0) { const float g = 1.f / (1.f + expf(-d * rsqrtf(ss / DM + EPS))); err_max(res, out[(size_t)row * DM + col], X1[(size_t)row * DM + col] + pl * g); }
    }
}
__global__ void chk_final(const unsigned* res, float* out, size_t n, int nres) {
    int first = -1; for (int i = 0; i < nres; ++i) if (__uint_as_float(res[i]) > 1.0f) { first = i; break; }
    float bucket = 0.f; if (first >= 0) { const float e = __uint_as_float(res[first]); bucket = fminf(fmaxf(floorf(log10f(e)) + 1.f, 0.f), 9.f); }
    const float val = first < 0 ? 0.f : 100.f * (float)(first + 1) + 10.f * bucket;
    for (size_t i = (size_t)blockIdx.x * blockDim.x + threadIdx.x; i < n; i += (size_t)gridDim.x * blockDim.x) out[i] = val;
}

__global__ void ck_big(const bf16_t* p, size_t n, unsigned long long* res) {
    unsigned long long c0 = 0, c2 = 0, c4 = 0; float mxv = 0.f;
    for (size_t i = (size_t)blockIdx.x * blockDim.x + threadIdx.x; i < n; i += (size_t)gridDim.x * blockDim.x) { const float v = bf2f(p[i]);
        if (!(fabsf(v) <= 3.0e38f)) ++c0; else if (fabsf(v) > 1.01f || v < -0.01f) { ++c2; mxv = fmaxf(mxv, fabsf(v)); if (v < 0.f) ++c4; } }
    if (c0 | c2) { atomicAdd(res, c0); atomicAdd(res + 2, c2); atomicAdd(res + 4, c4); atomicMax((unsigned*)(res + 3), __float_as_uint(mxv)); }
}
__global__ void ck_big_final(const unsigned long long* res, float* out, size_t n, int ld) {
    const float mxv = __uint_as_float((unsigned)res[3]);
    const float c1 = 1.0e4f * (1.f + floorf(log2f(1.f + (float)res[0])));
    const float negf = res[2] ? (float)res[4] / (float)res[2] : 0.f;
    const float c2 = 1000.f * (1.f + floorf(negf * 3.99f)) + 100.f * fminf(fmaxf(floorf(log10f(fmaxf(mxv, 1e-9f))) + 2.f, 0.f), 9.f);
    for (size_t i = (size_t)blockIdx.x * blockDim.x + threadIdx.x; i < n; i += (size_t)gridDim.x * blockDim.x) out[i] = (i == 0) ? c1 : c2;
}
struct CkBuf { int phase; int idx; size_t off; size_t n; int kind; };
#endif

extern "C" void kernel_launch(void* const* d_in, const int* in_sizes, int n_in, void* d_out, int out_size, void* d_ws, size_t ws_size, hipStream_t stream) {
    static int grid = 0;
    if (grid == 0) {
        if (n_in != 15 || out_size != SEQ * DM || ws_size < WS_END) { fprintf(stderr, "kernel_launch: unexpected problem (n_in %d, out %d, ws %zu)\n", n_in, out_size, ws_size); grid = -1; return; }
        int dev = 0, cus = 0;
        if (hipGetDevice(&dev) != hipSuccess || hipDeviceGetAttribute(&cus, hipDeviceAttributeMultiprocessorCount, dev) != hipSuccess) { grid = -1; return; }
        if (hipFuncSetAttribute((const void*)mk_fwd, hipFuncAttributeMaxDynamicSharedMemorySize, LDS_BYTES) != hipSuccess) { fprintf(stderr, "kernel_launch: hipFuncSetAttribute failed\n"); grid = -1; return; }
        int per_cu = 0;
        if (hipOccupancyMaxActiveBlocksPerMultiprocessor(&per_cu, (const void*)mk_fwd, 512, LDS_BYTES) != hipSuccess || per_cu < 1) fprintf(stderr, "kernel_launch: occupancy query says %d\n", per_cu);
        (void)hipGetLastError();
        grid = cus;
    }
    if (grid < 0) return;
    (void)hipMemsetAsync((char*)d_ws + WS_CTL, 0, CTL_ZERO_BYTES, stream);
    Args a{};
    for (int i = 0; i < 15; ++i) a.in[i] = (const float*)d_in[i];
    a.out = (float*)d_out; a.ws = (unsigned char*)d_ws;
#if MK_DIAG == 5
    {
        unsigned long long* res = (unsigned long long*)((char*)d_ws + 65536);
        (void)hipMemsetAsync((char*)d_ws + 65536 + 8, 0xFF, 8, stream);
        for (int ph = 0; ph < 2; ++ph) { a.ph_lo = ph; a.ph_hi = ph + 1; hipLaunchKernelGGL(mk_fwd, dim3(grid), dim3(512), LDS_BYTES, stream, a); }
        hipLaunchKernelGGL(ck_big, dim3(1024), dim3(256), 0, stream, (const bf16_t*)((char*)d_ws + WS_MA), (size_t)SEQ * DM, res);
        hipLaunchKernelGGL(ck_big_final, dim3(1024), dim3(256), 0, stream, (const unsigned long long*)res, (float*)d_out, (size_t)SEQ * DM, DM);
    }
#elif MK_DIAG == 4
    {
        unsigned* res = (unsigned*)((char*)d_ws + 65536);
        float* OREF = (float*)((char*)d_ws + 728 * MiB);
        const unsigned char* wsc = (const unsigned char*)d_ws;
        const float* const* in = a.in;
        for (int ph = 0; ph < NPHASE; ++ph) {
            a.ph_lo = ph; a.ph_hi = ph + 1; hipLaunchKernelGGL(mk_fwd, dim3(grid), dim3(512), LDS_BYTES, stream, a);
            if (ph == 1) hipLaunchKernelGGL(chk_inproj, dim3(512), dim3(256), 0, stream, in[0], in[2], in[3], in[4], wsc, res + 0, 32768);
            if (ph == 2) hipLaunchKernelGGL(chk_natten, dim3(256), dim3(256), 0, stream, wsc, in[6], in[7], in[8], res + 4, 1024);
            if (ph == 4) { hipLaunchKernelGGL(chk_hgrn_scan, dim3(4), dim3(512), 0, stream, wsc, OREF, 2);
                           hipLaunchKernelGGL(chk_hgrn_out, dim3(512), dim3(256), 0, stream, wsc, (const float*)OREF, in[5], res + 5, 2, 2); }
            if (ph == 5) hipLaunchKernelGGL(chk_branch, dim3(512), dim3(256), 0, stream, wsc, in[9], in[10], res + 6, 8192);
            if (ph == 6) hipLaunchKernelGGL(chk_wout, dim3(512), dim3(256), 0, stream, wsc, in[0], in[11], res + 7, 8192);
            if (ph == 7) hipLaunchKernelGGL(chk_gate, dim3(512), dim3(256), 0, stream, wsc, (const float*)d_out, in[1], in[14], in[13], in[12], res + 8, 8192);
        }
        hipLaunchKernelGGL(chk_final, dim3(1024), dim3(256), 0, stream, (const unsigned*)res, (float*)d_out, (size_t)SEQ * DM, 10);
    }
#elif MK_DIAG == 3
    {
        unsigned long long* res = (unsigned long long*)((char*)d_ws + 65536);
        bf16_t* SAVE = (bf16_t*)((char*)d_ws + 728 * MiB);
        (void)hipMemsetAsync((char*)d_ws + MiB, 0xAA, WS_END - MiB, stream);
        (void)hipMemsetAsync((char*)d_ws + 65536 + 8, 0xFF, 8, stream);
        for (int ph = 0; ph < 2; ++ph) { a.ph_lo = ph; a.ph_hi = ph + 1; hipLaunchKernelGGL(mk_fwd, dim3(grid), dim3(512), LDS_BYTES, stream, a); }
        (void)hipMemcpyAsync(SAVE, (char*)d_ws + MK_HOLE_BUF, (size_t)SEQ * MK_HOLE_LD * 2, hipMemcpyDeviceToDevice, stream);
        a.ph_lo = 1; a.ph_hi = 2; hipLaunchKernelGGL(mk_fwd, dim3(grid), dim3(512), LDS_BYTES, stream, a);
        hipLaunchKernelGGL(ck_diff, dim3(1024), dim3(256), 0, stream, (const bf16_t*)((char*)d_ws + MK_HOLE_BUF), (const bf16_t*)SAVE, (size_t)SEQ * MK_HOLE_LD, res);
        hipLaunchKernelGGL(ck_diff_final, dim3(1024), dim3(256), 0, stream, (const unsigned long long*)res, (float*)d_out, (size_t)SEQ * DM, MK_HOLE_LD);
    }
#elif MK_DIAG == 2
    {
        unsigned long long* res = (unsigned long long*)((char*)d_ws + 65536);
        (void)hipMemsetAsync((char*)d_ws + MiB, 0xAA, WS_END - MiB, stream);
        (void)hipMemsetAsync((char*)d_ws + 65536 + 8, 0xFF, 8, stream);
        a.ph_lo = 0; a.ph_hi = 1; hipLaunchKernelGGL(mk_fwd, dim3(grid), dim3(512), LDS_BYTES, stream, a);
        (void)hipMemsetAsync((char*)d_ws + MK_HOLE_BUF, 0xFF, (size_t)SEQ * MK_HOLE_LD * 2, stream);
        a.ph_lo = 1; a.ph_hi = 2; hipLaunchKernelGGL(mk_fwd, dim3(grid), dim3(512), LDS_BYTES, stream, a);
        hipLaunchKernelGGL(ck_holes, dim3(1024), dim3(256), 0, stream, (const bf16_t*)((char*)d_ws + MK_HOLE_BUF), (size_t)SEQ * MK_HOLE_LD, res);
        hipLaunchKernelGGL(ck_holes_final, dim3(1024), dim3(256), 0, stream, (const unsigned long long*)res, (float*)d_out, (size_t)SEQ * DM, MK_HOLE_MODE);
    }
#elif MK_DIAG
    {
        static const CkBuf B0[] = {
            {0, 0, WS_LOWER, 4096, 0}, {0, 1, WS_SSQ, 8192, 0}, {0, 2, WS_XGA, (size_t)SEQ * DM, 1}, {0, 3, WS_PB, (size_t)2 * SEQ * PLE, 1}, {0, 4, WS_WIN, (size_t)2 * NIN * DM, 1},
            {0, 5, WS_WA, (size_t)2 * DM * HW, 1}, {0, 6, WS_WB, (size_t)2 * DM * HW, 1}, {0, 7, WS_WO, (size_t)2 * DM * DM, 1}, {0, 8, WS_WG, (size_t)2 * DM * DM, 1}, {0, 9, WS_WP, (size_t)2 * DM * PLE, 1} };
        static const CkBuf BL[] = {
            {0, 10, WS_QH, (size_t)SEQ * HW, 1}, {0, 11, WS_VH, (size_t)SEQ * HW, 1}, {0, 12, WS_KF, (size_t)SEQ * HW, 1}, {0, 13, WS_KB, (size_t)SEQ * HW, 1}, {0, 14, WS_HG, (size_t)SEQ * HW, 1},
            {0, 15, WS_NQ, (size_t)SEQ * HW, 1}, {0, 16, WS_NK, (size_t)SEQ * HW, 1}, {0, 17, WS_VT, (size_t)SEQ * HW, 1}, {0, 18, WS_NG, (size_t)SEQ * HW, 1}, {0, 19, WS_GF, (size_t)SEQ * HW, 0},
            {0, 20, WS_GB, (size_t)SEQ * HW, 0}, {0, 21, WS_MA, (size_t)SEQ * DM, 1}, {0, 22, WS_MB, (size_t)SEQ * DM, 1},
            {1, 23, WS_LT, (size_t)2048 * 16384, 0}, {1, 24, WS_DD, (size_t)2048 * 128, 0}, {1, 25, WS_EE, (size_t)2048 * 128, 0}, {1, 26, WS_OB, (size_t)SEQ * HW, 1},
            {2, 27, WS_SP, (size_t)2048 * 16384, 1}, {3, 28, WS_OA, (size_t)SEQ * HW, 1}, {4, 29, WS_T, (size_t)SEQ * DM, 0}, {4, 30, WS_Y, (size_t)SEQ * DM, 1},
            {5, 31, WS_X1, (size_t)SEQ * DM, 0}, {5, 32, WS_XGB, (size_t)SEQ * DM, 1}, {6, 34, WS_PL, (size_t)SEQ * DM, 0}, {6, 35, (size_t)-1, (size_t)SEQ * DM, 0} };
        const int NS = 80;
        double* sums = (double*)((char*)d_ws + 65536);
        (void)hipMemsetAsync((char*)d_ws + MiB, 0xAA, WS_END - MiB, stream);
        for (int run = 0; run < 2; ++run) {
            (void)hipMemsetAsync((char*)d_ws + WS_CTL, 0, 32768, stream);
            for (int ph = 0; ph < NPHASE; ++ph) {
                a.ph_lo = ph; a.ph_hi = ph + 1; hipLaunchKernelGGL(mk_fwd, dim3(grid), dim3(512), LDS_BYTES, stream, a);
                if (ph == 0) { for (const CkBuf& b : B0) hipLaunchKernelGGL(ck_sum, dim3(1024), dim3(256), 0, stream, (const void*)((char*)d_ws + b.off), b.n, b.kind, sums + 2 * (run * NS + b.idx)); }
                else { const int l = (ph - 1) / 7, k = (ph - 1) % 7;
                    for (const CkBuf& b : BL) if (b.phase == k) hipLaunchKernelGGL(ck_sum, dim3(1024), dim3(256), 0, stream, b.off == (size_t)-1 ? (const void*)d_out : (const void*)((char*)d_ws + b.off), b.n, b.kind, sums + 2 * (run * NS + b.idx + 40 * l)); }
            }
        }
        hipLaunchKernelGGL(ck_final, dim3(1024), dim3(256), 0, stream, (const double*)sums, (float*)d_out, (size_t)SEQ * DM, NS);
    }
#elif MK_MULTI
    for (int ph = 0; ph < NPHASE; ++ph) { a.ph_lo = ph; a.ph_hi = ph + 1; hipLaunchKernelGGL(mk_fwd, dim3(grid), dim3(512), LDS_BYTES, stream, a); }
#else
    a.ph_lo = 0; a.ph_hi = NPHASE; hipLaunchKernelGGL(mk_fwd, dim3(grid), dim3(512), LDS_BYTES, stream, a);
#endif
}
```

```cpp
#include <hip/hip_runtime.h>
#include <cstdio>
#include <cstdint>

#ifndef MK_ALIGN
#define MK_ALIGN true
#endif
#ifndef MK_SP2
#define MK_SP2 true
#endif
#ifndef MK_TS
#define MK_TS 0
#endif
#ifndef MK_TS_A
#define MK_TS_A 0
#define MK_TS_B 1
#endif
#ifndef MK_REP_PHASE
#define MK_REP_PHASE -1
#endif
#ifndef MK_REP_DUMMY
#define MK_REP_DUMMY 0
#endif
#ifndef MK_REP_N
#define MK_REP_N 3
#endif
#ifndef MK_ENDFLUSH
#define MK_ENDFLUSH 0
#endif
#ifndef MK_MULTI
#define MK_MULTI 0
#endif

#define LAS __attribute__((address_space(3)))
typedef unsigned short bf16_t;
typedef short bf16x8 __attribute__((ext_vector_type(8)));
typedef float f32x4 __attribute__((ext_vector_type(4)));
typedef float f32x2 __attribute__((ext_vector_type(2)));
typedef unsigned u32x4 __attribute__((ext_vector_type(4)));
typedef unsigned u32x2 __attribute__((ext_vector_type(2)));

constexpr int SEQ = 8192, DM = 2048, NIN = 13312, HW = 1024, PLE = 256;
constexpr float EPS = 1e-6f;
constexpr int NPHASE = 15;

constexpr size_t MiB = 1u << 20;
constexpr size_t WS_CTL = 0, CTL_ZERO_BYTES = 1 * MiB;
constexpr size_t WS_LOWER = 1 * MiB;
constexpr size_t WS_SSQ = 1 * MiB + 64 * 1024;
constexpr size_t WS_DD = 2 * MiB;
constexpr size_t WS_EE = 3 * MiB;
constexpr size_t WS_WIN = 4 * MiB;
constexpr size_t WS_WA = 108 * MiB;
constexpr size_t WS_WB = 116 * MiB;
constexpr size_t WS_WO = 124 * MiB;
constexpr size_t WS_WG = 140 * MiB;
constexpr size_t WS_WP = 156 * MiB;
constexpr size_t WS_PB = 158 * MiB;
constexpr size_t WS_XGA = 166 * MiB;
constexpr size_t WS_XGB = 198 * MiB;
constexpr size_t WS_QH = 230 * MiB;
constexpr size_t WS_VH = 246 * MiB;
constexpr size_t WS_KF = 262 * MiB;
constexpr size_t WS_KB = 278 * MiB;
constexpr size_t WS_HG = 294 * MiB;
constexpr size_t WS_NQ = 310 * MiB;
constexpr size_t WS_NK = 326 * MiB;
constexpr size_t WS_VT = 342 * MiB;
constexpr size_t WS_NG = 358 * MiB;
constexpr size_t WS_OA = 374 * MiB;
constexpr size_t WS_OB = 390 * MiB;
constexpr size_t WS_GF = 406 * MiB;
constexpr size_t WS_GB = 438 * MiB;
constexpr size_t WS_MA = 470 * MiB;
constexpr size_t WS_MB = 502 * MiB;
constexpr size_t WS_LT = 534 * MiB;
constexpr size_t WS_SP = 662 * MiB;
constexpr size_t WS_PL = 726 * MiB;
constexpr size_t WS_END = 758 * MiB;
constexpr size_t WS_T = WS_LT;
constexpr size_t WS_Y = WS_SP;

constexpr int LDS_BYTES = 147456;
constexpr int LDS_MISC_OFF = 131072;

typedef __bf16 bf16x2_t __attribute__((ext_vector_type(2)));
__device__ __forceinline__ unsigned cvt_pk_bf16(float lo, float hi) { bf16x2_t v = {(__bf16)lo, (__bf16)hi}; return __builtin_bit_cast(unsigned, v); }
__device__ __forceinline__ float bf2f(unsigned short b) { return __uint_as_float(((unsigned)b) << 16); }
__device__ __forceinline__ float bflo(unsigned w) { return __uint_as_float(w << 16); }
__device__ __forceinline__ float bfhi(unsigned w) { return __uint_as_float(w & 0xffff0000u); }
__device__ __forceinline__ unsigned short f2bf1(float f) { return (unsigned short)(cvt_pk_bf16(f, 0.f) & 0xffffu); }
__device__ __forceinline__ float fast_rcp(float x) { return __builtin_amdgcn_rcpf(x); }
__device__ __forceinline__ float sigmoid_f(float x) { return fast_rcp(1.f + __expf(-x)); }
__device__ __forceinline__ float silu_f(float x) { return x * sigmoid_f(x); }

__device__ __forceinline__ int opaque_tid(int wid_s) { int lane; asm volatile("v_mbcnt_lo_u32_b32 %0, -1, 0\n\tv_mbcnt_hi_u32_b32 %0, -1, %0" : "=v"(lane)); asm volatile("" : "+s"(wid_s)); return wid_s * 64 + lane; }
__device__ __forceinline__ unsigned char* opaque_ptr(unsigned char* p) { asm volatile("" : "+s"(p)); return p; }
__device__ __forceinline__ int opaque_bid() { int b = blockIdx.x; asm volatile("" : "+s"(b)); return b; }
namespace pg8 {
#define PG8_LAS __attribute__((address_space(3)))
constexpr int BM = 256, BK = 64, HALF = 128, HTB = HALF * BK * 2, STAGE_BYTES = 8 * HTB, NXCD = 8, WGM = 8;
__host__ __device__ __forceinline__ int lds_byte(int r, int c) { const int st = (r >> 4) * 2 + (c >> 5), rr = r & 15, cc = c & 31, ob = rr * 64 + cc * 2; return st * 1024 + (ob ^ (((ob >> 9) & 1) << 5)); }
__host__ __device__ __forceinline__ void stage_rc(int b, int& R, int& C) { const int st = b / 1024, sb = b % 1024, swz = sb ^ (((sb >> 9) & 1) << 5); R = (st >> 1) * 16 + swz / 64; C = (st & 1) * 32 + (swz % 64) / 2; }
__host__ __device__ __forceinline__ int perm32(int rho) { const int n = rho >> 4, i = rho & 15; return 8 * (i >> 2) + 4 * n + (i & 3); }

struct Unit { int pm, pn; };
struct Gemm { const bf16_t* A; const bf16_t* Bt; int M, N, K; };

struct StaticOrder {
    int nM, nN, nwg, G, c;
    __host__ __device__ void init(int M, int N, int G_, int c_) { nM = M / BM; nN = N / BM; nwg = nM * nN; G = G_; c = c_; }
    __host__ __device__ bool next(int i, Unit& u) const {
        const long L = (long)i * G + c; if (L >= nwg) return false;
        int wgid = (int)L; { const int q = nwg / NXCD, r = nwg % NXCD, xcd = wgid % NXCD, off = wgid / NXCD; wgid = (xcd < r ? xcd * (q + 1) : r * (q + 1) + (xcd - r) * q) + off; }
        const int nig = WGM * nN, gid = wgid / nig, fm = gid * WGM, gsz = (nM - fm) < WGM ? (nM - fm) : WGM;
        u.pm = fm + ((wgid % nig) % gsz); u.pn = (wgid % nig) / gsz; return true;
    }
    __device__ __forceinline__ void a_ready(const Unit&) const {}
    __device__ __forceinline__ void done(const Unit&) const {}
};

template <class Epi, class Sched, bool ALIGN_EPI = MK_ALIGN, bool SP2 = MK_SP2>
__device__ __forceinline__ void gemm_phase(PG8_LAS unsigned char* lds, const Gemm g, const Sched& S, const Epi& E, int wid_s) {
    const int tid = opaque_tid(wid_s), wid = __builtin_amdgcn_readfirstlane(tid >> 6), lane = tid & 63, wr = wid >> 2, wc = wid & 3, fr = lane & 15, fq = lane >> 4;
    const int K = g.K, nt = K / BK;
    unsigned voffA[2], voffB[2];
#pragma unroll
    for (int i = 0; i < 2; ++i) { int R, C; stage_rc(tid * 16 + i * 8192, R, C); const int Rb = Epi::PERM ? ((R & ~31) + perm32(R & 31)) : R;
        voffA[i] = (unsigned)(R * K + C) * 2u; voffB[i] = (unsigned)(Rb * K + C) * 2u; }
    const size_t kstep = (size_t)(BK * 2);
    const size_t hstep = (size_t)HALF * K * 2;
    const size_t tstep = 2 * hstep;
    const unsigned ldsw = (unsigned)wid * 1024u;
    const int aoff = lds_byte(wr * 64 + fr, fq * 8), boff = lds_byte(wc * 32 + fr, fq * 8);
#define PG8_SA(b, h) (((b) * 2 + (h)) * HTB)
#define PG8_SB(b, h) ((4 + (b) * 2 + (h)) * HTB)
#define PG8_STAGE(bufoff, gbase, voff) do { _Pragma("unroll") for (int _i = 0; _i < 2; ++_i) \
        __builtin_amdgcn_global_load_lds((const unsigned*)((const char*)(gbase) + (voff)[_i]), (PG8_LAS unsigned*)(lds + (bufoff) + ldsw + _i * 8192), 16, 0, 0); } while (0)
#define PG8_LDA(dst, b, h) do { _Pragma("unroll") for (int m = 0; m < 4; ++m) _Pragma("unroll") for (int k = 0; k < 2; ++k) dst[m][k] = *(const PG8_LAS bf16x8*)(lds + PG8_SA(b, h) + aoff + m * 2048 + k * 1024); } while (0)
#define PG8_LDB(dst, b, h) do { _Pragma("unroll") for (int n = 0; n < 2; ++n) _Pragma("unroll") for (int k = 0; k < 2; ++k) dst[n][k] = *(const PG8_LAS bf16x8*)(lds + PG8_SB(b, h) + boff + n * 2048 + k * 1024); } while (0)
#define PG8_MMA(ai, bj, At, Bt) do { __builtin_amdgcn_s_setprio(1); _Pragma("unroll") for (int m = 0; m < 4; ++m) _Pragma("unroll") for (int n = 0; n < 2; ++n) _Pragma("unroll") for (int k = 0; k < 2; ++k) \
        acc[ai][bj][m][n] = __builtin_amdgcn_mfma_f32_16x16x32_bf16(Bt[n][k], At[m][k], acc[ai][bj][m][n], 0, 0, 0); __builtin_amdgcn_s_setprio(0); } while (0)
#define PG8_WAIT_V(n) asm volatile("s_waitcnt vmcnt(" #n ")" ::: "memory")
#define PG8_WAIT_L(n) asm volatile("s_waitcnt lgkmcnt(" #n ")" ::: "memory")
#define PG8_BAR __builtin_amdgcn_s_barrier()
#define PG8_SCHED __builtin_amdgcn_sched_barrier(0)
    Unit cur, nxt; int ui = 0;
    if (!S.next(0, cur)) return;
    f32x4 acc[2][2][4][2];
#pragma unroll
    for (int a = 0; a < 2; ++a)
#pragma unroll
        for (int b = 0; b < 2; ++b)
#pragma unroll
            for (int m = 0; m < 4; ++m)
#pragma unroll
                for (int n = 0; n < 2; ++n) acc[a][b][m][n] = (f32x4){0.f, 0.f, 0.f, 0.f};
    bf16x8 At[4][2], B0[2][2], B1[2][2];
    const char* cA = (const char*)g.A + (size_t)cur.pm * tstep; const char* cB = (const char*)g.Bt + (size_t)cur.pn * tstep;
    S.a_ready(cur);
    if constexpr (SP2) {
        PG8_STAGE(PG8_SB(0, 0), cB, voffB); PG8_STAGE(PG8_SB(0, 1), cB + hstep, voffB); PG8_STAGE(PG8_SA(0, 0), cA, voffA); PG8_STAGE(PG8_SA(0, 1), cA + hstep, voffA);
        if (wr == 1) PG8_BAR;
        PG8_WAIT_V(2); PG8_BAR;
        PG8_STAGE(PG8_SB(1, 0), cB + kstep, voffB); PG8_STAGE(PG8_SA(1, 0), cA + kstep, voffA); PG8_STAGE(PG8_SB(1, 1), cB + hstep + kstep, voffB);
        PG8_WAIT_V(6); PG8_BAR;
    } else {
        PG8_STAGE(PG8_SB(0, 0), cB, voffB); PG8_STAGE(PG8_SA(0, 0), cA, voffA); PG8_STAGE(PG8_SB(0, 1), cB + hstep, voffB); PG8_STAGE(PG8_SA(0, 1), cA + hstep, voffA);
        if (wr == 1) PG8_BAR;
        PG8_WAIT_V(4); PG8_BAR;
        PG8_STAGE(PG8_SB(1, 0), cB + kstep, voffB); PG8_STAGE(PG8_SA(1, 0), cA + kstep, voffA); PG8_STAGE(PG8_SB(1, 1), cB + hstep + kstep, voffB);
        PG8_WAIT_V(6); PG8_BAR;
    }
    for (;;) {
        const bool has_next = S.next(ui + 1, nxt);
        const char* nA = has_next ? (const char*)g.A + (size_t)nxt.pm * tstep : cA; const char* nB = has_next ? (const char*)g.Bt + (size_t)nxt.pn * tstep : cB;
        for (int t = 0; t < nt; t += 2) {
            const bool last = (t == nt - 2);
            const char* a1 = cA + (size_t)(t + 1) * kstep;
            const char* a2 = last ? nA : cA + (size_t)(t + 2) * kstep; const char* b2 = last ? nB : cB + (size_t)(t + 2) * kstep;
            const char* a3 = a2 + kstep; const char* b3 = b2 + kstep;
            if (last && has_next) S.a_ready(nxt);
            if constexpr (SP2) {
            PG8_LDB(B0, 0, 0); PG8_LDB(B1, 0, 1); PG8_SCHED; PG8_LDA(At, 0, 0); PG8_STAGE(PG8_SA(1, 1), a1 + hstep, voffA);
            PG8_WAIT_V(8); PG8_WAIT_L(0); PG8_BAR; PG8_MMA(0, 0, At, B0); PG8_MMA(0, 1, At, B1); PG8_BAR; PG8_SCHED;
            PG8_LDA(At, 0, 1); PG8_STAGE(PG8_SB(0, 0), b2, voffB); PG8_STAGE(PG8_SB(0, 1), b2 + hstep, voffB); PG8_STAGE(PG8_SA(0, 0), a2, voffA);
            PG8_WAIT_V(8); PG8_WAIT_L(0); PG8_BAR; PG8_MMA(1, 0, At, B0); PG8_MMA(1, 1, At, B1); PG8_BAR; PG8_SCHED;
            PG8_LDB(B0, 1, 0); PG8_LDB(B1, 1, 1); PG8_SCHED; PG8_LDA(At, 1, 0); PG8_STAGE(PG8_SA(0, 1), a2 + hstep, voffA);
            PG8_WAIT_V(8); PG8_WAIT_L(0); PG8_BAR; PG8_MMA(0, 0, At, B0); PG8_MMA(0, 1, At, B1); PG8_BAR; PG8_SCHED;
            PG8_LDA(At, 1, 1); PG8_STAGE(PG8_SB(1, 0), b3, voffB); PG8_STAGE(PG8_SB(1, 1), b3 + hstep, voffB); PG8_STAGE(PG8_SA(1, 0), a3, voffA);
            PG8_WAIT_V(8); PG8_WAIT_L(0); PG8_BAR; PG8_MMA(1, 0, At, B0); PG8_MMA(1, 1, At, B1); PG8_BAR; PG8_SCHED;
            } else {
            PG8_LDB(B0, 0, 0); PG8_SCHED; PG8_LDA(At, 0, 0); PG8_STAGE(PG8_SA(1, 1), a1 + hstep, voffA);
            PG8_WAIT_L(8); PG8_BAR; PG8_WAIT_L(0); PG8_MMA(0, 0, At, B0); PG8_BAR; PG8_SCHED;
            PG8_LDB(B1, 0, 1); PG8_STAGE(PG8_SB(0, 0), b2, voffB);
            PG8_BAR; PG8_WAIT_L(0); PG8_MMA(0, 1, At, B1); PG8_BAR;
            PG8_LDA(At, 0, 1); PG8_STAGE(PG8_SA(0, 0), a2, voffA);
            PG8_BAR; PG8_WAIT_L(0); PG8_MMA(1, 0, At, B0); PG8_BAR; PG8_SCHED;
            PG8_STAGE(PG8_SB(0, 1), b2 + hstep, voffB);
            PG8_WAIT_V(6); PG8_BAR; PG8_MMA(1, 1, At, B1); PG8_BAR;
            PG8_LDB(B0, 1, 0); PG8_SCHED; PG8_LDA(At, 1, 0); PG8_STAGE(PG8_SA(0, 1), a2 + hstep, voffA);
            PG8_WAIT_L(8); PG8_BAR; PG8_WAIT_L(0); PG8_MMA(0, 0, At, B0); PG8_BAR; PG8_SCHED;
            PG8_LDB(B1, 1, 1); PG8_STAGE(PG8_SB(1, 0), b3, voffB);
            PG8_BAR; PG8_WAIT_L(0); PG8_MMA(0, 1, At, B1); PG8_BAR;
            PG8_LDA(At, 1, 1); PG8_STAGE(PG8_SA(1, 0), a3, voffA);
            PG8_BAR; PG8_WAIT_L(0); PG8_MMA(1, 0, At, B0); PG8_BAR; PG8_SCHED;
            PG8_STAGE(PG8_SB(1, 1), b3 + hstep, voffB);
            PG8_WAIT_V(6); PG8_BAR; PG8_MMA(1, 1, At, B1); PG8_BAR;
            }
        }
        if constexpr (ALIGN_EPI) { if (wr == 0) PG8_BAR; }
        { const int t2 = opaque_tid(wid_s), w2 = __builtin_amdgcn_readfirstlane(t2 >> 6); E(acc, cur, w2 >> 2, w2 & 3, t2 & 15, (t2 & 63) >> 4); }
        if (!has_next) break;
#pragma unroll
        for (int a = 0; a < 2; ++a)
#pragma unroll
            for (int b = 0; b < 2; ++b)
#pragma unroll
                for (int m = 0; m < 4; ++m)
#pragma unroll
                    for (int n = 0; n < 2; ++n) acc[a][b][m][n] = (f32x4){0.f, 0.f, 0.f, 0.f};
        cur = nxt; cA = nA; cB = nB; ++ui;
        if constexpr (ALIGN_EPI) { if (wr == 1) PG8_BAR; }
    }
    PG8_WAIT_V(0);
    if constexpr (!ALIGN_EPI) { if (wr == 0) PG8_BAR; }
    PG8_BAR;
#undef PG8_SA
#undef PG8_SB
#undef PG8_STAGE
#undef PG8_LDA
#undef PG8_LDB
#undef PG8_MMA
#undef PG8_WAIT_V
#undef PG8_WAIT_L
#undef PG8_BAR
#undef PG8_SCHED
}
}

typedef f32x4 AccT[2][2][4][2];

#define GAS __attribute__((address_space(1)))
__device__ __forceinline__ void store8_bf16(bf16_t* p, const float (&v)[8]) {
    u32x4 w; w.x = cvt_pk_bf16(v[0], v[1]); w.y = cvt_pk_bf16(v[2], v[3]); w.z = cvt_pk_bf16(v[4], v[5]); w.w = cvt_pk_bf16(v[6], v[7]);
    *(GAS u32x4*)p = w;
}
__device__ __forceinline__ void cvt8_bf16(const u32x4 w, float (&v)[8]) {
    v[0] = bflo(w.x); v[1] = bfhi(w.x); v[2] = bflo(w.y); v[3] = bfhi(w.y); v[4] = bflo(w.z); v[5] = bfhi(w.z); v[6] = bflo(w.w); v[7] = bfhi(w.w);
}
__device__ __forceinline__ u32x4 ldg16(const void* p) { return *(const GAS u32x4*)p; }
__device__ __forceinline__ f32x4 ldgf4(const float* p) { return *(const GAS f32x4*)p; }
__device__ __forceinline__ float ldgf(const float* p) { return *(const GAS float*)p; }
__device__ __forceinline__ void load8_bf16(const bf16_t* p, float (&v)[8]) { cvt8_bf16(ldg16(p), v); }
__device__ __forceinline__ void store8_f32(float* p, const float (&v)[8]) {
    *(GAS f32x4*)p = (f32x4){v[0], v[1], v[2], v[3]}; *(GAS f32x4*)(p + 4) = (f32x4){v[4], v[5], v[6], v[7]};
}
__device__ __forceinline__ void load8_f32(const float* p, float (&v)[8]) {
    const f32x4 a = ldgf4(p), b = ldgf4(p + 4);
    v[0] = a[0]; v[1] = a[1]; v[2] = a[2]; v[3] = a[3]; v[4] = b[0]; v[5] = b[1]; v[6] = b[2]; v[7] = b[3];
}
__device__ __forceinline__ void acc8(const AccT& acc, int ai, int bj, int m, float (&v)[8]) {
    const f32x4 a = acc[ai][bj][m][0], b = acc[ai][bj][m][1];
    v[0] = a[0]; v[1] = a[1]; v[2] = a[2]; v[3] = a[3]; v[4] = b[0]; v[5] = b[1]; v[6] = b[2]; v[7] = b[3];
}
#define EPI_FENCE() asm volatile("" ::: "memory")
__device__ __forceinline__ void load_rs8(const float* ssq, int row0, float (&rs)[8]) {
#pragma unroll
    for (int i = 0; i < 8; ++i) rs[i] = ldgf(ssq + row0 + (i >> 2) * 128 + (i & 3) * 16);
#pragma unroll
    for (int i = 0; i < 8; ++i) rs[i] = rsqrtf(rs[i] * (1.0f / DM) + EPS);
}

template <int ACT> __device__ __forceinline__ void epi_plain(const AccT& acc, const float (&rs)[8], bf16_t* dst, int ld, int row0, int c0) {
#pragma unroll
    for (int ai = 0; ai < 2; ++ai)
#pragma unroll
        for (int m = 0; m < 4; ++m) {
            const int row = row0 + ai * 128 + m * 16; const float r = rs[ai * 4 + m];
#pragma unroll
            for (int bj = 0; bj < 2; ++bj) { float v[8]; acc8(acc, ai, bj, m, v);
#pragma unroll
                for (int e = 0; e < 8; ++e) { float z = v[e] * r; if (ACT == 1) z = silu_f(z); if (ACT == 2) z = sigmoid_f(z); v[e] = z; }
                store8_bf16(dst + (size_t)row * ld + c0 + bj * 128, v); }
        }
}
struct EpiInProj {
    static constexpr bool PERM = true;
    const float* ssq; const float* lower; unsigned char* ws;
    __device__ __forceinline__ void operator()(const AccT& acc, const pg8::Unit& u, int wr, int wc, int fr, int fq) const {
        const int colt = u.pn * 256, seg = colt >> 10;
        const int row0 = u.pm * 256 + wr * 64 + fr;
        const int cin = wc * 32 + 8 * fq;
        const int cseg = (colt & 1023) + cin;
        float rs[8]; load_rs8(ssq, row0, rs);
        if (seg == 2 || seg == 3) {
            const int dir = seg - 2;
            float* G = (float*)(ws + (dir ? WS_GB : WS_GF)); bf16_t* KK = (bf16_t*)(ws + (dir ? WS_KB : WS_KF));
#pragma unroll
            for (int bj = 0; bj < 2; ++bj) {
                const int c = cseg + bj * 128; float lb[8]; load8_f32(lower + dir * 1024 + c, lb);
#pragma unroll
                for (int ai = 0; ai < 2; ++ai)
#pragma unroll
                    for (int m = 0; m < 4; ++m) {
                        const int row = row0 + ai * 128 + m * 16; const float r = rs[ai * 4 + m];
                        float v[8], lg[8], kk[8]; acc8(acc, ai, bj, m, v);
#pragma unroll
                        for (int e = 0; e < 8; ++e) { const float z = v[e] * r; const float sg = sigmoid_f(z); const float f = lb[e] + (1.f - lb[e]) * sg;
                            lg[e] = __logf(fmaxf(f, 1e-6f)); kk[e] = (1.f - lb[e]) * fast_rcp(1.f + __expf(z)); }
                        store8_f32(G + (size_t)row * HW + c, lg); store8_bf16(KK + (size_t)row * HW + c, kk);
                    }
            }
        } else if (seg == 7) {
            bf16_t* VT = (bf16_t*)(ws + WS_VT);
#pragma unroll
            for (int ai = 0; ai < 2; ++ai)
#pragma unroll
                for (int m = 0; m < 4; ++m) {
                    const int row = row0 + ai * 128 + m * 16; const float r = rs[ai * 4 + m];
#pragma unroll
                    for (int bj = 0; bj < 2; ++bj) { float v[8]; acc8(acc, ai, bj, m, v); const int c = cseg + bj * 128;
#pragma unroll
                        for (int e = 0; e < 8; ++e) *(GAS bf16_t*)(VT + (size_t)(c + e) * SEQ + row) = f2bf1(v[e] * r); }
                }
        } else if (seg == 0) epi_plain<1>(acc, rs, (bf16_t*)(ws + WS_QH), HW, row0, cseg);
        else if (seg == 1) epi_plain<0>(acc, rs, (bf16_t*)(ws + WS_VH), HW, row0, cseg);
        else if (seg == 4) epi_plain<1>(acc, rs, (bf16_t*)(ws + WS_HG), HW, row0, cseg);
        else if (seg == 5) epi_plain<0>(acc, rs, (bf16_t*)(ws + WS_NQ), HW, row0, cseg);
        else if (seg == 6) epi_plain<0>(acc, rs, (bf16_t*)(ws + WS_NK), HW, row0, cseg);
        else if (seg == 8) epi_plain<1>(acc, rs, (bf16_t*)(ws + WS_NG), HW, row0, cseg);
        else if (seg < 11) epi_plain<2>(acc, rs, (bf16_t*)(ws + WS_MA), DM, row0, colt - 9216 + cin);
        else epi_plain<2>(acc, rs, (bf16_t*)(ws + WS_MB), DM, row0, colt - 11264 + cin);
    }
};

#define EPI_IT(it, ai, m, bj) const int ai = (it) >> 3, m = ((it) >> 1) & 3, bj = (it) & 1
struct EpiBrA {
    static constexpr bool PERM = true;
    const bf16_t* MA; float* T;
    __device__ __forceinline__ void operator()(const AccT& acc, const pg8::Unit& u, int wr, int wc, int fr, int fq) const {
        const int row0 = u.pm * 256 + wr * 64 + fr, c0 = u.pn * 256 + wc * 32 + 8 * fq;
        u32x4 g[2];
        g[0] = ldg16(MA + (size_t)row0 * DM + c0);
#pragma unroll
        for (int it = 0; it < 16; ++it) { EPI_IT(it, ai, m, bj);
            const size_t off = (size_t)(row0 + ai * 128 + m * 16) * DM + c0 + bj * 128;
            if (it + 1 < 16) { EPI_IT(it + 1, ai2, m2, bj2); g[(it + 1) & 1] = ldg16(MA + (size_t)(row0 + ai2 * 128 + m2 * 16) * DM + c0 + bj2 * 128); }
            float v[8], gg[8]; acc8(acc, ai, bj, m, v); cvt8_bf16(g[it & 1], gg);
#pragma unroll
            for (int e = 0; e < 8; ++e) v[e] *= gg[e];
            store8_f32(T + off, v); EPI_FENCE(); }
    }
};
struct EpiBrB {
    static constexpr bool PERM = true;
    const bf16_t* MB; const float* T; bf16_t* Y;
    __device__ __forceinline__ void operator()(const AccT& acc, const pg8::Unit& u, int wr, int wc, int fr, int fq) const {
        const int row0 = u.pm * 256 + wr * 64 + fr, c0 = u.pn * 256 + wc * 32 + 8 * fq;
        u32x4 g[2]; f32x4 t0[2], t1[2];
        { const size_t o = (size_t)row0 * DM + c0; g[0] = ldg16(MB + o); t0[0] = ldgf4(T + o); t1[0] = ldgf4(T + o + 4); }
#pragma unroll
        for (int it = 0; it < 16; ++it) { EPI_IT(it, ai, m, bj);
            const size_t off = (size_t)(row0 + ai * 128 + m * 16) * DM + c0 + bj * 128;
            if (it + 1 < 16) { EPI_IT(it + 1, ai2, m2, bj2); const size_t o = (size_t)(row0 + ai2 * 128 + m2 * 16) * DM + c0 + bj2 * 128; const int b = (it + 1) & 1;
                g[b] = ldg16(MB + o); t0[b] = ldgf4(T + o); t1[b] = ldgf4(T + o + 4); }
            float v[8], gg[8]; acc8(acc, ai, bj, m, v); cvt8_bf16(g[it & 1], gg); const f32x4 ta = t0[it & 1], tb = t1[it & 1];
#pragma unroll
            for (int e = 0; e < 8; ++e) v[e] = (e < 4 ? ta[e & 3] : tb[e & 3]) + v[e] * gg[e];
            store8_bf16(Y + off, v); EPI_FENCE(); }
    }
};
struct EpiWout {
    static constexpr bool PERM = true;
    const bf16_t* xin; bf16_t* XB1; float* ssq_out;
    __device__ __forceinline__ void operator()(const AccT& acc, const pg8::Unit& u, int wr, int wc, int fr, int fq) const {
        const int row0 = u.pm * 256 + wr * 64 + fr, c0 = u.pn * 256 + wc * 32 + 8 * fq;
        u32x4 xb[2];
        xb[0] = ldg16(xin + (size_t)row0 * DM + c0);
        float s = 0.f;
#pragma unroll
        for (int it = 0; it < 16; ++it) { EPI_IT(it, ai, m, bj);
            const int row = row0 + ai * 128 + m * 16; const size_t off = (size_t)row * DM + c0 + bj * 128;
            if (it + 1 < 16) { EPI_IT(it + 1, ai2, m2, bj2); xb[(it + 1) & 1] = ldg16(xin + (size_t)(row0 + ai2 * 128 + m2 * 16) * DM + c0 + bj2 * 128); }
            float v[8], xi[8]; acc8(acc, ai, bj, m, v); cvt8_bf16(xb[it & 1], xi);
#pragma unroll
            for (int e = 0; e < 8; ++e) { v[e] += xi[e]; s += v[e] * v[e]; }
            store8_bf16(XB1 + off, v);
            if (bj == 1) { s += __shfl_xor(s, 16); s += __shfl_xor(s, 32); if (fq == 0) atomicAdd(ssq_out + row, s); s = 0.f; }
            EPI_FENCE(); }
    }
};
struct EpiDummy {
    static constexpr bool PERM = true;
    bf16_t* D;
    __device__ __forceinline__ void operator()(const AccT& acc, const pg8::Unit& u, int wr, int wc, int fr, int fq) const {
        const int row0 = u.pm * 256 + wr * 64 + fr, c0 = (u.pn & 3) * 256 + wc * 32 + 8 * fq;
#pragma unroll
        for (int ai = 0; ai < 2; ++ai)
#pragma unroll
            for (int m = 0; m < 4; ++m) { const int row = row0 + ai * 128 + m * 16;
#pragma unroll
                for (int bj = 0; bj < 2; ++bj) { float v[8]; acc8(acc, ai, bj, m, v); store8_bf16(D + (size_t)row * HW + c0 + bj * 128, v); } }
    }
};
struct EpiPL {
    static constexpr bool PERM = true;
    bf16_t* PL;
    __device__ __forceinline__ void operator()(const AccT& acc, const pg8::Unit& u, int wr, int wc, int fr, int fq) const {
        const int row0 = u.pm * 256 + wr * 64 + fr, c0 = u.pn * 256 + wc * 32 + 8 * fq;
#pragma unroll
        for (int ai = 0; ai < 2; ++ai)
#pragma unroll
            for (int m = 0; m < 4; ++m) { const int row = row0 + ai * 128 + m * 16;
#pragma unroll
                for (int bj = 0; bj < 2; ++bj) { float v[8]; acc8(acc, ai, bj, m, v); store8_bf16(PL + (size_t)row * DM + c0 + bj * 128, v); } }
    }
};
struct EpiGate {
    static constexpr bool PERM = true;
    const float* ssq1; const bf16_t* XB1; const bf16_t* PL; float* xout; bf16_t* XBN; float* ssq_next; int has_next;
    __device__ __forceinline__ void operator()(const AccT& acc, const pg8::Unit& u, int wr, int wc, int fr, int fq) const {
        const int row0 = u.pm * 256 + wr * 64 + fr, c0 = u.pn * 256 + wc * 32 + 8 * fq;
        u32x4 xb[2], pb[2]; float sq[2];
        { const size_t o = (size_t)row0 * DM + c0; xb[0] = ldg16(XB1 + o); pb[0] = ldg16(PL + o); sq[0] = ldgf(ssq1 + row0); }
        float s = 0.f;
#pragma unroll
        for (int it = 0; it < 16; ++it) { EPI_IT(it, ai, m, bj);
            const int row = row0 + ai * 128 + m * 16; const size_t off = (size_t)row * DM + c0 + bj * 128;
            if (it + 1 < 16) { EPI_IT(it + 1, ai2, m2, bj2); const int rown = row0 + ai2 * 128 + m2 * 16; const size_t o = (size_t)rown * DM + c0 + bj2 * 128; const int b = (it + 1) & 1;
                xb[b] = ldg16(XB1 + o); pb[b] = ldg16(PL + o); sq[b] = ldgf(ssq1 + rown); }
            const float r = rsqrtf(sq[it & 1] * (1.0f / DM) + EPS);
            float v[8], x1[8], pl[8]; acc8(acc, ai, bj, m, v); cvt8_bf16(xb[it & 1], x1); cvt8_bf16(pb[it & 1], pl);
#pragma unroll
            for (int e = 0; e < 8; ++e) { const float g = sigmoid_f(v[e] * r); v[e] = x1[e] + pl[e] * g; s += v[e] * v[e]; }
            if (has_next) { store8_bf16(XBN + off, v);
                if (bj == 1) { s += __shfl_xor(s, 16); s += __shfl_xor(s, 32); if (fq == 0) atomicAdd(ssq_next + row, s); s = 0.f; } }
            else store8_f32(xout + off, v);
            EPI_FENCE(); }
    }
};

#define XB_TMO      128
#define XB_XCNT(j)  (256  + 64 * (j))
#define XB_XSUB(j)  (1280 + 64 * (j))
#define XB_XGEN(j)  (2304 + 64 * (j))
#define XB_TOP      3328
#define XB_TOPGEN   3392
#define XCD_BAR_WORDS 3456
#define XB_SPIN_CAP (1u << 18)
__device__ __forceinline__ unsigned xb_ld(unsigned* p)              { return __hip_atomic_load(p, __ATOMIC_RELAXED, __HIP_MEMORY_SCOPE_AGENT); }
__device__ __forceinline__ unsigned xb_add(unsigned* p, unsigned v) { return __hip_atomic_fetch_add(p, v, __ATOMIC_RELAXED, __HIP_MEMORY_SCOPE_AGENT); }
__device__ __forceinline__ unsigned xb_xcc_id() { return (unsigned)__builtin_amdgcn_s_getreg((3 << 11) | 20) & 0xFu; }
#define XB_SPIN(cond, bar) do { unsigned _sp = 0; while (cond) { __builtin_amdgcn_s_sleep(1); \
    if ((++_sp & 255u) == 0u) { if (xb_ld(&(bar)[XB_TMO])) break; if (_sp > XB_SPIN_CAP) { atomicAdd(&(bar)[XB_TMO], 1u); break; } } } } while (0)
struct XcdBarrier { unsigned* bar; unsigned x; volatile LAS unsigned* st; };
__device__ __forceinline__ XcdBarrier xcd_barrier_post(unsigned* bar, volatile LAS unsigned* st) {
    XcdBarrier b; b.bar = bar; b.x = xb_xcc_id(); b.st = st;
    if (threadIdx.x == 0) (void)xb_add(&bar[XB_XCNT(b.x)], 1u);
    return b;
}
__device__ __forceinline__ void xcd_barrier_complete(unsigned* bar, unsigned x, unsigned& nloc, unsigned& nx) {
    const unsigned G = gridDim.x * gridDim.y * gridDim.z;
    unsigned sum, cnt, mine, sp = 0u;
    for (;;) {
        sum = 0u; cnt = 0u; mine = 0u;
#pragma unroll
        for (unsigned j = 0; j < 16; ++j) { const unsigned c = xb_ld(&bar[XB_XCNT(j)]); sum += c; cnt += (c > 0u) ? 1u : 0u; mine = (j == x) ? c : mine; }
        if (sum == G) break;
        __builtin_amdgcn_s_sleep(1);
        if ((++sp & 255u) == 0u) { if (xb_ld(&bar[XB_TMO])) break; if (sp > XB_SPIN_CAP) { atomicAdd(&bar[XB_TMO], 1u); break; } }
    }
    nloc = mine > 0u ? mine : 1u; nx = cnt > 0u ? cnt : 1u;
}
__device__ __forceinline__ void xcd_barrier(const XcdBarrier& b) {
    asm volatile("s_waitcnt vmcnt(0)" ::: "memory");
    __syncthreads();
    if (threadIdx.x == 0) {
        unsigned* bar = b.bar;
        __builtin_amdgcn_s_waitcnt(0);
        unsigned nloc = b.st[0], nx = b.st[1];
        if (nloc == 0u) { xcd_barrier_complete(bar, b.x, nloc, nx); b.st[0] = nloc; b.st[1] = nx; }
        const unsigned old = xb_add(&bar[XB_XSUB(b.x)], 1u);
        const unsigned gen = old / nloc;
        if (old + 1u == (gen + 1u) * nloc) {
            __builtin_amdgcn_fence(__ATOMIC_RELEASE, "agent");
            asm volatile("s_waitcnt vmcnt(0)" ::: "memory");
            const unsigned og = xb_add(&bar[XB_TOP], 1u);
            const unsigned tg = og / nx;
            if (og + 1u == (tg + 1u) * nx) xb_add(&bar[XB_TOPGEN], 1u);
            else XB_SPIN(xb_ld(&bar[XB_TOPGEN]) == tg, bar);
            __builtin_amdgcn_fence(__ATOMIC_ACQUIRE, "agent");
            xb_add(&bar[XB_XGEN(b.x)], 1u);
            asm volatile("s_waitcnt vmcnt(0)" ::: "memory");
        } else {
            XB_SPIN(xb_ld(&bar[XB_XGEN(b.x)]) == gen, bar);
            __builtin_amdgcn_fence(__ATOMIC_ACQUIRE, "agent");
            asm volatile("s_waitcnt vmcnt(0)" ::: "memory");
        }
    }
    __syncthreads();
}

struct Args { const float* in[15]; float* out; unsigned char* ws; int ph_lo, ph_hi; };

__device__ __forceinline__ void transpose_convert(const float* __restrict__ W, bf16_t* __restrict__ WT, int K, int N, LAS float* tile, int rot, const float* kscale) {
    const int tid = threadIdx.x, nb = gridDim.x; const int bid = (int)((blockIdx.x + (unsigned)rot) % (unsigned)nb);
    const int nkt = K / 64, ntile = nkt * (N / 64);
    for (int t = bid; t < ntile; t += nb) {
        const int tk = t % nkt, tn = t / nkt;
        const float* src = W + (size_t)(tk * 64) * N + tn * 64;
#pragma unroll
        for (int i = 0; i < 2; ++i) { const int idx = tid + i * 512; const int k = idx >> 4, c4 = idx & 15; f32x4 v = ldgf4(src + (size_t)k * N + c4 * 4);
            if (kscale) v = v * ldgf(kscale + tk * 64 + k);
            LAS float* d = tile + k * 65 + c4 * 4; d[0] = v[0]; d[1] = v[1]; d[2] = v[2]; d[3] = v[3]; }
        __syncthreads();
        { const int n = tid >> 3, kq = tid & 7; float v[8];
#pragma unroll
          for (int j = 0; j < 8; ++j) v[j] = tile[(kq * 8 + j) * 65 + n];
          store8_bf16(WT + (size_t)(tn * 64 + n) * K + tk * 64 + kq * 8, v); }
        __syncthreads();
    }
}

__device__ __forceinline__ void p0_prologue(const Args& a, LAS unsigned char* lds) {
    unsigned char* ws = a.ws;
    const int tid = threadIdx.x, bid = blockIdx.x, nb = gridDim.x, gtid = bid * 512 + tid, gsz = nb * 512;
    {
        float* LOWER = (float*)(ws + WS_LOWER); const float* lbp = a.in[4];
        for (int i = gtid; i < 2048; i += gsz) { const float a0 = lbp[i], a1 = lbp[2048 + i]; LOWER[i] = 0.f; LOWER[2048 + i] = 1.f / (1.f + expf(a0 - a1)); }
        float* SSQ = (float*)(ws + WS_SSQ);
        for (int i = gtid; i < 3 * SEQ; i += gsz) SSQ[SEQ + i] = 0.f;
    }
    {
        const float* x = a.in[0]; bf16_t* XG = (bf16_t*)(ws + WS_XGA); float* SSQ = (float*)(ws + WS_SSQ);
        const int lane = tid & 63, gw = gtid >> 6, nw = gsz >> 6;
        for (int row = gw; row < SEQ; row += nw) {
            const f32x4* xr = (const f32x4*)(x + (size_t)row * DM); float s = 0.f;
#pragma unroll
            for (int j = 0; j < 8; ++j) { const f32x4 v = xr[j * 64 + lane];
                s += v[0] * v[0] + v[1] * v[1] + v[2] * v[2] + v[3] * v[3];
                u32x2 w; w.x = cvt_pk_bf16(v[0], v[1]); w.y = cvt_pk_bf16(v[2], v[3]);
                *(u32x2*)(XG + (size_t)row * DM + (j * 64 + lane) * 4) = w; }
#pragma unroll
            for (int o = 32; o >= 1; o >>= 1) s += __shfl_xor(s, o);
            if (lane == 0) SSQ[row] = s;
        }
    }
    {
        const f32x4* p = (const f32x4*)a.in[1]; bf16_t* PB = (bf16_t*)(ws + WS_PB);
        for (int i = gtid; i < 2 * SEQ * PLE / 4; i += gsz) { const f32x4 v = p[i]; u32x2 w; w.x = cvt_pk_bf16(v[0], v[1]); w.y = cvt_pk_bf16(v[2], v[3]); *(u32x2*)(PB + (size_t)i * 4) = w; }
    }
    LAS float* tile = (LAS float*)lds;
    for (int l = 0; l < 2; ++l) {
        transpose_convert(a.in[3] + (size_t)l * DM * NIN, (bf16_t*)(ws + WS_WIN) + (size_t)l * NIN * DM, DM, NIN, tile, 0, a.in[2] + l * DM);
        transpose_convert(a.in[9] + (size_t)l * HW * DM, (bf16_t*)(ws + WS_WA) + (size_t)l * DM * HW, HW, DM, tile, 0, nullptr);
        transpose_convert(a.in[10] + (size_t)l * HW * DM, (bf16_t*)(ws + WS_WB) + (size_t)l * DM * HW, HW, DM, tile, 0, nullptr);
        transpose_convert(a.in[11] + (size_t)l * DM * DM, (bf16_t*)(ws + WS_WO) + (size_t)l * DM * DM, DM, DM, tile, 0, nullptr);
        transpose_convert(a.in[13] + (size_t)l * DM * DM, (bf16_t*)(ws + WS_WG) + (size_t)l * DM * DM, DM, DM, tile, 0, a.in[12] + l * DM);
        transpose_convert(a.in[14] + (size_t)l * PLE * DM, (bf16_t*)(ws + WS_WP) + (size_t)l * DM * PLE, PLE, DM, tile, 128, nullptr);
    }
}

constexpr int HP_ROWB = 272;
constexpr int HT_ROWB = 144;

__device__ __forceinline__ void hg_cumsum(const float (&gv)[16], int seg, int kc, int dir, LAS float* SEGS, float (&b)[16], float& bref, float& blast) {
    float c = 0.f;
#pragma unroll
    for (int i = 0; i < 16; ++i) { c += gv[i]; b[i] = c; }
    const float tot = c;
    if (dir) {
#pragma unroll
        for (int i = 0; i < 16; ++i) b[i] = tot - b[i] + gv[i];
    }
    SEGS[seg * 128 + kc] = tot;
    __syncthreads();
    const float t0 = SEGS[kc], t1 = SEGS[128 + kc], t2 = SEGS[256 + kc], t3 = SEGS[384 + kc];
    float off;
    if (!dir) { off = (seg > 0 ? t0 : 0.f) + (seg > 1 ? t1 : 0.f) + (seg > 2 ? t2 : 0.f); bref = t0 + t1; }
    else      { off = (seg < 3 ? t3 : 0.f) + (seg < 2 ? t2 : 0.f) + (seg < 1 ? t1 : 0.f); bref = t2 + t3; }
    blast = (t0 + t1) + (t2 + t3);
#pragma unroll
    for (int i = 0; i < 16; ++i) b[i] += off;
}
__device__ __forceinline__ unsigned short ldg_u16(const bf16_t* p) { return *(const GAS bf16_t*)p; }

__device__ __forceinline__ void h1_phase(const Args& a, LAS unsigned char* lds, int wid_s) {
    unsigned char* ws = opaque_ptr(a.ws);
    const int tid = opaque_tid(wid_s), lane = tid & 63, w = __builtin_amdgcn_readfirstlane(tid >> 6), fr = lane & 15, fq = lane >> 4;
    const int kc = tid & 127, seg = tid >> 7;
    LAS float* SEGS = (LAS float*)lds; LAS float* SC = (LAS float*)(lds + 2048);
    LAS unsigned char* KpT = lds + 4096; LAS unsigned char* Vt = lds + 4096 + 128 * HT_ROWB;
    const bf16_t* VH = (const bf16_t*)(ws + WS_VH);
    float* LT = (float*)(ws + WS_LT); float* DD = (float*)(ws + WS_DD); float* EE = (float*)(ws + WS_EE);
    float gv[16]; unsigned short kr_[16], vr_[16];
#define H1_FETCH(item_) do { const int d_ = (item_) >> 10, h_ = ((item_) >> 7) & 7, cs_ = (item_) & 127, n_ = d_ ? 127 - cs_ : cs_; \
        const size_t o_ = (size_t)(64 * n_ + 16 * seg) * HW + h_ * 128 + kc; const float* G_ = (const float*)(ws + (d_ ? WS_GB : WS_GF)) + o_; const bf16_t* K_ = (const bf16_t*)(ws + (d_ ? WS_KB : WS_KF)) + o_; \
        _Pragma("unroll") for (int i = 0; i < 16; ++i) { gv[i] = ldgf(G_ + (size_t)i * HW); kr_[i] = ldg_u16(K_ + (size_t)i * HW); vr_[i] = ldg_u16(VH + o_ + (size_t)i * HW); } } while (0)
    int item = blockIdx.x;
    if (item < 2048) H1_FETCH(item);
    for (; item < 2048; item += gridDim.x) {
        const int d = item >> 10;
        float b[16], bref, blast;
        hg_cumsum(gv, seg, kc, d, SEGS, b, bref, blast);
        {
            unsigned kw[8], vw[8];
#pragma unroll
            for (int i = 0; i < 16; i += 2) {
                const float k0 = bf2f(kr_[i]) * __expf(fminf(bref - b[i], 80.f)), k1 = bf2f(kr_[i + 1]) * __expf(fminf(bref - b[i + 1], 80.f));
                kw[i >> 1] = cvt_pk_bf16(k0, k1);
                vw[i >> 1] = (unsigned)vr_[i] | ((unsigned)vr_[i + 1] << 16);
            }
            LAS u32x4* kd = (LAS u32x4*)(KpT + kc * HT_ROWB + seg * 32); kd[0] = (u32x4){kw[0], kw[1], kw[2], kw[3]}; kd[1] = (u32x4){kw[4], kw[5], kw[6], kw[7]};
            LAS u32x4* vd = (LAS u32x4*)(Vt + kc * HT_ROWB + seg * 32); vd[0] = (u32x4){vw[0], vw[1], vw[2], vw[3]}; vd[1] = (u32x4){vw[4], vw[5], vw[6], vw[7]};
            if (seg == 0) { SC[kc] = __expf(blast - bref); *(GAS float*)(DD + (size_t)item * 128 + kc) = __expf(blast); *(GAS float*)(EE + (size_t)item * 128 + kc) = __expf(bref); }
        }
        if (item + (int)gridDim.x < 2048) H1_FETCH(item + (int)gridDim.x);
        __syncthreads();
        {
            const int vt = w;
            bf16x8 bv[2];
#pragma unroll
            for (int ks = 0; ks < 2; ++ks) bv[ks] = *(const LAS bf16x8*)(Vt + (16 * vt + fr) * HT_ROWB + (32 * ks + 8 * fq) * 2);
            float* dst = LT + (size_t)item * 16384 + (size_t)(16 * vt + fr) * 128 + 4 * fq;
#pragma unroll
            for (int kt = 0; kt < 8; ++kt) {
                f32x4 acc = (f32x4){0.f, 0.f, 0.f, 0.f};
#pragma unroll
                for (int ks = 0; ks < 2; ++ks) { const bf16x8 af = *(const LAS bf16x8*)(KpT + (16 * kt + fr) * HT_ROWB + (32 * ks + 8 * fq) * 2);
                    acc = __builtin_amdgcn_mfma_f32_16x16x32_bf16(af, bv[ks], acc, 0, 0, 0); }
                const f32x4 sc = *(const LAS f32x4*)(SC + 16 * kt + 4 * fq);
                *(GAS f32x4*)(dst + 16 * kt) = acc * sc;
            }
        }
        __syncthreads();
    }
#undef H1_FETCH
}

__device__ __forceinline__ void h2_phase(const Args& a, int wid_s) {
    unsigned char* ws = opaque_ptr(a.ws);
    const int tid = opaque_tid(wid_s);
    const float* LT = (const float*)(ws + WS_LT); const float* DD = (const float*)(ws + WS_DD); const float* EE = (const float*)(ws + WS_EE);
    bf16_t* SP = (bf16_t*)(ws + WS_SP);
    for (int u = blockIdx.x; u < 256; u += gridDim.x) {
        const int chain = u >> 4, sub = u & 15;
        const int v = 8 * sub + (tid >> 6), k = 2 * (tid & 63);
        const size_t ibase = (size_t)chain * 128;
        float s0 = 0.f, s1 = 0.f;
        for (int cs0 = 0; cs0 < 128; cs0 += 8) {
            f32x2 lt[8], dd[8], ee[8];
#pragma unroll
            for (int j = 0; j < 8; ++j) { const size_t it = ibase + cs0 + j;
                lt[j] = *(const f32x2*)(LT + it * 16384 + v * 128 + k); dd[j] = *(const f32x2*)(DD + it * 128 + k); ee[j] = *(const f32x2*)(EE + it * 128 + k); }
#pragma unroll
            for (int j = 0; j < 8; ++j) { const size_t it = ibase + cs0 + j;
                *(unsigned*)(SP + it * 16384 + v * 128 + k) = cvt_pk_bf16(s0 * ee[j][0], s1 * ee[j][1]);
                s0 = dd[j][0] * s0 + lt[j][0]; s1 = dd[j][1] * s1 + lt[j][1]; }
        }
    }
}

__device__ __forceinline__ void h3_phase(const Args& a, int layer, LAS unsigned char* lds, int wid_s) {
    unsigned char* ws = opaque_ptr(a.ws);
    const int tid = opaque_tid(wid_s), lane = tid & 63, w = __builtin_amdgcn_readfirstlane(tid >> 6), fr = lane & 15, fq = lane >> 4;
    const int kc = tid & 127, seg = tid >> 7;
    LAS float* SEGS = (LAS float*)lds; LAS float* SSQP = (LAS float*)(lds + 2048);
    LAS unsigned char* Qp = lds + 4096; LAS unsigned char* Kp = Qp + 64 * HP_ROWB; LAS unsigned char* Vt = Kp + 64 * HP_ROWB; LAS unsigned char* Ab = Vt + 128 * HT_ROWB; LAS unsigned char* SPs = Ab + 64 * HT_ROWB;
    const bf16_t* QH = (const bf16_t*)(ws + WS_QH); const bf16_t* VH = (const bf16_t*)(ws + WS_VH); const bf16_t* HG = (const bf16_t*)(ws + WS_HG);
    const bf16_t* SP = (const bf16_t*)(ws + WS_SP); bf16_t* OA = (bf16_t*)(ws + WS_OA);
    const float* onorm = a.in[5] + layer * 128;
    float gv[16]; unsigned short qr_[16], kr_[16], vr_[16]; u32x4 spr[4];
#define H3_FETCH(item_, d_) do { const int n_ = (item_) >> 3, h_ = (item_) & 7, cs_ = (d_) ? 127 - n_ : n_; \
        const size_t o_ = (size_t)(64 * n_ + 16 * seg) * HW + h_ * 128 + kc; const float* G_ = (const float*)(ws + ((d_) ? WS_GB : WS_GF)) + o_; const bf16_t* K_ = (const bf16_t*)(ws + ((d_) ? WS_KB : WS_KF)) + o_; \
        const bf16_t* S_ = SP + (size_t)(((d_) * 8 + h_) * 128 + cs_) * 16384; \
        _Pragma("unroll") for (int i = 0; i < 16; ++i) { gv[i] = ldgf(G_ + (size_t)i * HW); qr_[i] = ldg_u16(QH + o_ + (size_t)i * HW); kr_[i] = ldg_u16(K_ + (size_t)i * HW); vr_[i] = ldg_u16(VH + o_ + (size_t)i * HW); } \
        _Pragma("unroll") for (int i = 0; i < 4; ++i) { const int q_ = tid + 512 * i; spr[i] = ldg16(S_ + (q_ >> 4) * 128 + (q_ & 15) * 8); } } while (0)
    int item = blockIdx.x;
    if (item < 1024) H3_FETCH(item, 0);
    for (; item < 1024; item += gridDim.x) {
        const int n = item >> 3, h = item & 7;
        const int tok0 = 64 * n;
        const int rt = w & 3, vg = w >> 2;
        f32x4 o[4];
#pragma unroll
        for (int j = 0; j < 4; ++j) o[j] = (f32x4){0.f, 0.f, 0.f, 0.f};
        u32x2 hgr[4];
        for (int d = 0; d < 2; ++d) {
            float b[16], bref, blast;
            hg_cumsum(gv, seg, kc, d, SEGS, b, bref, blast);
            {
                unsigned vw[8];
#pragma unroll
                for (int i = 0; i < 16; i += 2) {
                    const float e0 = b[i] - bref, e1 = b[i + 1] - bref;
                    const float q0 = bf2f(qr_[i]) * __expf(fminf(e0, 80.f)), q1 = bf2f(qr_[i + 1]) * __expf(fminf(e1, 80.f));
                    const float k0 = bf2f(kr_[i]) * __expf(fminf(-e0, 80.f)), k1 = bf2f(kr_[i + 1]) * __expf(fminf(-e1, 80.f));
                    *(LAS unsigned short*)(Qp + (16 * seg + i) * HP_ROWB + kc * 2) = f2bf1(q0);
                    *(LAS unsigned short*)(Qp + (16 * seg + i + 1) * HP_ROWB + kc * 2) = f2bf1(q1);
                    *(LAS unsigned short*)(Kp + (16 * seg + i) * HP_ROWB + kc * 2) = f2bf1(k0);
                    *(LAS unsigned short*)(Kp + (16 * seg + i + 1) * HP_ROWB + kc * 2) = f2bf1(k1);
                    vw[i >> 1] = (unsigned)vr_[i] | ((unsigned)vr_[i + 1] << 16);
                }
                LAS u32x4* vd = (LAS u32x4*)(Vt + kc * HT_ROWB + seg * 32); vd[0] = (u32x4){vw[0], vw[1], vw[2], vw[3]}; vd[1] = (u32x4){vw[4], vw[5], vw[6], vw[7]};
#pragma unroll
                for (int i = 0; i < 4; ++i) { const int q = tid + 512 * i; *(LAS u32x4*)(SPs + (q >> 4) * HP_ROWB + (q & 15) * 16) = spr[i]; }
            }
            if (d == 0) H3_FETCH(item, 1);
            else { if (item + (int)gridDim.x < 1024) H3_FETCH(item + (int)gridDim.x, 0);
#pragma unroll
                for (int j = 0; j < 4; ++j) hgr[j] = *(const GAS u32x2*)(HG + (size_t)(tok0 + 16 * rt + fr) * HW + h * 128 + 16 * (4 * vg + j) + 4 * fq); }
            __syncthreads();
            {
                const int art = w >> 1;
#pragma unroll
                for (int tt = 0; tt < 2; ++tt) {
                    const int st = 2 * (w & 1) + tt;
                    const bool need = d ? (st >= art) : (st <= art);
                    f32x4 acc = (f32x4){0.f, 0.f, 0.f, 0.f};
                    if (need) {
#pragma unroll
                        for (int ks = 0; ks < 4; ++ks) {
                            const bf16x8 af = *(const LAS bf16x8*)(Qp + (16 * art + fr) * HP_ROWB + (32 * ks + 8 * fq) * 2);
                            const bf16x8 bfr = *(const LAS bf16x8*)(Kp + (16 * st + fr) * HP_ROWB + (32 * ks + 8 * fq) * 2);
                            acc = __builtin_amdgcn_mfma_f32_16x16x32_bf16(af, bfr, acc, 0, 0, 0);
                        }
                    }
                    const int s_ = 16 * st + fr;
#pragma unroll
                    for (int r = 0; r < 4; ++r) { const int r_ = 16 * art + 4 * fq + r; const bool ok = need && (d ? (s_ >= r_) : (s_ <= r_));
                        *(LAS unsigned short*)(Ab + r_ * HT_ROWB + s_ * 2) = f2bf1(ok ? acc[r] : 0.f); }
                }
            }
            __syncthreads();
            {
                bf16x8 ab[2], qb[4];
#pragma unroll
                for (int ks = 0; ks < 2; ++ks) ab[ks] = *(const LAS bf16x8*)(Ab + (16 * rt + fr) * HT_ROWB + (32 * ks + 8 * fq) * 2);
#pragma unroll
                for (int ks = 0; ks < 4; ++ks) qb[ks] = *(const LAS bf16x8*)(Qp + (16 * rt + fr) * HP_ROWB + (32 * ks + 8 * fq) * 2);
#pragma unroll
                for (int j = 0; j < 4; ++j) {
                    const int vt = 4 * vg + j;
#pragma unroll
                    for (int ks = 0; ks < 2; ++ks) { const bf16x8 af = *(const LAS bf16x8*)(Vt + (16 * vt + fr) * HT_ROWB + (32 * ks + 8 * fq) * 2);
                        o[j] = __builtin_amdgcn_mfma_f32_16x16x32_bf16(af, ab[ks], o[j], 0, 0, 0); }
#pragma unroll
                    for (int ks = 0; ks < 4; ++ks) { const bf16x8 af = *(const LAS bf16x8*)(SPs + (16 * vt + fr) * HP_ROWB + (32 * ks + 8 * fq) * 2);
                        o[j] = __builtin_amdgcn_mfma_f32_16x16x32_bf16(af, qb[ks], o[j], 0, 0, 0); }
                }
            }
            __syncthreads();
        }
        {
            float s = 0.f;
#pragma unroll
            for (int j = 0; j < 4; ++j) s += o[j][0] * o[j][0] + o[j][1] * o[j][1] + o[j][2] * o[j][2] + o[j][3] * o[j][3];
            s += __shfl_xor(s, 16); s += __shfl_xor(s, 32);
            if (fq == 0) SSQP[vg * 64 + 16 * rt + fr] = s;
            __syncthreads();
            const int row = 16 * rt + fr; const float rs = rsqrtf((SSQP[row] + SSQP[64 + row]) * (1.0f / 128.f) + EPS);
#pragma unroll
            for (int j = 0; j < 4; ++j) { const int v0 = 16 * (4 * vg + j) + 4 * fq; const f32x4 on = ldgf4(onorm + v0);
                u32x2 ow; ow.x = cvt_pk_bf16(o[j][0] * rs * on[0] * bflo(hgr[j].x), o[j][1] * rs * on[1] * bfhi(hgr[j].x)); ow.y = cvt_pk_bf16(o[j][2] * rs * on[2] * bflo(hgr[j].y), o[j][3] * rs * on[3] * bfhi(hgr[j].y));
                *(GAS u32x2*)(OA + (size_t)(tok0 + row) * HW + h * 128 + v0) = ow; }
        }
    }
#undef H3_FETCH
}

constexpr int NAT_NB = 36864, NAT_KH = 64 * 272, NAT_VH = 128 * 144;
__device__ __forceinline__ void natten_phase(const Args& a, int layer, LAS unsigned char* lds, int wid_s) {
    unsigned char* ws = opaque_ptr(a.ws);
    const int tid = opaque_tid(wid_s), lane = tid & 63, w = __builtin_amdgcn_readfirstlane(tid >> 6), fr = lane & 15, fq = lane >> 4;
    LAS float* RP = (LAS float*)(lds + 2 * NAT_NB);
    const bf16_t* NQ = (const bf16_t*)(ws + WS_NQ); const bf16_t* NK = (const bf16_t*)(ws + WS_NK); const bf16_t* VT = (const bf16_t*)(ws + WS_VT);
    const bf16_t* NG = (const bf16_t*)(ws + WS_NG); bf16_t* OB = (bf16_t*)(ws + WS_OB);
    const float* gq = a.in[6] + layer * 128; const float* gk = a.in[7] + layer * 128; const float* rpb = a.in[8] + (size_t)layer * 8 * 465;
    for (int it = blockIdx.x; it < 512; it += gridDim.x) {
        const int r = it >> 2, hp = it & 3, hw = w >> 2, h = 2 * hp + hw, j = w & 3;
        const int r_start = min(max(r - 4, 0), 120);
        const bf16_t* ksrc[4]; const bf16_t* vsrc[4]; int kdst[4], vdst[4];
#pragma unroll
        for (int i = 0; i < 4; ++i) { const int q = tid + 512 * i, hd = q >> 10;
            { const int key = (q >> 4) & 63, ch = q & 15; ksrc[i] = NK + (size_t)(64 * r_start + key) * HW + (2 * hp + hd) * 128 + ch * 8; kdst[i] = hd * NAT_KH + key * 272 + ch * 16; }
            { const int d = (q >> 3) & 127, ch = q & 7; vsrc[i] = VT + (size_t)((2 * hp + hd) * 128 + d) * SEQ + 64 * r_start + ch * 8; vdst[i] = hd * NAT_VH + d * 144 + ch * 16; } }
        u32x4 R0[4], R1[4];
#define NAT_LOAD(st, R) do { _Pragma("unroll") for (int i = 0; i < 4; ++i) R[i] = ((st) < 8) ? ldg16(ksrc[i] + (size_t)(st) * 64 * HW) : ldg16(vsrc[i] + ((st) - 8) * 64); } while (0)
#define NAT_WRITE(st, R) do { _Pragma("unroll") for (int i = 0; i < 4; ++i) *(LAS u32x4*)(lds + ((st) & 1) * NAT_NB + (((st) < 8) ? kdst[i] : vdst[i])) = R[i]; } while (0)
        NAT_LOAD(0, R0); NAT_LOAD(1, R1);
        for (int i = tid; i < 930; i += 512) RP[i] = ldgf(rpb + (size_t)(2 * hp) * 465 + i);
        const int c0k = (j == 0) ? 0 : (j == 1) ? 8 : (j == 2) ? 24 : 32;
        const int cq = 16 * j + fr, tq = 64 * r + cq;
        const int cstart = min(max(cq - 8, 0), 48);
        bf16x8 qf[4];
        {
            float qv[4][8]; float ss = 0.f;
#pragma unroll
            for (int ks = 0; ks < 4; ++ks) { load8_bf16(NQ + (size_t)tq * HW + h * 128 + 32 * ks + 8 * fq, qv[ks]);
#pragma unroll
                for (int e = 0; e < 8; ++e) ss += qv[ks][e] * qv[ks][e]; }
            ss += __shfl_xor(ss, 16); ss += __shfl_xor(ss, 32);
            const float rq = rsqrtf(ss * (1.0f / 128.f) + EPS) * 0.08838834764831845f;
#pragma unroll
            for (int ks = 0; ks < 4; ++ks) { float g1[8], g2[8]; load8_f32(gq + 32 * ks + 8 * fq, g1); load8_f32(gk + 32 * ks + 8 * fq, g2);
                u32x4 wv;
                wv.x = cvt_pk_bf16(qv[ks][0] * rq * g1[0] * g2[0], qv[ks][1] * rq * g1[1] * g2[1]); wv.y = cvt_pk_bf16(qv[ks][2] * rq * g1[2] * g2[2], qv[ks][3] * rq * g1[3] * g2[3]);
                wv.z = cvt_pk_bf16(qv[ks][4] * rq * g1[4] * g2[4], qv[ks][5] * rq * g1[5] * g2[5]); wv.w = cvt_pk_bf16(qv[ks][6] * rq * g1[6] * g2[6], qv[ks][7] * rq * g1[7] * g2[7]);
                qf[ks] = __builtin_bit_cast(bf16x8, wv); }
        }
        NAT_WRITE(0, R0);
        __syncthreads();
        float s[8][2][4];
        float mx = -3.0e38f, l = 0.f;
        f32x4 o[8];
#pragma unroll
        for (int dt = 0; dt < 8; ++dt) o[dt] = (f32x4){0.f, 0.f, 0.f, 0.f};
#pragma unroll
        for (int st = 0; st < 16; ++st) {
            if (st + 2 < 16) { if (st & 1) NAT_LOAD(st + 2, R1); else NAT_LOAD(st + 2, R0); }
            LAS unsigned char* buf = lds + (st & 1) * NAT_NB;
            if (st < 8) {
                const int aa = st, kr = r_start + aa, row_off = kr - r + 7;
#pragma unroll
                for (int kt = 0; kt < 2; ++kt) {
                    bf16x8 kf[4]; float ssk = 0.f;
#pragma unroll
                    for (int ks = 0; ks < 4; ++ks) { const u32x4 wv = *(const LAS u32x4*)(buf + hw * NAT_KH + (c0k + 16 * kt + fr) * 272 + (32 * ks + 8 * fq) * 2); kf[ks] = __builtin_bit_cast(bf16x8, wv);
                        ssk += bflo(wv.x) * bflo(wv.x) + bfhi(wv.x) * bfhi(wv.x) + bflo(wv.y) * bflo(wv.y) + bfhi(wv.y) * bfhi(wv.y)
                             + bflo(wv.z) * bflo(wv.z) + bfhi(wv.z) * bfhi(wv.z) + bflo(wv.w) * bflo(wv.w) + bfhi(wv.w) * bfhi(wv.w); }
                    ssk += __shfl_xor(ssk, 16); ssk += __shfl_xor(ssk, 32);
                    const float rk = rsqrtf(ssk * (1.0f / 128.f) + EPS);
                    f32x4 acc = (f32x4){0.f, 0.f, 0.f, 0.f};
#pragma unroll
                    for (int ks = 0; ks < 4; ++ks) acc = __builtin_amdgcn_mfma_f32_16x16x32_bf16(kf[ks], qf[ks], acc, 0, 0, 0);
#pragma unroll
                    for (int rg = 0; rg < 4; ++rg) {
                        const int ki = 4 * fq + rg; const float rki = __shfl(rk, ki);
                        const int kcl = c0k + 16 * kt + ki; const bool valid = (kcl >= cstart) && (kcl < cstart + 16);
                        const int co = min(max(kcl - cq + 15, 0), 30);
                        const float bias = RP[hw * 465 + row_off * 31 + co];
                        const float sv = valid ? (acc[rg] * rki + bias) : -1.0e30f;
                        s[aa][kt][rg] = sv; mx = fmaxf(mx, sv);
                    }
                }
                if (st == 7) {
                    mx = fmaxf(mx, __shfl_xor(mx, 16)); mx = fmaxf(mx, __shfl_xor(mx, 32));
#pragma unroll
                    for (int a2 = 0; a2 < 8; ++a2)
#pragma unroll
                        for (int kt = 0; kt < 2; ++kt)
#pragma unroll
                            for (int rg = 0; rg < 4; ++rg) { const float p = __expf(s[a2][kt][rg] - mx); s[a2][kt][rg] = p; l += p; }
                    l += __shfl_xor(l, 16); l += __shfl_xor(l, 32);
                }
            } else {
                const int aa = st - 8;
                u32x4 pw; pw.x = cvt_pk_bf16(s[aa][0][0], s[aa][0][1]); pw.y = cvt_pk_bf16(s[aa][0][2], s[aa][0][3]); pw.z = cvt_pk_bf16(s[aa][1][0], s[aa][1][1]); pw.w = cvt_pk_bf16(s[aa][1][2], s[aa][1][3]);
                const bf16x8 pb = __builtin_bit_cast(bf16x8, pw);
#pragma unroll
                for (int dt = 0; dt < 8; ++dt) {
                    const LAS unsigned char* vp = buf + hw * NAT_VH + (16 * dt + fr) * 144 + (c0k + 4 * fq) * 2;
                    const u32x2 v0 = *(const LAS u32x2*)vp, v1 = *(const LAS u32x2*)(vp + 32);
                    const u32x4 vw = (u32x4){v0.x, v0.y, v1.x, v1.y};
                    o[dt] = __builtin_amdgcn_mfma_f32_16x16x32_bf16(__builtin_bit_cast(bf16x8, vw), pb, o[dt], 0, 0, 0);
                }
            }
            if (st + 1 < 16) { if (st & 1) NAT_WRITE(st + 1, R0); else NAT_WRITE(st + 1, R1); }
            __syncthreads();
        }
        const float inv = 1.0f / l;
#pragma unroll
        for (int dt = 0; dt < 8; ++dt) {
            const size_t off = (size_t)tq * HW + h * 128 + 16 * dt + 4 * fq;
            const u32x2 gw = *(const GAS u32x2*)(NG + off);
            u32x2 ow; ow.x = cvt_pk_bf16(o[dt][0] * inv * bflo(gw.x), o[dt][1] * inv * bfhi(gw.x)); ow.y = cvt_pk_bf16(o[dt][2] * inv * bflo(gw.y), o[dt][3] * inv * bfhi(gw.y));
            *(GAS u32x2*)(OB + off) = ow;
        }
#undef NAT_LOAD
#undef NAT_WRITE
    }
}

__global__ void __launch_bounds__(512, 2) mk_fwd(Args a) {
    extern __shared__ __attribute__((aligned(16))) unsigned char lds_raw[];
    LAS unsigned char* lds = (LAS unsigned char*)lds_raw;
    volatile LAS unsigned* MISC = (volatile LAS unsigned*)(lds + LDS_MISC_OFF);
    unsigned char* ws = a.ws;
    const int wid_s = __builtin_amdgcn_readfirstlane(threadIdx.x >> 6);
    if (threadIdx.x < 64) MISC[threadIdx.x] = 0u;
    __syncthreads();
    XcdBarrier bar; bar.bar = (unsigned*)(ws + WS_CTL) + 4096; bar.x = 0; bar.st = nullptr;
    const int lo = a.ph_lo, hi = a.ph_hi;
    if (hi - lo > 1) bar = xcd_barrier_post((unsigned*)(ws + WS_CTL) + 4096, MISC + 8);
#ifndef DIAG_MASK
#define DIAG_MASK 0x1ff
#endif
#define DM_(b) ((DIAG_MASK >> (b)) & 1)
#define IN(k) (lo <= (k) && (k) < hi)
#if MK_TS
    unsigned long long* TS = (unsigned long long*)(ws + 131072);
#define STAMP(k) do { if (blockIdx.x == 0 && threadIdx.x == 0) TS[k] = __builtin_amdgcn_s_memrealtime(); } while (0)
#define SEAM(k) do { if (IN(k) && (IN((k) + 1) || (k) == NPHASE - 1)) xcd_barrier(bar); STAMP((k) + 1); } while (0)
    STAMP(0);
#else
#define SEAM(k) do { if (IN(k) && IN((k) + 1)) xcd_barrier(bar); } while (0)
#endif
    const int G = gridDim.x, c = blockIdx.x;

    if (DM_(0) && IN(0)) { for (int rep = 0; rep < (MK_REP_PHASE == 0 ? MK_REP_N : 1); ++rep) { if (rep) xcd_barrier(bar); p0_prologue(a, lds); } }
    SEAM(0);
    for (int l = 0; l < 2; ++l) {
        const int pb = 1 + 7 * l;
        for (int rep = 0; rep < (MK_REP_PHASE == pb + 0 ? MK_REP_N : 1); ++rep) { if (rep) xcd_barrier(bar);
        if (DM_(1) && IN(pb + 0)) {
            unsigned char* ws = opaque_ptr(a.ws); bf16_t* XGA = (bf16_t*)(ws + WS_XGA); float* SSQ = (float*)(ws + WS_SSQ);
            pg8::Gemm g{XGA, (const bf16_t*)(ws + WS_WIN) + (size_t)l * NIN * DM, SEQ, NIN, DM}; pg8::StaticOrder S; S.init(SEQ, NIN, G, c);
            EpiInProj E{SSQ + (2 * l) * SEQ, (const float*)(ws + WS_LOWER) + l * 2048, ws};
            if (MK_REP_DUMMY && rep) { EpiDummy ED{(bf16_t*)(ws + WS_LT)}; pg8::gemm_phase<EpiDummy, pg8::StaticOrder>(lds, g, S, ED, wid_s); } else
            pg8::gemm_phase<EpiInProj, pg8::StaticOrder>(lds, g, S, E, wid_s);
        }
        if (DM_(1) && IN(pb + 0)) {
            unsigned char* ws = opaque_ptr(a.ws);
            const int nfull = (SEQ / 256) * (NIN / 256) % G;
            if (c >= nfull) {
                int kple = PLE; asm volatile("" : "+s"(kple));
                pg8::Gemm g2{(const bf16_t*)(ws + WS_PB) + (size_t)l * SEQ * PLE, (const bf16_t*)(ws + WS_WP) + (size_t)l * DM * PLE, SEQ, DM, kple}; pg8::StaticOrder S2; S2.init(SEQ, DM, G - nfull, c - nfull);
                EpiPL E2{(bf16_t*)(ws + WS_PL)};
                pg8::gemm_phase<EpiPL, pg8::StaticOrder>(lds, g2, S2, E2, wid_s);
            }
        } }
        SEAM(pb + 0);
        if (IN(pb + 1)) { for (int rep = 0; rep < (MK_REP_PHASE == pb + 1 ? MK_REP_N : 1); ++rep) { if (rep) xcd_barrier(bar); if (DM_(2)) h1_phase(a, lds, wid_s); }
            for (int rep = 0; rep < (MK_REP_PHASE == pb + 101 ? MK_REP_N : 1); ++rep) { if (rep) xcd_barrier(bar); if (DM_(8)) natten_phase(a, l, lds, wid_s); } }
        SEAM(pb + 1);
        if (DM_(3) && IN(pb + 2)) { for (int rep = 0; rep < (MK_REP_PHASE == pb + 2 ? MK_REP_N : 1); ++rep) { if (rep) xcd_barrier(bar); h2_phase(a, wid_s); } }
        SEAM(pb + 2);
        if (DM_(4) && IN(pb + 3)) { for (int rep = 0; rep < (MK_REP_PHASE == pb + 3 ? MK_REP_N : 1); ++rep) { if (rep) xcd_barrier(bar); h3_phase(a, l, lds, wid_s); } }
        SEAM(pb + 3);
        for (int rep = 0; rep < (MK_REP_PHASE == pb + 4 ? MK_REP_N : 1); ++rep) { if (rep) xcd_barrier(bar);
        if (DM_(5) && IN(pb + 4)) {
            unsigned char* ws = opaque_ptr(a.ws);
            pg8::StaticOrder S; S.init(SEQ, DM, G, c);
            { pg8::Gemm g{(const bf16_t*)(ws + WS_OA), (const bf16_t*)(ws + WS_WA) + (size_t)l * DM * HW, SEQ, DM, HW};
              EpiBrA E{(const bf16_t*)(ws + WS_MA), (float*)(ws + WS_T)};
              pg8::gemm_phase<EpiBrA, pg8::StaticOrder>(lds, g, S, E, wid_s); }
            { pg8::Gemm g{(const bf16_t*)(ws + WS_OB), (const bf16_t*)(ws + WS_WB) + (size_t)l * DM * HW, SEQ, DM, HW};
              EpiBrB E{(const bf16_t*)(ws + WS_MB), (const float*)(ws + WS_T), (bf16_t*)(ws + WS_Y)};
              pg8::gemm_phase<EpiBrB, pg8::StaticOrder>(lds, g, S, E, wid_s); }
        } }
        SEAM(pb + 4);
        for (int rep = 0; rep < (MK_REP_PHASE == pb + 5 ? MK_REP_N : 1); ++rep) { if (rep) xcd_barrier(bar);
        if (DM_(6) && IN(pb + 5)) {
            unsigned char* ws = opaque_ptr(a.ws); bf16_t* XGB = (bf16_t*)(ws + WS_XGB); float* SSQ = (float*)(ws + WS_SSQ);
            pg8::Gemm g{(const bf16_t*)(ws + WS_Y), (const bf16_t*)(ws + WS_WO) + (size_t)l * DM * DM, SEQ, DM, DM}; pg8::StaticOrder S; S.init(SEQ, DM, G, c);
            EpiWout E{(const bf16_t*)(ws + WS_XGA), XGB, rep ? (float*)(ws + 262144) : SSQ + (2 * l + 1) * SEQ};
            if (MK_REP_DUMMY && rep) { EpiDummy ED{(bf16_t*)(ws + WS_LT)}; pg8::gemm_phase<EpiDummy, pg8::StaticOrder>(lds, g, S, ED, wid_s); } else
            pg8::gemm_phase<EpiWout, pg8::StaticOrder>(lds, g, S, E, wid_s);
        } }
        SEAM(pb + 5);
        for (int rep = 0; rep < (MK_REP_PHASE == pb + 6 ? MK_REP_N : 1); ++rep) { if (rep) xcd_barrier(bar);
        if (DM_(7) && IN(pb + 6)) {
            unsigned char* ws = opaque_ptr(a.ws); bf16_t* XGA = (bf16_t*)(ws + WS_XGA); bf16_t* XGB = (bf16_t*)(ws + WS_XGB); float* SSQ = (float*)(ws + WS_SSQ);
            pg8::StaticOrder S; S.init(SEQ, DM, G, c);
            { pg8::Gemm g{XGB, (const bf16_t*)(ws + WS_WG) + (size_t)l * DM * DM, SEQ, DM, DM};
              EpiGate E{SSQ + (2 * l + 1) * SEQ, XGB, (const bf16_t*)(ws + WS_PL), a.out, XGA, rep ? (float*)(ws + 262144) : SSQ + (2 * l + 2 < 4 ? 2 * l + 2 : 0) * SEQ, l == 0 ? 1 : 0};
              pg8::gemm_phase<EpiGate, pg8::StaticOrder>(lds, g, S, E, wid_s); }
        } }
        SEAM(pb + 6);
    }
#if MK_TS
    if (blockIdx.x == 0) {
        const float dA = (float)(TS[MK_TS_A + 1] - TS[MK_TS_A]) * 0.01f, dB = (float)(TS[MK_TS_B + 1] - TS[MK_TS_B]) * 0.01f;
        for (int i = threadIdx.x; i < 1000000; i += 512) a.out[i] += (i == 0) ? 10.f * dA : 0.3f * dB;
    }
#endif
#undef IN
#undef SEAM
#if MK_ENDFLUSH
    asm volatile("s_waitcnt vmcnt(0)" ::: "memory");
    __builtin_amdgcn_fence(__ATOMIC_RELEASE, "agent");
    asm volatile("s_waitcnt vmcnt(0)" ::: "memory");
#endif
}


#ifndef MK_DIAG
#define MK_DIAG 0
#define MK_HOLE_BUF WS_MB
#define MK_HOLE_LD DM
#define MK_HOLE_MODE 0
#endif
#if MK_DIAG
__global__ void ck_sum(const void* p, size_t n, int kind, double* slot) {
    double s0 = 0.0, s1 = 0.0;
    for (size_t i = (size_t)blockIdx.x * blockDim.x + threadIdx.x; i < n; i += (size_t)gridDim.x * blockDim.x) {
        float v = kind ? bf2f(((const bf16_t*)p)[i]) : ((const float*)p)[i];
        if (!(v == v)) v = 12345.0f;
        const float wgt = (float)((int)((i * 2654435761ull >> 16) & 255) - 128);
        s0 += fabsf(v); s1 += (double)v * wgt;
    }
    for (int o = 32; o >= 1; o >>= 1) { s0 += __shfl_xor(s0, o); s1 += __shfl_xor(s1, o); }
    if ((threadIdx.x & 63) == 0) { atomicAdd(slot, s0); atomicAdd(slot + 1, s1); }
}
__global__ void ck_final(const double* sums, float* out, size_t n, int nslots) {
    int first = -1;
    for (int i = 0; i < nslots; ++i) { const double a0 = sums[2 * i], a1 = sums[2 * i + 1], b0 = sums[2 * (nslots + i)], b1 = sums[2 * (nslots + i) + 1];
        const bool bad = fabs(a0 - b0) > 1e-5 * (fabs(a0) + fabs(b0)) + 1e-30 || fabs(a1 - b1) > 1e-4 * (fabs(a0) + fabs(b0)) + 1e-30;
        if (bad) { first = i; break; } }
    const float val = first < 0 ? 0.f : 100.f * (float)(first + 1);
    for (size_t i = (size_t)blockIdx.x * blockDim.x + threadIdx.x; i < n; i += (size_t)gridDim.x * blockDim.x) out[i] = val;
}
__global__ void ck_holes(const bf16_t* p, size_t n, unsigned long long* res) {
    unsigned long long cnt = 0, mn = ~0ull;
    for (size_t i = (size_t)blockIdx.x * blockDim.x + threadIdx.x; i < n; i += (size_t)gridDim.x * blockDim.x) if (p[i] == 0xFFFFu) { ++cnt; if (i < mn) mn = i; }
    if (cnt) { atomicAdd(res, cnt); atomicMin(res + 1, mn); }
}
__global__ void ck_holes_final(const unsigned long long* res, float* out, size_t n, int mode) {
    const float val = mode == 0 ? (float)((double)res[0] / 65536.0 * 100.0) : mode == 1 ? (float)((res[1] == ~0ull ? 0 : (res[1] / 2048) ) ) + 100.f : (float)((res[1] == ~0ull ? 0 : (res[1] % 2048))) + 100.f;
    for (size_t i = (size_t)blockIdx.x * blockDim.x + threadIdx.x; i < n; i += (size_t)gridDim.x * blockDim.x) out[i] = val;
}
__global__ void ck_diff(const bf16_t* p, const bf16_t* q, size_t n, unsigned long long* res) {
    unsigned long long cnt = 0, mn = ~0ull, big = 0;
    for (size_t i = (size_t)blockIdx.x * blockDim.x + threadIdx.x; i < n; i += (size_t)gridDim.x * blockDim.x) if (p[i] != q[i]) { ++cnt; if (i < mn) mn = i; const float a = bf2f(p[i]), b = bf2f(q[i]); if (fabsf(a - b) > 0.02f * (fabsf(a) + fabsf(b))) ++big; }
    if (cnt) { atomicAdd(res, cnt); atomicMin(res + 1, mn); atomicAdd(res + 2, big); }
}
__global__ void ck_diff_final(const unsigned long long* res, float* out, size_t n, int ld) {
    const unsigned long long cnt = res[0], big = res[2];
    const float c2 = 100.f * (1.f + floorf(log2f(1.f + (float)cnt)));
    const float c1 = 1.0e6f * (1.f + floorf(log2f(1.f + (float)big)));
    for (size_t i = (size_t)blockIdx.x * blockDim.x + threadIdx.x; i < n; i += (size_t)gridDim.x * blockDim.x) out[i] = (i == 0) ? c1 : c2;
}

__device__ __forceinline__ unsigned hsh(unsigned x) { x ^= x >> 16; x *= 0x7feb352du; x ^= x >> 15; x *= 0x846ca68bu; x ^= x >> 16; return x; }
__device__ __forceinline__ float bfr(float f) { return bf2f(f2bf1(f)); }
__device__ __forceinline__ void err_max(unsigned* res, float got, float expv) { float e = fabsf(got - expv) / (0.02f + 0.02f * fabsf(expv)); if (!(e == e)) e = 1e9f; atomicMax(res, __float_as_uint(e)); }
__device__ __forceinline__ float wave_sum(float s) { for (int o = 32; o >= 1; o >>= 1) s += __shfl_xor(s, o); return s; }
__global__ void chk_inproj(const float* x, const float* g0, const float* win, const float* lbp, const unsigned char* ws, unsigned* res, int nsamp) {
    const int lane = threadIdx.x & 63, wv = (blockIdx.x * blockDim.x + threadIdx.x) >> 6, nw = (gridDim.x * blockDim.x) >> 6;
    for (int s = wv; s < nsamp; s += nw) {
        const int row = hsh(2 * s + 1) % SEQ, col = hsh(2 * s + 2) % NIN;
        float ss = 0.f, dot = 0.f;
        for (int k = lane; k < DM; k += 64) { const float xv = x[(size_t)row * DM + k]; ss += xv * xv; dot += bfr(xv * g0[k]) * bfr(win[(size_t)k * NIN + col]); }
        ss = wave_sum(ss); dot = wave_sum(dot);
        const float u = dot * rsqrtf(ss / DM + EPS);
        if (lane == 0) {
            const int seg = col >> 10, c = col & 1023; const size_t o1 = (size_t)row * HW + c;
            const float sg = 1.f / (1.f + expf(-u)), si = u * sg;
            if (seg == 0) err_max(res, bf2f(((const bf16_t*)(ws + WS_QH))[o1]), si);
            else if (seg == 1) err_max(res, bf2f(((const bf16_t*)(ws + WS_VH))[o1]), u);
            else if (seg == 2 || seg == 3) { const int dir = seg - 2; const float a0 = lbp[dir * 1024 + c], a1 = lbp[2048 + dir * 1024 + c]; const float lb = 0.f * (a0 + a1);
                const float f = lb + (1.f - lb) * sg; err_max(res + 1, ((const float*)(ws + (dir ? WS_GB : WS_GF)))[o1], logf(fmaxf(f, 1e-6f)));
                err_max(res + 1, bf2f(((const bf16_t*)(ws + (dir ? WS_KB : WS_KF)))[o1]), (1.f - lb) * (1.f - sg)); }
            else if (seg == 4) err_max(res, bf2f(((const bf16_t*)(ws + WS_HG))[o1]), si);
            else if (seg == 5) err_max(res, bf2f(((const bf16_t*)(ws + WS_NQ))[o1]), u);
            else if (seg == 6) err_max(res, bf2f(((const bf16_t*)(ws + WS_NK))[o1]), u);
            else if (seg == 7) err_max(res + 2, bf2f(((const bf16_t*)(ws + WS_VT))[(size_t)c * SEQ + row]), u);
            else if (seg == 8) err_max(res, bf2f(((const bf16_t*)(ws + WS_NG))[o1]), si);
            else if (seg < 11) err_max(res + 3, bf2f(((const bf16_t*)(ws + WS_MA))[(size_t)row * DM + col - 9216]), sg);
            else err_max(res + 9, bf2f(((const bf16_t*)(ws + WS_MB))[(size_t)row * DM + col - 11264]), sg);
        }
    }
}
__global__ void chk_natten(const unsigned char* ws, const float* gq, const float* gk, const float* rpb, unsigned* res, int nsamp) {
    const int lane = threadIdx.x & 63, wv = (blockIdx.x * blockDim.x + threadIdx.x) >> 6, nw = (gridDim.x * blockDim.x) >> 6;
    const bf16_t* NQ = (const bf16_t*)(ws + WS_NQ); const bf16_t* NK = (const bf16_t*)(ws + WS_NK); const bf16_t* VT = (const bf16_t*)(ws + WS_VT); const bf16_t* NG = (const bf16_t*)(ws + WS_NG); const bf16_t* OB = (const bf16_t*)(ws + WS_OB);
    for (int s = wv; s < nsamp; s += nw) {
        const int t = hsh(3 * s + 7) % SEQ, h = hsh(3 * s + 8) % 8; const int r = t >> 6, c = t & 63;
        const int rs0 = min(max(r - 4, 0), 120), cs0 = min(max(c - 8, 0), 48);
        float q0 = bf2f(NQ[(size_t)t * HW + h * 128 + lane]), q1 = bf2f(NQ[(size_t)t * HW + h * 128 + 64 + lane]);
        const float rq = rsqrtf(wave_sum(q0 * q0 + q1 * q1) / 128.f + EPS); q0 *= rq * gq[lane]; q1 *= rq * gq[64 + lane];
        float mx = -1e30f;
        float o0 = 0.f, o1 = 0.f, l = 0.f;
        for (int pass = 0; pass < 2; ++pass) {
            for (int a = 0; a < 8; ++a) for (int j = 0; j < 16; ++j) {
                const int kr = rs0 + a, kc = cs0 + j, tk = kr * 64 + kc;
                float k0 = bf2f(NK[(size_t)tk * HW + h * 128 + lane]), k1 = bf2f(NK[(size_t)tk * HW + h * 128 + 64 + lane]);
                const float rk = rsqrtf(wave_sum(k0 * k0 + k1 * k1) / 128.f + EPS);
                const float d = wave_sum(q0 * k0 * rk * gk[lane] + q1 * k1 * rk * gk[64 + lane]) * 0.08838834764831845f + rpb[(size_t)h * 465 + (kr - r + 7) * 31 + (kc - c + 15)];
                if (pass == 0) mx = fmaxf(mx, d);
                else { const float p = expf(d - mx); l += p; o0 += p * bf2f(VT[(size_t)(h * 128 + lane) * SEQ + tk]); o1 += p * bf2f(VT[(size_t)(h * 128 + 64 + lane) * SEQ + tk]); }
            }
        }
        const size_t ob = (size_t)t * HW + h * 128;
        err_max(res, bf2f(OB[ob + lane]), o0 / l * bf2f(NG[ob + lane])); err_max(res, bf2f(OB[ob + 64 + lane]), o1 / l * bf2f(NG[ob + 64 + lane]));
    }
}
__global__ void chk_hgrn_scan(const unsigned char* ws, float* OREF, int h0) {
    __shared__ float qs[128], ks[128], fs[128], vs[128], part[4][128];
    const int tid = threadIdx.x, v = tid & 127, kq = tid >> 7; const int h = h0 + (blockIdx.x >> 1), d = blockIdx.x & 1;
    const bf16_t* QH = (const bf16_t*)(ws + WS_QH); const bf16_t* VH = (const bf16_t*)(ws + WS_VH); const bf16_t* KK = (const bf16_t*)(ws + (d ? WS_KB : WS_KF)); const float* G = (const float*)(ws + (d ? WS_GB : WS_GF));
    float S[32];
#pragma unroll
    for (int i = 0; i < 32; ++i) S[i] = 0.f;
    float* out = OREF + (size_t)blockIdx.x * SEQ * 128;
    for (int step = 0; step < SEQ; ++step) {
        const int t = d ? SEQ - 1 - step : step;
        if (tid < 128) { qs[tid] = bf2f(QH[(size_t)t * HW + h * 128 + tid]); ks[tid] = bf2f(KK[(size_t)t * HW + h * 128 + tid]); fs[tid] = expf(G[(size_t)t * HW + h * 128 + tid]); vs[tid] = bf2f(VH[(size_t)t * HW + h * 128 + tid]); }
        __syncthreads();
        float p = 0.f; const float vv = vs[v];
#pragma unroll
        for (int i = 0; i < 32; ++i) { const int k = 32 * kq + i; S[i] = fs[k] * S[i] + ks[k] * vv; p += S[i] * qs[k]; }
        part[kq][v] = p;
        __syncthreads();
        if (tid < 128) out[(size_t)t * 128 + tid] = part[0][tid] + part[1][tid] + part[2][tid] + part[3][tid];
    }
}
__global__ void chk_hgrn_out(const unsigned char* ws, const float* OREF, const float* onorm, unsigned* res, int h0, int nh) {
    const int lane = threadIdx.x & 63, wv = (blockIdx.x * blockDim.x + threadIdx.x) >> 6, nw = (gridDim.x * blockDim.x) >> 6;
    const bf16_t* HG = (const bf16_t*)(ws + WS_HG); const bf16_t* OA = (const bf16_t*)(ws + WS_OA);
    for (int s = wv; s < nh * SEQ; s += nw) {
        const int hh = s / SEQ, t = s % SEQ, h = h0 + hh;
        const float* of = OREF + ((size_t)(2 * hh) * SEQ + t) * 128; const float* ob = OREF + ((size_t)(2 * hh + 1) * SEQ + t) * 128;
        const float a0 = of[lane] + ob[lane], a1 = of[64 + lane] + ob[64 + lane];
        const float rs = rsqrtf(wave_sum(a0 * a0 + a1 * a1) / 128.f + EPS);
        const size_t o = (size_t)t * HW + h * 128;
        err_max(res, bf2f(OA[o + lane]), a0 * rs * onorm[lane] * bf2f(HG[o + lane])); err_max(res, bf2f(OA[o + 64 + lane]), a1 * rs * onorm[64 + lane] * bf2f(HG[o + 64 + lane]));
    }
}
__global__ void chk_branch(const unsigned char* ws, const float* wa, const float* wb, unsigned* res, int nsamp) {
    const int lane = threadIdx.x & 63, wv = (blockIdx.x * blockDim.x + threadIdx.x) >> 6, nw = (gridDim.x * blockDim.x) >> 6;
    const bf16_t* OA = (const bf16_t*)(ws + WS_OA); const bf16_t* OB = (const bf16_t*)(ws + WS_OB); const bf16_t* MA = (const bf16_t*)(ws + WS_MA); const bf16_t* MB = (const bf16_t*)(ws + WS_MB); const bf16_t* Y = (const bf16_t*)(ws + WS_Y);
    for (int s = wv; s < nsamp; s += nw) {
        const int row = hsh(5 * s + 1) % SEQ, col = hsh(5 * s + 2) % DM; float da = 0.f, db = 0.f;
        for (int k = lane; k < HW; k += 64) { da += bf2f(OA[(size_t)row * HW + k]) * bfr(wa[(size_t)k * DM + col]); db += bf2f(OB[(size_t)row * HW + k]) * bfr(wb[(size_t)k * DM + col]); }
        da = wave_sum(da); db = wave_sum(db);
        if (lane == 0) err_max(res, bf2f(Y[(size_t)row * DM + col]), bf2f(MA[(size_t)row * DM + col]) * da + bf2f(MB[(size_t)row * DM + col]) * db);
    }
}
__global__ void chk_wout(const unsigned char* ws, const float* xin, const float* wo, unsigned* res, int nsamp) {
    const int lane = threadIdx.x & 63, wv = (blockIdx.x * blockDim.x + threadIdx.x) >> 6, nw = (gridDim.x * blockDim.x) >> 6;
    const bf16_t* Y = (const bf16_t*)(ws + WS_Y); const float* X1 = (const float*)(ws + WS_X1);
    for (int s = wv; s < nsamp; s += nw) {
        const int row = hsh(7 * s + 1) % SEQ, col = hsh(7 * s + 2) % DM; float d = 0.f;
        for (int k = lane; k < DM; k += 64) d += bf2f(Y[(size_t)row * DM + k]) * bfr(wo[(size_t)k * DM + col]);
        d = wave_sum(d);
        if (lane == 0) err_max(res, X1[(size_t)row * DM + col], xin[(size_t)row * DM + col] + d);
    }
}
__global__ void chk_gate(const unsigned char* ws, const float* out, const float* p, const float* wp, const float* wg, const float* pn, unsigned* res, int nsamp) {
    const int lane = threadIdx.x & 63, wv = (blockIdx.x * blockDim.x + threadIdx.x) >> 6, nw = (gridDim.x * blockDim.x) >> 6;
    const float* X1 = (const float*)(ws + WS_X1);
    for (int s = wv; s < nsamp; s += nw) {
        const int row = hsh(9 * s + 1) % SEQ, col = hsh(9 * s + 2) % DM; float d = 0.f, ss = 0.f, pl = 0.f;
        for (int k = lane; k < DM; k += 64) { const float xv = X1[(size_t)row * DM + k]; ss += xv * xv; d += bfr(xv * pn[k]) * bfr(wg[(size_t)k * DM + col]); }
        for (int k = lane; k < PLE; k += 64) pl += bfr(p[(size_t)row * PLE + k]) * bfr(wp[(size_t)k * DM + col]);
        d = wave_sum(d); ss = wave_sum(ss); pl = wave_sum(pl);
        if (lane == 0) { const float g = 1.f / (1.f + expf(-d * rsqrtf(ss / DM + EPS))); err_max(res, out[(size_t)row * DM + col], X1[(size_t)row * DM + col] + pl * g); }
    }
}
__global__ void chk_final(const unsigned* res, float* out, size_t n, int nres) {
    int first = -1; for (int i = 0; i < nres; ++i) if (__uint_as_float(res[i]) > 1.0f) { first = i; break; }
    float bucket = 0.f; if (first >= 0) { const float e = __uint_as_float(res[first]); bucket = fminf(fmaxf(floorf(log10f(e)) + 1.f, 0.f), 9.f); }
    const float val = first < 0 ? 0.f : 100.f * (float)(first + 1) + 10.f * bucket;
    for (size_t i = (size_t)blockIdx.x * blockDim.x + threadIdx.x; i < n; i += (size_t)gridDim.x * blockDim.x) out[i] = val;
}

__global__ void ck_big(const bf16_t* p, size_t n, unsigned long long* res) {
    unsigned long long c0 = 0, c2 = 0, c4 = 0; float mxv = 0.f;
    for (size_t i = (size_t)blockIdx.x * blockDim.x + threadIdx.x; i < n; i += (size_t)gridDim.x * blockDim.x) { const float v = bf2f(p[i]);
        if (!(fabsf(v) <= 3.0e38f)) ++c0; else if (fabsf(v) > 1.01f || v < -0.01f) { ++c2; mxv = fmaxf(mxv, fabsf(v)); if (v < 0.f) ++c4; } }
    if (c0 | c2) { atomicAdd(res, c0); atomicAdd(res + 2, c2); atomicAdd(res + 4, c4); atomicMax((unsigned*)(res + 3), __float_as_uint(mxv)); }
}
__global__ void ck_big_final(const unsigned long long* res, float* out, size_t n, int ld) {
    const float mxv = __uint_as_float((unsigned)res[3]);
    const float c1 = 1.0e4f * (1.f + floorf(log2f(1.f + (float)res[0])));
    const float negf = res[2] ? (float)res[4] / (float)res[2] : 0.f;
    const float c2 = 1000.f * (1.f + floorf(negf * 3.99f)) + 100.f * fminf(fmaxf(floorf(log10f(fmaxf(mxv, 1e-9f))) + 2.f, 0.f), 9.f);
    for (size_t i = (size_t)blockIdx.x * blockDim.x + threadIdx.x; i < n; i += (size_t)gridDim.x * blockDim.x) out[i] = (i == 0) ? c1 : c2;
}
struct CkBuf { int phase; int idx; size_t off; size_t n; int kind; };
#endif

extern "C" void kernel_launch(void* const* d_in, const int* in_sizes, int n_in, void* d_out, int out_size, void* d_ws, size_t ws_size, hipStream_t stream) {
    static int grid = 0;
    if (grid == 0) {
        if (n_in != 15 || out_size != SEQ * DM || ws_size < WS_END) { fprintf(stderr, "kernel_launch: unexpected problem (n_in %d, out %d, ws %zu)\n", n_in, out_size, ws_size); grid = -1; return; }
        int dev = 0, cus = 0;
        if (hipGetDevice(&dev) != hipSuccess || hipDeviceGetAttribute(&cus, hipDeviceAttributeMultiprocessorCount, dev) != hipSuccess) { grid = -1; return; }
        if (hipFuncSetAttribute((const void*)mk_fwd, hipFuncAttributeMaxDynamicSharedMemorySize, LDS_BYTES) != hipSuccess) { fprintf(stderr, "kernel_launch: hipFuncSetAttribute failed\n"); grid = -1; return; }
        int per_cu = 0;
        if (hipOccupancyMaxActiveBlocksPerMultiprocessor(&per_cu, (const void*)mk_fwd, 512, LDS_BYTES) != hipSuccess || per_cu < 1) fprintf(stderr, "kernel_launch: occupancy query says %d\n", per_cu);
        (void)hipGetLastError();
        grid = cus;
    }
    if (grid < 0) return;
    (void)hipMemsetAsync((char*)d_ws + WS_CTL, 0, CTL_ZERO_BYTES, stream);
    Args a{};
    for (int i = 0; i < 15; ++i) a.in[i] = (const float*)d_in[i];
    a.out = (float*)d_out; a.ws = (unsigned char*)d_ws;
#if MK_DIAG == 5
    {
        unsigned long long* res = (unsigned long long*)((char*)d_ws + 65536);
        (void)hipMemsetAsync((char*)d_ws + 65536 + 8, 0xFF, 8, stream);
        for (int ph = 0; ph < 2; ++ph) { a.ph_lo = ph; a.ph_hi = ph + 1; hipLaunchKernelGGL(mk_fwd, dim3(grid), dim3(512), LDS_BYTES, stream, a); }
        hipLaunchKernelGGL(ck_big, dim3(1024), dim3(256), 0, stream, (const bf16_t*)((char*)d_ws + WS_MA), (size_t)SEQ * DM, res);
        hipLaunchKernelGGL(ck_big_final, dim3(1024), dim3(256), 0, stream, (const unsigned long long*)res, (float*)d_out, (size_t)SEQ * DM, DM);
    }
#elif MK_DIAG == 4
    {
        unsigned* res = (unsigned*)((char*)d_ws + 65536);
        float* OREF = (float*)((char*)d_ws + 728 * MiB);
        const unsigned char* wsc = (const unsigned char*)d_ws;
        const float* const* in = a.in;
        for (int ph = 0; ph < NPHASE; ++ph) {
            a.ph_lo = ph; a.ph_hi = ph + 1; hipLaunchKernelGGL(mk_fwd, dim3(grid), dim3(512), LDS_BYTES, stream, a);
            if (ph == 1) hipLaunchKernelGGL(chk_inproj, dim3(512), dim3(256), 0, stream, in[0], in[2], in[3], in[4], wsc, res + 0, 32768);
            if (ph == 2) hipLaunchKernelGGL(chk_natten, dim3(256), dim3(256), 0, stream, wsc, in[6], in[7], in[8], res + 4, 1024);
            if (ph == 4) { hipLaunchKernelGGL(chk_hgrn_scan, dim3(4), dim3(512), 0, stream, wsc, OREF, 2);
                           hipLaunchKernelGGL(chk_hgrn_out, dim3(512), dim3(256), 0, stream, wsc, (const float*)OREF, in[5], res + 5, 2, 2); }
            if (ph == 5) hipLaunchKernelGGL(chk_branch, dim3(512), dim3(256), 0, stream, wsc, in[9], in[10], res + 6, 8192);
            if (ph == 6) hipLaunchKernelGGL(chk_wout, dim3(512), dim3(256), 0, stream, wsc, in[0], in[11], res + 7, 8192);
            if (ph == 7) hipLaunchKernelGGL(chk_gate, dim3(512), dim3(256), 0, stream, wsc, (const float*)d_out, in[1], in[14], in[13], in[12], res + 8, 8192);
        }
        hipLaunchKernelGGL(chk_final, dim3(1024), dim3(256), 0, stream, (const unsigned*)res, (float*)d_out, (size_t)SEQ * DM, 10);
    }
#elif MK_DIAG == 3
    {
        unsigned long long* res = (unsigned long long*)((char*)d_ws + 65536);
        bf16_t* SAVE = (bf16_t*)((char*)d_ws + 728 * MiB);
        (void)hipMemsetAsync((char*)d_ws + MiB, 0xAA, WS_END - MiB, stream);
        (void)hipMemsetAsync((char*)d_ws + 65536 + 8, 0xFF, 8, stream);
        for (int ph = 0; ph < 2; ++ph) { a.ph_lo = ph; a.ph_hi = ph + 1; hipLaunchKernelGGL(mk_fwd, dim3(grid), dim3(512), LDS_BYTES, stream, a); }
        (void)hipMemcpyAsync(SAVE, (char*)d_ws + MK_HOLE_BUF, (size_t)SEQ * MK_HOLE_LD * 2, hipMemcpyDeviceToDevice, stream);
        a.ph_lo = 1; a.ph_hi = 2; hipLaunchKernelGGL(mk_fwd, dim3(grid), dim3(512), LDS_BYTES, stream, a);
        hipLaunchKernelGGL(ck_diff, dim3(1024), dim3(256), 0, stream, (const bf16_t*)((char*)d_ws + MK_HOLE_BUF), (const bf16_t*)SAVE, (size_t)SEQ * MK_HOLE_LD, res);
        hipLaunchKernelGGL(ck_diff_final, dim3(1024), dim3(256), 0, stream, (const unsigned long long*)res, (float*)d_out, (size_t)SEQ * DM, MK_HOLE_LD);
    }
#elif MK_DIAG == 2
    {
        unsigned long long* res = (unsigned long long*)((char*)d_ws + 65536);
        (void)hipMemsetAsync((char*)d_ws + MiB, 0xAA, WS_END - MiB, stream);
        (void)hipMemsetAsync((char*)d_ws + 65536 + 8, 0xFF, 8, stream);
        a.ph_lo = 0; a.ph_hi = 1; hipLaunchKernelGGL(mk_fwd, dim3(grid), dim3(512), LDS_BYTES, stream, a);
        (void)hipMemsetAsync((char*)d_ws + MK_HOLE_BUF, 0xFF, (size_t)SEQ * MK_HOLE_LD * 2, stream);
        a.ph_lo = 1; a.ph_hi = 2; hipLaunchKernelGGL(mk_fwd, dim3(grid), dim3(512), LDS_BYTES, stream, a);
        hipLaunchKernelGGL(ck_holes, dim3(1024), dim3(256), 0, stream, (const bf16_t*)((char*)d_ws + MK_HOLE_BUF), (size_t)SEQ * MK_HOLE_LD, res);
        hipLaunchKernelGGL(ck_holes_final, dim3(1024), dim3(256), 0, stream, (const unsigned long long*)res, (float*)d_out, (size_t)SEQ * DM, MK_HOLE_MODE);
    }
#elif MK_DIAG
    {
        static const CkBuf B0[] = {
            {0, 0, WS_LOWER, 4096, 0}, {0, 1, WS_SSQ, 8192, 0}, {0, 2, WS_XGA, (size_t)SEQ * DM, 1}, {0, 3, WS_PB, (size_t)2 * SEQ * PLE, 1}, {0, 4, WS_WIN, (size_t)2 * NIN * DM, 1},
            {0, 5, WS_WA, (size_t)2 * DM * HW, 1}, {0, 6, WS_WB, (size_t)2 * DM * HW, 1}, {0, 7, WS_WO, (size_t)2 * DM * DM, 1}, {0, 8, WS_WG, (size_t)2 * DM * DM, 1}, {0, 9, WS_WP, (size_t)2 * DM * PLE, 1} };
        static const CkBuf BL[] = {
            {0, 10, WS_QH, (size_t)SEQ * HW, 1}, {0, 11, WS_VH, (size_t)SEQ * HW, 1}, {0, 12, WS_KF, (size_t)SEQ * HW, 1}, {0, 13, WS_KB, (size_t)SEQ * HW, 1}, {0, 14, WS_HG, (size_t)SEQ * HW, 1},
            {0, 15, WS_NQ, (size_t)SEQ * HW, 1}, {0, 16, WS_NK, (size_t)SEQ * HW, 1}, {0, 17, WS_VT, (size_t)SEQ * HW, 1}, {0, 18, WS_NG, (size_t)SEQ * HW, 1}, {0, 19, WS_GF, (size_t)SEQ * HW, 0},
            {0, 20, WS_GB, (size_t)SEQ * HW, 0}, {0, 21, WS_MA, (size_t)SEQ * DM, 1}, {0, 22, WS_MB, (size_t)SEQ * DM, 1},
            {1, 23, WS_LT, (size_t)2048 * 16384, 0}, {1, 24, WS_DD, (size_t)2048 * 128, 0}, {1, 25, WS_EE, (size_t)2048 * 128, 0}, {1, 26, WS_OB, (size_t)SEQ * HW, 1},
            {2, 27, WS_SP, (size_t)2048 * 16384, 1}, {3, 28, WS_OA, (size_t)SEQ * HW, 1}, {4, 29, WS_T, (size_t)SEQ * DM, 0}, {4, 30, WS_Y, (size_t)SEQ * DM, 1},
            {5, 31, WS_X1, (size_t)SEQ * DM, 0}, {5, 32, WS_XGB, (size_t)SEQ * DM, 1}, {6, 34, WS_PL, (size_t)SEQ * DM, 0}, {6, 35, (size_t)-1, (size_t)SEQ * DM, 0} };
        const int NS = 80;
        double* sums = (double*)((char*)d_ws + 65536);
        (void)hipMemsetAsync((char*)d_ws + MiB, 0xAA, WS_END - MiB, stream);
        for (int run = 0; run < 2; ++run) {
            (void)hipMemsetAsync((char*)d_ws + WS_CTL, 0, 32768, stream);
            for (int ph = 0; ph < NPHASE; ++ph) {
                a.ph_lo = ph; a.ph_hi = ph + 1; hipLaunchKernelGGL(mk_fwd, dim3(grid), dim3(512), LDS_BYTES, stream, a);
                if (ph == 0) { for (const CkBuf& b : B0) hipLaunchKernelGGL(ck_sum, dim3(1024), dim3(256), 0, stream, (const void*)((char*)d_ws + b.off), b.n, b.kind, sums + 2 * (run * NS + b.idx)); }
                else { const int l = (ph - 1) / 7, k = (ph - 1) % 7;
                    for (const CkBuf& b : BL) if (b.phase == k) hipLaunchKernelGGL(ck_sum, dim3(1024), dim3(256), 0, stream, b.off == (size_t)-1 ? (const void*)d_out : (const void*)((char*)d_ws + b.off), b.n, b.kind, sums + 2 * (run * NS + b.idx + 40 * l)); }
            }
        }
        hipLaunchKernelGGL(ck_final, dim3(1024), dim3(256), 0, stream, (const double*)sums, (float*)d_out, (size_t)SEQ * DM, NS);
    }
#elif MK_MULTI
    for (int ph = 0; ph < NPHASE; ++ph) { a.ph_lo = ph; a.ph_hi = ph + 1; hipLaunchKernelGGL(mk_fwd, dim3(grid), dim3(512), LDS_BYTES, stream, a); }
#else
    a.ph_lo = 0; a.ph_hi = NPHASE; hipLaunchKernelGGL(mk_fwd, dim3(grid), dim3(512), LDS_BYTES, stream, a);
#endif
}
```

```cpp
#include <hip/hip_runtime.h>
#include <cstdio>
#include <cstdint>

#ifndef MK_ALIGN
#define MK_ALIGN true
#endif
#ifndef MK_SP2
#define MK_SP2 true
#endif
#ifndef MK_TS
#define MK_TS 0
#endif
#ifndef MK_TS_A
#define MK_TS_A 0
#define MK_TS_B 1
#endif
#ifndef MK_REP_PHASE
#define MK_REP_PHASE -1
#endif
#ifndef MK_REP_DUMMY
#define MK_REP_DUMMY 0
#endif
#ifndef MK_REP_N
#define MK_REP_N 3
#endif
#ifndef MK_ENDFLUSH
#define MK_ENDFLUSH 0
#endif
#ifndef MK_MULTI
#define MK_MULTI 0
#endif

#define LAS __attribute__((address_space(3)))
typedef unsigned short bf16_t;
typedef short bf16x8 __attribute__((ext_vector_type(8)));
typedef float f32x4 __attribute__((ext_vector_type(4)));
typedef float f32x2 __attribute__((ext_vector_type(2)));
typedef unsigned u32x4 __attribute__((ext_vector_type(4)));
typedef unsigned u32x2 __attribute__((ext_vector_type(2)));

constexpr int SEQ = 8192, DM = 2048, NIN = 13312, HW = 1024, PLE = 256;
constexpr float EPS = 1e-6f;
constexpr int NPHASE = 15;

constexpr size_t MiB = 1u << 20;
constexpr size_t WS_CTL = 0, CTL_ZERO_BYTES = 1 * MiB;
constexpr size_t WS_LOWER = 1 * MiB;
constexpr size_t WS_SSQ = 1 * MiB + 64 * 1024;
constexpr size_t WS_DD = 2 * MiB;
constexpr size_t WS_EE = 3 * MiB;
constexpr size_t WS_WIN = 4 * MiB;
constexpr size_t WS_WA = 108 * MiB;
constexpr size_t WS_WB = 116 * MiB;
constexpr size_t WS_WO = 124 * MiB;
constexpr size_t WS_WG = 140 * MiB;
constexpr size_t WS_WP = 156 * MiB;
constexpr size_t WS_PB = 158 * MiB;
constexpr size_t WS_XGA = 166 * MiB;
constexpr size_t WS_XGB = 198 * MiB;
constexpr size_t WS_QH = 230 * MiB;
constexpr size_t WS_VH = 246 * MiB;
constexpr size_t WS_KF = 262 * MiB;
constexpr size_t WS_KB = 278 * MiB;
constexpr size_t WS_HG = 294 * MiB;
constexpr size_t WS_NQ = 310 * MiB;
constexpr size_t WS_NK = 326 * MiB;
constexpr size_t WS_VT = 342 * MiB;
constexpr size_t WS_NG = 358 * MiB;
constexpr size_t WS_OA = 374 * MiB;
constexpr size_t WS_OB = 390 * MiB;
constexpr size_t WS_GF = 406 * MiB;
constexpr size_t WS_GB = 438 * MiB;
constexpr size_t WS_MA = 470 * MiB;
constexpr size_t WS_MB = 502 * MiB;
constexpr size_t WS_LT = 534 * MiB;
constexpr size_t WS_SP = 662 * MiB;
constexpr size_t WS_PL = 726 * MiB;
constexpr size_t WS_END = 758 * MiB;
constexpr size_t WS_T = WS_LT;
constexpr size_t WS_Y = WS_SP;

constexpr int LDS_BYTES = 147456;
constexpr int LDS_MISC_OFF = 131072;

typedef __bf16 bf16x2_t __attribute__((ext_vector_type(2)));
__device__ __forceinline__ unsigned cvt_pk_bf16(float lo, float hi) { bf16x2_t v = {(__bf16)lo, (__bf16)hi}; return __builtin_bit_cast(unsigned, v); }
__device__ __forceinline__ float bf2f(unsigned short b) { return __uint_as_float(((unsigned)b) << 16); }
__device__ __forceinline__ float bflo(unsigned w) { return __uint_as_float(w << 16); }
__device__ __forceinline__ float bfhi(unsigned w) { return __uint_as_float(w & 0xffff0000u); }
__device__ __forceinline__ unsigned short f2bf1(float f) { return (unsigned short)(cvt_pk_bf16(f, 0.f) & 0xffffu); }
__device__ __forceinline__ float fast_rcp(float x) { return __builtin_amdgcn_rcpf(x); }
__device__ __forceinline__ float sigmoid_f(float x) { return fast_rcp(1.f + __expf(-x)); }
__device__ __forceinline__ float silu_f(float x) { return x * sigmoid_f(x); }

__device__ __forceinline__ int opaque_tid(int wid_s) { int lane; asm volatile("v_mbcnt_lo_u32_b32 %0, -1, 0\n\tv_mbcnt_hi_u32_b32 %0, -1, %0" : "=v"(lane)); asm volatile("" : "+s"(wid_s)); return wid_s * 64 + lane; }
__device__ __forceinline__ unsigned char* opaque_ptr(unsigned char* p) { asm volatile("" : "+s"(p)); return p; }
__device__ __forceinline__ int opaque_bid() { int b = blockIdx.x; asm volatile("" : "+s"(b)); return b; }
namespace pg8 {
#define PG8_LAS __attribute__((address_space(3)))
constexpr int BM = 256, BK = 64, HALF = 128, HTB = HALF * BK * 2, STAGE_BYTES = 8 * HTB, NXCD = 8, WGM = 8;
__host__ __device__ __forceinline__ int lds_byte(int r, int c) { const int st = (r >> 4) * 2 + (c >> 5), rr = r & 15, cc = c & 31, ob = rr * 64 + cc * 2; return st * 1024 + (ob ^ (((ob >> 9) & 1) << 5)); }
__host__ __device__ __forceinline__ void stage_rc(int b, int& R, int& C) { const int st = b / 1024, sb = b % 1024, swz = sb ^ (((sb >> 9) & 1) << 5); R = (st >> 1) * 16 + swz / 64; C = (st & 1) * 32 + (swz % 64) / 2; }
__host__ __device__ __forceinline__ int perm32(int rho) { const int n = rho >> 4, i = rho & 15; return 8 * (i >> 2) + 4 * n + (i & 3); }

struct Unit { int pm, pn; };
struct Gemm { const bf16_t* A; const bf16_t* Bt; int M, N, K; };

struct StaticOrder {
    int nM, nN, nwg, G, c;
    __host__ __device__ void init(int M, int N, int G_, int c_) { nM = M / BM; nN = N / BM; nwg = nM * nN; G = G_; c = c_; }
    __host__ __device__ bool next(int i, Unit& u) const {
        const long L = (long)i * G + c; if (L >= nwg) return false;
        int wgid = (int)L; { const int q = nwg / NXCD, r = nwg % NXCD, xcd = wgid % NXCD, off = wgid / NXCD; wgid = (xcd < r ? xcd * (q + 1) : r * (q + 1) + (xcd - r) * q) + off; }
        const int nig = WGM * nN, gid = wgid / nig, fm = gid * WGM, gsz = (nM - fm) < WGM ? (nM - fm) : WGM;
        u.pm = fm + ((wgid % nig) % gsz); u.pn = (wgid % nig) / gsz; return true;
    }
    __device__ __forceinline__ void a_ready(const Unit&) const {}
    __device__ __forceinline__ void done(const Unit&) const {}
};

template <class Epi, class Sched, bool ALIGN_EPI = MK_ALIGN, bool SP2 = MK_SP2>
__device__ __forceinline__ void gemm_phase(PG8_LAS unsigned char* lds, const Gemm g, const Sched& S, const Epi& E, int wid_s) {
    const int tid = opaque_tid(wid_s), wid = __builtin_amdgcn_readfirstlane(tid >> 6), lane = tid & 63, wr = wid >> 2, wc = wid & 3, fr = lane & 15, fq = lane >> 4;
    const int K = g.K, nt = K / BK;
    unsigned voffA[2], voffB[2];
#pragma unroll
    for (int i = 0; i < 2; ++i) { int R, C; stage_rc(tid * 16 + i * 8192, R, C); const int Rb = Epi::PERM ? ((R & ~31) + perm32(R & 31)) : R;
        voffA[i] = (unsigned)(R * K + C) * 2u; voffB[i] = (unsigned)(Rb * K + C) * 2u; }
    const size_t kstep = (size_t)(BK * 2);
    const size_t hstep = (size_t)HALF * K * 2;
    const size_t tstep = 2 * hstep;
    const unsigned ldsw = (unsigned)wid * 1024u;
    const int aoff = lds_byte(wr * 64 + fr, fq * 8), boff = lds_byte(wc * 32 + fr, fq * 8);
#define PG8_SA(b, h) (((b) * 2 + (h)) * HTB)
#define PG8_SB(b, h) ((4 + (b) * 2 + (h)) * HTB)
#define PG8_STAGE(bufoff, gbase, voff) do { _Pragma("unroll") for (int _i = 0; _i < 2; ++_i) \
        __builtin_amdgcn_global_load_lds((const unsigned*)((const char*)(gbase) + (voff)[_i]), (PG8_LAS unsigned*)(lds + (bufoff) + ldsw + _i * 8192), 16, 0, 0); } while (0)
#define PG8_LDA(dst, b, h) do { _Pragma("unroll") for (int m = 0; m < 4; ++m) _Pragma("unroll") for (int k = 0; k < 2; ++k) dst[m][k] = *(const PG8_LAS bf16x8*)(lds + PG8_SA(b, h) + aoff + m * 2048 + k * 1024); } while (0)
#define PG8_LDB(dst, b, h) do { _Pragma("unroll") for (int n = 0; n < 2; ++n) _Pragma("unroll") for (int k = 0; k < 2; ++k) dst[n][k] = *(const PG8_LAS bf16x8*)(lds + PG8_SB(b, h) + boff + n * 2048 + k * 1024); } while (0)
#define PG8_MMA(ai, bj, At, Bt) do { __builtin_amdgcn_s_setprio(1); _Pragma("unroll") for (int m = 0; m < 4; ++m) _Pragma("unroll") for (int n = 0; n < 2; ++n) _Pragma("unroll") for (int k = 0; k < 2; ++k) \
        acc[ai][bj][m][n] = __builtin_amdgcn_mfma_f32_16x16x32_bf16(Bt[n][k], At[m][k], acc[ai][bj][m][n], 0, 0, 0); __builtin_amdgcn_s_setprio(0); } while (0)
#define PG8_WAIT_V(n) asm volatile("s_waitcnt vmcnt(" #n ")" ::: "memory")
#define PG8_WAIT_L(n) asm volatile("s_waitcnt lgkmcnt(" #n ")" ::: "memory")
#define PG8_BAR __builtin_amdgcn_s_barrier()
#define PG8_SCHED __builtin_amdgcn_sched_barrier(0)
    Unit cur, nxt; int ui = 0;
    if (!S.next(0, cur)) return;
    f32x4 acc[2][2][4][2];
#pragma unroll
    for (int a = 0; a < 2; ++a)
#pragma unroll
        for (int b = 0; b < 2; ++b)
#pragma unroll
            for (int m = 0; m < 4; ++m)
#pragma unroll
                for (int n = 0; n < 2; ++n) acc[a][b][m][n] = (f32x4){0.f, 0.f, 0.f, 0.f};
    bf16x8 At[4][2], B0[2][2], B1[2][2];
    const char* cA = (const char*)g.A + (size_t)cur.pm * tstep; const char* cB = (const char*)g.Bt + (size_t)cur.pn * tstep;
    S.a_ready(cur);
    if constexpr (SP2) {
        PG8_STAGE(PG8_SB(0, 0), cB, voffB); PG8_STAGE(PG8_SB(0, 1), cB + hstep, voffB); PG8_STAGE(PG8_SA(0, 0), cA, voffA); PG8_STAGE(PG8_SA(0, 1), cA + hstep, voffA);
        if (wr == 1) PG8_BAR;
        PG8_WAIT_V(2); PG8_BAR;
        PG8_STAGE(PG8_SB(1, 0), cB + kstep, voffB); PG8_STAGE(PG8_SA(1, 0), cA + kstep, voffA); PG8_STAGE(PG8_SB(1, 1), cB + hstep + kstep, voffB);
        PG8_WAIT_V(6); PG8_BAR;
    } else {
        PG8_STAGE(PG8_SB(0, 0), cB, voffB); PG8_STAGE(PG8_SA(0, 0), cA, voffA); PG8_STAGE(PG8_SB(0, 1), cB + hstep, voffB); PG8_STAGE(PG8_SA(0, 1), cA + hstep, voffA);
        if (wr == 1) PG8_BAR;
        PG8_WAIT_V(4); PG8_BAR;
        PG8_STAGE(PG8_SB(1, 0), cB + kstep, voffB); PG8_STAGE(PG8_SA(1, 0), cA + kstep, voffA); PG8_STAGE(PG8_SB(1, 1), cB + hstep + kstep, voffB);
        PG8_WAIT_V(6); PG8_BAR;
    }
    for (;;) {
        const bool has_next = S.next(ui + 1, nxt);
        const char* nA = has_next ? (const char*)g.A + (size_t)nxt.pm * tstep : cA; const char* nB = has_next ? (const char*)g.Bt + (size_t)nxt.pn * tstep : cB;
        for (int t = 0; t < nt; t += 2) {
            const bool last = (t == nt - 2);
            const char* a1 = cA + (size_t)(t + 1) * kstep;
            const char* a2 = last ? nA : cA + (size_t)(t + 2) * kstep; const char* b2 = last ? nB : cB + (size_t)(t + 2) * kstep;
            const char* a3 = a2 + kstep; const char* b3 = b2 + kstep;
            if (last && has_next) S.a_ready(nxt);
            if constexpr (SP2) {
            PG8_LDB(B0, 0, 0); PG8_LDB(B1, 0, 1); PG8_SCHED; PG8_LDA(At, 0, 0); PG8_STAGE(PG8_SA(1, 1), a1 + hstep, voffA);
            PG8_WAIT_V(8); PG8_WAIT_L(0); PG8_BAR; PG8_MMA(0, 0, At, B0); PG8_MMA(0, 1, At, B1); PG8_BAR; PG8_SCHED;
            PG8_LDA(At, 0, 1); PG8_STAGE(PG8_SB(0, 0), b2, voffB); PG8_STAGE(PG8_SB(0, 1), b2 + hstep, voffB); PG8_STAGE(PG8_SA(0, 0), a2, voffA);
            PG8_WAIT_V(8); PG8_WAIT_L(0); PG8_BAR; PG8_MMA(1, 0, At, B0); PG8_MMA(1, 1, At, B1); PG8_BAR; PG8_SCHED;
            PG8_LDB(B0, 1, 0); PG8_LDB(B1, 1, 1); PG8_SCHED; PG8_LDA(At, 1, 0); PG8_STAGE(PG8_SA(0, 1), a2 + hstep, voffA);
            PG8_WAIT_V(8); PG8_WAIT_L(0); PG8_BAR; PG8_MMA(0, 0, At, B0); PG8_MMA(0, 1, At, B1); PG8_BAR; PG8_SCHED;
            PG8_LDA(At, 1, 1); PG8_STAGE(PG8_SB(1, 0), b3, voffB); PG8_STAGE(PG8_SB(1, 1), b3 + hstep, voffB); PG8_STAGE(PG8_SA(1, 0), a3, voffA);
            PG8_WAIT_V(8); PG8_WAIT_L(0); PG8_BAR; PG8_MMA(1, 0, At, B0); PG8_MMA(1, 1, At, B1); PG8_BAR; PG8_SCHED;
            } else {
            PG8_LDB(B0, 0, 0); PG8_SCHED; PG8_LDA(At, 0, 0); PG8_STAGE(PG8_SA(1, 1), a1 + hstep, voffA);
            PG8_WAIT_L(8); PG8_BAR; PG8_WAIT_L(0); PG8_MMA(0, 0, At, B0); PG8_BAR; PG8_SCHED;
            PG8_LDB(B1, 0, 1); PG8_STAGE(PG8_SB(0, 0), b2, voffB);
            PG8_BAR; PG8_WAIT_L(0); PG8_MMA(0, 1, At, B1); PG8_BAR;
            PG8_LDA(At, 0, 1); PG8_STAGE(PG8_SA(0, 0), a2, voffA);
            PG8_BAR; PG8_WAIT_L(0); PG8_MMA(1, 0, At, B0); PG8_BAR; PG8_SCHED;
            PG8_STAGE(PG8_SB(0, 1), b2 + hstep, voffB);
            PG8_WAIT_V(6); PG8_BAR; PG8_MMA(1, 1, At, B1); PG8_BAR;
            PG8_LDB(B0, 1, 0); PG8_SCHED; PG8_LDA(At, 1, 0); PG8_STAGE(PG8_SA(0, 1), a2 + hstep, voffA);
            PG8_WAIT_L(8); PG8_BAR; PG8_WAIT_L(0); PG8_MMA(0, 0, At, B0); PG8_BAR; PG8_SCHED;
            PG8_LDB(B1, 1, 1); PG8_STAGE(PG8_SB(1, 0), b3, voffB);
            PG8_BAR; PG8_WAIT_L(0); PG8_MMA(0, 1, At, B1); PG8_BAR;
            PG8_LDA(At, 1, 1); PG8_STAGE(PG8_SA(1, 0), a3, voffA);
            PG8_BAR; PG8_WAIT_L(0); PG8_MMA(1, 0, At, B0); PG8_BAR; PG8_SCHED;
            PG8_STAGE(PG8_SB(1, 1), b3 + hstep, voffB);
            PG8_WAIT_V(6); PG8_BAR; PG8_MMA(1, 1, At, B1); PG8_BAR;
            }
        }
        if constexpr (ALIGN_EPI) { if (wr == 0) PG8_BAR; }
        { const int t2 = opaque_tid(wid_s), w2 = __builtin_amdgcn_readfirstlane(t2 >> 6); E(acc, cur, w2 >> 2, w2 & 3, t2 & 15, (t2 & 63) >> 4); }
        if (!has_next) break;
#pragma unroll
        for (int a = 0; a < 2; ++a)
#pragma unroll
            for (int b = 0; b < 2; ++b)
#pragma unroll
                for (int m = 0; m < 4; ++m)
#pragma unroll
                    for (int n = 0; n < 2; ++n) acc[a][b][m][n] = (f32x4){0.f, 0.f, 0.f, 0.f};
        cur = nxt; cA = nA; cB = nB; ++ui;
        if constexpr (ALIGN_EPI) { if (wr == 1) PG8_BAR; }
    }
    PG8_WAIT_V(0);
    if constexpr (!ALIGN_EPI) { if (wr == 0) PG8_BAR; }
    PG8_BAR;
#undef PG8_SA
#undef PG8_SB
#undef PG8_STAGE
#undef PG8_LDA
#undef PG8_LDB
#undef PG8_MMA
#undef PG8_WAIT_V
#undef PG8_WAIT_L
#undef PG8_BAR
#undef PG8_SCHED
}
}

typedef f32x4 AccT[2][2][4][2];

#define GAS __attribute__((address_space(1)))
__device__ __forceinline__ void store8_bf16(bf16_t* p, const float (&v)[8]) {
    u32x4 w; w.x = cvt_pk_bf16(v[0], v[1]); w.y = cvt_pk_bf16(v[2], v[3]); w.z = cvt_pk_bf16(v[4], v[5]); w.w = cvt_pk_bf16(v[6], v[7]);
    *(GAS u32x4*)p = w;
}
__device__ __forceinline__ void cvt8_bf16(const u32x4 w, float (&v)[8]) {
    v[0] = bflo(w.x); v[1] = bfhi(w.x); v[2] = bflo(w.y); v[3] = bfhi(w.y); v[4] = bflo(w.z); v[5] = bfhi(w.z); v[6] = bflo(w.w); v[7] = bfhi(w.w);
}
__device__ __forceinline__ u32x4 ldg16(const void* p) { return *(const GAS u32x4*)p; }
__device__ __forceinline__ f32x4 ldgf4(const float* p) { return *(const GAS f32x4*)p; }
__device__ __forceinline__ float ldgf(const float* p) { return *(const GAS float*)p; }
__device__ __forceinline__ void load8_bf16(const bf16_t* p, float (&v)[8]) { cvt8_bf16(ldg16(p), v); }
__device__ __forceinline__ void store8_f32(float* p, const float (&v)[8]) {
    *(GAS f32x4*)p = (f32x4){v[0], v[1], v[2], v[3]}; *(GAS f32x4*)(p + 4) = (f32x4){v[4], v[5], v[6], v[7]};
}
__device__ __forceinline__ void load8_f32(const float* p, float (&v)[8]) {
    const f32x4 a = ldgf4(p), b = ldgf4(p + 4);
    v[0] = a[0]; v[1] = a[1]; v[2] = a[2]; v[3] = a[3]; v[4] = b[0]; v[5] = b[1]; v[6] = b[2]; v[7] = b[3];
}
__device__ __forceinline__ void acc8(const AccT& acc, int ai, int bj, int m, float (&v)[8]) {
    const f32x4 a = acc[ai][bj][m][0], b = acc[ai][bj][m][1];
    v[0] = a[0]; v[1] = a[1]; v[2] = a[2]; v[3] = a[3]; v[4] = b[0]; v[5] = b[1]; v[6] = b[2]; v[7] = b[3];
}
#define EPI_FENCE() asm volatile("" ::: "memory")
__device__ __forceinline__ void load_rs8(const float* ssq, int row0, float (&rs)[8]) {
#pragma unroll
    for (int i = 0; i < 8; ++i) rs[i] = ldgf(ssq + row0 + (i >> 2) * 128 + (i & 3) * 16);
#pragma unroll
    for (int i = 0; i < 8; ++i) rs[i] = rsqrtf(rs[i] * (1.0f / DM) + EPS);
}

template <int ACT> __device__ __forceinline__ void epi_plain(const AccT& acc, const float (&rs)[8], bf16_t* dst, int ld, int row0, int c0) {
#pragma unroll
    for (int ai = 0; ai < 2; ++ai)
#pragma unroll
        for (int m = 0; m < 4; ++m) {
            const int row = row0 + ai * 128 + m * 16; const float r = rs[ai * 4 + m];
#pragma unroll
            for (int bj = 0; bj < 2; ++bj) { float v[8]; acc8(acc, ai, bj, m, v);
#pragma unroll
                for (int e = 0; e < 8; ++e) { float z = v[e] * r; if (ACT == 1) z = silu_f(z); if (ACT == 2) z = sigmoid_f(z); v[e] = z; }
                store8_bf16(dst + (size_t)row * ld + c0 + bj * 128, v); }
        }
}
struct EpiInProj {
    static constexpr bool PERM = true;
    const float* ssq; const float* lower; unsigned char* ws;
    __device__ __forceinline__ void operator()(const AccT& acc, const pg8::Unit& u, int wr, int wc, int fr, int fq) const {
        const int colt = u.pn * 256, seg = colt >> 10;
        const int row0 = u.pm * 256 + wr * 64 + fr;
        const int cin = wc * 32 + 8 * fq;
        const int cseg = (colt & 1023) + cin;
        float rs[8]; load_rs8(ssq, row0, rs);
        if (seg == 2 || seg == 3) {
            const int dir = seg - 2;
            float* G = (float*)(ws + (dir ? WS_GB : WS_GF)); bf16_t* KK = (bf16_t*)(ws + (dir ? WS_KB : WS_KF));
#pragma unroll
            for (int bj = 0; bj < 2; ++bj) {
                const int c = cseg + bj * 128; float lb[8]; load8_f32(lower + dir * 1024 + c, lb);
#pragma unroll
                for (int ai = 0; ai < 2; ++ai)
#pragma unroll
                    for (int m = 0; m < 4; ++m) {
                        const int row = row0 + ai * 128 + m * 16; const float r = rs[ai * 4 + m];
                        float v[8], lg[8], kk[8]; acc8(acc, ai, bj, m, v);
#pragma unroll
                        for (int e = 0; e < 8; ++e) { const float z = v[e] * r; const float sg = sigmoid_f(z); const float f = lb[e] + (1.f - lb[e]) * sg;
                            lg[e] = __logf(fmaxf(f, 1e-6f)); kk[e] = (1.f - lb[e]) * fast_rcp(1.f + __expf(z)); }
                        store8_f32(G + (size_t)row * HW + c, lg); store8_bf16(KK + (size_t)row * HW + c, kk);
                    }
            }
        } else if (seg == 7) {
            bf16_t* VT = (bf16_t*)(ws + WS_VT);
#pragma unroll
            for (int ai = 0; ai < 2; ++ai)
#pragma unroll
                for (int m = 0; m < 4; ++m) {
                    const int row = row0 + ai * 128 + m * 16; const float r = rs[ai * 4 + m];
#pragma unroll
                    for (int bj = 0; bj < 2; ++bj) { float v[8]; acc8(acc, ai, bj, m, v); const int c = cseg + bj * 128;
#pragma unroll
                        for (int e = 0; e < 8; ++e) *(GAS bf16_t*)(VT + (size_t)(c + e) * SEQ + row) = f2bf1(v[e] * r); }
                }
        } else if (seg == 0) epi_plain<1>(acc, rs, (bf16_t*)(ws + WS_QH), HW, row0, cseg);
        else if (seg == 1) epi_plain<0>(acc, rs, (bf16_t*)(ws + WS_VH), HW, row0, cseg);
        else if (seg == 4) epi_plain<1>(acc, rs, (bf16_t*)(ws + WS_HG), HW, row0, cseg);
        else if (seg == 5) epi_plain<0>(acc, rs, (bf16_t*)(ws + WS_NQ), HW, row0, cseg);
        else if (seg == 6) epi_plain<0>(acc, rs, (bf16_t*)(ws + WS_NK), HW, row0, cseg);
        else if (seg == 8) epi_plain<1>(acc, rs, (bf16_t*)(ws + WS_NG), HW, row0, cseg);
        else if (seg < 11) epi_plain<2>(acc, rs, (bf16_t*)(ws + WS_MA), DM, row0, colt - 9216 + cin);
        else epi_plain<2>(acc, rs, (bf16_t*)(ws + WS_MB), DM, row0, colt - 11264 + cin);
    }
};

#define EPI_IT(it, ai, m, bj) const int ai = (it) >> 3, m = ((it) >> 1) & 3, bj = (it) & 1
struct EpiBrA {
    static constexpr bool PERM = true;
    const bf16_t* MA; float* T;
    __device__ __forceinline__ void operator()(const AccT& acc, const pg8::Unit& u, int wr, int wc, int fr, int fq) const {
        const int row0 = u.pm * 256 + wr * 64 + fr, c0 = u.pn * 256 + wc * 32 + 8 * fq;
        u32x4 g[2];
        g[0] = ldg16(MA + (size_t)row0 * DM + c0);
#pragma unroll
        for (int it = 0; it < 16; ++it) { EPI_IT(it, ai, m, bj);
            const size_t off = (size_t)(row0 + ai * 128 + m * 16) * DM + c0 + bj * 128;
            if (it + 1 < 16) { EPI_IT(it + 1, ai2, m2, bj2); g[(it + 1) & 1] = ldg16(MA + (size_t)(row0 + ai2 * 128 + m2 * 16) * DM + c0 + bj2 * 128); }
            float v[8], gg[8]; acc8(acc, ai, bj, m, v); cvt8_bf16(g[it & 1], gg);
#pragma unroll
            for (int e = 0; e < 8; ++e) v[e] *= gg[e];
            store8_f32(T + off, v); EPI_FENCE(); }
    }
};
struct EpiBrB {
    static constexpr bool PERM = true;
    const bf16_t* MB; const float* T; bf16_t* Y;
    __device__ __forceinline__ void operator()(const AccT& acc, const pg8::Unit& u, int wr, int wc, int fr, int fq) const {
        const int row0 = u.pm * 256 + wr * 64 + fr, c0 = u.pn * 256 + wc * 32 + 8 * fq;
        u32x4 g[2]; f32x4 t0[2], t1[2];
        { const size_t o = (size_t)row0 * DM + c0; g[0] = ldg16(MB + o); t0[0] = ldgf4(T + o); t1[0] = ldgf4(T + o + 4); }
#pragma unroll
        for (int it = 0; it < 16; ++it) { EPI_IT(it, ai, m, bj);
            const size_t off = (size_t)(row0 + ai * 128 + m * 16) * DM + c0 + bj * 128;
            if (it + 1 < 16) { EPI_IT(it + 1, ai2, m2, bj2); const size_t o = (size_t)(row0 + ai2 * 128 + m2 * 16) * DM + c0 + bj2 * 128; const int b = (it + 1) & 1;
                g[b] = ldg16(MB + o); t0[b] = ldgf4(T + o); t1[b] = ldgf4(T + o + 4); }
            float v[8], gg[8]; acc8(acc, ai, bj, m, v); cvt8_bf16(g[it & 1], gg); const f32x4 ta = t0[it & 1], tb = t1[it & 1];
#pragma unroll
            for (int e = 0; e < 8; ++e) v[e] = (e < 4 ? ta[e & 3] : tb[e & 3]) + v[e] * gg[e];
            store8_bf16(Y + off, v); EPI_FENCE(); }
    }
};
struct EpiWout {
    static constexpr bool PERM = true;
    const bf16_t* xin; bf16_t* XB1; float* ssq_out;
    __device__ __forceinline__ void operator()(const AccT& acc, const pg8::Unit& u, int wr, int wc, int fr, int fq) const {
        const int row0 = u.pm * 256 + wr * 64 + fr, c0 = u.pn * 256 + wc * 32 + 8 * fq;
        u32x4 xb[2];
        xb[0] = ldg16(xin + (size_t)row0 * DM + c0);
        float s = 0.f;
#pragma unroll
        for (int it = 0; it < 16; ++it) { EPI_IT(it, ai, m, bj);
            const int row = row0 + ai * 128 + m * 16; const size_t off = (size_t)row * DM + c0 + bj * 128;
            if (it + 1 < 16) { EPI_IT(it + 1, ai2, m2, bj2); xb[(it + 1) & 1] = ldg16(xin + (size_t)(row0 + ai2 * 128 + m2 * 16) * DM + c0 + bj2 * 128); }
            float v[8], xi[8]; acc8(acc, ai, bj, m, v); cvt8_bf16(xb[it & 1], xi);
#pragma unroll
            for (int e = 0; e < 8; ++e) { v[e] += xi[e]; s += v[e] * v[e]; }
            store8_bf16(XB1 + off, v);
            if (bj == 1) { s += __shfl_xor(s, 16); s += __shfl_xor(s, 32); if (fq == 0) atomicAdd(ssq_out + row, s); s = 0.f; }
            EPI_FENCE(); }
    }
};
struct EpiDummy {
    static constexpr bool PERM = true;
    bf16_t* D;
    __device__ __forceinline__ void operator()(const AccT& acc, const pg8::Unit& u, int wr, int wc, int fr, int fq) const {
        const int row0 = u.pm * 256 + wr * 64 + fr, c0 = (u.pn & 3) * 256 + wc * 32 + 8 * fq;
#pragma unroll
        for (int ai = 0; ai < 2; ++ai)
#pragma unroll
            for (int m = 0; m < 4; ++m) { const int row = row0 + ai * 128 + m * 16;
#pragma unroll
                for (int bj = 0; bj < 2; ++bj) { float v[8]; acc8(acc, ai, bj, m, v); store8_bf16(D + (size_t)row * HW + c0 + bj * 128, v); } }
    }
};
struct EpiPL {
    static constexpr bool PERM = true;
    bf16_t* PL;
    __device__ __forceinline__ void operator()(const AccT& acc, const pg8::Unit& u, int wr, int wc, int fr, int fq) const {
        const int row0 = u.pm * 256 + wr * 64 + fr, c0 = u.pn * 256 + wc * 32 + 8 * fq;
#pragma unroll
        for (int ai = 0; ai < 2; ++ai)
#pragma unroll
            for (int m = 0; m < 4; ++m) { const int row = row0 + ai * 128 + m * 16;
#pragma unroll
                for (int bj = 0; bj < 2; ++bj) { float v[8]; acc8(acc, ai, bj, m, v); store8_bf16(PL + (size_t)row * DM + c0 + bj * 128, v); } }
    }
};
struct EpiGate {
    static constexpr bool PERM = true;
    const float* ssq1; const bf16_t* XB1; const bf16_t* PL; float* xout; bf16_t* XBN; float* ssq_next; int has_next;
    __device__ __forceinline__ void operator()(const AccT& acc, const pg8::Unit& u, int wr, int wc, int fr, int fq) const {
        const int row0 = u.pm * 256 + wr * 64 + fr, c0 = u.pn * 256 + wc * 32 + 8 * fq;
        u32x4 xb[2], pb[2]; float sq[2];
        { const size_t o = (size_t)row0 * DM + c0; xb[0] = ldg16(XB1 + o); pb[0] = ldg16(PL + o); sq[0] = ldgf(ssq1 + row0); }
        float s = 0.f;
#pragma unroll
        for (int it = 0; it < 16; ++it) { EPI_IT(it, ai, m, bj);
            const int row = row0 + ai * 128 + m * 16; const size_t off = (size_t)row * DM + c0 + bj * 128;
            if (it + 1 < 16) { EPI_IT(it + 1, ai2, m2, bj2); const int rown = row0 + ai2 * 128 + m2 * 16; const size_t o = (size_t)rown * DM + c0 + bj2 * 128; const int b = (it + 1) & 1;
                xb[b] = ldg16(XB1 + o); pb[b] = ldg16(PL + o); sq[b] = ldgf(ssq1 + rown); }
            const float r = rsqrtf(sq[it & 1] * (1.0f / DM) + EPS);
            float v[8], x1[8], pl[8]; acc8(acc, ai, bj, m, v); cvt8_bf16(xb[it & 1], x1); cvt8_bf16(pb[it & 1], pl);
#pragma unroll
            for (int e = 0; e < 8; ++e) { const float g = sigmoid_f(v[e] * r); v[e] = x1[e] + pl[e] * g; s += v[e] * v[e]; }
            if (has_next) { store8_bf16(XBN + off, v);
                if (bj == 1) { s += __shfl_xor(s, 16); s += __shfl_xor(s, 32); if (fq == 0) atomicAdd(ssq_next + row, s); s = 0.f; } }
            else store8_f32(xout + off, v);
            EPI_FENCE(); }
    }
};

#define XB_TMO      128
#define XB_XCNT(j)  (256  + 64 * (j))
#define XB_XSUB(j)  (1280 + 64 * (j))
#define XB_XGEN(j)  (2304 + 64 * (j))
#define XB_TOP      3328
#define XB_TOPGEN   3392
#define XCD_BAR_WORDS 3456
#define XB_SPIN_CAP (1u << 18)
__device__ __forceinline__ unsigned xb_ld(unsigned* p)              { return __hip_atomic_load(p, __ATOMIC_RELAXED, __HIP_MEMORY_SCOPE_AGENT); }
__device__ __forceinline__ unsigned xb_add(unsigned* p, unsigned v) { return __hip_atomic_fetch_add(p, v, __ATOMIC_RELAXED, __HIP_MEMORY_SCOPE_AGENT); }
__device__ __forceinline__ unsigned xb_xcc_id() { return (unsigned)__builtin_amdgcn_s_getreg((3 << 11) | 20) & 0xFu; }
#define XB_SPIN(cond, bar) do { unsigned _sp = 0; while (cond) { __builtin_amdgcn_s_sleep(1); \
    if ((++_sp & 255u) == 0u) { if (xb_ld(&(bar)[XB_TMO])) break; if (_sp > XB_SPIN_CAP) { atomicAdd(&(bar)[XB_TMO], 1u); break; } } } } while (0)
struct XcdBarrier { unsigned* bar; unsigned x; volatile LAS unsigned* st; };
__device__ __forceinline__ XcdBarrier xcd_barrier_post(unsigned* bar, volatile LAS unsigned* st) {
    XcdBarrier b; b.bar = bar; b.x = xb_xcc_id(); b.st = st;
    if (threadIdx.x == 0) (void)xb_add(&bar[XB_XCNT(b.x)], 1u);
    return b;
}
__device__ __forceinline__ void xcd_barrier_complete(unsigned* bar, unsigned x, unsigned& nloc, unsigned& nx) {
    const unsigned G = gridDim.x * gridDim.y * gridDim.z;
    unsigned sum, cnt, mine, sp = 0u;
    for (;;) {
        sum = 0u; cnt = 0u; mine = 0u;
#pragma unroll
        for (unsigned j = 0; j < 16; ++j) { const unsigned c = xb_ld(&bar[XB_XCNT(j)]); sum += c; cnt += (c > 0u) ? 1u : 0u; mine = (j == x) ? c : mine; }
        if (sum == G) break;
        __builtin_amdgcn_s_sleep(1);
        if ((++sp & 255u) == 0u) { if (xb_ld(&bar[XB_TMO])) break; if (sp > XB_SPIN_CAP) { atomicAdd(&bar[XB_TMO], 1u); break; } }
    }
    nloc = mine > 0u ? mine : 1u; nx = cnt > 0u ? cnt : 1u;
}
__device__ __forceinline__ void xcd_barrier(const XcdBarrier& b) {
    asm volatile("s_waitcnt vmcnt(0)" ::: "memory");
    __syncthreads();
    if (threadIdx.x == 0) {
        unsigned* bar = b.bar;
        __builtin_amdgcn_s_waitcnt(0);
        unsigned nloc = b.st[0], nx = b.st[1];
        if (nloc == 0u) { xcd_barrier_complete(bar, b.x, nloc, nx); b.st[0] = nloc; b.st[1] = nx; }
        const unsigned old = xb_add(&bar[XB_XSUB(b.x)], 1u);
        const unsigned gen = old / nloc;
        if (old + 1u == (gen + 1u) * nloc) {
            __builtin_amdgcn_fence(__ATOMIC_RELEASE, "agent");
            asm volatile("s_waitcnt vmcnt(0)" ::: "memory");
            const unsigned og = xb_add(&bar[XB_TOP], 1u);
            const unsigned tg = og / nx;
            if (og + 1u == (tg + 1u) * nx) xb_add(&bar[XB_TOPGEN], 1u);
            else XB_SPIN(xb_ld(&bar[XB_TOPGEN]) == tg, bar);
            __builtin_amdgcn_fence(__ATOMIC_ACQUIRE, "agent");
            xb_add(&bar[XB_XGEN(b.x)], 1u);
            asm volatile("s_waitcnt vmcnt(0)" ::: "memory");
        } else {
            XB_SPIN(xb_ld(&bar[XB_XGEN(b.x)]) == gen, bar);
            __builtin_amdgcn_fence(__ATOMIC_ACQUIRE, "agent");
            asm volatile("s_waitcnt vmcnt(0)" ::: "memory");
        }
    }
    __syncthreads();
}

struct Args { const float* in[15]; float* out; unsigned char* ws; int ph_lo, ph_hi; };

__device__ __forceinline__ void transpose_convert(const float* __restrict__ W, bf16_t* __restrict__ WT, int K, int N, LAS float* tile, int rot, const float* kscale) {
    const int tid = threadIdx.x, nb = gridDim.x; const int bid = (int)((blockIdx.x + (unsigned)rot) % (unsigned)nb);
    const int nkt = K / 64, ntile = nkt * (N / 64);
    const int k0 = tid >> 4, c4 = tid & 15;
    f32x4 v0, v1;
#define TC_LOAD(t_) do { const int tk_ = (t_) % nkt, tn_ = (t_) / nkt; const float* s_ = W + (size_t)(tk_ * 64 + k0) * N + tn_ * 64 + c4 * 4; \
        v0 = ldgf4(s_); v1 = ldgf4(s_ + (size_t)32 * N); if (kscale) { v0 = v0 * ldgf(kscale + tk_ * 64 + k0); v1 = v1 * ldgf(kscale + tk_ * 64 + k0 + 32); } } while (0)
    int t = bid, par = 0;
    if (t < ntile) TC_LOAD(t);
    for (; t < ntile; t += nb, par ^= 1) {
        LAS float* tl = tile + par * (64 * 65);
        { LAS float* d = tl + k0 * 65 + c4 * 4; d[0] = v0[0]; d[1] = v0[1]; d[2] = v0[2]; d[3] = v0[3]; d += 32 * 65; d[0] = v1[0]; d[1] = v1[1]; d[2] = v1[2]; d[3] = v1[3]; }
        const int tk = t % nkt, tn = t / nkt;
        if (t + nb < ntile) TC_LOAD(t + nb);
        __syncthreads();
        { const int n = tid >> 3, kq = tid & 7; float v[8];
#pragma unroll
          for (int j = 0; j < 8; ++j) v[j] = tl[(kq * 8 + j) * 65 + n];
          store8_bf16(WT + (size_t)(tn * 64 + n) * K + tk * 64 + kq * 8, v); }
    }
    __syncthreads();
#undef TC_LOAD
}

__device__ __forceinline__ void p0_prologue(const Args& a, LAS unsigned char* lds) {
    unsigned char* ws = a.ws;
    const int tid = threadIdx.x, bid = blockIdx.x, nb = gridDim.x, gtid = bid * 512 + tid, gsz = nb * 512;
    {
        float* LOWER = (float*)(ws + WS_LOWER); const float* lbp = a.in[4];
        for (int i = gtid; i < 2048; i += gsz) { const float a0 = lbp[i], a1 = lbp[2048 + i]; LOWER[i] = 0.f; LOWER[2048 + i] = 1.f / (1.f + expf(a0 - a1)); }
        float* SSQ = (float*)(ws + WS_SSQ);
        for (int i = gtid; i < 3 * SEQ; i += gsz) SSQ[SEQ + i] = 0.f;
    }
    {
        const float* x = a.in[0]; bf16_t* XG = (bf16_t*)(ws + WS_XGA); float* SSQ = (float*)(ws + WS_SSQ);
        const int lane = tid & 63, gw = gtid >> 6, nw = gsz >> 6;
        for (int row = gw; row < SEQ; row += nw) {
            const f32x4* xr = (const f32x4*)(x + (size_t)row * DM); float s = 0.f;
#pragma unroll
            for (int j = 0; j < 8; ++j) { const f32x4 v = xr[j * 64 + lane];
                s += v[0] * v[0] + v[1] * v[1] + v[2] * v[2] + v[3] * v[3];
                u32x2 w; w.x = cvt_pk_bf16(v[0], v[1]); w.y = cvt_pk_bf16(v[2], v[3]);
                *(u32x2*)(XG + (size_t)row * DM + (j * 64 + lane) * 4) = w; }
#pragma unroll
            for (int o = 32; o >= 1; o >>= 1) s += __shfl_xor(s, o);
            if (lane == 0) SSQ[row] = s;
        }
    }
    {
        const f32x4* p = (const f32x4*)a.in[1]; bf16_t* PB = (bf16_t*)(ws + WS_PB);
        for (int i = gtid; i < 2 * SEQ * PLE / 4; i += gsz) { const f32x4 v = p[i]; u32x2 w; w.x = cvt_pk_bf16(v[0], v[1]); w.y = cvt_pk_bf16(v[2], v[3]); *(u32x2*)(PB + (size_t)i * 4) = w; }
    }
    LAS float* tile = (LAS float*)lds;
    for (int l = 0; l < 2; ++l) {
        transpose_convert(a.in[3] + (size_t)l * DM * NIN, (bf16_t*)(ws + WS_WIN) + (size_t)l * NIN * DM, DM, NIN, tile, 0, a.in[2] + l * DM);
        transpose_convert(a.in[9] + (size_t)l * HW * DM, (bf16_t*)(ws + WS_WA) + (size_t)l * DM * HW, HW, DM, tile, 0, nullptr);
        transpose_convert(a.in[10] + (size_t)l * HW * DM, (bf16_t*)(ws + WS_WB) + (size_t)l * DM * HW, HW, DM, tile, 0, nullptr);
        transpose_convert(a.in[11] + (size_t)l * DM * DM, (bf16_t*)(ws + WS_WO) + (size_t)l * DM * DM, DM, DM, tile, 0, nullptr);
        transpose_convert(a.in[13] + (size_t)l * DM * DM, (bf16_t*)(ws + WS_WG) + (size_t)l * DM * DM, DM, DM, tile, 0, a.in[12] + l * DM);
        transpose_convert(a.in[14] + (size_t)l * PLE * DM, (bf16_t*)(ws + WS_WP) + (size_t)l * DM * PLE, PLE, DM, tile, 128, nullptr);
    }
}

constexpr int HP_ROWB = 272;
constexpr int HT_ROWB = 144;

__device__ __forceinline__ void hg_cumsum(const float (&gv)[16], int seg, int kc, int dir, LAS float* SEGS, float (&b)[16], float& bref, float& blast) {
    float c = 0.f;
#pragma unroll
    for (int i = 0; i < 16; ++i) { c += gv[i]; b[i] = c; }
    const float tot = c;
    if (dir) {
#pragma unroll
        for (int i = 0; i < 16; ++i) b[i] = tot - b[i] + gv[i];
    }
    SEGS[seg * 128 + kc] = tot;
    __syncthreads();
    const float t0 = SEGS[kc], t1 = SEGS[128 + kc], t2 = SEGS[256 + kc], t3 = SEGS[384 + kc];
    float off;
    if (!dir) { off = (seg > 0 ? t0 : 0.f) + (seg > 1 ? t1 : 0.f) + (seg > 2 ? t2 : 0.f); bref = t0 + t1; }
    else      { off = (seg < 3 ? t3 : 0.f) + (seg < 2 ? t2 : 0.f) + (seg < 1 ? t1 : 0.f); bref = t2 + t3; }
    blast = (t0 + t1) + (t2 + t3);
#pragma unroll
    for (int i = 0; i < 16; ++i) b[i] += off;
}
__device__ __forceinline__ unsigned short ldg_u16(const bf16_t* p) { return *(const GAS bf16_t*)p; }

__device__ __forceinline__ void h1_phase(const Args& a, LAS unsigned char* lds, int wid_s) {
    unsigned char* ws = opaque_ptr(a.ws);
    const int tid = opaque_tid(wid_s), lane = tid & 63, w = __builtin_amdgcn_readfirstlane(tid >> 6), fr = lane & 15, fq = lane >> 4;
    const int kc = tid & 127, seg = tid >> 7;
    LAS float* SEGS = (LAS float*)lds; LAS float* SC = (LAS float*)(lds + 2048);
    LAS unsigned char* KpT = lds + 4096; LAS unsigned char* Vt = lds + 4096 + 128 * HT_ROWB;
    const bf16_t* VH = (const bf16_t*)(ws + WS_VH);
    bf16_t* LT = (bf16_t*)(ws + WS_LT); float* DD = (float*)(ws + WS_DD); float* EE = (float*)(ws + WS_EE);
    float gv[16]; unsigned short kr_[16], vr_[16];
#define H1_FETCH(item_) do { const int d_ = (item_) >> 10, h_ = ((item_) >> 7) & 7, cs_ = (item_) & 127, n_ = d_ ? 127 - cs_ : cs_; \
        const size_t o_ = (size_t)(64 * n_ + 16 * seg) * HW + h_ * 128 + kc; const float* G_ = (const float*)(ws + (d_ ? WS_GB : WS_GF)) + o_; const bf16_t* K_ = (const bf16_t*)(ws + (d_ ? WS_KB : WS_KF)) + o_; \
        _Pragma("unroll") for (int i = 0; i < 16; ++i) { gv[i] = ldgf(G_ + (size_t)i * HW); kr_[i] = ldg_u16(K_ + (size_t)i * HW); vr_[i] = ldg_u16(VH + o_ + (size_t)i * HW); } } while (0)
    int item = blockIdx.x;
    if (item < 2048) H1_FETCH(item);
    for (; item < 2048; item += gridDim.x) {
        const int d = item >> 10;
        float b[16], bref, blast;
        hg_cumsum(gv, seg, kc, d, SEGS, b, bref, blast);
        {
            unsigned kw[8], vw[8];
#pragma unroll
            for (int i = 0; i < 16; i += 2) {
                const float k0 = bf2f(kr_[i]) * __expf(fminf(bref - b[i], 80.f)), k1 = bf2f(kr_[i + 1]) * __expf(fminf(bref - b[i + 1], 80.f));
                kw[i >> 1] = cvt_pk_bf16(k0, k1);
                vw[i >> 1] = (unsigned)vr_[i] | ((unsigned)vr_[i + 1] << 16);
            }
            LAS u32x4* kd = (LAS u32x4*)(KpT + kc * HT_ROWB + seg * 32); kd[0] = (u32x4){kw[0], kw[1], kw[2], kw[3]}; kd[1] = (u32x4){kw[4], kw[5], kw[6], kw[7]};
            LAS u32x4* vd = (LAS u32x4*)(Vt + kc * HT_ROWB + seg * 32); vd[0] = (u32x4){vw[0], vw[1], vw[2], vw[3]}; vd[1] = (u32x4){vw[4], vw[5], vw[6], vw[7]};
            if (seg == 0) { SC[kc] = __expf(blast - bref); *(GAS float*)(DD + (size_t)item * 128 + kc) = __expf(blast); *(GAS float*)(EE + (size_t)item * 128 + kc) = __expf(bref); }
        }
        if (item + (int)gridDim.x < 2048) H1_FETCH(item + (int)gridDim.x);
        __syncthreads();
        {
            const int vt = w;
            bf16x8 bv[2];
#pragma unroll
            for (int ks = 0; ks < 2; ++ks) bv[ks] = *(const LAS bf16x8*)(Vt + (16 * vt + fr) * HT_ROWB + (32 * ks + 8 * fq) * 2);
            bf16_t* dst = LT + (size_t)item * 16384 + (size_t)(16 * vt + fr) * 128 + 4 * fq;
#pragma unroll
            for (int kt = 0; kt < 8; ++kt) {
                f32x4 acc = (f32x4){0.f, 0.f, 0.f, 0.f};
#pragma unroll
                for (int ks = 0; ks < 2; ++ks) { const bf16x8 af = *(const LAS bf16x8*)(KpT + (16 * kt + fr) * HT_ROWB + (32 * ks + 8 * fq) * 2);
                    acc = __builtin_amdgcn_mfma_f32_16x16x32_bf16(af, bv[ks], acc, 0, 0, 0); }
                const f32x4 sc = *(const LAS f32x4*)(SC + 16 * kt + 4 * fq);
                u32x2 ow; ow.x = cvt_pk_bf16(acc[0] * sc[0], acc[1] * sc[1]); ow.y = cvt_pk_bf16(acc[2] * sc[2], acc[3] * sc[3]);
                *(GAS u32x2*)(dst + 16 * kt) = ow;
            }
        }
        __syncthreads();
    }
#undef H1_FETCH
}

__device__ __forceinline__ void h2_phase(const Args& a, int wid_s) {
    unsigned char* ws = opaque_ptr(a.ws);
    const int tid = opaque_tid(wid_s);
    const bf16_t* LT = (const bf16_t*)(ws + WS_LT); const float* DD = (const float*)(ws + WS_DD); const float* EE = (const float*)(ws + WS_EE);
    bf16_t* SP = (bf16_t*)(ws + WS_SP);
    for (int u = blockIdx.x; u < 256; u += gridDim.x) {
        const int chain = u >> 4, sub = u & 15;
        const int v = 8 * sub + (tid >> 6), k = 2 * (tid & 63);
        const size_t ibase = (size_t)chain * 128;
        float s0 = 0.f, s1 = 0.f;
        for (int cs0 = 0; cs0 < 128; cs0 += 16) {
            unsigned lt[16]; f32x2 dd[16], ee[16];
#pragma unroll
            for (int j = 0; j < 16; ++j) { const size_t it = ibase + cs0 + j;
                lt[j] = *(const GAS unsigned*)(LT + it * 16384 + v * 128 + k); dd[j] = *(const GAS f32x2*)(DD + it * 128 + k); ee[j] = *(const GAS f32x2*)(EE + it * 128 + k); }
#pragma unroll
            for (int j = 0; j < 16; ++j) { const size_t it = ibase + cs0 + j;
                *(GAS unsigned*)(SP + it * 16384 + v * 128 + k) = cvt_pk_bf16(s0 * ee[j][0], s1 * ee[j][1]);
                s0 = dd[j][0] * s0 + bflo(lt[j]); s1 = dd[j][1] * s1 + bfhi(lt[j]); }
        }
    }
}

__device__ __forceinline__ void h3_phase(const Args& a, int layer, LAS unsigned char* lds, int wid_s) {
    unsigned char* ws = opaque_ptr(a.ws);
    const int tid = opaque_tid(wid_s), lane = tid & 63, w = __builtin_amdgcn_readfirstlane(tid >> 6), fr = lane & 15, fq = lane >> 4;
    const int kc = tid & 127, seg = tid >> 7;
    LAS float* SEGS = (LAS float*)lds; LAS float* SSQP = (LAS float*)(lds + 2048);
    LAS unsigned char* Qp = lds + 4096; LAS unsigned char* Kp = Qp + 64 * HP_ROWB; LAS unsigned char* Vt = Kp + 64 * HP_ROWB; LAS unsigned char* Ab = Vt + 128 * HT_ROWB; LAS unsigned char* SPs = Ab + 64 * HT_ROWB;
    const bf16_t* QH = (const bf16_t*)(ws + WS_QH); const bf16_t* VH = (const bf16_t*)(ws + WS_VH); const bf16_t* HG = (const bf16_t*)(ws + WS_HG);
    const bf16_t* SP = (const bf16_t*)(ws + WS_SP); bf16_t* OA = (bf16_t*)(ws + WS_OA);
    const float* onorm = a.in[5] + layer * 128;
    float gv[16]; unsigned short qr_[16], kr_[16], vr_[16]; u32x4 spr[4];
#define H3_FETCH(item_, d_) do { const int n_ = (item_) >> 3, h_ = (item_) & 7, cs_ = (d_) ? 127 - n_ : n_; \
        const size_t o_ = (size_t)(64 * n_ + 16 * seg) * HW + h_ * 128 + kc; const float* G_ = (const float*)(ws + ((d_) ? WS_GB : WS_GF)) + o_; const bf16_t* K_ = (const bf16_t*)(ws + ((d_) ? WS_KB : WS_KF)) + o_; \
        const bf16_t* S_ = SP + (size_t)(((d_) * 8 + h_) * 128 + cs_) * 16384; \
        _Pragma("unroll") for (int i = 0; i < 16; ++i) { gv[i] = ldgf(G_ + (size_t)i * HW); qr_[i] = ldg_u16(QH + o_ + (size_t)i * HW); kr_[i] = ldg_u16(K_ + (size_t)i * HW); vr_[i] = ldg_u16(VH + o_ + (size_t)i * HW); } \
        _Pragma("unroll") for (int i = 0; i < 4; ++i) { const int q_ = tid + 512 * i; spr[i] = ldg16(S_ + (q_ >> 4) * 128 + (q_ & 15) * 8); } } while (0)
    int item = blockIdx.x;
    if (item < 1024) H3_FETCH(item, 0);
    for (; item < 1024; item += gridDim.x) {
        const int n = item >> 3, h = item & 7;
        const int tok0 = 64 * n;
        const int rt = w & 3, vg = w >> 2;
        f32x4 o[4];
#pragma unroll
        for (int j = 0; j < 4; ++j) o[j] = (f32x4){0.f, 0.f, 0.f, 0.f};
        u32x2 hgr[4];
        for (int d = 0; d < 2; ++d) {
            float b[16], bref, blast;
            hg_cumsum(gv, seg, kc, d, SEGS, b, bref, blast);
            {
                unsigned vw[8];
#pragma unroll
                for (int i = 0; i < 16; i += 2) {
                    const float e0 = b[i] - bref, e1 = b[i + 1] - bref;
                    const float q0 = bf2f(qr_[i]) * __expf(fminf(e0, 80.f)), q1 = bf2f(qr_[i + 1]) * __expf(fminf(e1, 80.f));
                    const float k0 = bf2f(kr_[i]) * __expf(fminf(-e0, 80.f)), k1 = bf2f(kr_[i + 1]) * __expf(fminf(-e1, 80.f));
                    *(LAS unsigned short*)(Qp + (16 * seg + i) * HP_ROWB + kc * 2) = f2bf1(q0);
                    *(LAS unsigned short*)(Qp + (16 * seg + i + 1) * HP_ROWB + kc * 2) = f2bf1(q1);
                    *(LAS unsigned short*)(Kp + (16 * seg + i) * HP_ROWB + kc * 2) = f2bf1(k0);
                    *(LAS unsigned short*)(Kp + (16 * seg + i + 1) * HP_ROWB + kc * 2) = f2bf1(k1);
                    vw[i >> 1] = (unsigned)vr_[i] | ((unsigned)vr_[i + 1] << 16);
                }
                LAS u32x4* vd = (LAS u32x4*)(Vt + kc * HT_ROWB + seg * 32); vd[0] = (u32x4){vw[0], vw[1], vw[2], vw[3]}; vd[1] = (u32x4){vw[4], vw[5], vw[6], vw[7]};
#pragma unroll
                for (int i = 0; i < 4; ++i) { const int q = tid + 512 * i; *(LAS u32x4*)(SPs + (q >> 4) * HP_ROWB + (q & 15) * 16) = spr[i]; }
            }
            if (d == 0) H3_FETCH(item, 1);
            else { if (item + (int)gridDim.x < 1024) H3_FETCH(item + (int)gridDim.x, 0);
#pragma unroll
                for (int j = 0; j < 4; ++j) hgr[j] = *(const GAS u32x2*)(HG + (size_t)(tok0 + 16 * rt + fr) * HW + h * 128 + 16 * (4 * vg + j) + 4 * fq); }
            __syncthreads();
            {
                const int art = w >> 1;
#pragma unroll
                for (int tt = 0; tt < 2; ++tt) {
                    const int st = 2 * (w & 1) + tt;
                    const bool need = d ? (st >= art) : (st <= art);
                    f32x4 acc = (f32x4){0.f, 0.f, 0.f, 0.f};
                    if (need) {
#pragma unroll
                        for (int ks = 0; ks < 4; ++ks) {
                            const bf16x8 af = *(const LAS bf16x8*)(Qp + (16 * art + fr) * HP_ROWB + (32 * ks + 8 * fq) * 2);
                            const bf16x8 bfr = *(const LAS bf16x8*)(Kp + (16 * st + fr) * HP_ROWB + (32 * ks + 8 * fq) * 2);
                            acc = __builtin_amdgcn_mfma_f32_16x16x32_bf16(af, bfr, acc, 0, 0, 0);
                        }
                    }
                    const int s_ = 16 * st + fr;
#pragma unroll
                    for (int r = 0; r < 4; ++r) { const int r_ = 16 * art + 4 * fq + r; const bool ok = need && (d ? (s_ >= r_) : (s_ <= r_));
                        *(LAS unsigned short*)(Ab + r_ * HT_ROWB + s_ * 2) = f2bf1(ok ? acc[r] : 0.f); }
                }
            }
            __syncthreads();
            {
                bf16x8 ab[2], qb[4];
#pragma unroll
                for (int ks = 0; ks < 2; ++ks) ab[ks] = *(const LAS bf16x8*)(Ab + (16 * rt + fr) * HT_ROWB + (32 * ks + 8 * fq) * 2);
#pragma unroll
                for (int ks = 0; ks < 4; ++ks) qb[ks] = *(const LAS bf16x8*)(Qp + (16 * rt + fr) * HP_ROWB + (32 * ks + 8 * fq) * 2);
#pragma unroll
                for (int j = 0; j < 4; ++j) {
                    const int vt = 4 * vg + j;
#pragma unroll
                    for (int ks = 0; ks < 2; ++ks) { const bf16x8 af = *(const LAS bf16x8*)(Vt + (16 * vt + fr) * HT_ROWB + (32 * ks + 8 * fq) * 2);
                        o[j] = __builtin_amdgcn_mfma_f32_16x16x32_bf16(af, ab[ks], o[j], 0, 0, 0); }
#pragma unroll
                    for (int ks = 0; ks < 4; ++ks) { const bf16x8 af = *(const LAS bf16x8*)(SPs + (16 * vt + fr) * HP_ROWB + (32 * ks + 8 * fq) * 2);
                        o[j] = __builtin_amdgcn_mfma_f32_16x16x32_bf16(af, qb[ks], o[j], 0, 0, 0); }
                }
            }
            __syncthreads();
        }
        {
            float s = 0.f;
#pragma unroll
            for (int j = 0; j < 4; ++j) s += o[j][0] * o[j][0] + o[j][1] * o[j][1] + o[j][2] * o[j][2] + o[j][3] * o[j][3];
            s += __shfl_xor(s, 16); s += __shfl_xor(s, 32);
            if (fq == 0) SSQP[vg * 64 + 16 * rt + fr] = s;
            __syncthreads();
            const int row = 16 * rt + fr; const float rs = rsqrtf((SSQP[row] + SSQP[64 + row]) * (1.0f / 128.f) + EPS);
#pragma unroll
            for (int j = 0; j < 4; ++j) { const int v0 = 16 * (4 * vg + j) + 4 * fq; const f32x4 on = ldgf4(onorm + v0);
                u32x2 ow; ow.x = cvt_pk_bf16(o[j][0] * rs * on[0] * bflo(hgr[j].x), o[j][1] * rs * on[1] * bfhi(hgr[j].x)); ow.y = cvt_pk_bf16(o[j][2] * rs * on[2] * bflo(hgr[j].y), o[j][3] * rs * on[3] * bfhi(hgr[j].y));
                *(GAS u32x2*)(OA + (size_t)(tok0 + row) * HW + h * 128 + v0) = ow; }
        }
    }
#undef H3_FETCH
}

constexpr int NAT_NB = 36864, NAT_KH = 64 * 272, NAT_VH = 128 * 144;
__device__ __forceinline__ void natten_phase(const Args& a, int layer, LAS unsigned char* lds, int wid_s) {
    unsigned char* ws = opaque_ptr(a.ws);
    const int tid = opaque_tid(wid_s), lane = tid & 63, w = __builtin_amdgcn_readfirstlane(tid >> 6), fr = lane & 15, fq = lane >> 4;
    LAS float* RP = (LAS float*)(lds + 2 * NAT_NB);
    const bf16_t* NQ = (const bf16_t*)(ws + WS_NQ); const bf16_t* NK = (const bf16_t*)(ws + WS_NK); const bf16_t* VT = (const bf16_t*)(ws + WS_VT);
    const bf16_t* NG = (const bf16_t*)(ws + WS_NG); bf16_t* OB = (bf16_t*)(ws + WS_OB);
    const float* gq = a.in[6] + layer * 128; const float* gk = a.in[7] + layer * 128; const float* rpb = a.in[8] + (size_t)layer * 8 * 465;
    for (int it = blockIdx.x; it < 512; it += gridDim.x) {
        const int r = it >> 2, hp = it & 3, hw = w >> 2, h = 2 * hp + hw, j = w & 3;
        const int r_start = min(max(r - 4, 0), 120);
        const bf16_t* ksrc[4]; const bf16_t* vsrc[4]; int kdst[4], vdst[4];
#pragma unroll
        for (int i = 0; i < 4; ++i) { const int q = tid + 512 * i, hd = q >> 10;
            { const int key = (q >> 4) & 63, ch = q & 15; ksrc[i] = NK + (size_t)(64 * r_start + key) * HW + (2 * hp + hd) * 128 + ch * 8; kdst[i] = hd * NAT_KH + key * 272 + ch * 16; }
            { const int d = (q >> 3) & 127, ch = q & 7; vsrc[i] = VT + (size_t)((2 * hp + hd) * 128 + d) * SEQ + 64 * r_start + ch * 8; vdst[i] = hd * NAT_VH + d * 144 + ch * 16; } }
        u32x4 R0[4], R1[4];
#define NAT_LOAD(st, R) do { _Pragma("unroll") for (int i = 0; i < 4; ++i) R[i] = ((st) < 8) ? ldg16(ksrc[i] + (size_t)(st) * 64 * HW) : ldg16(vsrc[i] + ((st) - 8) * 64); } while (0)
#define NAT_WRITE(st, R) do { _Pragma("unroll") for (int i = 0; i < 4; ++i) *(LAS u32x4*)(lds + ((st) & 1) * NAT_NB + (((st) < 8) ? kdst[i] : vdst[i])) = R[i]; } while (0)
        NAT_LOAD(0, R0); NAT_LOAD(1, R1);
        for (int i = tid; i < 930; i += 512) RP[i] = ldgf(rpb + (size_t)(2 * hp) * 465 + i);
        const int c0k = (j == 0) ? 0 : (j == 1) ? 8 : (j == 2) ? 24 : 32;
        const int cq = 16 * j + fr, tq = 64 * r + cq;
        const int cstart = min(max(cq - 8, 0), 48);
        bf16x8 qf[4];
        {
            float qv[4][8]; float ss = 0.f;
#pragma unroll
            for (int ks = 0; ks < 4; ++ks) { load8_bf16(NQ + (size_t)tq * HW + h * 128 + 32 * ks + 8 * fq, qv[ks]);
#pragma unroll
                for (int e = 0; e < 8; ++e) ss += qv[ks][e] * qv[ks][e]; }
            ss += __shfl_xor(ss, 16); ss += __shfl_xor(ss, 32);
            const float rq = rsqrtf(ss * (1.0f / 128.f) + EPS) * 0.08838834764831845f;
#pragma unroll
            for (int ks = 0; ks < 4; ++ks) { float g1[8], g2[8]; load8_f32(gq + 32 * ks + 8 * fq, g1); load8_f32(gk + 32 * ks + 8 * fq, g2);
                u32x4 wv;
                wv.x = cvt_pk_bf16(qv[ks][0] * rq * g1[0] * g2[0], qv[ks][1] * rq * g1[1] * g2[1]); wv.y = cvt_pk_bf16(qv[ks][2] * rq * g1[2] * g2[2], qv[ks][3] * rq * g1[3] * g2[3]);
                wv.z = cvt_pk_bf16(qv[ks][4] * rq * g1[4] * g2[4], qv[ks][5] * rq * g1[5] * g2[5]); wv.w = cvt_pk_bf16(qv[ks][6] * rq * g1[6] * g2[6], qv[ks][7] * rq * g1[7] * g2[7]);
                qf[ks] = __builtin_bit_cast(bf16x8, wv); }
        }
        NAT_WRITE(0, R0);
        __syncthreads();
        float s[8][2][4];
        float mx = -3.0e38f, l = 0.f;
        f32x4 o[8];
#pragma unroll
        for (int dt = 0; dt < 8; ++dt) o[dt] = (f32x4){0.f, 0.f, 0.f, 0.f};
#pragma unroll
        for (int st = 0; st < 16; ++st) {
            if (st + 2 < 16) { if (st & 1) NAT_LOAD(st + 2, R1); else NAT_LOAD(st + 2, R0); }
            LAS unsigned char* buf = lds + (st & 1) * NAT_NB;
            if (st < 8) {
                const int aa = st, kr = r_start + aa, row_off = kr - r + 7;
#pragma unroll
                for (int kt = 0; kt < 2; ++kt) {
                    bf16x8 kf[4]; float ssk = 0.f;
#pragma unroll
                    for (int ks = 0; ks < 4; ++ks) { const u32x4 wv = *(const LAS u32x4*)(buf + hw * NAT_KH + (c0k + 16 * kt + fr) * 272 + (32 * ks + 8 * fq) * 2); kf[ks] = __builtin_bit_cast(bf16x8, wv);
                        ssk += bflo(wv.x) * bflo(wv.x) + bfhi(wv.x) * bfhi(wv.x) + bflo(wv.y) * bflo(wv.y) + bfhi(wv.y) * bfhi(wv.y)
                             + bflo(wv.z) * bflo(wv.z) + bfhi(wv.z) * bfhi(wv.z) + bflo(wv.w) * bflo(wv.w) + bfhi(wv.w) * bfhi(wv.w); }
                    ssk += __shfl_xor(ssk, 16); ssk += __shfl_xor(ssk, 32);
                    const float rk = rsqrtf(ssk * (1.0f / 128.f) + EPS);
                    f32x4 acc = (f32x4){0.f, 0.f, 0.f, 0.f};
#pragma unroll
                    for (int ks = 0; ks < 4; ++ks) acc = __builtin_amdgcn_mfma_f32_16x16x32_bf16(kf[ks], qf[ks], acc, 0, 0, 0);
#pragma unroll
                    for (int rg = 0; rg < 4; ++rg) {
                        const int ki = 4 * fq + rg; const float rki = __shfl(rk, ki);
                        const int kcl = c0k + 16 * kt + ki; const bool valid = (kcl >= cstart) && (kcl < cstart + 16);
                        const int co = min(max(kcl - cq + 15, 0), 30);
                        const float bias = RP[hw * 465 + row_off * 31 + co];
                        const float sv = valid ? (acc[rg] * rki + bias) : -1.0e30f;
                        s[aa][kt][rg] = sv; mx = fmaxf(mx, sv);
                    }
                }
                if (st == 7) {
                    mx = fmaxf(mx, __shfl_xor(mx, 16)); mx = fmaxf(mx, __shfl_xor(mx, 32));
#pragma unroll
                    for (int a2 = 0; a2 < 8; ++a2)
#pragma unroll
                        for (int kt = 0; kt < 2; ++kt)
#pragma unroll
                            for (int rg = 0; rg < 4; ++rg) { const float p = __expf(s[a2][kt][rg] - mx); s[a2][kt][rg] = p; l += p; }
                    l += __shfl_xor(l, 16); l += __shfl_xor(l, 32);
                }
            } else {
                const int aa = st - 8;
                u32x4 pw; pw.x = cvt_pk_bf16(s[aa][0][0], s[aa][0][1]); pw.y = cvt_pk_bf16(s[aa][0][2], s[aa][0][3]); pw.z = cvt_pk_bf16(s[aa][1][0], s[aa][1][1]); pw.w = cvt_pk_bf16(s[aa][1][2], s[aa][1][3]);
                const bf16x8 pb = __builtin_bit_cast(bf16x8, pw);
#pragma unroll
                for (int dt = 0; dt < 8; ++dt) {
                    const LAS unsigned char* vp = buf + hw * NAT_VH + (16 * dt + fr) * 144 + (c0k + 4 * fq) * 2;
                    const u32x2 v0 = *(const LAS u32x2*)vp, v1 = *(const LAS u32x2*)(vp + 32);
                    const u32x4 vw = (u32x4){v0.x, v0.y, v1.x, v1.y};
                    o[dt] = __builtin_amdgcn_mfma_f32_16x16x32_bf16(__builtin_bit_cast(bf16x8, vw), pb, o[dt], 0, 0, 0);
                }
            }
            if (st + 1 < 16) { if (st & 1) NAT_WRITE(st + 1, R0); else NAT_WRITE(st + 1, R1); }
            __syncthreads();
        }
        const float inv = 1.0f / l;
#pragma unroll
        for (int dt = 0; dt < 8; ++dt) {
            const size_t off = (size_t)tq * HW + h * 128 + 16 * dt + 4 * fq;
            const u32x2 gw = *(const GAS u32x2*)(NG + off);
            u32x2 ow; ow.x = cvt_pk_bf16(o[dt][0] * inv * bflo(gw.x), o[dt][1] * inv * bfhi(gw.x)); ow.y = cvt_pk_bf16(o[dt][2] * inv * bflo(gw.y), o[dt][3] * inv * bfhi(gw.y));
            *(GAS u32x2*)(OB + off) = ow;
        }
#undef NAT_LOAD
#undef NAT_WRITE
    }
}

__global__ void __launch_bounds__(512, 2) mk_fwd(Args a) {
    extern __shared__ __attribute__((aligned(16))) unsigned char lds_raw[];
    LAS unsigned char* lds = (LAS unsigned char*)lds_raw;
    volatile LAS unsigned* MISC = (volatile LAS unsigned*)(lds + LDS_MISC_OFF);
    unsigned char* ws = a.ws;
    const int wid_s = __builtin_amdgcn_readfirstlane(threadIdx.x >> 6);
    if (threadIdx.x < 64) MISC[threadIdx.x] = 0u;
    __syncthreads();
    XcdBarrier bar; bar.bar = (unsigned*)(ws + WS_CTL) + 4096; bar.x = 0; bar.st = nullptr;
    const int lo = a.ph_lo, hi = a.ph_hi;
    if (hi - lo > 1) bar = xcd_barrier_post((unsigned*)(ws + WS_CTL) + 4096, MISC + 8);
#ifndef DIAG_MASK
#define DIAG_MASK 0x1ff
#endif
#define DM_(b) ((DIAG_MASK >> (b)) & 1)
#define IN(k) (lo <= (k) && (k) < hi)
#if MK_TS
    unsigned long long* TS = (unsigned long long*)(ws + 131072);
#define STAMP(k) do { if (blockIdx.x == 0 && threadIdx.x == 0) TS[k] = __builtin_amdgcn_s_memrealtime(); } while (0)
#define SEAM(k) do { if (IN(k) && (IN((k) + 1) || (k) == NPHASE - 1)) xcd_barrier(bar); STAMP((k) + 1); } while (0)
    STAMP(0);
#else
#define SEAM(k) do { if (IN(k) && IN((k) + 1)) xcd_barrier(bar); } while (0)
#endif
    const int G = gridDim.x, c = blockIdx.x;

    if (DM_(0) && IN(0)) { for (int rep = 0; rep < (MK_REP_PHASE == 0 ? MK_REP_N : 1); ++rep) { if (rep) xcd_barrier(bar); p0_prologue(a, lds); } }
    SEAM(0);
    for (int l = 0; l < 2; ++l) {
        const int pb = 1 + 7 * l;
        for (int rep = 0; rep < (MK_REP_PHASE == pb + 0 ? MK_REP_N : 1); ++rep) { if (rep) xcd_barrier(bar);
        if (DM_(1) && IN(pb + 0)) {
            unsigned char* ws = opaque_ptr(a.ws); bf16_t* XGA = (bf16_t*)(ws + WS_XGA); float* SSQ = (float*)(ws + WS_SSQ);
            pg8::Gemm g{XGA, (const bf16_t*)(ws + WS_WIN) + (size_t)l * NIN * DM, SEQ, NIN, DM}; pg8::StaticOrder S; S.init(SEQ, NIN, G, c);
            EpiInProj E{SSQ + (2 * l) * SEQ, (const float*)(ws + WS_LOWER) + l * 2048, ws};
            if (MK_REP_DUMMY && rep) { EpiDummy ED{(bf16_t*)(ws + WS_LT)}; pg8::gemm_phase<EpiDummy, pg8::StaticOrder>(lds, g, S, ED, wid_s); } else
            pg8::gemm_phase<EpiInProj, pg8::StaticOrder>(lds, g, S, E, wid_s);
        }
        if (DM_(1) && IN(pb + 0)) {
            unsigned char* ws = opaque_ptr(a.ws);
            const int nfull = (SEQ / 256) * (NIN / 256) % G;
            if (c >= nfull) {
                int kple = PLE; asm volatile("" : "+s"(kple));
                pg8::Gemm g2{(const bf16_t*)(ws + WS_PB) + (size_t)l * SEQ * PLE, (const bf16_t*)(ws + WS_WP) + (size_t)l * DM * PLE, SEQ, DM, kple}; pg8::StaticOrder S2; S2.init(SEQ, DM, G - nfull, c - nfull);
                EpiPL E2{(bf16_t*)(ws + WS_PL)};
                pg8::gemm_phase<EpiPL, pg8::StaticOrder>(lds, g2, S2, E2, wid_s);
            }
        } }
        SEAM(pb + 0);
        if (IN(pb + 1)) { for (int rep = 0; rep < (MK_REP_PHASE == pb + 1 ? MK_REP_N : 1); ++rep) { if (rep) xcd_barrier(bar); if (DM_(2)) h1_phase(a, lds, wid_s); }
            for (int rep = 0; rep < (MK_REP_PHASE == pb + 101 ? MK_REP_N : 1); ++rep) { if (rep) xcd_barrier(bar); if (DM_(8)) natten_phase(a, l, lds, wid_s); } }
        SEAM(pb + 1);
        if (DM_(3) && IN(pb + 2)) { for (int rep = 0; rep < (MK_REP_PHASE == pb + 2 ? MK_REP_N : 1); ++rep) { if (rep) xcd_barrier(bar); h2_phase(a, wid_s); } }
        SEAM(pb + 2);
        if (DM_(4) && IN(pb + 3)) { for (int rep = 0; rep < (MK_REP_PHASE == pb + 3 ? MK_REP_N : 1); ++rep) { if (rep) xcd_barrier(bar); h3_phase(a, l, lds, wid_s); } }
        SEAM(pb + 3);
        for (int rep = 0; rep < (MK_REP_PHASE == pb + 4 ? MK_REP_N : 1); ++rep) { if (rep) xcd_barrier(bar);
        if (DM_(5) && IN(pb + 4)) {
            unsigned char* ws = opaque_ptr(a.ws);
            pg8::StaticOrder S; S.init(SEQ, DM, G, c);
            { pg8::Gemm g{(const bf16_t*)(ws + WS_OA), (const bf16_t*)(ws + WS_WA) + (size_t)l * DM * HW, SEQ, DM, HW};
              EpiBrA E{(const bf16_t*)(ws + WS_MA), (float*)(ws + WS_T)};
              pg8::gemm_phase<EpiBrA, pg8::StaticOrder>(lds, g, S, E, wid_s); }
            { pg8::Gemm g{(const bf16_t*)(ws + WS_OB), (const bf16_t*)(ws + WS_WB) + (size_t)l * DM * HW, SEQ, DM, HW};
              EpiBrB E{(const bf16_t*)(ws + WS_MB), (const float*)(ws + WS_T), (bf16_t*)(ws + WS_Y)};
              pg8::gemm_phase<EpiBrB, pg8::StaticOrder>(lds, g, S, E, wid_s); }
        } }
        SEAM(pb + 4);
        for (int rep = 0; rep < (MK_REP_PHASE == pb + 5 ? MK_REP_N : 1); ++rep) { if (rep) xcd_barrier(bar);
        if (DM_(6) && IN(pb + 5)) {
            unsigned char* ws = opaque_ptr(a.ws); bf16_t* XGB = (bf16_t*)(ws + WS_XGB); float* SSQ = (float*)(ws + WS_SSQ);
            pg8::Gemm g{(const bf16_t*)(ws + WS_Y), (const bf16_t*)(ws + WS_WO) + (size_t)l * DM * DM, SEQ, DM, DM}; pg8::StaticOrder S; S.init(SEQ, DM, G, c);
            EpiWout E{(const bf16_t*)(ws + WS_XGA), XGB, rep ? (float*)(ws + 262144) : SSQ + (2 * l + 1) * SEQ};
            if (MK_REP_DUMMY && rep) { EpiDummy ED{(bf16_t*)(ws + WS_LT)}; pg8::gemm_phase<EpiDummy, pg8::StaticOrder>(lds, g, S, ED, wid_s); } else
            pg8::gemm_phase<EpiWout, pg8::StaticOrder>(lds, g, S, E, wid_s);
        } }
        SEAM(pb + 5);
        for (int rep = 0; rep < (MK_REP_PHASE == pb + 6 ? MK_REP_N : 1); ++rep) { if (rep) xcd_barrier(bar);
        if (DM_(7) && IN(pb + 6)) {
            unsigned char* ws = opaque_ptr(a.ws); bf16_t* XGA = (bf16_t*)(ws + WS_XGA); bf16_t* XGB = (bf16_t*)(ws + WS_XGB); float* SSQ = (float*)(ws + WS_SSQ);
            pg8::StaticOrder S; S.init(SEQ, DM, G, c);
            { pg8::Gemm g{XGB, (const bf16_t*)(ws + WS_WG) + (size_t)l * DM * DM, SEQ, DM, DM};
              EpiGate E{SSQ + (2 * l + 1) * SEQ, XGB, (const bf16_t*)(ws + WS_PL), a.out, XGA, rep ? (float*)(ws + 262144) : SSQ + (2 * l + 2 < 4 ? 2 * l + 2 : 0) * SEQ, l == 0 ? 1 : 0};
              pg8::gemm_phase<EpiGate, pg8::StaticOrder>(lds, g, S, E, wid_s); }
        } }
        SEAM(pb + 6);
    }
#if MK_TS
    if (blockIdx.x == 0) {
        const float dA = (float)(TS[MK_TS_A + 1] - TS[MK_TS_A]) * 0.01f, dB = (float)(TS[MK_TS_B + 1] - TS[MK_TS_B]) * 0.01f;
        for (int i = threadIdx.x; i < 1000000; i += 512) a.out[i] += (i == 0) ? 10.f * dA : 0.3f * dB;
    }
#endif
#undef IN
#undef SEAM
#if MK_ENDFLUSH
    asm volatile("s_waitcnt vmcnt(0)" ::: "memory");
    __builtin_amdgcn_fence(__ATOMIC_RELEASE, "agent");
    asm volatile("s_waitcnt vmcnt(0)" ::: "memory");
#endif
}


#ifndef MK_DIAG
#define MK_DIAG 0
#define MK_HOLE_BUF WS_MB
#define MK_HOLE_LD DM
#define MK_HOLE_MODE 0
#endif
#if MK_DIAG
__global__ void ck_sum(const void* p, size_t n, int kind, double* slot) {
    double s0 = 0.0, s1 = 0.0;
    for (size_t i = (size_t)blockIdx.x * blockDim.x + threadIdx.x; i < n; i += (size_t)gridDim.x * blockDim.x) {
        float v = kind ? bf2f(((const bf16_t*)p)[i]) : ((const float*)p)[i];
        if (!(v == v)) v = 12345.0f;
        const float wgt = (float)((int)((i * 2654435761ull >> 16) & 255) - 128);
        s0 += fabsf(v); s1 += (double)v * wgt;
    }
    for (int o = 32; o >= 1; o >>= 1) { s0 += __shfl_xor(s0, o); s1 += __shfl_xor(s1, o); }
    if ((threadIdx.x & 63) == 0) { atomicAdd(slot, s0); atomicAdd(slot + 1, s1); }
}
__global__ void ck_final(const double* sums, float* out, size_t n, int nslots) {
    int first = -1;
    for (int i = 0; i < nslots; ++i) { const double a0 = sums[2 * i], a1 = sums[2 * i + 1], b0 = sums[2 * (nslots + i)], b1 = sums[2 * (nslots + i) + 1];
        const bool bad = fabs(a0 - b0) > 1e-5 * (fabs(a0) + fabs(b0)) + 1e-30 || fabs(a1 - b1) > 1e-4 * (fabs(a0) + fabs(b0)) + 1e-30;
        if (bad) { first = i; break; } }
    const float val = first < 0 ? 0.f : 100.f * (float)(first + 1);
    for (size_t i = (size_t)blockIdx.x * blockDim.x + threadIdx.x; i < n; i += (size_t)gridDim.x * blockDim.x) out[i] = val;
}
__global__ void ck_holes(const bf16_t* p, size_t n, unsigned long long* res) {
    unsigned long long cnt = 0, mn = ~0ull;
    for (size_t i = (size_t)blockIdx.x * blockDim.x + threadIdx.x; i < n; i += (size_t)gridDim.x * blockDim.x) if (p[i] == 0xFFFFu) { ++cnt; if (i < mn) mn = i; }
    if (cnt) { atomicAdd(res, cnt); atomicMin(res + 1, mn); }
}
__global__ void ck_holes_final(const unsigned long long* res, float* out, size_t n, int mode) {
    const float val = mode == 0 ? (float)((double)res[0] / 65536.0 * 100.0) : mode == 1 ? (float)((res[1] == ~0ull ? 0 : (res[1] / 2048) ) ) + 100.f : (float)((res[1] == ~0ull ? 0 : (res[1] % 2048))) + 100.f;
    for (size_t i = (size_t)blockIdx.x * blockDim.x + threadIdx.x; i < n; i += (size_t)gridDim.x * blockDim.x) out[i] = val;
}
__global__ void ck_diff(const bf16_t* p, const bf16_t* q, size_t n, unsigned long long* res) {
    unsigned long long cnt = 0, mn = ~0ull, big = 0;
    for (size_t i = (size_t)blockIdx.x * blockDim.x + threadIdx.x; i < n; i += (size_t)gridDim.x * blockDim.x) if (p[i] != q[i]) { ++cnt; if (i < mn) mn = i; const float a = bf2f(p[i]), b = bf2f(q[i]); if (fabsf(a - b) > 0.02f * (fabsf(a) + fabsf(b))) ++big; }
    if (cnt) { atomicAdd(res, cnt); atomicMin(res + 1, mn); atomicAdd(res + 2, big); }
}
__global__ void ck_diff_final(const unsigned long long* res, float* out, size_t n, int ld) {
    const unsigned long long cnt = res[0], big = res[2];
    const float c2 = 100.f * (1.f + floorf(log2f(1.f + (float)cnt)));
    const float c1 = 1.0e6f * (1.f + floorf(log2f(1.f + (float)big)));
    for (size_t i = (size_t)blockIdx.x * blockDim.x + threadIdx.x; i < n; i += (size_t)gridDim.x * blockDim.x) out[i] = (i == 0) ? c1 : c2;
}

__device__ __forceinline__ unsigned hsh(unsigned x) { x ^= x >> 16; x *= 0x7feb352du; x ^= x >> 15; x *= 0x846ca68bu; x ^= x >> 16; return x; }
__device__ __forceinline__ float bfr(float f) { return bf2f(f2bf1(f)); }
__device__ __forceinline__ void err_max(unsigned* res, float got, float expv) { float e = fabsf(got - expv) / (0.02f + 0.02f * fabsf(expv)); if (!(e == e)) e = 1e9f; atomicMax(res, __float_as_uint(e)); }
__device__ __forceinline__ float wave_sum(float s) { for (int o = 32; o >= 1; o >>= 1) s += __shfl_xor(s, o); return s; }
__global__ void chk_inproj(const float* x, const float* g0, const float* win, const float* lbp, const unsigned char* ws, unsigned* res, int nsamp) {
    const int lane = threadIdx.x & 63, wv = (blockIdx.x * blockDim.x + threadIdx.x) >> 6, nw = (gridDim.x * blockDim.x) >> 6;
    for (int s = wv; s < nsamp; s += nw) {
        const int row = hsh(2 * s + 1) % SEQ, col = hsh(2 * s + 2) % NIN;
        float ss = 0.f, dot = 0.f;
        for (int k = lane; k < DM; k += 64) { const float xv = x[(size_t)row * DM + k]; ss += xv * xv; dot += bfr(xv * g0[k]) * bfr(win[(size_t)k * NIN + col]); }
        ss = wave_sum(ss); dot = wave_sum(dot);
        const float u = dot * rsqrtf(ss / DM + EPS);
        if (lane == 0) {
            const int seg = col >> 10, c = col & 1023; const size_t o1 = (size_t)row * HW + c;
            const float sg = 1.f / (1.f + expf(-u)), si = u * sg;
            if (seg == 0) err_max(res, bf2f(((const bf16_t*)(ws + WS_QH))[o1]), si);
            else if (seg == 1) err_max(res, bf2f(((const bf16_t*)(ws + WS_VH))[o1]), u);
            else if (seg == 2 || seg == 3) { const int dir = seg - 2; const float a0 = lbp[dir * 1024 + c], a1 = lbp[2048 + dir * 1024 + c]; const float lb = 0.f * (a0 + a1);
                const float f = lb + (1.f - lb) * sg; err_max(res + 1, ((const float*)(ws + (dir ? WS_GB : WS_GF)))[o1], logf(fmaxf(f, 1e-6f)));
                err_max(res + 1, bf2f(((const bf16_t*)(ws + (dir ? WS_KB : WS_KF)))[o1]), (1.f - lb) * (1.f - sg)); }
            else if (seg == 4) err_max(res, bf2f(((const bf16_t*)(ws + WS_HG))[o1]), si);
            else if (seg == 5) err_max(res, bf2f(((const bf16_t*)(ws + WS_NQ))[o1]), u);
            else if (seg == 6) err_max(res, bf2f(((const bf16_t*)(ws + WS_NK))[o1]), u);
            else if (seg == 7) err_max(res + 2, bf2f(((const bf16_t*)(ws + WS_VT))[(size_t)c * SEQ + row]), u);
            else if (seg == 8) err_max(res, bf2f(((const bf16_t*)(ws + WS_NG))[o1]), si);
            else if (seg < 11) err_max(res + 3, bf2f(((const bf16_t*)(ws + WS_MA))[(size_t)row * DM + col - 9216]), sg);
            else err_max(res + 9, bf2f(((const bf16_t*)(ws + WS_MB))[(size_t)row * DM + col - 11264]), sg);
        }
    }
}
__global__ void chk_natten(const unsigned char* ws, const float* gq, const float* gk, const float* rpb, unsigned* res, int nsamp) {
    const int lane = threadIdx.x & 63, wv = (blockIdx.x * blockDim.x + threadIdx.x) >> 6, nw = (gridDim.x * blockDim.x) >> 6;
    const bf16_t* NQ = (const bf16_t*)(ws + WS_NQ); const bf16_t* NK = (const bf16_t*)(ws + WS_NK); const bf16_t* VT = (const bf16_t*)(ws + WS_VT); const bf16_t* NG = (const bf16_t*)(ws + WS_NG); const bf16_t* OB = (const bf16_t*)(ws + WS_OB);
    for (int s = wv; s < nsamp; s += nw) {
        const int t = hsh(3 * s + 7) % SEQ, h = hsh(3 * s + 8) % 8; const int r = t >> 6, c = t & 63;
        const int rs0 = min(max(r - 4, 0), 120), cs0 = min(max(c - 8, 0), 48);
        float q0 = bf2f(NQ[(size_t)t * HW + h * 128 + lane]), q1 = bf2f(NQ[(size_t)t * HW + h * 128 + 64 + lane]);
        const float rq = rsqrtf(wave_sum(q0 * q0 + q1 * q1) / 128.f + EPS); q0 *= rq * gq[lane]; q1 *= rq * gq[64 + lane];
        float mx = -1e30f;
        float o0 = 0.f, o1 = 0.f, l = 0.f;
        for (int pass = 0; pass < 2; ++pass) {
            for (int a = 0; a < 8; ++a) for (int j = 0; j < 16; ++j) {
                const int kr = rs0 + a, kc = cs0 + j, tk = kr * 64 + kc;
                float k0 = bf2f(NK[(size_t)tk * HW + h * 128 + lane]), k1 = bf2f(NK[(size_t)tk * HW + h * 128 + 64 + lane]);
                const float rk = rsqrtf(wave_sum(k0 * k0 + k1 * k1) / 128.f + EPS);
                const float d = wave_sum(q0 * k0 * rk * gk[lane] + q1 * k1 * rk * gk[64 + lane]) * 0.08838834764831845f + rpb[(size_t)h * 465 + (kr - r + 7) * 31 + (kc - c + 15)];
                if (pass == 0) mx = fmaxf(mx, d);
                else { const float p = expf(d - mx); l += p; o0 += p * bf2f(VT[(size_t)(h * 128 + lane) * SEQ + tk]); o1 += p * bf2f(VT[(size_t)(h * 128 + 64 + lane) * SEQ + tk]); }
            }
        }
        const size_t ob = (size_t)t * HW + h * 128;
        err_max(res, bf2f(OB[ob + lane]), o0 / l * bf2f(NG[ob + lane])); err_max(res, bf2f(OB[ob + 64 + lane]), o1 / l * bf2f(NG[ob + 64 + lane]));
    }
}
__global__ void chk_hgrn_scan(const unsigned char* ws, float* OREF, int h0) {
    __shared__ float qs[128], ks[128], fs[128], vs[128], part[4][128];
    const int tid = threadIdx.x, v = tid & 127, kq = tid >> 7; const int h = h0 + (blockIdx.x >> 1), d = blockIdx.x & 1;
    const bf16_t* QH = (const bf16_t*)(ws + WS_QH); const bf16_t* VH = (const bf16_t*)(ws + WS_VH); const bf16_t* KK = (const bf16_t*)(ws + (d ? WS_KB : WS_KF)); const float* G = (const float*)(ws + (d ? WS_GB : WS_GF));
    float S[32];
#pragma unroll
    for (int i = 0; i < 32; ++i) S[i] = 0.f;
    float* out = OREF + (size_t)blockIdx.x * SEQ * 128;
    for (int step = 0; step < SEQ; ++step) {
        const int t = d ? SEQ - 1 - step : step;
        if (tid < 128) { qs[tid] = bf2f(QH[(size_t)t * HW + h * 128 + tid]); ks[tid] = bf2f(KK[(size_t)t * HW + h * 128 + tid]); fs[tid] = expf(G[(size_t)t * HW + h * 128 + tid]); vs[tid] = bf2f(VH[(size_t)t * HW + h * 128 + tid]); }
        __syncthreads();
        float p = 0.f; const float vv = vs[v];
#pragma unroll
        for (int i = 0; i < 32; ++i) { const int k = 32 * kq + i; S[i] = fs[k] * S[i] + ks[k] * vv; p += S[i] * qs[k]; }
        part[kq][v] = p;
        __syncthreads();
        if (tid < 128) out[(size_t)t * 128 + tid] = part[0][tid] + part[1][tid] + part[2][tid] + part[3][tid];
    }
}
__global__ void chk_hgrn_out(const unsigned char* ws, const float* OREF, const float* onorm, unsigned* res, int h0, int nh) {
    const int lane = threadIdx.x & 63, wv = (blockIdx.x * blockDim.x + threadIdx.x) >> 6, nw = (gridDim.x * blockDim.x) >> 6;
    const bf16_t* HG = (const bf16_t*)(ws + WS_HG); const bf16_t* OA = (const bf16_t*)(ws + WS_OA);
    for (int s = wv; s < nh * SEQ; s += nw) {
        const int hh = s / SEQ, t = s % SEQ, h = h0 + hh;
        const float* of = OREF + ((size_t)(2 * hh) * SEQ + t) * 128; const float* ob = OREF + ((size_t)(2 * hh + 1) * SEQ + t) * 128;
        const float a0 = of[lane] + ob[lane], a1 = of[64 + lane] + ob[64 + lane];
        const float rs = rsqrtf(wave_sum(a0 * a0 + a1 * a1) / 128.f + EPS);
        const size_t o = (size_t)t * HW + h * 128;
        err_max(res, bf2f(OA[o + lane]), a0 * rs * onorm[lane] * bf2f(HG[o + lane])); err_max(res, bf2f(OA[o + 64 + lane]), a1 * rs * onorm[64 + lane] * bf2f(HG[o + 64 + lane]));
    }
}
__global__ void chk_branch(const unsigned char* ws, const float* wa, const float* wb, unsigned* res, int nsamp) {
    const int lane = threadIdx.x & 63, wv = (blockIdx.x * blockDim.x + threadIdx.x) >> 6, nw = (gridDim.x * blockDim.x) >> 6;
    const bf16_t* OA = (const bf16_t*)(ws + WS_OA); const bf16_t* OB = (const bf16_t*)(ws + WS_OB); const bf16_t* MA = (const bf16_t*)(ws + WS_MA); const bf16_t* MB = (const bf16_t*)(ws + WS_MB); const bf16_t* Y = (const bf16_t*)(ws + WS_Y);
    for (int s = wv; s < nsamp; s += nw) {
        const int row = hsh(5 * s + 1) % SEQ, col = hsh(5 * s + 2) % DM; float da = 0.f, db = 0.f;
        for (int k = lane; k < HW; k += 64) { da += bf2f(OA[(size_t)row * HW + k]) * bfr(wa[(size_t)k * DM + col]); db += bf2f(OB[(size_t)row * HW + k]) * bfr(wb[(size_t)k * DM + col]); }
        da = wave_sum(da); db = wave_sum(db);
        if (lane == 0) err_max(res, bf2f(Y[(size_t)row * DM + col]), bf2f(MA[(size_t)row * DM + col]) * da + bf2f(MB[(size_t)row * DM + col]) * db);
    }
}
__global__ void chk_wout(const unsigned char* ws, const float* xin, const float* wo, unsigned* res, int nsamp) {
    const int lane = threadIdx.x & 63, wv = (blockIdx.x * blockDim.x + threadIdx.x) >> 6, nw = (gridDim.x * blockDim.x) >> 6;
    const bf16_t* Y = (const bf16_t*)(ws + WS_Y); const float* X1 = (const float*)(ws + WS_X1);
    for (int s = wv; s < nsamp; s += nw) {
        const int row = hsh(7 * s + 1) % SEQ, col = hsh(7 * s + 2) % DM; float d = 0.f;
        for (int k = lane; k < DM; k += 64) d += bf2f(Y[(size_t)row * DM + k]) * bfr(wo[(size_t)k * DM + col]);
        d = wave_sum(d);
        if (lane == 0) err_max(res, X1[(size_t)row * DM + col], xin[(size_t)row * DM + col] + d);
    }
}
__global__ void chk_gate(const unsigned char* ws, const float* out, const float* p, const float* wp, const float* wg, const float* pn, unsigned* res, int nsamp) {
    const int lane = threadIdx.x & 63, wv = (blockIdx.x * blockDim.x + threadIdx.x) >> 6, nw = (gridDim.x * blockDim.x) >> 6;
    const float* X1 = (const float*)(ws + WS_X1);
    for (int s = wv; s < nsamp; s += nw) {
        const int row = hsh(9 * s + 1) % SEQ, col = hsh(9 * s + 2) % DM; float d = 0.f, ss = 0.f, pl = 0.f;
        for (int k = lane; k < DM; k += 64) { const float xv = X1[(size_t)row * DM + k]; ss += xv * xv; d += bfr(xv * pn[k]) * bfr(wg[(size_t)k * DM + col]); }
        for (int k = lane; k < PLE; k += 64) pl += bfr(p[(size_t)row * PLE + k]) * bfr(wp[(size_t)k * DM + col]);
        d = wave_sum(d); ss = wave_sum(ss); pl = wave_sum(pl);
        if (lane == 0) { const float g = 1.f / (1.f + expf(-d * rsqrtf(ss / DM + EPS))); err_max(res, out[(size_t)row * DM + col], X1[(size_t)row * DM + col] + pl * g); }
    }
}
__global__ void chk_final(const unsigned* res, float* out, size_t n, int nres) {
    int first = -1; for (int i = 0; i < nres; ++i) if (__uint_as_float(res[i]) > 1.0f) { first = i; break; }
    float bucket = 0.f; if (first >= 0) { const float e = __uint_as_float(res[first]); bucket = fminf(fmaxf(floorf(log10f(e)) + 1.f, 0.f), 9.f); }
    const float val = first < 0 ? 0.f : 100.f * (float)(first + 1) + 10.f * bucket;
    for (size_t i = (size_t)blockIdx.x * blockDim.x + threadIdx.x; i < n; i += (size_t)gridDim.x * blockDim.x) out[i] = val;
}

__global__ void ck_big(const bf16_t* p, size_t n, unsigned long long* res) {
    unsigned long long c0 = 0, c2 = 0, c4 = 0; float mxv = 0.f;
    for (size_t i = (size_t)blockIdx.x * blockDim.x + threadIdx.x; i < n; i += (size_t)gridDim.x * blockDim.x) { const float v = bf2f(p[i]);
        if (!(fabsf(v) <= 3.0e38f)) ++c0; else if (fabsf(v) > 1.01f || v < -0.01f) { ++c2; mxv = fmaxf(mxv, fabsf(v)); if (v < 0.f) ++c4; } }
    if (c0 | c2) { atomicAdd(res, c0); atomicAdd(res + 2, c2); atomicAdd(res + 4, c4); atomicMax((unsigned*)(res + 3), __float_as_uint(mxv)); }
}
__global__ void ck_big_final(const unsigned long long* res, float* out, size_t n, int ld) {
    const float mxv = __uint_as_float((unsigned)res[3]);
    const float c1 = 1.0e4f * (1.f + floorf(log2f(1.f + (float)res[0])));
    const float negf = res[2] ? (float)res[4] / (float)res[2] : 0.f;
    const float c2 = 1000.f * (1.f + floorf(negf * 3.99f)) + 100.f * fminf(fmaxf(floorf(log10f(fmaxf(mxv, 1e-9f))) + 2.f, 0.f), 9.f);
    for (size_t i = (size_t)blockIdx.x * blockDim.x + threadIdx.x; i < n; i += (size_t)gridDim.x * blockDim.x) out[i] = (i == 0) ? c1 : c2;
}
struct CkBuf { int phase; int idx; size_t off; size_t n; int kind; };
#endif

extern "C" void kernel_launch(void* const* d_in, const int* in_sizes, int n_in, void* d_out, int out_size, void* d_ws, size_t ws_size, hipStream_t stream) {
    static int grid = 0;
    if (grid == 0) {
        if (n_in != 15 || out_size != SEQ * DM || ws_size < WS_END) { fprintf(stderr, "kernel_launch: unexpected problem (n_in %d, out %d, ws %zu)\n", n_in, out_size, ws_size); grid = -1; return; }
        int dev = 0, cus = 0;
        if (hipGetDevice(&dev) != hipSuccess || hipDeviceGetAttribute(&cus, hipDeviceAttributeMultiprocessorCount, dev) != hipSuccess) { grid = -1; return; }
        if (hipFuncSetAttribute((const void*)mk_fwd, hipFuncAttributeMaxDynamicSharedMemorySize, LDS_BYTES) != hipSuccess) { fprintf(stderr, "kernel_launch: hipFuncSetAttribute failed\n"); grid = -1; return; }
        int per_cu = 0;
        if (hipOccupancyMaxActiveBlocksPerMultiprocessor(&per_cu, (const void*)mk_fwd, 512, LDS_BYTES) != hipSuccess || per_cu < 1) fprintf(stderr, "kernel_launch: occupancy query says %d\n", per_cu);
        (void)hipGetLastError();
        grid = cus;
    }
    if (grid < 0) return;
    (void)hipMemsetAsync((char*)d_ws + WS_CTL, 0, CTL_ZERO_BYTES, stream);
    Args a{};
    for (int i = 0; i < 15; ++i) a.in[i] = (const float*)d_in[i];
    a.out = (float*)d_out; a.ws = (unsigned char*)d_ws;
#if MK_DIAG == 5
    {
        unsigned long long* res = (unsigned long long*)((char*)d_ws + 65536);
        (void)hipMemsetAsync((char*)d_ws + 65536 + 8, 0xFF, 8, stream);
        for (int ph = 0; ph < 2; ++ph) { a.ph_lo = ph; a.ph_hi = ph + 1; hipLaunchKernelGGL(mk_fwd, dim3(grid), dim3(512), LDS_BYTES, stream, a); }
        hipLaunchKernelGGL(ck_big, dim3(1024), dim3(256), 0, stream, (const bf16_t*)((char*)d_ws + WS_MA), (size_t)SEQ * DM, res);
        hipLaunchKernelGGL(ck_big_final, dim3(1024), dim3(256), 0, stream, (const unsigned long long*)res, (float*)d_out, (size_t)SEQ * DM, DM);
    }
#elif MK_DIAG == 4
    {
        unsigned* res = (unsigned*)((char*)d_ws + 65536);
        float* OREF = (float*)((char*)d_ws + 728 * MiB);
        const unsigned char* wsc = (const unsigned char*)d_ws;
        const float* const* in = a.in;
        for (int ph = 0; ph < NPHASE; ++ph) {
            a.ph_lo = ph; a.ph_hi = ph + 1; hipLaunchKernelGGL(mk_fwd, dim3(grid), dim3(512), LDS_BYTES, stream, a);
            if (ph == 1) hipLaunchKernelGGL(chk_inproj, dim3(512), dim3(256), 0, stream, in[0], in[2], in[3], in[4], wsc, res + 0, 32768);
            if (ph == 2) hipLaunchKernelGGL(chk_natten, dim3(256), dim3(256), 0, stream, wsc, in[6], in[7], in[8], res + 4, 1024);
            if (ph == 4) { hipLaunchKernelGGL(chk_hgrn_scan, dim3(4), dim3(512), 0, stream, wsc, OREF, 2);
                           hipLaunchKernelGGL(chk_hgrn_out, dim3(512), dim3(256), 0, stream, wsc, (const float*)OREF, in[5], res + 5, 2, 2); }
            if (ph == 5) hipLaunchKernelGGL(chk_branch, dim3(512), dim3(256), 0, stream, wsc, in[9], in[10], res + 6, 8192);
            if (ph == 6) hipLaunchKernelGGL(chk_wout, dim3(512), dim3(256), 0, stream, wsc, in[0], in[11], res + 7, 8192);
            if (ph == 7) hipLaunchKernelGGL(chk_gate, dim3(512), dim3(256), 0, stream, wsc, (const float*)d_out, in[1], in[14], in[13], in[12], res + 8, 8192);
        }
        hipLaunchKernelGGL(chk_final, dim3(1024), dim3(256), 0, stream, (const unsigned*)res, (float*)d_out, (size_t)SEQ * DM, 10);
    }
#elif MK_DIAG == 3
    {
        unsigned long long* res = (unsigned long long*)((char*)d_ws + 65536);
        bf16_t* SAVE = (bf16_t*)((char*)d_ws + 728 * MiB);
        (void)hipMemsetAsync((char*)d_ws + MiB, 0xAA, WS_END - MiB, stream);
        (void)hipMemsetAsync((char*)d_ws + 65536 + 8, 0xFF, 8, stream);
        for (int ph = 0; ph < 2; ++ph) { a.ph_lo = ph; a.ph_hi = ph + 1; hipLaunchKernelGGL(mk_fwd, dim3(grid), dim3(512), LDS_BYTES, stream, a); }
        (void)hipMemcpyAsync(SAVE, (char*)d_ws + MK_HOLE_BUF, (size_t)SEQ * MK_HOLE_LD * 2, hipMemcpyDeviceToDevice, stream);
        a.ph_lo = 1; a.ph_hi = 2; hipLaunchKernelGGL(mk_fwd, dim3(grid), dim3(512), LDS_BYTES, stream, a);
        hipLaunchKernelGGL(ck_diff, dim3(1024), dim3(256), 0, stream, (const bf16_t*)((char*)d_ws + MK_HOLE_BUF), (const bf16_t*)SAVE, (size_t)SEQ * MK_HOLE_LD, res);
        hipLaunchKernelGGL(ck_diff_final, dim3(1024), dim3(256), 0, stream, (const unsigned long long*)res, (float*)d_out, (size_t)SEQ * DM, MK_HOLE_LD);
    }
#elif MK_DIAG == 2
    {
        unsigned long long* res = (unsigned long long*)((char*)d_ws + 65536);
        (void)hipMemsetAsync((char*)d_ws + MiB, 0xAA, WS_END - MiB, stream);
        (void)hipMemsetAsync((char*)d_ws + 65536 + 8, 0xFF, 8, stream);
        a.ph_lo = 0; a.ph_hi = 1; hipLaunchKernelGGL(mk_fwd, dim3(grid), dim3(512), LDS_BYTES, stream, a);
        (void)hipMemsetAsync((char*)d_ws + MK_HOLE_BUF, 0xFF, (size_t)SEQ * MK_HOLE_LD * 2, stream);
        a.ph_lo = 1; a.ph_hi = 2; hipLaunchKernelGGL(mk_fwd, dim3(grid), dim3(512), LDS_BYTES, stream, a);
        hipLaunchKernelGGL(ck_holes, dim3(1024), dim3(256), 0, stream, (const bf16_t*)((char*)d_ws + MK_HOLE_BUF), (size_t)SEQ * MK_HOLE_LD, res);
        hipLaunchKernelGGL(ck_holes_final, dim3(1024), dim3(256), 0, stream, (const unsigned long long*)res, (float*)d_out, (size_t)SEQ * DM, MK_HOLE_MODE);
    }
#elif MK_DIAG
    {
        static const CkBuf B0[] = {
            {0, 0, WS_LOWER, 4096, 0}, {0, 1, WS_SSQ, 8192, 0}, {0, 2, WS_XGA, (size_t)SEQ * DM, 1}, {0, 3, WS_PB, (size_t)2 * SEQ * PLE, 1}, {0, 4, WS_WIN, (size_t)2 * NIN * DM, 1},
            {0, 5, WS_WA, (size_t)2 * DM * HW, 1}, {0, 6, WS_WB, (size_t)2 * DM * HW, 1}, {0, 7, WS_WO, (size_t)2 * DM * DM, 1}, {0, 8, WS_WG, (size_t)2 * DM * DM, 1}, {0, 9, WS_WP, (size_t)2 * DM * PLE, 1} };
        static const CkBuf BL[] = {
            {0, 10, WS_QH, (size_t)SEQ * HW, 1}, {0, 11, WS_VH, (size_t)SEQ * HW, 1}, {0, 12, WS_KF, (size_t)SEQ * HW, 1}, {0, 13, WS_KB, (size_t)SEQ * HW, 1}, {0, 14, WS_HG, (size_t)SEQ * HW, 1},
            {0, 15, WS_NQ, (size_t)SEQ * HW, 1}, {0, 16, WS_NK, (size_t)SEQ * HW, 1}, {0, 17, WS_VT, (size_t)SEQ * HW, 1}, {0, 18, WS_NG, (size_t)SEQ * HW, 1}, {0, 19, WS_GF, (size_t)SEQ * HW, 0},
            {0, 20, WS_GB, (size_t)SEQ * HW, 0}, {0, 21, WS_MA, (size_t)SEQ * DM, 1}, {0, 22, WS_MB, (size_t)SEQ * DM, 1},
            {1, 23, WS_LT, (size_t)2048 * 16384, 0}, {1, 24, WS_DD, (size_t)2048 * 128, 0}, {1, 25, WS_EE, (size_t)2048 * 128, 0}, {1, 26, WS_OB, (size_t)SEQ * HW, 1},
            {2, 27, WS_SP, (size_t)2048 * 16384, 1}, {3, 28, WS_OA, (size_t)SEQ * HW, 1}, {4, 29, WS_T, (size_t)SEQ * DM, 0}, {4, 30, WS_Y, (size_t)SEQ * DM, 1},
            {5, 31, WS_X1, (size_t)SEQ * DM, 0}, {5, 32, WS_XGB, (size_t)SEQ * DM, 1}, {6, 34, WS_PL, (size_t)SEQ * DM, 0}, {6, 35, (size_t)-1, (size_t)SEQ * DM, 0} };
        const int NS = 80;
        double* sums = (double*)((char*)d_ws + 65536);
        (void)hipMemsetAsync((char*)d_ws + MiB, 0xAA, WS_END - MiB, stream);
        for (int run = 0; run < 2; ++run) {
            (void)hipMemsetAsync((char*)d_ws + WS_CTL, 0, 32768, stream);
            for (int ph = 0; ph < NPHASE; ++ph) {
                a.ph_lo = ph; a.ph_hi = ph + 1; hipLaunchKernelGGL(mk_fwd, dim3(grid), dim3(512), LDS_BYTES, stream, a);
                if (ph == 0) { for (const CkBuf& b : B0) hipLaunchKernelGGL(ck_sum, dim3(1024), dim3(256), 0, stream, (const void*)((char*)d_ws + b.off), b.n, b.kind, sums + 2 * (run * NS + b.idx)); }
                else { const int l = (ph - 1) / 7, k = (ph - 1) % 7;
                    for (const CkBuf& b : BL) if (b.phase == k) hipLaunchKernelGGL(ck_sum, dim3(1024), dim3(256), 0, stream, b.off == (size_t)-1 ? (const void*)d_out : (const void*)((char*)d_ws + b.off), b.n, b.kind, sums + 2 * (run * NS + b.idx + 40 * l)); }
            }
        }
        hipLaunchKernelGGL(ck_final, dim3(1024), dim3(256), 0, stream, (const double*)sums, (float*)d_out, (size_t)SEQ * DM, NS);
    }
#elif MK_MULTI
    for (int ph = 0; ph < NPHASE; ++ph) { a.ph_lo = ph; a.ph_hi = ph + 1; hipLaunchKernelGGL(mk_fwd, dim3(grid), dim3(512), LDS_BYTES, stream, a); }
#else
    a.ph_lo = 0; a.ph_hi = NPHASE; hipLaunchKernelGGL(mk_fwd, dim3(grid), dim3(512), LDS_BYTES, stream, a);
#endif
}
```

```cpp
#include <hip/hip_runtime.h>
#include <cstdio>
#include <cstdint>

#ifndef MK_ALIGN
#define MK_ALIGN true
#endif
#ifndef MK_SP2
#define MK_SP2 true
#endif
#ifndef MK_TS
#define MK_TS 0
#endif
#ifndef MK_TS_A
#define MK_TS_A 0
#define MK_TS_B 1
#endif
#ifndef MK_REP_PHASE
#define MK_REP_PHASE -1
#endif
#ifndef MK_REP_DUMMY
#define MK_REP_DUMMY 0
#endif
#ifndef MK_REP_N
#define MK_REP_N 3
#endif
#ifndef MK_ENDFLUSH
#define MK_ENDFLUSH 0
#endif
#ifndef MK_MULTI
#define MK_MULTI 0
#endif

#define LAS __attribute__((address_space(3)))
typedef unsigned short bf16_t;
typedef short bf16x8 __attribute__((ext_vector_type(8)));
typedef float f32x4 __attribute__((ext_vector_type(4)));
typedef float f32x2 __attribute__((ext_vector_type(2)));
typedef unsigned u32x4 __attribute__((ext_vector_type(4)));
typedef unsigned u32x2 __attribute__((ext_vector_type(2)));

constexpr int SEQ = 8192, DM = 2048, NIN = 13312, HW = 1024, PLE = 256;
constexpr float EPS = 1e-6f;
constexpr int NPHASE = 15;

constexpr size_t MiB = 1u << 20;
constexpr size_t WS_CTL = 0, CTL_ZERO_BYTES = 1 * MiB;
constexpr size_t WS_LOWER = 1 * MiB;
constexpr size_t WS_SSQ = 1 * MiB + 64 * 1024;
constexpr size_t WS_DD = 2 * MiB;
constexpr size_t WS_EE = 3 * MiB;
constexpr size_t WS_WIN = 4 * MiB;
constexpr size_t WS_WA = 108 * MiB;
constexpr size_t WS_WB = 116 * MiB;
constexpr size_t WS_WO = 124 * MiB;
constexpr size_t WS_WG = 140 * MiB;
constexpr size_t WS_WP = 156 * MiB;
constexpr size_t WS_PB = 158 * MiB;
constexpr size_t WS_XGA = 166 * MiB;
constexpr size_t WS_XGB = 198 * MiB;
constexpr size_t WS_QH = 230 * MiB;
constexpr size_t WS_VH = 246 * MiB;
constexpr size_t WS_KF = 262 * MiB;
constexpr size_t WS_KB = 278 * MiB;
constexpr size_t WS_HG = 294 * MiB;
constexpr size_t WS_NQ = 310 * MiB;
constexpr size_t WS_NK = 326 * MiB;
constexpr size_t WS_VT = 342 * MiB;
constexpr size_t WS_NG = 358 * MiB;
constexpr size_t WS_OA = 374 * MiB;
constexpr size_t WS_OB = 390 * MiB;
constexpr size_t WS_GF = 406 * MiB;
constexpr size_t WS_GB = 438 * MiB;
constexpr size_t WS_MA = 470 * MiB;
constexpr size_t WS_MB = 502 * MiB;
constexpr size_t WS_LT = 534 * MiB;
constexpr size_t WS_SP = 662 * MiB;
constexpr size_t WS_PL = 726 * MiB;
constexpr size_t WS_END = 758 * MiB;
constexpr size_t WS_T = WS_LT;
constexpr size_t WS_Y = WS_SP;

constexpr int LDS_BYTES = 147456;
constexpr int LDS_MISC_OFF = 131072;

typedef __bf16 bf16x2_t __attribute__((ext_vector_type(2)));
__device__ __forceinline__ unsigned cvt_pk_bf16(float lo, float hi) { bf16x2_t v = {(__bf16)lo, (__bf16)hi}; return __builtin_bit_cast(unsigned, v); }
__device__ __forceinline__ float bf2f(unsigned short b) { return __uint_as_float(((unsigned)b) << 16); }
__device__ __forceinline__ float bflo(unsigned w) { return __uint_as_float(w << 16); }
__device__ __forceinline__ float bfhi(unsigned w) { return __uint_as_float(w & 0xffff0000u); }
__device__ __forceinline__ unsigned short f2bf1(float f) { return (unsigned short)(cvt_pk_bf16(f, 0.f) & 0xffffu); }
__device__ __forceinline__ float fast_rcp(float x) { return __builtin_amdgcn_rcpf(x); }
__device__ __forceinline__ float sigmoid_f(float x) { return fast_rcp(1.f + __expf(-x)); }
__device__ __forceinline__ float silu_f(float x) { return x * sigmoid_f(x); }

__device__ __forceinline__ int opaque_tid(int wid_s) { int lane; asm volatile("v_mbcnt_lo_u32_b32 %0, -1, 0\n\tv_mbcnt_hi_u32_b32 %0, -1, %0" : "=v"(lane)); asm volatile("" : "+s"(wid_s)); return wid_s * 64 + lane; }
__device__ __forceinline__ unsigned char* opaque_ptr(unsigned char* p) { asm volatile("" : "+s"(p)); return p; }
__device__ __forceinline__ int opaque_bid() { int b = blockIdx.x; asm volatile("" : "+s"(b)); return b; }
namespace pg8 {
#define PG8_LAS __attribute__((address_space(3)))
constexpr int BM = 256, BK = 64, HALF = 128, HTB = HALF * BK * 2, STAGE_BYTES = 8 * HTB, NXCD = 8, WGM = 8;
__host__ __device__ __forceinline__ int lds_byte(int r, int c) { const int st = (r >> 4) * 2 + (c >> 5), rr = r & 15, cc = c & 31, ob = rr * 64 + cc * 2; return st * 1024 + (ob ^ (((ob >> 9) & 1) << 5)); }
__host__ __device__ __forceinline__ void stage_rc(int b, int& R, int& C) { const int st = b / 1024, sb = b % 1024, swz = sb ^ (((sb >> 9) & 1) << 5); R = (st >> 1) * 16 + swz / 64; C = (st & 1) * 32 + (swz % 64) / 2; }
__host__ __device__ __forceinline__ int perm32(int rho) { const int n = rho >> 4, i = rho & 15; return 8 * (i >> 2) + 4 * n + (i & 3); }

struct Unit { int pm, pn, z; };
struct Gemm { const bf16_t* A; const bf16_t* Bt; int M, N, K; const bf16_t* A2; const bf16_t* Bt2; };

struct StaticOrder {
    int nM, nN, nwg, G, c;
    __host__ __device__ void init(int M, int N, int G_, int c_) { nM = M / BM; nN = N / BM; nwg = nM * nN; G = G_; c = c_; }
    __host__ __device__ bool next(int i, Unit& u) const {
        const long L = (long)i * G + c; if (L >= nwg) return false;
        int wgid = (int)L; { const int q = nwg / NXCD, r = nwg % NXCD, xcd = wgid % NXCD, off = wgid / NXCD; wgid = (xcd < r ? xcd * (q + 1) : r * (q + 1) + (xcd - r) * q) + off; }
        const int nig = WGM * nN, gid = wgid / nig, fm = gid * WGM, gsz = (nM - fm) < WGM ? (nM - fm) : WGM;
        u.pm = fm + ((wgid % nig) % gsz); u.pn = (wgid % nig) / gsz; u.z = 0; return true;
    }
    __device__ __forceinline__ void a_ready(const Unit&) const {}
    __device__ __forceinline__ void done(const Unit&) const {}
};
struct PairOrder : StaticOrder {
    __host__ __device__ bool next(int i, Unit& u) const { const bool ok = StaticOrder::next(i >> 1, u); u.z = i & 1; return ok; }
};

template <class Epi, class Sched, bool ALIGN_EPI = MK_ALIGN, bool SP2 = MK_SP2>
__device__ __forceinline__ void gemm_phase(PG8_LAS unsigned char* lds, const Gemm g, const Sched& S, const Epi& E, int wid_s) {
    const int tid = opaque_tid(wid_s), wid = __builtin_amdgcn_readfirstlane(tid >> 6), lane = tid & 63, wr = wid >> 2, wc = wid & 3, fr = lane & 15, fq = lane >> 4;
    const int K = g.K, nt = K / BK;
    unsigned voffA[2], voffB[2];
#pragma unroll
    for (int i = 0; i < 2; ++i) { int R, C; stage_rc(tid * 16 + i * 8192, R, C); const int Rb = Epi::PERM ? ((R & ~31) + perm32(R & 31)) : R;
        voffA[i] = (unsigned)(R * K + C) * 2u; voffB[i] = (unsigned)(Rb * K + C) * 2u; }
    const size_t kstep = (size_t)(BK * 2);
    const size_t hstep = (size_t)HALF * K * 2;
    const size_t tstep = 2 * hstep;
    const unsigned ldsw = (unsigned)wid * 1024u;
    const int aoff = lds_byte(wr * 64 + fr, fq * 8), boff = lds_byte(wc * 32 + fr, fq * 8);
#define PG8_SA(b, h) (((b) * 2 + (h)) * HTB)
#define PG8_SB(b, h) ((4 + (b) * 2 + (h)) * HTB)
#define PG8_STAGE(bufoff, gbase, voff) do { _Pragma("unroll") for (int _i = 0; _i < 2; ++_i) \
        __builtin_amdgcn_global_load_lds((const unsigned*)((const char*)(gbase) + (voff)[_i]), (PG8_LAS unsigned*)(lds + (bufoff) + ldsw + _i * 8192), 16, 0, 0); } while (0)
#define PG8_LDA(dst, b, h) do { _Pragma("unroll") for (int m = 0; m < 4; ++m) _Pragma("unroll") for (int k = 0; k < 2; ++k) dst[m][k] = *(const PG8_LAS bf16x8*)(lds + PG8_SA(b, h) + aoff + m * 2048 + k * 1024); } while (0)
#define PG8_LDB(dst, b, h) do { _Pragma("unroll") for (int n = 0; n < 2; ++n) _Pragma("unroll") for (int k = 0; k < 2; ++k) dst[n][k] = *(const PG8_LAS bf16x8*)(lds + PG8_SB(b, h) + boff + n * 2048 + k * 1024); } while (0)
#define PG8_MMA(ai, bj, At, Bt) do { __builtin_amdgcn_s_setprio(1); _Pragma("unroll") for (int m = 0; m < 4; ++m) _Pragma("unroll") for (int n = 0; n < 2; ++n) _Pragma("unroll") for (int k = 0; k < 2; ++k) \
        acc[ai][bj][m][n] = __builtin_amdgcn_mfma_f32_16x16x32_bf16(Bt[n][k], At[m][k], acc[ai][bj][m][n], 0, 0, 0); __builtin_amdgcn_s_setprio(0); } while (0)
#define PG8_WAIT_V(n) asm volatile("s_waitcnt vmcnt(" #n ")" ::: "memory")
#define PG8_WAIT_L(n) asm volatile("s_waitcnt lgkmcnt(" #n ")" ::: "memory")
#define PG8_BAR __builtin_amdgcn_s_barrier()
#define PG8_SCHED __builtin_amdgcn_sched_barrier(0)
    Unit cur, nxt; int ui = 0;
    if (!S.next(0, cur)) return;
    f32x4 acc[2][2][4][2];
#pragma unroll
    for (int a = 0; a < 2; ++a)
#pragma unroll
        for (int b = 0; b < 2; ++b)
#pragma unroll
            for (int m = 0; m < 4; ++m)
#pragma unroll
                for (int n = 0; n < 2; ++n) acc[a][b][m][n] = (f32x4){0.f, 0.f, 0.f, 0.f};
    bf16x8 At[4][2], B0[2][2], B1[2][2];
    const char* cA = (const char*)(cur.z ? g.A2 : g.A) + (size_t)cur.pm * tstep; const char* cB = (const char*)(cur.z ? g.Bt2 : g.Bt) + (size_t)cur.pn * tstep;
    S.a_ready(cur);
    if constexpr (SP2) {
        PG8_STAGE(PG8_SB(0, 0), cB, voffB); PG8_STAGE(PG8_SB(0, 1), cB + hstep, voffB); PG8_STAGE(PG8_SA(0, 0), cA, voffA); PG8_STAGE(PG8_SA(0, 1), cA + hstep, voffA);
        if (wr == 1) PG8_BAR;
        PG8_WAIT_V(2); PG8_BAR;
        PG8_STAGE(PG8_SB(1, 0), cB + kstep, voffB); PG8_STAGE(PG8_SA(1, 0), cA + kstep, voffA); PG8_STAGE(PG8_SB(1, 1), cB + hstep + kstep, voffB);
        PG8_WAIT_V(6); PG8_BAR;
    } else {
        PG8_STAGE(PG8_SB(0, 0), cB, voffB); PG8_STAGE(PG8_SA(0, 0), cA, voffA); PG8_STAGE(PG8_SB(0, 1), cB + hstep, voffB); PG8_STAGE(PG8_SA(0, 1), cA + hstep, voffA);
        if (wr == 1) PG8_BAR;
        PG8_WAIT_V(4); PG8_BAR;
        PG8_STAGE(PG8_SB(1, 0), cB + kstep, voffB); PG8_STAGE(PG8_SA(1, 0), cA + kstep, voffA); PG8_STAGE(PG8_SB(1, 1), cB + hstep + kstep, voffB);
        PG8_WAIT_V(6); PG8_BAR;
    }
    for (;;) {
        const bool has_next = S.next(ui + 1, nxt);
        const char* nA = has_next ? (const char*)(nxt.z ? g.A2 : g.A) + (size_t)nxt.pm * tstep : cA; const char* nB = has_next ? (const char*)(nxt.z ? g.Bt2 : g.Bt) + (size_t)nxt.pn * tstep : cB;
        for (int t = 0; t < nt; t += 2) {
            const bool last = (t == nt - 2);
            const char* a1 = cA + (size_t)(t + 1) * kstep;
            const char* a2 = last ? nA : cA + (size_t)(t + 2) * kstep; const char* b2 = last ? nB : cB + (size_t)(t + 2) * kstep;
            const char* a3 = a2 + kstep; const char* b3 = b2 + kstep;
            if (last && has_next) S.a_ready(nxt);
            if constexpr (SP2) {
            PG8_LDB(B0, 0, 0); PG8_LDB(B1, 0, 1); PG8_SCHED; PG8_LDA(At, 0, 0); PG8_STAGE(PG8_SA(1, 1), a1 + hstep, voffA);
            PG8_WAIT_V(8); PG8_WAIT_L(0); PG8_BAR; PG8_MMA(0, 0, At, B0); PG8_MMA(0, 1, At, B1); PG8_BAR; PG8_SCHED;
            PG8_LDA(At, 0, 1); PG8_STAGE(PG8_SB(0, 0), b2, voffB); PG8_STAGE(PG8_SB(0, 1), b2 + hstep, voffB); PG8_STAGE(PG8_SA(0, 0), a2, voffA);
            PG8_WAIT_V(8); PG8_WAIT_L(0); PG8_BAR; PG8_MMA(1, 0, At, B0); PG8_MMA(1, 1, At, B1); PG8_BAR; PG8_SCHED;
            PG8_LDB(B0, 1, 0); PG8_LDB(B1, 1, 1); PG8_SCHED; PG8_LDA(At, 1, 0); PG8_STAGE(PG8_SA(0, 1), a2 + hstep, voffA);
            PG8_WAIT_V(8); PG8_WAIT_L(0); PG8_BAR; PG8_MMA(0, 0, At, B0); PG8_MMA(0, 1, At, B1); PG8_BAR; PG8_SCHED;
            PG8_LDA(At, 1, 1); PG8_STAGE(PG8_SB(1, 0), b3, voffB); PG8_STAGE(PG8_SB(1, 1), b3 + hstep, voffB); PG8_STAGE(PG8_SA(1, 0), a3, voffA);
            PG8_WAIT_V(8); PG8_WAIT_L(0); PG8_BAR; PG8_MMA(1, 0, At, B0); PG8_MMA(1, 1, At, B1); PG8_BAR; PG8_SCHED;
            } else {
            PG8_LDB(B0, 0, 0); PG8_SCHED; PG8_LDA(At, 0, 0); PG8_STAGE(PG8_SA(1, 1), a1 + hstep, voffA);
            PG8_WAIT_L(8); PG8_BAR; PG8_WAIT_L(0); PG8_MMA(0, 0, At, B0); PG8_BAR; PG8_SCHED;
            PG8_LDB(B1, 0, 1); PG8_STAGE(PG8_SB(0, 0), b2, voffB);
            PG8_BAR; PG8_WAIT_L(0); PG8_MMA(0, 1, At, B1); PG8_BAR;
            PG8_LDA(At, 0, 1); PG8_STAGE(PG8_SA(0, 0), a2, voffA);
            PG8_BAR; PG8_WAIT_L(0); PG8_MMA(1, 0, At, B0); PG8_BAR; PG8_SCHED;
            PG8_STAGE(PG8_SB(0, 1), b2 + hstep, voffB);
            PG8_WAIT_V(6); PG8_BAR; PG8_MMA(1, 1, At, B1); PG8_BAR;
            PG8_LDB(B0, 1, 0); PG8_SCHED; PG8_LDA(At, 1, 0); PG8_STAGE(PG8_SA(0, 1), a2 + hstep, voffA);
            PG8_WAIT_L(8); PG8_BAR; PG8_WAIT_L(0); PG8_MMA(0, 0, At, B0); PG8_BAR; PG8_SCHED;
            PG8_LDB(B1, 1, 1); PG8_STAGE(PG8_SB(1, 0), b3, voffB);
            PG8_BAR; PG8_WAIT_L(0); PG8_MMA(0, 1, At, B1); PG8_BAR;
            PG8_LDA(At, 1, 1); PG8_STAGE(PG8_SA(1, 0), a3, voffA);
            PG8_BAR; PG8_WAIT_L(0); PG8_MMA(1, 0, At, B0); PG8_BAR; PG8_SCHED;
            PG8_STAGE(PG8_SB(1, 1), b3 + hstep, voffB);
            PG8_WAIT_V(6); PG8_BAR; PG8_MMA(1, 1, At, B1); PG8_BAR;
            }
        }
        if constexpr (ALIGN_EPI) { if (wr == 0) PG8_BAR; }
        { const int t2 = opaque_tid(wid_s), w2 = __builtin_amdgcn_readfirstlane(t2 >> 6); E(acc, cur, w2 >> 2, w2 & 3, t2 & 15, (t2 & 63) >> 4); }
        if (!has_next) break;
#pragma unroll
        for (int a = 0; a < 2; ++a)
#pragma unroll
            for (int b = 0; b < 2; ++b)
#pragma unroll
                for (int m = 0; m < 4; ++m)
#pragma unroll
                    for (int n = 0; n < 2; ++n) acc[a][b][m][n] = (f32x4){0.f, 0.f, 0.f, 0.f};
        cur = nxt; cA = nA; cB = nB; ++ui;
        if constexpr (ALIGN_EPI) { if (wr == 1) PG8_BAR; }
    }
    PG8_WAIT_V(0);
    if constexpr (!ALIGN_EPI) { if (wr == 0) PG8_BAR; }
    PG8_BAR;
#undef PG8_SA
#undef PG8_SB
#undef PG8_STAGE
#undef PG8_LDA
#undef PG8_LDB
#undef PG8_MMA
#undef PG8_WAIT_V
#undef PG8_WAIT_L
#undef PG8_BAR
#undef PG8_SCHED
}
}

typedef f32x4 AccT[2][2][4][2];

#define GAS __attribute__((address_space(1)))
__device__ __forceinline__ void store8_bf16(bf16_t* p, const float (&v)[8]) {
    u32x4 w; w.x = cvt_pk_bf16(v[0], v[1]); w.y = cvt_pk_bf16(v[2], v[3]); w.z = cvt_pk_bf16(v[4], v[5]); w.w = cvt_pk_bf16(v[6], v[7]);
    *(GAS u32x4*)p = w;
}
__device__ __forceinline__ void cvt8_bf16(const u32x4 w, float (&v)[8]) {
    v[0] = bflo(w.x); v[1] = bfhi(w.x); v[2] = bflo(w.y); v[3] = bfhi(w.y); v[4] = bflo(w.z); v[5] = bfhi(w.z); v[6] = bflo(w.w); v[7] = bfhi(w.w);
}
__device__ __forceinline__ u32x4 ldg16(const void* p) { return *(const GAS u32x4*)p; }
__device__ __forceinline__ f32x4 ldgf4(const float* p) { return *(const GAS f32x4*)p; }
__device__ __forceinline__ float ldgf(const float* p) { return *(const GAS float*)p; }
__device__ __forceinline__ void load8_bf16(const bf16_t* p, float (&v)[8]) { cvt8_bf16(ldg16(p), v); }
__device__ __forceinline__ void store8_f32(float* p, const float (&v)[8]) {
    *(GAS f32x4*)p = (f32x4){v[0], v[1], v[2], v[3]}; *(GAS f32x4*)(p + 4) = (f32x4){v[4], v[5], v[6], v[7]};
}
__device__ __forceinline__ void load8_f32(const float* p, float (&v)[8]) {
    const f32x4 a = ldgf4(p), b = ldgf4(p + 4);
    v[0] = a[0]; v[1] = a[1]; v[2] = a[2]; v[3] = a[3]; v[4] = b[0]; v[5] = b[1]; v[6] = b[2]; v[7] = b[3];
}
__device__ __forceinline__ void acc8(const AccT& acc, int ai, int bj, int m, float (&v)[8]) {
    const f32x4 a = acc[ai][bj][m][0], b = acc[ai][bj][m][1];
    v[0] = a[0]; v[1] = a[1]; v[2] = a[2]; v[3] = a[3]; v[4] = b[0]; v[5] = b[1]; v[6] = b[2]; v[7] = b[3];
}
#define EPI_FENCE() asm volatile("" ::: "memory")
__device__ __forceinline__ void load_rs8(const float* ssq, int row0, float (&rs)[8]) {
#pragma unroll
    for (int i = 0; i < 8; ++i) rs[i] = ldgf(ssq + row0 + (i >> 2) * 128 + (i & 3) * 16);
#pragma unroll
    for (int i = 0; i < 8; ++i) rs[i] = rsqrtf(rs[i] * (1.0f / DM) + EPS);
}

template <int ACT> __device__ __forceinline__ void epi_plain(const AccT& acc, const float (&rs)[8], bf16_t* dst, int ld, int row0, int c0) {
#pragma unroll
    for (int ai = 0; ai < 2; ++ai)
#pragma unroll
        for (int m = 0; m < 4; ++m) {
            const int row = row0 + ai * 128 + m * 16; const float r = rs[ai * 4 + m];
#pragma unroll
            for (int bj = 0; bj < 2; ++bj) { float v[8]; acc8(acc, ai, bj, m, v);
#pragma unroll
                for (int e = 0; e < 8; ++e) { float z = v[e] * r; if (ACT == 1) z = silu_f(z); if (ACT == 2) z = sigmoid_f(z); v[e] = z; }
                store8_bf16(dst + (size_t)row * ld + c0 + bj * 128, v); }
        }
}
struct EpiInProj {
    static constexpr bool PERM = true;
    const float* ssq; const float* lower; unsigned char* ws;
    __device__ __forceinline__ void operator()(const AccT& acc, const pg8::Unit& u, int wr, int wc, int fr, int fq) const {
        const int colt = u.pn * 256, seg = colt >> 10;
        const int row0 = u.pm * 256 + wr * 64 + fr;
        const int cin = wc * 32 + 8 * fq;
        const int cseg = (colt & 1023) + cin;
        float rs[8]; load_rs8(ssq, row0, rs);
        if (seg == 2 || seg == 3) {
            const int dir = seg - 2;
            float* G = (float*)(ws + (dir ? WS_GB : WS_GF)); bf16_t* KK = (bf16_t*)(ws + (dir ? WS_KB : WS_KF));
#pragma unroll
            for (int bj = 0; bj < 2; ++bj) {
                const int c = cseg + bj * 128; float lb[8]; load8_f32(lower + dir * 1024 + c, lb);
#pragma unroll
                for (int ai = 0; ai < 2; ++ai)
#pragma unroll
                    for (int m = 0; m < 4; ++m) {
                        const int row = row0 + ai * 128 + m * 16; const float r = rs[ai * 4 + m];
                        float v[8], lg[8], kk[8]; acc8(acc, ai, bj, m, v);
#pragma unroll
                        for (int e = 0; e < 8; ++e) { const float z = v[e] * r; const float sg = sigmoid_f(z); const float f = lb[e] + (1.f - lb[e]) * sg;
                            lg[e] = __logf(fmaxf(f, 1e-6f)); kk[e] = (1.f - lb[e]) * fast_rcp(1.f + __expf(z)); }
                        store8_f32(G + (size_t)row * HW + c, lg); store8_bf16(KK + (size_t)row * HW + c, kk);
                    }
            }
        } else if (seg == 7) {
            bf16_t* VT = (bf16_t*)(ws + WS_VT);
#pragma unroll
            for (int ai = 0; ai < 2; ++ai)
#pragma unroll
                for (int m = 0; m < 4; ++m) {
                    const int row = row0 + ai * 128 + m * 16; const float r = rs[ai * 4 + m];
#pragma unroll
                    for (int bj = 0; bj < 2; ++bj) { float v[8]; acc8(acc, ai, bj, m, v); const int c = cseg + bj * 128;
#pragma unroll
                        for (int e = 0; e < 8; ++e) *(GAS bf16_t*)(VT + (size_t)(c + e) * SEQ + row) = f2bf1(v[e] * r); }
                }
        } else if (seg == 0) epi_plain<1>(acc, rs, (bf16_t*)(ws + WS_QH), HW, row0, cseg);
        else if (seg == 1) epi_plain<0>(acc, rs, (bf16_t*)(ws + WS_VH), HW, row0, cseg);
        else if (seg == 4) epi_plain<1>(acc, rs, (bf16_t*)(ws + WS_HG), HW, row0, cseg);
        else if (seg == 5) epi_plain<0>(acc, rs, (bf16_t*)(ws + WS_NQ), HW, row0, cseg);
        else if (seg == 6) epi_plain<0>(acc, rs, (bf16_t*)(ws + WS_NK), HW, row0, cseg);
        else if (seg == 8) epi_plain<1>(acc, rs, (bf16_t*)(ws + WS_NG), HW, row0, cseg);
        else if (seg < 11) epi_plain<2>(acc, rs, (bf16_t*)(ws + WS_MA), DM, row0, colt - 9216 + cin);
        else epi_plain<2>(acc, rs, (bf16_t*)(ws + WS_MB), DM, row0, colt - 11264 + cin);
    }
};

#define EPI_IT(it, ai, m, bj) const int ai = (it) >> 3, m = ((it) >> 1) & 3, bj = (it) & 1
struct EpiBranch {
    static constexpr bool PERM = true;
    const bf16_t* MA; const bf16_t* MB; bf16_t* T; bf16_t* Y;
    __device__ __forceinline__ void operator()(const AccT& acc, const pg8::Unit& u, int wr, int wc, int fr, int fq) const {
        const int row0 = u.pm * 256 + wr * 64 + fr, c0 = u.pn * 256 + wc * 32 + 8 * fq;
        if (u.z == 0) {
            u32x4 g[2];
            g[0] = ldg16(MA + (size_t)row0 * DM + c0);
#pragma unroll
            for (int it = 0; it < 16; ++it) { EPI_IT(it, ai, m, bj);
                const size_t off = (size_t)(row0 + ai * 128 + m * 16) * DM + c0 + bj * 128;
                if (it + 1 < 16) { EPI_IT(it + 1, ai2, m2, bj2); g[(it + 1) & 1] = ldg16(MA + (size_t)(row0 + ai2 * 128 + m2 * 16) * DM + c0 + bj2 * 128); }
                float v[8], gg[8]; acc8(acc, ai, bj, m, v); cvt8_bf16(g[it & 1], gg);
#pragma unroll
                for (int e = 0; e < 8; ++e) v[e] *= gg[e];
                store8_bf16(T + off, v); EPI_FENCE(); }
        } else {
            u32x4 g[2], t[2];
            { const size_t o = (size_t)row0 * DM + c0; g[0] = ldg16(MB + o); t[0] = ldg16(T + o); }
#pragma unroll
            for (int it = 0; it < 16; ++it) { EPI_IT(it, ai, m, bj);
                const size_t off = (size_t)(row0 + ai * 128 + m * 16) * DM + c0 + bj * 128;
                if (it + 1 < 16) { EPI_IT(it + 1, ai2, m2, bj2); const size_t o = (size_t)(row0 + ai2 * 128 + m2 * 16) * DM + c0 + bj2 * 128; const int b = (it + 1) & 1;
                    g[b] = ldg16(MB + o); t[b] = ldg16(T + o); }
                float v[8], gg[8], tt[8]; acc8(acc, ai, bj, m, v); cvt8_bf16(g[it & 1], gg); cvt8_bf16(t[it & 1], tt);
#pragma unroll
                for (int e = 0; e < 8; ++e) v[e] = tt[e] + v[e] * gg[e];
                store8_bf16(Y + off, v); EPI_FENCE(); }
        }
    }
};
struct EpiWout {
    static constexpr bool PERM = true;
    const bf16_t* xin; bf16_t* XB1; float* ssq_out;
    __device__ __forceinline__ void operator()(const AccT& acc, const pg8::Unit& u, int wr, int wc, int fr, int fq) const {
        const int row0 = u.pm * 256 + wr * 64 + fr, c0 = u.pn * 256 + wc * 32 + 8 * fq;
        u32x4 xb[2];
        xb[0] = ldg16(xin + (size_t)row0 * DM + c0);
        float s = 0.f;
#pragma unroll
        for (int it = 0; it < 16; ++it) { EPI_IT(it, ai, m, bj);
            const int row = row0 + ai * 128 + m * 16; const size_t off = (size_t)row * DM + c0 + bj * 128;
            if (it + 1 < 16) { EPI_IT(it + 1, ai2, m2, bj2); xb[(it + 1) & 1] = ldg16(xin + (size_t)(row0 + ai2 * 128 + m2 * 16) * DM + c0 + bj2 * 128); }
            float v[8], xi[8]; acc8(acc, ai, bj, m, v); cvt8_bf16(xb[it & 1], xi);
#pragma unroll
            for (int e = 0; e < 8; ++e) { v[e] += xi[e]; s += v[e] * v[e]; }
            store8_bf16(XB1 + off, v);
            if (bj == 1) { s += __shfl_xor(s, 16); s += __shfl_xor(s, 32); if (fq == 0) atomicAdd(ssq_out + row, s); s = 0.f; }
            EPI_FENCE(); }
    }
};
struct EpiDummy {
    static constexpr bool PERM = true;
    bf16_t* D;
    __device__ __forceinline__ void operator()(const AccT& acc, const pg8::Unit& u, int wr, int wc, int fr, int fq) const {
        const int row0 = u.pm * 256 + wr * 64 + fr, c0 = (u.pn & 3) * 256 + wc * 32 + 8 * fq;
#pragma unroll
        for (int ai = 0; ai < 2; ++ai)
#pragma unroll
            for (int m = 0; m < 4; ++m) { const int row = row0 + ai * 128 + m * 16;
#pragma unroll
                for (int bj = 0; bj < 2; ++bj) { float v[8]; acc8(acc, ai, bj, m, v); store8_bf16(D + (size_t)row * HW + c0 + bj * 128, v); } }
    }
};
struct EpiPL {
    static constexpr bool PERM = true;
    bf16_t* PL;
    __device__ __forceinline__ void operator()(const AccT& acc, const pg8::Unit& u, int wr, int wc, int fr, int fq) const {
        const int row0 = u.pm * 256 + wr * 64 + fr, c0 = u.pn * 256 + wc * 32 + 8 * fq;
#pragma unroll
        for (int ai = 0; ai < 2; ++ai)
#pragma unroll
            for (int m = 0; m < 4; ++m) { const int row = row0 + ai * 128 + m * 16;
#pragma unroll
                for (int bj = 0; bj < 2; ++bj) { float v[8]; acc8(acc, ai, bj, m, v); store8_bf16(PL + (size_t)row * DM + c0 + bj * 128, v); } }
    }
};
struct EpiGate {
    static constexpr bool PERM = true;
    const float* ssq1; const bf16_t* XB1; const bf16_t* PL; float* xout; bf16_t* XBN; float* ssq_next; int has_next;
    __device__ __forceinline__ void operator()(const AccT& acc, const pg8::Unit& u, int wr, int wc, int fr, int fq) const {
        const int row0 = u.pm * 256 + wr * 64 + fr, c0 = u.pn * 256 + wc * 32 + 8 * fq;
        u32x4 xb[2], pb[2]; float sq[2];
        { const size_t o = (size_t)row0 * DM + c0; xb[0] = ldg16(XB1 + o); pb[0] = ldg16(PL + o); sq[0] = ldgf(ssq1 + row0); }
        float s = 0.f;
#pragma unroll
        for (int it = 0; it < 16; ++it) { EPI_IT(it, ai, m, bj);
            const int row = row0 + ai * 128 + m * 16; const size_t off = (size_t)row * DM + c0 + bj * 128;
            if (it + 1 < 16) { EPI_IT(it + 1, ai2, m2, bj2); const int rown = row0 + ai2 * 128 + m2 * 16; const size_t o = (size_t)rown * DM + c0 + bj2 * 128; const int b = (it + 1) & 1;
                xb[b] = ldg16(XB1 + o); pb[b] = ldg16(PL + o); sq[b] = ldgf(ssq1 + rown); }
            const float r = rsqrtf(sq[it & 1] * (1.0f / DM) + EPS);
            float v[8], x1[8], pl[8]; acc8(acc, ai, bj, m, v); cvt8_bf16(xb[it & 1], x1); cvt8_bf16(pb[it & 1], pl);
#pragma unroll
            for (int e = 0; e < 8; ++e) { const float g = sigmoid_f(v[e] * r); v[e] = x1[e] + pl[e] * g; s += v[e] * v[e]; }
            if (has_next) { store8_bf16(XBN + off, v);
                if (bj == 1) { s += __shfl_xor(s, 16); s += __shfl_xor(s, 32); if (fq == 0) atomicAdd(ssq_next + row, s); s = 0.f; } }
            else store8_f32(xout + off, v);
            EPI_FENCE(); }
    }
};

#define XB_TMO      128
#define XB_XCNT(j)  (256  + 64 * (j))
#define XB_XSUB(j)  (1280 + 64 * (j))
#define XB_XGEN(j)  (2304 + 64 * (j))
#define XB_TOP      3328
#define XB_TOPGEN   3392
#define XCD_BAR_WORDS 3456
#define XB_SPIN_CAP (1u << 18)
__device__ __forceinline__ unsigned xb_ld(unsigned* p)              { return __hip_atomic_load(p, __ATOMIC_RELAXED, __HIP_MEMORY_SCOPE_AGENT); }
__device__ __forceinline__ unsigned xb_add(unsigned* p, unsigned v) { return __hip_atomic_fetch_add(p, v, __ATOMIC_RELAXED, __HIP_MEMORY_SCOPE_AGENT); }
__device__ __forceinline__ unsigned xb_xcc_id() { return (unsigned)__builtin_amdgcn_s_getreg((3 << 11) | 20) & 0xFu; }
#define XB_SPIN(cond, bar) do { unsigned _sp = 0; while (cond) { __builtin_amdgcn_s_sleep(1); \
    if ((++_sp & 255u) == 0u) { if (xb_ld(&(bar)[XB_TMO])) break; if (_sp > XB_SPIN_CAP) { atomicAdd(&(bar)[XB_TMO], 1u); break; } } } } while (0)
struct XcdBarrier { unsigned* bar; unsigned x; volatile LAS unsigned* st; };
__device__ __forceinline__ XcdBarrier xcd_barrier_post(unsigned* bar, volatile LAS unsigned* st) {
    XcdBarrier b; b.bar = bar; b.x = xb_xcc_id(); b.st = st;
    if (threadIdx.x == 0) (void)xb_add(&bar[XB_XCNT(b.x)], 1u);
    return b;
}
__device__ __forceinline__ void xcd_barrier_complete(unsigned* bar, unsigned x, unsigned& nloc, unsigned& nx) {
    const unsigned G = gridDim.x * gridDim.y * gridDim.z;
    unsigned sum, cnt, mine, sp = 0u;
    for (;;) {
        sum = 0u; cnt = 0u; mine = 0u;
#pragma unroll
        for (unsigned j = 0; j < 16; ++j) { const unsigned c = xb_ld(&bar[XB_XCNT(j)]); sum += c; cnt += (c > 0u) ? 1u : 0u; mine = (j == x) ? c : mine; }
        if (sum == G) break;
        __builtin_amdgcn_s_sleep(1);
        if ((++sp & 255u) == 0u) { if (xb_ld(&bar[XB_TMO])) break; if (sp > XB_SPIN_CAP) { atomicAdd(&bar[XB_TMO], 1u); break; } }
    }
    nloc = mine > 0u ? mine : 1u; nx = cnt > 0u ? cnt : 1u;
}
__device__ __forceinline__ void xcd_barrier(const XcdBarrier& b) {
    asm volatile("s_waitcnt vmcnt(0)" ::: "memory");
    __syncthreads();
    if (threadIdx.x == 0) {
        unsigned* bar = b.bar;
        __builtin_amdgcn_s_waitcnt(0);
        unsigned nloc = b.st[0], nx = b.st[1];
        if (nloc == 0u) { xcd_barrier_complete(bar, b.x, nloc, nx); b.st[0] = nloc; b.st[1] = nx; }
        const unsigned old = xb_add(&bar[XB_XSUB(b.x)], 1u);
        const unsigned gen = old / nloc;
        if (old + 1u == (gen + 1u) * nloc) {
            __builtin_amdgcn_fence(__ATOMIC_RELEASE, "agent");
            asm volatile("s_waitcnt vmcnt(0)" ::: "memory");
            const unsigned og = xb_add(&bar[XB_TOP], 1u);
            const unsigned tg = og / nx;
            if (og + 1u == (tg + 1u) * nx) xb_add(&bar[XB_TOPGEN], 1u);
            else XB_SPIN(xb_ld(&bar[XB_TOPGEN]) == tg, bar);
            __builtin_amdgcn_fence(__ATOMIC_ACQUIRE, "agent");
            xb_add(&bar[XB_XGEN(b.x)], 1u);
            asm volatile("s_waitcnt vmcnt(0)" ::: "memory");
        } else {
            XB_SPIN(xb_ld(&bar[XB_XGEN(b.x)]) == gen, bar);
            __builtin_amdgcn_fence(__ATOMIC_ACQUIRE, "agent");
            asm volatile("s_waitcnt vmcnt(0)" ::: "memory");
        }
    }
    __syncthreads();
}

struct Args { const float* in[15]; float* out; unsigned char* ws; int ph_lo, ph_hi; };

__device__ __forceinline__ void transpose_convert(const float* __restrict__ W, bf16_t* __restrict__ WT, int K, int N, LAS float* tile, int rot, const float* kscale) {
    const int tid = threadIdx.x, nb = gridDim.x; const int bid = (int)((blockIdx.x + (unsigned)rot) % (unsigned)nb);
    const int nkt = K / 64, ntile = nkt * (N / 64);
    const int k0 = tid >> 4, c4 = tid & 15;
    f32x4 v0, v1;
#define TC_LOAD(t_) do { const int tk_ = (t_) % nkt, tn_ = (t_) / nkt; const float* s_ = W + (size_t)(tk_ * 64 + k0) * N + tn_ * 64 + c4 * 4; \
        v0 = ldgf4(s_); v1 = ldgf4(s_ + (size_t)32 * N); if (kscale) { v0 = v0 * ldgf(kscale + tk_ * 64 + k0); v1 = v1 * ldgf(kscale + tk_ * 64 + k0 + 32); } } while (0)
    int t = bid, par = 0;
    if (t < ntile) TC_LOAD(t);
    for (; t < ntile; t += nb, par ^= 1) {
        LAS float* tl = tile + par * (64 * 65);
        { LAS float* d = tl + k0 * 65 + c4 * 4; d[0] = v0[0]; d[1] = v0[1]; d[2] = v0[2]; d[3] = v0[3]; d += 32 * 65; d[0] = v1[0]; d[1] = v1[1]; d[2] = v1[2]; d[3] = v1[3]; }
        const int tk = t % nkt, tn = t / nkt;
        if (t + nb < ntile) TC_LOAD(t + nb);
        __syncthreads();
        { const int n = tid >> 3, kq = tid & 7; float v[8];
#pragma unroll
          for (int j = 0; j < 8; ++j) v[j] = tl[(kq * 8 + j) * 65 + n];
          store8_bf16(WT + (size_t)(tn * 64 + n) * K + tk * 64 + kq * 8, v); }
    }
    __syncthreads();
#undef TC_LOAD
}

__device__ __forceinline__ void p0_prologue(const Args& a, LAS unsigned char* lds) {
    unsigned char* ws = a.ws;
    const int tid = threadIdx.x, bid = blockIdx.x, nb = gridDim.x, gtid = bid * 512 + tid, gsz = nb * 512;
    {
        float* LOWER = (float*)(ws + WS_LOWER); const float* lbp = a.in[4];
        for (int i = gtid; i < 2048; i += gsz) { const float a0 = lbp[i], a1 = lbp[2048 + i]; LOWER[i] = 0.f; LOWER[2048 + i] = 1.f / (1.f + expf(a0 - a1)); }
        float* SSQ = (float*)(ws + WS_SSQ);
        for (int i = gtid; i < 3 * SEQ; i += gsz) SSQ[SEQ + i] = 0.f;
    }
    {
        const float* x = a.in[0]; bf16_t* XG = (bf16_t*)(ws + WS_XGA); float* SSQ = (float*)(ws + WS_SSQ);
        const int lane = tid & 63, gw = gtid >> 6, nw = gsz >> 6;
        for (int row = gw; row < SEQ; row += nw) {
            const f32x4* xr = (const f32x4*)(x + (size_t)row * DM); float s = 0.f;
#pragma unroll
            for (int j = 0; j < 8; ++j) { const f32x4 v = xr[j * 64 + lane];
                s += v[0] * v[0] + v[1] * v[1] + v[2] * v[2] + v[3] * v[3];
                u32x2 w; w.x = cvt_pk_bf16(v[0], v[1]); w.y = cvt_pk_bf16(v[2], v[3]);
                *(u32x2*)(XG + (size_t)row * DM + (j * 64 + lane) * 4) = w; }
#pragma unroll
            for (int o = 32; o >= 1; o >>= 1) s += __shfl_xor(s, o);
            if (lane == 0) SSQ[row] = s;
        }
    }
    {
        const f32x4* p = (const f32x4*)a.in[1]; bf16_t* PB = (bf16_t*)(ws + WS_PB);
        for (int i = gtid; i < 2 * SEQ * PLE / 4; i += gsz) { const f32x4 v = p[i]; u32x2 w; w.x = cvt_pk_bf16(v[0], v[1]); w.y = cvt_pk_bf16(v[2], v[3]); *(u32x2*)(PB + (size_t)i * 4) = w; }
    }
    LAS float* tile = (LAS float*)lds;
    for (int l = 0; l < 2; ++l) {
        transpose_convert(a.in[3] + (size_t)l * DM * NIN, (bf16_t*)(ws + WS_WIN) + (size_t)l * NIN * DM, DM, NIN, tile, 0, a.in[2] + l * DM);
        transpose_convert(a.in[9] + (size_t)l * HW * DM, (bf16_t*)(ws + WS_WA) + (size_t)l * DM * HW, HW, DM, tile, 0, nullptr);
        transpose_convert(a.in[10] + (size_t)l * HW * DM, (bf16_t*)(ws + WS_WB) + (size_t)l * DM * HW, HW, DM, tile, 0, nullptr);
        transpose_convert(a.in[11] + (size_t)l * DM * DM, (bf16_t*)(ws + WS_WO) + (size_t)l * DM * DM, DM, DM, tile, 0, nullptr);
        transpose_convert(a.in[13] + (size_t)l * DM * DM, (bf16_t*)(ws + WS_WG) + (size_t)l * DM * DM, DM, DM, tile, 0, a.in[12] + l * DM);
        transpose_convert(a.in[14] + (size_t)l * PLE * DM, (bf16_t*)(ws + WS_WP) + (size_t)l * DM * PLE, PLE, DM, tile, 128, nullptr);
    }
}

constexpr int HP_ROWB = 272;
constexpr int HT_ROWB = 144;

__device__ __forceinline__ void hg_cumsum(const float (&gv)[16], int seg, int kc, int dir, LAS float* SEGS, float (&b)[16], float& bref, float& blast) {
    float c = 0.f;
#pragma unroll
    for (int i = 0; i < 16; ++i) { c += gv[i]; b[i] = c; }
    const float tot = c;
    if (dir) {
#pragma unroll
        for (int i = 0; i < 16; ++i) b[i] = tot - b[i] + gv[i];
    }
    SEGS[seg * 128 + kc] = tot;
    __syncthreads();
    const float t0 = SEGS[kc], t1 = SEGS[128 + kc], t2 = SEGS[256 + kc], t3 = SEGS[384 + kc];
    float off;
    if (!dir) { off = (seg > 0 ? t0 : 0.f) + (seg > 1 ? t1 : 0.f) + (seg > 2 ? t2 : 0.f); bref = t0 + t1; }
    else      { off = (seg < 3 ? t3 : 0.f) + (seg < 2 ? t2 : 0.f) + (seg < 1 ? t1 : 0.f); bref = t2 + t3; }
    blast = (t0 + t1) + (t2 + t3);
#pragma unroll
    for (int i = 0; i < 16; ++i) b[i] += off;
}
__device__ __forceinline__ unsigned short ldg_u16(const bf16_t* p) { return *(const GAS bf16_t*)p; }

__device__ __forceinline__ void h1_phase(const Args& a, LAS unsigned char* lds, int wid_s) {
    unsigned char* ws = opaque_ptr(a.ws);
    const int tid = opaque_tid(wid_s), lane = tid & 63, w = __builtin_amdgcn_readfirstlane(tid >> 6), fr = lane & 15, fq = lane >> 4;
    const int kc = tid & 127, seg = tid >> 7;
    LAS float* SEGS = (LAS float*)lds; LAS float* SC = (LAS float*)(lds + 2048);
    LAS unsigned char* KpT = lds + 4096; LAS unsigned char* Vt = lds + 4096 + 128 * HT_ROWB;
    const bf16_t* VH = (const bf16_t*)(ws + WS_VH);
    bf16_t* LT = (bf16_t*)(ws + WS_LT); float* DD = (float*)(ws + WS_DD); float* EE = (float*)(ws + WS_EE);
    float gv[16]; unsigned short kr_[16], vr_[16];
#define H1_FETCH(item_) do { const int d_ = (item_) >> 10, h_ = ((item_) >> 7) & 7, cs_ = (item_) & 127, n_ = d_ ? 127 - cs_ : cs_; \
        const size_t o_ = (size_t)(64 * n_ + 16 * seg) * HW + h_ * 128 + kc; const float* G_ = (const float*)(ws + (d_ ? WS_GB : WS_GF)) + o_; const bf16_t* K_ = (const bf16_t*)(ws + (d_ ? WS_KB : WS_KF)) + o_; \
        _Pragma("unroll") for (int i = 0; i < 16; ++i) { gv[i] = ldgf(G_ + (size_t)i * HW); kr_[i] = ldg_u16(K_ + (size_t)i * HW); vr_[i] = ldg_u16(VH + o_ + (size_t)i * HW); } } while (0)
    int item = blockIdx.x;
    if (item < 2048) H1_FETCH(item);
    for (; item < 2048; item += gridDim.x) {
        const int d = item >> 10;
        float b[16], bref, blast;
        hg_cumsum(gv, seg, kc, d, SEGS, b, bref, blast);
        {
            unsigned kw[8], vw[8];
#pragma unroll
            for (int i = 0; i < 16; i += 2) {
                const float k0 = bf2f(kr_[i]) * __expf(fminf(bref - b[i], 80.f)), k1 = bf2f(kr_[i + 1]) * __expf(fminf(bref - b[i + 1], 80.f));
                kw[i >> 1] = cvt_pk_bf16(k0, k1);
                vw[i >> 1] = (unsigned)vr_[i] | ((unsigned)vr_[i + 1] << 16);
            }
            LAS u32x4* kd = (LAS u32x4*)(KpT + kc * HT_ROWB + seg * 32); kd[0] = (u32x4){kw[0], kw[1], kw[2], kw[3]}; kd[1] = (u32x4){kw[4], kw[5], kw[6], kw[7]};
            LAS u32x4* vd = (LAS u32x4*)(Vt + kc * HT_ROWB + seg * 32); vd[0] = (u32x4){vw[0], vw[1], vw[2], vw[3]}; vd[1] = (u32x4){vw[4], vw[5], vw[6], vw[7]};
            if (seg == 0) { SC[kc] = __expf(blast - bref); *(GAS float*)(DD + (size_t)item * 128 + kc) = __expf(blast); *(GAS float*)(EE + (size_t)item * 128 + kc) = __expf(bref); }
        }
        if (item + (int)gridDim.x < 2048) H1_FETCH(item + (int)gridDim.x);
        __syncthreads();
        {
            const int vt = w;
            bf16x8 bv[2];
#pragma unroll
            for (int ks = 0; ks < 2; ++ks) bv[ks] = *(const LAS bf16x8*)(Vt + (16 * vt + fr) * HT_ROWB + (32 * ks + 8 * fq) * 2);
            bf16_t* dst = LT + (size_t)item * 16384 + (size_t)(16 * vt + fr) * 128 + 4 * fq;
#pragma unroll
            for (int kt = 0; kt < 8; ++kt) {
                f32x4 acc = (f32x4){0.f, 0.f, 0.f, 0.f};
#pragma unroll
                for (int ks = 0; ks < 2; ++ks) { const bf16x8 af = *(const LAS bf16x8*)(KpT + (16 * kt + fr) * HT_ROWB + (32 * ks + 8 * fq) * 2);
                    acc = __builtin_amdgcn_mfma_f32_16x16x32_bf16(af, bv[ks], acc, 0, 0, 0); }
                const f32x4 sc = *(const LAS f32x4*)(SC + 16 * kt + 4 * fq);
                u32x2 ow; ow.x = cvt_pk_bf16(acc[0] * sc[0], acc[1] * sc[1]); ow.y = cvt_pk_bf16(acc[2] * sc[2], acc[3] * sc[3]);
                *(GAS u32x2*)(dst + 16 * kt) = ow;
            }
        }
        __syncthreads();
    }
#undef H1_FETCH
}

__device__ __forceinline__ void h2_phase(const Args& a, int wid_s) {
    unsigned char* ws = opaque_ptr(a.ws);
    const int tid = opaque_tid(wid_s);
    const bf16_t* LT = (const bf16_t*)(ws + WS_LT); const float* DD = (const float*)(ws + WS_DD); const float* EE = (const float*)(ws + WS_EE);
    bf16_t* SP = (bf16_t*)(ws + WS_SP);
    for (int u = blockIdx.x; u < 256; u += gridDim.x) {
        const int chain = u >> 4, sub = u & 15;
        const int v = 8 * sub + (tid >> 6), k = 2 * (tid & 63);
        const size_t ibase = (size_t)chain * 128;
        float s0 = 0.f, s1 = 0.f;
        for (int cs0 = 0; cs0 < 128; cs0 += 16) {
            unsigned lt[16]; f32x2 dd[16], ee[16];
#pragma unroll
            for (int j = 0; j < 16; ++j) { const size_t it = ibase + cs0 + j;
                lt[j] = *(const GAS unsigned*)(LT + it * 16384 + v * 128 + k); dd[j] = *(const GAS f32x2*)(DD + it * 128 + k); ee[j] = *(const GAS f32x2*)(EE + it * 128 + k); }
#pragma unroll
            for (int j = 0; j < 16; ++j) { const size_t it = ibase + cs0 + j;
                *(GAS unsigned*)(SP + it * 16384 + v * 128 + k) = cvt_pk_bf16(s0 * ee[j][0], s1 * ee[j][1]);
                s0 = dd[j][0] * s0 + bflo(lt[j]); s1 = dd[j][1] * s1 + bfhi(lt[j]); }
        }
    }
}

__device__ __forceinline__ void h3_phase(const Args& a, int layer, LAS unsigned char* lds, int wid_s) {
    unsigned char* ws = opaque_ptr(a.ws);
    const int tid = opaque_tid(wid_s), lane = tid & 63, w = __builtin_amdgcn_readfirstlane(tid >> 6), fr = lane & 15, fq = lane >> 4;
    const int kc = tid & 127, seg = tid >> 7;
    LAS float* SEGS = (LAS float*)lds; LAS float* SSQP = (LAS float*)(lds + 2048);
    LAS unsigned char* Qp = lds + 4096; LAS unsigned char* Kp = Qp + 64 * HP_ROWB; LAS unsigned char* Vt = Kp + 64 * HP_ROWB; LAS unsigned char* Ab = Vt + 128 * HT_ROWB; LAS unsigned char* SPs = Ab + 64 * HT_ROWB;
    const bf16_t* QH = (const bf16_t*)(ws + WS_QH); const bf16_t* VH = (const bf16_t*)(ws + WS_VH); const bf16_t* HG = (const bf16_t*)(ws + WS_HG);
    const bf16_t* SP = (const bf16_t*)(ws + WS_SP); bf16_t* OA = (bf16_t*)(ws + WS_OA);
    const float* onorm = a.in[5] + layer * 128;
    float gv[16]; unsigned short qr_[16], kr_[16], vr_[16]; u32x4 spr[4];
#define H3_FETCH(item_, d_) do { const int n_ = (item_) >> 3, h_ = (item_) & 7, cs_ = (d_) ? 127 - n_ : n_; \
        const size_t o_ = (size_t)(64 * n_ + 16 * seg) * HW + h_ * 128 + kc; const float* G_ = (const float*)(ws + ((d_) ? WS_GB : WS_GF)) + o_; const bf16_t* K_ = (const bf16_t*)(ws + ((d_) ? WS_KB : WS_KF)) + o_; \
        const bf16_t* S_ = SP + (size_t)(((d_) * 8 + h_) * 128 + cs_) * 16384; \
        _Pragma("unroll") for (int i = 0; i < 16; ++i) { gv[i] = ldgf(G_ + (size_t)i * HW); qr_[i] = ldg_u16(QH + o_ + (size_t)i * HW); kr_[i] = ldg_u16(K_ + (size_t)i * HW); vr_[i] = ldg_u16(VH + o_ + (size_t)i * HW); } \
        _Pragma("unroll") for (int i = 0; i < 4; ++i) { const int q_ = tid + 512 * i; spr[i] = ldg16(S_ + (q_ >> 4) * 128 + (q_ & 15) * 8); } } while (0)
    int item = blockIdx.x;
    if (item < 1024) H3_FETCH(item, 0);
    for (; item < 1024; item += gridDim.x) {
        const int n = item >> 3, h = item & 7;
        const int tok0 = 64 * n;
        const int rt = w & 3, vg = w >> 2;
        f32x4 o[4];
#pragma unroll
        for (int j = 0; j < 4; ++j) o[j] = (f32x4){0.f, 0.f, 0.f, 0.f};
        u32x2 hgr[4];
        for (int d = 0; d < 2; ++d) {
            float b[16], bref, blast;
            hg_cumsum(gv, seg, kc, d, SEGS, b, bref, blast);
            {
                unsigned vw[8];
#pragma unroll
                for (int i = 0; i < 16; i += 2) {
                    const float e0 = b[i] - bref, e1 = b[i + 1] - bref;
                    const float q0 = bf2f(qr_[i]) * __expf(fminf(e0, 80.f)), q1 = bf2f(qr_[i + 1]) * __expf(fminf(e1, 80.f));
                    const float k0 = bf2f(kr_[i]) * __expf(fminf(-e0, 80.f)), k1 = bf2f(kr_[i + 1]) * __expf(fminf(-e1, 80.f));
                    *(LAS unsigned short*)(Qp + (16 * seg + i) * HP_ROWB + kc * 2) = f2bf1(q0);
                    *(LAS unsigned short*)(Qp + (16 * seg + i + 1) * HP_ROWB + kc * 2) = f2bf1(q1);
                    *(LAS unsigned short*)(Kp + (16 * seg + i) * HP_ROWB + kc * 2) = f2bf1(k0);
                    *(LAS unsigned short*)(Kp + (16 * seg + i + 1) * HP_ROWB + kc * 2) = f2bf1(k1);
                    vw[i >> 1] = (unsigned)vr_[i] | ((unsigned)vr_[i + 1] << 16);
                }
                LAS u32x4* vd = (LAS u32x4*)(Vt + kc * HT_ROWB + seg * 32); vd[0] = (u32x4){vw[0], vw[1], vw[2], vw[3]}; vd[1] = (u32x4){vw[4], vw[5], vw[6], vw[7]};
#pragma unroll
                for (int i = 0; i < 4; ++i) { const int q = tid + 512 * i; *(LAS u32x4*)(SPs + (q >> 4) * HP_ROWB + (q & 15) * 16) = spr[i]; }
            }
            if (d == 0) H3_FETCH(item, 1);
            else { if (item + (int)gridDim.x < 1024) H3_FETCH(item + (int)gridDim.x, 0);
#pragma unroll
                for (int j = 0; j < 4; ++j) hgr[j] = *(const GAS u32x2*)(HG + (size_t)(tok0 + 16 * rt + fr) * HW + h * 128 + 16 * (4 * vg + j) + 4 * fq); }
            __syncthreads();
            {
                const int art = w >> 1;
#pragma unroll
                for (int tt = 0; tt < 2; ++tt) {
                    const int st = 2 * (w & 1) + tt;
                    const bool need = d ? (st >= art) : (st <= art);
                    f32x4 acc = (f32x4){0.f, 0.f, 0.f, 0.f};
                    if (need) {
#pragma unroll
                        for (int ks = 0; ks < 4; ++ks) {
                            const bf16x8 af = *(const LAS bf16x8*)(Qp + (16 * art + fr) * HP_ROWB + (32 * ks + 8 * fq) * 2);
                            const bf16x8 bfr = *(const LAS bf16x8*)(Kp + (16 * st + fr) * HP_ROWB + (32 * ks + 8 * fq) * 2);
                            acc = __builtin_amdgcn_mfma_f32_16x16x32_bf16(af, bfr, acc, 0, 0, 0);
                        }
                    }
                    const int s_ = 16 * st + fr;
#pragma unroll
                    for (int r = 0; r < 4; ++r) { const int r_ = 16 * art + 4 * fq + r; const bool ok = need && (d ? (s_ >= r_) : (s_ <= r_));
                        *(LAS unsigned short*)(Ab + r_ * HT_ROWB + s_ * 2) = f2bf1(ok ? acc[r] : 0.f); }
                }
            }
            __syncthreads();
            {
                bf16x8 ab[2], qb[4];
#pragma unroll
                for (int ks = 0; ks < 2; ++ks) ab[ks] = *(const LAS bf16x8*)(Ab + (16 * rt + fr) * HT_ROWB + (32 * ks + 8 * fq) * 2);
#pragma unroll
                for (int ks = 0; ks < 4; ++ks) qb[ks] = *(const LAS bf16x8*)(Qp + (16 * rt + fr) * HP_ROWB + (32 * ks + 8 * fq) * 2);
#pragma unroll
                for (int j = 0; j < 4; ++j) {
                    const int vt = 4 * vg + j;
#pragma unroll
                    for (int ks = 0; ks < 2; ++ks) { const bf16x8 af = *(const LAS bf16x8*)(Vt + (16 * vt + fr) * HT_ROWB + (32 * ks + 8 * fq) * 2);
                        o[j] = __builtin_amdgcn_mfma_f32_16x16x32_bf16(af, ab[ks], o[j], 0, 0, 0); }
#pragma unroll
                    for (int ks = 0; ks < 4; ++ks) { const bf16x8 af = *(const LAS bf16x8*)(SPs + (16 * vt + fr) * HP_ROWB + (32 * ks + 8 * fq) * 2);
                        o[j] = __builtin_amdgcn_mfma_f32_16x16x32_bf16(af, qb[ks], o[j], 0, 0, 0); }
                }
            }
            __syncthreads();
        }
        {
            float s = 0.f;
#pragma unroll
            for (int j = 0; j < 4; ++j) s += o[j][0] * o[j][0] + o[j][1] * o[j][1] + o[j][2] * o[j][2] + o[j][3] * o[j][3];
            s += __shfl_xor(s, 16); s += __shfl_xor(s, 32);
            if (fq == 0) SSQP[vg * 64 + 16 * rt + fr] = s;
            __syncthreads();
            const int row = 16 * rt + fr; const float rs = rsqrtf((SSQP[row] + SSQP[64 + row]) * (1.0f / 128.f) + EPS);
#pragma unroll
            for (int j = 0; j < 4; ++j) { const int v0 = 16 * (4 * vg + j) + 4 * fq; const f32x4 on = ldgf4(onorm + v0);
                u32x2 ow; ow.x = cvt_pk_bf16(o[j][0] * rs * on[0] * bflo(hgr[j].x), o[j][1] * rs * on[1] * bfhi(hgr[j].x)); ow.y = cvt_pk_bf16(o[j][2] * rs * on[2] * bflo(hgr[j].y), o[j][3] * rs * on[3] * bfhi(hgr[j].y));
                *(GAS u32x2*)(OA + (size_t)(tok0 + row) * HW + h * 128 + v0) = ow; }
        }
    }
#undef H3_FETCH
}

constexpr int NAT_NB = 36864, NAT_KH = 64 * 272, NAT_VH = 128 * 144;
__device__ __forceinline__ void natten_phase(const Args& a, int layer, LAS unsigned char* lds, int wid_s) {
    unsigned char* ws = opaque_ptr(a.ws);
    const int tid = opaque_tid(wid_s), lane = tid & 63, w = __builtin_amdgcn_readfirstlane(tid >> 6), fr = lane & 15, fq = lane >> 4;
    LAS float* RP = (LAS float*)(lds + 2 * NAT_NB);
    const bf16_t* NQ = (const bf16_t*)(ws + WS_NQ); const bf16_t* NK = (const bf16_t*)(ws + WS_NK); const bf16_t* VT = (const bf16_t*)(ws + WS_VT);
    const bf16_t* NG = (const bf16_t*)(ws + WS_NG); bf16_t* OB = (bf16_t*)(ws + WS_OB);
    const float* gq = a.in[6] + layer * 128; const float* gk = a.in[7] + layer * 128; const float* rpb = a.in[8] + (size_t)layer * 8 * 465;
    for (int it = blockIdx.x; it < 512; it += gridDim.x) {
        const int r = it >> 2, hp = it & 3, hw = w >> 2, h = 2 * hp + hw, j = w & 3;
        const int r_start = min(max(r - 4, 0), 120);
        const bf16_t* ksrc[4]; const bf16_t* vsrc[4]; int kdst[4], vdst[4];
#pragma unroll
        for (int i = 0; i < 4; ++i) { const int q = tid + 512 * i, hd = q >> 10;
            { const int key = (q >> 4) & 63, ch = q & 15; ksrc[i] = NK + (size_t)(64 * r_start + key) * HW + (2 * hp + hd) * 128 + ch * 8; kdst[i] = hd * NAT_KH + key * 272 + ch * 16; }
            { const int d = (q >> 3) & 127, ch = q & 7; vsrc[i] = VT + (size_t)((2 * hp + hd) * 128 + d) * SEQ + 64 * r_start + ch * 8; vdst[i] = hd * NAT_VH + d * 144 + ch * 16; } }
        u32x4 R0[4], R1[4];
#define NAT_LOAD(st, R) do { _Pragma("unroll") for (int i = 0; i < 4; ++i) R[i] = ((st) < 8) ? ldg16(ksrc[i] + (size_t)(st) * 64 * HW) : ldg16(vsrc[i] + ((st) - 8) * 64); } while (0)
#define NAT_WRITE(st, R) do { _Pragma("unroll") for (int i = 0; i < 4; ++i) *(LAS u32x4*)(lds + ((st) & 1) * NAT_NB + (((st) < 8) ? kdst[i] : vdst[i])) = R[i]; } while (0)
        NAT_LOAD(0, R0); NAT_LOAD(1, R1);
        for (int i = tid; i < 930; i += 512) RP[i] = ldgf(rpb + (size_t)(2 * hp) * 465 + i);
        const int c0k = (j == 0) ? 0 : (j == 1) ? 8 : (j == 2) ? 24 : 32;
        const int cq = 16 * j + fr, tq = 64 * r + cq;
        const int cstart = min(max(cq - 8, 0), 48);
        bf16x8 qf[4];
        {
            float qv[4][8]; float ss = 0.f;
#pragma unroll
            for (int ks = 0; ks < 4; ++ks) { load8_bf16(NQ + (size_t)tq * HW + h * 128 + 32 * ks + 8 * fq, qv[ks]);
#pragma unroll
                for (int e = 0; e < 8; ++e) ss += qv[ks][e] * qv[ks][e]; }
            ss += __shfl_xor(ss, 16); ss += __shfl_xor(ss, 32);
            const float rq = rsqrtf(ss * (1.0f / 128.f) + EPS) * 0.08838834764831845f;
#pragma unroll
            for (int ks = 0; ks < 4; ++ks) { float g1[8], g2[8]; load8_f32(gq + 32 * ks + 8 * fq, g1); load8_f32(gk + 32 * ks + 8 * fq, g2);
                u32x4 wv;
                wv.x = cvt_pk_bf16(qv[ks][0] * rq * g1[0] * g2[0], qv[ks][1] * rq * g1[1] * g2[1]); wv.y = cvt_pk_bf16(qv[ks][2] * rq * g1[2] * g2[2], qv[ks][3] * rq * g1[3] * g2[3]);
                wv.z = cvt_pk_bf16(qv[ks][4] * rq * g1[4] * g2[4], qv[ks][5] * rq * g1[5] * g2[5]); wv.w = cvt_pk_bf16(qv[ks][6] * rq * g1[6] * g2[6], qv[ks][7] * rq * g1[7] * g2[7]);
                qf[ks] = __builtin_bit_cast(bf16x8, wv); }
        }
        NAT_WRITE(0, R0);
        __syncthreads();
        float s[8][2][4];
        float mx = -3.0e38f, l = 0.f;
        f32x4 o[8];
#pragma unroll
        for (int dt = 0; dt < 8; ++dt) o[dt] = (f32x4){0.f, 0.f, 0.f, 0.f};
#pragma unroll
        for (int st = 0; st < 16; ++st) {
            if (st + 2 < 16) { if (st & 1) NAT_LOAD(st + 2, R1); else NAT_LOAD(st + 2, R0); }
            LAS unsigned char* buf = lds + (st & 1) * NAT_NB;
            if (st < 8) {
                const int aa = st, kr = r_start + aa, row_off = kr - r + 7;
#pragma unroll
                for (int kt = 0; kt < 2; ++kt) {
                    bf16x8 kf[4]; float ssk = 0.f;
#pragma unroll
                    for (int ks = 0; ks < 4; ++ks) { const u32x4 wv = *(const LAS u32x4*)(buf + hw * NAT_KH + (c0k + 16 * kt + fr) * 272 + (32 * ks + 8 * fq) * 2); kf[ks] = __builtin_bit_cast(bf16x8, wv);
                        ssk += bflo(wv.x) * bflo(wv.x) + bfhi(wv.x) * bfhi(wv.x) + bflo(wv.y) * bflo(wv.y) + bfhi(wv.y) * bfhi(wv.y)
                             + bflo(wv.z) * bflo(wv.z) + bfhi(wv.z) * bfhi(wv.z) + bflo(wv.w) * bflo(wv.w) + bfhi(wv.w) * bfhi(wv.w); }
                    ssk += __shfl_xor(ssk, 16); ssk += __shfl_xor(ssk, 32);
                    const float rk = rsqrtf(ssk * (1.0f / 128.f) + EPS);
                    f32x4 acc = (f32x4){0.f, 0.f, 0.f, 0.f};
#pragma unroll
                    for (int ks = 0; ks < 4; ++ks) acc = __builtin_amdgcn_mfma_f32_16x16x32_bf16(kf[ks], qf[ks], acc, 0, 0, 0);
#pragma unroll
                    for (int rg = 0; rg < 4; ++rg) {
                        const int ki = 4 * fq + rg; const float rki = __shfl(rk, ki);
                        const int kcl = c0k + 16 * kt + ki; const bool valid = (kcl >= cstart) && (kcl < cstart + 16);
                        const int co = min(max(kcl - cq + 15, 0), 30);
                        const float bias = RP[hw * 465 + row_off * 31 + co];
                        const float sv = valid ? (acc[rg] * rki + bias) : -1.0e30f;
                        s[aa][kt][rg] = sv; mx = fmaxf(mx, sv);
                    }
                }
                if (st == 7) {
                    mx = fmaxf(mx, __shfl_xor(mx, 16)); mx = fmaxf(mx, __shfl_xor(mx, 32));
#pragma unroll
                    for (int a2 = 0; a2 < 8; ++a2)
#pragma unroll
                        for (int kt = 0; kt < 2; ++kt)
#pragma unroll
                            for (int rg = 0; rg < 4; ++rg) { const float p = __expf(s[a2][kt][rg] - mx); s[a2][kt][rg] = p; l += p; }
                    l += __shfl_xor(l, 16); l += __shfl_xor(l, 32);
                }
            } else {
                const int aa = st - 8;
                u32x4 pw; pw.x = cvt_pk_bf16(s[aa][0][0], s[aa][0][1]); pw.y = cvt_pk_bf16(s[aa][0][2], s[aa][0][3]); pw.z = cvt_pk_bf16(s[aa][1][0], s[aa][1][1]); pw.w = cvt_pk_bf16(s[aa][1][2], s[aa][1][3]);
                const bf16x8 pb = __builtin_bit_cast(bf16x8, pw);
#pragma unroll
                for (int dt = 0; dt < 8; ++dt) {
                    const LAS unsigned char* vp = buf + hw * NAT_VH + (16 * dt + fr) * 144 + (c0k + 4 * fq) * 2;
                    const u32x2 v0 = *(const LAS u32x2*)vp, v1 = *(const LAS u32x2*)(vp + 32);
                    const u32x4 vw = (u32x4){v0.x, v0.y, v1.x, v1.y};
                    o[dt] = __builtin_amdgcn_mfma_f32_16x16x32_bf16(__builtin_bit_cast(bf16x8, vw), pb, o[dt], 0, 0, 0);
                }
            }
            if (st + 1 < 16) { if (st & 1) NAT_WRITE(st + 1, R0); else NAT_WRITE(st + 1, R1); }
            __syncthreads();
        }
        const float inv = 1.0f / l;
#pragma unroll
        for (int dt = 0; dt < 8; ++dt) {
            const size_t off = (size_t)tq * HW + h * 128 + 16 * dt + 4 * fq;
            const u32x2 gw = *(const GAS u32x2*)(NG + off);
            u32x2 ow; ow.x = cvt_pk_bf16(o[dt][0] * inv * bflo(gw.x), o[dt][1] * inv * bfhi(gw.x)); ow.y = cvt_pk_bf16(o[dt][2] * inv * bflo(gw.y), o[dt][3] * inv * bfhi(gw.y));
            *(GAS u32x2*)(OB + off) = ow;
        }
#undef NAT_LOAD
#undef NAT_WRITE
    }
}

__global__ void __launch_bounds__(512, 2) mk_fwd(Args a) {
    extern __shared__ __attribute__((aligned(16))) unsigned char lds_raw[];
    LAS unsigned char* lds = (LAS unsigned char*)lds_raw;
    volatile LAS unsigned* MISC = (volatile LAS unsigned*)(lds + LDS_MISC_OFF);
    unsigned char* ws = a.ws;
    const int wid_s = __builtin_amdgcn_readfirstlane(threadIdx.x >> 6);
    if (threadIdx.x < 64) MISC[threadIdx.x] = 0u;
    __syncthreads();
    XcdBarrier bar; bar.bar = (unsigned*)(ws + WS_CTL) + 4096; bar.x = 0; bar.st = nullptr;
    const int lo = a.ph_lo, hi = a.ph_hi;
    if (hi - lo > 1) bar = xcd_barrier_post((unsigned*)(ws + WS_CTL) + 4096, MISC + 8);
#ifndef DIAG_MASK
#define DIAG_MASK 0x1ff
#endif
#define DM_(b) ((DIAG_MASK >> (b)) & 1)
#define IN(k) (lo <= (k) && (k) < hi)
#if MK_TS
    unsigned long long* TS = (unsigned long long*)(ws + 131072);
#define STAMP(k) do { if (blockIdx.x == 0 && threadIdx.x == 0) TS[k] = __builtin_amdgcn_s_memrealtime(); } while (0)
#define SEAM(k) do { if (IN(k) && (IN((k) + 1) || (k) == NPHASE - 1)) xcd_barrier(bar); STAMP((k) + 1); } while (0)
    STAMP(0);
#else
#define SEAM(k) do { if (IN(k) && IN((k) + 1)) xcd_barrier(bar); } while (0)
#endif
    const int G = gridDim.x, c = blockIdx.x;

    if (DM_(0) && IN(0)) { for (int rep = 0; rep < (MK_REP_PHASE == 0 ? MK_REP_N : 1); ++rep) { if (rep) xcd_barrier(bar); p0_prologue(a, lds); } }
    SEAM(0);
    for (int l = 0; l < 2; ++l) {
        const int pb = 1 + 7 * l;
        for (int rep = 0; rep < (MK_REP_PHASE == pb + 0 ? MK_REP_N : 1); ++rep) { if (rep) xcd_barrier(bar);
        if (DM_(1) && IN(pb + 0)) {
            unsigned char* ws = opaque_ptr(a.ws); bf16_t* XGA = (bf16_t*)(ws + WS_XGA); float* SSQ = (float*)(ws + WS_SSQ);
            pg8::Gemm g{XGA, (const bf16_t*)(ws + WS_WIN) + (size_t)l * NIN * DM, SEQ, NIN, DM, nullptr, nullptr}; pg8::StaticOrder S; S.init(SEQ, NIN, G, c);
            EpiInProj E{SSQ + (2 * l) * SEQ, (const float*)(ws + WS_LOWER) + l * 2048, ws};
            if (MK_REP_DUMMY && rep) { EpiDummy ED{(bf16_t*)(ws + WS_LT)}; pg8::gemm_phase<EpiDummy, pg8::StaticOrder>(lds, g, S, ED, wid_s); } else
            pg8::gemm_phase<EpiInProj, pg8::StaticOrder>(lds, g, S, E, wid_s);
        }
        if (DM_(1) && IN(pb + 0)) {
            unsigned char* ws = opaque_ptr(a.ws);
            const int nfull = (SEQ / 256) * (NIN / 256) % G;
            if (c >= nfull) {
                int kple = PLE; asm volatile("" : "+s"(kple));
                pg8::Gemm g2{(const bf16_t*)(ws + WS_PB) + (size_t)l * SEQ * PLE, (const bf16_t*)(ws + WS_WP) + (size_t)l * DM * PLE, SEQ, DM, kple, nullptr, nullptr}; pg8::StaticOrder S2; S2.init(SEQ, DM, G - nfull, c - nfull);
                EpiPL E2{(bf16_t*)(ws + WS_PL)};
                pg8::gemm_phase<EpiPL, pg8::StaticOrder>(lds, g2, S2, E2, wid_s);
            }
        } }
        SEAM(pb + 0);
        if (IN(pb + 1)) { for (int rep = 0; rep < (MK_REP_PHASE == pb + 1 ? MK_REP_N : 1); ++rep) { if (rep) xcd_barrier(bar); if (DM_(2)) h1_phase(a, lds, wid_s); }
            for (int rep = 0; rep < (MK_REP_PHASE == pb + 101 ? MK_REP_N : 1); ++rep) { if (rep) xcd_barrier(bar); if (DM_(8)) natten_phase(a, l, lds, wid_s); } }
        SEAM(pb + 1);
        if (DM_(3) && IN(pb + 2)) { for (int rep = 0; rep < (MK_REP_PHASE == pb + 2 ? MK_REP_N : 1); ++rep) { if (rep) xcd_barrier(bar); h2_phase(a, wid_s); } }
        SEAM(pb + 2);
        if (DM_(4) && IN(pb + 3)) { for (int rep = 0; rep < (MK_REP_PHASE == pb + 3 ? MK_REP_N : 1); ++rep) { if (rep) xcd_barrier(bar); h3_phase(a, l, lds, wid_s); } }
        SEAM(pb + 3);
        for (int rep = 0; rep < (MK_REP_PHASE == pb + 4 ? MK_REP_N : 1); ++rep) { if (rep) xcd_barrier(bar);
        if (DM_(5) && IN(pb + 4)) {
            unsigned char* ws = opaque_ptr(a.ws);
            pg8::PairOrder S; S.init(SEQ, DM, G, c);
            pg8::Gemm g{(const bf16_t*)(ws + WS_OA), (const bf16_t*)(ws + WS_WA) + (size_t)l * DM * HW, SEQ, DM, HW, (const bf16_t*)(ws + WS_OB), (const bf16_t*)(ws + WS_WB) + (size_t)l * DM * HW};
            EpiBranch E{(const bf16_t*)(ws + WS_MA), (const bf16_t*)(ws + WS_MB), (bf16_t*)(ws + WS_T), (bf16_t*)(ws + WS_Y)};
            pg8::gemm_phase<EpiBranch, pg8::PairOrder>(lds, g, S, E, wid_s);
        } }
        SEAM(pb + 4);
        for (int rep = 0; rep < (MK_REP_PHASE == pb + 5 ? MK_REP_N : 1); ++rep) { if (rep) xcd_barrier(bar);
        if (DM_(6) && IN(pb + 5)) {
            unsigned char* ws = opaque_ptr(a.ws); bf16_t* XGB = (bf16_t*)(ws + WS_XGB); float* SSQ = (float*)(ws + WS_SSQ);
            pg8::Gemm g{(const bf16_t*)(ws + WS_Y), (const bf16_t*)(ws + WS_WO) + (size_t)l * DM * DM, SEQ, DM, DM, nullptr, nullptr}; pg8::StaticOrder S; S.init(SEQ, DM, G, c);
            EpiWout E{(const bf16_t*)(ws + WS_XGA), XGB, rep ? (float*)(ws + 262144) : SSQ + (2 * l + 1) * SEQ};
            if (MK_REP_DUMMY && rep) { EpiDummy ED{(bf16_t*)(ws + WS_LT)}; pg8::gemm_phase<EpiDummy, pg8::StaticOrder>(lds, g, S, ED, wid_s); } else
            pg8::gemm_phase<EpiWout, pg8::StaticOrder>(lds, g, S, E, wid_s);
        } }
        SEAM(pb + 5);
        for (int rep = 0; rep < (MK_REP_PHASE == pb + 6 ? MK_REP_N : 1); ++rep) { if (rep) xcd_barrier(bar);
        if (DM_(7) && IN(pb + 6)) {
            unsigned char* ws = opaque_ptr(a.ws); bf16_t* XGA = (bf16_t*)(ws + WS_XGA); bf16_t* XGB = (bf16_t*)(ws + WS_XGB); float* SSQ = (float*)(ws + WS_SSQ);
            pg8::StaticOrder S; S.init(SEQ, DM, G, c);
            { pg8::Gemm g{XGB, (const bf16_t*)(ws + WS_WG) + (size_t)l * DM * DM, SEQ, DM, DM, nullptr, nullptr};
              EpiGate E{SSQ + (2 * l + 1) * SEQ, XGB, (const bf16_t*)(ws + WS_PL), a.out, XGA, rep ? (float*)(ws + 262144) : SSQ + (2 * l + 2 < 4 ? 2 * l + 2 : 0) * SEQ, l == 0 ? 1 : 0};
              pg8::gemm_phase<EpiGate, pg8::StaticOrder>(lds, g, S, E, wid_s); }
        } }
        SEAM(pb + 6);
    }
#if MK_TS
    if (blockIdx.x == 0) {
        const float dA = (float)(TS[MK_TS_A + 1] - TS[MK_TS_A]) * 0.01f, dB = (float)(TS[MK_TS_B + 1] - TS[MK_TS_B]) * 0.01f;
        for (int i = threadIdx.x; i < 1000000; i += 512) a.out[i] += (i == 0) ? 10.f * dA : 0.3f * dB;
    }
#endif
#undef IN
#undef SEAM
#if MK_ENDFLUSH
    asm volatile("s_waitcnt vmcnt(0)" ::: "memory");
    __builtin_amdgcn_fence(__ATOMIC_RELEASE, "agent");
    asm volatile("s_waitcnt vmcnt(0)" ::: "memory");
#endif
}


#ifndef MK_DIAG
#define MK_DIAG 0
#define MK_HOLE_BUF WS_MB
#define MK_HOLE_LD DM
#define MK_HOLE_MODE 0
#endif
#if MK_DIAG
__global__ void ck_sum(const void* p, size_t n, int kind, double* slot) {
    double s0 = 0.0, s1 = 0.0;
    for (size_t i = (size_t)blockIdx.x * blockDim.x + threadIdx.x; i < n; i += (size_t)gridDim.x * blockDim.x) {
        float v = kind ? bf2f(((const bf16_t*)p)[i]) : ((const float*)p)[i];
        if (!(v == v)) v = 12345.0f;
        const float wgt = (float)((int)((i * 2654435761ull >> 16) & 255) - 128);
        s0 += fabsf(v); s1 += (double)v * wgt;
    }
    for (int o = 32; o >= 1; o >>= 1) { s0 += __shfl_xor(s0, o); s1 += __shfl_xor(s1, o); }
    if ((threadIdx.x & 63) == 0) { atomicAdd(slot, s0); atomicAdd(slot + 1, s1); }
}
__global__ void ck_final(const double* sums, float* out, size_t n, int nslots) {
    int first = -1;
    for (int i = 0; i < nslots; ++i) { const double a0 = sums[2 * i], a1 = sums[2 * i + 1], b0 = sums[2 * (nslots + i)], b1 = sums[2 * (nslots + i) + 1];
        const bool bad = fabs(a0 - b0) > 1e-5 * (fabs(a0) + fabs(b0)) + 1e-30 || fabs(a1 - b1) > 1e-4 * (fabs(a0) + fabs(b0)) + 1e-30;
        if (bad) { first = i; break; } }
    const float val = first < 0 ? 0.f : 100.f * (float)(first + 1);
    for (size_t i = (size_t)blockIdx.x * blockDim.x + threadIdx.x; i < n; i += (size_t)gridDim.x * blockDim.x) out[i] = val;
}
__global__ void ck_holes(const bf16_t* p, size_t n, unsigned long long* res) {
    unsigned long long cnt = 0, mn = ~0ull;
    for (size_t i = (size_t)blockIdx.x * blockDim.x + threadIdx.x; i < n; i += (size_t)gridDim.x * blockDim.x) if (p[i] == 0xFFFFu) { ++cnt; if (i < mn) mn = i; }
    if (cnt) { atomicAdd(res, cnt); atomicMin(res + 1, mn); }
}
__global__ void ck_holes_final(const unsigned long long* res, float* out, size_t n, int mode) {
    const float val = mode == 0 ? (float)((double)res[0] / 65536.0 * 100.0) : mode == 1 ? (float)((res[1] == ~0ull ? 0 : (res[1] / 2048) ) ) + 100.f : (float)((res[1] == ~0ull ? 0 : (res[1] % 2048))) + 100.f;
    for (size_t i = (size_t)blockIdx.x * blockDim.x + threadIdx.x; i < n; i += (size_t)gridDim.x * blockDim.x) out[i] = val;
}
__global__ void ck_diff(const bf16_t* p, const bf16_t* q, size_t n, unsigned long long* res) {
    unsigned long long cnt = 0, mn = ~0ull, big = 0;
    for (size_t i = (size_t)blockIdx.x * blockDim.x + threadIdx.x; i < n; i += (size_t)gridDim.x * blockDim.x) if (p[i] != q[i]) { ++cnt; if (i < mn) mn = i; const float a = bf2f(p[i]), b = bf2f(q[i]); if (fabsf(a - b) > 0.02f * (fabsf(a) + fabsf(b))) ++big; }
    if (cnt) { atomicAdd(res, cnt); atomicMin(res + 1, mn); atomicAdd(res + 2, big); }
}
__global__ void ck_diff_final(const unsigned long long* res, float* out, size_t n, int ld) {
    const unsigned long long cnt = res[0], big = res[2];
    const float c2 = 100.f * (1.f + floorf(log2f(1.f + (float)cnt)));
    const float c1 = 1.0e6f * (1.f + floorf(log2f(1.f + (float)big)));
    for (size_t i = (size_t)blockIdx.x * blockDim.x + threadIdx.x; i < n; i += (size_t)gridDim.x * blockDim.x) out[i] = (i == 0) ? c1 : c2;
}

__device__ __forceinline__ unsigned hsh(unsigned x) { x ^= x >> 16; x *= 0x7feb352du; x ^= x >> 15; x *= 0x846ca68bu; x ^= x >> 16; return x; }
__device__ __forceinline__ float bfr(float f) { return bf2f(f2bf1(f)); }
__device__ __forceinline__ void err_max(unsigned* res, float got, float expv) { float e = fabsf(got - expv) / (0.02f + 0.02f * fabsf(expv)); if (!(e == e)) e = 1e9f; atomicMax(res, __float_as_uint(e)); }
__device__ __forceinline__ float wave_sum(float s) { for (int o = 32; o >= 1; o >>= 1) s += __shfl_xor(s, o); return s; }
__global__ void chk_inproj(const float* x, const float* g0, const float* win, const float* lbp, const unsigned char* ws, unsigned* res, int nsamp) {
    const int lane = threadIdx.x & 63, wv = (blockIdx.x * blockDim.x + threadIdx.x) >> 6, nw = (gridDim.x * blockDim.x) >> 6;
    for (int s = wv; s < nsamp; s += nw) {
        const int row = hsh(2 * s + 1) % SEQ, col = hsh(2 * s + 2) % NIN;
        float ss = 0.f, dot = 0.f;
        for (int k = lane; k < DM; k += 64) { const float xv = x[(size_t)row * DM + k]; ss += xv * xv; dot += bfr(xv * g0[k]) * bfr(win[(size_t)k * NIN + col]); }
        ss = wave_sum(ss); dot = wave_sum(dot);
        const float u = dot * rsqrtf(ss / DM + EPS);
        if (lane == 0) {
            const int seg = col >> 10, c = col & 1023; const size_t o1 = (size_t)row * HW + c;
            const float sg = 1.f / (1.f + expf(-u)), si = u * sg;
            if (seg == 0) err_max(res, bf2f(((const bf16_t*)(ws + WS_QH))[o1]), si);
            else if (seg == 1) err_max(res, bf2f(((const bf16_t*)(ws + WS_VH))[o1]), u);
            else if (seg == 2 || seg == 3) { const int dir = seg - 2; const float a0 = lbp[dir * 1024 + c], a1 = lbp[2048 + dir * 1024 + c]; const float lb = 0.f * (a0 + a1);
                const float f = lb + (1.f - lb) * sg; err_max(res + 1, ((const float*)(ws + (dir ? WS_GB : WS_GF)))[o1], logf(fmaxf(f, 1e-6f)));
                err_max(res + 1, bf2f(((const bf16_t*)(ws + (dir ? WS_KB : WS_KF)))[o1]), (1.f - lb) * (1.f - sg)); }
            else if (seg == 4) err_max(res, bf2f(((const bf16_t*)(ws + WS_HG))[o1]), si);
            else if (seg == 5) err_max(res, bf2f(((const bf16_t*)(ws + WS_NQ))[o1]), u);
            else if (seg == 6) err_max(res, bf2f(((const bf16_t*)(ws + WS_NK))[o1]), u);
            else if (seg == 7) err_max(res + 2, bf2f(((const bf16_t*)(ws + WS_VT))[(size_t)c * SEQ + row]), u);
            else if (seg == 8) err_max(res, bf2f(((const bf16_t*)(ws + WS_NG))[o1]), si);
            else if (seg < 11) err_max(res + 3, bf2f(((const bf16_t*)(ws + WS_MA))[(size_t)row * DM + col - 9216]), sg);
            else err_max(res + 9, bf2f(((const bf16_t*)(ws + WS_MB))[(size_t)row * DM + col - 11264]), sg);
        }
    }
}
__global__ void chk_natten(const unsigned char* ws, const float* gq, const float* gk, const float* rpb, unsigned* res, int nsamp) {
    const int lane = threadIdx.x & 63, wv = (blockIdx.x * blockDim.x + threadIdx.x) >> 6, nw = (gridDim.x * blockDim.x) >> 6;
    const bf16_t* NQ = (const bf16_t*)(ws + WS_NQ); const bf16_t* NK = (const bf16_t*)(ws + WS_NK); const bf16_t* VT = (const bf16_t*)(ws + WS_VT); const bf16_t* NG = (const bf16_t*)(ws + WS_NG); const bf16_t* OB = (const bf16_t*)(ws + WS_OB);
    for (int s = wv; s < nsamp; s += nw) {
        const int t = hsh(3 * s + 7) % SEQ, h = hsh(3 * s + 8) % 8; const int r = t >> 6, c = t & 63;
        const int rs0 = min(max(r - 4, 0), 120), cs0 = min(max(c - 8, 0), 48);
        float q0 = bf2f(NQ[(size_t)t * HW + h * 128 + lane]), q1 = bf2f(NQ[(size_t)t * HW + h * 128 + 64 + lane]);
        const float rq = rsqrtf(wave_sum(q0 * q0 + q1 * q1) / 128.f + EPS); q0 *= rq * gq[lane]; q1 *= rq * gq[64 + lane];
        float mx = -1e30f;
        float o0 = 0.f, o1 = 0.f, l = 0.f;
        for (int pass = 0; pass < 2; ++pass) {
            for (int a = 0; a < 8; ++a) for (int j = 0; j < 16; ++j) {
                const int kr = rs0 + a, kc = cs0 + j, tk = kr * 64 + kc;
                float k0 = bf2f(NK[(size_t)tk * HW + h * 128 + lane]), k1 = bf2f(NK[(size_t)tk * HW + h * 128 + 64 + lane]);
                const float rk = rsqrtf(wave_sum(k0 * k0 + k1 * k1) / 128.f + EPS);
                const float d = wave_sum(q0 * k0 * rk * gk[lane] + q1 * k1 * rk * gk[64 + lane]) * 0.08838834764831845f + rpb[(size_t)h * 465 + (kr - r + 7) * 31 + (kc - c + 15)];
                if (pass == 0) mx = fmaxf(mx, d);
                else { const float p = expf(d - mx); l += p; o0 += p * bf2f(VT[(size_t)(h * 128 + lane) * SEQ + tk]); o1 += p * bf2f(VT[(size_t)(h * 128 + 64 + lane) * SEQ + tk]); }
            }
        }
        const size_t ob = (size_t)t * HW + h * 128;
        err_max(res, bf2f(OB[ob + lane]), o0 / l * bf2f(NG[ob + lane])); err_max(res, bf2f(OB[ob + 64 + lane]), o1 / l * bf2f(NG[ob + 64 + lane]));
    }
}
__global__ void chk_hgrn_scan(const unsigned char* ws, float* OREF, int h0) {
    __shared__ float qs[128], ks[128], fs[128], vs[128], part[4][128];
    const int tid = threadIdx.x, v = tid & 127, kq = tid >> 7; const int h = h0 + (blockIdx.x >> 1), d = blockIdx.x & 1;
    const bf16_t* QH = (const bf16_t*)(ws + WS_QH); const bf16_t* VH = (const bf16_t*)(ws + WS_VH); const bf16_t* KK = (const bf16_t*)(ws + (d ? WS_KB : WS_KF)); const float* G = (const float*)(ws + (d ? WS_GB : WS_GF));
    float S[32];
#pragma unroll
    for (int i = 0; i < 32; ++i) S[i] = 0.f;
    float* out = OREF + (size_t)blockIdx.x * SEQ * 128;
    for (int step = 0; step < SEQ; ++step) {
        const int t = d ? SEQ - 1 - step : step;
        if (tid < 128) { qs[tid] = bf2f(QH[(size_t)t * HW + h * 128 + tid]); ks[tid] = bf2f(KK[(size_t)t * HW + h * 128 + tid]); fs[tid] = expf(G[(size_t)t * HW + h * 128 + tid]); vs[tid] = bf2f(VH[(size_t)t * HW + h * 128 + tid]); }
        __syncthreads();
        float p = 0.f; const float vv = vs[v];
#pragma unroll
        for (int i = 0; i < 32; ++i) { const int k = 32 * kq + i; S[i] = fs[k] * S[i] + ks[k] * vv; p += S[i] * qs[k]; }
        part[kq][v] = p;
        __syncthreads();
        if (tid < 128) out[(size_t)t * 128 + tid] = part[0][tid] + part[1][tid] + part[2][tid] + part[3][tid];
    }
}
__global__ void chk_hgrn_out(const unsigned char* ws, const float* OREF, const float* onorm, unsigned* res, int h0, int nh) {
    const int lane = threadIdx.x & 63, wv = (blockIdx.x * blockDim.x + threadIdx.x) >> 6, nw = (gridDim.x * blockDim.x) >> 6;
    const bf16_t* HG = (const bf16_t*)(ws + WS_HG); const bf16_t* OA = (const bf16_t*)(ws + WS_OA);
    for (int s = wv; s < nh * SEQ; s += nw) {
        const int hh = s / SEQ, t = s % SEQ, h = h0 + hh;
        const float* of = OREF + ((size_t)(2 * hh) * SEQ + t) * 128; const float* ob = OREF + ((size_t)(2 * hh + 1) * SEQ + t) * 128;
        const float a0 = of[lane] + ob[lane], a1 = of[64 + lane] + ob[64 + lane];
        const float rs = rsqrtf(wave_sum(a0 * a0 + a1 * a1) / 128.f + EPS);
        const size_t o = (size_t)t * HW + h * 128;
        err_max(res, bf2f(OA[o + lane]), a0 * rs * onorm[lane] * bf2f(HG[o + lane])); err_max(res, bf2f(OA[o + 64 + lane]), a1 * rs * onorm[64 + lane] * bf2f(HG[o + 64 + lane]));
    }
}
__global__ void chk_branch(const unsigned char* ws, const float* wa, const float* wb, unsigned* res, int nsamp) {
    const int lane = threadIdx.x & 63, wv = (blockIdx.x * blockDim.x + threadIdx.x) >> 6, nw = (gridDim.x * blockDim.x) >> 6;
    const bf16_t* OA = (const bf16_t*)(ws + WS_OA); const bf16_t* OB = (const bf16_t*)(ws + WS_OB); const bf16_t* MA = (const bf16_t*)(ws + WS_MA); const bf16_t* MB = (const bf16_t*)(ws + WS_MB); const bf16_t* Y = (const bf16_t*)(ws + WS_Y);
    for (int s = wv; s < nsamp; s += nw) {
        const int row = hsh(5 * s + 1) % SEQ, col = hsh(5 * s + 2) % DM; float da = 0.f, db = 0.f;
        for (int k = lane; k < HW; k += 64) { da += bf2f(OA[(size_t)row * HW + k]) * bfr(wa[(size_t)k * DM + col]); db += bf2f(OB[(size_t)row * HW + k]) * bfr(wb[(size_t)k * DM + col]); }
        da = wave_sum(da); db = wave_sum(db);
        if (lane == 0) err_max(res, bf2f(Y[(size_t)row * DM + col]), bf2f(MA[(size_t)row * DM + col]) * da + bf2f(MB[(size_t)row * DM + col]) * db);
    }
}
__global__ void chk_wout(const unsigned char* ws, const float* xin, const float* wo, unsigned* res, int nsamp) {
    const int lane = threadIdx.x & 63, wv = (blockIdx.x * blockDim.x + threadIdx.x) >> 6, nw = (gridDim.x * blockDim.x) >> 6;
    const bf16_t* Y = (const bf16_t*)(ws + WS_Y); const float* X1 = (const float*)(ws + WS_X1);
    for (int s = wv; s < nsamp; s += nw) {
        const int row = hsh(7 * s + 1) % SEQ, col = hsh(7 * s + 2) % DM; float d = 0.f;
        for (int k = lane; k < DM; k += 64) d += bf2f(Y[(size_t)row * DM + k]) * bfr(wo[(size_t)k * DM + col]);
        d = wave_sum(d);
        if (lane == 0) err_max(res, X1[(size_t)row * DM + col], xin[(size_t)row * DM + col] + d);
    }
}
__global__ void chk_gate(const unsigned char* ws, const float* out, const float* p, const float* wp, const float* wg, const float* pn, unsigned* res, int nsamp) {
    const int lane = threadIdx.x & 63, wv = (blockIdx.x * blockDim.x + threadIdx.x) >> 6, nw = (gridDim.x * blockDim.x) >> 6;
    const float* X1 = (const float*)(ws + WS_X1);
    for (int s = wv; s < nsamp; s += nw) {
        const int row = hsh(9 * s + 1) % SEQ, col = hsh(9 * s + 2) % DM; float d = 0.f, ss = 0.f, pl = 0.f;
        for (int k = lane; k < DM; k += 64) { const float xv = X1[(size_t)row * DM + k]; ss += xv * xv; d += bfr(xv * pn[k]) * bfr(wg[(size_t)k * DM + col]); }
        for (int k = lane; k < PLE; k += 64) pl += bfr(p[(size_t)row * PLE + k]) * bfr(wp[(size_t)k * DM + col]);
        d = wave_sum(d); ss = wave_sum(ss); pl = wave_sum(pl);
        if (lane == 0) { const float g = 1.f / (1.f + expf(-d * rsqrtf(ss / DM + EPS))); err_max(res, out[(size_t)row * DM + col], X1[(size_t)row * DM + col] + pl * g); }
    }
}
__global__ void chk_final(const unsigned* res, float* out, size_t n, int nres) {
    int first = -1; for (int i = 0; i < nres; ++i) if (__uint_as_float(res[i]) > 1.0f) { first = i; break; }
    float bucket = 0.f; if (first >= 0) { const float e = __uint_as_float(res[first]); bucket = fminf(fmaxf(floorf(log10f(e)) + 1.f, 0.f), 9.f); }
    const float val = first < 0 ? 0.f : 100.f * (float)(first + 1) + 10.f * bucket;
    for (size_t i = (size_t)blockIdx.x * blockDim.x + threadIdx.x; i < n; i += (size_t)gridDim.x * blockDim.x) out[i] = val;
}

__global__ void ck_big(const bf16_t* p, size_t n, unsigned long long* res) {
    unsigned long long c0 = 0, c2 = 0, c4 = 0; float mxv = 0.f;
    for (size_t i = (size_t)blockIdx.x * blockDim.x + threadIdx.x; i < n; i += (size_t)gridDim.x * blockDim.x) { const float v = bf2f(p[i]);
        if (!(fabsf(v) <= 3.0e38f)) ++c0; else if (fabsf(v) > 1.01f || v < -0.01f) { ++c2; mxv = fmaxf(mxv, fabsf(v)); if (v < 0.f) ++c4; } }
    if (c0 | c2) { atomicAdd(res, c0); atomicAdd(res + 2, c2); atomicAdd(res + 4, c4); atomicMax((unsigned*)(res + 3), __float_as_uint(mxv)); }
}
__global__ void ck_big_final(const unsigned long long* res, float* out, size_t n, int ld) {
    const float mxv = __uint_as_float((unsigned)res[3]);
    const float c1 = 1.0e4f * (1.f + floorf(log2f(1.f + (float)res[0])));
    const float negf = res[2] ? (float)res[4] / (float)res[2] : 0.f;
    const float c2 = 1000.f * (1.f + floorf(negf * 3.99f)) + 100.f * fminf(fmaxf(floorf(log10f(fmaxf(mxv, 1e-9f))) + 2.f, 0.f), 9.f);
    for (size_t i = (size_t)blockIdx.x * blockDim.x + threadIdx.x; i < n; i += (size_t)gridDim.x * blockDim.x) out[i] = (i == 0) ? c1 : c2;
}
struct CkBuf { int phase; int idx; size_t off; size_t n; int kind; };
#endif

extern "C" void kernel_launch(void* const* d_in, const int* in_sizes, int n_in, void* d_out, int out_size, void* d_ws, size_t ws_size, hipStream_t stream) {
    static int grid = 0;
    if (grid == 0) {
        if (n_in != 15 || out_size != SEQ * DM || ws_size < WS_END) { fprintf(stderr, "kernel_launch: unexpected problem (n_in %d, out %d, ws %zu)\n", n_in, out_size, ws_size); grid = -1; return; }
        int dev = 0, cus = 0;
        if (hipGetDevice(&dev) != hipSuccess || hipDeviceGetAttribute(&cus, hipDeviceAttributeMultiprocessorCount, dev) != hipSuccess) { grid = -1; return; }
        if (hipFuncSetAttribute((const void*)mk_fwd, hipFuncAttributeMaxDynamicSharedMemorySize, LDS_BYTES) != hipSuccess) { fprintf(stderr, "kernel_launch: hipFuncSetAttribute failed\n"); grid = -1; return; }
        int per_cu = 0;
        if (hipOccupancyMaxActiveBlocksPerMultiprocessor(&per_cu, (const void*)mk_fwd, 512, LDS_BYTES) != hipSuccess || per_cu < 1) fprintf(stderr, "kernel_launch: occupancy query says %d\n", per_cu);
        (void)hipGetLastError();
        grid = cus;
    }
    if (grid < 0) return;
    (void)hipMemsetAsync((char*)d_ws + WS_CTL, 0, CTL_ZERO_BYTES, stream);
    Args a{};
    for (int i = 0; i < 15; ++i) a.in[i] = (const float*)d_in[i];
    a.out = (float*)d_out; a.ws = (unsigned char*)d_ws;
#if MK_DIAG == 5
    {
        unsigned long long* res = (unsigned long long*)((char*)d_ws + 65536);
        (void)hipMemsetAsync((char*)d_ws + 65536 + 8, 0xFF, 8, stream);
        for (int ph = 0; ph < 2; ++ph) { a.ph_lo = ph; a.ph_hi = ph + 1; hipLaunchKernelGGL(mk_fwd, dim3(grid), dim3(512), LDS_BYTES, stream, a); }
        hipLaunchKernelGGL(ck_big, dim3(1024), dim3(256), 0, stream, (const bf16_t*)((char*)d_ws + WS_MA), (size_t)SEQ * DM, res);
        hipLaunchKernelGGL(ck_big_final, dim3(1024), dim3(256), 0, stream, (const unsigned long long*)res, (float*)d_out, (size_t)SEQ * DM, DM);
    }
#elif MK_DIAG == 4
    {
        unsigned* res = (unsigned*)((char*)d_ws + 65536);
        float* OREF = (float*)((char*)d_ws + 728 * MiB);
        const unsigned char* wsc = (const unsigned char*)d_ws;
        const float* const* in = a.in;
        for (int ph = 0; ph < NPHASE; ++ph) {
            a.ph_lo = ph; a.ph_hi = ph + 1; hipLaunchKernelGGL(mk_fwd, dim3(grid), dim3(512), LDS_BYTES, stream, a);
            if (ph == 1) hipLaunchKernelGGL(chk_inproj, dim3(512), dim3(256), 0, stream, in[0], in[2], in[3], in[4], wsc, res + 0, 32768);
            if (ph == 2) hipLaunchKernelGGL(chk_natten, dim3(256), dim3(256), 0, stream, wsc, in[6], in[7], in[8], res + 4, 1024);
            if (ph == 4) { hipLaunchKernelGGL(chk_hgrn_scan, dim3(4), dim3(512), 0, stream, wsc, OREF, 2);
                           hipLaunchKernelGGL(chk_hgrn_out, dim3(512), dim3(256), 0, stream, wsc, (const float*)OREF, in[5], res + 5, 2, 2); }
            if (ph == 5) hipLaunchKernelGGL(chk_branch, dim3(512), dim3(256), 0, stream, wsc, in[9], in[10], res + 6, 8192);
            if (ph == 6) hipLaunchKernelGGL(chk_wout, dim3(512), dim3(256), 0, stream, wsc, in[0], in[11], res + 7, 8192);
            if (ph == 7) hipLaunchKernelGGL(chk_gate, dim3(512), dim3(256), 0, stream, wsc, (const float*)d_out, in[1], in[14], in[13], in[12], res + 8, 8192);
        }
        hipLaunchKernelGGL(chk_final, dim3(1024), dim3(256), 0, stream, (const unsigned*)res, (float*)d_out, (size_t)SEQ * DM, 10);
    }
#elif MK_DIAG == 3
    {
        unsigned long long* res = (unsigned long long*)((char*)d_ws + 65536);
        bf16_t* SAVE = (bf16_t*)((char*)d_ws + 728 * MiB);
        (void)hipMemsetAsync((char*)d_ws + MiB, 0xAA, WS_END - MiB, stream);
        (void)hipMemsetAsync((char*)d_ws + 65536 + 8, 0xFF, 8, stream);
        for (int ph = 0; ph < 2; ++ph) { a.ph_lo = ph; a.ph_hi = ph + 1; hipLaunchKernelGGL(mk_fwd, dim3(grid), dim3(512), LDS_BYTES, stream, a); }
        (void)hipMemcpyAsync(SAVE, (char*)d_ws + MK_HOLE_BUF, (size_t)SEQ * MK_HOLE_LD * 2, hipMemcpyDeviceToDevice, stream);
        a.ph_lo = 1; a.ph_hi = 2; hipLaunchKernelGGL(mk_fwd, dim3(grid), dim3(512), LDS_BYTES, stream, a);
        hipLaunchKernelGGL(ck_diff, dim3(1024), dim3(256), 0, stream, (const bf16_t*)((char*)d_ws + MK_HOLE_BUF), (const bf16_t*)SAVE, (size_t)SEQ * MK_HOLE_LD, res);
        hipLaunchKernelGGL(ck_diff_final, dim3(1024), dim3(256), 0, stream, (const unsigned long long*)res, (float*)d_out, (size_t)SEQ * DM, MK_HOLE_LD);
    }
#elif MK_DIAG == 2
    {
        unsigned long long* res = (unsigned long long*)((char*)d_ws + 65536);
        (void)hipMemsetAsync((char*)d_ws + MiB, 0xAA, WS_END - MiB, stream);
        (void)hipMemsetAsync((char*)d_ws + 65536 + 8, 0xFF, 8, stream);
        a.ph_lo = 0; a.ph_hi = 1; hipLaunchKernelGGL(mk_fwd, dim3(grid), dim3(512), LDS_BYTES, stream, a);
        (void)hipMemsetAsync((char*)d_ws + MK_HOLE_BUF, 0xFF, (size_t)SEQ * MK_HOLE_LD * 2, stream);
        a.ph_lo = 1; a.ph_hi = 2; hipLaunchKernelGGL(mk_fwd, dim3(grid), dim3(512), LDS_BYTES, stream, a);
        hipLaunchKernelGGL(ck_holes, dim3(1024), dim3(256), 0, stream, (const bf16_t*)((char*)d_ws + MK_HOLE_BUF), (size_t)SEQ * MK_HOLE_LD, res);
        hipLaunchKernelGGL(ck_holes_final, dim3(1024), dim3(256), 0, stream, (const unsigned long long*)res, (float*)d_out, (size_t)SEQ * DM, MK_HOLE_MODE);
    }
#elif MK_DIAG
    {
        static const CkBuf B0[] = {
            {0, 0, WS_LOWER, 4096, 0}, {0, 1, WS_SSQ, 8192, 0}, {0, 2, WS_XGA, (size_t)SEQ * DM, 1}, {0, 3, WS_PB, (size_t)2 * SEQ * PLE, 1}, {0, 4, WS_WIN, (size_t)2 * NIN * DM, 1},
            {0, 5, WS_WA, (size_t)2 * DM * HW, 1}, {0, 6, WS_WB, (size_t)2 * DM * HW, 1}, {0, 7, WS_WO, (size_t)2 * DM * DM, 1}, {0, 8, WS_WG, (size_t)2 * DM * DM, 1}, {0, 9, WS_WP, (size_t)2 * DM * PLE, 1} };
        static const CkBuf BL[] = {
            {0, 10, WS_QH, (size_t)SEQ * HW, 1}, {0, 11, WS_VH, (size_t)SEQ * HW, 1}, {0, 12, WS_KF, (size_t)SEQ * HW, 1}, {0, 13, WS_KB, (size_t)SEQ * HW, 1}, {0, 14, WS_HG, (size_t)SEQ * HW, 1},
            {0, 15, WS_NQ, (size_t)SEQ * HW, 1}, {0, 16, WS_NK, (size_t)SEQ * HW, 1}, {0, 17, WS_VT, (size_t)SEQ * HW, 1}, {0, 18, WS_NG, (size_t)SEQ * HW, 1}, {0, 19, WS_GF, (size_t)SEQ * HW, 0},
            {0, 20, WS_GB, (size_t)SEQ * HW, 0}, {0, 21, WS_MA, (size_t)SEQ * DM, 1}, {0, 22, WS_MB, (size_t)SEQ * DM, 1},
            {1, 23, WS_LT, (size_t)2048 * 16384, 0}, {1, 24, WS_DD, (size_t)2048 * 128, 0}, {1, 25, WS_EE, (size_t)2048 * 128, 0}, {1, 26, WS_OB, (size_t)SEQ * HW, 1},
            {2, 27, WS_SP, (size_t)2048 * 16384, 1}, {3, 28, WS_OA, (size_t)SEQ * HW, 1}, {4, 29, WS_T, (size_t)SEQ * DM, 0}, {4, 30, WS_Y, (size_t)SEQ * DM, 1},
            {5, 31, WS_X1, (size_t)SEQ * DM, 0}, {5, 32, WS_XGB, (size_t)SEQ * DM, 1}, {6, 34, WS_PL, (size_t)SEQ * DM, 0}, {6, 35, (size_t)-1, (size_t)SEQ * DM, 0} };
        const int NS = 80;
        double* sums = (double*)((char*)d_ws + 65536);
        (void)hipMemsetAsync((char*)d_ws + MiB, 0xAA, WS_END - MiB, stream);
        for (int run = 0; run < 2; ++run) {
            (void)hipMemsetAsync((char*)d_ws + WS_CTL, 0, 32768, stream);
            for (int ph = 0; ph < NPHASE; ++ph) {
                a.ph_lo = ph; a.ph_hi = ph + 1; hipLaunchKernelGGL(mk_fwd, dim3(grid), dim3(512), LDS_BYTES, stream, a);
                if (ph == 0) { for (const CkBuf& b : B0) hipLaunchKernelGGL(ck_sum, dim3(1024), dim3(256), 0, stream, (const void*)((char*)d_ws + b.off), b.n, b.kind, sums + 2 * (run * NS + b.idx)); }
                else { const int l = (ph - 1) / 7, k = (ph - 1) % 7;
                    for (const CkBuf& b : BL) if (b.phase == k) hipLaunchKernelGGL(ck_sum, dim3(1024), dim3(256), 0, stream, b.off == (size_t)-1 ? (const void*)d_out : (const void*)((char*)d_ws + b.off), b.n, b.kind, sums + 2 * (run * NS + b.idx + 40 * l)); }
            }
        }
        hipLaunchKernelGGL(ck_final, dim3(1024), dim3(256), 0, stream, (const double*)sums, (float*)d_out, (size_t)SEQ * DM, NS);
    }
#elif MK_MULTI
    for (int ph = 0; ph < NPHASE; ++ph) { a.ph_lo = ph; a.ph_hi = ph + 1; hipLaunchKernelGGL(mk_fwd, dim3(grid), dim3(512), LDS_BYTES, stream, a); }
#else
    a.ph_lo = 0; a.ph_hi = NPHASE; hipLaunchKernelGGL(mk_fwd, dim3(grid), dim3(512), LDS_BYTES, stream, a);
#endif
}
```

```cpp
#include <hip/hip_runtime.h>
#include <cstdio>
#include <cstdint>

#ifndef MK_ALIGN
#define MK_ALIGN true
#endif
#ifndef MK_SP2
#define MK_SP2 true
#endif
#ifndef MK_TS
#define MK_TS 0
#endif
#ifndef MK_TS_A
#define MK_TS_A 0
#define MK_TS_B 1
#endif
#ifndef MK_REP_PHASE
#define MK_REP_PHASE -1
#endif
#ifndef MK_REP_DUMMY
#define MK_REP_DUMMY 0
#endif
#ifndef MK_REP_N
#define MK_REP_N 3
#endif
#ifndef MK_ENDFLUSH
#define MK_ENDFLUSH 0
#endif
#ifndef MK_MULTI
#define MK_MULTI 0
#endif

#define LAS __attribute__((address_space(3)))
typedef unsigned short bf16_t;
typedef short bf16x8 __attribute__((ext_vector_type(8)));
typedef float f32x4 __attribute__((ext_vector_type(4)));
typedef float f32x2 __attribute__((ext_vector_type(2)));
typedef unsigned u32x4 __attribute__((ext_vector_type(4)));
typedef unsigned u32x2 __attribute__((ext_vector_type(2)));

constexpr int SEQ = 8192, DM = 2048, NIN = 13312, HW = 1024, PLE = 256;
constexpr float EPS = 1e-6f;
constexpr int NPHASE = 15;

constexpr size_t MiB = 1u << 20;
constexpr size_t WS_CTL = 0, CTL_ZERO_BYTES = 1 * MiB;
constexpr size_t WS_LOWER = 1 * MiB;
constexpr size_t WS_SSQ = 1 * MiB + 64 * 1024;
constexpr size_t WS_DD = 2 * MiB;
constexpr size_t WS_EE = 3 * MiB;
constexpr size_t WS_WIN = 4 * MiB;
constexpr size_t WS_WA = 108 * MiB;
constexpr size_t WS_WB = 116 * MiB;
constexpr size_t WS_WO = 124 * MiB;
constexpr size_t WS_WG = 140 * MiB;
constexpr size_t WS_WP = 156 * MiB;
constexpr size_t WS_PB = 158 * MiB;
constexpr size_t WS_XGA = 166 * MiB;
constexpr size_t WS_XGB = 198 * MiB;
constexpr size_t WS_QH = 230 * MiB;
constexpr size_t WS_VH = 246 * MiB;
constexpr size_t WS_KF = 262 * MiB;
constexpr size_t WS_KB = 278 * MiB;
constexpr size_t WS_HG = 294 * MiB;
constexpr size_t WS_NQ = 310 * MiB;
constexpr size_t WS_NK = 326 * MiB;
constexpr size_t WS_VT = 342 * MiB;
constexpr size_t WS_NG = 358 * MiB;
constexpr size_t WS_OA = 374 * MiB;
constexpr size_t WS_OB = 390 * MiB;
constexpr size_t WS_GF = 406 * MiB;
constexpr size_t WS_GB = 438 * MiB;
constexpr size_t WS_MA = 470 * MiB;
constexpr size_t WS_MB = 502 * MiB;
constexpr size_t WS_LT = 534 * MiB;
constexpr size_t WS_SP = 662 * MiB;
constexpr size_t WS_PL = 726 * MiB;
constexpr size_t WS_END = 758 * MiB;
constexpr size_t WS_T = WS_LT;
constexpr size_t WS_Y = WS_SP;

constexpr int LDS_BYTES = 147456;
constexpr int LDS_MISC_OFF = 131072;

typedef __bf16 bf16x2_t __attribute__((ext_vector_type(2)));
__device__ __forceinline__ unsigned cvt_pk_bf16(float lo, float hi) { bf16x2_t v = {(__bf16)lo, (__bf16)hi}; return __builtin_bit_cast(unsigned, v); }
__device__ __forceinline__ float bf2f(unsigned short b) { return __uint_as_float(((unsigned)b) << 16); }
__device__ __forceinline__ float bflo(unsigned w) { return __uint_as_float(w << 16); }
__device__ __forceinline__ float bfhi(unsigned w) { return __uint_as_float(w & 0xffff0000u); }
__device__ __forceinline__ unsigned short f2bf1(float f) { return (unsigned short)(cvt_pk_bf16(f, 0.f) & 0xffffu); }
typedef _Float16 f16x2_t __attribute__((ext_vector_type(2)));
__device__ __forceinline__ unsigned cvt_pk_f16(float lo, float hi) { f16x2_t v = {(_Float16)lo, (_Float16)hi}; return __builtin_bit_cast(unsigned, v); }
__device__ __forceinline__ float f16_to_f32(unsigned short h) { return (float)__builtin_bit_cast(_Float16, h); }
__device__ __forceinline__ float fast_rcp(float x) { return __builtin_amdgcn_rcpf(x); }
__device__ __forceinline__ float sigmoid_f(float x) { return fast_rcp(1.f + __expf(-x)); }
__device__ __forceinline__ float silu_f(float x) { return x * sigmoid_f(x); }

__device__ __forceinline__ int opaque_tid(int wid_s) { int lane; asm volatile("v_mbcnt_lo_u32_b32 %0, -1, 0\n\tv_mbcnt_hi_u32_b32 %0, -1, %0" : "=v"(lane)); asm volatile("" : "+s"(wid_s)); return wid_s * 64 + lane; }
__device__ __forceinline__ unsigned char* opaque_ptr(unsigned char* p) { asm volatile("" : "+s"(p)); return p; }
__device__ __forceinline__ int opaque_bid() { int b = blockIdx.x; asm volatile("" : "+s"(b)); return b; }
namespace pg8 {
#define PG8_LAS __attribute__((address_space(3)))
constexpr int BM = 256, BK = 64, HALF = 128, HTB = HALF * BK * 2, STAGE_BYTES = 8 * HTB, NXCD = 8, WGM = 8;
__host__ __device__ __forceinline__ int lds_byte(int r, int c) { const int st = (r >> 4) * 2 + (c >> 5), rr = r & 15, cc = c & 31, ob = rr * 64 + cc * 2; return st * 1024 + (ob ^ (((ob >> 9) & 1) << 5)); }
__host__ __device__ __forceinline__ void stage_rc(int b, int& R, int& C) { const int st = b / 1024, sb = b % 1024, swz = sb ^ (((sb >> 9) & 1) << 5); R = (st >> 1) * 16 + swz / 64; C = (st & 1) * 32 + (swz % 64) / 2; }
__host__ __device__ __forceinline__ int perm32(int rho) { const int n = rho >> 4, i = rho & 15; return 8 * (i >> 2) + 4 * n + (i & 3); }

struct Unit { int pm, pn, z; };
struct Gemm { const bf16_t* A; const bf16_t* Bt; int M, N, K; const bf16_t* A2; const bf16_t* Bt2; };

struct StaticOrder {
    int nM, nN, nwg, G, c;
    __host__ __device__ void init(int M, int N, int G_, int c_) { nM = M / BM; nN = N / BM; nwg = nM * nN; G = G_; c = c_; }
    __host__ __device__ bool next(int i, Unit& u) const {
        const long L = (long)i * G + c; if (L >= nwg) return false;
        int wgid = (int)L; { const int q = nwg / NXCD, r = nwg % NXCD, xcd = wgid % NXCD, off = wgid / NXCD; wgid = (xcd < r ? xcd * (q + 1) : r * (q + 1) + (xcd - r) * q) + off; }
        const int nig = WGM * nN, gid = wgid / nig, fm = gid * WGM, gsz = (nM - fm) < WGM ? (nM - fm) : WGM;
        u.pm = fm + ((wgid % nig) % gsz); u.pn = (wgid % nig) / gsz; u.z = 0; return true;
    }
    __device__ __forceinline__ void a_ready(const Unit&) const {}
    __device__ __forceinline__ void done(const Unit&) const {}
};
struct PairOrder : StaticOrder {
    __host__ __device__ bool next(int i, Unit& u) const { const bool ok = StaticOrder::next(i >> 1, u); u.z = i & 1; return ok; }
};

template <class Epi, class Sched, bool ALIGN_EPI = MK_ALIGN, bool SP2 = MK_SP2>
__device__ __forceinline__ void gemm_phase(PG8_LAS unsigned char* lds, const Gemm g, const Sched& S, const Epi& E, int wid_s) {
    const int tid = opaque_tid(wid_s), wid = __builtin_amdgcn_readfirstlane(tid >> 6), lane = tid & 63, wr = wid >> 2, wc = wid & 3, fr = lane & 15, fq = lane >> 4;
    const int K = g.K, nt = K / BK;
    unsigned voffA[2], voffB[2];
#pragma unroll
    for (int i = 0; i < 2; ++i) { int R, C; stage_rc(tid * 16 + i * 8192, R, C); const int Rb = Epi::PERM ? ((R & ~31) + perm32(R & 31)) : R;
        voffA[i] = (unsigned)(R * K + C) * 2u; voffB[i] = (unsigned)(Rb * K + C) * 2u; }
    const size_t kstep = (size_t)(BK * 2);
    const size_t hstep = (size_t)HALF * K * 2;
    const size_t tstep = 2 * hstep;
    const unsigned ldsw = (unsigned)wid * 1024u;
    const int aoff = lds_byte(wr * 64 + fr, fq * 8), boff = lds_byte(wc * 32 + fr, fq * 8);
#define PG8_SA(b, h) (((b) * 2 + (h)) * HTB)
#define PG8_SB(b, h) ((4 + (b) * 2 + (h)) * HTB)
#define PG8_STAGE(bufoff, gbase, voff) do { _Pragma("unroll") for (int _i = 0; _i < 2; ++_i) \
        __builtin_amdgcn_global_load_lds((const unsigned*)((const char*)(gbase) + (voff)[_i]), (PG8_LAS unsigned*)(lds + (bufoff) + ldsw + _i * 8192), 16, 0, 0); } while (0)
#define PG8_LDA(dst, b, h) do { _Pragma("unroll") for (int m = 0; m < 4; ++m) _Pragma("unroll") for (int k = 0; k < 2; ++k) dst[m][k] = *(const PG8_LAS bf16x8*)(lds + PG8_SA(b, h) + aoff + m * 2048 + k * 1024); } while (0)
#define PG8_LDB(dst, b, h) do { _Pragma("unroll") for (int n = 0; n < 2; ++n) _Pragma("unroll") for (int k = 0; k < 2; ++k) dst[n][k] = *(const PG8_LAS bf16x8*)(lds + PG8_SB(b, h) + boff + n * 2048 + k * 1024); } while (0)
#define PG8_MMA(ai, bj, At, Bt) do { __builtin_amdgcn_s_setprio(1); _Pragma("unroll") for (int m = 0; m < 4; ++m) _Pragma("unroll") for (int n = 0; n < 2; ++n) _Pragma("unroll") for (int k = 0; k < 2; ++k) \
        acc[ai][bj][m][n] = __builtin_amdgcn_mfma_f32_16x16x32_bf16(Bt[n][k], At[m][k], acc[ai][bj][m][n], 0, 0, 0); __builtin_amdgcn_s_setprio(0); } while (0)
#define PG8_WAIT_V(n) asm volatile("s_waitcnt vmcnt(" #n ")" ::: "memory")
#define PG8_WAIT_L(n) asm volatile("s_waitcnt lgkmcnt(" #n ")" ::: "memory")
#define PG8_BAR __builtin_amdgcn_s_barrier()
#define PG8_SCHED __builtin_amdgcn_sched_barrier(0)
    Unit cur, nxt; int ui = 0;
    if (!S.next(0, cur)) return;
    f32x4 acc[2][2][4][2];
#pragma unroll
    for (int a = 0; a < 2; ++a)
#pragma unroll
        for (int b = 0; b < 2; ++b)
#pragma unroll
            for (int m = 0; m < 4; ++m)
#pragma unroll
                for (int n = 0; n < 2; ++n) acc[a][b][m][n] = (f32x4){0.f, 0.f, 0.f, 0.f};
    bf16x8 At[4][2], B0[2][2], B1[2][2];
    const char* cA = (const char*)(cur.z ? g.A2 : g.A) + (size_t)cur.pm * tstep; const char* cB = (const char*)(cur.z ? g.Bt2 : g.Bt) + (size_t)cur.pn * tstep;
    S.a_ready(cur);
    if constexpr (SP2) {
        PG8_STAGE(PG8_SB(0, 0), cB, voffB); PG8_STAGE(PG8_SB(0, 1), cB + hstep, voffB); PG8_STAGE(PG8_SA(0, 0), cA, voffA); PG8_STAGE(PG8_SA(0, 1), cA + hstep, voffA);
        if (wr == 1) PG8_BAR;
        PG8_WAIT_V(2); PG8_BAR;
        PG8_STAGE(PG8_SB(1, 0), cB + kstep, voffB); PG8_STAGE(PG8_SA(1, 0), cA + kstep, voffA); PG8_STAGE(PG8_SB(1, 1), cB + hstep + kstep, voffB);
        PG8_WAIT_V(6); PG8_BAR;
    } else {
        PG8_STAGE(PG8_SB(0, 0), cB, voffB); PG8_STAGE(PG8_SA(0, 0), cA, voffA); PG8_STAGE(PG8_SB(0, 1), cB + hstep, voffB); PG8_STAGE(PG8_SA(0, 1), cA + hstep, voffA);
        if (wr == 1) PG8_BAR;
        PG8_WAIT_V(4); PG8_BAR;
        PG8_STAGE(PG8_SB(1, 0), cB + kstep, voffB); PG8_STAGE(PG8_SA(1, 0), cA + kstep, voffA); PG8_STAGE(PG8_SB(1, 1), cB + hstep + kstep, voffB);
        PG8_WAIT_V(6); PG8_BAR;
    }
    for (;;) {
        const bool has_next = S.next(ui + 1, nxt);
        const char* nA = has_next ? (const char*)(nxt.z ? g.A2 : g.A) + (size_t)nxt.pm * tstep : cA; const char* nB = has_next ? (const char*)(nxt.z ? g.Bt2 : g.Bt) + (size_t)nxt.pn * tstep : cB;
        for (int t = 0; t < nt; t += 2) {
            const bool last = (t == nt - 2);
            const char* a1 = cA + (size_t)(t + 1) * kstep;
            const char* a2 = last ? nA : cA + (size_t)(t + 2) * kstep; const char* b2 = last ? nB : cB + (size_t)(t + 2) * kstep;
            const char* a3 = a2 + kstep; const char* b3 = b2 + kstep;
            if (last && has_next) S.a_ready(nxt);
            if constexpr (SP2) {
            PG8_LDB(B0, 0, 0); PG8_LDB(B1, 0, 1); PG8_SCHED; PG8_LDA(At, 0, 0); PG8_STAGE(PG8_SA(1, 1), a1 + hstep, voffA);
            PG8_WAIT_V(8); PG8_WAIT_L(0); PG8_BAR; PG8_MMA(0, 0, At, B0); PG8_MMA(0, 1, At, B1); PG8_BAR; PG8_SCHED;
            PG8_LDA(At, 0, 1); PG8_STAGE(PG8_SB(0, 0), b2, voffB); PG8_STAGE(PG8_SB(0, 1), b2 + hstep, voffB); PG8_STAGE(PG8_SA(0, 0), a2, voffA);
            PG8_WAIT_V(8); PG8_WAIT_L(0); PG8_BAR; PG8_MMA(1, 0, At, B0); PG8_MMA(1, 1, At, B1); PG8_BAR; PG8_SCHED;
            PG8_LDB(B0, 1, 0); PG8_LDB(B1, 1, 1); PG8_SCHED; PG8_LDA(At, 1, 0); PG8_STAGE(PG8_SA(0, 1), a2 + hstep, voffA);
            PG8_WAIT_V(8); PG8_WAIT_L(0); PG8_BAR; PG8_MMA(0, 0, At, B0); PG8_MMA(0, 1, At, B1); PG8_BAR; PG8_SCHED;
            PG8_LDA(At, 1, 1); PG8_STAGE(PG8_SB(1, 0), b3, voffB); PG8_STAGE(PG8_SB(1, 1), b3 + hstep, voffB); PG8_STAGE(PG8_SA(1, 0), a3, voffA);
            PG8_WAIT_V(8); PG8_WAIT_L(0); PG8_BAR; PG8_MMA(1, 0, At, B0); PG8_MMA(1, 1, At, B1); PG8_BAR; PG8_SCHED;
            } else {
            PG8_LDB(B0, 0, 0); PG8_SCHED; PG8_LDA(At, 0, 0); PG8_STAGE(PG8_SA(1, 1), a1 + hstep, voffA);
            PG8_WAIT_L(8); PG8_BAR; PG8_WAIT_L(0); PG8_MMA(0, 0, At, B0); PG8_BAR; PG8_SCHED;
            PG8_LDB(B1, 0, 1); PG8_STAGE(PG8_SB(0, 0), b2, voffB);
            PG8_BAR; PG8_WAIT_L(0); PG8_MMA(0, 1, At, B1); PG8_BAR;
            PG8_LDA(At, 0, 1); PG8_STAGE(PG8_SA(0, 0), a2, voffA);
            PG8_BAR; PG8_WAIT_L(0); PG8_MMA(1, 0, At, B0); PG8_BAR; PG8_SCHED;
            PG8_STAGE(PG8_SB(0, 1), b2 + hstep, voffB);
            PG8_WAIT_V(6); PG8_BAR; PG8_MMA(1, 1, At, B1); PG8_BAR;
            PG8_LDB(B0, 1, 0); PG8_SCHED; PG8_LDA(At, 1, 0); PG8_STAGE(PG8_SA(0, 1), a2 + hstep, voffA);
            PG8_WAIT_L(8); PG8_BAR; PG8_WAIT_L(0); PG8_MMA(0, 0, At, B0); PG8_BAR; PG8_SCHED;
            PG8_LDB(B1, 1, 1); PG8_STAGE(PG8_SB(1, 0), b3, voffB);
            PG8_BAR; PG8_WAIT_L(0); PG8_MMA(0, 1, At, B1); PG8_BAR;
            PG8_LDA(At, 1, 1); PG8_STAGE(PG8_SA(1, 0), a3, voffA);
            PG8_BAR; PG8_WAIT_L(0); PG8_MMA(1, 0, At, B0); PG8_BAR; PG8_SCHED;
            PG8_STAGE(PG8_SB(1, 1), b3 + hstep, voffB);
            PG8_WAIT_V(6); PG8_BAR; PG8_MMA(1, 1, At, B1); PG8_BAR;
            }
        }
        if constexpr (ALIGN_EPI) { if (wr == 0) PG8_BAR; }
        { const int t2 = opaque_tid(wid_s), w2 = __builtin_amdgcn_readfirstlane(t2 >> 6); E(acc, cur, w2 >> 2, w2 & 3, t2 & 15, (t2 & 63) >> 4); }
        if (!has_next) break;
#pragma unroll
        for (int a = 0; a < 2; ++a)
#pragma unroll
            for (int b = 0; b < 2; ++b)
#pragma unroll
                for (int m = 0; m < 4; ++m)
#pragma unroll
                    for (int n = 0; n < 2; ++n) acc[a][b][m][n] = (f32x4){0.f, 0.f, 0.f, 0.f};
        cur = nxt; cA = nA; cB = nB; ++ui;
        if constexpr (ALIGN_EPI) { if (wr == 1) PG8_BAR; }
    }
    PG8_WAIT_V(0);
    if constexpr (!ALIGN_EPI) { if (wr == 0) PG8_BAR; }
    PG8_BAR;
#undef PG8_SA
#undef PG8_SB
#undef PG8_STAGE
#undef PG8_LDA
#undef PG8_LDB
#undef PG8_MMA
#undef PG8_WAIT_V
#undef PG8_WAIT_L
#undef PG8_BAR
#undef PG8_SCHED
}
}

typedef f32x4 AccT[2][2][4][2];

#define GAS __attribute__((address_space(1)))
__device__ __forceinline__ void store8_bf16(bf16_t* p, const float (&v)[8]) {
    u32x4 w; w.x = cvt_pk_bf16(v[0], v[1]); w.y = cvt_pk_bf16(v[2], v[3]); w.z = cvt_pk_bf16(v[4], v[5]); w.w = cvt_pk_bf16(v[6], v[7]);
    *(GAS u32x4*)p = w;
}
__device__ __forceinline__ void cvt8_bf16(const u32x4 w, float (&v)[8]) {
    v[0] = bflo(w.x); v[1] = bfhi(w.x); v[2] = bflo(w.y); v[3] = bfhi(w.y); v[4] = bflo(w.z); v[5] = bfhi(w.z); v[6] = bflo(w.w); v[7] = bfhi(w.w);
}
__device__ __forceinline__ u32x4 ldg16(const void* p) { return *(const GAS u32x4*)p; }
__device__ __forceinline__ f32x4 ldgf4(const float* p) { return *(const GAS f32x4*)p; }
__device__ __forceinline__ float ldgf(const float* p) { return *(const GAS float*)p; }
__device__ __forceinline__ void load8_bf16(const bf16_t* p, float (&v)[8]) { cvt8_bf16(ldg16(p), v); }
__device__ __forceinline__ void store8_f32(float* p, const float (&v)[8]) {
    *(GAS f32x4*)p = (f32x4){v[0], v[1], v[2], v[3]}; *(GAS f32x4*)(p + 4) = (f32x4){v[4], v[5], v[6], v[7]};
}
__device__ __forceinline__ void load8_f32(const float* p, float (&v)[8]) {
    const f32x4 a = ldgf4(p), b = ldgf4(p + 4);
    v[0] = a[0]; v[1] = a[1]; v[2] = a[2]; v[3] = a[3]; v[4] = b[0]; v[5] = b[1]; v[6] = b[2]; v[7] = b[3];
}
__device__ __forceinline__ void acc8(const AccT& acc, int ai, int bj, int m, float (&v)[8]) {
    const f32x4 a = acc[ai][bj][m][0], b = acc[ai][bj][m][1];
    v[0] = a[0]; v[1] = a[1]; v[2] = a[2]; v[3] = a[3]; v[4] = b[0]; v[5] = b[1]; v[6] = b[2]; v[7] = b[3];
}
#define EPI_FENCE() asm volatile("" ::: "memory")
__device__ __forceinline__ void load_rs8(const float* ssq, int row0, float (&rs)[8]) {
#pragma unroll
    for (int i = 0; i < 8; ++i) rs[i] = ldgf(ssq + row0 + (i >> 2) * 128 + (i & 3) * 16);
#pragma unroll
    for (int i = 0; i < 8; ++i) rs[i] = rsqrtf(rs[i] * (1.0f / DM) + EPS);
}

template <int ACT> __device__ __forceinline__ void epi_plain(const AccT& acc, const float (&rs)[8], bf16_t* dst, int ld, int row0, int c0) {
#pragma unroll
    for (int ai = 0; ai < 2; ++ai)
#pragma unroll
        for (int m = 0; m < 4; ++m) {
            const int row = row0 + ai * 128 + m * 16; const float r = rs[ai * 4 + m];
#pragma unroll
            for (int bj = 0; bj < 2; ++bj) { float v[8]; acc8(acc, ai, bj, m, v);
#pragma unroll
                for (int e = 0; e < 8; ++e) { float z = v[e] * r; if (ACT == 1) z = silu_f(z); if (ACT == 2) z = sigmoid_f(z); v[e] = z; }
                store8_bf16(dst + (size_t)row * ld + c0 + bj * 128, v); }
        }
}
struct EpiInProj {
    static constexpr bool PERM = true;
    const float* ssq; const float* lower; unsigned char* ws;
    __device__ __forceinline__ void operator()(const AccT& acc, const pg8::Unit& u, int wr, int wc, int fr, int fq) const {
        const int colt = u.pn * 256, seg = colt >> 10;
        const int row0 = u.pm * 256 + wr * 64 + fr;
        const int cin = wc * 32 + 8 * fq;
        const int cseg = (colt & 1023) + cin;
        float rs[8]; load_rs8(ssq, row0, rs);
        if (seg == 2 || seg == 3) {
            const int dir = seg - 2;
            unsigned short* G = (unsigned short*)(ws + (dir ? WS_GB : WS_GF)); bf16_t* KK = (bf16_t*)(ws + (dir ? WS_KB : WS_KF));
#pragma unroll
            for (int bj = 0; bj < 2; ++bj) {
                const int c = cseg + bj * 128; float lb[8]; load8_f32(lower + dir * 1024 + c, lb);
#pragma unroll
                for (int ai = 0; ai < 2; ++ai)
#pragma unroll
                    for (int m = 0; m < 4; ++m) {
                        const int row = row0 + ai * 128 + m * 16; const float r = rs[ai * 4 + m];
                        float v[8], lg[8], kk[8]; acc8(acc, ai, bj, m, v);
#pragma unroll
                        for (int e = 0; e < 8; ++e) { const float z = v[e] * r; const float sg = sigmoid_f(z); const float f = lb[e] + (1.f - lb[e]) * sg;
                            lg[e] = __logf(fmaxf(f, 1e-6f)); kk[e] = (1.f - lb[e]) * fast_rcp(1.f + __expf(z)); }
                        { u32x4 wg; wg.x = cvt_pk_f16(lg[0], lg[1]); wg.y = cvt_pk_f16(lg[2], lg[3]); wg.z = cvt_pk_f16(lg[4], lg[5]); wg.w = cvt_pk_f16(lg[6], lg[7]); *(GAS u32x4*)(G + (size_t)row * HW + c) = wg; }
                        store8_bf16(KK + (size_t)row * HW + c, kk);
                    }
            }
        } else if (seg == 7) {
            bf16_t* VT = (bf16_t*)(ws + WS_VT);
#pragma unroll
            for (int ai = 0; ai < 2; ++ai)
#pragma unroll
                for (int m = 0; m < 4; ++m) {
                    const int row = row0 + ai * 128 + m * 16; const float r = rs[ai * 4 + m];
#pragma unroll
                    for (int bj = 0; bj < 2; ++bj) { float v[8]; acc8(acc, ai, bj, m, v); const int c = cseg + bj * 128;
#pragma unroll
                        for (int e = 0; e < 8; ++e) *(GAS bf16_t*)(VT + (size_t)(c + e) * SEQ + row) = f2bf1(v[e] * r); }
                }
        } else if (seg == 0) epi_plain<1>(acc, rs, (bf16_t*)(ws + WS_QH), HW, row0, cseg);
        else if (seg == 1) epi_plain<0>(acc, rs, (bf16_t*)(ws + WS_VH), HW, row0, cseg);
        else if (seg == 4) epi_plain<1>(acc, rs, (bf16_t*)(ws + WS_HG), HW, row0, cseg);
        else if (seg == 5) epi_plain<0>(acc, rs, (bf16_t*)(ws + WS_NQ), HW, row0, cseg);
        else if (seg == 6) epi_plain<0>(acc, rs, (bf16_t*)(ws + WS_NK), HW, row0, cseg);
        else if (seg == 8) epi_plain<1>(acc, rs, (bf16_t*)(ws + WS_NG), HW, row0, cseg);
        else if (seg < 11) epi_plain<2>(acc, rs, (bf16_t*)(ws + WS_MA), DM, row0, colt - 9216 + cin);
        else epi_plain<2>(acc, rs, (bf16_t*)(ws + WS_MB), DM, row0, colt - 11264 + cin);
    }
};

#define EPI_IT(it, ai, m, bj) const int ai = (it) >> 3, m = ((it) >> 1) & 3, bj = (it) & 1
struct EpiBranch {
    static constexpr bool PERM = true;
    const bf16_t* MA; const bf16_t* MB; bf16_t* T; bf16_t* Y;
    __device__ __forceinline__ void operator()(const AccT& acc, const pg8::Unit& u, int wr, int wc, int fr, int fq) const {
        const int row0 = u.pm * 256 + wr * 64 + fr, c0 = u.pn * 256 + wc * 32 + 8 * fq;
        if (u.z == 0) {
            u32x4 g[2];
            g[0] = ldg16(MA + (size_t)row0 * DM + c0);
#pragma unroll
            for (int it = 0; it < 16; ++it) { EPI_IT(it, ai, m, bj);
                const size_t off = (size_t)(row0 + ai * 128 + m * 16) * DM + c0 + bj * 128;
                if (it + 1 < 16) { EPI_IT(it + 1, ai2, m2, bj2); g[(it + 1) & 1] = ldg16(MA + (size_t)(row0 + ai2 * 128 + m2 * 16) * DM + c0 + bj2 * 128); }
                float v[8], gg[8]; acc8(acc, ai, bj, m, v); cvt8_bf16(g[it & 1], gg);
#pragma unroll
                for (int e = 0; e < 8; ++e) v[e] *= gg[e];
                store8_bf16(T + off, v); EPI_FENCE(); }
        } else {
            u32x4 g[2], t[2];
            { const size_t o = (size_t)row0 * DM + c0; g[0] = ldg16(MB + o); t[0] = ldg16(T + o); }
#pragma unroll
            for (int it = 0; it < 16; ++it) { EPI_IT(it, ai, m, bj);
                const size_t off = (size_t)(row0 + ai * 128 + m * 16) * DM + c0 + bj * 128;
                if (it + 1 < 16) { EPI_IT(it + 1, ai2, m2, bj2); const size_t o = (size_t)(row0 + ai2 * 128 + m2 * 16) * DM + c0 + bj2 * 128; const int b = (it + 1) & 1;
                    g[b] = ldg16(MB + o); t[b] = ldg16(T + o); }
                float v[8], gg[8], tt[8]; acc8(acc, ai, bj, m, v); cvt8_bf16(g[it & 1], gg); cvt8_bf16(t[it & 1], tt);
#pragma unroll
                for (int e = 0; e < 8; ++e) v[e] = tt[e] + v[e] * gg[e];
                store8_bf16(Y + off, v); EPI_FENCE(); }
        }
    }
};
struct EpiWout {
    static constexpr bool PERM = true;
    const bf16_t* xin; bf16_t* XB1; float* ssq_out;
    __device__ __forceinline__ void operator()(const AccT& acc, const pg8::Unit& u, int wr, int wc, int fr, int fq) const {
        const int row0 = u.pm * 256 + wr * 64 + fr, c0 = u.pn * 256 + wc * 32 + 8 * fq;
        u32x4 xb[2];
        xb[0] = ldg16(xin + (size_t)row0 * DM + c0);
        float s = 0.f;
#pragma unroll
        for (int it = 0; it < 16; ++it) { EPI_IT(it, ai, m, bj);
            const int row = row0 + ai * 128 + m * 16; const size_t off = (size_t)row * DM + c0 + bj * 128;
            if (it + 1 < 16) { EPI_IT(it + 1, ai2, m2, bj2); xb[(it + 1) & 1] = ldg16(xin + (size_t)(row0 + ai2 * 128 + m2 * 16) * DM + c0 + bj2 * 128); }
            float v[8], xi[8]; acc8(acc, ai, bj, m, v); cvt8_bf16(xb[it & 1], xi);
#pragma unroll
            for (int e = 0; e < 8; ++e) { v[e] += xi[e]; s += v[e] * v[e]; }
            store8_bf16(XB1 + off, v);
            if (bj == 1) { s += __shfl_xor(s, 16); s += __shfl_xor(s, 32); if (fq == 0) atomicAdd(ssq_out + row, s); s = 0.f; }
            EPI_FENCE(); }
    }
};
struct EpiDummy {
    static constexpr bool PERM = true;
    bf16_t* D;
    __device__ __forceinline__ void operator()(const AccT& acc, const pg8::Unit& u, int wr, int wc, int fr, int fq) const {
#if MK_REP_DUMMY == 2
#pragma unroll
        for (int ai = 0; ai < 2; ++ai)
#pragma unroll
            for (int bj = 0; bj < 2; ++bj)
#pragma unroll
                for (int m = 0; m < 4; ++m) { asm volatile("" :: "v"(acc[ai][bj][m][0]), "v"(acc[ai][bj][m][1])); }
#else
        const int row0 = u.pm * 256 + wr * 64 + fr, c0 = (u.pn & 3) * 256 + wc * 32 + 8 * fq;
#pragma unroll
        for (int ai = 0; ai < 2; ++ai)
#pragma unroll
            for (int m = 0; m < 4; ++m) { const int row = row0 + ai * 128 + m * 16;
#pragma unroll
                for (int bj = 0; bj < 2; ++bj) { float v[8]; acc8(acc, ai, bj, m, v); store8_bf16(D + (size_t)row * HW + c0 + bj * 128, v); } }
#endif
    }
};
struct EpiPL {
    static constexpr bool PERM = true;
    bf16_t* PL;
    __device__ __forceinline__ void operator()(const AccT& acc, const pg8::Unit& u, int wr, int wc, int fr, int fq) const {
        const int row0 = u.pm * 256 + wr * 64 + fr, c0 = u.pn * 256 + wc * 32 + 8 * fq;
#pragma unroll
        for (int ai = 0; ai < 2; ++ai)
#pragma unroll
            for (int m = 0; m < 4; ++m) { const int row = row0 + ai * 128 + m * 16;
#pragma unroll
                for (int bj = 0; bj < 2; ++bj) { float v[8]; acc8(acc, ai, bj, m, v); store8_bf16(PL + (size_t)row * DM + c0 + bj * 128, v); } }
    }
};
struct EpiGate {
    static constexpr bool PERM = true;
    const float* ssq1; const bf16_t* XB1; const bf16_t* PL; float* xout; bf16_t* XBN; float* ssq_next; int has_next;
    __device__ __forceinline__ void operator()(const AccT& acc, const pg8::Unit& u, int wr, int wc, int fr, int fq) const {
        const int row0 = u.pm * 256 + wr * 64 + fr, c0 = u.pn * 256 + wc * 32 + 8 * fq;
        u32x4 xb[2], pb[2]; float sq[2];
        { const size_t o = (size_t)row0 * DM + c0; xb[0] = ldg16(XB1 + o); pb[0] = ldg16(PL + o); sq[0] = ldgf(ssq1 + row0); }
        float s = 0.f;
#pragma unroll
        for (int it = 0; it < 16; ++it) { EPI_IT(it, ai, m, bj);
            const int row = row0 + ai * 128 + m * 16; const size_t off = (size_t)row * DM + c0 + bj * 128;
            if (it + 1 < 16) { EPI_IT(it + 1, ai2, m2, bj2); const int rown = row0 + ai2 * 128 + m2 * 16; const size_t o = (size_t)rown * DM + c0 + bj2 * 128; const int b = (it + 1) & 1;
                xb[b] = ldg16(XB1 + o); pb[b] = ldg16(PL + o); sq[b] = ldgf(ssq1 + rown); }
            const float r = rsqrtf(sq[it & 1] * (1.0f / DM) + EPS);
            float v[8], x1[8], pl[8]; acc8(acc, ai, bj, m, v); cvt8_bf16(xb[it & 1], x1); cvt8_bf16(pb[it & 1], pl);
#pragma unroll
            for (int e = 0; e < 8; ++e) { const float g = sigmoid_f(v[e] * r); v[e] = x1[e] + pl[e] * g; s += v[e] * v[e]; }
            if (has_next) { store8_bf16(XBN + off, v);
                if (bj == 1) { s += __shfl_xor(s, 16); s += __shfl_xor(s, 32); if (fq == 0) atomicAdd(ssq_next + row, s); s = 0.f; } }
            else store8_f32(xout + off, v);
            EPI_FENCE(); }
    }
};

#define XB_TMO      128
#define XB_XCNT(j)  (256  + 64 * (j))
#define XB_XSUB(j)  (1280 + 64 * (j))
#define XB_XGEN(j)  (2304 + 64 * (j))
#define XB_TOP      3328
#define XB_TOPGEN   3392
#define XCD_BAR_WORDS 3456
#define XB_SPIN_CAP (1u << 18)
__device__ __forceinline__ unsigned xb_ld(unsigned* p)              { return __hip_atomic_load(p, __ATOMIC_RELAXED, __HIP_MEMORY_SCOPE_AGENT); }
__device__ __forceinline__ unsigned xb_add(unsigned* p, unsigned v) { return __hip_atomic_fetch_add(p, v, __ATOMIC_RELAXED, __HIP_MEMORY_SCOPE_AGENT); }
__device__ __forceinline__ unsigned xb_xcc_id() { return (unsigned)__builtin_amdgcn_s_getreg((3 << 11) | 20) & 0xFu; }
#define XB_SPIN(cond, bar) do { unsigned _sp = 0; while (cond) { __builtin_amdgcn_s_sleep(1); \
    if ((++_sp & 255u) == 0u) { if (xb_ld(&(bar)[XB_TMO])) break; if (_sp > XB_SPIN_CAP) { atomicAdd(&(bar)[XB_TMO], 1u); break; } } } } while (0)
struct XcdBarrier { unsigned* bar; unsigned x; volatile LAS unsigned* st; };
__device__ __forceinline__ XcdBarrier xcd_barrier_post(unsigned* bar, volatile LAS unsigned* st) {
    XcdBarrier b; b.bar = bar; b.x = xb_xcc_id(); b.st = st;
    if (threadIdx.x == 0) (void)xb_add(&bar[XB_XCNT(b.x)], 1u);
    return b;
}
__device__ __forceinline__ void xcd_barrier_complete(unsigned* bar, unsigned x, unsigned& nloc, unsigned& nx) {
    const unsigned G = gridDim.x * gridDim.y * gridDim.z;
    unsigned sum, cnt, mine, sp = 0u;
    for (;;) {
        sum = 0u; cnt = 0u; mine = 0u;
#pragma unroll
        for (unsigned j = 0; j < 16; ++j) { const unsigned c = xb_ld(&bar[XB_XCNT(j)]); sum += c; cnt += (c > 0u) ? 1u : 0u; mine = (j == x) ? c : mine; }
        if (sum == G) break;
        __builtin_amdgcn_s_sleep(1);
        if ((++sp & 255u) == 0u) { if (xb_ld(&bar[XB_TMO])) break; if (sp > XB_SPIN_CAP) { atomicAdd(&bar[XB_TMO], 1u); break; } }
    }
    nloc = mine > 0u ? mine : 1u; nx = cnt > 0u ? cnt : 1u;
}
__device__ __forceinline__ void xcd_barrier(const XcdBarrier& b) {
    asm volatile("s_waitcnt vmcnt(0)" ::: "memory");
    __syncthreads();
    if (threadIdx.x == 0) {
        unsigned* bar = b.bar;
        __builtin_amdgcn_s_waitcnt(0);
        unsigned nloc = b.st[0], nx = b.st[1];
        if (nloc == 0u) { xcd_barrier_complete(bar, b.x, nloc, nx); b.st[0] = nloc; b.st[1] = nx; }
        const unsigned old = xb_add(&bar[XB_XSUB(b.x)], 1u);
        const unsigned gen = old / nloc;
        if (old + 1u == (gen + 1u) * nloc) {
            __builtin_amdgcn_fence(__ATOMIC_RELEASE, "agent");
            asm volatile("s_waitcnt vmcnt(0)" ::: "memory");
            const unsigned og = xb_add(&bar[XB_TOP], 1u);
            const unsigned tg = og / nx;
            if (og + 1u == (tg + 1u) * nx) xb_add(&bar[XB_TOPGEN], 1u);
            else XB_SPIN(xb_ld(&bar[XB_TOPGEN]) == tg, bar);
            __builtin_amdgcn_fence(__ATOMIC_ACQUIRE, "agent");
            xb_add(&bar[XB_XGEN(b.x)], 1u);
            asm volatile("s_waitcnt vmcnt(0)" ::: "memory");
        } else {
            XB_SPIN(xb_ld(&bar[XB_XGEN(b.x)]) == gen, bar);
            __builtin_amdgcn_fence(__ATOMIC_ACQUIRE, "agent");
            asm volatile("s_waitcnt vmcnt(0)" ::: "memory");
        }
    }
    __syncthreads();
}

struct Args { const float* in[15]; float* out; unsigned char* ws; int ph_lo, ph_hi; };

__device__ __forceinline__ void transpose_convert(const float* __restrict__ W, bf16_t* __restrict__ WT, int K, int N, LAS float* tile, int rot, const float* kscale) {
    const int tid = threadIdx.x, nb = gridDim.x; const int bid = (int)((blockIdx.x + (unsigned)rot) % (unsigned)nb);
    const int nkt = K / 64, ntile = nkt * (N / 64);
    const int k0 = tid >> 4, c4 = tid & 15;
    f32x4 v0, v1;
#define TC_LOAD(t_) do { const int tk_ = (t_) % nkt, tn_ = (t_) / nkt; const float* s_ = W + (size_t)(tk_ * 64 + k0) * N + tn_ * 64 + c4 * 4; \
        v0 = ldgf4(s_); v1 = ldgf4(s_ + (size_t)32 * N); if (kscale) { v0 = v0 * ldgf(kscale + tk_ * 64 + k0); v1 = v1 * ldgf(kscale + tk_ * 64 + k0 + 32); } } while (0)
    int t = bid, par = 0;
    if (t < ntile) TC_LOAD(t);
    for (; t < ntile; t += nb, par ^= 1) {
        LAS float* tl = tile + par * (64 * 65);
        { LAS float* d = tl + k0 * 65 + c4 * 4; d[0] = v0[0]; d[1] = v0[1]; d[2] = v0[2]; d[3] = v0[3]; d += 32 * 65; d[0] = v1[0]; d[1] = v1[1]; d[2] = v1[2]; d[3] = v1[3]; }
        const int tk = t % nkt, tn = t / nkt;
        if (t + nb < ntile) TC_LOAD(t + nb);
        __syncthreads();
        { const int n = tid >> 3, kq = tid & 7; float v[8];
#pragma unroll
          for (int j = 0; j < 8; ++j) v[j] = tl[(kq * 8 + j) * 65 + n];
          store8_bf16(WT + (size_t)(tn * 64 + n) * K + tk * 64 + kq * 8, v); }
    }
    __syncthreads();
#undef TC_LOAD
}

__device__ __forceinline__ void p0_prologue(const Args& a, LAS unsigned char* lds) {
    unsigned char* ws = a.ws;
    const int tid = threadIdx.x, bid = blockIdx.x, nb = gridDim.x, gtid = bid * 512 + tid, gsz = nb * 512;
    {
        float* LOWER = (float*)(ws + WS_LOWER); const float* lbp = a.in[4];
        for (int i = gtid; i < 2048; i += gsz) { const float a0 = lbp[i], a1 = lbp[2048 + i]; LOWER[i] = 0.f; LOWER[2048 + i] = 1.f / (1.f + expf(a0 - a1)); }
        float* SSQ = (float*)(ws + WS_SSQ);
        for (int i = gtid; i < 3 * SEQ; i += gsz) SSQ[SEQ + i] = 0.f;
    }
    {
        const float* x = a.in[0]; bf16_t* XG = (bf16_t*)(ws + WS_XGA); float* SSQ = (float*)(ws + WS_SSQ);
        const int lane = tid & 63, gw = gtid >> 6, nw = gsz >> 6;
        for (int row = gw; row < SEQ; row += nw) {
            const f32x4* xr = (const f32x4*)(x + (size_t)row * DM); float s = 0.f;
#pragma unroll
            for (int j = 0; j < 8; ++j) { const f32x4 v = xr[j * 64 + lane];
                s += v[0] * v[0] + v[1] * v[1] + v[2] * v[2] + v[3] * v[3];
                u32x2 w; w.x = cvt_pk_bf16(v[0], v[1]); w.y = cvt_pk_bf16(v[2], v[3]);
                *(u32x2*)(XG + (size_t)row * DM + (j * 64 + lane) * 4) = w; }
#pragma unroll
            for (int o = 32; o >= 1; o >>= 1) s += __shfl_xor(s, o);
            if (lane == 0) SSQ[row] = s;
        }
    }
    {
        const f32x4* p = (const f32x4*)a.in[1]; bf16_t* PB = (bf16_t*)(ws + WS_PB);
        for (int i = gtid; i < 2 * SEQ * PLE / 4; i += gsz) { const f32x4 v = p[i]; u32x2 w; w.x = cvt_pk_bf16(v[0], v[1]); w.y = cvt_pk_bf16(v[2], v[3]); *(u32x2*)(PB + (size_t)i * 4) = w; }
    }
    LAS float* tile = (LAS float*)lds;
    for (int l = 0; l < 2; ++l) {
        transpose_convert(a.in[3] + (size_t)l * DM * NIN, (bf16_t*)(ws + WS_WIN) + (size_t)l * NIN * DM, DM, NIN, tile, 0, a.in[2] + l * DM);
        transpose_convert(a.in[9] + (size_t)l * HW * DM, (bf16_t*)(ws + WS_WA) + (size_t)l * DM * HW, HW, DM, tile, 0, nullptr);
        transpose_convert(a.in[10] + (size_t)l * HW * DM, (bf16_t*)(ws + WS_WB) + (size_t)l * DM * HW, HW, DM, tile, 0, nullptr);
        transpose_convert(a.in[11] + (size_t)l * DM * DM, (bf16_t*)(ws + WS_WO) + (size_t)l * DM * DM, DM, DM, tile, 0, nullptr);
        transpose_convert(a.in[13] + (size_t)l * DM * DM, (bf16_t*)(ws + WS_WG) + (size_t)l * DM * DM, DM, DM, tile, 0, a.in[12] + l * DM);
        transpose_convert(a.in[14] + (size_t)l * PLE * DM, (bf16_t*)(ws + WS_WP) + (size_t)l * DM * PLE, PLE, DM, tile, 128, nullptr);
    }
}

constexpr int HP_ROWB = 272;
constexpr int HT_ROWB = 144;

__device__ __forceinline__ void hg_cumsum(const float (&gv)[16], int seg, int kc, int dir, LAS float* SEGS, float (&b)[16], float& bref, float& blast) {
    float c = 0.f;
#pragma unroll
    for (int i = 0; i < 16; ++i) { c += gv[i]; b[i] = c; }
    const float tot = c;
    if (dir) {
#pragma unroll
        for (int i = 0; i < 16; ++i) b[i] = tot - b[i] + gv[i];
    }
    SEGS[seg * 128 + kc] = tot;
    __syncthreads();
    const float t0 = SEGS[kc], t1 = SEGS[128 + kc], t2 = SEGS[256 + kc], t3 = SEGS[384 + kc];
    float off;
    if (!dir) { off = (seg > 0 ? t0 : 0.f) + (seg > 1 ? t1 : 0.f) + (seg > 2 ? t2 : 0.f); bref = t0 + t1; }
    else      { off = (seg < 3 ? t3 : 0.f) + (seg < 2 ? t2 : 0.f) + (seg < 1 ? t1 : 0.f); bref = t2 + t3; }
    blast = (t0 + t1) + (t2 + t3);
#pragma unroll
    for (int i = 0; i < 16; ++i) b[i] += off;
}
__device__ __forceinline__ unsigned short ldg_u16(const bf16_t* p) { return *(const GAS bf16_t*)p; }

__device__ __forceinline__ void h1_phase(const Args& a, LAS unsigned char* lds, int wid_s) {
    unsigned char* ws = opaque_ptr(a.ws);
    const int tid = opaque_tid(wid_s), lane = tid & 63, w = __builtin_amdgcn_readfirstlane(tid >> 6), fr = lane & 15, fq = lane >> 4;
    const int kc = tid & 127, seg = tid >> 7;
    LAS float* SEGS = (LAS float*)lds; LAS float* SC = (LAS float*)(lds + 2048);
    LAS unsigned char* KpT = lds + 4096; LAS unsigned char* Vt = lds + 4096 + 128 * HT_ROWB;
    const bf16_t* VH = (const bf16_t*)(ws + WS_VH);
    bf16_t* LT = (bf16_t*)(ws + WS_LT); float* DD = (float*)(ws + WS_DD); float* EE = (float*)(ws + WS_EE);
    unsigned short gr_[16], kr_[16], vr_[16];
#define H1_FETCH(item_) do { const int d_ = (item_) >> 10, h_ = ((item_) >> 7) & 7, cs_ = (item_) & 127, n_ = d_ ? 127 - cs_ : cs_; \
        const size_t o_ = (size_t)(64 * n_ + 16 * seg) * HW + h_ * 128 + kc; const bf16_t* G_ = (const bf16_t*)(ws + (d_ ? WS_GB : WS_GF)) + o_; const bf16_t* K_ = (const bf16_t*)(ws + (d_ ? WS_KB : WS_KF)) + o_; \
        _Pragma("unroll") for (int i = 0; i < 16; ++i) { gr_[i] = ldg_u16(G_ + (size_t)i * HW); kr_[i] = ldg_u16(K_ + (size_t)i * HW); vr_[i] = ldg_u16(VH + o_ + (size_t)i * HW); } } while (0)
    int item = blockIdx.x;
    if (item < 2048) H1_FETCH(item);
    for (; item < 2048; item += gridDim.x) {
        const int d = item >> 10;
        float b[16], bref, blast, gv[16];
#pragma unroll
        for (int i = 0; i < 16; ++i) gv[i] = f16_to_f32(gr_[i]);
        hg_cumsum(gv, seg, kc, d, SEGS, b, bref, blast);
        {
            unsigned kw[8], vw[8];
#pragma unroll
            for (int i = 0; i < 16; i += 2) {
                const float k0 = bf2f(kr_[i]) * __expf(fminf(bref - b[i], 80.f)), k1 = bf2f(kr_[i + 1]) * __expf(fminf(bref - b[i + 1], 80.f));
                kw[i >> 1] = cvt_pk_bf16(k0, k1);
                vw[i >> 1] = (unsigned)vr_[i] | ((unsigned)vr_[i + 1] << 16);
            }
            LAS u32x4* kd = (LAS u32x4*)(KpT + kc * HT_ROWB + seg * 32); kd[0] = (u32x4){kw[0], kw[1], kw[2], kw[3]}; kd[1] = (u32x4){kw[4], kw[5], kw[6], kw[7]};
            LAS u32x4* vd = (LAS u32x4*)(Vt + kc * HT_ROWB + seg * 32); vd[0] = (u32x4){vw[0], vw[1], vw[2], vw[3]}; vd[1] = (u32x4){vw[4], vw[5], vw[6], vw[7]};
            if (seg == 0) { SC[kc] = __expf(blast - bref); *(GAS float*)(DD + (size_t)item * 128 + kc) = __expf(blast); *(GAS float*)(EE + (size_t)item * 128 + kc) = __expf(bref); }
        }
        if (item + (int)gridDim.x < 2048) H1_FETCH(item + (int)gridDim.x);
        __syncthreads();
        {
            const int vt = w;
            bf16x8 bv[2];
#pragma unroll
            for (int ks = 0; ks < 2; ++ks) bv[ks] = *(const LAS bf16x8*)(Vt + (16 * vt + fr) * HT_ROWB + (32 * ks + 8 * fq) * 2);
            bf16_t* dst = LT + (size_t)item * 16384 + (size_t)(16 * vt + fr) * 128 + 4 * fq;
#pragma unroll
            for (int kt = 0; kt < 8; ++kt) {
                f32x4 acc = (f32x4){0.f, 0.f, 0.f, 0.f};
#pragma unroll
                for (int ks = 0; ks < 2; ++ks) { const bf16x8 af = *(const LAS bf16x8*)(KpT + (16 * kt + fr) * HT_ROWB + (32 * ks + 8 * fq) * 2);
                    acc = __builtin_amdgcn_mfma_f32_16x16x32_bf16(af, bv[ks], acc, 0, 0, 0); }
                const f32x4 sc = *(const LAS f32x4*)(SC + 16 * kt + 4 * fq);
                u32x2 ow; ow.x = cvt_pk_bf16(acc[0] * sc[0], acc[1] * sc[1]); ow.y = cvt_pk_bf16(acc[2] * sc[2], acc[3] * sc[3]);
                *(GAS u32x2*)(dst + 16 * kt) = ow;
            }
        }
        __syncthreads();
    }
#undef H1_FETCH
}

__device__ __forceinline__ void h2_phase(const Args& a, int wid_s) {
    unsigned char* ws = opaque_ptr(a.ws);
    const int tid = opaque_tid(wid_s);
    const bf16_t* LT = (const bf16_t*)(ws + WS_LT); const float* DD = (const float*)(ws + WS_DD); const float* EE = (const float*)(ws + WS_EE);
    bf16_t* SP = (bf16_t*)(ws + WS_SP);
    for (int u = blockIdx.x; u < 256; u += gridDim.x) {
        const int chain = u >> 4, sub = u & 15;
        const int v = 8 * sub + (tid >> 6), k = 2 * (tid & 63);
        const size_t ibase = (size_t)chain * 128;
        float s0 = 0.f, s1 = 0.f;
        for (int cs0 = 0; cs0 < 128; cs0 += 16) {
            unsigned lt[16]; f32x2 dd[16], ee[16];
#pragma unroll
            for (int j = 0; j < 16; ++j) { const size_t it = ibase + cs0 + j;
                lt[j] = *(const GAS unsigned*)(LT + it * 16384 + v * 128 + k); dd[j] = *(const GAS f32x2*)(DD + it * 128 + k); ee[j] = *(const GAS f32x2*)(EE + it * 128 + k); }
#pragma unroll
            for (int j = 0; j < 16; ++j) { const size_t it = ibase + cs0 + j;
                *(GAS unsigned*)(SP + it * 16384 + v * 128 + k) = cvt_pk_bf16(s0 * ee[j][0], s1 * ee[j][1]);
                s0 = dd[j][0] * s0 + bflo(lt[j]); s1 = dd[j][1] * s1 + bfhi(lt[j]); }
        }
    }
}

__device__ __forceinline__ void h3_phase(const Args& a, int layer, LAS unsigned char* lds, int wid_s) {
    unsigned char* ws = opaque_ptr(a.ws);
    const int tid = opaque_tid(wid_s), lane = tid & 63, w = __builtin_amdgcn_readfirstlane(tid >> 6), fr = lane & 15, fq = lane >> 4;
    const int kc = tid & 127, seg = tid >> 7;
    LAS float* SEGS = (LAS float*)lds; LAS float* SSQP = (LAS float*)(lds + 2048);
    LAS unsigned char* Qp = lds + 4096; LAS unsigned char* Kp = Qp + 64 * HP_ROWB; LAS unsigned char* Vt = Kp + 64 * HP_ROWB; LAS unsigned char* Ab = Vt + 128 * HT_ROWB; LAS unsigned char* SPs = Ab + 64 * HT_ROWB;
    const bf16_t* QH = (const bf16_t*)(ws + WS_QH); const bf16_t* VH = (const bf16_t*)(ws + WS_VH); const bf16_t* HG = (const bf16_t*)(ws + WS_HG);
    const bf16_t* SP = (const bf16_t*)(ws + WS_SP); bf16_t* OA = (bf16_t*)(ws + WS_OA);
    const float* onorm = a.in[5] + layer * 128;
    unsigned short gr_[16], qr_[16], kr_[16], vr_[16]; u32x4 spr[4];
#define H3_FETCH(item_, d_) do { const int n_ = (item_) >> 3, h_ = (item_) & 7, cs_ = (d_) ? 127 - n_ : n_; \
        const size_t o_ = (size_t)(64 * n_ + 16 * seg) * HW + h_ * 128 + kc; const bf16_t* G_ = (const bf16_t*)(ws + ((d_) ? WS_GB : WS_GF)) + o_; const bf16_t* K_ = (const bf16_t*)(ws + ((d_) ? WS_KB : WS_KF)) + o_; \
        const bf16_t* S_ = SP + (size_t)(((d_) * 8 + h_) * 128 + cs_) * 16384; \
        _Pragma("unroll") for (int i = 0; i < 16; ++i) { gr_[i] = ldg_u16(G_ + (size_t)i * HW); qr_[i] = ldg_u16(QH + o_ + (size_t)i * HW); kr_[i] = ldg_u16(K_ + (size_t)i * HW); vr_[i] = ldg_u16(VH + o_ + (size_t)i * HW); } \
        _Pragma("unroll") for (int i = 0; i < 4; ++i) { const int q_ = tid + 512 * i; spr[i] = ldg16(S_ + (q_ >> 4) * 128 + (q_ & 15) * 8); } } while (0)
    int item = blockIdx.x;
    if (item < 1024) H3_FETCH(item, 0);
    for (; item < 1024; item += gridDim.x) {
        const int n = item >> 3, h = item & 7;
        const int tok0 = 64 * n;
        const int rt = w & 3, vg = w >> 2;
        f32x4 o[4];
#pragma unroll
        for (int j = 0; j < 4; ++j) o[j] = (f32x4){0.f, 0.f, 0.f, 0.f};
        u32x2 hgr[4];
        for (int d = 0; d < 2; ++d) {
            float b[16], bref, blast, gv[16];
#pragma unroll
            for (int i = 0; i < 16; ++i) gv[i] = f16_to_f32(gr_[i]);
            hg_cumsum(gv, seg, kc, d, SEGS, b, bref, blast);
            {
                unsigned vw[8];
#pragma unroll
                for (int i = 0; i < 16; i += 2) {
                    const float e0 = b[i] - bref, e1 = b[i + 1] - bref;
                    const float q0 = bf2f(qr_[i]) * __expf(fminf(e0, 80.f)), q1 = bf2f(qr_[i + 1]) * __expf(fminf(e1, 80.f));
                    const float k0 = bf2f(kr_[i]) * __expf(fminf(-e0, 80.f)), k1 = bf2f(kr_[i + 1]) * __expf(fminf(-e1, 80.f));
                    *(LAS unsigned short*)(Qp + (16 * seg + i) * HP_ROWB + kc * 2) = f2bf1(q0);
                    *(LAS unsigned short*)(Qp + (16 * seg + i + 1) * HP_ROWB + kc * 2) = f2bf1(q1);
                    *(LAS unsigned short*)(Kp + (16 * seg + i) * HP_ROWB + kc * 2) = f2bf1(k0);
                    *(LAS unsigned short*)(Kp + (16 * seg + i + 1) * HP_ROWB + kc * 2) = f2bf1(k1);
                    vw[i >> 1] = (unsigned)vr_[i] | ((unsigned)vr_[i + 1] << 16);
                }
                LAS u32x4* vd = (LAS u32x4*)(Vt + kc * HT_ROWB + seg * 32); vd[0] = (u32x4){vw[0], vw[1], vw[2], vw[3]}; vd[1] = (u32x4){vw[4], vw[5], vw[6], vw[7]};
#pragma unroll
                for (int i = 0; i < 4; ++i) { const int q = tid + 512 * i; *(LAS u32x4*)(SPs + (q >> 4) * HP_ROWB + (q & 15) * 16) = spr[i]; }
            }
            if (d == 0) H3_FETCH(item, 1);
            else { if (item + (int)gridDim.x < 1024) H3_FETCH(item + (int)gridDim.x, 0);
#pragma unroll
                for (int j = 0; j < 4; ++j) hgr[j] = *(const GAS u32x2*)(HG + (size_t)(tok0 + 16 * rt + fr) * HW + h * 128 + 16 * (4 * vg + j) + 4 * fq); }
            __syncthreads();
            {
                const int art = w >> 1;
#pragma unroll
                for (int tt = 0; tt < 2; ++tt) {
                    const int st = 2 * (w & 1) + tt;
                    const bool need = d ? (st >= art) : (st <= art);
                    f32x4 acc = (f32x4){0.f, 0.f, 0.f, 0.f};
                    if (need) {
#pragma unroll
                        for (int ks = 0; ks < 4; ++ks) {
                            const bf16x8 af = *(const LAS bf16x8*)(Qp + (16 * art + fr) * HP_ROWB + (32 * ks + 8 * fq) * 2);
                            const bf16x8 bfr = *(const LAS bf16x8*)(Kp + (16 * st + fr) * HP_ROWB + (32 * ks + 8 * fq) * 2);
                            acc = __builtin_amdgcn_mfma_f32_16x16x32_bf16(af, bfr, acc, 0, 0, 0);
                        }
                    }
                    const int s_ = 16 * st + fr;
#pragma unroll
                    for (int r = 0; r < 4; ++r) { const int r_ = 16 * art + 4 * fq + r; const bool ok = need && (d ? (s_ >= r_) : (s_ <= r_));
                        *(LAS unsigned short*)(Ab + r_ * HT_ROWB + s_ * 2) = f2bf1(ok ? acc[r] : 0.f); }
                }
            }
            __syncthreads();
            {
                bf16x8 ab[2], qb[4];
#pragma unroll
                for (int ks = 0; ks < 2; ++ks) ab[ks] = *(const LAS bf16x8*)(Ab + (16 * rt + fr) * HT_ROWB + (32 * ks + 8 * fq) * 2);
#pragma unroll
                for (int ks = 0; ks < 4; ++ks) qb[ks] = *(const LAS bf16x8*)(Qp + (16 * rt + fr) * HP_ROWB + (32 * ks + 8 * fq) * 2);
#pragma unroll
                for (int j = 0; j < 4; ++j) {
                    const int vt = 4 * vg + j;
#pragma unroll
                    for (int ks = 0; ks < 2; ++ks) { const bf16x8 af = *(const LAS bf16x8*)(Vt + (16 * vt + fr) * HT_ROWB + (32 * ks + 8 * fq) * 2);
                        o[j] = __builtin_amdgcn_mfma_f32_16x16x32_bf16(af, ab[ks], o[j], 0, 0, 0); }
#pragma unroll
                    for (int ks = 0; ks < 4; ++ks) { const bf16x8 af = *(const LAS bf16x8*)(SPs + (16 * vt + fr) * HP_ROWB + (32 * ks + 8 * fq) * 2);
                        o[j] = __builtin_amdgcn_mfma_f32_16x16x32_bf16(af, qb[ks], o[j], 0, 0, 0); }
                }
            }
            __syncthreads();
        }
        {
            float s = 0.f;
#pragma unroll
            for (int j = 0; j < 4; ++j) s += o[j][0] * o[j][0] + o[j][1] * o[j][1] + o[j][2] * o[j][2] + o[j][3] * o[j][3];
            s += __shfl_xor(s, 16); s += __shfl_xor(s, 32);
            if (fq == 0) SSQP[vg * 64 + 16 * rt + fr] = s;
            __syncthreads();
            const int row = 16 * rt + fr; const float rs = rsqrtf((SSQP[row] + SSQP[64 + row]) * (1.0f / 128.f) + EPS);
#pragma unroll
            for (int j = 0; j < 4; ++j) { const int v0 = 16 * (4 * vg + j) + 4 * fq; const f32x4 on = ldgf4(onorm + v0);
                u32x2 ow; ow.x = cvt_pk_bf16(o[j][0] * rs * on[0] * bflo(hgr[j].x), o[j][1] * rs * on[1] * bfhi(hgr[j].x)); ow.y = cvt_pk_bf16(o[j][2] * rs * on[2] * bflo(hgr[j].y), o[j][3] * rs * on[3] * bfhi(hgr[j].y));
                *(GAS u32x2*)(OA + (size_t)(tok0 + row) * HW + h * 128 + v0) = ow; }
        }
    }
#undef H3_FETCH
}

constexpr int NAT_NB = 36864, NAT_KH = 64 * 272, NAT_VH = 128 * 144;
__device__ __forceinline__ void natten_phase(const Args& a, int layer, LAS unsigned char* lds, int wid_s) {
    unsigned char* ws = opaque_ptr(a.ws);
    const int tid = opaque_tid(wid_s), lane = tid & 63, w = __builtin_amdgcn_readfirstlane(tid >> 6), fr = lane & 15, fq = lane >> 4;
    LAS float* RP = (LAS float*)(lds + 2 * NAT_NB);
    const bf16_t* NQ = (const bf16_t*)(ws + WS_NQ); const bf16_t* NK = (const bf16_t*)(ws + WS_NK); const bf16_t* VT = (const bf16_t*)(ws + WS_VT);
    const bf16_t* NG = (const bf16_t*)(ws + WS_NG); bf16_t* OB = (bf16_t*)(ws + WS_OB);
    const float* gq = a.in[6] + layer * 128; const float* gk = a.in[7] + layer * 128; const float* rpb = a.in[8] + (size_t)layer * 8 * 465;
    for (int it = blockIdx.x; it < 512; it += gridDim.x) {
        const int r = it >> 2, hp = it & 3, hw = w >> 2, h = 2 * hp + hw, j = w & 3;
        const int r_start = min(max(r - 4, 0), 120);
        const bf16_t* ksrc[4]; const bf16_t* vsrc[4]; int kdst[4], vdst[4];
#pragma unroll
        for (int i = 0; i < 4; ++i) { const int q = tid + 512 * i, hd = q >> 10;
            { const int key = (q >> 4) & 63, ch = q & 15; ksrc[i] = NK + (size_t)(64 * r_start + key) * HW + (2 * hp + hd) * 128 + ch * 8; kdst[i] = hd * NAT_KH + key * 272 + ch * 16; }
            { const int d = (q >> 3) & 127, ch = q & 7; vsrc[i] = VT + (size_t)((2 * hp + hd) * 128 + d) * SEQ + 64 * r_start + ch * 8; vdst[i] = hd * NAT_VH + d * 144 + ch * 16; } }
        u32x4 R0[4], R1[4];
#define NAT_LOAD(st, R) do { _Pragma("unroll") for (int i = 0; i < 4; ++i) R[i] = ((st) < 8) ? ldg16(ksrc[i] + (size_t)(st) * 64 * HW) : ldg16(vsrc[i] + ((st) - 8) * 64); } while (0)
#define NAT_WRITE(st, R) do { _Pragma("unroll") for (int i = 0; i < 4; ++i) *(LAS u32x4*)(lds + ((st) & 1) * NAT_NB + (((st) < 8) ? kdst[i] : vdst[i])) = R[i]; } while (0)
        NAT_LOAD(0, R0); NAT_LOAD(1, R1);
        for (int i = tid; i < 930; i += 512) RP[i] = ldgf(rpb + (size_t)(2 * hp) * 465 + i);
        const int c0k = (j == 0) ? 0 : (j == 1) ? 8 : (j == 2) ? 24 : 32;
        const int cq = 16 * j + fr, tq = 64 * r + cq;
        const int cstart = min(max(cq - 8, 0), 48);
        bf16x8 qf[4];
        {
            float qv[4][8]; float ss = 0.f;
#pragma unroll
            for (int ks = 0; ks < 4; ++ks) { load8_bf16(NQ + (size_t)tq * HW + h * 128 + 32 * ks + 8 * fq, qv[ks]);
#pragma unroll
                for (int e = 0; e < 8; ++e) ss += qv[ks][e] * qv[ks][e]; }
            ss += __shfl_xor(ss, 16); ss += __shfl_xor(ss, 32);
            const float rq = rsqrtf(ss * (1.0f / 128.f) + EPS) * 0.08838834764831845f;
#pragma unroll
            for (int ks = 0; ks < 4; ++ks) { float g1[8], g2[8]; load8_f32(gq + 32 * ks + 8 * fq, g1); load8_f32(gk + 32 * ks + 8 * fq, g2);
                u32x4 wv;
                wv.x = cvt_pk_bf16(qv[ks][0] * rq * g1[0] * g2[0], qv[ks][1] * rq * g1[1] * g2[1]); wv.y = cvt_pk_bf16(qv[ks][2] * rq * g1[2] * g2[2], qv[ks][3] * rq * g1[3] * g2[3]);
                wv.z = cvt_pk_bf16(qv[ks][4] * rq * g1[4] * g2[4], qv[ks][5] * rq * g1[5] * g2[5]); wv.w = cvt_pk_bf16(qv[ks][6] * rq * g1[6] * g2[6], qv[ks][7] * rq * g1[7] * g2[7]);
                qf[ks] = __builtin_bit_cast(bf16x8, wv); }
        }
        NAT_WRITE(0, R0);
        __syncthreads();
        float s[8][2][4];
        float mx = -3.0e38f, l = 0.f;
        f32x4 o[8];
#pragma unroll
        for (int dt = 0; dt < 8; ++dt) o[dt] = (f32x4){0.f, 0.f, 0.f, 0.f};
#pragma unroll
        for (int st = 0; st < 16; ++st) {
            if (st + 2 < 16) { if (st & 1) NAT_LOAD(st + 2, R1); else NAT_LOAD(st + 2, R0); }
            LAS unsigned char* buf = lds + (st & 1) * NAT_NB;
            if (st < 8) {
                const int aa = st, kr = r_start + aa, row_off = kr - r + 7;
#pragma unroll
                for (int kt = 0; kt < 2; ++kt) {
                    bf16x8 kf[4]; float ssk = 0.f;
#pragma unroll
                    for (int ks = 0; ks < 4; ++ks) { const u32x4 wv = *(const LAS u32x4*)(buf + hw * NAT_KH + (c0k + 16 * kt + fr) * 272 + (32 * ks + 8 * fq) * 2); kf[ks] = __builtin_bit_cast(bf16x8, wv);
                        ssk += bflo(wv.x) * bflo(wv.x) + bfhi(wv.x) * bfhi(wv.x) + bflo(wv.y) * bflo(wv.y) + bfhi(wv.y) * bfhi(wv.y)
                             + bflo(wv.z) * bflo(wv.z) + bfhi(wv.z) * bfhi(wv.z) + bflo(wv.w) * bflo(wv.w) + bfhi(wv.w) * bfhi(wv.w); }
                    ssk += __shfl_xor(ssk, 16); ssk += __shfl_xor(ssk, 32);
                    const float rk = rsqrtf(ssk * (1.0f / 128.f) + EPS);
                    f32x4 acc = (f32x4){0.f, 0.f, 0.f, 0.f};
#pragma unroll
                    for (int ks = 0; ks < 4; ++ks) acc = __builtin_amdgcn_mfma_f32_16x16x32_bf16(kf[ks], qf[ks], acc, 0, 0, 0);
#pragma unroll
                    for (int rg = 0; rg < 4; ++rg) {
                        const int ki = 4 * fq + rg; const float rki = __shfl(rk, ki);
                        const int kcl = c0k + 16 * kt + ki; const bool valid = (kcl >= cstart) && (kcl < cstart + 16);
                        const int co = min(max(kcl - cq + 15, 0), 30);
                        const float bias = RP[hw * 465 + row_off * 31 + co];
                        const float sv = valid ? (acc[rg] * rki + bias) : -1.0e30f;
                        s[aa][kt][rg] = sv; mx = fmaxf(mx, sv);
                    }
                }
                if (st == 7) {
                    mx = fmaxf(mx, __shfl_xor(mx, 16)); mx = fmaxf(mx, __shfl_xor(mx, 32));
#pragma unroll
                    for (int a2 = 0; a2 < 8; ++a2)
#pragma unroll
                        for (int kt = 0; kt < 2; ++kt)
#pragma unroll
                            for (int rg = 0; rg < 4; ++rg) { const float p = __expf(s[a2][kt][rg] - mx); s[a2][kt][rg] = p; l += p; }
                    l += __shfl_xor(l, 16); l += __shfl_xor(l, 32);
                }
            } else {
                const int aa = st - 8;
                u32x4 pw; pw.x = cvt_pk_bf16(s[aa][0][0], s[aa][0][1]); pw.y = cvt_pk_bf16(s[aa][0][2], s[aa][0][3]); pw.z = cvt_pk_bf16(s[aa][1][0], s[aa][1][1]); pw.w = cvt_pk_bf16(s[aa][1][2], s[aa][1][3]);
                const bf16x8 pb = __builtin_bit_cast(bf16x8, pw);
#pragma unroll
                for (int dt = 0; dt < 8; ++dt) {
                    const LAS unsigned char* vp = buf + hw * NAT_VH + (16 * dt + fr) * 144 + (c0k + 4 * fq) * 2;
                    const u32x2 v0 = *(const LAS u32x2*)vp, v1 = *(const LAS u32x2*)(vp + 32);
                    const u32x4 vw = (u32x4){v0.x, v0.y, v1.x, v1.y};
                    o[dt] = __builtin_amdgcn_mfma_f32_16x16x32_bf16(__builtin_bit_cast(bf16x8, vw), pb, o[dt], 0, 0, 0);
                }
            }
            if (st + 1 < 16) { if (st & 1) NAT_WRITE(st + 1, R0); else NAT_WRITE(st + 1, R1); }
            __syncthreads();
        }
        const float inv = 1.0f / l;
#pragma unroll
        for (int dt = 0; dt < 8; ++dt) {
            const size_t off = (size_t)tq * HW + h * 128 + 16 * dt + 4 * fq;
            const u32x2 gw = *(const GAS u32x2*)(NG + off);
            u32x2 ow; ow.x = cvt_pk_bf16(o[dt][0] * inv * bflo(gw.x), o[dt][1] * inv * bfhi(gw.x)); ow.y = cvt_pk_bf16(o[dt][2] * inv * bflo(gw.y), o[dt][3] * inv * bfhi(gw.y));
            *(GAS u32x2*)(OB + off) = ow;
        }
#undef NAT_LOAD
#undef NAT_WRITE
    }
}

__global__ void __launch_bounds__(512, 2) mk_fwd(Args a) {
    extern __shared__ __attribute__((aligned(16))) unsigned char lds_raw[];
    LAS unsigned char* lds = (LAS unsigned char*)lds_raw;
    volatile LAS unsigned* MISC = (volatile LAS unsigned*)(lds + LDS_MISC_OFF);
    unsigned char* ws = a.ws;
    const int wid_s = __builtin_amdgcn_readfirstlane(threadIdx.x >> 6);
    if (threadIdx.x < 64) MISC[threadIdx.x] = 0u;
    __syncthreads();
    XcdBarrier bar; bar.bar = (unsigned*)(ws + WS_CTL) + 4096; bar.x = 0; bar.st = nullptr;
    const int lo = a.ph_lo, hi = a.ph_hi;
    if (hi - lo > 1) bar = xcd_barrier_post((unsigned*)(ws + WS_CTL) + 4096, MISC + 8);
#ifndef DIAG_MASK
#define DIAG_MASK 0x1ff
#endif
#define DM_(b) ((DIAG_MASK >> (b)) & 1)
#define IN(k) (lo <= (k) && (k) < hi)
#if MK_TS
    unsigned long long* TS = (unsigned long long*)(ws + 131072);
#define STAMP(k) do { if (blockIdx.x == 0 && threadIdx.x == 0) TS[k] = __builtin_amdgcn_s_memrealtime(); } while (0)
#define SEAM(k) do { if (IN(k) && (IN((k) + 1) || (k) == NPHASE - 1)) xcd_barrier(bar); STAMP((k) + 1); } while (0)
    STAMP(0);
#else
#define SEAM(k) do { if (IN(k) && IN((k) + 1)) xcd_barrier(bar); } while (0)
#endif
    const int G = gridDim.x, c = blockIdx.x;

    if (DM_(0) && IN(0)) { for (int rep = 0; rep < (MK_REP_PHASE == 0 ? MK_REP_N : 1); ++rep) { if (rep) xcd_barrier(bar); p0_prologue(a, lds); } }
    SEAM(0);
    for (int l = 0; l < 2; ++l) {
        const int pb = 1 + 7 * l;
        for (int rep = 0; rep < (MK_REP_PHASE == pb + 0 ? MK_REP_N : 1); ++rep) { if (rep) xcd_barrier(bar);
        if (DM_(1) && IN(pb + 0)) {
            unsigned char* ws = opaque_ptr(a.ws);
            const int nfull = (SEQ / 256) * (NIN / 256) % G;
            if (c >= nfull) {
                int kple = PLE; asm volatile("" : "+s"(kple));
                pg8::Gemm g2{(const bf16_t*)(ws + WS_PB) + (size_t)l * SEQ * PLE, (const bf16_t*)(ws + WS_WP) + (size_t)l * DM * PLE, SEQ, DM, kple, nullptr, nullptr}; pg8::StaticOrder S2; S2.init(SEQ, DM, G - nfull, c - nfull);
                EpiPL E2{(bf16_t*)(ws + WS_PL)};
                pg8::gemm_phase<EpiPL, pg8::StaticOrder>(lds, g2, S2, E2, wid_s);
            }
        }
        if (DM_(1) && IN(pb + 0)) {
            unsigned char* ws = opaque_ptr(a.ws); bf16_t* XGA = (bf16_t*)(ws + WS_XGA); float* SSQ = (float*)(ws + WS_SSQ);
            pg8::Gemm g{XGA, (const bf16_t*)(ws + WS_WIN) + (size_t)l * NIN * DM, SEQ, NIN, DM, nullptr, nullptr}; pg8::StaticOrder S; S.init(SEQ, NIN, G, c);
            EpiInProj E{SSQ + (2 * l) * SEQ, (const float*)(ws + WS_LOWER) + l * 2048, ws};
            if (MK_REP_DUMMY && rep) { EpiDummy ED{(bf16_t*)(ws + WS_LT)}; pg8::gemm_phase<EpiDummy, pg8::StaticOrder>(lds, g, S, ED, wid_s); } else
            pg8::gemm_phase<EpiInProj, pg8::StaticOrder>(lds, g, S, E, wid_s);
        } }
        SEAM(pb + 0);
        if (IN(pb + 1)) { for (int rep = 0; rep < (MK_REP_PHASE == pb + 1 ? MK_REP_N : 1); ++rep) { if (rep) xcd_barrier(bar); if (DM_(2)) h1_phase(a, lds, wid_s); }
            for (int rep = 0; rep < (MK_REP_PHASE == pb + 101 ? MK_REP_N : 1); ++rep) { if (rep) xcd_barrier(bar); if (DM_(8)) natten_phase(a, l, lds, wid_s); } }
        SEAM(pb + 1);
        if (DM_(3) && IN(pb + 2)) { for (int rep = 0; rep < (MK_REP_PHASE == pb + 2 ? MK_REP_N : 1); ++rep) { if (rep) xcd_barrier(bar); h2_phase(a, wid_s); } }
        SEAM(pb + 2);
        if (DM_(4) && IN(pb + 3)) { for (int rep = 0; rep < (MK_REP_PHASE == pb + 3 ? MK_REP_N : 1); ++rep) { if (rep) xcd_barrier(bar); h3_phase(a, l, lds, wid_s); } }
        SEAM(pb + 3);
        for (int rep = 0; rep < (MK_REP_PHASE == pb + 4 ? MK_REP_N : 1); ++rep) { if (rep) xcd_barrier(bar);
        if (DM_(5) && IN(pb + 4)) {
            unsigned char* ws = opaque_ptr(a.ws);
            pg8::PairOrder S; S.init(SEQ, DM, G, c);
            pg8::Gemm g{(const bf16_t*)(ws + WS_OA), (const bf16_t*)(ws + WS_WA) + (size_t)l * DM * HW, SEQ, DM, HW, (const bf16_t*)(ws + WS_OB), (const bf16_t*)(ws + WS_WB) + (size_t)l * DM * HW};
            EpiBranch E{(const bf16_t*)(ws + WS_MA), (const bf16_t*)(ws + WS_MB), (bf16_t*)(ws + WS_T), (bf16_t*)(ws + WS_Y)};
            pg8::gemm_phase<EpiBranch, pg8::PairOrder>(lds, g, S, E, wid_s);
        } }
        SEAM(pb + 4);
        for (int rep = 0; rep < (MK_REP_PHASE == pb + 5 ? MK_REP_N : 1); ++rep) { if (rep) xcd_barrier(bar);
        if (DM_(6) && IN(pb + 5)) {
            unsigned char* ws = opaque_ptr(a.ws); bf16_t* XGB = (bf16_t*)(ws + WS_XGB); float* SSQ = (float*)(ws + WS_SSQ);
            pg8::Gemm g{(const bf16_t*)(ws + WS_Y), (const bf16_t*)(ws + WS_WO) + (size_t)l * DM * DM, SEQ, DM, DM, nullptr, nullptr}; pg8::StaticOrder S; S.init(SEQ, DM, G, c);
            EpiWout E{(const bf16_t*)(ws + WS_XGA), XGB, rep ? (float*)(ws + 262144) : SSQ + (2 * l + 1) * SEQ};
            if (MK_REP_DUMMY && rep) { EpiDummy ED{(bf16_t*)(ws + WS_LT)}; pg8::gemm_phase<EpiDummy, pg8::StaticOrder>(lds, g, S, ED, wid_s); } else
            pg8::gemm_phase<EpiWout, pg8::StaticOrder>(lds, g, S, E, wid_s);
        } }
        SEAM(pb + 5);
        for (int rep = 0; rep < (MK_REP_PHASE == pb + 6 ? MK_REP_N : 1); ++rep) { if (rep) xcd_barrier(bar);
        if (DM_(7) && IN(pb + 6)) {
            unsigned char* ws = opaque_ptr(a.ws); bf16_t* XGA = (bf16_t*)(ws + WS_XGA); bf16_t* XGB = (bf16_t*)(ws + WS_XGB); float* SSQ = (float*)(ws + WS_SSQ);
            pg8::StaticOrder S; S.init(SEQ, DM, G, c);
            { pg8::Gemm g{XGB, (const bf16_t*)(ws + WS_WG) + (size_t)l * DM * DM, SEQ, DM, DM, nullptr, nullptr};
              EpiGate E{SSQ + (2 * l + 1) * SEQ, XGB, (const bf16_t*)(ws + WS_PL), a.out, XGA, rep ? (float*)(ws + 262144) : SSQ + (2 * l + 2 < 4 ? 2 * l + 2 : 0) * SEQ, l == 0 ? 1 : 0};
              pg8::gemm_phase<EpiGate, pg8::StaticOrder>(lds, g, S, E, wid_s); }
        } }
        SEAM(pb + 6);
    }
#if MK_TS
    if (blockIdx.x == 0) {
        const float dA = (float)(TS[MK_TS_A + 1] - TS[MK_TS_A]) * 0.01f, dB = (float)(TS[MK_TS_B + 1] - TS[MK_TS_B]) * 0.01f;
        for (int i = threadIdx.x; i < 1000000; i += 512) a.out[i] += (i == 0) ? 10.f * dA : 0.3f * dB;
    }
#endif
#undef IN
#undef SEAM
#if MK_ENDFLUSH
    asm volatile("s_waitcnt vmcnt(0)" ::: "memory");
    __builtin_amdgcn_fence(__ATOMIC_RELEASE, "agent");
    asm volatile("s_waitcnt vmcnt(0)" ::: "memory");
#endif
}


#ifndef MK_DIAG
#define MK_DIAG 0
#define MK_HOLE_BUF WS_MB
#define MK_HOLE_LD DM
#define MK_HOLE_MODE 0
#endif
#if MK_DIAG
__global__ void ck_sum(const void* p, size_t n, int kind, double* slot) {
    double s0 = 0.0, s1 = 0.0;
    for (size_t i = (size_t)blockIdx.x * blockDim.x + threadIdx.x; i < n; i += (size_t)gridDim.x * blockDim.x) {
        float v = kind ? bf2f(((const bf16_t*)p)[i]) : ((const float*)p)[i];
        if (!(v == v)) v = 12345.0f;
        const float wgt = (float)((int)((i * 2654435761ull >> 16) & 255) - 128);
        s0 += fabsf(v); s1 += (double)v * wgt;
    }
    for (int o = 32; o >= 1; o >>= 1) { s0 += __shfl_xor(s0, o); s1 += __shfl_xor(s1, o); }
    if ((threadIdx.x & 63) == 0) { atomicAdd(slot, s0); atomicAdd(slot + 1, s1); }
}
__global__ void ck_final(const double* sums, float* out, size_t n, int nslots) {
    int first = -1;
    for (int i = 0; i < nslots; ++i) { const double a0 = sums[2 * i], a1 = sums[2 * i + 1], b0 = sums[2 * (nslots + i)], b1 = sums[2 * (nslots + i) + 1];
        const bool bad = fabs(a0 - b0) > 1e-5 * (fabs(a0) + fabs(b0)) + 1e-30 || fabs(a1 - b1) > 1e-4 * (fabs(a0) + fabs(b0)) + 1e-30;
        if (bad) { first = i; break; } }
    const float val = first < 0 ? 0.f : 100.f * (float)(first + 1);
    for (size_t i = (size_t)blockIdx.x * blockDim.x + threadIdx.x; i < n; i += (size_t)gridDim.x * blockDim.x) out[i] = val;
}
__global__ void ck_holes(const bf16_t* p, size_t n, unsigned long long* res) {
    unsigned long long cnt = 0, mn = ~0ull;
    for (size_t i = (size_t)blockIdx.x * blockDim.x + threadIdx.x; i < n; i += (size_t)gridDim.x * blockDim.x) if (p[i] == 0xFFFFu) { ++cnt; if (i < mn) mn = i; }
    if (cnt) { atomicAdd(res, cnt); atomicMin(res + 1, mn); }
}
__global__ void ck_holes_final(const unsigned long long* res, float* out, size_t n, int mode) {
    const float val = mode == 0 ? (float)((double)res[0] / 65536.0 * 100.0) : mode == 1 ? (float)((res[1] == ~0ull ? 0 : (res[1] / 2048) ) ) + 100.f : (float)((res[1] == ~0ull ? 0 : (res[1] % 2048))) + 100.f;
    for (size_t i = (size_t)blockIdx.x * blockDim.x + threadIdx.x; i < n; i += (size_t)gridDim.x * blockDim.x) out[i] = val;
}
__global__ void ck_diff(const bf16_t* p, const bf16_t* q, size_t n, unsigned long long* res) {
    unsigned long long cnt = 0, mn = ~0ull, big = 0;
    for (size_t i = (size_t)blockIdx.x * blockDim.x + threadIdx.x; i < n; i += (size_t)gridDim.x * blockDim.x) if (p[i] != q[i]) { ++cnt; if (i < mn) mn = i; const float a = bf2f(p[i]), b = bf2f(q[i]); if (fabsf(a - b) > 0.02f * (fabsf(a) + fabsf(b))) ++big; }
    if (cnt) { atomicAdd(res, cnt); atomicMin(res + 1, mn); atomicAdd(res + 2, big); }
}
__global__ void ck_diff_final(const unsigned long long* res, float* out, size_t n, int ld) {
    const unsigned long long cnt = res[0], big = res[2];
    const float c2 = 100.f * (1.f + floorf(log2f(1.f + (float)cnt)));
    const float c1 = 1.0e6f * (1.f + floorf(log2f(1.f + (float)big)));
    for (size_t i = (size_t)blockIdx.x * blockDim.x + threadIdx.x; i < n; i += (size_t)gridDim.x * blockDim.x) out[i] = (i == 0) ? c1 : c2;
}

__device__ __forceinline__ unsigned hsh(unsigned x) { x ^= x >> 16; x *= 0x7feb352du; x ^= x >> 15; x *= 0x846ca68bu; x ^= x >> 16; return x; }
__device__ __forceinline__ float bfr(float f) { return bf2f(f2bf1(f)); }
__device__ __forceinline__ void err_max(unsigned* res, float got, float expv) { float e = fabsf(got - expv) / (0.02f + 0.02f * fabsf(expv)); if (!(e == e)) e = 1e9f; atomicMax(res, __float_as_uint(e)); }
__device__ __forceinline__ float wave_sum(float s) { for (int o = 32; o >= 1; o >>= 1) s += __shfl_xor(s, o); return s; }
__global__ void chk_inproj(const float* x, const float* g0, const float* win, const float* lbp, const unsigned char* ws, unsigned* res, int nsamp) {
    const int lane = threadIdx.x & 63, wv = (blockIdx.x * blockDim.x + threadIdx.x) >> 6, nw = (gridDim.x * blockDim.x) >> 6;
    for (int s = wv; s < nsamp; s += nw) {
        const int row = hsh(2 * s + 1) % SEQ, col = hsh(2 * s + 2) % NIN;
        float ss = 0.f, dot = 0.f;
        for (int k = lane; k < DM; k += 64) { const float xv = x[(size_t)row * DM + k]; ss += xv * xv; dot += bfr(xv * g0[k]) * bfr(win[(size_t)k * NIN + col]); }
        ss = wave_sum(ss); dot = wave_sum(dot);
        const float u = dot * rsqrtf(ss / DM + EPS);
        if (lane == 0) {
            const int seg = col >> 10, c = col & 1023; const size_t o1 = (size_t)row * HW + c;
            const float sg = 1.f / (1.f + expf(-u)), si = u * sg;
            if (seg == 0) err_max(res, bf2f(((const bf16_t*)(ws + WS_QH))[o1]), si);
            else if (seg == 1) err_max(res, bf2f(((const bf16_t*)(ws + WS_VH))[o1]), u);
            else if (seg == 2 || seg == 3) { const int dir = seg - 2; const float a0 = lbp[dir * 1024 + c], a1 = lbp[2048 + dir * 1024 + c]; const float lb = 0.f * (a0 + a1);
                const float f = lb + (1.f - lb) * sg; err_max(res + 1, ((const float*)(ws + (dir ? WS_GB : WS_GF)))[o1], logf(fmaxf(f, 1e-6f)));
                err_max(res + 1, bf2f(((const bf16_t*)(ws + (dir ? WS_KB : WS_KF)))[o1]), (1.f - lb) * (1.f - sg)); }
            else if (seg == 4) err_max(res, bf2f(((const bf16_t*)(ws + WS_HG))[o1]), si);
            else if (seg == 5) err_max(res, bf2f(((const bf16_t*)(ws + WS_NQ))[o1]), u);
            else if (seg == 6) err_max(res, bf2f(((const bf16_t*)(ws + WS_NK))[o1]), u);
            else if (seg == 7) err_max(res + 2, bf2f(((const bf16_t*)(ws + WS_VT))[(size_t)c * SEQ + row]), u);
            else if (seg == 8) err_max(res, bf2f(((const bf16_t*)(ws + WS_NG))[o1]), si);
            else if (seg < 11) err_max(res + 3, bf2f(((const bf16_t*)(ws + WS_MA))[(size_t)row * DM + col - 9216]), sg);
            else err_max(res + 9, bf2f(((const bf16_t*)(ws + WS_MB))[(size_t)row * DM + col - 11264]), sg);
        }
    }
}
__global__ void chk_natten(const unsigned char* ws, const float* gq, const float* gk, const float* rpb, unsigned* res, int nsamp) {
    const int lane = threadIdx.x & 63, wv = (blockIdx.x * blockDim.x + threadIdx.x) >> 6, nw = (gridDim.x * blockDim.x) >> 6;
    const bf16_t* NQ = (const bf16_t*)(ws + WS_NQ); const bf16_t* NK = (const bf16_t*)(ws + WS_NK); const bf16_t* VT = (const bf16_t*)(ws + WS_VT); const bf16_t* NG = (const bf16_t*)(ws + WS_NG); const bf16_t* OB = (const bf16_t*)(ws + WS_OB);
    for (int s = wv; s < nsamp; s += nw) {
        const int t = hsh(3 * s + 7) % SEQ, h = hsh(3 * s + 8) % 8; const int r = t >> 6, c = t & 63;
        const int rs0 = min(max(r - 4, 0), 120), cs0 = min(max(c - 8, 0), 48);
        float q0 = bf2f(NQ[(size_t)t * HW + h * 128 + lane]), q1 = bf2f(NQ[(size_t)t * HW + h * 128 + 64 + lane]);
        const float rq = rsqrtf(wave_sum(q0 * q0 + q1 * q1) / 128.f + EPS); q0 *= rq * gq[lane]; q1 *= rq * gq[64 + lane];
        float mx = -1e30f;
        float o0 = 0.f, o1 = 0.f, l = 0.f;
        for (int pass = 0; pass < 2; ++pass) {
            for (int a = 0; a < 8; ++a) for (int j = 0; j < 16; ++j) {
                const int kr = rs0 + a, kc = cs0 + j, tk = kr * 64 + kc;
                float k0 = bf2f(NK[(size_t)tk * HW + h * 128 + lane]), k1 = bf2f(NK[(size_t)tk * HW + h * 128 + 64 + lane]);
                const float rk = rsqrtf(wave_sum(k0 * k0 + k1 * k1) / 128.f + EPS);
                const float d = wave_sum(q0 * k0 * rk * gk[lane] + q1 * k1 * rk * gk[64 + lane]) * 0.08838834764831845f + rpb[(size_t)h * 465 + (kr - r + 7) * 31 + (kc - c + 15)];
                if (pass == 0) mx = fmaxf(mx, d);
                else { const float p = expf(d - mx); l += p; o0 += p * bf2f(VT[(size_t)(h * 128 + lane) * SEQ + tk]); o1 += p * bf2f(VT[(size_t)(h * 128 + 64 + lane) * SEQ + tk]); }
            }
        }
        const size_t ob = (size_t)t * HW + h * 128;
        err_max(res, bf2f(OB[ob + lane]), o0 / l * bf2f(NG[ob + lane])); err_max(res, bf2f(OB[ob + 64 + lane]), o1 / l * bf2f(NG[ob + 64 + lane]));
    }
}
__global__ void chk_hgrn_scan(const unsigned char* ws, float* OREF, int h0) {
    __shared__ float qs[128], ks[128], fs[128], vs[128], part[4][128];
    const int tid = threadIdx.x, v = tid & 127, kq = tid >> 7; const int h = h0 + (blockIdx.x >> 1), d = blockIdx.x & 1;
    const bf16_t* QH = (const bf16_t*)(ws + WS_QH); const bf16_t* VH = (const bf16_t*)(ws + WS_VH); const bf16_t* KK = (const bf16_t*)(ws + (d ? WS_KB : WS_KF)); const float* G = (const float*)(ws + (d ? WS_GB : WS_GF));
    float S[32];
#pragma unroll
    for (int i = 0; i < 32; ++i) S[i] = 0.f;
    float* out = OREF + (size_t)blockIdx.x * SEQ * 128;
    for (int step = 0; step < SEQ; ++step) {
        const int t = d ? SEQ - 1 - step : step;
        if (tid < 128) { qs[tid] = bf2f(QH[(size_t)t * HW + h * 128 + tid]); ks[tid] = bf2f(KK[(size_t)t * HW + h * 128 + tid]); fs[tid] = expf(G[(size_t)t * HW + h * 128 + tid]); vs[tid] = bf2f(VH[(size_t)t * HW + h * 128 + tid]); }
        __syncthreads();
        float p = 0.f; const float vv = vs[v];
#pragma unroll
        for (int i = 0; i < 32; ++i) { const int k = 32 * kq + i; S[i] = fs[k] * S[i] + ks[k] * vv; p += S[i] * qs[k]; }
        part[kq][v] = p;
        __syncthreads();
        if (tid < 128) out[(size_t)t * 128 + tid] = part[0][tid] + part[1][tid] + part[2][tid] + part[3][tid];
    }
}
__global__ void chk_hgrn_out(const unsigned char* ws, const float* OREF, const float* onorm, unsigned* res, int h0, int nh) {
    const int lane = threadIdx.x & 63, wv = (blockIdx.x * blockDim.x + threadIdx.x) >> 6, nw = (gridDim.x * blockDim.x) >> 6;
    const bf16_t* HG = (const bf16_t*)(ws + WS_HG); const bf16_t* OA = (const bf16_t*)(ws + WS_OA);
    for (int s = wv; s < nh * SEQ; s += nw) {
        const int hh = s / SEQ, t = s % SEQ, h = h0 + hh;
        const float* of = OREF + ((size_t)(2 * hh) * SEQ + t) * 128; const float* ob = OREF + ((size_t)(2 * hh + 1) * SEQ + t) * 128;
        const float a0 = of[lane] + ob[lane], a1 = of[64 + lane] + ob[64 + lane];
        const float rs = rsqrtf(wave_sum(a0 * a0 + a1 * a1) / 128.f + EPS);
        const size_t o = (size_t)t * HW + h * 128;
        err_max(res, bf2f(OA[o + lane]), a0 * rs * onorm[lane] * bf2f(HG[o + lane])); err_max(res, bf2f(OA[o + 64 + lane]), a1 * rs * onorm[64 + lane] * bf2f(HG[o + 64 + lane]));
    }
}
__global__ void chk_branch(const unsigned char* ws, const float* wa, const float* wb, unsigned* res, int nsamp) {
    const int lane = threadIdx.x & 63, wv = (blockIdx.x * blockDim.x + threadIdx.x) >> 6, nw = (gridDim.x * blockDim.x) >> 6;
    const bf16_t* OA = (const bf16_t*)(ws + WS_OA); const bf16_t* OB = (const bf16_t*)(ws + WS_OB); const bf16_t* MA = (const bf16_t*)(ws + WS_MA); const bf16_t* MB = (const bf16_t*)(ws + WS_MB); const bf16_t* Y = (const bf16_t*)(ws + WS_Y);
    for (int s = wv; s < nsamp; s += nw) {
        const int row = hsh(5 * s + 1) % SEQ, col = hsh(5 * s + 2) % DM; float da = 0.f, db = 0.f;
        for (int k = lane; k < HW; k += 64) { da += bf2f(OA[(size_t)row * HW + k]) * bfr(wa[(size_t)k * DM + col]); db += bf2f(OB[(size_t)row * HW + k]) * bfr(wb[(size_t)k * DM + col]); }
        da = wave_sum(da); db = wave_sum(db);
        if (lane == 0) err_max(res, bf2f(Y[(size_t)row * DM + col]), bf2f(MA[(size_t)row * DM + col]) * da + bf2f(MB[(size_t)row * DM + col]) * db);
    }
}
__global__ void chk_wout(const unsigned char* ws, const float* xin, const float* wo, unsigned* res, int nsamp) {
    const int lane = threadIdx.x & 63, wv = (blockIdx.x * blockDim.x + threadIdx.x) >> 6, nw = (gridDim.x * blockDim.x) >> 6;
    const bf16_t* Y = (const bf16_t*)(ws + WS_Y); const float* X1 = (const float*)(ws + WS_X1);
    for (int s = wv; s < nsamp; s += nw) {
        const int row = hsh(7 * s + 1) % SEQ, col = hsh(7 * s + 2) % DM; float d = 0.f;
        for (int k = lane; k < DM; k += 64) d += bf2f(Y[(size_t)row * DM + k]) * bfr(wo[(size_t)k * DM + col]);
        d = wave_sum(d);
        if (lane == 0) err_max(res, X1[(size_t)row * DM + col], xin[(size_t)row * DM + col] + d);
    }
}
__global__ void chk_gate(const unsigned char* ws, const float* out, const float* p, const float* wp, const float* wg, const float* pn, unsigned* res, int nsamp) {
    const int lane = threadIdx.x & 63, wv = (blockIdx.x * blockDim.x + threadIdx.x) >> 6, nw = (gridDim.x * blockDim.x) >> 6;
    const float* X1 = (const float*)(ws + WS_X1);
    for (int s = wv; s < nsamp; s += nw) {
        const int row = hsh(9 * s + 1) % SEQ, col = hsh(9 * s + 2) % DM; float d = 0.f, ss = 0.f, pl = 0.f;
        for (int k = lane; k < DM; k += 64) { const float xv = X1[(size_t)row * DM + k]; ss += xv * xv; d += bfr(xv * pn[k]) * bfr(wg[(size_t)k * DM + col]); }
        for (int k = lane; k < PLE; k += 64) pl += bfr(p[(size_t)row * PLE + k]) * bfr(wp[(size_t)k * DM + col]);
        d = wave_sum(d); ss = wave_sum(ss); pl = wave_sum(pl);
        if (lane == 0) { const float g = 1.f / (1.f + expf(-d * rsqrtf(ss / DM + EPS))); err_max(res, out[(size_t)row * DM + col], X1[(size_t)row * DM + col] + pl * g); }
    }
}
__global__ void chk_final(const unsigned* res, float* out, size_t n, int nres) {
    int first = -1; for (int i = 0; i < nres; ++i) if (__uint_as_float(res[i]) > 1.0f) { first = i; break; }
    float bucket = 0.f; if (first >= 0) { const float e = __uint_as_float(res[first]); bucket = fminf(fmaxf(floorf(log10f(e)) + 1.f, 0.f), 9.f); }
    const float val = first < 0 ? 0.f : 100.f * (float)(first + 1) + 10.f * bucket;
    for (size_t i = (size_t)blockIdx.x * blockDim.x + threadIdx.x; i < n; i += (size_t)gridDim.x * blockDim.x) out[i] = val;
}

__global__ void ck_big(const bf16_t* p, size_t n, unsigned long long* res) {
    unsigned long long c0 = 0, c2 = 0, c4 = 0; float mxv = 0.f;
    for (size_t i = (size_t)blockIdx.x * blockDim.x + threadIdx.x; i < n; i += (size_t)gridDim.x * blockDim.x) { const float v = bf2f(p[i]);
        if (!(fabsf(v) <= 3.0e38f)) ++c0; else if (fabsf(v) > 1.01f || v < -0.01f) { ++c2; mxv = fmaxf(mxv, fabsf(v)); if (v < 0.f) ++c4; } }
    if (c0 | c2) { atomicAdd(res, c0); atomicAdd(res + 2, c2); atomicAdd(res + 4, c4); atomicMax((unsigned*)(res + 3), __float_as_uint(mxv)); }
}
__global__ void ck_big_final(const unsigned long long* res, float* out, size_t n, int ld) {
    const float mxv = __uint_as_float((unsigned)res[3]);
    const float c1 = 1.0e4f * (1.f + floorf(log2f(1.f + (float)res[0])));
    const float negf = res[2] ? (float)res[4] / (float)res[2] : 0.f;
    const float c2 = 1000.f * (1.f + floorf(negf * 3.99f)) + 100.f * fminf(fmaxf(floorf(log10f(fmaxf(mxv, 1e-9f))) + 2.f, 0.f), 9.f);
    for (size_t i = (size_t)blockIdx.x * blockDim.x + threadIdx.x; i < n; i += (size_t)gridDim.x * blockDim.x) out[i] = (i == 0) ? c1 : c2;
}
struct CkBuf { int phase; int idx; size_t off; size_t n; int kind; };
#endif

extern "C" void kernel_launch(void* const* d_in, const int* in_sizes, int n_in, void* d_out, int out_size, void* d_ws, size_t ws_size, hipStream_t stream) {
    static int grid = 0;
    if (grid == 0) {
        if (n_in != 15 || out_size != SEQ * DM || ws_size < WS_END) { fprintf(stderr, "kernel_launch: unexpected problem (n_in %d, out %d, ws %zu)\n", n_in, out_size, ws_size); grid = -1; return; }
        int dev = 0, cus = 0;
        if (hipGetDevice(&dev) != hipSuccess || hipDeviceGetAttribute(&cus, hipDeviceAttributeMultiprocessorCount, dev) != hipSuccess) { grid = -1; return; }
        if (hipFuncSetAttribute((const void*)mk_fwd, hipFuncAttributeMaxDynamicSharedMemorySize, LDS_BYTES) != hipSuccess) { fprintf(stderr, "kernel_launch: hipFuncSetAttribute failed\n"); grid = -1; return; }
        int per_cu = 0;
        if (hipOccupancyMaxActiveBlocksPerMultiprocessor(&per_cu, (const void*)mk_fwd, 512, LDS_BYTES) != hipSuccess || per_cu < 1) fprintf(stderr, "kernel_launch: occupancy query says %d\n", per_cu);
        (void)hipGetLastError();
        grid = cus;
    }
    if (grid < 0) return;
    (void)hipMemsetAsync((char*)d_ws + WS_CTL, 0, CTL_ZERO_BYTES, stream);
    Args a{};
    for (int i = 0; i < 15; ++i) a.in[i] = (const float*)d_in[i];
    a.out = (float*)d_out; a.ws = (unsigned char*)d_ws;
#if MK_DIAG == 5
    {
        unsigned long long* res = (unsigned long long*)((char*)d_ws + 65536);
        (void)hipMemsetAsync((char*)d_ws + 65536 + 8, 0xFF, 8, stream);
        for (int ph = 0; ph < 2; ++ph) { a.ph_lo = ph; a.ph_hi = ph + 1; hipLaunchKernelGGL(mk_fwd, dim3(grid), dim3(512), LDS_BYTES, stream, a); }
        hipLaunchKernelGGL(ck_big, dim3(1024), dim3(256), 0, stream, (const bf16_t*)((char*)d_ws + WS_MA), (size_t)SEQ * DM, res);
        hipLaunchKernelGGL(ck_big_final, dim3(1024), dim3(256), 0, stream, (const unsigned long long*)res, (float*)d_out, (size_t)SEQ * DM, DM);
    }
#elif MK_DIAG == 4
    {
        unsigned* res = (unsigned*)((char*)d_ws + 65536);
        float* OREF = (float*)((char*)d_ws + 728 * MiB);
        const unsigned char* wsc = (const unsigned char*)d_ws;
        const float* const* in = a.in;
        for (int ph = 0; ph < NPHASE; ++ph) {
            a.ph_lo = ph; a.ph_hi = ph + 1; hipLaunchKernelGGL(mk_fwd, dim3(grid), dim3(512), LDS_BYTES, stream, a);
            if (ph == 1) hipLaunchKernelGGL(chk_inproj, dim3(512), dim3(256), 0, stream, in[0], in[2], in[3], in[4], wsc, res + 0, 32768);
            if (ph == 2) hipLaunchKernelGGL(chk_natten, dim3(256), dim3(256), 0, stream, wsc, in[6], in[7], in[8], res + 4, 1024);
            if (ph == 4) { hipLaunchKernelGGL(chk_hgrn_scan, dim3(4), dim3(512), 0, stream, wsc, OREF, 2);
                           hipLaunchKernelGGL(chk_hgrn_out, dim3(512), dim3(256), 0, stream, wsc, (const float*)OREF, in[5], res + 5, 2, 2); }
            if (ph == 5) hipLaunchKernelGGL(chk_branch, dim3(512), dim3(256), 0, stream, wsc, in[9], in[10], res + 6, 8192);
            if (ph == 6) hipLaunchKernelGGL(chk_wout, dim3(512), dim3(256), 0, stream, wsc, in[0], in[11], res + 7, 8192);
            if (ph == 7) hipLaunchKernelGGL(chk_gate, dim3(512), dim3(256), 0, stream, wsc, (const float*)d_out, in[1], in[14], in[13], in[12], res + 8, 8192);
        }
        hipLaunchKernelGGL(chk_final, dim3(1024), dim3(256), 0, stream, (const unsigned*)res, (float*)d_out, (size_t)SEQ * DM, 10);
    }
#elif MK_DIAG == 3
    {
        unsigned long long* res = (unsigned long long*)((char*)d_ws + 65536);
        bf16_t* SAVE = (bf16_t*)((char*)d_ws + 728 * MiB);
        (void)hipMemsetAsync((char*)d_ws + MiB, 0xAA, WS_END - MiB, stream);
        (void)hipMemsetAsync((char*)d_ws + 65536 + 8, 0xFF, 8, stream);
        for (int ph = 0; ph < 2; ++ph) { a.ph_lo = ph; a.ph_hi = ph + 1; hipLaunchKernelGGL(mk_fwd, dim3(grid), dim3(512), LDS_BYTES, stream, a); }
        (void)hipMemcpyAsync(SAVE, (char*)d_ws + MK_HOLE_BUF, (size_t)SEQ * MK_HOLE_LD * 2, hipMemcpyDeviceToDevice, stream);
        a.ph_lo = 1; a.ph_hi = 2; hipLaunchKernelGGL(mk_fwd, dim3(grid), dim3(512), LDS_BYTES, stream, a);
        hipLaunchKernelGGL(ck_diff, dim3(1024), dim3(256), 0, stream, (const bf16_t*)((char*)d_ws + MK_HOLE_BUF), (const bf16_t*)SAVE, (size_t)SEQ * MK_HOLE_LD, res);
        hipLaunchKernelGGL(ck_diff_final, dim3(1024), dim3(256), 0, stream, (const unsigned long long*)res, (float*)d_out, (size_t)SEQ * DM, MK_HOLE_LD);
    }
#elif MK_DIAG == 2
    {
        unsigned long long* res = (unsigned long long*)((char*)d_ws + 65536);
        (void)hipMemsetAsync((char*)d_ws + MiB, 0xAA, WS_END - MiB, stream);
        (void)hipMemsetAsync((char*)d_ws + 65536 + 8, 0xFF, 8, stream);
        a.ph_lo = 0; a.ph_hi = 1; hipLaunchKernelGGL(mk_fwd, dim3(grid), dim3(512), LDS_BYTES, stream, a);
        (void)hipMemsetAsync((char*)d_ws + MK_HOLE_BUF, 0xFF, (size_t)SEQ * MK_HOLE_LD * 2, stream);
        a.ph_lo = 1; a.ph_hi = 2; hipLaunchKernelGGL(mk_fwd, dim3(grid), dim3(512), LDS_BYTES, stream, a);
        hipLaunchKernelGGL(ck_holes, dim3(1024), dim3(256), 0, stream, (const bf16_t*)((char*)d_ws + MK_HOLE_BUF), (size_t)SEQ * MK_HOLE_LD, res);
        hipLaunchKernelGGL(ck_holes_final, dim3(1024), dim3(256), 0, stream, (const unsigned long long*)res, (float*)d_out, (size_t)SEQ * DM, MK_HOLE_MODE);
    }
#elif MK_DIAG
    {
        static const CkBuf B0[] = {
            {0, 0, WS_LOWER, 4096, 0}, {0, 1, WS_SSQ, 8192, 0}, {0, 2, WS_XGA, (size_t)SEQ * DM, 1}, {0, 3, WS_PB, (size_t)2 * SEQ * PLE, 1}, {0, 4, WS_WIN, (size_t)2 * NIN * DM, 1},
            {0, 5, WS_WA, (size_t)2 * DM * HW, 1}, {0, 6, WS_WB, (size_t)2 * DM * HW, 1}, {0, 7, WS_WO, (size_t)2 * DM * DM, 1}, {0, 8, WS_WG, (size_t)2 * DM * DM, 1}, {0, 9, WS_WP, (size_t)2 * DM * PLE, 1} };
        static const CkBuf BL[] = {
            {0, 10, WS_QH, (size_t)SEQ * HW, 1}, {0, 11, WS_VH, (size_t)SEQ * HW, 1}, {0, 12, WS_KF, (size_t)SEQ * HW, 1}, {0, 13, WS_KB, (size_t)SEQ * HW, 1}, {0, 14, WS_HG, (size_t)SEQ * HW, 1},
            {0, 15, WS_NQ, (size_t)SEQ * HW, 1}, {0, 16, WS_NK, (size_t)SEQ * HW, 1}, {0, 17, WS_VT, (size_t)SEQ * HW, 1}, {0, 18, WS_NG, (size_t)SEQ * HW, 1}, {0, 19, WS_GF, (size_t)SEQ * HW, 0},
            {0, 20, WS_GB, (size_t)SEQ * HW, 0}, {0, 21, WS_MA, (size_t)SEQ * DM, 1}, {0, 22, WS_MB, (size_t)SEQ * DM, 1},
            {1, 23, WS_LT, (size_t)2048 * 16384, 0}, {1, 24, WS_DD, (size_t)2048 * 128, 0}, {1, 25, WS_EE, (size_t)2048 * 128, 0}, {1, 26, WS_OB, (size_t)SEQ * HW, 1},
            {2, 27, WS_SP, (size_t)2048 * 16384, 1}, {3, 28, WS_OA, (size_t)SEQ * HW, 1}, {4, 29, WS_T, (size_t)SEQ * DM, 0}, {4, 30, WS_Y, (size_t)SEQ * DM, 1},
            {5, 31, WS_X1, (size_t)SEQ * DM, 0}, {5, 32, WS_XGB, (size_t)SEQ * DM, 1}, {6, 34, WS_PL, (size_t)SEQ * DM, 0}, {6, 35, (size_t)-1, (size_t)SEQ * DM, 0} };
        const int NS = 80;
        double* sums = (double*)((char*)d_ws + 65536);
        (void)hipMemsetAsync((char*)d_ws + MiB, 0xAA, WS_END - MiB, stream);
        for (int run = 0; run < 2; ++run) {
            (void)hipMemsetAsync((char*)d_ws + WS_CTL, 0, 32768, stream);
            for (int ph = 0; ph < NPHASE; ++ph) {
                a.ph_lo = ph; a.ph_hi = ph + 1; hipLaunchKernelGGL(mk_fwd, dim3(grid), dim3(512), LDS_BYTES, stream, a);
                if (ph == 0) { for (const CkBuf& b : B0) hipLaunchKernelGGL(ck_sum, dim3(1024), dim3(256), 0, stream, (const void*)((char*)d_ws + b.off), b.n, b.kind, sums + 2 * (run * NS + b.idx)); }
                else { const int l = (ph - 1) / 7, k = (ph - 1) % 7;
                    for (const CkBuf& b : BL) if (b.phase == k) hipLaunchKernelGGL(ck_sum, dim3(1024), dim3(256), 0, stream, b.off == (size_t)-1 ? (const void*)d_out : (const void*)((char*)d_ws + b.off), b.n, b.kind, sums + 2 * (run * NS + b.idx + 40 * l)); }
            }
        }
        hipLaunchKernelGGL(ck_final, dim3(1024), dim3(256), 0, stream, (const double*)sums, (float*)d_out, (size_t)SEQ * DM, NS);
    }
#elif MK_MULTI
    for (int ph = 0; ph < NPHASE; ++ph) { a.ph_lo = ph; a.ph_hi = ph + 1; hipLaunchKernelGGL(mk_fwd, dim3(grid), dim3(512), LDS_BYTES, stream, a); }
#else
    a.ph_lo = 0; a.ph_hi = NPHASE; hipLaunchKernelGGL(mk_fwd, dim3(grid), dim3(512), LDS_BYTES, stream, a);
#endif
}
```

```cpp
#include <hip/hip_runtime.h>
#include <cstdio>
#include <cstdint>

#ifndef MK_ALIGN
#define MK_ALIGN true
#endif
#ifndef MK_SP2
#define MK_SP2 true
#endif
#ifndef MK_TS
#define MK_TS 0
#endif
#ifndef MK_TS_A
#define MK_TS_A 0
#define MK_TS_B 1
#endif
#ifndef MK_REP_PHASE
#define MK_REP_PHASE -1
#endif
#ifndef MK_REP_DUMMY
#define MK_REP_DUMMY 0
#endif
#ifndef MK_REP_N
#define MK_REP_N 3
#endif
#ifndef MK_ENDFLUSH
#define MK_ENDFLUSH 0
#endif
#ifndef MK_MULTI
#define MK_MULTI 0
#endif

#define LAS __attribute__((address_space(3)))
typedef unsigned short bf16_t;
typedef short bf16x8 __attribute__((ext_vector_type(8)));
typedef float f32x4 __attribute__((ext_vector_type(4)));
typedef float f32x2 __attribute__((ext_vector_type(2)));
typedef unsigned u32x4 __attribute__((ext_vector_type(4)));
typedef unsigned u32x2 __attribute__((ext_vector_type(2)));

constexpr int SEQ = 8192, DM = 2048, NIN = 13312, HW = 1024, PLE = 256;
constexpr float EPS = 1e-6f;
constexpr int NPHASE = 15;

constexpr size_t MiB = 1u << 20;
constexpr size_t WS_CTL = 0, CTL_ZERO_BYTES = 1 * MiB;
constexpr size_t WS_LOWER = 1 * MiB;
constexpr size_t WS_SSQ = 1 * MiB + 64 * 1024;
constexpr size_t WS_DD = 2 * MiB;
constexpr size_t WS_EE = 3 * MiB;
constexpr size_t WS_WIN = 4 * MiB;
constexpr size_t WS_WA = 108 * MiB;
constexpr size_t WS_WB = 116 * MiB;
constexpr size_t WS_WO = 124 * MiB;
constexpr size_t WS_WG = 140 * MiB;
constexpr size_t WS_WP = 156 * MiB;
constexpr size_t WS_PB = 158 * MiB;
constexpr size_t WS_XGA = 166 * MiB;
constexpr size_t WS_XGB = 198 * MiB;
constexpr size_t WS_QH = 230 * MiB;
constexpr size_t WS_VH = 246 * MiB;
constexpr size_t WS_KF = 262 * MiB;
constexpr size_t WS_KB = 278 * MiB;
constexpr size_t WS_HG = 294 * MiB;
constexpr size_t WS_NQ = 310 * MiB;
constexpr size_t WS_NK = 326 * MiB;
constexpr size_t WS_VT = 342 * MiB;
constexpr size_t WS_NG = 358 * MiB;
constexpr size_t WS_OA = 374 * MiB;
constexpr size_t WS_OB = 390 * MiB;
constexpr size_t WS_GF = 406 * MiB;
constexpr size_t WS_GB = 438 * MiB;
constexpr size_t WS_MA = 470 * MiB;
constexpr size_t WS_MB = 502 * MiB;
constexpr size_t WS_LT = 534 * MiB;
constexpr size_t WS_SP = WS_LT;
constexpr size_t WS_T = 662 * MiB;
constexpr size_t WS_Y = 694 * MiB;
constexpr size_t WS_PL = 726 * MiB;
constexpr size_t WS_END = 758 * MiB;

constexpr int LDS_BYTES = 147456;
constexpr int LDS_MISC_OFF = 131072;

typedef __bf16 bf16x2_t __attribute__((ext_vector_type(2)));
__device__ __forceinline__ unsigned cvt_pk_bf16(float lo, float hi) { bf16x2_t v = {(__bf16)lo, (__bf16)hi}; return __builtin_bit_cast(unsigned, v); }
__device__ __forceinline__ float bf2f(unsigned short b) { return __uint_as_float(((unsigned)b) << 16); }
__device__ __forceinline__ float bflo(unsigned w) { return __uint_as_float(w << 16); }
__device__ __forceinline__ float bfhi(unsigned w) { return __uint_as_float(w & 0xffff0000u); }
__device__ __forceinline__ unsigned short f2bf1(float f) { return (unsigned short)(cvt_pk_bf16(f, 0.f) & 0xffffu); }
typedef _Float16 f16x2_t __attribute__((ext_vector_type(2)));
__device__ __forceinline__ unsigned cvt_pk_f16(float lo, float hi) { f16x2_t v = {(_Float16)lo, (_Float16)hi}; return __builtin_bit_cast(unsigned, v); }
__device__ __forceinline__ float f16_to_f32(unsigned short h) { return (float)__builtin_bit_cast(_Float16, h); }
__device__ __forceinline__ float fast_rcp(float x) { return __builtin_amdgcn_rcpf(x); }
__device__ __forceinline__ float sigmoid_f(float x) { return fast_rcp(1.f + __expf(-x)); }
__device__ __forceinline__ float silu_f(float x) { return x * sigmoid_f(x); }

__device__ __forceinline__ int opaque_tid(int wid_s) { int lane; asm volatile("v_mbcnt_lo_u32_b32 %0, -1, 0\n\tv_mbcnt_hi_u32_b32 %0, -1, %0" : "=v"(lane)); asm volatile("" : "+s"(wid_s)); return wid_s * 64 + lane; }
__device__ __forceinline__ unsigned char* opaque_ptr(unsigned char* p) { asm volatile("" : "+s"(p)); return p; }
__device__ __forceinline__ int opaque_bid() { int b = blockIdx.x; asm volatile("" : "+s"(b)); return b; }
namespace pg8 {
#define PG8_LAS __attribute__((address_space(3)))
constexpr int BM = 256, BK = 64, HALF = 128, HTB = HALF * BK * 2, STAGE_BYTES = 8 * HTB, NXCD = 8, WGM = 8;
__host__ __device__ __forceinline__ int lds_byte(int r, int c) { const int st = (r >> 4) * 2 + (c >> 5), rr = r & 15, cc = c & 31, ob = rr * 64 + cc * 2; return st * 1024 + (ob ^ (((ob >> 9) & 1) << 5)); }
__host__ __device__ __forceinline__ void stage_rc(int b, int& R, int& C) { const int st = b / 1024, sb = b % 1024, swz = sb ^ (((sb >> 9) & 1) << 5); R = (st >> 1) * 16 + swz / 64; C = (st & 1) * 32 + (swz % 64) / 2; }
__host__ __device__ __forceinline__ int perm32(int rho) { const int n = rho >> 4, i = rho & 15; return 8 * (i >> 2) + 4 * n + (i & 3); }

struct Unit { int pm, pn, z; };
struct Gemm { const bf16_t* A; const bf16_t* Bt; int M, N, K; const bf16_t* A2; const bf16_t* Bt2; };

struct StaticOrder {
    int nM, nN, nwg, G, c;
    __host__ __device__ void init(int M, int N, int G_, int c_) { nM = M / BM; nN = N / BM; nwg = nM * nN; G = G_; c = c_; }
    __host__ __device__ bool next(int i, Unit& u) const {
        const long L = (long)i * G + c; if (L >= nwg) return false;
        int wgid = (int)L; { const int q = nwg / NXCD, r = nwg % NXCD, xcd = wgid % NXCD, off = wgid / NXCD; wgid = (xcd < r ? xcd * (q + 1) : r * (q + 1) + (xcd - r) * q) + off; }
        const int nig = WGM * nN, gid = wgid / nig, fm = gid * WGM, gsz = (nM - fm) < WGM ? (nM - fm) : WGM;
        u.pm = fm + ((wgid % nig) % gsz); u.pn = (wgid % nig) / gsz; u.z = 0; return true;
    }
    __device__ __forceinline__ void a_ready(const Unit&) const {}
    __device__ __forceinline__ void done(const Unit&) const {}
};
struct PairOrder : StaticOrder {
    __host__ __device__ bool next(int i, Unit& u) const { const bool ok = StaticOrder::next(i >> 1, u); u.z = i & 1; return ok; }
};

template <class Epi, class Sched, bool ALIGN_EPI = MK_ALIGN, bool SP2 = MK_SP2>
__device__ __forceinline__ void gemm_phase(PG8_LAS unsigned char* lds, const Gemm g, const Sched& S, const Epi& E, int wid_s) {
    const int tid = opaque_tid(wid_s), wid = __builtin_amdgcn_readfirstlane(tid >> 6), lane = tid & 63, wr = wid >> 2, wc = wid & 3, fr = lane & 15, fq = lane >> 4;
    const int K = g.K, nt = K / BK;
    unsigned voffA[2], voffB[2];
#pragma unroll
    for (int i = 0; i < 2; ++i) { int R, C; stage_rc(tid * 16 + i * 8192, R, C); const int Rb = Epi::PERM ? ((R & ~31) + perm32(R & 31)) : R;
        voffA[i] = (unsigned)(R * K + C) * 2u; voffB[i] = (unsigned)(Rb * K + C) * 2u; }
    const size_t kstep = (size_t)(BK * 2);
    const size_t hstep = (size_t)HALF * K * 2;
    const size_t tstep = 2 * hstep;
    const unsigned ldsw = (unsigned)wid * 1024u;
    const int aoff = lds_byte(wr * 64 + fr, fq * 8), boff = lds_byte(wc * 32 + fr, fq * 8);
#define PG8_SA(b, h) (((b) * 2 + (h)) * HTB)
#define PG8_SB(b, h) ((4 + (b) * 2 + (h)) * HTB)
#define PG8_STAGE(bufoff, gbase, voff) do { _Pragma("unroll") for (int _i = 0; _i < 2; ++_i) \
        __builtin_amdgcn_global_load_lds((const unsigned*)((const char*)(gbase) + (voff)[_i]), (PG8_LAS unsigned*)(lds + (bufoff) + ldsw + _i * 8192), 16, 0, 0); } while (0)
#define PG8_LDA(dst, b, h) do { _Pragma("unroll") for (int m = 0; m < 4; ++m) _Pragma("unroll") for (int k = 0; k < 2; ++k) dst[m][k] = *(const PG8_LAS bf16x8*)(lds + PG8_SA(b, h) + aoff + m * 2048 + k * 1024); } while (0)
#define PG8_LDB(dst, b, h) do { _Pragma("unroll") for (int n = 0; n < 2; ++n) _Pragma("unroll") for (int k = 0; k < 2; ++k) dst[n][k] = *(const PG8_LAS bf16x8*)(lds + PG8_SB(b, h) + boff + n * 2048 + k * 1024); } while (0)
#define PG8_MMA(ai, bj, At, Bt) do { __builtin_amdgcn_s_setprio(1); _Pragma("unroll") for (int m = 0; m < 4; ++m) _Pragma("unroll") for (int n = 0; n < 2; ++n) _Pragma("unroll") for (int k = 0; k < 2; ++k) \
        acc[ai][bj][m][n] = __builtin_amdgcn_mfma_f32_16x16x32_bf16(Bt[n][k], At[m][k], acc[ai][bj][m][n], 0, 0, 0); __builtin_amdgcn_s_setprio(0); } while (0)
#define PG8_WAIT_V(n) asm volatile("s_waitcnt vmcnt(" #n ")" ::: "memory")
#define PG8_WAIT_L(n) asm volatile("s_waitcnt lgkmcnt(" #n ")" ::: "memory")
#define PG8_BAR __builtin_amdgcn_s_barrier()
#define PG8_SCHED __builtin_amdgcn_sched_barrier(0)
    Unit cur, nxt; int ui = 0;
    if (!S.next(0, cur)) return;
    f32x4 acc[2][2][4][2];
#pragma unroll
    for (int a = 0; a < 2; ++a)
#pragma unroll
        for (int b = 0; b < 2; ++b)
#pragma unroll
            for (int m = 0; m < 4; ++m)
#pragma unroll
                for (int n = 0; n < 2; ++n) acc[a][b][m][n] = (f32x4){0.f, 0.f, 0.f, 0.f};
    bf16x8 At[4][2], B0[2][2], B1[2][2];
    const char* cA = (const char*)(cur.z ? g.A2 : g.A) + (size_t)cur.pm * tstep; const char* cB = (const char*)(cur.z ? g.Bt2 : g.Bt) + (size_t)cur.pn * tstep;
    S.a_ready(cur);
    if constexpr (SP2) {
        PG8_STAGE(PG8_SB(0, 0), cB, voffB); PG8_STAGE(PG8_SB(0, 1), cB + hstep, voffB); PG8_STAGE(PG8_SA(0, 0), cA, voffA); PG8_STAGE(PG8_SA(0, 1), cA + hstep, voffA);
        if (wr == 1) PG8_BAR;
        PG8_WAIT_V(2); PG8_BAR;
        PG8_STAGE(PG8_SB(1, 0), cB + kstep, voffB); PG8_STAGE(PG8_SA(1, 0), cA + kstep, voffA); PG8_STAGE(PG8_SB(1, 1), cB + hstep + kstep, voffB);
        PG8_WAIT_V(6); PG8_BAR;
    } else {
        PG8_STAGE(PG8_SB(0, 0), cB, voffB); PG8_STAGE(PG8_SA(0, 0), cA, voffA); PG8_STAGE(PG8_SB(0, 1), cB + hstep, voffB); PG8_STAGE(PG8_SA(0, 1), cA + hstep, voffA);
        if (wr == 1) PG8_BAR;
        PG8_WAIT_V(4); PG8_BAR;
        PG8_STAGE(PG8_SB(1, 0), cB + kstep, voffB); PG8_STAGE(PG8_SA(1, 0), cA + kstep, voffA); PG8_STAGE(PG8_SB(1, 1), cB + hstep + kstep, voffB);
        PG8_WAIT_V(6); PG8_BAR;
    }
    for (;;) {
        const bool has_next = S.next(ui + 1, nxt);
        const char* nA = has_next ? (const char*)(nxt.z ? g.A2 : g.A) + (size_t)nxt.pm * tstep : cA; const char* nB = has_next ? (const char*)(nxt.z ? g.Bt2 : g.Bt) + (size_t)nxt.pn * tstep : cB;
        for (int t = 0; t < nt; t += 2) {
            const bool last = (t == nt - 2);
            const char* a1 = cA + (size_t)(t + 1) * kstep;
            const char* a2 = last ? nA : cA + (size_t)(t + 2) * kstep; const char* b2 = last ? nB : cB + (size_t)(t + 2) * kstep;
            const char* a3 = a2 + kstep; const char* b3 = b2 + kstep;
            if (last && has_next) S.a_ready(nxt);
            if constexpr (SP2) {
            PG8_LDB(B0, 0, 0); PG8_LDB(B1, 0, 1); PG8_SCHED; PG8_LDA(At, 0, 0); PG8_STAGE(PG8_SA(1, 1), a1 + hstep, voffA);
            PG8_WAIT_V(8); PG8_WAIT_L(0); PG8_BAR; PG8_MMA(0, 0, At, B0); PG8_MMA(0, 1, At, B1); PG8_BAR; PG8_SCHED;
            PG8_LDA(At, 0, 1); PG8_STAGE(PG8_SB(0, 0), b2, voffB); PG8_STAGE(PG8_SB(0, 1), b2 + hstep, voffB); PG8_STAGE(PG8_SA(0, 0), a2, voffA);
            PG8_WAIT_V(8); PG8_WAIT_L(0); PG8_BAR; PG8_MMA(1, 0, At, B0); PG8_MMA(1, 1, At, B1); PG8_BAR; PG8_SCHED;
            PG8_LDB(B0, 1, 0); PG8_LDB(B1, 1, 1); PG8_SCHED; PG8_LDA(At, 1, 0); PG8_STAGE(PG8_SA(0, 1), a2 + hstep, voffA);
            PG8_WAIT_V(8); PG8_WAIT_L(0); PG8_BAR; PG8_MMA(0, 0, At, B0); PG8_MMA(0, 1, At, B1); PG8_BAR; PG8_SCHED;
            PG8_LDA(At, 1, 1); PG8_STAGE(PG8_SB(1, 0), b3, voffB); PG8_STAGE(PG8_SB(1, 1), b3 + hstep, voffB); PG8_STAGE(PG8_SA(1, 0), a3, voffA);
            PG8_WAIT_V(8); PG8_WAIT_L(0); PG8_BAR; PG8_MMA(1, 0, At, B0); PG8_MMA(1, 1, At, B1); PG8_BAR; PG8_SCHED;
            } else {
            PG8_LDB(B0, 0, 0); PG8_SCHED; PG8_LDA(At, 0, 0); PG8_STAGE(PG8_SA(1, 1), a1 + hstep, voffA);
            PG8_WAIT_L(8); PG8_BAR; PG8_WAIT_L(0); PG8_MMA(0, 0, At, B0); PG8_BAR; PG8_SCHED;
            PG8_LDB(B1, 0, 1); PG8_STAGE(PG8_SB(0, 0), b2, voffB);
            PG8_BAR; PG8_WAIT_L(0); PG8_MMA(0, 1, At, B1); PG8_BAR;
            PG8_LDA(At, 0, 1); PG8_STAGE(PG8_SA(0, 0), a2, voffA);
            PG8_BAR; PG8_WAIT_L(0); PG8_MMA(1, 0, At, B0); PG8_BAR; PG8_SCHED;
            PG8_STAGE(PG8_SB(0, 1), b2 + hstep, voffB);
            PG8_WAIT_V(6); PG8_BAR; PG8_MMA(1, 1, At, B1); PG8_BAR;
            PG8_LDB(B0, 1, 0); PG8_SCHED; PG8_LDA(At, 1, 0); PG8_STAGE(PG8_SA(0, 1), a2 + hstep, voffA);
            PG8_WAIT_L(8); PG8_BAR; PG8_WAIT_L(0); PG8_MMA(0, 0, At, B0); PG8_BAR; PG8_SCHED;
            PG8_LDB(B1, 1, 1); PG8_STAGE(PG8_SB(1, 0), b3, voffB);
            PG8_BAR; PG8_WAIT_L(0); PG8_MMA(0, 1, At, B1); PG8_BAR;
            PG8_LDA(At, 1, 1); PG8_STAGE(PG8_SA(1, 0), a3, voffA);
            PG8_BAR; PG8_WAIT_L(0); PG8_MMA(1, 0, At, B0); PG8_BAR; PG8_SCHED;
            PG8_STAGE(PG8_SB(1, 1), b3 + hstep, voffB);
            PG8_WAIT_V(6); PG8_BAR; PG8_MMA(1, 1, At, B1); PG8_BAR;
            }
        }
        if constexpr (ALIGN_EPI) { if (wr == 0) PG8_BAR; }
        { const int t2 = opaque_tid(wid_s), w2 = __builtin_amdgcn_readfirstlane(t2 >> 6); E(acc, cur, w2 >> 2, w2 & 3, t2 & 15, (t2 & 63) >> 4); }
        if (!has_next) break;
#pragma unroll
        for (int a = 0; a < 2; ++a)
#pragma unroll
            for (int b = 0; b < 2; ++b)
#pragma unroll
                for (int m = 0; m < 4; ++m)
#pragma unroll
                    for (int n = 0; n < 2; ++n) acc[a][b][m][n] = (f32x4){0.f, 0.f, 0.f, 0.f};
        cur = nxt; cA = nA; cB = nB; ++ui;
        if constexpr (ALIGN_EPI) { if (wr == 1) PG8_BAR; }
    }
    PG8_WAIT_V(0);
    if constexpr (!ALIGN_EPI) { if (wr == 0) PG8_BAR; }
    PG8_BAR;
#undef PG8_SA
#undef PG8_SB
#undef PG8_STAGE
#undef PG8_LDA
#undef PG8_LDB
#undef PG8_MMA
#undef PG8_WAIT_V
#undef PG8_WAIT_L
#undef PG8_BAR
#undef PG8_SCHED
}
}

typedef f32x4 AccT[2][2][4][2];

#define GAS __attribute__((address_space(1)))
#ifndef MK_SC1
#define MK_SC1 0
#endif
__device__ __forceinline__ void stg16(void* p, u32x4 w) {
#if MK_SC1
    asm volatile("global_store_dwordx4 %0, %1, off sc1\n\ts_nop 1" :: "v"((GAS void*)p), "v"(w) : "memory");
#else
    *(GAS u32x4*)p = w;
#endif
}
__device__ __forceinline__ void store8_bf16(bf16_t* p, const float (&v)[8]) {
    u32x4 w; w.x = cvt_pk_bf16(v[0], v[1]); w.y = cvt_pk_bf16(v[2], v[3]); w.z = cvt_pk_bf16(v[4], v[5]); w.w = cvt_pk_bf16(v[6], v[7]);
    stg16(p, w);
}
__device__ __forceinline__ void cvt8_bf16(const u32x4 w, float (&v)[8]) {
    v[0] = bflo(w.x); v[1] = bfhi(w.x); v[2] = bflo(w.y); v[3] = bfhi(w.y); v[4] = bflo(w.z); v[5] = bfhi(w.z); v[6] = bflo(w.w); v[7] = bfhi(w.w);
}
__device__ __forceinline__ u32x4 ldg16(const void* p) { return *(const GAS u32x4*)p; }
__device__ __forceinline__ f32x4 ldgf4(const float* p) { return *(const GAS f32x4*)p; }
__device__ __forceinline__ float ldgf(const float* p) { return *(const GAS float*)p; }
__device__ __forceinline__ void load8_bf16(const bf16_t* p, float (&v)[8]) { cvt8_bf16(ldg16(p), v); }
__device__ __forceinline__ void store8_f32(float* p, const float (&v)[8]) {
    stg16(p, __builtin_bit_cast(u32x4, (f32x4){v[0], v[1], v[2], v[3]})); stg16(p + 4, __builtin_bit_cast(u32x4, (f32x4){v[4], v[5], v[6], v[7]}));
}
__device__ __forceinline__ void load8_f32(const float* p, float (&v)[8]) {
    const f32x4 a = ldgf4(p), b = ldgf4(p + 4);
    v[0] = a[0]; v[1] = a[1]; v[2] = a[2]; v[3] = a[3]; v[4] = b[0]; v[5] = b[1]; v[6] = b[2]; v[7] = b[3];
}
__device__ __forceinline__ void acc8(const AccT& acc, int ai, int bj, int m, float (&v)[8]) {
    const f32x4 a = acc[ai][bj][m][0], b = acc[ai][bj][m][1];
    v[0] = a[0]; v[1] = a[1]; v[2] = a[2]; v[3] = a[3]; v[4] = b[0]; v[5] = b[1]; v[6] = b[2]; v[7] = b[3];
}
#define EPI_FENCE() asm volatile("" ::: "memory")
__device__ __forceinline__ void load_rs8(const float* ssq, int row0, float (&rs)[8]) {
#pragma unroll
    for (int i = 0; i < 8; ++i) rs[i] = ldgf(ssq + row0 + (i >> 2) * 128 + (i & 3) * 16);
#pragma unroll
    for (int i = 0; i < 8; ++i) rs[i] = rsqrtf(rs[i] * (1.0f / DM) + EPS);
}

template <int ACT> __device__ __forceinline__ void epi_plain(const AccT& acc, const float (&rs)[8], bf16_t* dst, int ld, int row0, int c0) {
#pragma unroll
    for (int ai = 0; ai < 2; ++ai)
#pragma unroll
        for (int m = 0; m < 4; ++m) {
            const int row = row0 + ai * 128 + m * 16; const float r = rs[ai * 4 + m];
#pragma unroll
            for (int bj = 0; bj < 2; ++bj) { float v[8]; acc8(acc, ai, bj, m, v);
#pragma unroll
                for (int e = 0; e < 8; ++e) { float z = v[e] * r; if (ACT == 1) z = silu_f(z); if (ACT == 2) z = sigmoid_f(z); v[e] = z; }
                store8_bf16(dst + (size_t)row * ld + c0 + bj * 128, v); }
        }
}
struct EpiInProj {
    static constexpr bool PERM = true;
    const float* ssq; const float* lower; unsigned char* ws;
    __device__ __forceinline__ void operator()(const AccT& acc, const pg8::Unit& u, int wr, int wc, int fr, int fq) const {
        const int colt = u.pn * 256, seg = colt >> 10;
        const int row0 = u.pm * 256 + wr * 64 + fr;
        const int cin = wc * 32 + 8 * fq;
        const int cseg = (colt & 1023) + cin;
        float rs[8]; load_rs8(ssq, row0, rs);
        if (seg == 2 || seg == 3) {
            const int dir = seg - 2;
            unsigned short* G = (unsigned short*)(ws + (dir ? WS_GB : WS_GF)); bf16_t* KK = (bf16_t*)(ws + (dir ? WS_KB : WS_KF));
#pragma unroll
            for (int bj = 0; bj < 2; ++bj) {
                const int c = cseg + bj * 128; float lb[8]; load8_f32(lower + dir * 1024 + c, lb);
#pragma unroll
                for (int ai = 0; ai < 2; ++ai)
#pragma unroll
                    for (int m = 0; m < 4; ++m) {
                        const int row = row0 + ai * 128 + m * 16; const float r = rs[ai * 4 + m];
                        float v[8], lg[8], kk[8]; acc8(acc, ai, bj, m, v);
#pragma unroll
                        for (int e = 0; e < 8; ++e) { const float z = v[e] * r; const float sg = sigmoid_f(z); const float f = lb[e] + (1.f - lb[e]) * sg;
                            lg[e] = __logf(fmaxf(f, 1e-6f)); kk[e] = (1.f - lb[e]) * fast_rcp(1.f + __expf(z)); }
                        { u32x4 wg; wg.x = cvt_pk_f16(lg[0], lg[1]); wg.y = cvt_pk_f16(lg[2], lg[3]); wg.z = cvt_pk_f16(lg[4], lg[5]); wg.w = cvt_pk_f16(lg[6], lg[7]); *(GAS u32x4*)(G + (size_t)row * HW + c) = wg; }
                        store8_bf16(KK + (size_t)row * HW + c, kk);
                    }
            }
        } else if (seg == 7) {
            bf16_t* VT = (bf16_t*)(ws + WS_VT);
#pragma unroll
            for (int ai = 0; ai < 2; ++ai)
#pragma unroll
                for (int m = 0; m < 4; ++m) {
                    const int row = row0 + ai * 128 + m * 16; const float r = rs[ai * 4 + m];
#pragma unroll
                    for (int bj = 0; bj < 2; ++bj) { float v[8]; acc8(acc, ai, bj, m, v); const int c = cseg + bj * 128;
#pragma unroll
                        for (int e = 0; e < 8; ++e) *(GAS bf16_t*)(VT + (size_t)(c + e) * SEQ + row) = f2bf1(v[e] * r); }
                }
        } else if (seg == 0) epi_plain<1>(acc, rs, (bf16_t*)(ws + WS_QH), HW, row0, cseg);
        else if (seg == 1) epi_plain<0>(acc, rs, (bf16_t*)(ws + WS_VH), HW, row0, cseg);
        else if (seg == 4) epi_plain<1>(acc, rs, (bf16_t*)(ws + WS_HG), HW, row0, cseg);
        else if (seg == 5) epi_plain<0>(acc, rs, (bf16_t*)(ws + WS_NQ), HW, row0, cseg);
        else if (seg == 6) epi_plain<0>(acc, rs, (bf16_t*)(ws + WS_NK), HW, row0, cseg);
        else if (seg == 8) epi_plain<1>(acc, rs, (bf16_t*)(ws + WS_NG), HW, row0, cseg);
        else if (seg < 11) epi_plain<2>(acc, rs, (bf16_t*)(ws + WS_MA), DM, row0, colt - 9216 + cin);
        else epi_plain<2>(acc, rs, (bf16_t*)(ws + WS_MB), DM, row0, colt - 11264 + cin);
    }
};

#define EPI_IT(it, ai, m, bj) const int ai = (it) >> 3, m = ((it) >> 1) & 3, bj = (it) & 1
struct EpiBranch {
    static constexpr bool PERM = true;
    const bf16_t* MA; const bf16_t* MB; bf16_t* T; bf16_t* Y;
    __device__ __forceinline__ void operator()(const AccT& acc, const pg8::Unit& u, int wr, int wc, int fr, int fq) const {
        const int row0 = u.pm * 256 + wr * 64 + fr, c0 = u.pn * 256 + wc * 32 + 8 * fq;
        if (u.z == 0) {
            u32x4 g[2];
            g[0] = ldg16(MA + (size_t)row0 * DM + c0);
#pragma unroll
            for (int it = 0; it < 16; ++it) { EPI_IT(it, ai, m, bj);
                const size_t off = (size_t)(row0 + ai * 128 + m * 16) * DM + c0 + bj * 128;
                if (it + 1 < 16) { EPI_IT(it + 1, ai2, m2, bj2); g[(it + 1) & 1] = ldg16(MA + (size_t)(row0 + ai2 * 128 + m2 * 16) * DM + c0 + bj2 * 128); }
                float v[8], gg[8]; acc8(acc, ai, bj, m, v); cvt8_bf16(g[it & 1], gg);
#pragma unroll
                for (int e = 0; e < 8; ++e) v[e] *= gg[e];
                store8_bf16(T + off, v); EPI_FENCE(); }
        } else {
            u32x4 g[2], t[2];
            { const size_t o = (size_t)row0 * DM + c0; g[0] = ldg16(MB + o); t[0] = ldg16(T + o); }
#pragma unroll
            for (int it = 0; it < 16; ++it) { EPI_IT(it, ai, m, bj);
                const size_t off = (size_t)(row0 + ai * 128 + m * 16) * DM + c0 + bj * 128;
                if (it + 1 < 16) { EPI_IT(it + 1, ai2, m2, bj2); const size_t o = (size_t)(row0 + ai2 * 128 + m2 * 16) * DM + c0 + bj2 * 128; const int b = (it + 1) & 1;
                    g[b] = ldg16(MB + o); t[b] = ldg16(T + o); }
                float v[8], gg[8], tt[8]; acc8(acc, ai, bj, m, v); cvt8_bf16(g[it & 1], gg); cvt8_bf16(t[it & 1], tt);
#pragma unroll
                for (int e = 0; e < 8; ++e) v[e] = tt[e] + v[e] * gg[e];
                store8_bf16(Y + off, v); EPI_FENCE(); }
        }
    }
};
struct EpiWout {
    static constexpr bool PERM = true;
    const bf16_t* xin; bf16_t* XB1; float* ssq_out;
    __device__ __forceinline__ void operator()(const AccT& acc, const pg8::Unit& u, int wr, int wc, int fr, int fq) const {
        const int row0 = u.pm * 256 + wr * 64 + fr, c0 = u.pn * 256 + wc * 32 + 8 * fq;
        u32x4 xb[2];
        xb[0] = ldg16(xin + (size_t)row0 * DM + c0);
        float s = 0.f;
#pragma unroll
        for (int it = 0; it < 16; ++it) { EPI_IT(it, ai, m, bj);
            const int row = row0 + ai * 128 + m * 16; const size_t off = (size_t)row * DM + c0 + bj * 128;
            if (it + 1 < 16) { EPI_IT(it + 1, ai2, m2, bj2); xb[(it + 1) & 1] = ldg16(xin + (size_t)(row0 + ai2 * 128 + m2 * 16) * DM + c0 + bj2 * 128); }
            float v[8], xi[8]; acc8(acc, ai, bj, m, v); cvt8_bf16(xb[it & 1], xi);
#pragma unroll
            for (int e = 0; e < 8; ++e) { v[e] += xi[e]; s += v[e] * v[e]; }
            store8_bf16(XB1 + off, v);
            if (bj == 1) { s += __shfl_xor(s, 16); s += __shfl_xor(s, 32); if (fq == 0) atomicAdd(ssq_out + row, s); s = 0.f; }
            EPI_FENCE(); }
    }
};
struct EpiDummy {
    static constexpr bool PERM = true;
    bf16_t* D;
    __device__ __forceinline__ void operator()(const AccT& acc, const pg8::Unit& u, int wr, int wc, int fr, int fq) const {
#if MK_REP_DUMMY == 2
#pragma unroll
        for (int ai = 0; ai < 2; ++ai)
#pragma unroll
            for (int bj = 0; bj < 2; ++bj)
#pragma unroll
                for (int m = 0; m < 4; ++m) { asm volatile("" :: "v"(acc[ai][bj][m][0]), "v"(acc[ai][bj][m][1])); }
#else
        const int row0 = u.pm * 256 + wr * 64 + fr, c0 = (u.pn & 3) * 256 + wc * 32 + 8 * fq;
#pragma unroll
        for (int ai = 0; ai < 2; ++ai)
#pragma unroll
            for (int m = 0; m < 4; ++m) { const int row = row0 + ai * 128 + m * 16;
#pragma unroll
                for (int bj = 0; bj < 2; ++bj) { float v[8]; acc8(acc, ai, bj, m, v); store8_bf16(D + (size_t)row * HW + c0 + bj * 128, v); } }
#endif
    }
};
struct EpiPL {
    static constexpr bool PERM = true;
    bf16_t* PL;
    __device__ __forceinline__ void operator()(const AccT& acc, const pg8::Unit& u, int wr, int wc, int fr, int fq) const {
        const int row0 = u.pm * 256 + wr * 64 + fr, c0 = u.pn * 256 + wc * 32 + 8 * fq;
#pragma unroll
        for (int ai = 0; ai < 2; ++ai)
#pragma unroll
            for (int m = 0; m < 4; ++m) { const int row = row0 + ai * 128 + m * 16;
#pragma unroll
                for (int bj = 0; bj < 2; ++bj) { float v[8]; acc8(acc, ai, bj, m, v); store8_bf16(PL + (size_t)row * DM + c0 + bj * 128, v); } }
    }
};
struct EpiGate {
    static constexpr bool PERM = true;
    const float* ssq1; const bf16_t* XB1; const bf16_t* PL; float* xout; bf16_t* XBN; float* ssq_next; int has_next;
    __device__ __forceinline__ void operator()(const AccT& acc, const pg8::Unit& u, int wr, int wc, int fr, int fq) const {
        const int row0 = u.pm * 256 + wr * 64 + fr, c0 = u.pn * 256 + wc * 32 + 8 * fq;
        u32x4 xb[2], pb[2]; float sq[2];
        { const size_t o = (size_t)row0 * DM + c0; xb[0] = ldg16(XB1 + o); pb[0] = ldg16(PL + o); sq[0] = ldgf(ssq1 + row0); }
        float s = 0.f;
#pragma unroll
        for (int it = 0; it < 16; ++it) { EPI_IT(it, ai, m, bj);
            const int row = row0 + ai * 128 + m * 16; const size_t off = (size_t)row * DM + c0 + bj * 128;
            if (it + 1 < 16) { EPI_IT(it + 1, ai2, m2, bj2); const int rown = row0 + ai2 * 128 + m2 * 16; const size_t o = (size_t)rown * DM + c0 + bj2 * 128; const int b = (it + 1) & 1;
                xb[b] = ldg16(XB1 + o); pb[b] = ldg16(PL + o); sq[b] = ldgf(ssq1 + rown); }
            const float r = rsqrtf(sq[it & 1] * (1.0f / DM) + EPS);
            float v[8], x1[8], pl[8]; acc8(acc, ai, bj, m, v); cvt8_bf16(xb[it & 1], x1); cvt8_bf16(pb[it & 1], pl);
#pragma unroll
            for (int e = 0; e < 8; ++e) { const float g = sigmoid_f(v[e] * r); v[e] = x1[e] + pl[e] * g; s += v[e] * v[e]; }
            if (has_next) { store8_bf16(XBN + off, v);
                if (bj == 1) { s += __shfl_xor(s, 16); s += __shfl_xor(s, 32); if (fq == 0) atomicAdd(ssq_next + row, s); s = 0.f; } }
            else store8_f32(xout + off, v);
            EPI_FENCE(); }
    }
};

#define XB_TMO      128
#define XB_XCNT(j)  (256  + 64 * (j))
#define XB_XSUB(j)  (1280 + 64 * (j))
#define XB_XGEN(j)  (2304 + 64 * (j))
#define XB_TOP      3328
#define XB_TOPGEN   3392
#define XCD_BAR_WORDS 3456
#define XB_SPIN_CAP (1u << 18)
__device__ __forceinline__ unsigned xb_ld(unsigned* p)              { return __hip_atomic_load(p, __ATOMIC_RELAXED, __HIP_MEMORY_SCOPE_AGENT); }
__device__ __forceinline__ unsigned xb_add(unsigned* p, unsigned v) { return __hip_atomic_fetch_add(p, v, __ATOMIC_RELAXED, __HIP_MEMORY_SCOPE_AGENT); }
__device__ __forceinline__ unsigned xb_xcc_id() { return (unsigned)__builtin_amdgcn_s_getreg((3 << 11) | 20) & 0xFu; }
#define XB_SPIN(cond, bar) do { unsigned _sp = 0; while (cond) { __builtin_amdgcn_s_sleep(1); \
    if ((++_sp & 255u) == 0u) { if (xb_ld(&(bar)[XB_TMO])) break; if (_sp > XB_SPIN_CAP) { atomicAdd(&(bar)[XB_TMO], 1u); break; } } } } while (0)
struct XcdBarrier { unsigned* bar; unsigned x; volatile LAS unsigned* st; };
__device__ __forceinline__ XcdBarrier xcd_barrier_post(unsigned* bar, volatile LAS unsigned* st) {
    XcdBarrier b; b.bar = bar; b.x = xb_xcc_id(); b.st = st;
    if (threadIdx.x == 0) (void)xb_add(&bar[XB_XCNT(b.x)], 1u);
    return b;
}
__device__ __forceinline__ void xcd_barrier_complete(unsigned* bar, unsigned x, unsigned& nloc, unsigned& nx) {
    const unsigned G = gridDim.x * gridDim.y * gridDim.z;
    unsigned sum, cnt, mine, sp = 0u;
    for (;;) {
        sum = 0u; cnt = 0u; mine = 0u;
#pragma unroll
        for (unsigned j = 0; j < 16; ++j) { const unsigned c = xb_ld(&bar[XB_XCNT(j)]); sum += c; cnt += (c > 0u) ? 1u : 0u; mine = (j == x) ? c : mine; }
        if (sum == G) break;
        __builtin_amdgcn_s_sleep(1);
        if ((++sp & 255u) == 0u) { if (xb_ld(&bar[XB_TMO])) break; if (sp > XB_SPIN_CAP) { atomicAdd(&bar[XB_TMO], 1u); break; } }
    }
    nloc = mine > 0u ? mine : 1u; nx = cnt > 0u ? cnt : 1u;
}
__device__ __forceinline__ void xcd_barrier(const XcdBarrier& b) {
    asm volatile("s_waitcnt vmcnt(0)" ::: "memory");
    __syncthreads();
    if (threadIdx.x == 0) {
        unsigned* bar = b.bar;
        __builtin_amdgcn_s_waitcnt(0);
        unsigned nloc = b.st[0], nx = b.st[1];
        if (nloc == 0u) { xcd_barrier_complete(bar, b.x, nloc, nx); b.st[0] = nloc; b.st[1] = nx; }
        const unsigned old = xb_add(&bar[XB_XSUB(b.x)], 1u);
        const unsigned gen = old / nloc;
        if (old + 1u == (gen + 1u) * nloc) {
            __builtin_amdgcn_fence(__ATOMIC_RELEASE, "agent");
            asm volatile("s_waitcnt vmcnt(0)" ::: "memory");
            const unsigned og = xb_add(&bar[XB_TOP], 1u);
            const unsigned tg = og / nx;
            if (og + 1u == (tg + 1u) * nx) xb_add(&bar[XB_TOPGEN], 1u);
            else XB_SPIN(xb_ld(&bar[XB_TOPGEN]) == tg, bar);
            __builtin_amdgcn_fence(__ATOMIC_ACQUIRE, "agent");
            xb_add(&bar[XB_XGEN(b.x)], 1u);
            asm volatile("s_waitcnt vmcnt(0)" ::: "memory");
        } else {
            XB_SPIN(xb_ld(&bar[XB_XGEN(b.x)]) == gen, bar);
            __builtin_amdgcn_fence(__ATOMIC_ACQUIRE, "agent");
            asm volatile("s_waitcnt vmcnt(0)" ::: "memory");
        }
    }
    __syncthreads();
}

struct Args { const float* in[15]; float* out; unsigned char* ws; int ph_lo, ph_hi; };

__device__ __forceinline__ void transpose_convert(const float* __restrict__ W, bf16_t* __restrict__ WT, int K, int N, LAS float* tile, int rot, const float* kscale) {
    const int tid = threadIdx.x, nb = gridDim.x; const int bid = (int)((blockIdx.x + (unsigned)rot) % (unsigned)nb);
    const int nkt = K / 64, ntile = nkt * (N / 64);
    const int k0 = tid >> 4, c4 = tid & 15;
    f32x4 v0, v1;
#define TC_LOAD(t_) do { const int tk_ = (t_) % nkt, tn_ = (t_) / nkt; const float* s_ = W + (size_t)(tk_ * 64 + k0) * N + tn_ * 64 + c4 * 4; \
        v0 = ldgf4(s_); v1 = ldgf4(s_ + (size_t)32 * N); if (kscale) { v0 = v0 * ldgf(kscale + tk_ * 64 + k0); v1 = v1 * ldgf(kscale + tk_ * 64 + k0 + 32); } } while (0)
    int t = bid, par = 0;
    if (t < ntile) TC_LOAD(t);
    for (; t < ntile; t += nb, par ^= 1) {
        LAS float* tl = tile + par * (64 * 65);
        { LAS float* d = tl + k0 * 65 + c4 * 4; d[0] = v0[0]; d[1] = v0[1]; d[2] = v0[2]; d[3] = v0[3]; d += 32 * 65; d[0] = v1[0]; d[1] = v1[1]; d[2] = v1[2]; d[3] = v1[3]; }
        const int tk = t % nkt, tn = t / nkt;
        if (t + nb < ntile) TC_LOAD(t + nb);
        __syncthreads();
        { const int n = tid >> 3, kq = tid & 7; float v[8];
#pragma unroll
          for (int j = 0; j < 8; ++j) v[j] = tl[(kq * 8 + j) * 65 + n];
          store8_bf16(WT + (size_t)(tn * 64 + n) * K + tk * 64 + kq * 8, v); }
    }
    __syncthreads();
#undef TC_LOAD
}

__device__ __forceinline__ void p0_prologue(const Args& a, LAS unsigned char* lds) {
    unsigned char* ws = a.ws;
    const int tid = threadIdx.x, bid = blockIdx.x, nb = gridDim.x, gtid = bid * 512 + tid, gsz = nb * 512;
    {
        float* LOWER = (float*)(ws + WS_LOWER); const float* lbp = a.in[4];
        for (int i = gtid; i < 2048; i += gsz) { const float a0 = lbp[i], a1 = lbp[2048 + i]; LOWER[i] = 0.f; LOWER[2048 + i] = 1.f / (1.f + expf(a0 - a1)); }
        float* SSQ = (float*)(ws + WS_SSQ);
        for (int i = gtid; i < 3 * SEQ; i += gsz) SSQ[SEQ + i] = 0.f;
    }
    {
        const float* x = a.in[0]; bf16_t* XG = (bf16_t*)(ws + WS_XGA); float* SSQ = (float*)(ws + WS_SSQ);
        const int lane = tid & 63, gw = gtid >> 6, nw = gsz >> 6;
        for (int row = gw; row < SEQ; row += nw) {
            const float* xr = x + (size_t)row * DM; f32x4 v[8]; float s = 0.f;
#pragma unroll
            for (int j = 0; j < 8; ++j) v[j] = ldgf4(xr + (j * 64 + lane) * 4);
#pragma unroll
            for (int j = 0; j < 8; ++j) { s += v[j][0] * v[j][0] + v[j][1] * v[j][1] + v[j][2] * v[j][2] + v[j][3] * v[j][3];
                u32x2 w; w.x = cvt_pk_bf16(v[j][0], v[j][1]); w.y = cvt_pk_bf16(v[j][2], v[j][3]);
                *(GAS u32x2*)(XG + (size_t)row * DM + (j * 64 + lane) * 4) = w; }
#pragma unroll
            for (int o = 32; o >= 1; o >>= 1) s += __shfl_xor(s, o);
            if (lane == 0) SSQ[row] = s;
        }
    }
    {
        const float* p = a.in[1]; bf16_t* PB = (bf16_t*)(ws + WS_PB);
        for (int i = gtid; i < 2 * SEQ * PLE / 16; i += gsz) { f32x4 v[4];
#pragma unroll
            for (int j = 0; j < 4; ++j) v[j] = ldgf4(p + (size_t)i * 16 + j * 4);
            u32x4 w0, w1; w0.x = cvt_pk_bf16(v[0][0], v[0][1]); w0.y = cvt_pk_bf16(v[0][2], v[0][3]); w0.z = cvt_pk_bf16(v[1][0], v[1][1]); w0.w = cvt_pk_bf16(v[1][2], v[1][3]);
            w1.x = cvt_pk_bf16(v[2][0], v[2][1]); w1.y = cvt_pk_bf16(v[2][2], v[2][3]); w1.z = cvt_pk_bf16(v[3][0], v[3][1]); w1.w = cvt_pk_bf16(v[3][2], v[3][3]);
            *(GAS u32x4*)(PB + (size_t)i * 16) = w0; *(GAS u32x4*)(PB + (size_t)i * 16 + 8) = w1; }
    }
    LAS float* tile = (LAS float*)lds;
    for (int l = 0; l < 2; ++l) {
        transpose_convert(a.in[3] + (size_t)l * DM * NIN, (bf16_t*)(ws + WS_WIN) + (size_t)l * NIN * DM, DM, NIN, tile, 0, a.in[2] + l * DM);
        transpose_convert(a.in[9] + (size_t)l * HW * DM, (bf16_t*)(ws + WS_WA) + (size_t)l * DM * HW, HW, DM, tile, 0, nullptr);
        transpose_convert(a.in[10] + (size_t)l * HW * DM, (bf16_t*)(ws + WS_WB) + (size_t)l * DM * HW, HW, DM, tile, 0, nullptr);
        transpose_convert(a.in[11] + (size_t)l * DM * DM, (bf16_t*)(ws + WS_WO) + (size_t)l * DM * DM, DM, DM, tile, 0, nullptr);
        transpose_convert(a.in[13] + (size_t)l * DM * DM, (bf16_t*)(ws + WS_WG) + (size_t)l * DM * DM, DM, DM, tile, 0, a.in[12] + l * DM);
        transpose_convert(a.in[14] + (size_t)l * PLE * DM, (bf16_t*)(ws + WS_WP) + (size_t)l * DM * PLE, PLE, DM, tile, 128, nullptr);
    }
}

constexpr int HP_ROWB = 272;
constexpr int HT_ROWB = 144;

__device__ __forceinline__ void hg_cumsum(const float (&gv)[16], int seg, int kc, int dir, LAS float* SEGS, float (&b)[16], float& bref, float& blast) {
    float c = 0.f;
#pragma unroll
    for (int i = 0; i < 16; ++i) { c += gv[i]; b[i] = c; }
    const float tot = c;
    if (dir) {
#pragma unroll
        for (int i = 0; i < 16; ++i) b[i] = tot - b[i] + gv[i];
    }
    SEGS[seg * 128 + kc] = tot;
    __syncthreads();
    const float t0 = SEGS[kc], t1 = SEGS[128 + kc], t2 = SEGS[256 + kc], t3 = SEGS[384 + kc];
    float off;
    if (!dir) { off = (seg > 0 ? t0 : 0.f) + (seg > 1 ? t1 : 0.f) + (seg > 2 ? t2 : 0.f); bref = t0 + t1; }
    else      { off = (seg < 3 ? t3 : 0.f) + (seg < 2 ? t2 : 0.f) + (seg < 1 ? t1 : 0.f); bref = t2 + t3; }
    blast = (t0 + t1) + (t2 + t3);
#pragma unroll
    for (int i = 0; i < 16; ++i) b[i] += off;
}
__device__ __forceinline__ unsigned short ldg_u16(const bf16_t* p) { return *(const GAS bf16_t*)p; }

__device__ __forceinline__ void h1_phase(const Args& a, LAS unsigned char* lds, int wid_s) {
    unsigned char* ws = opaque_ptr(a.ws);
    const int tid = opaque_tid(wid_s), lane = tid & 63, w = __builtin_amdgcn_readfirstlane(tid >> 6), fr = lane & 15, fq = lane >> 4;
    const int kc = tid & 127, seg = tid >> 7;
    LAS float* SEGS = (LAS float*)lds; LAS float* SC = (LAS float*)(lds + 2048);
    LAS unsigned char* KpT = lds + 4096; LAS unsigned char* Vt = lds + 4096 + 128 * HT_ROWB;
    const bf16_t* VH = (const bf16_t*)(ws + WS_VH);
    bf16_t* LT = (bf16_t*)(ws + WS_LT); float* DD = (float*)(ws + WS_DD); float* EE = (float*)(ws + WS_EE);
    unsigned short gr_[16], kr_[16], vr_[16];
#define H1_FETCH(item_) do { const int d_ = (item_) >> 10, h_ = ((item_) >> 7) & 7, cs_ = (item_) & 127, n_ = d_ ? 127 - cs_ : cs_; \
        const size_t o_ = (size_t)(64 * n_ + 16 * seg) * HW + h_ * 128 + kc; const bf16_t* G_ = (const bf16_t*)(ws + (d_ ? WS_GB : WS_GF)) + o_; const bf16_t* K_ = (const bf16_t*)(ws + (d_ ? WS_KB : WS_KF)) + o_; \
        _Pragma("unroll") for (int i = 0; i < 16; ++i) { gr_[i] = ldg_u16(G_ + (size_t)i * HW); kr_[i] = ldg_u16(K_ + (size_t)i * HW); vr_[i] = ldg_u16(VH + o_ + (size_t)i * HW); } } while (0)
    int item = blockIdx.x;
    if (item < 2048) H1_FETCH(item);
    for (; item < 2048; item += gridDim.x) {
        const int d = item >> 10;
        float b[16], bref, blast, gv[16];
#pragma unroll
        for (int i = 0; i < 16; ++i) gv[i] = f16_to_f32(gr_[i]);
        hg_cumsum(gv, seg, kc, d, SEGS, b, bref, blast);
        {
            unsigned kw[8], vw[8];
#pragma unroll
            for (int i = 0; i < 16; i += 2) {
                const float k0 = bf2f(kr_[i]) * __expf(fminf(bref - b[i], 80.f)), k1 = bf2f(kr_[i + 1]) * __expf(fminf(bref - b[i + 1], 80.f));
                kw[i >> 1] = cvt_pk_bf16(k0, k1);
                vw[i >> 1] = (unsigned)vr_[i] | ((unsigned)vr_[i + 1] << 16);
            }
            LAS u32x4* kd = (LAS u32x4*)(KpT + kc * HT_ROWB + seg * 32); kd[0] = (u32x4){kw[0], kw[1], kw[2], kw[3]}; kd[1] = (u32x4){kw[4], kw[5], kw[6], kw[7]};
            LAS u32x4* vd = (LAS u32x4*)(Vt + kc * HT_ROWB + seg * 32); vd[0] = (u32x4){vw[0], vw[1], vw[2], vw[3]}; vd[1] = (u32x4){vw[4], vw[5], vw[6], vw[7]};
            if (seg == 0) { SC[kc] = __expf(blast - bref); *(GAS float*)(DD + (size_t)item * 128 + kc) = __expf(blast); *(GAS float*)(EE + (size_t)item * 128 + kc) = __expf(bref); }
        }
        if (item + (int)gridDim.x < 2048) H1_FETCH(item + (int)gridDim.x);
        __syncthreads();
        {
            const int vt = w;
            bf16x8 bv[2];
#pragma unroll
            for (int ks = 0; ks < 2; ++ks) bv[ks] = *(const LAS bf16x8*)(Vt + (16 * vt + fr) * HT_ROWB + (32 * ks + 8 * fq) * 2);
            bf16_t* dst = LT + (size_t)item * 16384 + (size_t)(16 * vt + fr) * 128 + 4 * fq;
#pragma unroll
            for (int kt = 0; kt < 8; ++kt) {
                f32x4 acc = (f32x4){0.f, 0.f, 0.f, 0.f};
#pragma unroll
                for (int ks = 0; ks < 2; ++ks) { const bf16x8 af = *(const LAS bf16x8*)(KpT + (16 * kt + fr) * HT_ROWB + (32 * ks + 8 * fq) * 2);
                    acc = __builtin_amdgcn_mfma_f32_16x16x32_bf16(af, bv[ks], acc, 0, 0, 0); }
                const f32x4 sc = *(const LAS f32x4*)(SC + 16 * kt + 4 * fq);
                u32x2 ow; ow.x = cvt_pk_bf16(acc[0] * sc[0], acc[1] * sc[1]); ow.y = cvt_pk_bf16(acc[2] * sc[2], acc[3] * sc[3]);
                *(GAS u32x2*)(dst + 16 * kt) = ow;
            }
        }
    }
#undef H1_FETCH
}

__device__ __forceinline__ void h2_phase(const Args& a, int wid_s) {
    unsigned char* ws = opaque_ptr(a.ws);
    const int tid = opaque_tid(wid_s);
    const bf16_t* LT = (const bf16_t*)(ws + WS_LT); const float* DD = (const float*)(ws + WS_DD); const float* EE = (const float*)(ws + WS_EE);
    bf16_t* SP = (bf16_t*)(ws + WS_SP);
    for (int u = blockIdx.x; u < 256; u += gridDim.x) {
        const int chain = u >> 4, sub = u & 15;
        const int v = 8 * sub + (tid >> 6), k = 2 * (tid & 63);
        const size_t ibase = (size_t)chain * 128;
        float s0 = 0.f, s1 = 0.f;
        for (int cs0 = 0; cs0 < 128; cs0 += 16) {
            unsigned lt[16]; f32x2 dd[16], ee[16];
#pragma unroll
            for (int j = 0; j < 16; ++j) { const size_t it = ibase + cs0 + j;
                lt[j] = *(const GAS unsigned*)(LT + it * 16384 + v * 128 + k); dd[j] = *(const GAS f32x2*)(DD + it * 128 + k); ee[j] = *(const GAS f32x2*)(EE + it * 128 + k); }
#pragma unroll
            for (int j = 0; j < 16; ++j) { const size_t it = ibase + cs0 + j;
                *(GAS unsigned*)(SP + it * 16384 + v * 128 + k) = cvt_pk_bf16(s0 * ee[j][0], s1 * ee[j][1]);
                s0 = dd[j][0] * s0 + bflo(lt[j]); s1 = dd[j][1] * s1 + bfhi(lt[j]); }
        }
    }
}

__device__ __forceinline__ void h3_phase(const Args& a, int layer, LAS unsigned char* lds, int wid_s) {
    unsigned char* ws = opaque_ptr(a.ws);
    const int tid = opaque_tid(wid_s), lane = tid & 63, w = __builtin_amdgcn_readfirstlane(tid >> 6), fr = lane & 15, fq = lane >> 4;
    const int kc = tid & 127, seg = tid >> 7;
    LAS float* SEGS = (LAS float*)lds; LAS float* SSQP = (LAS float*)(lds + 2048);
    LAS unsigned char* Qp = lds + 4096; LAS unsigned char* Kp = Qp + 64 * HP_ROWB; LAS unsigned char* Vt = Kp + 64 * HP_ROWB; LAS unsigned char* Ab = Vt + 128 * HT_ROWB; LAS unsigned char* SPs = Ab + 64 * HT_ROWB;
    const bf16_t* QH = (const bf16_t*)(ws + WS_QH); const bf16_t* VH = (const bf16_t*)(ws + WS_VH); const bf16_t* HG = (const bf16_t*)(ws + WS_HG);
    const bf16_t* SP = (const bf16_t*)(ws + WS_SP); bf16_t* OA = (bf16_t*)(ws + WS_OA);
    const float* onorm = a.in[5] + layer * 128;
    unsigned short gr_[16], qr_[16], kr_[16], vr_[16]; u32x4 spr[4];
#define H3_FETCH(item_, d_) do { const int n_ = (item_) >> 3, h_ = (item_) & 7, cs_ = (d_) ? 127 - n_ : n_; \
        const size_t o_ = (size_t)(64 * n_ + 16 * seg) * HW + h_ * 128 + kc; const bf16_t* G_ = (const bf16_t*)(ws + ((d_) ? WS_GB : WS_GF)) + o_; const bf16_t* K_ = (const bf16_t*)(ws + ((d_) ? WS_KB : WS_KF)) + o_; \
        const bf16_t* S_ = SP + (size_t)(((d_) * 8 + h_) * 128 + cs_) * 16384; \
        _Pragma("unroll") for (int i = 0; i < 16; ++i) { gr_[i] = ldg_u16(G_ + (size_t)i * HW); qr_[i] = ldg_u16(QH + o_ + (size_t)i * HW); kr_[i] = ldg_u16(K_ + (size_t)i * HW); vr_[i] = ldg_u16(VH + o_ + (size_t)i * HW); } \
        _Pragma("unroll") for (int i = 0; i < 4; ++i) { const int q_ = tid + 512 * i; spr[i] = ldg16(S_ + (q_ >> 4) * 128 + (q_ & 15) * 8); } } while (0)
    int item = blockIdx.x;
    if (item < 1024) H3_FETCH(item, 0);
    for (; item < 1024; item += gridDim.x) {
        const int n = item >> 3, h = item & 7;
        const int tok0 = 64 * n;
        const int rt = w & 3, vg = w >> 2;
        f32x4 o[4];
#pragma unroll
        for (int j = 0; j < 4; ++j) o[j] = (f32x4){0.f, 0.f, 0.f, 0.f};
        u32x2 hgr[4];
        for (int d = 0; d < 2; ++d) {
            float b[16], bref, blast, gv[16];
#pragma unroll
            for (int i = 0; i < 16; ++i) gv[i] = f16_to_f32(gr_[i]);
            hg_cumsum(gv, seg, kc, d, SEGS, b, bref, blast);
            {
                unsigned vw[8];
#pragma unroll
                for (int i = 0; i < 16; i += 2) {
                    const float e0 = b[i] - bref, e1 = b[i + 1] - bref;
                    const float q0 = bf2f(qr_[i]) * __expf(fminf(e0, 80.f)), q1 = bf2f(qr_[i + 1]) * __expf(fminf(e1, 80.f));
                    const float k0 = bf2f(kr_[i]) * __expf(fminf(-e0, 80.f)), k1 = bf2f(kr_[i + 1]) * __expf(fminf(-e1, 80.f));
                    *(LAS unsigned short*)(Qp + (16 * seg + i) * HP_ROWB + kc * 2) = f2bf1(q0);
                    *(LAS unsigned short*)(Qp + (16 * seg + i + 1) * HP_ROWB + kc * 2) = f2bf1(q1);
                    *(LAS unsigned short*)(Kp + (16 * seg + i) * HP_ROWB + kc * 2) = f2bf1(k0);
                    *(LAS unsigned short*)(Kp + (16 * seg + i + 1) * HP_ROWB + kc * 2) = f2bf1(k1);
                    vw[i >> 1] = (unsigned)vr_[i] | ((unsigned)vr_[i + 1] << 16);
                }
                LAS u32x4* vd = (LAS u32x4*)(Vt + kc * HT_ROWB + seg * 32); vd[0] = (u32x4){vw[0], vw[1], vw[2], vw[3]}; vd[1] = (u32x4){vw[4], vw[5], vw[6], vw[7]};
#pragma unroll
                for (int i = 0; i < 4; ++i) { const int q = tid + 512 * i; *(LAS u32x4*)(SPs + (q >> 4) * HP_ROWB + (q & 15) * 16) = spr[i]; }
            }
            if (d == 0) H3_FETCH(item, 1);
            else { if (item + (int)gridDim.x < 1024) H3_FETCH(item + (int)gridDim.x, 0);
#pragma unroll
                for (int j = 0; j < 4; ++j) hgr[j] = *(const GAS u32x2*)(HG + (size_t)(tok0 + 16 * rt + fr) * HW + h * 128 + 16 * (4 * vg + j) + 4 * fq); }
            __syncthreads();
            {
                const int art = w >> 1;
#pragma unroll
                for (int tt = 0; tt < 2; ++tt) {
                    const int st = 2 * (w & 1) + tt;
                    const bool need = d ? (st >= art) : (st <= art);
                    f32x4 acc = (f32x4){0.f, 0.f, 0.f, 0.f};
                    if (need) {
#pragma unroll
                        for (int ks = 0; ks < 4; ++ks) {
                            const bf16x8 af = *(const LAS bf16x8*)(Qp + (16 * art + fr) * HP_ROWB + (32 * ks + 8 * fq) * 2);
                            const bf16x8 bfr = *(const LAS bf16x8*)(Kp + (16 * st + fr) * HP_ROWB + (32 * ks + 8 * fq) * 2);
                            acc = __builtin_amdgcn_mfma_f32_16x16x32_bf16(af, bfr, acc, 0, 0, 0);
                        }
                    }
                    const int s_ = 16 * st + fr;
#pragma unroll
                    for (int r = 0; r < 4; ++r) { const int r_ = 16 * art + 4 * fq + r; const bool ok = need && (d ? (s_ >= r_) : (s_ <= r_));
                        *(LAS unsigned short*)(Ab + r_ * HT_ROWB + s_ * 2) = f2bf1(ok ? acc[r] : 0.f); }
                }
            }
            __syncthreads();
            {
                bf16x8 ab[2], qb[4];
#pragma unroll
                for (int ks = 0; ks < 2; ++ks) ab[ks] = *(const LAS bf16x8*)(Ab + (16 * rt + fr) * HT_ROWB + (32 * ks + 8 * fq) * 2);
#pragma unroll
                for (int ks = 0; ks < 4; ++ks) qb[ks] = *(const LAS bf16x8*)(Qp + (16 * rt + fr) * HP_ROWB + (32 * ks + 8 * fq) * 2);
#pragma unroll
                for (int j = 0; j < 4; ++j) {
                    const int vt = 4 * vg + j;
#pragma unroll
                    for (int ks = 0; ks < 2; ++ks) { const bf16x8 af = *(const LAS bf16x8*)(Vt + (16 * vt + fr) * HT_ROWB + (32 * ks + 8 * fq) * 2);
                        o[j] = __builtin_amdgcn_mfma_f32_16x16x32_bf16(af, ab[ks], o[j], 0, 0, 0); }
#pragma unroll
                    for (int ks = 0; ks < 4; ++ks) { const bf16x8 af = *(const LAS bf16x8*)(SPs + (16 * vt + fr) * HP_ROWB + (32 * ks + 8 * fq) * 2);
                        o[j] = __builtin_amdgcn_mfma_f32_16x16x32_bf16(af, qb[ks], o[j], 0, 0, 0); }
                }
            }
        }
        {
            float s = 0.f;
#pragma unroll
            for (int j = 0; j < 4; ++j) s += o[j][0] * o[j][0] + o[j][1] * o[j][1] + o[j][2] * o[j][2] + o[j][3] * o[j][3];
            s += __shfl_xor(s, 16); s += __shfl_xor(s, 32);
            if (fq == 0) SSQP[vg * 64 + 16 * rt + fr] = s;
            __syncthreads();
            const int row = 16 * rt + fr; const float rs = rsqrtf((SSQP[row] + SSQP[64 + row]) * (1.0f / 128.f) + EPS);
#pragma unroll
            for (int j = 0; j < 4; ++j) { const int v0 = 16 * (4 * vg + j) + 4 * fq; const f32x4 on = ldgf4(onorm + v0);
                u32x2 ow; ow.x = cvt_pk_bf16(o[j][0] * rs * on[0] * bflo(hgr[j].x), o[j][1] * rs * on[1] * bfhi(hgr[j].x)); ow.y = cvt_pk_bf16(o[j][2] * rs * on[2] * bflo(hgr[j].y), o[j][3] * rs * on[3] * bfhi(hgr[j].y));
                *(GAS u32x2*)(OA + (size_t)(tok0 + row) * HW + h * 128 + v0) = ow; }
        }
    }
#undef H3_FETCH
}

constexpr int NAT_NB = 36864, NAT_KH = 64 * 272, NAT_VH = 128 * 144;
__device__ __forceinline__ void natten_phase(const Args& a, int layer, LAS unsigned char* lds, int wid_s) {
    unsigned char* ws = opaque_ptr(a.ws);
    const int tid = opaque_tid(wid_s), lane = tid & 63, w = __builtin_amdgcn_readfirstlane(tid >> 6), fr = lane & 15, fq = lane >> 4;
    LAS float* RP = (LAS float*)(lds + 2 * NAT_NB);
    const bf16_t* NQ = (const bf16_t*)(ws + WS_NQ); const bf16_t* NK = (const bf16_t*)(ws + WS_NK); const bf16_t* VT = (const bf16_t*)(ws + WS_VT);
    const bf16_t* NG = (const bf16_t*)(ws + WS_NG); bf16_t* OB = (bf16_t*)(ws + WS_OB);
    const float* gq = a.in[6] + layer * 128; const float* gk = a.in[7] + layer * 128; const float* rpb = a.in[8] + (size_t)layer * 8 * 465;
    for (int it = blockIdx.x; it < 512; it += gridDim.x) {
        const int r = it >> 2, hp = it & 3, hw = w >> 2, h = 2 * hp + hw, j = w & 3;
        const int r_start = min(max(r - 4, 0), 120);
        const bf16_t* ksrc[4]; const bf16_t* vsrc[4]; int kdst[4], vdst[4];
#pragma unroll
        for (int i = 0; i < 4; ++i) { const int q = tid + 512 * i, hd = q >> 10;
            { const int key = (q >> 4) & 63, ch = q & 15; ksrc[i] = NK + (size_t)(64 * r_start + key) * HW + (2 * hp + hd) * 128 + ch * 8; kdst[i] = hd * NAT_KH + key * 272 + ch * 16; }
            { const int d = (q >> 3) & 127, ch = q & 7; vsrc[i] = VT + (size_t)((2 * hp + hd) * 128 + d) * SEQ + 64 * r_start + ch * 8; vdst[i] = hd * NAT_VH + d * 144 + ch * 16; } }
        u32x4 R0[4], R1[4], R2[4];
#define NAT_LOAD(st, R) do { _Pragma("unroll") for (int i = 0; i < 4; ++i) R[i] = ((st) < 8) ? ldg16(ksrc[i] + (size_t)(st) * 64 * HW) : ldg16(vsrc[i] + ((st) - 8) * 64); } while (0)
#define NAT_WRITE(st, R) do { _Pragma("unroll") for (int i = 0; i < 4; ++i) *(LAS u32x4*)(lds + ((st) & 1) * NAT_NB + (((st) < 8) ? kdst[i] : vdst[i])) = R[i]; } while (0)
        NAT_LOAD(0, R0); NAT_LOAD(1, R1); NAT_LOAD(2, R2);
        for (int i = tid; i < 930; i += 512) RP[i] = ldgf(rpb + (size_t)(2 * hp) * 465 + i);
        const int c0k = (j == 0) ? 0 : (j == 1) ? 8 : (j == 2) ? 24 : 32;
        const int cq = 16 * j + fr, tq = 64 * r + cq;
        const int cstart = min(max(cq - 8, 0), 48);
        bf16x8 qf[4];
        {
            float qv[4][8]; float ss = 0.f;
#pragma unroll
            for (int ks = 0; ks < 4; ++ks) { load8_bf16(NQ + (size_t)tq * HW + h * 128 + 32 * ks + 8 * fq, qv[ks]);
#pragma unroll
                for (int e = 0; e < 8; ++e) ss += qv[ks][e] * qv[ks][e]; }
            ss += __shfl_xor(ss, 16); ss += __shfl_xor(ss, 32);
            const float rq = rsqrtf(ss * (1.0f / 128.f) + EPS) * 0.08838834764831845f;
#pragma unroll
            for (int ks = 0; ks < 4; ++ks) { float g1[8], g2[8]; load8_f32(gq + 32 * ks + 8 * fq, g1); load8_f32(gk + 32 * ks + 8 * fq, g2);
                u32x4 wv;
                wv.x = cvt_pk_bf16(qv[ks][0] * rq * g1[0] * g2[0], qv[ks][1] * rq * g1[1] * g2[1]); wv.y = cvt_pk_bf16(qv[ks][2] * rq * g1[2] * g2[2], qv[ks][3] * rq * g1[3] * g2[3]);
                wv.z = cvt_pk_bf16(qv[ks][4] * rq * g1[4] * g2[4], qv[ks][5] * rq * g1[5] * g2[5]); wv.w = cvt_pk_bf16(qv[ks][6] * rq * g1[6] * g2[6], qv[ks][7] * rq * g1[7] * g2[7]);
                qf[ks] = __builtin_bit_cast(bf16x8, wv); }
        }
        NAT_WRITE(0, R0);
        __syncthreads();
        float s[8][2][4];
        float mx = -3.0e38f, l = 0.f;
        f32x4 o[8];
#pragma unroll
        for (int dt = 0; dt < 8; ++dt) o[dt] = (f32x4){0.f, 0.f, 0.f, 0.f};
#pragma unroll
        for (int st = 0; st < 16; ++st) {
            if (st + 3 < 16) { if (st % 3 == 0) NAT_LOAD(st + 3, R0); else if (st % 3 == 1) NAT_LOAD(st + 3, R1); else NAT_LOAD(st + 3, R2); }
            LAS unsigned char* buf = lds + (st & 1) * NAT_NB;
            if (st < 8) {
                const int aa = st, kr = r_start + aa, row_off = kr - r + 7;
#pragma unroll
                for (int kt = 0; kt < 2; ++kt) {
                    bf16x8 kf[4]; float ssk = 0.f;
#pragma unroll
                    for (int ks = 0; ks < 4; ++ks) { const u32x4 wv = *(const LAS u32x4*)(buf + hw * NAT_KH + (c0k + 16 * kt + fr) * 272 + (32 * ks + 8 * fq) * 2); kf[ks] = __builtin_bit_cast(bf16x8, wv);
                        ssk += bflo(wv.x) * bflo(wv.x) + bfhi(wv.x) * bfhi(wv.x) + bflo(wv.y) * bflo(wv.y) + bfhi(wv.y) * bfhi(wv.y)
                             + bflo(wv.z) * bflo(wv.z) + bfhi(wv.z) * bfhi(wv.z) + bflo(wv.w) * bflo(wv.w) + bfhi(wv.w) * bfhi(wv.w); }
                    ssk += __shfl_xor(ssk, 16); ssk += __shfl_xor(ssk, 32);
                    const float rk = rsqrtf(ssk * (1.0f / 128.f) + EPS);
                    f32x4 acc = (f32x4){0.f, 0.f, 0.f, 0.f};
#pragma unroll
                    for (int ks = 0; ks < 4; ++ks) acc = __builtin_amdgcn_mfma_f32_16x16x32_bf16(kf[ks], qf[ks], acc, 0, 0, 0);
#pragma unroll
                    for (int rg = 0; rg < 4; ++rg) {
                        const int ki = 4 * fq + rg; const float rki = __shfl(rk, ki);
                        const int kcl = c0k + 16 * kt + ki; const bool valid = (kcl >= cstart) && (kcl < cstart + 16);
                        const int co = min(max(kcl - cq + 15, 0), 30);
                        const float bias = RP[hw * 465 + row_off * 31 + co];
                        const float sv = valid ? (acc[rg] * rki + bias) : -1.0e30f;
                        s[aa][kt][rg] = sv; mx = fmaxf(mx, sv);
                    }
                }
                if (st == 7) {
                    mx = fmaxf(mx, __shfl_xor(mx, 16)); mx = fmaxf(mx, __shfl_xor(mx, 32));
#pragma unroll
                    for (int a2 = 0; a2 < 8; ++a2)
#pragma unroll
                        for (int kt = 0; kt < 2; ++kt)
#pragma unroll
                            for (int rg = 0; rg < 4; ++rg) { const float p = __expf(s[a2][kt][rg] - mx); s[a2][kt][rg] = p; l += p; }
                    l += __shfl_xor(l, 16); l += __shfl_xor(l, 32);
                }
            } else {
                const int aa = st - 8;
                u32x4 pw; pw.x = cvt_pk_bf16(s[aa][0][0], s[aa][0][1]); pw.y = cvt_pk_bf16(s[aa][0][2], s[aa][0][3]); pw.z = cvt_pk_bf16(s[aa][1][0], s[aa][1][1]); pw.w = cvt_pk_bf16(s[aa][1][2], s[aa][1][3]);
                const bf16x8 pb = __builtin_bit_cast(bf16x8, pw);
#pragma unroll
                for (int dt = 0; dt < 8; ++dt) {
                    const LAS unsigned char* vp = buf + hw * NAT_VH + (16 * dt + fr) * 144 + (c0k + 4 * fq) * 2;
                    const u32x2 v0 = *(const LAS u32x2*)vp, v1 = *(const LAS u32x2*)(vp + 32);
                    const u32x4 vw = (u32x4){v0.x, v0.y, v1.x, v1.y};
                    o[dt] = __builtin_amdgcn_mfma_f32_16x16x32_bf16(__builtin_bit_cast(bf16x8, vw), pb, o[dt], 0, 0, 0);
                }
            }
            if (st + 1 < 16) { if ((st + 1) % 3 == 0) NAT_WRITE(st + 1, R0); else if ((st + 1) % 3 == 1) NAT_WRITE(st + 1, R1); else NAT_WRITE(st + 1, R2); }
            __syncthreads();
        }
        const float inv = 1.0f / l;
#pragma unroll
        for (int dt = 0; dt < 8; ++dt) {
            const size_t off = (size_t)tq * HW + h * 128 + 16 * dt + 4 * fq;
            const u32x2 gw = *(const GAS u32x2*)(NG + off);
            u32x2 ow; ow.x = cvt_pk_bf16(o[dt][0] * inv * bflo(gw.x), o[dt][1] * inv * bfhi(gw.x)); ow.y = cvt_pk_bf16(o[dt][2] * inv * bflo(gw.y), o[dt][3] * inv * bfhi(gw.y));
            *(GAS u32x2*)(OB + off) = ow;
        }
#undef NAT_LOAD
#undef NAT_WRITE
    }
}

__global__ void __launch_bounds__(512, 2) mk_fwd(Args a) {
    extern __shared__ __attribute__((aligned(16))) unsigned char lds_raw[];
    LAS unsigned char* lds = (LAS unsigned char*)lds_raw;
    volatile LAS unsigned* MISC = (volatile LAS unsigned*)(lds + LDS_MISC_OFF);
    unsigned char* ws = a.ws;
    const int wid_s = __builtin_amdgcn_readfirstlane(threadIdx.x >> 6);
    if (threadIdx.x < 64) MISC[threadIdx.x] = 0u;
    __syncthreads();
    XcdBarrier bar; bar.bar = (unsigned*)(ws + WS_CTL) + 4096; bar.x = 0; bar.st = nullptr;
    const int lo = a.ph_lo, hi = a.ph_hi;
    if (hi - lo > 1) bar = xcd_barrier_post((unsigned*)(ws + WS_CTL) + 4096, MISC + 8);
#ifndef DIAG_MASK
#define DIAG_MASK 0x1ff
#endif
#define DM_(b) ((DIAG_MASK >> (b)) & 1)
#define IN(k) (lo <= (k) && (k) < hi)
#if MK_TS
    unsigned long long* TS = (unsigned long long*)(ws + 131072);
#define STAMP(k) do { if (blockIdx.x == 0 && threadIdx.x == 0) TS[k] = __builtin_amdgcn_s_memrealtime(); } while (0)
#define SEAM(k) do { if (IN(k) && (IN((k) + 1) || (k) == NPHASE - 1)) xcd_barrier(bar); STAMP((k) + 1); } while (0)
    STAMP(0);
#else
#define SEAM(k) do { if (IN(k) && IN((k) + 1)) xcd_barrier(bar); } while (0)
#endif
    const int G = gridDim.x, c = blockIdx.x;

    if (DM_(0) && IN(0)) { for (int rep = 0; rep < (MK_REP_PHASE == 0 ? MK_REP_N : 1); ++rep) { if (rep) xcd_barrier(bar); p0_prologue(a, lds); } }
    SEAM(0);
    for (int l = 0; l < 2; ++l) {
        const int pb = 1 + 7 * l;
        for (int rep = 0; rep < (MK_REP_PHASE == pb + 0 ? MK_REP_N : 1); ++rep) { if (rep) xcd_barrier(bar);
        if (DM_(1) && IN(pb + 0)) {
            unsigned char* ws = opaque_ptr(a.ws);
            const int nfull = (SEQ / 256) * (NIN / 256) % G;
            if (c >= nfull) {
                int kple = PLE; asm volatile("" : "+s"(kple));
                pg8::Gemm g2{(const bf16_t*)(ws + WS_PB) + (size_t)l * SEQ * PLE, (const bf16_t*)(ws + WS_WP) + (size_t)l * DM * PLE, SEQ, DM, kple, nullptr, nullptr}; pg8::StaticOrder S2; S2.init(SEQ, DM, G - nfull, c - nfull);
                EpiPL E2{(bf16_t*)(ws + WS_PL)};
                pg8::gemm_phase<EpiPL, pg8::StaticOrder>(lds, g2, S2, E2, wid_s);
            }
        }
        if (DM_(1) && IN(pb + 0)) {
            unsigned char* ws = opaque_ptr(a.ws); bf16_t* XGA = (bf16_t*)(ws + WS_XGA); float* SSQ = (float*)(ws + WS_SSQ);
            pg8::Gemm g{XGA, (const bf16_t*)(ws + WS_WIN) + (size_t)l * NIN * DM, SEQ, NIN, DM, nullptr, nullptr}; pg8::StaticOrder S; S.init(SEQ, NIN, G, c);
            EpiInProj E{SSQ + (2 * l) * SEQ, (const float*)(ws + WS_LOWER) + l * 2048, ws};
            if (MK_REP_DUMMY && rep) { EpiDummy ED{(bf16_t*)(ws + WS_LT)}; pg8::gemm_phase<EpiDummy, pg8::StaticOrder>(lds, g, S, ED, wid_s); } else
            pg8::gemm_phase<EpiInProj, pg8::StaticOrder>(lds, g, S, E, wid_s);
        } }
        SEAM(pb + 0);
        if (IN(pb + 1)) { for (int rep = 0; rep < (MK_REP_PHASE == pb + 1 ? MK_REP_N : 1); ++rep) { if (rep) xcd_barrier(bar); if (DM_(2)) h1_phase(a, lds, wid_s); }
            for (int rep = 0; rep < (MK_REP_PHASE == pb + 101 ? MK_REP_N : 1); ++rep) { if (rep) xcd_barrier(bar); if (DM_(8)) natten_phase(a, l, lds, wid_s); } }
        SEAM(pb + 1);
        if (DM_(3) && IN(pb + 2)) { for (int rep = 0; rep < (MK_REP_PHASE == pb + 2 ? MK_REP_N : 1); ++rep) { if (rep) xcd_barrier(bar); h2_phase(a, wid_s); } }
        SEAM(pb + 2);
        if (DM_(4) && IN(pb + 3)) { for (int rep = 0; rep < (MK_REP_PHASE == pb + 3 ? MK_REP_N : 1); ++rep) { if (rep) xcd_barrier(bar); h3_phase(a, l, lds, wid_s); } }
        SEAM(pb + 3);
        for (int rep = 0; rep < (MK_REP_PHASE == pb + 4 ? MK_REP_N : 1); ++rep) { if (rep) xcd_barrier(bar);
        if (DM_(5) && IN(pb + 4)) {
            unsigned char* ws = opaque_ptr(a.ws);
            pg8::PairOrder S; S.init(SEQ, DM, G, c);
            pg8::Gemm g{(const bf16_t*)(ws + WS_OA), (const bf16_t*)(ws + WS_WA) + (size_t)l * DM * HW, SEQ, DM, HW, (const bf16_t*)(ws + WS_OB), (const bf16_t*)(ws + WS_WB) + (size_t)l * DM * HW};
            EpiBranch E{(const bf16_t*)(ws + WS_MA), (const bf16_t*)(ws + WS_MB), (bf16_t*)(ws + WS_T), (bf16_t*)(ws + WS_Y)};
            pg8::gemm_phase<EpiBranch, pg8::PairOrder>(lds, g, S, E, wid_s);
        } }
        SEAM(pb + 4);
        for (int rep = 0; rep < (MK_REP_PHASE == pb + 5 ? MK_REP_N : 1); ++rep) { if (rep) xcd_barrier(bar);
        if (DM_(6) && IN(pb + 5)) {
            unsigned char* ws = opaque_ptr(a.ws); bf16_t* XGB = (bf16_t*)(ws + WS_XGB); float* SSQ = (float*)(ws + WS_SSQ);
            pg8::Gemm g{(const bf16_t*)(ws + WS_Y), (const bf16_t*)(ws + WS_WO) + (size_t)l * DM * DM, SEQ, DM, DM, nullptr, nullptr}; pg8::StaticOrder S; S.init(SEQ, DM, G, c);
            EpiWout E{(const bf16_t*)(ws + WS_XGA), XGB, rep ? (float*)(ws + 262144) : SSQ + (2 * l + 1) * SEQ};
            if (MK_REP_DUMMY && rep) { EpiDummy ED{(bf16_t*)(ws + WS_LT)}; pg8::gemm_phase<EpiDummy, pg8::StaticOrder>(lds, g, S, ED, wid_s); } else
            pg8::gemm_phase<EpiWout, pg8::StaticOrder>(lds, g, S, E, wid_s);
        } }
        SEAM(pb + 5);
        for (int rep = 0; rep < (MK_REP_PHASE == pb + 6 ? MK_REP_N : 1); ++rep) { if (rep) xcd_barrier(bar);
        if (DM_(7) && IN(pb + 6)) {
            unsigned char* ws = opaque_ptr(a.ws); bf16_t* XGA = (bf16_t*)(ws + WS_XGA); bf16_t* XGB = (bf16_t*)(ws + WS_XGB); float* SSQ = (float*)(ws + WS_SSQ);
            pg8::StaticOrder S; S.init(SEQ, DM, G, c);
            { pg8::Gemm g{XGB, (const bf16_t*)(ws + WS_WG) + (size_t)l * DM * DM, SEQ, DM, DM, nullptr, nullptr};
              EpiGate E{SSQ + (2 * l + 1) * SEQ, XGB, (const bf16_t*)(ws + WS_PL), a.out, XGA, rep ? (float*)(ws + 262144) : SSQ + (2 * l + 2 < 4 ? 2 * l + 2 : 0) * SEQ, l == 0 ? 1 : 0};
              pg8::gemm_phase<EpiGate, pg8::StaticOrder>(lds, g, S, E, wid_s); }
        } }
        SEAM(pb + 6);
    }
#if MK_TS
    if (blockIdx.x == 0) {
        const float dA = (float)(TS[MK_TS_A + 1] - TS[MK_TS_A]) * 0.01f, dB = (float)(TS[MK_TS_B + 1] - TS[MK_TS_B]) * 0.01f;
        for (int i = threadIdx.x; i < 1000000; i += 512) a.out[i] += (i == 0) ? 10.f * dA : 0.3f * dB;
    }
#endif
#undef IN
#undef SEAM
#if MK_ENDFLUSH
    asm volatile("s_waitcnt vmcnt(0)" ::: "memory");
    __builtin_amdgcn_fence(__ATOMIC_RELEASE, "agent");
    asm volatile("s_waitcnt vmcnt(0)" ::: "memory");
#endif
}


#ifndef MK_DIAG
#define MK_DIAG 0
#define MK_HOLE_BUF WS_MB
#define MK_HOLE_LD DM
#define MK_HOLE_MODE 0
#endif
#if MK_DIAG
__global__ void ck_sum(const void* p, size_t n, int kind, double* slot) {
    double s0 = 0.0, s1 = 0.0;
    for (size_t i = (size_t)blockIdx.x * blockDim.x + threadIdx.x; i < n; i += (size_t)gridDim.x * blockDim.x) {
        float v = kind ? bf2f(((const bf16_t*)p)[i]) : ((const float*)p)[i];
        if (!(v == v)) v = 12345.0f;
        const float wgt = (float)((int)((i * 2654435761ull >> 16) & 255) - 128);
        s0 += fabsf(v); s1 += (double)v * wgt;
    }
    for (int o = 32; o >= 1; o >>= 1) { s0 += __shfl_xor(s0, o); s1 += __shfl_xor(s1, o); }
    if ((threadIdx.x & 63) == 0) { atomicAdd(slot, s0); atomicAdd(slot + 1, s1); }
}
__global__ void ck_final(const double* sums, float* out, size_t n, int nslots) {
    int first = -1;
    for (int i = 0; i < nslots; ++i) { const double a0 = sums[2 * i], a1 = sums[2 * i + 1], b0 = sums[2 * (nslots + i)], b1 = sums[2 * (nslots + i) + 1];
        const bool bad = fabs(a0 - b0) > 1e-5 * (fabs(a0) + fabs(b0)) + 1e-30 || fabs(a1 - b1) > 1e-4 * (fabs(a0) + fabs(b0)) + 1e-30;
        if (bad) { first = i; break; } }
    const float val = first < 0 ? 0.f : 100.f * (float)(first + 1);
    for (size_t i = (size_t)blockIdx.x * blockDim.x + threadIdx.x; i < n; i += (size_t)gridDim.x * blockDim.x) out[i] = val;
}
__global__ void ck_holes(const bf16_t* p, size_t n, unsigned long long* res) {
    unsigned long long cnt = 0, mn = ~0ull;
    for (size_t i = (size_t)blockIdx.x * blockDim.x + threadIdx.x; i < n; i += (size_t)gridDim.x * blockDim.x) if (p[i] == 0xFFFFu) { ++cnt; if (i < mn) mn = i; }
    if (cnt) { atomicAdd(res, cnt); atomicMin(res + 1, mn); }
}
__global__ void ck_holes_final(const unsigned long long* res, float* out, size_t n, int mode) {
    const float val = mode == 0 ? (float)((double)res[0] / 65536.0 * 100.0) : mode == 1 ? (float)((res[1] == ~0ull ? 0 : (res[1] / 2048) ) ) + 100.f : (float)((res[1] == ~0ull ? 0 : (res[1] % 2048))) + 100.f;
    for (size_t i = (size_t)blockIdx.x * blockDim.x + threadIdx.x; i < n; i += (size_t)gridDim.x * blockDim.x) out[i] = val;
}
__global__ void ck_diff(const bf16_t* p, const bf16_t* q, size_t n, unsigned long long* res) {
    unsigned long long cnt = 0, mn = ~0ull, big = 0;
    for (size_t i = (size_t)blockIdx.x * blockDim.x + threadIdx.x; i < n; i += (size_t)gridDim.x * blockDim.x) if (p[i] != q[i]) { ++cnt; if (i < mn) mn = i; const float a = bf2f(p[i]), b = bf2f(q[i]); if (fabsf(a - b) > 0.02f * (fabsf(a) + fabsf(b))) ++big; }
    if (cnt) { atomicAdd(res, cnt); atomicMin(res + 1, mn); atomicAdd(res + 2, big); }
}
__global__ void ck_diff_final(const unsigned long long* res, float* out, size_t n, int ld) {
    const unsigned long long cnt = res[0], big = res[2];
    const float c2 = 100.f * (1.f + floorf(log2f(1.f + (float)cnt)));
    const float c1 = 1.0e6f * (1.f + floorf(log2f(1.f + (float)big)));
    for (size_t i = (size_t)blockIdx.x * blockDim.x + threadIdx.x; i < n; i += (size_t)gridDim.x * blockDim.x) out[i] = (i == 0) ? c1 : c2;
}

__device__ __forceinline__ unsigned hsh(unsigned x) { x ^= x >> 16; x *= 0x7feb352du; x ^= x >> 15; x *= 0x846ca68bu; x ^= x >> 16; return x; }
__device__ __forceinline__ float bfr(float f) { return bf2f(f2bf1(f)); }
__device__ __forceinline__ void err_max(unsigned* res, float got, float expv) { float e = fabsf(got - expv) / (0.02f + 0.02f * fabsf(expv)); if (!(e == e)) e = 1e9f; atomicMax(res, __float_as_uint(e)); }
__device__ __forceinline__ float wave_sum(float s) { for (int o = 32; o >= 1; o >>= 1) s += __shfl_xor(s, o); return s; }
__global__ void chk_inproj(const float* x, const float* g0, const float* win, const float* lbp, const unsigned char* ws, unsigned* res, int nsamp) {
    const int lane = threadIdx.x & 63, wv = (blockIdx.x * blockDim.x + threadIdx.x) >> 6, nw = (gridDim.x * blockDim.x) >> 6;
    for (int s = wv; s < nsamp; s += nw) {
        const int row = hsh(2 * s + 1) % SEQ, col = hsh(2 * s + 2) % NIN;
        float ss = 0.f, dot = 0.f;
        for (int k = lane; k < DM; k += 64) { const float xv = x[(size_t)row * DM + k]; ss += xv * xv; dot += bfr(xv * g0[k]) * bfr(win[(size_t)k * NIN + col]); }
        ss = wave_sum(ss); dot = wave_sum(dot);
        const float u = dot * rsqrtf(ss / DM + EPS);
        if (lane == 0) {
            const int seg = col >> 10, c = col & 1023; const size_t o1 = (size_t)row * HW + c;
            const float sg = 1.f / (1.f + expf(-u)), si = u * sg;
            if (seg == 0) err_max(res, bf2f(((const bf16_t*)(ws + WS_QH))[o1]), si);
            else if (seg == 1) err_max(res, bf2f(((const bf16_t*)(ws + WS_VH))[o1]), u);
            else if (seg == 2 || seg == 3) { const int dir = seg - 2; const float a0 = lbp[dir * 1024 + c], a1 = lbp[2048 + dir * 1024 + c]; const float lb = 0.f * (a0 + a1);
                const float f = lb + (1.f - lb) * sg; err_max(res + 1, ((const float*)(ws + (dir ? WS_GB : WS_GF)))[o1], logf(fmaxf(f, 1e-6f)));
                err_max(res + 1, bf2f(((const bf16_t*)(ws + (dir ? WS_KB : WS_KF)))[o1]), (1.f - lb) * (1.f - sg)); }
            else if (seg == 4) err_max(res, bf2f(((const bf16_t*)(ws + WS_HG))[o1]), si);
            else if (seg == 5) err_max(res, bf2f(((const bf16_t*)(ws + WS_NQ))[o1]), u);
            else if (seg == 6) err_max(res, bf2f(((const bf16_t*)(ws + WS_NK))[o1]), u);
            else if (seg == 7) err_max(res + 2, bf2f(((const bf16_t*)(ws + WS_VT))[(size_t)c * SEQ + row]), u);
            else if (seg == 8) err_max(res, bf2f(((const bf16_t*)(ws + WS_NG))[o1]), si);
            else if (seg < 11) err_max(res + 3, bf2f(((const bf16_t*)(ws + WS_MA))[(size_t)row * DM + col - 9216]), sg);
            else err_max(res + 9, bf2f(((const bf16_t*)(ws + WS_MB))[(size_t)row * DM + col - 11264]), sg);
        }
    }
}
__global__ void chk_natten(const unsigned char* ws, const float* gq, const float* gk, const float* rpb, unsigned* res, int nsamp) {
    const int lane = threadIdx.x & 63, wv = (blockIdx.x * blockDim.x + threadIdx.x) >> 6, nw = (gridDim.x * blockDim.x) >> 6;
    const bf16_t* NQ = (const bf16_t*)(ws + WS_NQ); const bf16_t* NK = (const bf16_t*)(ws + WS_NK); const bf16_t* VT = (const bf16_t*)(ws + WS_VT); const bf16_t* NG = (const bf16_t*)(ws + WS_NG); const bf16_t* OB = (const bf16_t*)(ws + WS_OB);
    for (int s = wv; s < nsamp; s += nw) {
        const int t = hsh(3 * s + 7) % SEQ, h = hsh(3 * s + 8) % 8; const int r = t >> 6, c = t & 63;
        const int rs0 = min(max(r - 4, 0), 120), cs0 = min(max(c - 8, 0), 48);
        float q0 = bf2f(NQ[(size_t)t * HW + h * 128 + lane]), q1 = bf2f(NQ[(size_t)t * HW + h * 128 + 64 + lane]);
        const float rq = rsqrtf(wave_sum(q0 * q0 + q1 * q1) / 128.f + EPS); q0 *= rq * gq[lane]; q1 *= rq * gq[64 + lane];
        float mx = -1e30f;
        float o0 = 0.f, o1 = 0.f, l = 0.f;
        for (int pass = 0; pass < 2; ++pass) {
            for (int a = 0; a < 8; ++a) for (int j = 0; j < 16; ++j) {
                const int kr = rs0 + a, kc = cs0 + j, tk = kr * 64 + kc;
                float k0 = bf2f(NK[(size_t)tk * HW + h * 128 + lane]), k1 = bf2f(NK[(size_t)tk * HW + h * 128 + 64 + lane]);
                const float rk = rsqrtf(wave_sum(k0 * k0 + k1 * k1) / 128.f + EPS);
                const float d = wave_sum(q0 * k0 * rk * gk[lane] + q1 * k1 * rk * gk[64 + lane]) * 0.08838834764831845f + rpb[(size_t)h * 465 + (kr - r + 7) * 31 + (kc - c + 15)];
                if (pass == 0) mx = fmaxf(mx, d);
                else { const float p = expf(d - mx); l += p; o0 += p * bf2f(VT[(size_t)(h * 128 + lane) * SEQ + tk]); o1 += p * bf2f(VT[(size_t)(h * 128 + 64 + lane) * SEQ + tk]); }
            }
        }
        const size_t ob = (size_t)t * HW + h * 128;
        err_max(res, bf2f(OB[ob + lane]), o0 / l * bf2f(NG[ob + lane])); err_max(res, bf2f(OB[ob + 64 + lane]), o1 / l * bf2f(NG[ob + 64 + lane]));
    }
}
__global__ void chk_hgrn_scan(const unsigned char* ws, float* OREF, int h0) {
    __shared__ float qs[128], ks[128], fs[128], vs[128], part[4][128];
    const int tid = threadIdx.x, v = tid & 127, kq = tid >> 7; const int h = h0 + (blockIdx.x >> 1), d = blockIdx.x & 1;
    const bf16_t* QH = (const bf16_t*)(ws + WS_QH); const bf16_t* VH = (const bf16_t*)(ws + WS_VH); const bf16_t* KK = (const bf16_t*)(ws + (d ? WS_KB : WS_KF)); const float* G = (const float*)(ws + (d ? WS_GB : WS_GF));
    float S[32];
#pragma unroll
    for (int i = 0; i < 32; ++i) S[i] = 0.f;
    float* out = OREF + (size_t)blockIdx.x * SEQ * 128;
    for (int step = 0; step < SEQ; ++step) {
        const int t = d ? SEQ - 1 - step : step;
        if (tid < 128) { qs[tid] = bf2f(QH[(size_t)t * HW + h * 128 + tid]); ks[tid] = bf2f(KK[(size_t)t * HW + h * 128 + tid]); fs[tid] = expf(G[(size_t)t * HW + h * 128 + tid]); vs[tid] = bf2f(VH[(size_t)t * HW + h * 128 + tid]); }
        __syncthreads();
        float p = 0.f; const float vv = vs[v];
#pragma unroll
        for (int i = 0; i < 32; ++i) { const int k = 32 * kq + i; S[i] = fs[k] * S[i] + ks[k] * vv; p += S[i] * qs[k]; }
        part[kq][v] = p;
        __syncthreads();
        if (tid < 128) out[(size_t)t * 128 + tid] = part[0][tid] + part[1][tid] + part[2][tid] + part[3][tid];
    }
}
__global__ void chk_hgrn_out(const unsigned char* ws, const float* OREF, const float* onorm, unsigned* res, int h0, int nh) {
    const int lane = threadIdx.x & 63, wv = (blockIdx.x * blockDim.x + threadIdx.x) >> 6, nw = (gridDim.x * blockDim.x) >> 6;
    const bf16_t* HG = (const bf16_t*)(ws + WS_HG); const bf16_t* OA = (const bf16_t*)(ws + WS_OA);
    for (int s = wv; s < nh * SEQ; s += nw) {
        const int hh = s / SEQ, t = s % SEQ, h = h0 + hh;
        const float* of = OREF + ((size_t)(2 * hh) * SEQ + t) * 128; const float* ob = OREF + ((size_t)(2 * hh + 1) * SEQ + t) * 128;
        const float a0 = of[lane] + ob[lane], a1 = of[64 + lane] + ob[64 + lane];
        const float rs = rsqrtf(wave_sum(a0 * a0 + a1 * a1) / 128.f + EPS);
        const size_t o = (size_t)t * HW + h * 128;
        err_max(res, bf2f(OA[o + lane]), a0 * rs * onorm[lane] * bf2f(HG[o + lane])); err_max(res, bf2f(OA[o + 64 + lane]), a1 * rs * onorm[64 + lane] * bf2f(HG[o + 64 + lane]));
    }
}
__global__ void chk_branch(const unsigned char* ws, const float* wa, const float* wb, unsigned* res, int nsamp) {
    const int lane = threadIdx.x & 63, wv = (blockIdx.x * blockDim.x + threadIdx.x) >> 6, nw = (gridDim.x * blockDim.x) >> 6;
    const bf16_t* OA = (const bf16_t*)(ws + WS_OA); const bf16_t* OB = (const bf16_t*)(ws + WS_OB); const bf16_t* MA = (const bf16_t*)(ws + WS_MA); const bf16_t* MB = (const bf16_t*)(ws + WS_MB); const bf16_t* Y = (const bf16_t*)(ws + WS_Y);
    for (int s = wv; s < nsamp; s += nw) {
        const int row = hsh(5 * s + 1) % SEQ, col = hsh(5 * s + 2) % DM; float da = 0.f, db = 0.f;
        for (int k = lane; k < HW; k += 64) { da += bf2f(OA[(size_t)row * HW + k]) * bfr(wa[(size_t)k * DM + col]); db += bf2f(OB[(size_t)row * HW + k]) * bfr(wb[(size_t)k * DM + col]); }
        da = wave_sum(da); db = wave_sum(db);
        if (lane == 0) err_max(res, bf2f(Y[(size_t)row * DM + col]), bf2f(MA[(size_t)row * DM + col]) * da + bf2f(MB[(size_t)row * DM + col]) * db);
    }
}
__global__ void chk_wout(const unsigned char* ws, const float* xin, const float* wo, unsigned* res, int nsamp) {
    const int lane = threadIdx.x & 63, wv = (blockIdx.x * blockDim.x + threadIdx.x) >> 6, nw = (gridDim.x * blockDim.x) >> 6;
    const bf16_t* Y = (const bf16_t*)(ws + WS_Y); const float* X1 = (const float*)(ws + WS_X1);
    for (int s = wv; s < nsamp; s += nw) {
        const int row = hsh(7 * s + 1) % SEQ, col = hsh(7 * s + 2) % DM; float d = 0.f;
        for (int k = lane; k < DM; k += 64) d += bf2f(Y[(size_t)row * DM + k]) * bfr(wo[(size_t)k * DM + col]);
        d = wave_sum(d);
        if (lane == 0) err_max(res, X1[(size_t)row * DM + col], xin[(size_t)row * DM + col] + d);
    }
}
__global__ void chk_gate(const unsigned char* ws, const float* out, const float* p, const float* wp, const float* wg, const float* pn, unsigned* res, int nsamp) {
    const int lane = threadIdx.x & 63, wv = (blockIdx.x * blockDim.x + threadIdx.x) >> 6, nw = (gridDim.x * blockDim.x) >> 6;
    const float* X1 = (const float*)(ws + WS_X1);
    for (int s = wv; s < nsamp; s += nw) {
        const int row = hsh(9 * s + 1) % SEQ, col = hsh(9 * s + 2) % DM; float d = 0.f, ss = 0.f, pl = 0.f;
        for (int k = lane; k < DM; k += 64) { const float xv = X1[(size_t)row * DM + k]; ss += xv * xv; d += bfr(xv * pn[k]) * bfr(wg[(size_t)k * DM + col]); }
        for (int k = lane; k < PLE; k += 64) pl += bfr(p[(size_t)row * PLE + k]) * bfr(wp[(size_t)k * DM + col]);
        d = wave_sum(d); ss = wave_sum(ss); pl = wave_sum(pl);
        if (lane == 0) { const float g = 1.f / (1.f + expf(-d * rsqrtf(ss / DM + EPS))); err_max(res, out[(size_t)row * DM + col], X1[(size_t)row * DM + col] + pl * g); }
    }
}
__global__ void chk_final(const unsigned* res, float* out, size_t n, int nres) {
    int first = -1; for (int i = 0; i < nres; ++i) if (__uint_as_float(res[i]) > 1.0f) { first = i; break; }
    float bucket = 0.f; if (first >= 0) { const float e = __uint_as_float(res[first]); bucket = fminf(fmaxf(floorf(log10f(e)) + 1.f, 0.f), 9.f); }
    const float val = first < 0 ? 0.f : 100.f * (float)(first + 1) + 10.f * bucket;
    for (size_t i = (size_t)blockIdx.x * blockDim.x + threadIdx.x; i < n; i += (size_t)gridDim.x * blockDim.x) out[i] = val;
}

__global__ void ck_big(const bf16_t* p, size_t n, unsigned long long* res) {
    unsigned long long c0 = 0, c2 = 0, c4 = 0; float mxv = 0.f;
    for (size_t i = (size_t)blockIdx.x * blockDim.x + threadIdx.x; i < n; i += (size_t)gridDim.x * blockDim.x) { const float v = bf2f(p[i]);
        if (!(fabsf(v) <= 3.0e38f)) ++c0; else if (fabsf(v) > 1.01f || v < -0.01f) { ++c2; mxv = fmaxf(mxv, fabsf(v)); if (v < 0.f) ++c4; } }
    if (c0 | c2) { atomicAdd(res, c0); atomicAdd(res + 2, c2); atomicAdd(res + 4, c4); atomicMax((unsigned*)(res + 3), __float_as_uint(mxv)); }
}
__global__ void ck_big_final(const unsigned long long* res, float* out, size_t n, int ld) {
    const float mxv = __uint_as_float((unsigned)res[3]);
    const float c1 = 1.0e4f * (1.f + floorf(log2f(1.f + (float)res[0])));
    const float negf = res[2] ? (float)res[4] / (float)res[2] : 0.f;
    const float c2 = 1000.f * (1.f + floorf(negf * 3.99f)) + 100.f * fminf(fmaxf(floorf(log10f(fmaxf(mxv, 1e-9f))) + 2.f, 0.f), 9.f);
    for (size_t i = (size_t)blockIdx.x * blockDim.x + threadIdx.x; i < n; i += (size_t)gridDim.x * blockDim.x) out[i] = (i == 0) ? c1 : c2;
}
struct CkBuf { int phase; int idx; size_t off; size_t n; int kind; };
#endif

extern "C" void kernel_launch(void* const* d_in, const int* in_sizes, int n_in, void* d_out, int out_size, void* d_ws, size_t ws_size, hipStream_t stream) {
    static int grid = 0;
    if (grid == 0) {
        if (n_in != 15 || out_size != SEQ * DM || ws_size < WS_END) { fprintf(stderr, "kernel_launch: unexpected problem (n_in %d, out %d, ws %zu)\n", n_in, out_size, ws_size); grid = -1; return; }
        int dev = 0, cus = 0;
        if (hipGetDevice(&dev) != hipSuccess || hipDeviceGetAttribute(&cus, hipDeviceAttributeMultiprocessorCount, dev) != hipSuccess) { grid = -1; return; }
        if (hipFuncSetAttribute((const void*)mk_fwd, hipFuncAttributeMaxDynamicSharedMemorySize, LDS_BYTES) != hipSuccess) { fprintf(stderr, "kernel_launch: hipFuncSetAttribute failed\n"); grid = -1; return; }
        int per_cu = 0;
        if (hipOccupancyMaxActiveBlocksPerMultiprocessor(&per_cu, (const void*)mk_fwd, 512, LDS_BYTES) != hipSuccess || per_cu < 1) fprintf(stderr, "kernel_launch: occupancy query says %d\n", per_cu);
        (void)hipGetLastError();
        grid = cus;
    }
    if (grid < 0) return;
    (void)hipMemsetAsync((char*)d_ws + WS_CTL, 0, CTL_ZERO_BYTES, stream);
    Args a{};
    for (int i = 0; i < 15; ++i) a.in[i] = (const float*)d_in[i];
    a.out = (float*)d_out; a.ws = (unsigned char*)d_ws;
#if MK_DIAG == 5
    {
        unsigned long long* res = (unsigned long long*)((char*)d_ws + 65536);
        (void)hipMemsetAsync((char*)d_ws + 65536 + 8, 0xFF, 8, stream);
        for (int ph = 0; ph < 2; ++ph) { a.ph_lo = ph; a.ph_hi = ph + 1; hipLaunchKernelGGL(mk_fwd, dim3(grid), dim3(512), LDS_BYTES, stream, a); }
        hipLaunchKernelGGL(ck_big, dim3(1024), dim3(256), 0, stream, (const bf16_t*)((char*)d_ws + WS_MA), (size_t)SEQ * DM, res);
        hipLaunchKernelGGL(ck_big_final, dim3(1024), dim3(256), 0, stream, (const unsigned long long*)res, (float*)d_out, (size_t)SEQ * DM, DM);
    }
#elif MK_DIAG == 4
    {
        unsigned* res = (unsigned*)((char*)d_ws + 65536);
        float* OREF = (float*)((char*)d_ws + 728 * MiB);
        const unsigned char* wsc = (const unsigned char*)d_ws;
        const float* const* in = a.in;
        for (int ph = 0; ph < NPHASE; ++ph) {
            a.ph_lo = ph; a.ph_hi = ph + 1; hipLaunchKernelGGL(mk_fwd, dim3(grid), dim3(512), LDS_BYTES, stream, a);
            if (ph == 1) hipLaunchKernelGGL(chk_inproj, dim3(512), dim3(256), 0, stream, in[0], in[2], in[3], in[4], wsc, res + 0, 32768);
            if (ph == 2) hipLaunchKernelGGL(chk_natten, dim3(256), dim3(256), 0, stream, wsc, in[6], in[7], in[8], res + 4, 1024);
            if (ph == 4) { hipLaunchKernelGGL(chk_hgrn_scan, dim3(4), dim3(512), 0, stream, wsc, OREF, 2);
                           hipLaunchKernelGGL(chk_hgrn_out, dim3(512), dim3(256), 0, stream, wsc, (const float*)OREF, in[5], res + 5, 2, 2); }
            if (ph == 5) hipLaunchKernelGGL(chk_branch, dim3(512), dim3(256), 0, stream, wsc, in[9], in[10], res + 6, 8192);
            if (ph == 6) hipLaunchKernelGGL(chk_wout, dim3(512), dim3(256), 0, stream, wsc, in[0], in[11], res + 7, 8192);
            if (ph == 7) hipLaunchKernelGGL(chk_gate, dim3(512), dim3(256), 0, stream, wsc, (const float*)d_out, in[1], in[14], in[13], in[12], res + 8, 8192);
        }
        hipLaunchKernelGGL(chk_final, dim3(1024), dim3(256), 0, stream, (const unsigned*)res, (float*)d_out, (size_t)SEQ * DM, 10);
    }
#elif MK_DIAG == 3
    {
        unsigned long long* res = (unsigned long long*)((char*)d_ws + 65536);
        bf16_t* SAVE = (bf16_t*)((char*)d_ws + 728 * MiB);
        (void)hipMemsetAsync((char*)d_ws + MiB, 0xAA, WS_END - MiB, stream);
        (void)hipMemsetAsync((char*)d_ws + 65536 + 8, 0xFF, 8, stream);
        for (int ph = 0; ph < 2; ++ph) { a.ph_lo = ph; a.ph_hi = ph + 1; hipLaunchKernelGGL(mk_fwd, dim3(grid), dim3(512), LDS_BYTES, stream, a); }
        (void)hipMemcpyAsync(SAVE, (char*)d_ws + MK_HOLE_BUF, (size_t)SEQ * MK_HOLE_LD * 2, hipMemcpyDeviceToDevice, stream);
        a.ph_lo = 1; a.ph_hi = 2; hipLaunchKernelGGL(mk_fwd, dim3(grid), dim3(512), LDS_BYTES, stream, a);
        hipLaunchKernelGGL(ck_diff, dim3(1024), dim3(256), 0, stream, (const bf16_t*)((char*)d_ws + MK_HOLE_BUF), (const bf16_t*)SAVE, (size_t)SEQ * MK_HOLE_LD, res);
        hipLaunchKernelGGL(ck_diff_final, dim3(1024), dim3(256), 0, stream, (const unsigned long long*)res, (float*)d_out, (size_t)SEQ * DM, MK_HOLE_LD);
    }
#elif MK_DIAG == 2
    {
        unsigned long long* res = (unsigned long long*)((char*)d_ws + 65536);
        (void)hipMemsetAsync((char*)d_ws + MiB, 0xAA, WS_END - MiB, stream);
        (void)hipMemsetAsync((char*)d_ws + 65536 + 8, 0xFF, 8, stream);
        a.ph_lo = 0; a.ph_hi = 1; hipLaunchKernelGGL(mk_fwd, dim3(grid), dim3(512), LDS_BYTES, stream, a);
        (void)hipMemsetAsync((char*)d_ws + MK_HOLE_BUF, 0xFF, (size_t)SEQ * MK_HOLE_LD * 2, stream);
        a.ph_lo = 1; a.ph_hi = 2; hipLaunchKernelGGL(mk_fwd, dim3(grid), dim3(512), LDS_BYTES, stream, a);
        hipLaunchKernelGGL(ck_holes, dim3(1024), dim3(256), 0, stream, (const bf16_t*)((char*)d_ws + MK_HOLE_BUF), (size_t)SEQ * MK_HOLE_LD, res);
        hipLaunchKernelGGL(ck_holes_final, dim3(1024), dim3(256), 0, stream, (const unsigned long long*)res, (float*)d_out, (size_t)SEQ * DM, MK_HOLE_MODE);
    }
#elif MK_DIAG
    {
        static const CkBuf B0[] = {
            {0, 0, WS_LOWER, 4096, 0}, {0, 1, WS_SSQ, 8192, 0}, {0, 2, WS_XGA, (size_t)SEQ * DM, 1}, {0, 3, WS_PB, (size_t)2 * SEQ * PLE, 1}, {0, 4, WS_WIN, (size_t)2 * NIN * DM, 1},
            {0, 5, WS_WA, (size_t)2 * DM * HW, 1}, {0, 6, WS_WB, (size_t)2 * DM * HW, 1}, {0, 7, WS_WO, (size_t)2 * DM * DM, 1}, {0, 8, WS_WG, (size_t)2 * DM * DM, 1}, {0, 9, WS_WP, (size_t)2 * DM * PLE, 1} };
        static const CkBuf BL[] = {
            {0, 10, WS_QH, (size_t)SEQ * HW, 1}, {0, 11, WS_VH, (size_t)SEQ * HW, 1}, {0, 12, WS_KF, (size_t)SEQ * HW, 1}, {0, 13, WS_KB, (size_t)SEQ * HW, 1}, {0, 14, WS_HG, (size_t)SEQ * HW, 1},
            {0, 15, WS_NQ, (size_t)SEQ * HW, 1}, {0, 16, WS_NK, (size_t)SEQ * HW, 1}, {0, 17, WS_VT, (size_t)SEQ * HW, 1}, {0, 18, WS_NG, (size_t)SEQ * HW, 1}, {0, 19, WS_GF, (size_t)SEQ * HW, 0},
            {0, 20, WS_GB, (size_t)SEQ * HW, 0}, {0, 21, WS_MA, (size_t)SEQ * DM, 1}, {0, 22, WS_MB, (size_t)SEQ * DM, 1},
            {1, 23, WS_LT, (size_t)2048 * 16384, 0}, {1, 24, WS_DD, (size_t)2048 * 128, 0}, {1, 25, WS_EE, (size_t)2048 * 128, 0}, {1, 26, WS_OB, (size_t)SEQ * HW, 1},
            {2, 27, WS_SP, (size_t)2048 * 16384, 1}, {3, 28, WS_OA, (size_t)SEQ * HW, 1}, {4, 29, WS_T, (size_t)SEQ * DM, 0}, {4, 30, WS_Y, (size_t)SEQ * DM, 1},
            {5, 31, WS_X1, (size_t)SEQ * DM, 0}, {5, 32, WS_XGB, (size_t)SEQ * DM, 1}, {6, 34, WS_PL, (size_t)SEQ * DM, 0}, {6, 35, (size_t)-1, (size_t)SEQ * DM, 0} };
        const int NS = 80;
        double* sums = (double*)((char*)d_ws + 65536);
        (void)hipMemsetAsync((char*)d_ws + MiB, 0xAA, WS_END - MiB, stream);
        for (int run = 0; run < 2; ++run) {
            (void)hipMemsetAsync((char*)d_ws + WS_CTL, 0, 32768, stream);
            for (int ph = 0; ph < NPHASE; ++ph) {
                a.ph_lo = ph; a.ph_hi = ph + 1; hipLaunchKernelGGL(mk_fwd, dim3(grid), dim3(512), LDS_BYTES, stream, a);
                if (ph == 0) { for (const CkBuf& b : B0) hipLaunchKernelGGL(ck_sum, dim3(1024), dim3(256), 0, stream, (const void*)((char*)d_ws + b.off), b.n, b.kind, sums + 2 * (run * NS + b.idx)); }
                else { const int l = (ph - 1) / 7, k = (ph - 1) % 7;
                    for (const CkBuf& b : BL) if (b.phase == k) hipLaunchKernelGGL(ck_sum, dim3(1024), dim3(256), 0, stream, b.off == (size_t)-1 ? (const void*)d_out : (const void*)((char*)d_ws + b.off), b.n, b.kind, sums + 2 * (run * NS + b.idx + 40 * l)); }
            }
        }
        hipLaunchKernelGGL(ck_final, dim3(1024), dim3(256), 0, stream, (const double*)sums, (float*)d_out, (size_t)SEQ * DM, NS);
    }
#elif MK_MULTI
    for (int ph = 0; ph < NPHASE; ++ph) { a.ph_lo = ph; a.ph_hi = ph + 1; hipLaunchKernelGGL(mk_fwd, dim3(grid), dim3(512), LDS_BYTES, stream, a); }
#else
    a.ph_lo = 0; a.ph_hi = NPHASE; hipLaunchKernelGGL(mk_fwd, dim3(grid), dim3(512), LDS_BYTES, stream, a);
#endif
}
```

```cpp
#include <hip/hip_runtime.h>
#include <cstdio>
#include <cstdint>

#ifndef MK_ALIGN
#define MK_ALIGN true
#endif
#ifndef MK_SP2
#define MK_SP2 true
#endif
#ifndef MK_MULTI
#define MK_MULTI 0
#endif

#define LAS __attribute__((address_space(3)))
typedef unsigned short bf16_t;
typedef short bf16x8 __attribute__((ext_vector_type(8)));
typedef float f32x4 __attribute__((ext_vector_type(4)));
typedef float f32x2 __attribute__((ext_vector_type(2)));
typedef short v4i16_t __attribute__((ext_vector_type(4)));
typedef unsigned u32x4 __attribute__((ext_vector_type(4)));
typedef unsigned u32x2 __attribute__((ext_vector_type(2)));

constexpr int SEQ = 8192, DM = 2048, NIN = 13312, HW = 1024, PLE = 256;
constexpr float EPS = 1e-6f;
constexpr int NPHASE = 15;

constexpr size_t MiB = 1u << 20;
constexpr size_t WS_CTL = 0, CTL_ZERO_BYTES = 64 * 1024;
constexpr size_t WS_LOWER = 1 * MiB;
constexpr size_t WS_SSQ = 1 * MiB + 64 * 1024;
constexpr size_t WS_RKS = 1 * MiB + 256 * 1024;
constexpr size_t WS_DD = 2 * MiB;
constexpr size_t WS_EE = 3 * MiB;
constexpr size_t WS_WIN = 4 * MiB;
constexpr size_t WS_WA = 108 * MiB;
constexpr size_t WS_WB = 116 * MiB;
constexpr size_t WS_WO = 124 * MiB;
constexpr size_t WS_WG = 140 * MiB;
constexpr size_t WS_WP = 156 * MiB;
constexpr size_t WS_PB = 158 * MiB;
constexpr size_t WS_XGA = 166 * MiB;
constexpr size_t WS_XGB = 198 * MiB;
constexpr size_t WS_QH = 230 * MiB;
constexpr size_t WS_VH = 246 * MiB;
constexpr size_t WS_KF = 262 * MiB;
constexpr size_t WS_KB = 278 * MiB;
constexpr size_t WS_HG = 294 * MiB;
constexpr size_t WS_NQ = 310 * MiB;
constexpr size_t WS_NK = 326 * MiB;
constexpr size_t WS_VT = 342 * MiB;
constexpr size_t WS_NG = 358 * MiB;
constexpr size_t WS_OA = 374 * MiB;
constexpr size_t WS_OB = 390 * MiB;
constexpr size_t WS_GF = 406 * MiB;
constexpr size_t WS_GB = 438 * MiB;
constexpr size_t WS_MA = 470 * MiB;
constexpr size_t WS_MB = 502 * MiB;
constexpr size_t WS_LT = 534 * MiB;
constexpr size_t WS_SP = WS_LT;
constexpr size_t WS_T = 662 * MiB;
constexpr size_t WS_Y = 694 * MiB;
constexpr size_t WS_PL = 726 * MiB;
constexpr size_t WS_END = 758 * MiB;

constexpr int LDS_BYTES = 147456;
constexpr int LDS_MISC_OFF = 131072;

typedef __bf16 bf16x2_t __attribute__((ext_vector_type(2)));
__device__ __forceinline__ unsigned cvt_pk_bf16(float lo, float hi) { bf16x2_t v = {(__bf16)lo, (__bf16)hi}; return __builtin_bit_cast(unsigned, v); }
__device__ __forceinline__ float bf2f(unsigned short b) { return __uint_as_float(((unsigned)b) << 16); }
__device__ __forceinline__ float bflo(unsigned w) { return __uint_as_float(w << 16); }
__device__ __forceinline__ float bfhi(unsigned w) { return __uint_as_float(w & 0xffff0000u); }
__device__ __forceinline__ unsigned short f2bf1(float f) { return (unsigned short)(cvt_pk_bf16(f, 0.f) & 0xffffu); }
typedef _Float16 f16x2_t __attribute__((ext_vector_type(2)));
__device__ __forceinline__ unsigned cvt_pk_f16(float lo, float hi) { f16x2_t v = {(_Float16)lo, (_Float16)hi}; return __builtin_bit_cast(unsigned, v); }
__device__ __forceinline__ float f16_to_f32(unsigned short h) { return (float)__builtin_bit_cast(_Float16, h); }
__device__ __forceinline__ float fast_rcp(float x) { return __builtin_amdgcn_rcpf(x); }
__device__ __forceinline__ float sigmoid_f(float x) { return fast_rcp(1.f + __expf(-x)); }
__device__ __forceinline__ float silu_f(float x) { return x * sigmoid_f(x); }
typedef float f32x2 __attribute__((ext_vector_type(2)));
__device__ __forceinline__ f32x2 exp2_2(f32x2 a) { return (f32x2){__builtin_amdgcn_exp2f(a.x), __builtin_amdgcn_exp2f(a.y)}; }
__device__ __forceinline__ f32x2 rcp_2(f32x2 a) { return (f32x2){__builtin_amdgcn_rcpf(a.x), __builtin_amdgcn_rcpf(a.y)}; }
__device__ __forceinline__ f32x2 sig2(f32x2 a, float rn) { return rcp_2(exp2_2(a * rn) + 1.0f); }
#define NLOG2E (-1.4426950408889634f)

__device__ __forceinline__ int opaque_tid(int wid_s) { int lane; asm volatile("v_mbcnt_lo_u32_b32 %0, -1, 0\n\tv_mbcnt_hi_u32_b32 %0, -1, %0" : "=v"(lane)); asm volatile("" : "+s"(wid_s)); return wid_s * 64 + lane; }
__device__ __forceinline__ unsigned char* opaque_ptr(unsigned char* p) { asm volatile("" : "+s"(p)); return p; }
__device__ __forceinline__ int opaque_bid() { int b = blockIdx.x; asm volatile("" : "+s"(b)); return b; }
namespace pg8 {
#define PG8_LAS __attribute__((address_space(3)))
constexpr int BM = 256, BK = 64, HALF = 128, HTB = HALF * BK * 2, STAGE_BYTES = 8 * HTB, NXCD = 8, WGM = 8;
__host__ __device__ __forceinline__ int lds_byte(int r, int c) { const int st = (r >> 4) * 2 + (c >> 5), rr = r & 15, cc = c & 31, ob = rr * 64 + cc * 2; return st * 1024 + (ob ^ (((ob >> 9) & 1) << 5)); }
__host__ __device__ __forceinline__ void stage_rc(int b, int& R, int& C) { const int st = b / 1024, sb = b % 1024, swz = sb ^ (((sb >> 9) & 1) << 5); R = (st >> 1) * 16 + swz / 64; C = (st & 1) * 32 + (swz % 64) / 2; }
__host__ __device__ __forceinline__ int perm32(int rho) { const int n = rho >> 4, i = rho & 15; return 8 * (i >> 2) + 4 * n + (i & 3); }

struct Unit { int pm, pn, z; };
struct Gemm { const bf16_t* A; const bf16_t* Bt; int M, N, K; const bf16_t* A2; const bf16_t* Bt2; };

struct StaticOrder {
    int nM, nN, nwg, G, c;
    __host__ __device__ void init(int M, int N, int G_, int c_) { nM = M / BM; nN = N / BM; nwg = nM * nN; G = G_; c = c_; }
    __host__ __device__ bool next(int i, Unit& u) const {
        const long L = (long)i * G + c; if (L >= nwg) return false;
        int wgid = (int)L; { const int q = nwg / NXCD, r = nwg % NXCD, xcd = wgid % NXCD, off = wgid / NXCD; wgid = (xcd < r ? xcd * (q + 1) : r * (q + 1) + (xcd - r) * q) + off; }
        const int nig = WGM * nN, gid = wgid / nig, fm = gid * WGM, gsz = (nM - fm) < WGM ? (nM - fm) : WGM;
        u.pm = fm + ((wgid % nig) % gsz); u.pn = (wgid % nig) / gsz; u.z = 0; return true;
    }
    __device__ __forceinline__ void a_ready(const Unit&) const {}
    __device__ __forceinline__ void done(const Unit&) const {}
};
struct PairOrder : StaticOrder {
    unsigned nxv = 0u;
    unsigned* flag = nullptr;
    volatile PG8_LAS unsigned* lflag = nullptr; unsigned tag = 0u; int wid = 0;
    __host__ __device__ bool next(int i, Unit& u) const { const bool ok = StaticOrder::next(i >> 1, u); u.z = i & 1; return ok; }
    __device__ __forceinline__ void a_ready(const Unit& u) const {
        if (u.z == 1 && flag) {
            unsigned sp = 0u;
            if (wid == 0) {
                while (__hip_atomic_load(flag, __ATOMIC_RELAXED, __HIP_MEMORY_SCOPE_AGENT) < nxv) { __builtin_amdgcn_s_sleep(1); if (++sp > (1u << 18)) break; }
                __builtin_amdgcn_fence(__ATOMIC_ACQUIRE, "agent");
                asm volatile("s_waitcnt vmcnt(0)" ::: "memory");
                *lflag = tag;
            } else {
                while (*lflag != tag) { __builtin_amdgcn_s_sleep(1); if (++sp > (1u << 22)) break; }
            }
        }
    }
};

typedef f32x4 AccArr[2][2][4][2];
__device__ __forceinline__ void acc_zero(AccArr& acc) {
#pragma unroll
    for (int a = 0; a < 2; ++a)
#pragma unroll
        for (int b = 0; b < 2; ++b)
#pragma unroll
            for (int m = 0; m < 4; ++m)
#pragma unroll
                for (int n = 0; n < 2; ++n) acc[a][b][m][n] = (f32x4){0.f, 0.f, 0.f, 0.f};
}
template <class Epi> __device__ __forceinline__ auto acc_init(const Epi& E, AccArr& acc, const Unit& u, int wid_s) -> decltype(E.init(acc, u, wid_s)) { return E.init(acc, u, wid_s); }
template <class Epi> __device__ __forceinline__ void acc_init(const Epi&, AccArr& acc, const Unit&, ...) { acc_zero(acc); }
template <class Epi> __device__ __forceinline__ auto epi_pre(const Epi& E, float (&pv)[8], const Unit& u, int wid_s) -> decltype(E.pre(pv, u, wid_s)) { return E.pre(pv, u, wid_s); }
template <class Epi> __device__ __forceinline__ void epi_pre(const Epi&, float (&)[8], const Unit&, ...) {}
template <class Epi, class A> __device__ __forceinline__ auto epi_call(const Epi& E, A& acc, const Unit& u, int wr, int wc, int fr, int fq, const float (&pv)[8]) -> decltype(E(acc, u, wr, wc, fr, fq, pv)) { return E(acc, u, wr, wc, fr, fq, pv); }
template <class Epi, class A> __device__ __forceinline__ void epi_call(const Epi& E, A& acc, const Unit& u, int wr, int wc, int fr, int fq, ...) { E(acc, u, wr, wc, fr, fq); }
template <class Epi, class = void> struct Epi_relax { static constexpr int value = 0; };
template <class Epi> struct Epi_relax<Epi, decltype((void)Epi::RELAX)> { static constexpr int value = Epi::RELAX; };
template <class Epi, class Sched, bool ALIGN_EPI = MK_ALIGN, bool SP2 = MK_SP2>
__device__ __forceinline__ void gemm_phase(PG8_LAS unsigned char* lds, const Gemm g, const Sched& S, const Epi& E, int wid_s) {
    const int tid = opaque_tid(wid_s), wid = __builtin_amdgcn_readfirstlane(tid >> 6), lane = tid & 63, wr = wid >> 2, wc = wid & 3, fr = lane & 15, fq = lane >> 4;
    const int K = g.K, nt = K / BK;
    unsigned voffA[2], voffB[2];
#pragma unroll
    for (int i = 0; i < 2; ++i) { int R, C; stage_rc(tid * 16 + i * 8192, R, C); const int Rb = Epi::PERM ? ((R & ~31) + perm32(R & 31)) : R;
        voffA[i] = (unsigned)(R * K + C) * 2u; voffB[i] = (unsigned)(Rb * K + C) * 2u; }
    const size_t kstep = (size_t)(BK * 2);
    const size_t hstep = (size_t)HALF * K * 2;
    const size_t tstep = 2 * hstep;
    const unsigned ldsw = (unsigned)wid * 1024u;
    const int aoff = lds_byte(wr * 64 + fr, fq * 8), boff = lds_byte(wc * 32 + fr, fq * 8);
#define PG8_SA(b, h) (((b) * 2 + (h)) * HTB)
#define PG8_SB(b, h) ((4 + (b) * 2 + (h)) * HTB)
#define PG8_STAGE(bufoff, gbase, voff) do { _Pragma("unroll") for (int _i = 0; _i < 2; ++_i) \
        __builtin_amdgcn_global_load_lds((const unsigned*)((const char*)(gbase) + (voff)[_i]), (PG8_LAS unsigned*)(lds + (bufoff) + ldsw + _i * 8192), 16, 0, 0); } while (0)
#define PG8_LDA(dst, b, h) do { _Pragma("unroll") for (int m = 0; m < 4; ++m) _Pragma("unroll") for (int k = 0; k < 2; ++k) dst[m][k] = *(const PG8_LAS bf16x8*)(lds + PG8_SA(b, h) + aoff + m * 2048 + k * 1024); } while (0)
#define PG8_LDB(dst, b, h) do { _Pragma("unroll") for (int n = 0; n < 2; ++n) _Pragma("unroll") for (int k = 0; k < 2; ++k) dst[n][k] = *(const PG8_LAS bf16x8*)(lds + PG8_SB(b, h) + boff + n * 2048 + k * 1024); } while (0)
#define PG8_MMA(ai, bj, At, Bt) do { __builtin_amdgcn_s_setprio(1); _Pragma("unroll") for (int m = 0; m < 4; ++m) _Pragma("unroll") for (int n = 0; n < 2; ++n) _Pragma("unroll") for (int k = 0; k < 2; ++k) \
        acc[ai][bj][m][n] = __builtin_amdgcn_mfma_f32_16x16x32_bf16(Bt[n][k], At[m][k], acc[ai][bj][m][n], 0, 0, 0); __builtin_amdgcn_s_setprio(0); } while (0)
#define PG8_WAIT_V(n) asm volatile("s_waitcnt vmcnt(" #n ")" ::: "memory")
#define PG8_WAIT_L(n) asm volatile("s_waitcnt lgkmcnt(" #n ")" ::: "memory")
#define PG8_WAIT_V8R(rlx) asm volatile("s_waitcnt vmcnt(32)\n\ts_cmp_lg_u32 %0, 0\n\ts_cbranch_scc1 1f\n\ts_waitcnt vmcnt(8)\n1:" :: "s"(rlx) : "memory", "scc")
#define PG8_BAR __builtin_amdgcn_s_barrier()
#define PG8_SCHED __builtin_amdgcn_sched_barrier(0)
    Unit cur, nxt; int ui = 0;
    if (!S.next(0, cur)) return;
    f32x4 acc[2][2][4][2];
    acc_init(E, acc, cur, wid_s);
    float pv[8]; epi_pre(E, pv, cur, wid_s);
    bf16x8 At[4][2], B0[2][2], B1[2][2];
    const char* cA = (const char*)(cur.z ? g.A2 : g.A) + (size_t)cur.pm * tstep; const char* cB = (const char*)(cur.z ? g.Bt2 : g.Bt) + (size_t)cur.pn * tstep;
    S.a_ready(cur);
    if constexpr (SP2) {
        PG8_STAGE(PG8_SB(0, 0), cB, voffB); PG8_STAGE(PG8_SB(0, 1), cB + hstep, voffB); PG8_STAGE(PG8_SA(0, 0), cA, voffA); PG8_STAGE(PG8_SA(0, 1), cA + hstep, voffA);
        if (wr == 1) PG8_BAR;
        PG8_WAIT_V(2); PG8_BAR;
        PG8_STAGE(PG8_SB(1, 0), cB + kstep, voffB); PG8_STAGE(PG8_SA(1, 0), cA + kstep, voffA); PG8_STAGE(PG8_SB(1, 1), cB + hstep + kstep, voffB);
        PG8_WAIT_V(6); PG8_BAR;
    } else {
        PG8_STAGE(PG8_SB(0, 0), cB, voffB); PG8_STAGE(PG8_SA(0, 0), cA, voffA); PG8_STAGE(PG8_SB(0, 1), cB + hstep, voffB); PG8_STAGE(PG8_SA(0, 1), cA + hstep, voffA);
        if (wr == 1) PG8_BAR;
        PG8_WAIT_V(4); PG8_BAR;
        PG8_STAGE(PG8_SB(1, 0), cB + kstep, voffB); PG8_STAGE(PG8_SA(1, 0), cA + kstep, voffA); PG8_STAGE(PG8_SB(1, 1), cB + hstep + kstep, voffB);
        PG8_WAIT_V(6); PG8_BAR;
    }
    for (;;) {
        const bool has_next = S.next(ui + 1, nxt);
        const char* nA = has_next ? (const char*)(nxt.z ? g.A2 : g.A) + (size_t)nxt.pm * tstep : cA; const char* nB = has_next ? (const char*)(nxt.z ? g.Bt2 : g.Bt) + (size_t)nxt.pn * tstep : cB;
        for (int t = 0; t < nt; t += 2) {
            const bool last = (t == nt - 2);
            const char* a1 = cA + (size_t)(t + 1) * kstep;
            const char* a2 = last ? nA : cA + (size_t)(t + 2) * kstep; const char* b2 = last ? nB : cB + (size_t)(t + 2) * kstep;
            const char* a3 = a2 + kstep; const char* b3 = b2 + kstep;
            if (last && has_next) S.a_ready(nxt);
            if constexpr (SP2) {
            const int rlx = (Epi_relax<Epi>::value == 24) ? __builtin_amdgcn_readfirstlane((t == 0 && ui > 0) ? 1 : 0) : 0;
            PG8_LDB(B0, 0, 0); PG8_LDB(B1, 0, 1); PG8_SCHED; PG8_LDA(At, 0, 0); PG8_STAGE(PG8_SA(1, 1), a1 + hstep, voffA);
            PG8_WAIT_V8R(rlx); PG8_WAIT_L(0); PG8_BAR; PG8_MMA(0, 0, At, B0); PG8_MMA(0, 1, At, B1); PG8_BAR; PG8_SCHED;
            PG8_LDA(At, 0, 1); PG8_STAGE(PG8_SB(0, 0), b2, voffB); PG8_STAGE(PG8_SB(0, 1), b2 + hstep, voffB); PG8_STAGE(PG8_SA(0, 0), a2, voffA);
            PG8_WAIT_V8R(rlx); PG8_WAIT_L(0); PG8_BAR; PG8_MMA(1, 0, At, B0); PG8_MMA(1, 1, At, B1); PG8_BAR; PG8_SCHED;
            PG8_LDB(B0, 1, 0); PG8_LDB(B1, 1, 1); PG8_SCHED; PG8_LDA(At, 1, 0); PG8_STAGE(PG8_SA(0, 1), a2 + hstep, voffA);
            PG8_WAIT_V(8); PG8_WAIT_L(0); PG8_BAR; PG8_MMA(0, 0, At, B0); PG8_MMA(0, 1, At, B1); PG8_BAR; PG8_SCHED;
            PG8_LDA(At, 1, 1); PG8_STAGE(PG8_SB(1, 0), b3, voffB); PG8_STAGE(PG8_SB(1, 1), b3 + hstep, voffB); PG8_STAGE(PG8_SA(1, 0), a3, voffA);
            PG8_WAIT_V(8); PG8_WAIT_L(0); PG8_BAR; PG8_MMA(1, 0, At, B0); PG8_MMA(1, 1, At, B1); PG8_BAR; PG8_SCHED;
            } else {
            PG8_LDB(B0, 0, 0); PG8_SCHED; PG8_LDA(At, 0, 0); PG8_STAGE(PG8_SA(1, 1), a1 + hstep, voffA);
            PG8_WAIT_L(8); PG8_BAR; PG8_WAIT_L(0); PG8_MMA(0, 0, At, B0); PG8_BAR; PG8_SCHED;
            PG8_LDB(B1, 0, 1); PG8_STAGE(PG8_SB(0, 0), b2, voffB);
            PG8_BAR; PG8_WAIT_L(0); PG8_MMA(0, 1, At, B1); PG8_BAR;
            PG8_LDA(At, 0, 1); PG8_STAGE(PG8_SA(0, 0), a2, voffA);
            PG8_BAR; PG8_WAIT_L(0); PG8_MMA(1, 0, At, B0); PG8_BAR; PG8_SCHED;
            PG8_STAGE(PG8_SB(0, 1), b2 + hstep, voffB);
            PG8_WAIT_V(6); PG8_BAR; PG8_MMA(1, 1, At, B1); PG8_BAR;
            PG8_LDB(B0, 1, 0); PG8_SCHED; PG8_LDA(At, 1, 0); PG8_STAGE(PG8_SA(0, 1), a2 + hstep, voffA);
            PG8_WAIT_L(8); PG8_BAR; PG8_WAIT_L(0); PG8_MMA(0, 0, At, B0); PG8_BAR; PG8_SCHED;
            PG8_LDB(B1, 1, 1); PG8_STAGE(PG8_SB(1, 0), b3, voffB);
            PG8_BAR; PG8_WAIT_L(0); PG8_MMA(0, 1, At, B1); PG8_BAR;
            PG8_LDA(At, 1, 1); PG8_STAGE(PG8_SA(1, 0), a3, voffA);
            PG8_BAR; PG8_WAIT_L(0); PG8_MMA(1, 0, At, B0); PG8_BAR; PG8_SCHED;
            PG8_STAGE(PG8_SB(1, 1), b3 + hstep, voffB);
            PG8_WAIT_V(6); PG8_BAR; PG8_MMA(1, 1, At, B1); PG8_BAR;
            }
        }
        if constexpr (ALIGN_EPI) { if (wr == 0) PG8_BAR; }
        { const int t2 = opaque_tid(wid_s), w2 = __builtin_amdgcn_readfirstlane(t2 >> 6); epi_call(E, acc, cur, w2 >> 2, w2 & 3, t2 & 15, (t2 & 63) >> 4, pv); }
        if (!has_next) break;
        acc_init(E, acc, nxt, wid_s); epi_pre(E, pv, nxt, wid_s);
        cur = nxt; cA = nA; cB = nB; ++ui;
        if constexpr (ALIGN_EPI) { if (wr == 1) PG8_BAR; }
    }
    PG8_WAIT_V(0);
    if constexpr (!ALIGN_EPI) { if (wr == 0) PG8_BAR; }
    PG8_BAR;
#undef PG8_SA
#undef PG8_SB
#undef PG8_STAGE
#undef PG8_LDA
#undef PG8_LDB
#undef PG8_MMA
#undef PG8_WAIT_V
#undef PG8_WAIT_L
#undef PG8_BAR
#undef PG8_SCHED
}
}

typedef f32x4 AccT[2][2][4][2];

#define GAS __attribute__((address_space(1)))
__device__ __forceinline__ void stg16(void* p, u32x4 w) { *(GAS u32x4*)p = w; }
__device__ __forceinline__ void store8_bf16(bf16_t* p, const float (&v)[8]) {
    u32x4 w; w.x = cvt_pk_bf16(v[0], v[1]); w.y = cvt_pk_bf16(v[2], v[3]); w.z = cvt_pk_bf16(v[4], v[5]); w.w = cvt_pk_bf16(v[6], v[7]);
    stg16(p, w);
}
__device__ __forceinline__ void cvt8_bf16(const u32x4 w, float (&v)[8]) {
    v[0] = bflo(w.x); v[1] = bfhi(w.x); v[2] = bflo(w.y); v[3] = bfhi(w.y); v[4] = bflo(w.z); v[5] = bfhi(w.z); v[6] = bflo(w.w); v[7] = bfhi(w.w);
}
__device__ __forceinline__ u32x4 ldg16(const void* p) { return *(const GAS u32x4*)p; }
__device__ __forceinline__ u32x4 ldg16_nt(const void* p) { return __builtin_nontemporal_load((const GAS u32x4*)p); }
__device__ __forceinline__ u32x2 ldg8_nt(const void* p) { return __builtin_nontemporal_load((const GAS u32x2*)p); }
__device__ __forceinline__ unsigned ldg4_nt(const void* p) { return __builtin_nontemporal_load((const GAS unsigned*)p); }
__device__ __forceinline__ unsigned ldg4_nt(const GAS unsigned char* p) { return __builtin_nontemporal_load((const GAS unsigned*)p); }
__device__ __forceinline__ f32x4 ldgf4(const float* p) { return *(const GAS f32x4*)p; }
__device__ __forceinline__ f32x4 ldgf4_nt(const float* p) { return __builtin_nontemporal_load((const GAS f32x4*)p); }
__device__ __forceinline__ float ldgf(const float* p) { return *(const GAS float*)p; }
__device__ __forceinline__ void load8_bf16(const bf16_t* p, float (&v)[8]) { cvt8_bf16(ldg16(p), v); }
__device__ __forceinline__ void store8_f32(float* p, const float (&v)[8]) {
    stg16(p, __builtin_bit_cast(u32x4, (f32x4){v[0], v[1], v[2], v[3]})); stg16(p + 4, __builtin_bit_cast(u32x4, (f32x4){v[4], v[5], v[6], v[7]}));
}
__device__ __forceinline__ void load8_f32(const float* p, float (&v)[8]) {
    const f32x4 a = ldgf4(p), b = ldgf4(p + 4);
    v[0] = a[0]; v[1] = a[1]; v[2] = a[2]; v[3] = a[3]; v[4] = b[0]; v[5] = b[1]; v[6] = b[2]; v[7] = b[3];
}
__device__ __forceinline__ void acc8(const AccT& acc, int ai, int bj, int m, float (&v)[8]) {
    const f32x4 a = acc[ai][bj][m][0], b = acc[ai][bj][m][1];
    v[0] = a[0]; v[1] = a[1]; v[2] = a[2]; v[3] = a[3]; v[4] = b[0]; v[5] = b[1]; v[6] = b[2]; v[7] = b[3];
}
#define EPI_FENCE() asm volatile("" ::: "memory")
__device__ __forceinline__ void load_rs8(const float* ssq, int row0, float (&rs)[8]) {
#pragma unroll
    for (int i = 0; i < 8; ++i) rs[i] = ldgf(ssq + row0 + (i >> 2) * 128 + (i & 3) * 16);
#pragma unroll
    for (int i = 0; i < 8; ++i) rs[i] = rsqrtf(rs[i] * (1.0f / DM) + EPS);
}

template <int ACT> __device__ __forceinline__ void epi_plain(const AccT& acc, const float (&rs)[8], bf16_t* dst, int ld, int row0, int c0) {
#pragma unroll
    for (int ai = 0; ai < 2; ++ai)
#pragma unroll
        for (int m = 0; m < 4; ++m) {
            const int row = row0 + ai * 128 + m * 16; const float r = rs[ai * 4 + m];
            const float rn = r * NLOG2E;
#pragma unroll
            for (int bj = 0; bj < 2; ++bj) { u32x4 w;
#pragma unroll
                for (int p = 0; p < 4; ++p) { const f32x4 a4 = acc[ai][bj][m][p >> 1]; const f32x2 a = (p & 1) ? __builtin_shufflevector(a4, a4, 2, 3) : __builtin_shufflevector(a4, a4, 0, 1);
                    f32x2 z = a * r; if (ACT == 1) z = z * sig2(a, rn); if (ACT == 2) z = sig2(a, rn);
                    w[p] = cvt_pk_bf16(z.x, z.y); }
                stg16(dst + ((size_t)((c0 >> 7) + bj) * SEQ + row) * 128 + (c0 & 127), w); }
        }
}
__device__ __forceinline__ void epi_gate8(const AccT& acc, const float (&rs)[8], unsigned char* dst, int row0, int c0) {
#pragma unroll
    for (int ai = 0; ai < 2; ++ai)
#pragma unroll
        for (int m = 0; m < 4; ++m) {
            const int row = row0 + ai * 128 + m * 16; const float r = rs[ai * 4 + m];
            const float rn = r * NLOG2E;
#pragma unroll
            for (int bj = 0; bj < 2; ++bj) { unsigned q[8];
#pragma unroll
                for (int p = 0; p < 4; ++p) { const f32x4 a4 = acc[ai][bj][m][p >> 1]; const f32x2 a = (p & 1) ? __builtin_shufflevector(a4, a4, 2, 3) : __builtin_shufflevector(a4, a4, 0, 1);
                    const f32x2 g = sig2(a, rn) * 255.f + 0.5f;
                    q[2 * p] = max((unsigned)g.x, 1u); q[2 * p + 1] = max((unsigned)g.y, 1u); }
                u32x2 w; w.x = q[0] | (q[1] << 8) | (q[2] << 16) | (q[3] << 24); w.y = q[4] | (q[5] << 8) | (q[6] << 16) | (q[7] << 24);
                *(GAS u32x2*)(dst + (size_t)row * DM + c0 + bj * 128) = w; }
        }
}
__device__ __forceinline__ void cvt8_u8(const u32x2 w, float (&v)[8]) {
#pragma unroll
    for (int e = 0; e < 8; ++e) v[e] = (float)(((e < 4 ? w.x : w.y) >> (8 * (e & 3))) & 0xffu) * (1.0f / 255.f);
}
__device__ __forceinline__ u32x2 ldg8(const void* p) { return *(const GAS u32x2*)p; }
struct EpiInProj {
    static constexpr bool PERM = true;
    static constexpr int RELAX = 24;
    const float* ssq; const float* lower; unsigned char* ws;
    __device__ __forceinline__ void pre(float (&pv)[8], const pg8::Unit& u, int wid_s) const {
        const int t = opaque_tid(wid_s), row0 = u.pm * 256 + ((t >> 6) >> 2) * 64 + (t & 15);
#pragma unroll
        for (int i = 0; i < 8; ++i) pv[i] = ldgf(ssq + row0 + (i >> 2) * 128 + (i & 3) * 16);
    }
    __device__ __forceinline__ void operator()(const AccT& acc, const pg8::Unit& u, int wr, int wc, int fr, int fq, const float (&pv)[8]) const {
        const int colt = u.pn * 256, seg = colt >> 10;
        const int row0 = u.pm * 256 + wr * 64 + fr;
        const int cin = wc * 32 + 8 * fq;
        const int cseg = (colt & 1023) + cin;
        float rs[8];
#pragma unroll
        for (int i = 0; i < 8; ++i) rs[i] = rsqrtf(pv[i] * (1.0f / DM) + EPS);
        if (seg == 2 || seg == 3) {
            const int dir = seg - 2;
            unsigned short* G = (unsigned short*)(ws + (dir ? WS_GB : WS_GF));
#pragma unroll
            for (int bj = 0; bj < 2; ++bj) {
                const int c = cseg + bj * 128; float lb[8]; load8_f32(lower + dir * 1024 + c, lb);
#pragma unroll
                for (int ai = 0; ai < 2; ++ai)
#pragma unroll
                    for (int m = 0; m < 4; ++m) {
                        const int row = row0 + ai * 128 + m * 16; const float r = rs[ai * 4 + m];
                        float lg[8]; const float rn = r * NLOG2E;
#pragma unroll
                        for (int p = 0; p < 4; ++p) { const f32x4 a4 = acc[ai][bj][m][p >> 1]; const f32x2 a = (p & 1) ? __builtin_shufflevector(a4, a4, 2, 3) : __builtin_shufflevector(a4, a4, 0, 1);
                            const f32x2 l2 = (f32x2){lb[2 * p], lb[2 * p + 1]};
                            const f32x2 f = l2 + (1.0f - l2) * sig2(a, rn);
                            const f32x2 lf = (f32x2){__builtin_amdgcn_logf(fmaxf(f.x, 1e-6f)), __builtin_amdgcn_logf(fmaxf(f.y, 1e-6f))} * 0.6931471805599453f;
                            lg[2 * p] = lf.x; lg[2 * p + 1] = lf.y; }
                        { u32x4 wg; wg.x = cvt_pk_f16(lg[0], lg[1]); wg.y = cvt_pk_f16(lg[2], lg[3]); wg.z = cvt_pk_f16(lg[4], lg[5]); wg.w = cvt_pk_f16(lg[6], lg[7]); *(GAS u32x4*)(G + ((size_t)(c >> 7) * SEQ + row) * 128 + (c & 127)) = wg; }
                    }
            }
        } else if (seg == 7) epi_plain<0>(acc, rs, (bf16_t*)(ws + WS_VT), HW, row0, cseg);
        else if (seg == 0) epi_plain<1>(acc, rs, (bf16_t*)(ws + WS_QH), HW, row0, cseg);
        else if (seg == 1) epi_plain<0>(acc, rs, (bf16_t*)(ws + WS_VH), HW, row0, cseg);
        else if (seg == 4) epi_plain<1>(acc, rs, (bf16_t*)(ws + WS_HG), HW, row0, cseg);
        else if (seg == 5) epi_plain<0>(acc, rs, (bf16_t*)(ws + WS_NQ), HW, row0, cseg);
        else if (seg == 6) {
            bf16_t* NK = (bf16_t*)(ws + WS_NK); float* RKS = (float*)(ws + WS_RKS); const int hd0 = (colt & 1023) >> 7;
#pragma unroll
            for (int ai = 0; ai < 2; ++ai)
#pragma unroll
                for (int m = 0; m < 4; ++m) { const int row = row0 + ai * 128 + m * 16; const float r = rs[ai * 4 + m];
#pragma unroll
                    for (int bj = 0; bj < 2; ++bj) { float v[8]; acc8(acc, ai, bj, m, v); float s = 0.f;
#pragma unroll
                        for (int e = 0; e < 8; ++e) { v[e] *= r; s += v[e] * v[e]; }
                        store8_bf16(NK + ((size_t)((cseg >> 7) + bj) * SEQ + row) * 128 + (cseg & 127), v);
                        s += __shfl_xor(s, 16); s += __shfl_xor(s, 32);
                        if (fq == 0) atomicAdd(RKS + row * 8 + hd0 + bj, s); } }
        }
        else if (seg == 8) epi_plain<1>(acc, rs, (bf16_t*)(ws + WS_NG), HW, row0, cseg);
        else if (seg < 11) epi_gate8(acc, rs, (unsigned char*)(ws + WS_MA), row0, colt - 9216 + cin);
        else epi_gate8(acc, rs, (unsigned char*)(ws + WS_MB), row0, colt - 11264 + cin);
    }
};

struct EpiMBTail {
    static constexpr bool PERM = true;
    const float* ssq; unsigned char* MB;
    __device__ __forceinline__ void operator()(const AccT& acc, const pg8::Unit& u, int wr, int wc, int fr, int fq) const {
        const int row0 = u.pm * 256 + wr * 64 + fr;
        float rs[8]; load_rs8(ssq, row0, rs);
        epi_gate8(acc, rs, MB, row0, 1024 + u.pn * 256 + wc * 32 + 8 * fq);
    }
};

#define EPI_IT(it, ai, m, bj) const int ai = (it) >> 3, m = ((it) >> 1) & 3, bj = (it) & 1
struct EpiBranch {
    static constexpr bool PERM = true;
    const unsigned char* MA; const unsigned char* MB; bf16_t* Y;
    __device__ __forceinline__ void init(AccT& acc, const pg8::Unit& u, int) const { if (u.z == 0) pg8::acc_zero(acc); }
    __device__ __forceinline__ void operator()(AccT& acc, const pg8::Unit& u, int wr, int wc, int fr, int fq) const {
        const int row0 = u.pm * 256 + wr * 64 + fr, c0 = u.pn * 256 + wc * 32 + 8 * fq;
        if (u.z == 0) {
            u32x2 ga[2], gb[2];
            { const size_t o = (size_t)row0 * DM + c0; ga[0] = ldg8(MA + o); gb[0] = ldg8_nt(MB + o); }
#pragma unroll
            for (int it = 0; it < 16; ++it) { EPI_IT(it, ai, m, bj);
                if (it + 1 < 16) { EPI_IT(it + 1, ai2, m2, bj2); const size_t o = (size_t)(row0 + ai2 * 128 + m2 * 16) * DM + c0 + bj2 * 128; const int b = (it + 1) & 1; ga[b] = ldg8(MA + o); gb[b] = ldg8_nt(MB + o); }
                const u32x2 wa = ga[it & 1], wb = gb[it & 1];
#pragma unroll
                for (int p = 0; p < 4; ++p) { const unsigned ua = (p < 2 ? wa.x : wa.y) >> (16 * (p & 1)), ub = (p < 2 ? wb.x : wb.y) >> (16 * (p & 1));
                    const f32x2 qa = (f32x2){(float)(ua & 0xffu), (float)((ua >> 8) & 0xffu)}, qb = (f32x2){(float)(ub & 0xffu), (float)((ub >> 8) & 0xffu)};
                    const f32x2 ratio = qb * rcp_2(qa);
                    f32x4& a4 = acc[ai][bj][m][p >> 1];
                    if (p & 1) { a4[2] *= ratio.x; a4[3] *= ratio.y; } else { a4[0] *= ratio.x; a4[1] *= ratio.y; } }
                EPI_FENCE(); }
        } else {
            u32x2 g[2];
            g[0] = ldg8_nt(MA + (size_t)row0 * DM + c0);
#pragma unroll
            for (int it = 0; it < 16; ++it) { EPI_IT(it, ai, m, bj);
                const size_t off = (size_t)(row0 + ai * 128 + m * 16) * DM + c0 + bj * 128;
                if (it + 1 < 16) { EPI_IT(it + 1, ai2, m2, bj2); g[(it + 1) & 1] = ldg8_nt(MA + (size_t)(row0 + ai2 * 128 + m2 * 16) * DM + c0 + bj2 * 128); }
                float v[8], gg[8]; acc8(acc, ai, bj, m, v); cvt8_u8(g[it & 1], gg);
#pragma unroll
                for (int e = 0; e < 8; ++e) v[e] *= gg[e];
                store8_bf16(Y + off, v); EPI_FENCE(); }
        }
    }
};
struct EpiWout {
    static constexpr bool PERM = true;
    const bf16_t* xin; bf16_t* XB1; float* ssq_out;
    __device__ __forceinline__ void operator()(const AccT& acc, const pg8::Unit& u, int wr, int wc, int fr, int fq) const {
        const int row0 = u.pm * 256 + wr * 64 + fr, c0 = u.pn * 256 + wc * 32 + 8 * fq;
        u32x4 xb[2];
        xb[0] = ldg16_nt(xin + (size_t)row0 * DM + c0);
        float s = 0.f;
#pragma unroll
        for (int it = 0; it < 16; ++it) { EPI_IT(it, ai, m, bj);
            const int row = row0 + ai * 128 + m * 16; const size_t off = (size_t)row * DM + c0 + bj * 128;
            if (it + 1 < 16) { EPI_IT(it + 1, ai2, m2, bj2); xb[(it + 1) & 1] = ldg16_nt(xin + (size_t)(row0 + ai2 * 128 + m2 * 16) * DM + c0 + bj2 * 128); }
            float v[8], xi[8]; acc8(acc, ai, bj, m, v); cvt8_bf16(xb[it & 1], xi);
#pragma unroll
            for (int e = 0; e < 8; ++e) { v[e] += xi[e]; s += v[e] * v[e]; }
            store8_bf16(XB1 + off, v);
            if (bj == 1) { s += __shfl_xor(s, 16); s += __shfl_xor(s, 32); if (fq == 0) atomicAdd(ssq_out + row, s); s = 0.f; }
            EPI_FENCE(); }
    }
};
struct EpiPL {
    static constexpr bool PERM = true;
    bf16_t* PL;
    __device__ __forceinline__ void operator()(const AccT& acc, const pg8::Unit& u, int wr, int wc, int fr, int fq) const {
        const int row0 = u.pm * 256 + wr * 64 + fr, c0 = u.pn * 256 + wc * 32 + 8 * fq;
#pragma unroll
        for (int ai = 0; ai < 2; ++ai)
#pragma unroll
            for (int m = 0; m < 4; ++m) { const int row = row0 + ai * 128 + m * 16;
#pragma unroll
                for (int bj = 0; bj < 2; ++bj) { float v[8]; acc8(acc, ai, bj, m, v); store8_bf16(PL + (size_t)row * DM + c0 + bj * 128, v); } }
    }
};
struct EpiGate {
    static constexpr bool PERM = true;
    const float* ssq1; const bf16_t* XB1; const bf16_t* PL; float* xout; bf16_t* XBN; float* ssq_next; int has_next;
    __device__ __forceinline__ void operator()(const AccT& acc, const pg8::Unit& u, int wr, int wc, int fr, int fq) const {
        const int row0 = u.pm * 256 + wr * 64 + fr, c0 = u.pn * 256 + wc * 32 + 8 * fq;
        u32x4 xb[2], pb[2]; float sq[2];
        { const size_t o = (size_t)row0 * DM + c0; xb[0] = ldg16(XB1 + o); pb[0] = ldg16_nt(PL + o); sq[0] = ldgf(ssq1 + row0); }
        float s = 0.f;
#pragma unroll
        for (int it = 0; it < 16; ++it) { EPI_IT(it, ai, m, bj);
            const int row = row0 + ai * 128 + m * 16; const size_t off = (size_t)row * DM + c0 + bj * 128;
            if (it + 1 < 16) { EPI_IT(it + 1, ai2, m2, bj2); const int rown = row0 + ai2 * 128 + m2 * 16; const size_t o = (size_t)rown * DM + c0 + bj2 * 128; const int b = (it + 1) & 1;
                xb[b] = ldg16(XB1 + o); pb[b] = ldg16_nt(PL + o); sq[b] = ldgf(ssq1 + rown); }
            const float r = rsqrtf(sq[it & 1] * (1.0f / DM) + EPS);
            float v[8], x1[8], pl[8]; acc8(acc, ai, bj, m, v); cvt8_bf16(xb[it & 1], x1); cvt8_bf16(pb[it & 1], pl);
#pragma unroll
            for (int p = 0; p < 4; ++p) { const f32x2 g = sig2((f32x2){v[2 * p], v[2 * p + 1]}, r * NLOG2E);
                const f32x2 y = (f32x2){x1[2 * p], x1[2 * p + 1]} + (f32x2){pl[2 * p], pl[2 * p + 1]} * g; v[2 * p] = y.x; v[2 * p + 1] = y.y; s += y.x * y.x + y.y * y.y; }
            if (has_next) { store8_bf16(XBN + off, v);
                if (bj == 1) { s += __shfl_xor(s, 16); s += __shfl_xor(s, 32); if (fq == 0) atomicAdd(ssq_next + row, s); s = 0.f; } }
            else store8_f32(xout + off, v);
            EPI_FENCE(); }
    }
};

#define XB_TMO      128
#define XB_XCNT(j)  (256  + 64 * (j))
#define XB_XSUB(j)  (1280 + 64 * (j))
#define XB_XGEN(j)  (2304 + 64 * (j))
#define XB_TOP      3328
#define XB_TOPGEN   3392
#define XCD_BAR_WORDS 3456
#define XB_SPIN_CAP (1u << 18)
__device__ __forceinline__ unsigned xb_ld(unsigned* p)              { return __hip_atomic_load(p, __ATOMIC_RELAXED, __HIP_MEMORY_SCOPE_AGENT); }
__device__ __forceinline__ unsigned xb_add(unsigned* p, unsigned v) { return __hip_atomic_fetch_add(p, v, __ATOMIC_RELAXED, __HIP_MEMORY_SCOPE_AGENT); }
__device__ __forceinline__ unsigned xb_xcc_id() { return (unsigned)__builtin_amdgcn_s_getreg((3 << 11) | 20) & 0xFu; }
#define XB_SPIN(cond, bar) do { unsigned _sp = 0; while (cond) { __builtin_amdgcn_s_sleep(1); \
    if ((++_sp & 255u) == 0u) { if (xb_ld(&(bar)[XB_TMO])) break; if (_sp > XB_SPIN_CAP) { atomicAdd(&(bar)[XB_TMO], 1u); break; } } } } while (0)
struct XcdBarrier { unsigned* bar; unsigned x; volatile LAS unsigned* st; };
__device__ __forceinline__ XcdBarrier xcd_barrier_post(unsigned* bar, volatile LAS unsigned* st) {
    XcdBarrier b; b.bar = bar; b.x = xb_xcc_id(); b.st = st;
    if (threadIdx.x == 0) (void)xb_add(&bar[XB_XCNT(b.x)], 1u);
    return b;
}
__device__ __forceinline__ void xcd_barrier_complete(unsigned* bar, unsigned x, unsigned& nloc, unsigned& nx) {
    const unsigned G = gridDim.x * gridDim.y * gridDim.z;
    unsigned sum, cnt, mine, sp = 0u;
    for (;;) {
        sum = 0u; cnt = 0u; mine = 0u;
#pragma unroll
        for (unsigned j = 0; j < 16; ++j) { const unsigned c = xb_ld(&bar[XB_XCNT(j)]); sum += c; cnt += (c > 0u) ? 1u : 0u; mine = (j == x) ? c : mine; }
        if (sum == G) break;
        __builtin_amdgcn_s_sleep(1);
        if ((++sp & 255u) == 0u) { if (xb_ld(&bar[XB_TMO])) break; if (sp > XB_SPIN_CAP) { atomicAdd(&bar[XB_TMO], 1u); break; } }
    }
    nloc = mine > 0u ? mine : 1u; nx = cnt > 0u ? cnt : 1u;
}
#define XB_KBASE   1536
#define XB_KSTRIDE 576
__device__ __forceinline__ void xcd_arrive(const XcdBarrier& b, int k) {
    asm volatile("s_waitcnt vmcnt(0)" ::: "memory");
    __syncthreads();
    if (threadIdx.x == 0) {
        unsigned* bar = b.bar;
        __builtin_amdgcn_s_waitcnt(0);
        unsigned nloc = b.st[0], nx = b.st[1];
        if (nloc == 0u) { xcd_barrier_complete(bar, b.x, nloc, nx); b.st[0] = nloc; b.st[1] = nx; }
        unsigned* kb = bar + XB_KBASE + k * XB_KSTRIDE;
        const unsigned old = xb_add(&kb[b.x * 32u], 1u);
        if (old + 1u == nloc) {
            __builtin_amdgcn_fence(__ATOMIC_RELEASE, "agent");
            asm volatile("s_waitcnt vmcnt(0)" ::: "memory");
            (void)xb_add(&kb[512], 1u);
        }
    }
}
__device__ __forceinline__ void xcd_wait(const XcdBarrier& b, int k) {
    if (threadIdx.x == 0) {
        unsigned* bar = b.bar; unsigned* kb = bar + XB_KBASE + k * XB_KSTRIDE;
        const unsigned nx = b.st[1];
        XB_SPIN(xb_ld(&kb[512]) < nx, bar);
        __builtin_amdgcn_fence(__ATOMIC_ACQUIRE, "agent");
        asm volatile("s_waitcnt vmcnt(0)" ::: "memory");
    }
    __syncthreads();
}

struct Args { const float* in[15]; float* out; unsigned char* ws; int ph_lo, ph_hi; };
constexpr int CONV_NTILE = 3200 + 9856;
constexpr int CONV_NBATCH = CONV_NTILE / 4;
constexpr int CONV_D_WP0 = 128 / 4, CONV_D_BR0 = 1152 / 4, CONV_D_WO0 = 2176 / 4, CONV_D_WG0 = 3200 / 4, CONV_D_IN1 = 9984 / 4;
__device__ __forceinline__ void conv_fill(const Args& a, LAS unsigned char* lds, int wid_s, unsigned* flag, unsigned nxv, volatile LAS unsigned* lw) {
    unsigned char* ws = opaque_ptr(a.ws);
    const int tid = opaque_tid(wid_s);
    unsigned* ticket = (unsigned*)(ws + WS_CTL) + 64;
    LAS float* tiles = (LAS float*)lds;
    const int k0 = tid >> 4, c4 = tid & 15, n = tid >> 3, kq = tid & 7;
    if (tid == 0) { int p = (int)lw[1] - 1; const unsigned f0 = flag ? (xb_ld(flag) >= nxv ? 1u : 0u) : 0u; if (p < 0) p = (int)xb_add(ticket, 1u); lw[1] = 0u; lw[0] = (unsigned)p; lw[2] = flag ? f0 : ((unsigned)p >= nxv ? 1u : 0u); }
    for (;;) {
        __syncthreads();
        const int t = __builtin_amdgcn_readfirstlane((int)lw[0]); const unsigned stop = __builtin_amdgcn_readfirstlane(lw[2]);
        if (t >= CONV_NBATCH) break;
        if (stop) { if (tid == 0) lw[1] = (unsigned)t + 1u; break; }
        unsigned tn = 0u, fn = 0u;
        if (tid == 0) { tn = xb_add(ticket, 1u); fn = flag ? xb_ld(flag) : 0u; }
        const int ft = 4 * t;
        int kind, lay, base;
        if (ft < 3200) { lay = 0; if (ft < 128) { kind = 5; base = 0; } else if (ft < 640) { kind = 1; base = 128; } else if (ft < 1152) { kind = 2; base = 640; } else if (ft < 2176) { kind = 3; base = 1152; } else { kind = 4; base = 2176; } }
        else { lay = 1; if (ft < 9856) { kind = 0; base = 3200; } else if (ft < 9984) { kind = 5; base = 9856; } else if (ft < 10496) { kind = 1; base = 9984; } else if (ft < 11008) { kind = 2; base = 10496; } else if (ft < 12032) { kind = 3; base = 11008; } else { kind = 4; base = 12032; } }
        const float* W; bf16_t* WT; int K, N; const float* ksc = nullptr;
        if (kind == 0)      { W = a.in[3] + (size_t)lay * DM * NIN;  WT = (bf16_t*)(ws + WS_WIN) + (size_t)lay * NIN * DM; K = DM;  N = NIN; ksc = a.in[2] + lay * DM; }
        else if (kind == 1) { W = a.in[9] + (size_t)lay * HW * DM;   WT = (bf16_t*)(ws + WS_WA) + (size_t)lay * DM * HW;   K = HW;  N = DM; }
        else if (kind == 2) { W = a.in[10] + (size_t)lay * HW * DM;  WT = (bf16_t*)(ws + WS_WB) + (size_t)lay * DM * HW;   K = HW;  N = DM; }
        else if (kind == 3) { W = a.in[11] + (size_t)lay * DM * DM;  WT = (bf16_t*)(ws + WS_WO) + (size_t)lay * DM * DM;   K = DM;  N = DM; }
        else if (kind == 4) { W = a.in[13] + (size_t)lay * DM * DM;  WT = (bf16_t*)(ws + WS_WG) + (size_t)lay * DM * DM;   K = DM;  N = DM; ksc = a.in[12] + lay * DM; }
        else                { W = a.in[14] + (size_t)lay * PLE * DM; WT = (bf16_t*)(ws + WS_WP) + (size_t)lay * DM * PLE;  K = PLE; N = DM; }
        const int nkt = K / 64;
        f32x4 v[4][2];
#pragma unroll
        for (int q = 0; q < 4; ++q) { const int lt = ft + q - base, tk = lt % nkt, tc = lt / nkt;
            const float* s_ = W + (size_t)(tk * 64 + k0) * N + tc * 64 + c4 * 4;
            v[q][0] = ldgf4_nt(s_); v[q][1] = ldgf4_nt(s_ + (size_t)32 * N);
            if (ksc) { v[q][0] = v[q][0] * ldgf(ksc + tk * 64 + k0); v[q][1] = v[q][1] * ldgf(ksc + tk * 64 + k0 + 32); } }
#pragma unroll
        for (int q = 0; q < 4; ++q) { LAS float* d = tiles + q * (64 * 65) + k0 * 65 + c4 * 4;
            d[0] = v[q][0][0]; d[1] = v[q][0][1]; d[2] = v[q][0][2]; d[3] = v[q][0][3]; d += 32 * 65; d[0] = v[q][1][0]; d[1] = v[q][1][1]; d[2] = v[q][1][2]; d[3] = v[q][1][3]; }
        __syncthreads();
#pragma unroll
        for (int q = 0; q < 4; ++q) { const int lt = ft + q - base, tk = lt % nkt, tc = lt / nkt; float o[8];
#pragma unroll
            for (int j = 0; j < 8; ++j) o[j] = tiles[q * (64 * 65) + (kq * 8 + j) * 65 + n];
            store8_bf16(WT + (size_t)(tc * 64 + n) * K + tk * 64 + kq * 8, o); }
        if (tid == 0) { lw[0] = tn; lw[2] = flag ? (fn >= nxv ? 1u : 0u) : (tn >= nxv ? 1u : 0u); }
    }
    __syncthreads();
}


__device__ __forceinline__ void transpose_convert(const float* __restrict__ W, bf16_t* __restrict__ WT, int K, int N, LAS float* tile, int rot, const float* kscale) {
    const int tid = threadIdx.x, nb = gridDim.x; const int bid = (int)((blockIdx.x + (unsigned)rot) % (unsigned)nb);
    const int nkt = K / 64, ntile = nkt * (N / 64);
    const int k0 = tid >> 4, c4 = tid & 15;
    f32x4 v0, v1;
#define TC_LOAD(t_) do { const int tk_ = (t_) % nkt, tn_ = (t_) / nkt; const float* s_ = W + (size_t)(tk_ * 64 + k0) * N + tn_ * 64 + c4 * 4; \
        v0 = ldgf4_nt(s_); v1 = ldgf4_nt(s_ + (size_t)32 * N); if (kscale) { v0 = v0 * ldgf(kscale + tk_ * 64 + k0); v1 = v1 * ldgf(kscale + tk_ * 64 + k0 + 32); } } while (0)
    int t = bid, par = 0;
    if (t < ntile) TC_LOAD(t);
    for (; t < ntile; t += nb, par ^= 1) {
        LAS float* tl = tile + par * (64 * 65);
        { LAS float* d = tl + k0 * 65 + c4 * 4; d[0] = v0[0]; d[1] = v0[1]; d[2] = v0[2]; d[3] = v0[3]; d += 32 * 65; d[0] = v1[0]; d[1] = v1[1]; d[2] = v1[2]; d[3] = v1[3]; }
        const int tk = t % nkt, tn = t / nkt;
        if (t + nb < ntile) TC_LOAD(t + nb);
        __syncthreads();
        { const int n = tid >> 3, kq = tid & 7; float v[8];
#pragma unroll
          for (int j = 0; j < 8; ++j) v[j] = tl[(kq * 8 + j) * 65 + n];
          store8_bf16(WT + (size_t)(tn * 64 + n) * K + tk * 64 + kq * 8, v); }
    }
    __syncthreads();
#undef TC_LOAD
}

__device__ __forceinline__ void p0_prologue(const Args& a, LAS unsigned char* lds, int nlayers) {
    unsigned char* ws = a.ws;
    const int tid = threadIdx.x, bid = blockIdx.x, nb = gridDim.x, gtid = bid * 512 + tid, gsz = nb * 512;
    {
        float* LOWER = (float*)(ws + WS_LOWER); const float* lbp = a.in[4];
        for (int i = gtid; i < 2048; i += gsz) { const float a0 = lbp[i], a1 = lbp[2048 + i]; LOWER[i] = 0.f; LOWER[2048 + i] = 1.f / (1.f + expf(a0 - a1)); }
        float* SSQ = (float*)(ws + WS_SSQ);
        for (int i = gtid; i < 3 * SEQ; i += gsz) SSQ[SEQ + i] = 0.f;
        float* RKS = (float*)(ws + WS_RKS);
        for (int i = gtid; i < SEQ * 8; i += gsz) RKS[i] = 0.f;
    }
    {
        const float* x = a.in[0]; bf16_t* XG = (bf16_t*)(ws + WS_XGA); float* SSQ = (float*)(ws + WS_SSQ);
        const int lane = tid & 63, gw = gtid >> 6, nw = gsz >> 6;
        for (int row = gw; row < SEQ; row += nw) {
            const float* xr = x + (size_t)row * DM; f32x4 v[8]; float s = 0.f;
#pragma unroll
            for (int j = 0; j < 8; ++j) v[j] = ldgf4_nt(xr + (j * 64 + lane) * 4);
#pragma unroll
            for (int j = 0; j < 8; ++j) { s += v[j][0] * v[j][0] + v[j][1] * v[j][1] + v[j][2] * v[j][2] + v[j][3] * v[j][3];
                u32x2 w; w.x = cvt_pk_bf16(v[j][0], v[j][1]); w.y = cvt_pk_bf16(v[j][2], v[j][3]);
                *(GAS u32x2*)(XG + (size_t)row * DM + (j * 64 + lane) * 4) = w; }
#pragma unroll
            for (int o = 32; o >= 1; o >>= 1) s += __shfl_xor(s, o);
            if (lane == 0) SSQ[row] = s;
        }
    }
    {
        const float* p = a.in[1]; bf16_t* PB = (bf16_t*)(ws + WS_PB);
        for (int i = gtid; i < 2 * SEQ * PLE / 16; i += gsz) { f32x4 v[4];
#pragma unroll
            for (int j = 0; j < 4; ++j) v[j] = ldgf4_nt(p + (size_t)i * 16 + j * 4);
            u32x4 w0, w1; w0.x = cvt_pk_bf16(v[0][0], v[0][1]); w0.y = cvt_pk_bf16(v[0][2], v[0][3]); w0.z = cvt_pk_bf16(v[1][0], v[1][1]); w0.w = cvt_pk_bf16(v[1][2], v[1][3]);
            w1.x = cvt_pk_bf16(v[2][0], v[2][1]); w1.y = cvt_pk_bf16(v[2][2], v[2][3]); w1.z = cvt_pk_bf16(v[3][0], v[3][1]); w1.w = cvt_pk_bf16(v[3][2], v[3][3]);
            *(GAS u32x4*)(PB + (size_t)i * 16) = w0; *(GAS u32x4*)(PB + (size_t)i * 16 + 8) = w1; }
    }
    LAS float* tile = (LAS float*)lds;
    if (nlayers < 2) {
        transpose_convert(a.in[3], (bf16_t*)(ws + WS_WIN), DM, NIN, tile, 0, a.in[2]);
        return;
    }
    for (int l = 0; l < 2; ++l) {
        transpose_convert(a.in[3] + (size_t)l * DM * NIN, (bf16_t*)(ws + WS_WIN) + (size_t)l * NIN * DM, DM, NIN, tile, 0, a.in[2] + l * DM);
        transpose_convert(a.in[9] + (size_t)l * HW * DM, (bf16_t*)(ws + WS_WA) + (size_t)l * DM * HW, HW, DM, tile, 0, nullptr);
        transpose_convert(a.in[10] + (size_t)l * HW * DM, (bf16_t*)(ws + WS_WB) + (size_t)l * DM * HW, HW, DM, tile, 0, nullptr);
        transpose_convert(a.in[11] + (size_t)l * DM * DM, (bf16_t*)(ws + WS_WO) + (size_t)l * DM * DM, DM, DM, tile, 0, nullptr);
        transpose_convert(a.in[13] + (size_t)l * DM * DM, (bf16_t*)(ws + WS_WG) + (size_t)l * DM * DM, DM, DM, tile, 0, a.in[12] + l * DM);
        transpose_convert(a.in[14] + (size_t)l * PLE * DM, (bf16_t*)(ws + WS_WP) + (size_t)l * DM * PLE, PLE, DM, tile, 128, nullptr);
    }
}

constexpr int HP_ROWB = 272;
constexpr int HT_ROWB = 144;

__device__ __forceinline__ void hg_cumsum(const float (&gv)[16], int seg, int kc, int dir, LAS float* SEGS, float (&b)[16], float& bref, float& blast) {
    float c = 0.f;
#pragma unroll
    for (int i = 0; i < 16; ++i) { c += gv[i]; b[i] = c; }
    const float tot = c;
    if (dir) {
#pragma unroll
        for (int i = 0; i < 16; ++i) b[i] = tot - b[i] + gv[i];
    }
    SEGS[seg * 128 + kc] = tot;
    __syncthreads();
    const float t0 = SEGS[kc], t1 = SEGS[128 + kc], t2 = SEGS[256 + kc], t3 = SEGS[384 + kc];
    float off;
    if (!dir) { off = (seg > 0 ? t0 : 0.f) + (seg > 1 ? t1 : 0.f) + (seg > 2 ? t2 : 0.f); bref = t0 + t1; }
    else      { off = (seg < 3 ? t3 : 0.f) + (seg < 2 ? t2 : 0.f) + (seg < 1 ? t1 : 0.f); bref = t2 + t3; }
    blast = (t0 + t1) + (t2 + t3);
#pragma unroll
    for (int i = 0; i < 16; ++i) b[i] += off;
}
__device__ __forceinline__ unsigned short ldg_u16(const bf16_t* p) { return *(const GAS bf16_t*)p; }
__device__ __forceinline__ unsigned char ldg_u8(const unsigned char* p) { return *(const GAS unsigned char*)p; }

__device__ __forceinline__ void hg_cumsum2(const float (&g0)[8], const float (&g1)[8], int sg, int cp, int dir, LAS float* SEGS, float (&b0)[8], float (&b1)[8], f32x2& bref, f32x2& blast) {
    float c0 = 0.f, c1 = 0.f;
#pragma unroll
    for (int i = 0; i < 8; ++i) { c0 += g0[i]; b0[i] = c0; c1 += g1[i]; b1[i] = c1; }
    if (dir) {
#pragma unroll
        for (int i = 0; i < 8; ++i) { b0[i] = c0 - b0[i] + g0[i]; b1[i] = c1 - b1[i] + g1[i]; }
    }
    *(LAS f32x2*)(SEGS + sg * 128 + 2 * cp) = (f32x2){c0, c1};
    __syncthreads();
    f32x2 t[8];
#pragma unroll
    for (int s = 0; s < 8; ++s) t[s] = *(const LAS f32x2*)(SEGS + s * 128 + 2 * cp);
    f32x2 off = (f32x2){0.f, 0.f};
#pragma unroll
    for (int s = 0; s < 8; ++s) if (dir ? (s > sg) : (s < sg)) off += t[s];
    const f32x2 lo = (t[0] + t[1]) + (t[2] + t[3]), hi = (t[4] + t[5]) + (t[6] + t[7]);
    bref = dir ? hi : lo; blast = lo + hi;
#pragma unroll
    for (int i = 0; i < 8; ++i) { b0[i] += off.x; b1[i] += off.y; }
}
__device__ __forceinline__ void h1_phase(const Args& a, LAS unsigned char* lds, int wid_s) {
    unsigned char* ws = opaque_ptr(a.ws);
    const int tid = opaque_tid(wid_s), lane = tid & 63, w = __builtin_amdgcn_readfirstlane(tid >> 6), fr = lane & 15, fq = lane >> 4;
    const int cp = tid & 63, sg = w;
    LAS float* SEGS = (LAS float*)lds;
    LAS float* SC = (LAS float*)(lds + 8192);
    LAS unsigned char* KpT = lds + 12288;
    LAS unsigned char* Vt = KpT + 2 * 128 * HT_ROWB;
    const bf16_t* VH = (const bf16_t*)(ws + WS_VH); const bf16_t* GF = (const bf16_t*)(ws + WS_GF); const bf16_t* GB = (const bf16_t*)(ws + WS_GB);
    bf16_t* LT = (bf16_t*)(ws + WS_LT); float* DD = (float*)(ws + WS_DD); float* EE = (float*)(ws + WS_EE);
    unsigned gf_[8], gb_[8], vr_[8];
#define H1_FETCH(hn_) do { const int n_ = (hn_) & 127, h_ = (hn_) >> 7; const size_t o_ = ((size_t)h_ * SEQ + 64 * n_ + 8 * sg) * 128 + 2 * cp; \
        _Pragma("unroll") for (int i = 0; i < 8; ++i) { gf_[i] = *(const GAS unsigned*)(GF + o_ + (size_t)i * 128); gb_[i] = *(const GAS unsigned*)(GB + o_ + (size_t)i * 128); vr_[i] = *(const GAS unsigned*)(VH + o_ + (size_t)i * 128); } } while (0)
    int hn = blockIdx.x;
    if (hn < 1024) H1_FETCH(hn);
    for (; hn < 1024; hn += gridDim.x) {
        const int itemF = hn, itemB = 1024 + (hn & ~127) + 127 - (hn & 127);
        float gF0[8], gF1[8], gB0[8], gB1[8], bF0[8], bF1[8], bB0[8], bB1[8];
        {
            float cF0 = 0.f, cF1 = 0.f, cB0 = 0.f, cB1 = 0.f;
#pragma unroll
            for (int i = 0; i < 8; ++i) {
                gF0[i] = f16_to_f32((unsigned short)(gf_[i] & 0xffffu)); gF1[i] = f16_to_f32((unsigned short)(gf_[i] >> 16));
                gB0[i] = f16_to_f32((unsigned short)(gb_[i] & 0xffffu)); gB1[i] = f16_to_f32((unsigned short)(gb_[i] >> 16));
                cF0 += gF0[i]; bF0[i] = cF0; cF1 += gF1[i]; bF1[i] = cF1; cB0 += gB0[i]; bB0[i] = cB0; cB1 += gB1[i]; bB1[i] = cB1; }
#pragma unroll
            for (int i = 0; i < 8; ++i) { bB0[i] = cB0 - bB0[i] + gB0[i]; bB1[i] = cB1 - bB1[i] + gB1[i]; }
            *(LAS f32x2*)(SEGS + sg * 128 + 2 * cp) = (f32x2){cF0, cF1}; *(LAS f32x2*)(SEGS + 1024 + sg * 128 + 2 * cp) = (f32x2){cB0, cB1};
        }
        __syncthreads();
        f32x2 brefF, blastF, brefB, blastB;
        {
            f32x2 tF[8], tB[8];
#pragma unroll
            for (int s2 = 0; s2 < 8; ++s2) { tF[s2] = *(const LAS f32x2*)(SEGS + s2 * 128 + 2 * cp); tB[s2] = *(const LAS f32x2*)(SEGS + 1024 + s2 * 128 + 2 * cp); }
            f32x2 offF = (f32x2){0.f, 0.f}, offB = (f32x2){0.f, 0.f};
#pragma unroll
            for (int s2 = 0; s2 < 8; ++s2) { if (s2 < sg) offF += tF[s2]; if (s2 > sg) offB += tB[s2]; }
            const f32x2 loF = (tF[0] + tF[1]) + (tF[2] + tF[3]), hiF = (tF[4] + tF[5]) + (tF[6] + tF[7]);
            const f32x2 loB = (tB[0] + tB[1]) + (tB[2] + tB[3]), hiB = (tB[4] + tB[5]) + (tB[6] + tB[7]);
            brefF = loF; blastF = loF + hiF; brefB = hiB; blastB = loB + hiB;
#pragma unroll
            for (int i = 0; i < 8; ++i) { bF0[i] += offF.x; bF1[i] += offF.y; bB0[i] += offB.x; bB1[i] += offB.y; }
        }
        {
            u32x4 kF0, kF1, kB0, kB1, vw0, vw1;
#pragma unroll
            for (int i = 0; i < 8; i += 2) {
                kF0[i >> 1] = cvt_pk_bf16((1.f - __expf(gF0[i])) * __expf(fminf(brefF.x - bF0[i], 80.f)), (1.f - __expf(gF0[i + 1])) * __expf(fminf(brefF.x - bF0[i + 1], 80.f)));
                kF1[i >> 1] = cvt_pk_bf16((1.f - __expf(gF1[i])) * __expf(fminf(brefF.y - bF1[i], 80.f)), (1.f - __expf(gF1[i + 1])) * __expf(fminf(brefF.y - bF1[i + 1], 80.f)));
                kB0[i >> 1] = cvt_pk_bf16((1.f - __expf(gB0[i])) * __expf(fminf(brefB.x - bB0[i], 80.f)), (1.f - __expf(gB0[i + 1])) * __expf(fminf(brefB.x - bB0[i + 1], 80.f)));
                kB1[i >> 1] = cvt_pk_bf16((1.f - __expf(gB1[i])) * __expf(fminf(brefB.y - bB1[i], 80.f)), (1.f - __expf(gB1[i + 1])) * __expf(fminf(brefB.y - bB1[i + 1], 80.f)));
                vw0[i >> 1] = (vr_[i] & 0xffffu) | (vr_[i + 1] << 16); vw1[i >> 1] = (vr_[i] >> 16) | (vr_[i + 1] & 0xffff0000u);
            }
            *(LAS u32x4*)(KpT + (2 * cp) * HT_ROWB + sg * 16) = kF0; *(LAS u32x4*)(KpT + (2 * cp + 1) * HT_ROWB + sg * 16) = kF1;
            *(LAS u32x4*)(KpT + 128 * HT_ROWB + (2 * cp) * HT_ROWB + sg * 16) = kB0; *(LAS u32x4*)(KpT + 128 * HT_ROWB + (2 * cp + 1) * HT_ROWB + sg * 16) = kB1;
            *(LAS u32x4*)(Vt + (2 * cp) * HT_ROWB + sg * 16) = vw0; *(LAS u32x4*)(Vt + (2 * cp + 1) * HT_ROWB + sg * 16) = vw1;
            if (sg == 0) {
                *(LAS f32x2*)(SC + 2 * cp) = (f32x2){__expf(blastF.x - brefF.x), __expf(blastF.y - brefF.y)}; *(LAS f32x2*)(SC + 128 + 2 * cp) = (f32x2){__expf(blastB.x - brefB.x), __expf(blastB.y - brefB.y)};
                *(GAS f32x2*)(DD + (size_t)itemF * 128 + 2 * cp) = (f32x2){__expf(blastF.x), __expf(blastF.y)}; *(GAS f32x2*)(EE + (size_t)itemF * 128 + 2 * cp) = (f32x2){__expf(brefF.x), __expf(brefF.y)};
                *(GAS f32x2*)(DD + (size_t)itemB * 128 + 2 * cp) = (f32x2){__expf(blastB.x), __expf(blastB.y)}; *(GAS f32x2*)(EE + (size_t)itemB * 128 + 2 * cp) = (f32x2){__expf(brefB.x), __expf(brefB.y)}; }
        }
        if (hn + (int)gridDim.x < 1024) H1_FETCH(hn + (int)gridDim.x);
        __syncthreads();
        {
            const int vt = w;
            bf16x8 bv[2];
#pragma unroll
            for (int ks = 0; ks < 2; ++ks) bv[ks] = *(const LAS bf16x8*)(Vt + (16 * vt + fr) * HT_ROWB + (32 * ks + 8 * fq) * 2);
#pragma unroll
            for (int dd = 0; dd < 2; ++dd) {
                bf16_t* dst = LT + (size_t)(dd ? itemB : itemF) * 16384 + (size_t)(16 * vt + fr) * 128 + 4 * fq;
                const LAS unsigned char* Kd = KpT + dd * 128 * HT_ROWB; const LAS float* Sd = SC + dd * 128;
#pragma unroll
                for (int kt = 0; kt < 8; ++kt) {
                    f32x4 acc = (f32x4){0.f, 0.f, 0.f, 0.f};
#pragma unroll
                    for (int ks = 0; ks < 2; ++ks) { const bf16x8 af = *(const LAS bf16x8*)(Kd + (16 * kt + fr) * HT_ROWB + (32 * ks + 8 * fq) * 2);
                        acc = __builtin_amdgcn_mfma_f32_16x16x32_bf16(af, bv[ks], acc, 0, 0, 0); }
                    const f32x4 sc = *(const LAS f32x4*)(Sd + 16 * kt + 4 * fq);
                    u32x2 ow; ow.x = cvt_pk_bf16(acc[0] * sc[0], acc[1] * sc[1]); ow.y = cvt_pk_bf16(acc[2] * sc[2], acc[3] * sc[3]);
                    *(GAS u32x2*)(dst + 16 * kt) = ow;
                }
            }
        }
    }
#undef H1_FETCH
}

__device__ __forceinline__ void h2_phase(const Args& a, LAS unsigned char* lds, int wid_s, int bid, int nb) {
    unsigned char* ws = opaque_ptr(a.ws);
    const int tid = opaque_tid(wid_s);
    const float* DD = (const float*)(ws + WS_DD); const float* EE = (const float*)(ws + WS_EE);
    bf16_t* SP = (bf16_t*)(ws + WS_SP);
    LAS float* DL = (LAS float*)lds; LAS float* EL = (LAS float*)(lds + 65536);
    for (int u = bid; u < 256; u += nb) {
        const int chain = u >> 4, sub = u & 15;
        const int v = 8 * sub + (tid >> 6), k = 2 * (tid & 63);
        const size_t ibase = (size_t)chain * 128;
        __syncthreads();
#pragma unroll
        for (int j = 0; j < 8; ++j) { const int idx = (tid + 512 * j) * 4; *(LAS f32x4*)(DL + idx) = ldgf4(DD + ibase * 128 + idx); *(LAS f32x4*)(EL + idx) = ldgf4(EE + ibase * 128 + idx); }
        __syncthreads();
        float s0 = 0.f, s1 = 0.f;
        unsigned ltA[32], ltB[32];
        const unsigned voff = (unsigned)(v * 128 + k) * 2u;
        GAS unsigned char* chbase = (GAS unsigned char*)SP + ibase * 32768;
#define H2_LOAD(L, c0_) do { _Pragma("unroll") for (int j = 0; j < 32; ++j) L[j] = ldg4_nt(chbase + (size_t)((c0_) + j) * 32768 + voff); } while (0)
#define H2_SCAN(L, c0_) do { _Pragma("unroll") for (int j = 0; j < 32; ++j) { const f32x2 dd = *(const LAS f32x2*)(DL + ((c0_) + j) * 128 + k), ee = *(const LAS f32x2*)(EL + ((c0_) + j) * 128 + k); \
            *(GAS unsigned*)(chbase + (size_t)((c0_) + j) * 32768 + voff) = cvt_pk_bf16(s0 * ee[0], s1 * ee[1]); \
            s0 = dd[0] * s0 + bflo(L[j]); s1 = dd[1] * s1 + bfhi(L[j]); } } while (0)
        H2_LOAD(ltA, 0); EPI_FENCE();
        H2_LOAD(ltB, 32); H2_SCAN(ltA, 0); EPI_FENCE();
        H2_LOAD(ltA, 64); H2_SCAN(ltB, 32); EPI_FENCE();
        H2_LOAD(ltB, 96); H2_SCAN(ltA, 64); EPI_FENCE();
        H2_SCAN(ltB, 96);
#undef H2_LOAD
#undef H2_SCAN
    }
    __syncthreads();
}

__device__ __forceinline__ void h3_phase(const Args& a, int layer, LAS unsigned char* lds, int wid_s) {
    unsigned char* ws = opaque_ptr(a.ws);
    const int tid = opaque_tid(wid_s), lane = tid & 63, w = __builtin_amdgcn_readfirstlane(tid >> 6), fr = lane & 15, fq = lane >> 4;
    const int cp = tid & 63, sg = w;
    LAS float* SEGS = (LAS float*)lds; LAS float* SSQP = (LAS float*)(lds + 4096);
    LAS unsigned char* Qp = lds + 8192; LAS unsigned char* Kp = Qp + 64 * HP_ROWB; LAS unsigned char* Vt = Kp + 64 * HP_ROWB; LAS unsigned char* Ab = Vt + 128 * HT_ROWB; LAS unsigned char* SPs = Ab + 64 * HT_ROWB;
    const bf16_t* QH = (const bf16_t*)(ws + WS_QH); const bf16_t* VH = (const bf16_t*)(ws + WS_VH); const bf16_t* HG = (const bf16_t*)(ws + WS_HG);
    const bf16_t* SP = (const bf16_t*)(ws + WS_SP); bf16_t* OA = (bf16_t*)(ws + WS_OA);
    const float* onorm = a.in[5] + layer * 128;
    unsigned gr_[8], qr_[8], vr_[8]; u32x4 spr[4];
#define H3_FETCH(item_, d_) do { const int n_ = (item_) >> 3, h_ = (item_) & 7, cs_ = (d_) ? 127 - n_ : n_; \
        const size_t o_ = ((size_t)h_ * SEQ + 64 * n_ + 8 * sg) * 128 + 2 * cp; const bf16_t* G_ = (const bf16_t*)(ws + ((d_) ? WS_GB : WS_GF)) + o_; \
        const bf16_t* S_ = SP + (size_t)(((d_) * 8 + h_) * 128 + cs_) * 16384; \
        _Pragma("unroll") for (int i = 0; i < 8; ++i) { gr_[i] = ldg4_nt(G_ + (size_t)i * 128); \
            if ((d_) == 0) { qr_[i] = ldg4_nt(QH + o_ + (size_t)i * 128); vr_[i] = ldg4_nt(VH + o_ + (size_t)i * 128); } }   \
        _Pragma("unroll") for (int i = 0; i < 4; ++i) { const int q_ = tid + 512 * i; spr[i] = ldg16_nt(S_ + (q_ >> 4) * 128 + (q_ & 15) * 8); } } while (0)
    f32x4 onr[4];
#pragma unroll
    for (int j = 0; j < 4; ++j) onr[j] = ldgf4(onorm + 16 * (4 * (w >> 2) + j) + 4 * fq);
    int item = blockIdx.x;
    if (item < 1024) H3_FETCH(item, 0);
    for (; item < 1024; item += gridDim.x) {
        const int n = item >> 3, h = item & 7;
        const int tok0 = 64 * n;
        const int rt = w & 3, vg = w >> 2;
        f32x4 o[4];
#pragma unroll
        for (int j = 0; j < 4; ++j) o[j] = (f32x4){0.f, 0.f, 0.f, 0.f};
        u32x2 hgr[4];
        for (int d = 0; d < 2; ++d) {
            float b0[8], b1[8], g0[8], g1[8]; f32x2 bref, blast;
#pragma unroll
            for (int i = 0; i < 8; ++i) { g0[i] = f16_to_f32((unsigned short)(gr_[i] & 0xffffu)); g1[i] = f16_to_f32((unsigned short)(gr_[i] >> 16)); }
            hg_cumsum2(g0, g1, sg, cp, d, SEGS, b0, b1, bref, blast);
            {
                u32x4 vw0, vw1;
#pragma unroll
                for (int i = 0; i < 8; ++i) {
                    const float e0 = b0[i] - bref.x, e1 = b1[i] - bref.y;
                    const float q0 = bflo(qr_[i]) * __expf(fminf(e0, 80.f)), q1 = bfhi(qr_[i]) * __expf(fminf(e1, 80.f));
                    const float k0 = (1.f - __expf(g0[i])) * __expf(fminf(-e0, 80.f)), k1 = (1.f - __expf(g1[i])) * __expf(fminf(-e1, 80.f));
                    *(LAS unsigned*)(Qp + (8 * sg + i) * HP_ROWB + 4 * cp) = cvt_pk_bf16(q0, q1);
                    *(LAS unsigned*)(Kp + (8 * sg + i) * HP_ROWB + 4 * cp) = cvt_pk_bf16(k0, k1);
                }
#pragma unroll
                for (int i = 0; i < 8; i += 2) { vw0[i >> 1] = (vr_[i] & 0xffffu) | (vr_[i + 1] << 16); vw1[i >> 1] = (vr_[i] >> 16) | (vr_[i + 1] & 0xffff0000u); }
                if (d == 0) { *(LAS u32x4*)(Vt + (2 * cp) * HT_ROWB + sg * 16) = vw0; *(LAS u32x4*)(Vt + (2 * cp + 1) * HT_ROWB + sg * 16) = vw1; }
#pragma unroll
                for (int i = 0; i < 4; ++i) { const int q = tid + 512 * i; *(LAS u32x4*)(SPs + (q >> 4) * HP_ROWB + (q & 15) * 16) = spr[i]; }
            }
            if (d == 0) H3_FETCH(item, 1);
            else { if (item + (int)gridDim.x < 1024) H3_FETCH(item + (int)gridDim.x, 0);
#pragma unroll
                for (int j = 0; j < 4; ++j) hgr[j] = ldg8_nt(HG + ((size_t)h * SEQ + tok0 + 16 * rt + fr) * 128 + 16 * (4 * vg + j) + 4 * fq); }
            __syncthreads();
            {
                const int art = w >> 1;
#pragma unroll
                for (int tt = 0; tt < 2; ++tt) {
                    const int st = 2 * (w & 1) + tt;
                    const bool need = d ? (st >= art) : (st <= art);
                    f32x4 acc = (f32x4){0.f, 0.f, 0.f, 0.f};
                    if (need) {
#pragma unroll
                        for (int ks = 0; ks < 4; ++ks) {
                            const bf16x8 af = *(const LAS bf16x8*)(Qp + (16 * art + fr) * HP_ROWB + (32 * ks + 8 * fq) * 2);
                            const bf16x8 bfr = *(const LAS bf16x8*)(Kp + (16 * st + fr) * HP_ROWB + (32 * ks + 8 * fq) * 2);
                            acc = __builtin_amdgcn_mfma_f32_16x16x32_bf16(af, bfr, acc, 0, 0, 0);
                        }
                    }
                    const int s_ = 16 * st + fr;
#pragma unroll
                    for (int r = 0; r < 4; ++r) { const int r_ = 16 * art + 4 * fq + r; const bool ok = need && (d ? (s_ >= r_) : (s_ <= r_));
                        *(LAS unsigned short*)(Ab + r_ * HT_ROWB + s_ * 2) = f2bf1(ok ? acc[r] : 0.f); }
                }
            }
            __syncthreads();
            {
                bf16x8 ab[2], qb[4];
#pragma unroll
                for (int ks = 0; ks < 2; ++ks) ab[ks] = *(const LAS bf16x8*)(Ab + (16 * rt + fr) * HT_ROWB + (32 * ks + 8 * fq) * 2);
#pragma unroll
                for (int ks = 0; ks < 4; ++ks) qb[ks] = *(const LAS bf16x8*)(Qp + (16 * rt + fr) * HP_ROWB + (32 * ks + 8 * fq) * 2);
#pragma unroll
                for (int j = 0; j < 4; ++j) {
                    const int vt = 4 * vg + j;
#pragma unroll
                    for (int ks = 0; ks < 2; ++ks) { const bf16x8 af = *(const LAS bf16x8*)(Vt + (16 * vt + fr) * HT_ROWB + (32 * ks + 8 * fq) * 2);
                        o[j] = __builtin_amdgcn_mfma_f32_16x16x32_bf16(af, ab[ks], o[j], 0, 0, 0); }
#pragma unroll
                    for (int ks = 0; ks < 4; ++ks) { const bf16x8 af = *(const LAS bf16x8*)(SPs + (16 * vt + fr) * HP_ROWB + (32 * ks + 8 * fq) * 2);
                        o[j] = __builtin_amdgcn_mfma_f32_16x16x32_bf16(af, qb[ks], o[j], 0, 0, 0); }
                }
            }
        }
        {
            float s = 0.f;
#pragma unroll
            for (int j = 0; j < 4; ++j) s += o[j][0] * o[j][0] + o[j][1] * o[j][1] + o[j][2] * o[j][2] + o[j][3] * o[j][3];
            s += __shfl_xor(s, 16); s += __shfl_xor(s, 32);
            if (fq == 0) SSQP[vg * 64 + 16 * rt + fr] = s;
            __syncthreads();
            const int row = 16 * rt + fr; const float rs = rsqrtf((SSQP[row] + SSQP[64 + row]) * (1.0f / 128.f) + EPS);
#pragma unroll
            for (int j = 0; j < 4; ++j) { const int v0 = 16 * (4 * vg + j) + 4 * fq; const f32x4 on = onr[j];
                u32x2 ow; ow.x = cvt_pk_bf16(o[j][0] * rs * on[0] * bflo(hgr[j].x), o[j][1] * rs * on[1] * bfhi(hgr[j].x)); ow.y = cvt_pk_bf16(o[j][2] * rs * on[2] * bflo(hgr[j].y), o[j][3] * rs * on[3] * bfhi(hgr[j].y));
                *(GAS u32x2*)(OA + (size_t)(tok0 + row) * HW + h * 128 + v0) = ow; }
        }
    }
#undef H3_FETCH
}

constexpr int NAT_SLOT = 18432, NAT_RP_OFF = 3 * NAT_SLOT, NAT_RK_OFF = NAT_RP_OFF + 2048;
__device__ __forceinline__ void natten_phase(const Args& a, int layer, LAS unsigned char* lds, int wid_s) {
    unsigned char* ws = opaque_ptr(a.ws);
    const int tid = opaque_tid(wid_s), lane = tid & 63, w = __builtin_amdgcn_readfirstlane(tid >> 6), fr = lane & 15, fq = lane >> 4;
    LAS float* RP = (LAS float*)(lds + NAT_RP_OFF);
    LAS float* RKL = (LAS float*)(lds + NAT_RK_OFF);
    LAS float* GQK = (LAS float*)(lds + NAT_RK_OFF + 1024);
    const bf16_t* NQ = (const bf16_t*)(ws + WS_NQ); const bf16_t* NK = (const bf16_t*)(ws + WS_NK); const bf16_t* VT = (const bf16_t*)(ws + WS_VT);
    const bf16_t* NG = (const bf16_t*)(ws + WS_NG); bf16_t* OB = (bf16_t*)(ws + WS_OB); const float* RKS = (const float*)(ws + WS_RKS);
    const float* gq = a.in[6] + layer * 128; const float* gk = a.in[7] + layer * 128; const float* rpb = a.in[8] + (size_t)layer * 8 * 465;
    if (tid < 128) GQK[tid] = ldgf(gq + tid) * ldgf(gk + tid);
    const int rr = w >> 2, j = w & 3;
    const int c0k = (j == 0) ? 0 : (j == 1) ? 8 : (j == 2) ? 24 : 32;
    const int cq = 16 * j + fr;
    const int cstart = min(max(cq - 8, 0), 48);
    bool vmask[2][4]; int cob[2][4];
#pragma unroll
    for (int kt = 0; kt < 2; ++kt)
#pragma unroll
        for (int rg = 0; rg < 4; ++rg) { const int kcl = c0k + 16 * kt + 4 * fq + rg; vmask[kt][rg] = (kcl >= cstart) && (kcl < cstart + 16); cob[kt][rg] = min(max(kcl - cq + 15, 0), 30); }
    int ksoff[2], vsoff[2], kdst[2], vdst[2];
#pragma unroll
    for (int i = 0; i < 2; ++i) { const int q = tid + 512 * i;
        { const int key = q >> 4, ch = q & 15; ksoff[i] = key * 128 + ch * 8; kdst[i] = key * 272 + ch * 16; }
        vsoff[i] = ksoff[i]; vdst[i] = (q >> 4) * 288 + (q & 15) * 16; }
    u32x4 R0[2], R1[2], R2[2], qraw[4]; float K0 = 0.f, K1 = 0.f, K2 = 0.f;
#define NAT_LOAD(g, R, KS, rs0_, h_) do { const int gr_ = min((rs0_) + (((g) < 9) ? (g) : (g) - 9), 127); \
        _Pragma("unroll") for (int i = 0; i < 2; ++i) R[i] = ((g) < 9) ? ldg16(NK + ((size_t)(h_) * SEQ + gr_ * 64) * 128 + ksoff[i]) : ldg16(VT + ((size_t)(h_) * SEQ + gr_ * 64) * 128 + vsoff[i]); \
        if ((g) < 9 && w == 0) KS = ldgf(RKS + ((size_t)gr_ * 64 + (tid & 63)) * 8 + (h_)); } while (0)
#define NAT_WRITE(g, R, KS) do { _Pragma("unroll") for (int i = 0; i < 2; ++i) *(LAS u32x4*)(lds + ((g) % 3) * NAT_SLOT + (((g) < 9) ? kdst[i] : vdst[i])) = R[i]; \
        if ((g) < 9 && w == 0) RKL[((g) % 3) * 64 + (tid & 63)] = rsqrtf(KS * (1.0f / 128.f) + EPS); } while (0)
#define NAT_QLOAD(r0_, h_) do { const size_t tq_ = (size_t)(64 * ((r0_) + rr) + cq); _Pragma("unroll") for (int ks = 0; ks < 4; ++ks) qraw[ks] = ldg16_nt(NQ + ((size_t)(h_) * SEQ + tq_) * 128 + 32 * ks + 8 * fq); } while (0)
    int it = blockIdx.x, h_prev = -1;
    if (it < 512) { const int r0 = 2 * (it >> 3), h = it & 7, rs0 = min(max(r0 - 4, 0), 120);
        NAT_LOAD(0, R0, K0, rs0, h); NAT_LOAD(1, R1, K1, rs0, h); NAT_LOAD(2, R2, K2, rs0, h); NAT_QLOAD(r0, h); }
    for (; it < 512; it += gridDim.x) {
        const int r0 = 2 * (it >> 3), h = it & 7, r = r0 + rr;
        const int rs0 = min(max(r0 - 4, 0), 120), rs1 = min(max(r0 - 3, 0), 120), dsel = rr ? rs1 - rs0 : 0, my_rs = rs0 + dsel;
        const int itn = it + (int)gridDim.x; const bool has_next = itn < 512;
        const int r0n = 2 * (itn >> 3), hn = itn & 7, rs0n = min(max(r0n - 4, 0), 120);
        if (h != h_prev) { for (int i = tid; i < 465; i += 512) RP[i] = ldgf(rpb + (size_t)h * 465 + i); h_prev = h; }
        const int tq = 64 * r + cq;
        bf16x8 qf[4];
        {
            float qv[4][8]; float ss = 0.f;
#pragma unroll
            for (int ks = 0; ks < 4; ++ks) { cvt8_bf16(qraw[ks], qv[ks]);
#pragma unroll
                for (int e = 0; e < 8; ++e) ss += qv[ks][e] * qv[ks][e]; }
            ss += __shfl_xor(ss, 16); ss += __shfl_xor(ss, 32);
            const float rq = rsqrtf(ss * (1.0f / 128.f) + EPS) * 0.08838834764831845f;
            NAT_WRITE(0, R0, K0); NAT_WRITE(1, R1, K1);
            __syncthreads();
#pragma unroll
            for (int ks = 0; ks < 4; ++ks) { const f32x4 ga = *(const LAS f32x4*)(GQK + 32 * ks + 8 * fq), gb = *(const LAS f32x4*)(GQK + 32 * ks + 8 * fq + 4);
                u32x4 wv;
                wv.x = cvt_pk_bf16(qv[ks][0] * rq * ga[0], qv[ks][1] * rq * ga[1]); wv.y = cvt_pk_bf16(qv[ks][2] * rq * ga[2], qv[ks][3] * rq * ga[3]);
                wv.z = cvt_pk_bf16(qv[ks][4] * rq * gb[0], qv[ks][5] * rq * gb[1]); wv.w = cvt_pk_bf16(qv[ks][6] * rq * gb[2], qv[ks][7] * rq * gb[3]);
                qf[ks] = __builtin_bit_cast(bf16x8, wv); }
        }
        float s[8][2][4];
        float mx = -3.0e38f, l = 0.f;
        f32x4 o[8];
        u32x2 gw[8];
#pragma unroll
        for (int dt = 0; dt < 8; ++dt) o[dt] = (f32x4){0.f, 0.f, 0.f, 0.f};
#pragma unroll
        for (int t = 0; t < 17; ++t) {
            if (t + 3 < 18) { if (t % 3 == 0) NAT_LOAD(t + 3, R0, K0, rs0, h); else if (t % 3 == 1) NAT_LOAD(t + 3, R1, K1, rs0, h); else NAT_LOAD(t + 3, R2, K2, rs0, h); }
            if (t == 9) {
#pragma unroll
                for (int dt = 0; dt < 8; ++dt) gw[dt] = ldg8_nt(NG + ((size_t)h * SEQ + tq) * 128 + 16 * dt + 4 * fq); }
            if (has_next) {
                if (t == 13) NAT_QLOAD(r0n, hn);
                if (t == 14) NAT_LOAD(0, R0, K0, rs0n, hn);
                if (t == 15) NAT_LOAD(1, R1, K1, rs0n, hn);
                if (t == 16) NAT_LOAD(2, R2, K2, rs0n, hn);
            }
            const int slot = (t % 3 + dsel) % 3;
            const LAS unsigned char* buf = lds + slot * NAT_SLOT;
            if (t < 8) {
                const int aa = t, kr = my_rs + aa, row_off = kr - r + 7;
#pragma unroll
                for (int kt = 0; kt < 2; ++kt) {
                    bf16x8 kf[4];
#pragma unroll
                    for (int ks = 0; ks < 4; ++ks) kf[ks] = *(const LAS bf16x8*)(buf + (c0k + 16 * kt + fr) * 272 + (32 * ks + 8 * fq) * 2);
                    const f32x4 rk4 = *(const LAS f32x4*)(RKL + slot * 64 + c0k + 16 * kt + 4 * fq);
                    f32x4 acc = (f32x4){0.f, 0.f, 0.f, 0.f};
#pragma unroll
                    for (int ks = 0; ks < 4; ++ks) acc = __builtin_amdgcn_mfma_f32_16x16x32_bf16(kf[ks], qf[ks], acc, 0, 0, 0);
#pragma unroll
                    for (int rg = 0; rg < 4; ++rg) {
                        const float bias = RP[row_off * 31 + cob[kt][rg]];
                        const float sv = vmask[kt][rg] ? (acc[rg] * rk4[rg] + bias) : -1.0e30f;
                        s[aa][kt][rg] = sv; mx = fmaxf(mx, sv);
                    }
                }
                if (t == 7) {
                    mx = fmaxf(mx, __shfl_xor(mx, 16)); mx = fmaxf(mx, __shfl_xor(mx, 32));
#pragma unroll
                    for (int a2 = 0; a2 < 8; ++a2)
#pragma unroll
                        for (int kt = 0; kt < 2; ++kt)
#pragma unroll
                            for (int rg = 0; rg < 4; ++rg) { const float p = __expf(s[a2][kt][rg] - mx); s[a2][kt][rg] = p; l += p; }
                    l += __shfl_xor(l, 16); l += __shfl_xor(l, 32);
                }
            } else if (t > 8) {
                const int aa = t - 9;
                u32x4 pw; pw.x = cvt_pk_bf16(s[aa][0][0], s[aa][0][1]); pw.y = cvt_pk_bf16(s[aa][0][2], s[aa][0][3]); pw.z = cvt_pk_bf16(s[aa][1][0], s[aa][1][1]); pw.w = cvt_pk_bf16(s[aa][1][2], s[aa][1][3]);
                const bf16x8 pb = __builtin_bit_cast(bf16x8, pw);
#pragma unroll
                for (int dt = 0; dt < 8; ++dt) {
                    const LAS unsigned char* vp = buf + (c0k + 4 * fq + (fr >> 2)) * 288 + (16 * dt + 4 * (fr & 3)) * 2;
                    const u32x2 v0 = __builtin_bit_cast(u32x2, __builtin_amdgcn_ds_read_tr16_b64_v4i16((LAS v4i16_t*)vp)), v1 = __builtin_bit_cast(u32x2, __builtin_amdgcn_ds_read_tr16_b64_v4i16((LAS v4i16_t*)(vp + 16 * 288)));
                    const u32x4 vw = (u32x4){v0.x, v0.y, v1.x, v1.y};
                    o[dt] = __builtin_amdgcn_mfma_f32_16x16x32_bf16(__builtin_bit_cast(bf16x8, vw), pb, o[dt], 0, 0, 0);
                }
            }
            if (t + 2 < 18) { if ((t + 2) % 3 == 0) NAT_WRITE(t + 2, R0, K0); else if ((t + 2) % 3 == 1) NAT_WRITE(t + 2, R1, K1); else NAT_WRITE(t + 2, R2, K2); }
            __syncthreads();
        }
        const float inv = 1.0f / l;
#pragma unroll
        for (int dt = 0; dt < 8; ++dt) {
            const size_t off = (size_t)tq * HW + h * 128 + 16 * dt + 4 * fq;
            u32x2 ow; ow.x = cvt_pk_bf16(o[dt][0] * inv * bflo(gw[dt].x), o[dt][1] * inv * bfhi(gw[dt].x)); ow.y = cvt_pk_bf16(o[dt][2] * inv * bflo(gw[dt].y), o[dt][3] * inv * bfhi(gw[dt].y));
            *(GAS u32x2*)(OB + off) = ow;
        }
    }
#undef NAT_LOAD
#undef NAT_WRITE
#undef NAT_QLOAD
}

__global__ void __launch_bounds__(512, 2) mk_fwd(Args a) {
    extern __shared__ __attribute__((aligned(16))) unsigned char lds_raw[];
    LAS unsigned char* lds = (LAS unsigned char*)lds_raw;
    volatile LAS unsigned* MISC = (volatile LAS unsigned*)(lds + LDS_MISC_OFF);
    const int wid_s = __builtin_amdgcn_readfirstlane(threadIdx.x >> 6);
    if (threadIdx.x < 64) MISC[threadIdx.x] = 0u;
    __syncthreads();
    XcdBarrier bar; bar.bar = (unsigned*)(a.ws + WS_CTL) + 4096; bar.x = 0; bar.st = nullptr;
    const int lo = a.ph_lo, hi = a.ph_hi;
    if (hi - lo > 1) bar = xcd_barrier_post((unsigned*)(a.ws + WS_CTL) + 4096, MISC + 8);
#define IN(k) (lo <= (k) && (k) < hi)
#define SEAM(k) do { if (IN(k) && IN((k) + 1)) { xcd_arrive(bar, (k)); xcd_wait(bar, (k)); } } while (0)
    const int G = gridDim.x, c = blockIdx.x;

    const bool fill = IN(0) && IN(8);
#define FLAGK(k) (bar.bar + XB_KBASE + (k) * XB_KSTRIDE + 512)
#define NXV (bar.st[1])
#define SEAMF(k, on) do { if (IN(k) && IN((k) + 1)) { xcd_arrive(bar, (k)); if (on) conv_fill(a, lds, wid_s, FLAGK(k), NXV, MISC + 20); xcd_wait(bar, (k)); } } while (0)
    if (IN(0)) p0_prologue(a, lds, fill ? 1 : 2);
    SEAMF(0, fill);
    for (int l = 0; l < 2; ++l) {
        const int pb = 1 + 7 * l;
        if (IN(pb + 0)) {
            unsigned char* ws = opaque_ptr(a.ws); bf16_t* XGA = (bf16_t*)(ws + WS_XGA); float* SSQ = (float*)(ws + WS_SSQ);
            pg8::Gemm g{XGA, (const bf16_t*)(ws + WS_WIN) + (size_t)l * NIN * DM, SEQ, NIN - 1024, DM, nullptr, nullptr}; pg8::StaticOrder S; S.init(SEQ, NIN - 1024, G, c);
            EpiInProj E{SSQ + (2 * l) * SEQ, (const float*)(ws + WS_LOWER) + l * 2048, ws};
            pg8::gemm_phase<EpiInProj, pg8::StaticOrder>(lds, g, S, E, wid_s);
        }
        SEAMF(pb + 0, fill);
        if (IN(pb + 1)) h1_phase(a, lds, wid_s);
        if (fill && l == 0) conv_fill(a, lds, wid_s, nullptr, CONV_D_WP0, MISC + 20);
        if (IN(pb + 1) && IN(pb + 2)) { xcd_arrive(bar, pb + 1); if (c >= G / 2) { if (fill) conv_fill(a, lds, wid_s, FLAGK(pb + 1), NXV, MISC + 20); xcd_wait(bar, pb + 1); } }
        if (IN(pb + 2)) {
            const int ng = G / 2;
            if (c < ng) {
                unsigned char* ws = opaque_ptr(a.ws); float* SSQ = (float*)(ws + WS_SSQ);
                pg8::Gemm g{(const bf16_t*)(ws + WS_XGA), (const bf16_t*)(ws + WS_WIN) + (size_t)l * NIN * DM + (size_t)(NIN - 1024) * DM, SEQ, 1024, DM, nullptr, nullptr}; pg8::StaticOrder S; S.init(SEQ, 1024, ng, c);
                EpiMBTail E{SSQ + (2 * l) * SEQ, (unsigned char*)(ws + WS_MB)};
                pg8::gemm_phase<EpiMBTail, pg8::StaticOrder>(lds, g, S, E, wid_s);
            } else {
                h2_phase(a, lds, wid_s, c - ng, G - ng);
                unsigned char* ws = opaque_ptr(a.ws);
                int kple = PLE; asm volatile("" : "+s"(kple));
                pg8::Gemm g2{(const bf16_t*)(ws + WS_PB) + (size_t)l * SEQ * PLE, (const bf16_t*)(ws + WS_WP) + (size_t)l * DM * PLE, SEQ, DM, kple, nullptr, nullptr}; pg8::StaticOrder S2; S2.init(SEQ, DM, G - ng, c - ng);
                EpiPL E2{(bf16_t*)(ws + WS_PL)};
                pg8::gemm_phase<EpiPL, pg8::StaticOrder>(lds, g2, S2, E2, wid_s);
            }
        }
        if (fill) conv_fill(a, lds, wid_s, nullptr, l == 0 ? CONV_D_BR0 : CONV_NBATCH, MISC + 20);
        if (IN(pb + 2) && IN(pb + 3)) xcd_arrive(bar, pb + 2);
        if (IN(pb + 3)) { natten_phase(a, l, lds, wid_s); __syncthreads(); if (IN(pb + 4)) xcd_arrive(bar, 15 + l); }
        if (IN(pb + 2) && IN(pb + 3)) xcd_wait(bar, pb + 2);
        if (IN(pb + 3)) h3_phase(a, l, lds, wid_s);
        if (IN(pb + 3) && IN(pb + 4)) xcd_arrive(bar, pb + 3);
        if (IN(pb + 4)) {
            unsigned char* ws = opaque_ptr(a.ws);
            if (IN(pb + 3)) xcd_wait(bar, 15 + l);
            pg8::PairOrder S; S.init(SEQ, DM, G, c);
            S.flag = (IN(pb + 3)) ? FLAGK(pb + 3) : nullptr; S.nxv = NXV; S.lflag = MISC + 16; S.tag = (unsigned)(pb + 3) + 1u; S.wid = wid_s;
            pg8::Gemm g{(const bf16_t*)(ws + WS_OB), (const bf16_t*)(ws + WS_WB) + (size_t)l * DM * HW, SEQ, DM, HW, (const bf16_t*)(ws + WS_OA), (const bf16_t*)(ws + WS_WA) + (size_t)l * DM * HW};
            EpiBranch E{(const unsigned char*)(ws + WS_MA), (const unsigned char*)(ws + WS_MB), (bf16_t*)(ws + WS_Y)};
            pg8::gemm_phase<EpiBranch, pg8::PairOrder>(lds, g, S, E, wid_s);
        }
        if (fill && l == 0) conv_fill(a, lds, wid_s, nullptr, CONV_D_WO0, MISC + 20);
        SEAMF(pb + 4, fill && l == 0);
        if (IN(pb + 5)) {
            unsigned char* ws = opaque_ptr(a.ws); bf16_t* XGB = (bf16_t*)(ws + WS_XGB); float* SSQ = (float*)(ws + WS_SSQ);
            for (int i = c * 512 + opaque_tid(wid_s); i < SEQ * 8; i += G * 512) *(GAS float*)((float*)(ws + WS_RKS) + i) = 0.f;
            pg8::Gemm g{(const bf16_t*)(ws + WS_Y), (const bf16_t*)(ws + WS_WO) + (size_t)l * DM * DM, SEQ, DM, DM, nullptr, nullptr}; pg8::StaticOrder S; S.init(SEQ, DM, G, c);
            EpiWout E{(const bf16_t*)(ws + WS_XGA), XGB, SSQ + (2 * l + 1) * SEQ};
            pg8::gemm_phase<EpiWout, pg8::StaticOrder>(lds, g, S, E, wid_s);
        }
        if (fill && l == 0) conv_fill(a, lds, wid_s, nullptr, CONV_D_WG0, MISC + 20);
        SEAMF(pb + 5, fill && l == 0);
        if (IN(pb + 6)) {
            unsigned char* ws = opaque_ptr(a.ws); bf16_t* XGA = (bf16_t*)(ws + WS_XGA); bf16_t* XGB = (bf16_t*)(ws + WS_XGB); float* SSQ = (float*)(ws + WS_SSQ);
            pg8::StaticOrder S; S.init(SEQ, DM, G, c);
            pg8::Gemm g{XGB, (const bf16_t*)(ws + WS_WG) + (size_t)l * DM * DM, SEQ, DM, DM, nullptr, nullptr};
            EpiGate E{SSQ + (2 * l + 1) * SEQ, XGB, (const bf16_t*)(ws + WS_PL), a.out, XGA, SSQ + (2 * l + 2 < 4 ? 2 * l + 2 : 0) * SEQ, l == 0 ? 1 : 0};
            pg8::gemm_phase<EpiGate, pg8::StaticOrder>(lds, g, S, E, wid_s);
        }
        if (fill && l == 0) conv_fill(a, lds, wid_s, nullptr, CONV_D_IN1, MISC + 20);
        SEAMF(pb + 6, fill && l == 0);
    }
#undef IN
#undef SEAM
}

extern "C" void kernel_launch(void* const* d_in, const int* in_sizes, int n_in, void* d_out, int out_size, void* d_ws, size_t ws_size, hipStream_t stream) {
    static int grid = 0;
    if (grid == 0) {
        if (n_in != 15 || out_size != SEQ * DM || ws_size < WS_END) { fprintf(stderr, "kernel_launch: unexpected problem (n_in %d, out %d, ws %zu)\n", n_in, out_size, ws_size); grid = -1; return; }
        int dev = 0, cus = 0;
        if (hipGetDevice(&dev) != hipSuccess || hipDeviceGetAttribute(&cus, hipDeviceAttributeMultiprocessorCount, dev) != hipSuccess) { grid = -1; return; }
        if (hipFuncSetAttribute((const void*)mk_fwd, hipFuncAttributeMaxDynamicSharedMemorySize, LDS_BYTES) != hipSuccess) { fprintf(stderr, "kernel_launch: hipFuncSetAttribute failed\n"); grid = -1; return; }
        int per_cu = 0;
        if (hipOccupancyMaxActiveBlocksPerMultiprocessor(&per_cu, (const void*)mk_fwd, 512, LDS_BYTES) != hipSuccess || per_cu < 1) fprintf(stderr, "kernel_launch: occupancy query says %d\n", per_cu);
        (void)hipGetLastError();
        grid = cus;
    }
    if (grid < 0) return;
    (void)hipMemsetAsync((char*)d_ws + WS_CTL, 0, CTL_ZERO_BYTES, stream);
    Args a{};
    for (int i = 0; i < 15; ++i) a.in[i] = (const float*)d_in[i];
    a.out = (float*)d_out; a.ws = (unsigned char*)d_ws;
#if MK_MULTI
    for (int ph = 0; ph < NPHASE; ++ph) { a.ph_lo = ph; a.ph_hi = ph + 1; hipLaunchKernelGGL(mk_fwd, dim3(grid), dim3(512), LDS_BYTES, stream, a); }
#else
    a.ph_lo = 0; a.ph_hi = NPHASE; hipLaunchKernelGGL(mk_fwd, dim3(grid), dim3(512), LDS_BYTES, stream, a);
#endif
}
```

```cpp
#include <hip/hip_runtime.h>
#include <cstdio>
#include <cstdint>

#ifndef MK_ALIGN
#define MK_ALIGN true
#endif
#ifndef MK_SP2
#define MK_SP2 true
#endif
#ifndef MK_MULTI
#define MK_MULTI 0
#endif

#define LAS __attribute__((address_space(3)))
typedef unsigned short bf16_t;
typedef short bf16x8 __attribute__((ext_vector_type(8)));
typedef float f32x4 __attribute__((ext_vector_type(4)));
typedef float f32x2 __attribute__((ext_vector_type(2)));
typedef short v4i16_t __attribute__((ext_vector_type(4)));
typedef unsigned u32x4 __attribute__((ext_vector_type(4)));
typedef unsigned u32x2 __attribute__((ext_vector_type(2)));

constexpr int SEQ = 8192, DM = 2048, NIN = 13312, HW = 1024, PLE = 256;
constexpr float EPS = 1e-6f;
constexpr int NPHASE = 15;

constexpr size_t MiB = 1u << 20;
constexpr size_t WS_CTL = 0, CTL_ZERO_BYTES = 64 * 1024;
constexpr size_t WS_LOWER = 1 * MiB;
constexpr size_t WS_SSQ = 1 * MiB + 64 * 1024;
constexpr size_t WS_RKS = 1 * MiB + 256 * 1024;
constexpr size_t WS_DD = 2 * MiB;
constexpr size_t WS_EE = 3 * MiB;
constexpr size_t WS_WIN = 4 * MiB;
constexpr size_t WS_WA = 108 * MiB;
constexpr size_t WS_WB = 116 * MiB;
constexpr size_t WS_WO = 124 * MiB;
constexpr size_t WS_WG = 140 * MiB;
constexpr size_t WS_WP = 156 * MiB;
constexpr size_t WS_PB = 158 * MiB;
constexpr size_t WS_XGA = 166 * MiB;
constexpr size_t WS_XGB = 198 * MiB;
constexpr size_t WS_QH = 230 * MiB;
constexpr size_t WS_VH = 246 * MiB;
constexpr size_t WS_KF = 262 * MiB;
constexpr size_t WS_KB = 278 * MiB;
constexpr size_t WS_HG = 294 * MiB;
constexpr size_t WS_NQ = 310 * MiB;
constexpr size_t WS_NK = 326 * MiB;
constexpr size_t WS_VT = 342 * MiB;
constexpr size_t WS_NG = 358 * MiB;
constexpr size_t WS_OA = 374 * MiB;
constexpr size_t WS_OB = 390 * MiB;
constexpr size_t WS_GF = 406 * MiB;
constexpr size_t WS_GB = 438 * MiB;
constexpr size_t WS_MA = 470 * MiB;
constexpr size_t WS_MB = 502 * MiB;
constexpr size_t WS_LT = 534 * MiB;
constexpr size_t WS_SP = WS_LT;
constexpr size_t WS_T = 662 * MiB;
constexpr size_t WS_Y = 694 * MiB;
constexpr size_t WS_PL = 726 * MiB;
constexpr size_t WS_END = 758 * MiB;

constexpr int LDS_BYTES = 147456;
constexpr int LDS_MISC_OFF = 131072;

typedef __bf16 bf16x2_t __attribute__((ext_vector_type(2)));
__device__ __forceinline__ unsigned cvt_pk_bf16(float lo, float hi) { bf16x2_t v = {(__bf16)lo, (__bf16)hi}; return __builtin_bit_cast(unsigned, v); }
__device__ __forceinline__ float bf2f(unsigned short b) { return __uint_as_float(((unsigned)b) << 16); }
__device__ __forceinline__ float bflo(unsigned w) { return __uint_as_float(w << 16); }
__device__ __forceinline__ float bfhi(unsigned w) { return __uint_as_float(w & 0xffff0000u); }
__device__ __forceinline__ unsigned short f2bf1(float f) { return (unsigned short)(cvt_pk_bf16(f, 0.f) & 0xffffu); }
typedef _Float16 f16x2_t __attribute__((ext_vector_type(2)));
__device__ __forceinline__ unsigned cvt_pk_f16(float lo, float hi) { f16x2_t v = {(_Float16)lo, (_Float16)hi}; return __builtin_bit_cast(unsigned, v); }
__device__ __forceinline__ float f16_to_f32(unsigned short h) { return (float)__builtin_bit_cast(_Float16, h); }
__device__ __forceinline__ float fast_rcp(float x) { return __builtin_amdgcn_rcpf(x); }
__device__ __forceinline__ float sigmoid_f(float x) { return fast_rcp(1.f + __expf(-x)); }
__device__ __forceinline__ float silu_f(float x) { return x * sigmoid_f(x); }
typedef float f32x2 __attribute__((ext_vector_type(2)));
__device__ __forceinline__ f32x2 exp2_2(f32x2 a) { return (f32x2){__builtin_amdgcn_exp2f(a.x), __builtin_amdgcn_exp2f(a.y)}; }
__device__ __forceinline__ f32x2 rcp_2(f32x2 a) { return (f32x2){__builtin_amdgcn_rcpf(a.x), __builtin_amdgcn_rcpf(a.y)}; }
__device__ __forceinline__ f32x2 sig2(f32x2 a, float rn) { return rcp_2(exp2_2(a * rn) + 1.0f); }
#define NLOG2E (-1.4426950408889634f)

__device__ __forceinline__ int opaque_tid(int wid_s) { int lane; asm volatile("v_mbcnt_lo_u32_b32 %0, -1, 0\n\tv_mbcnt_hi_u32_b32 %0, -1, %0" : "=v"(lane)); asm volatile("" : "+s"(wid_s)); return wid_s * 64 + lane; }
__device__ __forceinline__ unsigned char* opaque_ptr(unsigned char* p) { asm volatile("" : "+s"(p)); return p; }
__device__ __forceinline__ int opaque_bid() { int b = blockIdx.x; asm volatile("" : "+s"(b)); return b; }
namespace pg8 {
#define PG8_LAS __attribute__((address_space(3)))
constexpr int BM = 256, BK = 64, HALF = 128, HTB = HALF * BK * 2, STAGE_BYTES = 8 * HTB, NXCD = 8, WGM = 8;
__host__ __device__ __forceinline__ int lds_byte(int r, int c) { const int st = (r >> 4) * 2 + (c >> 5), rr = r & 15, cc = c & 31, ob = rr * 64 + cc * 2; return st * 1024 + (ob ^ (((ob >> 9) & 1) << 5)); }
__host__ __device__ __forceinline__ void stage_rc(int b, int& R, int& C) { const int st = b / 1024, sb = b % 1024, swz = sb ^ (((sb >> 9) & 1) << 5); R = (st >> 1) * 16 + swz / 64; C = (st & 1) * 32 + (swz % 64) / 2; }
__host__ __device__ __forceinline__ int perm32(int rho) { const int n = rho >> 4, i = rho & 15; return 8 * (i >> 2) + 4 * n + (i & 3); }

struct Unit { int pm, pn, z; };
struct Gemm { const bf16_t* A; const bf16_t* Bt; int M, N, K; const bf16_t* A2; const bf16_t* Bt2; };

struct StaticOrder {
    int nM, nN, nwg, G, c;
    __host__ __device__ void init(int M, int N, int G_, int c_) { nM = M / BM; nN = N / BM; nwg = nM * nN; G = G_; c = c_; }
    __host__ __device__ bool next(int i, Unit& u) const {
        const long L = (long)i * G + c; if (L >= nwg) return false;
        int wgid = (int)L; { const int q = nwg / NXCD, r = nwg % NXCD, xcd = wgid % NXCD, off = wgid / NXCD; wgid = (xcd < r ? xcd * (q + 1) : r * (q + 1) + (xcd - r) * q) + off; }
        const int nig = WGM * nN, gid = wgid / nig, fm = gid * WGM, gsz = (nM - fm) < WGM ? (nM - fm) : WGM;
        u.pm = fm + ((wgid % nig) % gsz); u.pn = (wgid % nig) / gsz; u.z = 0; return true;
    }
    __device__ __forceinline__ void a_ready(const Unit&) const {}
    __device__ __forceinline__ void done(const Unit&) const {}
};
struct PairOrder : StaticOrder {
    unsigned nxv = 0u;
    unsigned* flag = nullptr;
    volatile PG8_LAS unsigned* lflag = nullptr; unsigned tag = 0u; int wid = 0;
    __host__ __device__ bool next(int i, Unit& u) const { const bool ok = StaticOrder::next(i >> 1, u); u.z = i & 1; return ok; }
    __device__ __forceinline__ void a_ready(const Unit& u) const {
        if (u.z == 1 && flag) {
            unsigned sp = 0u;
            if (wid == 0) {
                while (__hip_atomic_load(flag, __ATOMIC_RELAXED, __HIP_MEMORY_SCOPE_AGENT) < nxv) { __builtin_amdgcn_s_sleep(1); if (++sp > (1u << 18)) break; }
                __builtin_amdgcn_fence(__ATOMIC_ACQUIRE, "agent");
                asm volatile("s_waitcnt vmcnt(0)" ::: "memory");
                *lflag = tag;
            } else {
                while (*lflag != tag) { __builtin_amdgcn_s_sleep(1); if (++sp > (1u << 22)) break; }
            }
        }
    }
};

typedef f32x4 AccArr[2][2][4][2];
__device__ __forceinline__ void acc_zero(AccArr& acc) {
#pragma unroll
    for (int a = 0; a < 2; ++a)
#pragma unroll
        for (int b = 0; b < 2; ++b)
#pragma unroll
            for (int m = 0; m < 4; ++m)
#pragma unroll
                for (int n = 0; n < 2; ++n) acc[a][b][m][n] = (f32x4){0.f, 0.f, 0.f, 0.f};
}
template <class Epi> __device__ __forceinline__ auto acc_init(const Epi& E, AccArr& acc, const Unit& u, int wid_s) -> decltype(E.init(acc, u, wid_s)) { return E.init(acc, u, wid_s); }
template <class Epi> __device__ __forceinline__ void acc_init(const Epi&, AccArr& acc, const Unit&, ...) { acc_zero(acc); }
template <class Epi> __device__ __forceinline__ auto epi_pre(const Epi& E, float (&pv)[8], const Unit& u, int wid_s) -> decltype(E.pre(pv, u, wid_s)) { return E.pre(pv, u, wid_s); }
template <class Epi> __device__ __forceinline__ void epi_pre(const Epi&, float (&)[8], const Unit&, ...) {}
template <class Epi, class A> __device__ __forceinline__ auto epi_call(const Epi& E, A& acc, const Unit& u, int wr, int wc, int fr, int fq, const float (&pv)[8]) -> decltype(E(acc, u, wr, wc, fr, fq, pv)) { return E(acc, u, wr, wc, fr, fq, pv); }
template <class Epi, class A> __device__ __forceinline__ void epi_call(const Epi& E, A& acc, const Unit& u, int wr, int wc, int fr, int fq, ...) { E(acc, u, wr, wc, fr, fq); }
template <class Epi, class = void> struct Epi_relax { static constexpr int value = 0; };
template <class Epi> struct Epi_relax<Epi, decltype((void)Epi::RELAX)> { static constexpr int value = Epi::RELAX; };
template <class Epi, class Sched, bool ALIGN_EPI = MK_ALIGN, bool SP2 = MK_SP2>
__device__ __forceinline__ void gemm_phase(PG8_LAS unsigned char* lds, const Gemm g, const Sched& S, const Epi& E, int wid_s) {
    const int tid = opaque_tid(wid_s), wid = __builtin_amdgcn_readfirstlane(tid >> 6), lane = tid & 63, wr = wid >> 2, wc = wid & 3, fr = lane & 15, fq = lane >> 4;
    const int K = g.K, nt = K / BK;
    unsigned voffA[2], voffB[2];
#pragma unroll
    for (int i = 0; i < 2; ++i) { int R, C; stage_rc(tid * 16 + i * 8192, R, C); const int Rb = Epi::PERM ? ((R & ~31) + perm32(R & 31)) : R;
        voffA[i] = (unsigned)(R * K + C) * 2u; voffB[i] = (unsigned)(Rb * K + C) * 2u; }
    const size_t kstep = (size_t)(BK * 2);
    const size_t hstep = (size_t)HALF * K * 2;
    const size_t tstep = 2 * hstep;
    const unsigned ldsw = (unsigned)wid * 1024u;
    const int aoff = lds_byte(wr * 64 + fr, fq * 8), boff = lds_byte(wc * 32 + fr, fq * 8);
#define PG8_SA(b, h) (((b) * 2 + (h)) * HTB)
#define PG8_SB(b, h) ((4 + (b) * 2 + (h)) * HTB)
#define PG8_STAGE(bufoff, gbase, voff) do { _Pragma("unroll") for (int _i = 0; _i < 2; ++_i) \
        __builtin_amdgcn_global_load_lds((const unsigned*)((const char*)(gbase) + (voff)[_i]), (PG8_LAS unsigned*)(lds + (bufoff) + ldsw + _i * 8192), 16, 0, 0); } while (0)
#define PG8_LDA(dst, b, h) do { _Pragma("unroll") for (int m = 0; m < 4; ++m) _Pragma("unroll") for (int k = 0; k < 2; ++k) dst[m][k] = *(const PG8_LAS bf16x8*)(lds + PG8_SA(b, h) + aoff + m * 2048 + k * 1024); } while (0)
#define PG8_LDB(dst, b, h) do { _Pragma("unroll") for (int n = 0; n < 2; ++n) _Pragma("unroll") for (int k = 0; k < 2; ++k) dst[n][k] = *(const PG8_LAS bf16x8*)(lds + PG8_SB(b, h) + boff + n * 2048 + k * 1024); } while (0)
#define PG8_MMA(ai, bj, At, Bt) do { __builtin_amdgcn_s_setprio(1); _Pragma("unroll") for (int m = 0; m < 4; ++m) _Pragma("unroll") for (int n = 0; n < 2; ++n) _Pragma("unroll") for (int k = 0; k < 2; ++k) \
        acc[ai][bj][m][n] = __builtin_amdgcn_mfma_f32_16x16x32_bf16(Bt[n][k], At[m][k], acc[ai][bj][m][n], 0, 0, 0); __builtin_amdgcn_s_setprio(0); } while (0)
#define PG8_WAIT_V(n) asm volatile("s_waitcnt vmcnt(" #n ")" ::: "memory")
#define PG8_WAIT_L(n) asm volatile("s_waitcnt lgkmcnt(" #n ")" ::: "memory")
#define PG8_WAIT_V8R(rlx) asm volatile("s_waitcnt vmcnt(32)\n\ts_cmp_lg_u32 %0, 0\n\ts_cbranch_scc1 1f\n\ts_waitcnt vmcnt(8)\n1:" :: "s"(rlx) : "memory", "scc")
#define PG8_BAR __builtin_amdgcn_s_barrier()
#define PG8_SCHED __builtin_amdgcn_sched_barrier(0)
    Unit cur, nxt; int ui = 0;
    if (!S.next(0, cur)) return;
    f32x4 acc[2][2][4][2];
    acc_init(E, acc, cur, wid_s);
    float pv[8]; epi_pre(E, pv, cur, wid_s);
    bf16x8 At[4][2], B0[2][2], B1[2][2];
    const char* cA = (const char*)(cur.z ? g.A2 : g.A) + (size_t)cur.pm * tstep; const char* cB = (const char*)(cur.z ? g.Bt2 : g.Bt) + (size_t)cur.pn * tstep;
    S.a_ready(cur);
    if constexpr (SP2) {
        PG8_STAGE(PG8_SB(0, 0), cB, voffB); PG8_STAGE(PG8_SB(0, 1), cB + hstep, voffB); PG8_STAGE(PG8_SA(0, 0), cA, voffA); PG8_STAGE(PG8_SA(0, 1), cA + hstep, voffA);
        if (wr == 1) PG8_BAR;
        PG8_WAIT_V(2); PG8_BAR;
        PG8_STAGE(PG8_SB(1, 0), cB + kstep, voffB); PG8_STAGE(PG8_SA(1, 0), cA + kstep, voffA); PG8_STAGE(PG8_SB(1, 1), cB + hstep + kstep, voffB);
        PG8_WAIT_V(6); PG8_BAR;
    } else {
        PG8_STAGE(PG8_SB(0, 0), cB, voffB); PG8_STAGE(PG8_SA(0, 0), cA, voffA); PG8_STAGE(PG8_SB(0, 1), cB + hstep, voffB); PG8_STAGE(PG8_SA(0, 1), cA + hstep, voffA);
        if (wr == 1) PG8_BAR;
        PG8_WAIT_V(4); PG8_BAR;
        PG8_STAGE(PG8_SB(1, 0), cB + kstep, voffB); PG8_STAGE(PG8_SA(1, 0), cA + kstep, voffA); PG8_STAGE(PG8_SB(1, 1), cB + hstep + kstep, voffB);
        PG8_WAIT_V(6); PG8_BAR;
    }
    for (;;) {
        const bool has_next = S.next(ui + 1, nxt);
        const char* nA = has_next ? (const char*)(nxt.z ? g.A2 : g.A) + (size_t)nxt.pm * tstep : cA; const char* nB = has_next ? (const char*)(nxt.z ? g.Bt2 : g.Bt) + (size_t)nxt.pn * tstep : cB;
        for (int t = 0; t < nt; t += 2) {
            const bool last = (t == nt - 2);
            const char* a1 = cA + (size_t)(t + 1) * kstep;
            const char* a2 = last ? nA : cA + (size_t)(t + 2) * kstep; const char* b2 = last ? nB : cB + (size_t)(t + 2) * kstep;
            const char* a3 = a2 + kstep; const char* b3 = b2 + kstep;
            if (last && has_next) S.a_ready(nxt);
            if constexpr (SP2) {
            const int rlx = (Epi_relax<Epi>::value == 24) ? __builtin_amdgcn_readfirstlane((t == 0 && ui > 0) ? 1 : 0) : 0;
            PG8_LDB(B0, 0, 0); PG8_LDB(B1, 0, 1); PG8_SCHED; PG8_LDA(At, 0, 0); PG8_STAGE(PG8_SA(1, 1), a1 + hstep, voffA);
            PG8_WAIT_V8R(rlx); PG8_WAIT_L(0); PG8_BAR; PG8_MMA(0, 0, At, B0); PG8_MMA(0, 1, At, B1); PG8_BAR; PG8_SCHED;
            PG8_LDA(At, 0, 1); PG8_STAGE(PG8_SB(0, 0), b2, voffB); PG8_STAGE(PG8_SB(0, 1), b2 + hstep, voffB); PG8_STAGE(PG8_SA(0, 0), a2, voffA);
            PG8_WAIT_V8R(rlx); PG8_WAIT_L(0); PG8_BAR; PG8_MMA(1, 0, At, B0); PG8_MMA(1, 1, At, B1); PG8_BAR; PG8_SCHED;
            PG8_LDB(B0, 1, 0); PG8_LDB(B1, 1, 1); PG8_SCHED; PG8_LDA(At, 1, 0); PG8_STAGE(PG8_SA(0, 1), a2 + hstep, voffA);
            PG8_WAIT_V(8); PG8_WAIT_L(0); PG8_BAR; PG8_MMA(0, 0, At, B0); PG8_MMA(0, 1, At, B1); PG8_BAR; PG8_SCHED;
            PG8_LDA(At, 1, 1); PG8_STAGE(PG8_SB(1, 0), b3, voffB); PG8_STAGE(PG8_SB(1, 1), b3 + hstep, voffB); PG8_STAGE(PG8_SA(1, 0), a3, voffA);
            PG8_WAIT_V(8); PG8_WAIT_L(0); PG8_BAR; PG8_MMA(1, 0, At, B0); PG8_MMA(1, 1, At, B1); PG8_BAR; PG8_SCHED;
            } else {
            PG8_LDB(B0, 0, 0); PG8_SCHED; PG8_LDA(At, 0, 0); PG8_STAGE(PG8_SA(1, 1), a1 + hstep, voffA);
            PG8_WAIT_L(8); PG8_BAR; PG8_WAIT_L(0); PG8_MMA(0, 0, At, B0); PG8_BAR; PG8_SCHED;
            PG8_LDB(B1, 0, 1); PG8_STAGE(PG8_SB(0, 0), b2, voffB);
            PG8_BAR; PG8_WAIT_L(0); PG8_MMA(0, 1, At, B1); PG8_BAR;
            PG8_LDA(At, 0, 1); PG8_STAGE(PG8_SA(0, 0), a2, voffA);
            PG8_BAR; PG8_WAIT_L(0); PG8_MMA(1, 0, At, B0); PG8_BAR; PG8_SCHED;
            PG8_STAGE(PG8_SB(0, 1), b2 + hstep, voffB);
            PG8_WAIT_V(6); PG8_BAR; PG8_MMA(1, 1, At, B1); PG8_BAR;
            PG8_LDB(B0, 1, 0); PG8_SCHED; PG8_LDA(At, 1, 0); PG8_STAGE(PG8_SA(0, 1), a2 + hstep, voffA);
            PG8_WAIT_L(8); PG8_BAR; PG8_WAIT_L(0); PG8_MMA(0, 0, At, B0); PG8_BAR; PG8_SCHED;
            PG8_LDB(B1, 1, 1); PG8_STAGE(PG8_SB(1, 0), b3, voffB);
            PG8_BAR; PG8_WAIT_L(0); PG8_MMA(0, 1, At, B1); PG8_BAR;
            PG8_LDA(At, 1, 1); PG8_STAGE(PG8_SA(1, 0), a3, voffA);
            PG8_BAR; PG8_WAIT_L(0); PG8_MMA(1, 0, At, B0); PG8_BAR; PG8_SCHED;
            PG8_STAGE(PG8_SB(1, 1), b3 + hstep, voffB);
            PG8_WAIT_V(6); PG8_BAR; PG8_MMA(1, 1, At, B1); PG8_BAR;
            }
        }
        if constexpr (ALIGN_EPI) { if (wr == 0) PG8_BAR; }
        { const int t2 = opaque_tid(wid_s), w2 = __builtin_amdgcn_readfirstlane(t2 >> 6); epi_call(E, acc, cur, w2 >> 2, w2 & 3, t2 & 15, (t2 & 63) >> 4, pv); }
        if (!has_next) break;
        acc_init(E, acc, nxt, wid_s); epi_pre(E, pv, nxt, wid_s);
        cur = nxt; cA = nA; cB = nB; ++ui;
        if constexpr (ALIGN_EPI) { if (wr == 1) PG8_BAR; }
    }
    PG8_WAIT_V(0);
    if constexpr (!ALIGN_EPI) { if (wr == 0) PG8_BAR; }
    PG8_BAR;
#undef PG8_SA
#undef PG8_SB
#undef PG8_STAGE
#undef PG8_LDA
#undef PG8_LDB
#undef PG8_MMA
#undef PG8_WAIT_V
#undef PG8_WAIT_L
#undef PG8_BAR
#undef PG8_SCHED
}
}

typedef f32x4 AccT[2][2][4][2];

#define GAS __attribute__((address_space(1)))
__device__ __forceinline__ void stg16(void* p, u32x4 w) { *(GAS u32x4*)p = w; }
__device__ __forceinline__ void store8_bf16(bf16_t* p, const float (&v)[8]) {
    u32x4 w; w.x = cvt_pk_bf16(v[0], v[1]); w.y = cvt_pk_bf16(v[2], v[3]); w.z = cvt_pk_bf16(v[4], v[5]); w.w = cvt_pk_bf16(v[6], v[7]);
    stg16(p, w);
}
__device__ __forceinline__ void cvt8_bf16(const u32x4 w, float (&v)[8]) {
    v[0] = bflo(w.x); v[1] = bfhi(w.x); v[2] = bflo(w.y); v[3] = bfhi(w.y); v[4] = bflo(w.z); v[5] = bfhi(w.z); v[6] = bflo(w.w); v[7] = bfhi(w.w);
}
__device__ __forceinline__ u32x4 ldg16(const void* p) { return *(const GAS u32x4*)p; }
__device__ __forceinline__ u32x4 ldg16_nt(const void* p) { return __builtin_nontemporal_load((const GAS u32x4*)p); }
__device__ __forceinline__ u32x2 ldg8_nt(const void* p) { return __builtin_nontemporal_load((const GAS u32x2*)p); }
__device__ __forceinline__ unsigned ldg4_nt(const void* p) { return __builtin_nontemporal_load((const GAS unsigned*)p); }
__device__ __forceinline__ unsigned ldg4_nt(const GAS unsigned char* p) { return __builtin_nontemporal_load((const GAS unsigned*)p); }
__device__ __forceinline__ f32x4 ldgf4(const float* p) { return *(const GAS f32x4*)p; }
__device__ __forceinline__ f32x4 ldgf4_nt(const float* p) { return __builtin_nontemporal_load((const GAS f32x4*)p); }
__device__ __forceinline__ float ldgf(const float* p) { return *(const GAS float*)p; }
__device__ __forceinline__ void load8_bf16(const bf16_t* p, float (&v)[8]) { cvt8_bf16(ldg16(p), v); }
__device__ __forceinline__ void store8_f32(float* p, const float (&v)[8]) {
    stg16(p, __builtin_bit_cast(u32x4, (f32x4){v[0], v[1], v[2], v[3]})); stg16(p + 4, __builtin_bit_cast(u32x4, (f32x4){v[4], v[5], v[6], v[7]}));
}
__device__ __forceinline__ void load8_f32(const float* p, float (&v)[8]) {
    const f32x4 a = ldgf4(p), b = ldgf4(p + 4);
    v[0] = a[0]; v[1] = a[1]; v[2] = a[2]; v[3] = a[3]; v[4] = b[0]; v[5] = b[1]; v[6] = b[2]; v[7] = b[3];
}
__device__ __forceinline__ void acc8(const AccT& acc, int ai, int bj, int m, float (&v)[8]) {
    const f32x4 a = acc[ai][bj][m][0], b = acc[ai][bj][m][1];
    v[0] = a[0]; v[1] = a[1]; v[2] = a[2]; v[3] = a[3]; v[4] = b[0]; v[5] = b[1]; v[6] = b[2]; v[7] = b[3];
}
#define EPI_FENCE() asm volatile("" ::: "memory")
__device__ __forceinline__ void load_rs8(const float* ssq, int row0, float (&rs)[8]) {
#pragma unroll
    for (int i = 0; i < 8; ++i) rs[i] = ldgf(ssq + row0 + (i >> 2) * 128 + (i & 3) * 16);
#pragma unroll
    for (int i = 0; i < 8; ++i) rs[i] = rsqrtf(rs[i] * (1.0f / DM) + EPS);
}

template <int ACT> __device__ __forceinline__ void epi_plain(const AccT& acc, const float (&rs)[8], bf16_t* dst, int ld, int row0, int c0) {
#pragma unroll
    for (int ai = 0; ai < 2; ++ai)
#pragma unroll
        for (int m = 0; m < 4; ++m) {
            const int row = row0 + ai * 128 + m * 16; const float r = rs[ai * 4 + m];
            const float rn = r * NLOG2E;
#pragma unroll
            for (int bj = 0; bj < 2; ++bj) { u32x4 w;
#pragma unroll
                for (int p = 0; p < 4; ++p) { const f32x4 a4 = acc[ai][bj][m][p >> 1]; const f32x2 a = (p & 1) ? __builtin_shufflevector(a4, a4, 2, 3) : __builtin_shufflevector(a4, a4, 0, 1);
                    f32x2 z = a * r; if (ACT == 1) z = z * sig2(a, rn); if (ACT == 2) z = sig2(a, rn);
                    w[p] = cvt_pk_bf16(z.x, z.y); }
                stg16(dst + ((size_t)((c0 >> 7) + bj) * SEQ + row) * 128 + (c0 & 127), w); }
        }
}
__device__ __forceinline__ void epi_gate8(const AccT& acc, const float (&rs)[8], unsigned char* dst, int row0, int c0) {
#pragma unroll
    for (int ai = 0; ai < 2; ++ai)
#pragma unroll
        for (int m = 0; m < 4; ++m) {
            const int row = row0 + ai * 128 + m * 16; const float r = rs[ai * 4 + m];
            const float rn = r * NLOG2E;
#pragma unroll
            for (int bj = 0; bj < 2; ++bj) { unsigned q[8];
#pragma unroll
                for (int p = 0; p < 4; ++p) { const f32x4 a4 = acc[ai][bj][m][p >> 1]; const f32x2 a = (p & 1) ? __builtin_shufflevector(a4, a4, 2, 3) : __builtin_shufflevector(a4, a4, 0, 1);
                    const f32x2 g = sig2(a, rn) * 255.f + 0.5f;
                    q[2 * p] = max((unsigned)g.x, 1u); q[2 * p + 1] = max((unsigned)g.y, 1u); }
                u32x2 w; w.x = q[0] | (q[1] << 8) | (q[2] << 16) | (q[3] << 24); w.y = q[4] | (q[5] << 8) | (q[6] << 16) | (q[7] << 24);
                *(GAS u32x2*)(dst + (size_t)row * DM + c0 + bj * 128) = w; }
        }
}
__device__ __forceinline__ void cvt8_u8(const u32x2 w, float (&v)[8]) {
#pragma unroll
    for (int e = 0; e < 8; ++e) v[e] = (float)(((e < 4 ? w.x : w.y) >> (8 * (e & 3))) & 0xffu) * (1.0f / 255.f);
}
__device__ __forceinline__ u32x2 ldg8(const void* p) { return *(const GAS u32x2*)p; }
struct EpiInProj {
    static constexpr bool PERM = true;
    static constexpr int RELAX = 24;
    const float* ssq; const float* lower; unsigned char* ws;
    __device__ __forceinline__ void pre(float (&pv)[8], const pg8::Unit& u, int wid_s) const {
        const int t = opaque_tid(wid_s), row0 = u.pm * 256 + ((t >> 6) >> 2) * 64 + (t & 15);
#pragma unroll
        for (int i = 0; i < 8; ++i) pv[i] = ldgf(ssq + row0 + (i >> 2) * 128 + (i & 3) * 16);
    }
    __device__ __forceinline__ void operator()(const AccT& acc, const pg8::Unit& u, int wr, int wc, int fr, int fq, const float (&pv)[8]) const {
        const int colt = u.pn * 256, seg = colt >> 10;
        const int row0 = u.pm * 256 + wr * 64 + fr;
        const int cin = wc * 32 + 8 * fq;
        const int cseg = (colt & 1023) + cin;
        float rs[8];
#pragma unroll
        for (int i = 0; i < 8; ++i) rs[i] = rsqrtf(pv[i] * (1.0f / DM) + EPS);
        if (seg == 2 || seg == 3) {
            const int dir = seg - 2;
            unsigned short* G = (unsigned short*)(ws + (dir ? WS_GB : WS_GF));
#pragma unroll
            for (int bj = 0; bj < 2; ++bj) {
                const int c = cseg + bj * 128; float lb[8]; load8_f32(lower + dir * 1024 + c, lb);
#pragma unroll
                for (int ai = 0; ai < 2; ++ai)
#pragma unroll
                    for (int m = 0; m < 4; ++m) {
                        const int row = row0 + ai * 128 + m * 16; const float r = rs[ai * 4 + m];
                        float lg[8]; const float rn = r * NLOG2E;
#pragma unroll
                        for (int p = 0; p < 4; ++p) { const f32x4 a4 = acc[ai][bj][m][p >> 1]; const f32x2 a = (p & 1) ? __builtin_shufflevector(a4, a4, 2, 3) : __builtin_shufflevector(a4, a4, 0, 1);
                            const f32x2 l2 = (f32x2){lb[2 * p], lb[2 * p + 1]};
                            const f32x2 f = l2 + (1.0f - l2) * sig2(a, rn);
                            const f32x2 lf = (f32x2){__builtin_amdgcn_logf(fmaxf(f.x, 1e-6f)), __builtin_amdgcn_logf(fmaxf(f.y, 1e-6f))} * 0.6931471805599453f;
                            lg[2 * p] = lf.x; lg[2 * p + 1] = lf.y; }
                        { u32x4 wg; wg.x = cvt_pk_f16(lg[0], lg[1]); wg.y = cvt_pk_f16(lg[2], lg[3]); wg.z = cvt_pk_f16(lg[4], lg[5]); wg.w = cvt_pk_f16(lg[6], lg[7]); *(GAS u32x4*)(G + ((size_t)(c >> 7) * SEQ + row) * 128 + (c & 127)) = wg; }
                    }
            }
        } else if (seg == 7) epi_plain<0>(acc, rs, (bf16_t*)(ws + WS_VT), HW, row0, cseg);
        else if (seg == 0) epi_plain<1>(acc, rs, (bf16_t*)(ws + WS_QH), HW, row0, cseg);
        else if (seg == 1) epi_plain<0>(acc, rs, (bf16_t*)(ws + WS_VH), HW, row0, cseg);
        else if (seg == 4) epi_plain<1>(acc, rs, (bf16_t*)(ws + WS_HG), HW, row0, cseg);
        else if (seg == 5) epi_plain<0>(acc, rs, (bf16_t*)(ws + WS_NQ), HW, row0, cseg);
        else if (seg == 6) {
            bf16_t* NK = (bf16_t*)(ws + WS_NK); float* RKS = (float*)(ws + WS_RKS); const int hd0 = (colt & 1023) >> 7;
#pragma unroll
            for (int ai = 0; ai < 2; ++ai)
#pragma unroll
                for (int m = 0; m < 4; ++m) { const int row = row0 + ai * 128 + m * 16; const float r = rs[ai * 4 + m];
#pragma unroll
                    for (int bj = 0; bj < 2; ++bj) { float v[8]; acc8(acc, ai, bj, m, v); float s = 0.f;
#pragma unroll
                        for (int e = 0; e < 8; ++e) { v[e] *= r; s += v[e] * v[e]; }
                        store8_bf16(NK + ((size_t)((cseg >> 7) + bj) * SEQ + row) * 128 + (cseg & 127), v);
                        s += __shfl_xor(s, 16); s += __shfl_xor(s, 32);
                        if (fq == 0) atomicAdd(RKS + row * 8 + hd0 + bj, s); } }
        }
        else if (seg == 8) epi_plain<1>(acc, rs, (bf16_t*)(ws + WS_NG), HW, row0, cseg);
        else if (seg < 11) epi_gate8(acc, rs, (unsigned char*)(ws + WS_MA), row0, colt - 9216 + cin);
        else epi_gate8(acc, rs, (unsigned char*)(ws + WS_MB), row0, colt - 11264 + cin);
    }
};

struct EpiMBTail {
    static constexpr bool PERM = true;
    const float* ssq; unsigned char* MB;
    __device__ __forceinline__ void operator()(const AccT& acc, const pg8::Unit& u, int wr, int wc, int fr, int fq) const {
        const int row0 = u.pm * 256 + wr * 64 + fr;
        float rs[8]; load_rs8(ssq, row0, rs);
        epi_gate8(acc, rs, MB, row0, 1024 + u.pn * 256 + wc * 32 + 8 * fq);
    }
};

#define EPI_IT(it, ai, m, bj) const int ai = (it) >> 3, m = ((it) >> 1) & 3, bj = (it) & 1
struct EpiBranch {
    static constexpr bool PERM = true;
    const unsigned char* MA; const unsigned char* MB; bf16_t* Y;
    __device__ __forceinline__ void init(AccT& acc, const pg8::Unit& u, int) const { if (u.z == 0) pg8::acc_zero(acc); }
    __device__ __forceinline__ void operator()(AccT& acc, const pg8::Unit& u, int wr, int wc, int fr, int fq) const {
        const int row0 = u.pm * 256 + wr * 64 + fr, c0 = u.pn * 256 + wc * 32 + 8 * fq;
        if (u.z == 0) {
            u32x2 ga[2], gb[2];
            { const size_t o = (size_t)row0 * DM + c0; ga[0] = ldg8(MA + o); gb[0] = ldg8_nt(MB + o); }
#pragma unroll
            for (int it = 0; it < 16; ++it) { EPI_IT(it, ai, m, bj);
                if (it + 1 < 16) { EPI_IT(it + 1, ai2, m2, bj2); const size_t o = (size_t)(row0 + ai2 * 128 + m2 * 16) * DM + c0 + bj2 * 128; const int b = (it + 1) & 1; ga[b] = ldg8(MA + o); gb[b] = ldg8_nt(MB + o); }
                const u32x2 wa = ga[it & 1], wb = gb[it & 1];
#pragma unroll
                for (int p = 0; p < 4; ++p) { const unsigned ua = (p < 2 ? wa.x : wa.y) >> (16 * (p & 1)), ub = (p < 2 ? wb.x : wb.y) >> (16 * (p & 1));
                    const f32x2 qa = (f32x2){(float)(ua & 0xffu), (float)((ua >> 8) & 0xffu)}, qb = (f32x2){(float)(ub & 0xffu), (float)((ub >> 8) & 0xffu)};
                    const f32x2 ratio = qb * rcp_2(qa);
                    f32x4& a4 = acc[ai][bj][m][p >> 1];
                    if (p & 1) { a4[2] *= ratio.x; a4[3] *= ratio.y; } else { a4[0] *= ratio.x; a4[1] *= ratio.y; } }
                EPI_FENCE(); }
        } else {
            u32x2 g[2];
            g[0] = ldg8_nt(MA + (size_t)row0 * DM + c0);
#pragma unroll
            for (int it = 0; it < 16; ++it) { EPI_IT(it, ai, m, bj);
                const size_t off = (size_t)(row0 + ai * 128 + m * 16) * DM + c0 + bj * 128;
                if (it + 1 < 16) { EPI_IT(it + 1, ai2, m2, bj2); g[(it + 1) & 1] = ldg8_nt(MA + (size_t)(row0 + ai2 * 128 + m2 * 16) * DM + c0 + bj2 * 128); }
                float v[8], gg[8]; acc8(acc, ai, bj, m, v); cvt8_u8(g[it & 1], gg);
#pragma unroll
                for (int e = 0; e < 8; ++e) v[e] *= gg[e];
                store8_bf16(Y + off, v); EPI_FENCE(); }
        }
    }
};
struct EpiWout {
    static constexpr bool PERM = true;
    const bf16_t* xin; bf16_t* XB1; float* ssq_out;
    __device__ __forceinline__ void operator()(const AccT& acc, const pg8::Unit& u, int wr, int wc, int fr, int fq) const {
        const int row0 = u.pm * 256 + wr * 64 + fr, c0 = u.pn * 256 + wc * 32 + 8 * fq;
        u32x4 xb[2];
        xb[0] = ldg16_nt(xin + (size_t)row0 * DM + c0);
        float s = 0.f;
#pragma unroll
        for (int it = 0; it < 16; ++it) { EPI_IT(it, ai, m, bj);
            const int row = row0 + ai * 128 + m * 16; const size_t off = (size_t)row * DM + c0 + bj * 128;
            if (it + 1 < 16) { EPI_IT(it + 1, ai2, m2, bj2); xb[(it + 1) & 1] = ldg16_nt(xin + (size_t)(row0 + ai2 * 128 + m2 * 16) * DM + c0 + bj2 * 128); }
            float v[8], xi[8]; acc8(acc, ai, bj, m, v); cvt8_bf16(xb[it & 1], xi);
#pragma unroll
            for (int e = 0; e < 8; ++e) { v[e] += xi[e]; s += v[e] * v[e]; }
            store8_bf16(XB1 + off, v);
            if (bj == 1) { s += __shfl_xor(s, 16); s += __shfl_xor(s, 32); if (fq == 0) atomicAdd(ssq_out + row, s); s = 0.f; }
            EPI_FENCE(); }
    }
};
struct EpiPL {
    static constexpr bool PERM = true;
    bf16_t* PL;
    __device__ __forceinline__ void operator()(const AccT& acc, const pg8::Unit& u, int wr, int wc, int fr, int fq) const {
        const int row0 = u.pm * 256 + wr * 64 + fr, c0 = u.pn * 256 + wc * 32 + 8 * fq;
#pragma unroll
        for (int ai = 0; ai < 2; ++ai)
#pragma unroll
            for (int m = 0; m < 4; ++m) { const int row = row0 + ai * 128 + m * 16;
#pragma unroll
                for (int bj = 0; bj < 2; ++bj) { float v[8]; acc8(acc, ai, bj, m, v); store8_bf16(PL + (size_t)row * DM + c0 + bj * 128, v); } }
    }
};
struct EpiGate {
    static constexpr bool PERM = true;
    const float* ssq1; const bf16_t* XB1; const bf16_t* PL; float* xout; bf16_t* XBN; float* ssq_next; int has_next;
    __device__ __forceinline__ void operator()(const AccT& acc, const pg8::Unit& u, int wr, int wc, int fr, int fq) const {
        const int row0 = u.pm * 256 + wr * 64 + fr, c0 = u.pn * 256 + wc * 32 + 8 * fq;
        u32x4 xb[2], pb[2]; float sq[2];
        { const size_t o = (size_t)row0 * DM + c0; xb[0] = ldg16(XB1 + o); pb[0] = ldg16_nt(PL + o); sq[0] = ldgf(ssq1 + row0); }
        float s = 0.f;
#pragma unroll
        for (int it = 0; it < 16; ++it) { EPI_IT(it, ai, m, bj);
            const int row = row0 + ai * 128 + m * 16; const size_t off = (size_t)row * DM + c0 + bj * 128;
            if (it + 1 < 16) { EPI_IT(it + 1, ai2, m2, bj2); const int rown = row0 + ai2 * 128 + m2 * 16; const size_t o = (size_t)rown * DM + c0 + bj2 * 128; const int b = (it + 1) & 1;
                xb[b] = ldg16(XB1 + o); pb[b] = ldg16_nt(PL + o); sq[b] = ldgf(ssq1 + rown); }
            const float r = rsqrtf(sq[it & 1] * (1.0f / DM) + EPS);
            float v[8], x1[8], pl[8]; acc8(acc, ai, bj, m, v); cvt8_bf16(xb[it & 1], x1); cvt8_bf16(pb[it & 1], pl);
#pragma unroll
            for (int p = 0; p < 4; ++p) { const f32x2 g = sig2((f32x2){v[2 * p], v[2 * p + 1]}, r * NLOG2E);
                const f32x2 y = (f32x2){x1[2 * p], x1[2 * p + 1]} + (f32x2){pl[2 * p], pl[2 * p + 1]} * g; v[2 * p] = y.x; v[2 * p + 1] = y.y; s += y.x * y.x + y.y * y.y; }
            if (has_next) { store8_bf16(XBN + off, v);
                if (bj == 1) { s += __shfl_xor(s, 16); s += __shfl_xor(s, 32); if (fq == 0) atomicAdd(ssq_next + row, s); s = 0.f; } }
            else store8_f32(xout + off, v);
            EPI_FENCE(); }
    }
};

#define XB_TMO      128
#define XB_XCNT(j)  (256  + 64 * (j))
#define XB_XSUB(j)  (1280 + 64 * (j))
#define XB_XGEN(j)  (2304 + 64 * (j))
#define XB_TOP      3328
#define XB_TOPGEN   3392
#define XCD_BAR_WORDS 3456
#define XB_SPIN_CAP (1u << 18)
__device__ __forceinline__ unsigned xb_ld(unsigned* p)              { return __hip_atomic_load(p, __ATOMIC_RELAXED, __HIP_MEMORY_SCOPE_AGENT); }
__device__ __forceinline__ unsigned xb_add(unsigned* p, unsigned v) { return __hip_atomic_fetch_add(p, v, __ATOMIC_RELAXED, __HIP_MEMORY_SCOPE_AGENT); }
__device__ __forceinline__ unsigned xb_xcc_id() { return (unsigned)__builtin_amdgcn_s_getreg((3 << 11) | 20) & 0xFu; }
#define XB_SPIN(cond, bar) do { unsigned _sp = 0; while (cond) { __builtin_amdgcn_s_sleep(1); \
    if ((++_sp & 255u) == 0u) { if (xb_ld(&(bar)[XB_TMO])) break; if (_sp > XB_SPIN_CAP) { atomicAdd(&(bar)[XB_TMO], 1u); break; } } } } while (0)
struct XcdBarrier { unsigned* bar; unsigned x; volatile LAS unsigned* st; };
__device__ __forceinline__ XcdBarrier xcd_barrier_post(unsigned* bar, volatile LAS unsigned* st) {
    XcdBarrier b; b.bar = bar; b.x = xb_xcc_id(); b.st = st;
    if (threadIdx.x == 0) (void)xb_add(&bar[XB_XCNT(b.x)], 1u);
    return b;
}
__device__ __forceinline__ void xcd_barrier_complete(unsigned* bar, unsigned x, unsigned& nloc, unsigned& nx) {
    const unsigned G = gridDim.x * gridDim.y * gridDim.z;
    unsigned sum, cnt, mine, sp = 0u;
    for (;;) {
        sum = 0u; cnt = 0u; mine = 0u;
#pragma unroll
        for (unsigned j = 0; j < 16; ++j) { const unsigned c = xb_ld(&bar[XB_XCNT(j)]); sum += c; cnt += (c > 0u) ? 1u : 0u; mine = (j == x) ? c : mine; }
        if (sum == G) break;
        __builtin_amdgcn_s_sleep(1);
        if ((++sp & 255u) == 0u) { if (xb_ld(&bar[XB_TMO])) break; if (sp > XB_SPIN_CAP) { atomicAdd(&bar[XB_TMO], 1u); break; } }
    }
    nloc = mine > 0u ? mine : 1u; nx = cnt > 0u ? cnt : 1u;
}
#define XB_KBASE   1536
#define XB_KSTRIDE 576
__device__ __forceinline__ void xcd_arrive(const XcdBarrier& b, int k) {
    asm volatile("s_waitcnt vmcnt(0)" ::: "memory");
    __syncthreads();
    if (threadIdx.x == 0) {
        unsigned* bar = b.bar;
        __builtin_amdgcn_s_waitcnt(0);
        unsigned nloc = b.st[0], nx = b.st[1];
        if (nloc == 0u) { xcd_barrier_complete(bar, b.x, nloc, nx); b.st[0] = nloc; b.st[1] = nx; }
        unsigned* kb = bar + XB_KBASE + k * XB_KSTRIDE;
        const unsigned old = xb_add(&kb[b.x * 32u], 1u);
        if (old + 1u == nloc) {
            __builtin_amdgcn_fence(__ATOMIC_RELEASE, "agent");
            asm volatile("s_waitcnt vmcnt(0)" ::: "memory");
            (void)xb_add(&kb[512], 1u);
        }
    }
}
__device__ __forceinline__ void xcd_wait(const XcdBarrier& b, int k) {
    if (threadIdx.x == 0) {
        unsigned* bar = b.bar; unsigned* kb = bar + XB_KBASE + k * XB_KSTRIDE;
        const unsigned nx = b.st[1];
        XB_SPIN(xb_ld(&kb[512]) < nx, bar);
        __builtin_amdgcn_fence(__ATOMIC_ACQUIRE, "agent");
        asm volatile("s_waitcnt vmcnt(0)" ::: "memory");
    }
    __syncthreads();
}

struct Args { const float* in[15]; float* out; unsigned char* ws; int ph_lo, ph_hi; };
constexpr int CONV_NTILE = 3200 + 9856;
constexpr int CONV_NBATCH = CONV_NTILE / 4;
constexpr int CONV_D_WP0 = 128 / 4, CONV_D_BR0 = 1152 / 4, CONV_D_WO0 = 2176 / 4, CONV_D_WG0 = 3200 / 4, CONV_D_IN1 = 9984 / 4;
__device__ __forceinline__ void conv_fill(const Args& a, LAS unsigned char* lds, int wid_s, unsigned* flag, unsigned nxv, volatile LAS unsigned* lw) {
    unsigned char* ws = opaque_ptr(a.ws);
    const int tid = opaque_tid(wid_s);
    unsigned* ticket = (unsigned*)(ws + WS_CTL) + 64;
    LAS float* tiles = (LAS float*)lds;
    const int k0 = tid >> 4, c4 = tid & 15, n = tid >> 3, kq = tid & 7;
    if (tid == 0) { int p = (int)lw[1] - 1; const unsigned f0 = flag ? (xb_ld(flag) >= nxv ? 1u : 0u) : 0u; if (p < 0) p = (int)xb_add(ticket, 1u); lw[1] = 0u; lw[0] = (unsigned)p; lw[2] = flag ? f0 : ((unsigned)p >= nxv ? 1u : 0u); }
    for (;;) {
        __syncthreads();
        const int t = __builtin_amdgcn_readfirstlane((int)lw[0]); const unsigned stop = __builtin_amdgcn_readfirstlane(lw[2]);
        if (t >= CONV_NBATCH) break;
        if (stop) { if (tid == 0) lw[1] = (unsigned)t + 1u; break; }
        unsigned tn = 0u, fn = 0u;
        if (tid == 0) { tn = xb_add(ticket, 1u); fn = flag ? xb_ld(flag) : 0u; }
        const int ft = 4 * t;
        int kind, lay, base;
        if (ft < 3200) { lay = 0; if (ft < 128) { kind = 5; base = 0; } else if (ft < 640) { kind = 1; base = 128; } else if (ft < 1152) { kind = 2; base = 640; } else if (ft < 2176) { kind = 3; base = 1152; } else { kind = 4; base = 2176; } }
        else { lay = 1; if (ft < 9856) { kind = 0; base = 3200; } else if (ft < 9984) { kind = 5; base = 9856; } else if (ft < 10496) { kind = 1; base = 9984; } else if (ft < 11008) { kind = 2; base = 10496; } else if (ft < 12032) { kind = 3; base = 11008; } else { kind = 4; base = 12032; } }
        const float* W; bf16_t* WT; int K, N; const float* ksc = nullptr;
        if (kind == 0)      { W = a.in[3] + (size_t)lay * DM * NIN;  WT = (bf16_t*)(ws + WS_WIN) + (size_t)lay * NIN * DM; K = DM;  N = NIN; ksc = a.in[2] + lay * DM; }
        else if (kind == 1) { W = a.in[9] + (size_t)lay * HW * DM;   WT = (bf16_t*)(ws + WS_WA) + (size_t)lay * DM * HW;   K = HW;  N = DM; }
        else if (kind == 2) { W = a.in[10] + (size_t)lay * HW * DM;  WT = (bf16_t*)(ws + WS_WB) + (size_t)lay * DM * HW;   K = HW;  N = DM; }
        else if (kind == 3) { W = a.in[11] + (size_t)lay * DM * DM;  WT = (bf16_t*)(ws + WS_WO) + (size_t)lay * DM * DM;   K = DM;  N = DM; }
        else if (kind == 4) { W = a.in[13] + (size_t)lay * DM * DM;  WT = (bf16_t*)(ws + WS_WG) + (size_t)lay * DM * DM;   K = DM;  N = DM; ksc = a.in[12] + lay * DM; }
        else                { W = a.in[14] + (size_t)lay * PLE * DM; WT = (bf16_t*)(ws + WS_WP) + (size_t)lay * DM * PLE;  K = PLE; N = DM; }
        const int nkt = K / 64;
        f32x4 v[4][2];
#pragma unroll
        for (int q = 0; q < 4; ++q) { const int lt = ft + q - base, tk = lt % nkt, tc = lt / nkt;
            const float* s_ = W + (size_t)(tk * 64 + k0) * N + tc * 64 + c4 * 4;
            v[q][0] = ldgf4_nt(s_); v[q][1] = ldgf4_nt(s_ + (size_t)32 * N);
            if (ksc) { v[q][0] = v[q][0] * ldgf(ksc + tk * 64 + k0); v[q][1] = v[q][1] * ldgf(ksc + tk * 64 + k0 + 32); } }
#pragma unroll
        for (int q = 0; q < 4; ++q) { LAS float* d = tiles + q * (64 * 65) + k0 * 65 + c4 * 4;
            d[0] = v[q][0][0]; d[1] = v[q][0][1]; d[2] = v[q][0][2]; d[3] = v[q][0][3]; d += 32 * 65; d[0] = v[q][1][0]; d[1] = v[q][1][1]; d[2] = v[q][1][2]; d[3] = v[q][1][3]; }
        __syncthreads();
#pragma unroll
        for (int q = 0; q < 4; ++q) { const int lt = ft + q - base, tk = lt % nkt, tc = lt / nkt; float o[8];
#pragma unroll
            for (int j = 0; j < 8; ++j) o[j] = tiles[q * (64 * 65) + (kq * 8 + j) * 65 + n];
            store8_bf16(WT + (size_t)(tc * 64 + n) * K + tk * 64 + kq * 8, o); }
        if (tid == 0) { lw[0] = tn; lw[2] = flag ? (fn >= nxv ? 1u : 0u) : (tn >= nxv ? 1u : 0u); }
    }
    __syncthreads();
}


__device__ __forceinline__ void transpose_convert(const float* __restrict__ W, bf16_t* __restrict__ WT, int K, int N, LAS float* tile, int rot, const float* kscale) {
    const int tid = threadIdx.x, nb = gridDim.x; const int bid = (int)((blockIdx.x + (unsigned)rot) % (unsigned)nb);
    const int nkt = K / 64, ntile = nkt * (N / 64);
    const int k0 = tid >> 4, c4 = tid & 15;
    f32x4 v0, v1;
#define TC_LOAD(t_) do { const int tk_ = (t_) % nkt, tn_ = (t_) / nkt; const float* s_ = W + (size_t)(tk_ * 64 + k0) * N + tn_ * 64 + c4 * 4; \
        v0 = ldgf4_nt(s_); v1 = ldgf4_nt(s_ + (size_t)32 * N); if (kscale) { v0 = v0 * ldgf(kscale + tk_ * 64 + k0); v1 = v1 * ldgf(kscale + tk_ * 64 + k0 + 32); } } while (0)
    int t = bid, par = 0;
    if (t < ntile) TC_LOAD(t);
    for (; t < ntile; t += nb, par ^= 1) {
        LAS float* tl = tile + par * (64 * 65);
        { LAS float* d = tl + k0 * 65 + c4 * 4; d[0] = v0[0]; d[1] = v0[1]; d[2] = v0[2]; d[3] = v0[3]; d += 32 * 65; d[0] = v1[0]; d[1] = v1[1]; d[2] = v1[2]; d[3] = v1[3]; }
        const int tk = t % nkt, tn = t / nkt;
        if (t + nb < ntile) TC_LOAD(t + nb);
        __syncthreads();
        { const int n = tid >> 3, kq = tid & 7; float v[8];
#pragma unroll
          for (int j = 0; j < 8; ++j) v[j] = tl[(kq * 8 + j) * 65 + n];
          store8_bf16(WT + (size_t)(tn * 64 + n) * K + tk * 64 + kq * 8, v); }
    }
    __syncthreads();
#undef TC_LOAD
}

__device__ __forceinline__ void p0_prologue(const Args& a, LAS unsigned char* lds, int nlayers) {
    unsigned char* ws = a.ws;
    const int tid = threadIdx.x, bid = blockIdx.x, nb = gridDim.x, gtid = bid * 512 + tid, gsz = nb * 512;
    {
        float* LOWER = (float*)(ws + WS_LOWER); const float* lbp = a.in[4];
        for (int i = gtid; i < 2048; i += gsz) { const float a0 = lbp[i], a1 = lbp[2048 + i]; LOWER[i] = 0.f; LOWER[2048 + i] = 1.f / (1.f + expf(a0 - a1)); }
        float* SSQ = (float*)(ws + WS_SSQ);
        for (int i = gtid; i < 3 * SEQ; i += gsz) SSQ[SEQ + i] = 0.f;
        float* RKS = (float*)(ws + WS_RKS);
        for (int i = gtid; i < SEQ * 8; i += gsz) RKS[i] = 0.f;
    }
    {
        const float* x = a.in[0]; bf16_t* XG = (bf16_t*)(ws + WS_XGA); float* SSQ = (float*)(ws + WS_SSQ);
        const int lane = tid & 63, gw = gtid >> 6, nw = gsz >> 6;
        for (int row = gw; row < SEQ; row += nw) {
            const float* xr = x + (size_t)row * DM; f32x4 v[8]; float s = 0.f;
#pragma unroll
            for (int j = 0; j < 8; ++j) v[j] = ldgf4_nt(xr + (j * 64 + lane) * 4);
#pragma unroll
            for (int j = 0; j < 8; ++j) { s += v[j][0] * v[j][0] + v[j][1] * v[j][1] + v[j][2] * v[j][2] + v[j][3] * v[j][3];
                u32x2 w; w.x = cvt_pk_bf16(v[j][0], v[j][1]); w.y = cvt_pk_bf16(v[j][2], v[j][3]);
                *(GAS u32x2*)(XG + (size_t)row * DM + (j * 64 + lane) * 4) = w; }
#pragma unroll
            for (int o = 32; o >= 1; o >>= 1) s += __shfl_xor(s, o);
            if (lane == 0) SSQ[row] = s;
        }
    }
    {
        const float* p = a.in[1]; bf16_t* PB = (bf16_t*)(ws + WS_PB);
        for (int i = gtid; i < 2 * SEQ * PLE / 16; i += gsz) { f32x4 v[4];
#pragma unroll
            for (int j = 0; j < 4; ++j) v[j] = ldgf4_nt(p + (size_t)i * 16 + j * 4);
            u32x4 w0, w1; w0.x = cvt_pk_bf16(v[0][0], v[0][1]); w0.y = cvt_pk_bf16(v[0][2], v[0][3]); w0.z = cvt_pk_bf16(v[1][0], v[1][1]); w0.w = cvt_pk_bf16(v[1][2], v[1][3]);
            w1.x = cvt_pk_bf16(v[2][0], v[2][1]); w1.y = cvt_pk_bf16(v[2][2], v[2][3]); w1.z = cvt_pk_bf16(v[3][0], v[3][1]); w1.w = cvt_pk_bf16(v[3][2], v[3][3]);
            *(GAS u32x4*)(PB + (size_t)i * 16) = w0; *(GAS u32x4*)(PB + (size_t)i * 16 + 8) = w1; }
    }
    LAS float* tile = (LAS float*)lds;
    if (nlayers < 2) {
        transpose_convert(a.in[3], (bf16_t*)(ws + WS_WIN), DM, NIN, tile, 0, a.in[2]);
        return;
    }
    for (int l = 0; l < 2; ++l) {
        transpose_convert(a.in[3] + (size_t)l * DM * NIN, (bf16_t*)(ws + WS_WIN) + (size_t)l * NIN * DM, DM, NIN, tile, 0, a.in[2] + l * DM);
        transpose_convert(a.in[9] + (size_t)l * HW * DM, (bf16_t*)(ws + WS_WA) + (size_t)l * DM * HW, HW, DM, tile, 0, nullptr);
        transpose_convert(a.in[10] + (size_t)l * HW * DM, (bf16_t*)(ws + WS_WB) + (size_t)l * DM * HW, HW, DM, tile, 0, nullptr);
        transpose_convert(a.in[11] + (size_t)l * DM * DM, (bf16_t*)(ws + WS_WO) + (size_t)l * DM * DM, DM, DM, tile, 0, nullptr);
        transpose_convert(a.in[13] + (size_t)l * DM * DM, (bf16_t*)(ws + WS_WG) + (size_t)l * DM * DM, DM, DM, tile, 0, a.in[12] + l * DM);
        transpose_convert(a.in[14] + (size_t)l * PLE * DM, (bf16_t*)(ws + WS_WP) + (size_t)l * DM * PLE, PLE, DM, tile, 128, nullptr);
    }
}

constexpr int HP_ROWB = 272;
constexpr int HT_ROWB = 144;

__device__ __forceinline__ void hg_cumsum(const float (&gv)[16], int seg, int kc, int dir, LAS float* SEGS, float (&b)[16], float& bref, float& blast) {
    float c = 0.f;
#pragma unroll
    for (int i = 0; i < 16; ++i) { c += gv[i]; b[i] = c; }
    const float tot = c;
    if (dir) {
#pragma unroll
        for (int i = 0; i < 16; ++i) b[i] = tot - b[i] + gv[i];
    }
    SEGS[seg * 128 + kc] = tot;
    __syncthreads();
    const float t0 = SEGS[kc], t1 = SEGS[128 + kc], t2 = SEGS[256 + kc], t3 = SEGS[384 + kc];
    float off;
    if (!dir) { off = (seg > 0 ? t0 : 0.f) + (seg > 1 ? t1 : 0.f) + (seg > 2 ? t2 : 0.f); bref = t0 + t1; }
    else      { off = (seg < 3 ? t3 : 0.f) + (seg < 2 ? t2 : 0.f) + (seg < 1 ? t1 : 0.f); bref = t2 + t3; }
    blast = (t0 + t1) + (t2 + t3);
#pragma unroll
    for (int i = 0; i < 16; ++i) b[i] += off;
}
__device__ __forceinline__ unsigned short ldg_u16(const bf16_t* p) { return *(const GAS bf16_t*)p; }
__device__ __forceinline__ unsigned char ldg_u8(const unsigned char* p) { return *(const GAS unsigned char*)p; }

__device__ __forceinline__ void hg_cumsum2(const float (&g0)[8], const float (&g1)[8], int sg, int cp, int dir, LAS float* SEGS, float (&b0)[8], float (&b1)[8], f32x2& bref, f32x2& blast) {
    float c0 = 0.f, c1 = 0.f;
#pragma unroll
    for (int i = 0; i < 8; ++i) { c0 += g0[i]; b0[i] = c0; c1 += g1[i]; b1[i] = c1; }
    if (dir) {
#pragma unroll
        for (int i = 0; i < 8; ++i) { b0[i] = c0 - b0[i] + g0[i]; b1[i] = c1 - b1[i] + g1[i]; }
    }
    *(LAS f32x2*)(SEGS + sg * 128 + 2 * cp) = (f32x2){c0, c1};
    __syncthreads();
    f32x2 t[8];
#pragma unroll
    for (int s = 0; s < 8; ++s) t[s] = *(const LAS f32x2*)(SEGS + s * 128 + 2 * cp);
    f32x2 off = (f32x2){0.f, 0.f};
#pragma unroll
    for (int s = 0; s < 8; ++s) if (dir ? (s > sg) : (s < sg)) off += t[s];
    const f32x2 lo = (t[0] + t[1]) + (t[2] + t[3]), hi = (t[4] + t[5]) + (t[6] + t[7]);
    bref = dir ? hi : lo; blast = lo + hi;
#pragma unroll
    for (int i = 0; i < 8; ++i) { b0[i] += off.x; b1[i] += off.y; }
}
__device__ __forceinline__ void h1_phase(const Args& a, LAS unsigned char* lds, int wid_s) {
    unsigned char* ws = opaque_ptr(a.ws);
    const int tid = opaque_tid(wid_s), lane = tid & 63, w = __builtin_amdgcn_readfirstlane(tid >> 6), fr = lane & 15, fq = lane >> 4;
    const int cp = tid & 63, sg = w;
    const int kpos = ((((2 * cp) >> 2) & 3) << 5) + (((2 * cp) >> 4) << 2) + ((2 * cp) & 3);
    LAS float* SEGS = (LAS float*)lds; LAS float* SC = (LAS float*)(lds + 4096);
    LAS unsigned char* KpT = lds + 8192; LAS unsigned char* Vt = lds + 8192 + 128 * HT_ROWB;
    const bf16_t* VH = (const bf16_t*)(ws + WS_VH);
    bf16_t* LT = (bf16_t*)(ws + WS_LT); float* DD = (float*)(ws + WS_DD); float* EE = (float*)(ws + WS_EE);
    unsigned gr_[8], vr_[8];
#define H1_FETCH(sub_) do { const int d_ = (sub_) & 1, hn_ = (sub_) >> 1, n_ = hn_ & 127, h_ = hn_ >> 7; \
        const size_t o_ = ((size_t)h_ * SEQ + 64 * n_ + 8 * sg) * 128 + 2 * cp; const bf16_t* G_ = (const bf16_t*)(ws + (d_ ? WS_GB : WS_GF)) + o_; \
        _Pragma("unroll") for (int i = 0; i < 8; ++i) gr_[i] = *(const GAS unsigned*)(G_ + (size_t)i * 128); \
        if (!d_) { _Pragma("unroll") for (int i = 0; i < 8; ++i) vr_[i] = *(const GAS unsigned*)(VH + o_ + (size_t)i * 128); } } while (0)
    int sub = 2 * blockIdx.x;
    if (sub < 2048) H1_FETCH(sub);
    while (sub < 2048) {
        const int d = sub & 1, hn = sub >> 1;
        const int item = d ? 1024 + (hn & ~127) + 127 - (hn & 127) : hn;
        float b0[8], b1[8], g0[8], g1[8]; f32x2 bref, blast;
#pragma unroll
        for (int i = 0; i < 8; ++i) { g0[i] = f16_to_f32((unsigned short)(gr_[i] & 0xffffu)); g1[i] = f16_to_f32((unsigned short)(gr_[i] >> 16)); }
        hg_cumsum2(g0, g1, sg, cp, d, SEGS, b0, b1, bref, blast);
        {
            u32x4 kw0, kw1, vw0, vw1;
#pragma unroll
            for (int i = 0; i < 8; i += 2) {
                const float ka = (1.f - __expf(g0[i])) * __expf(fminf(bref.x - b0[i], 80.f)), kb = (1.f - __expf(g0[i + 1])) * __expf(fminf(bref.x - b0[i + 1], 80.f));
                const float kc_ = (1.f - __expf(g1[i])) * __expf(fminf(bref.y - b1[i], 80.f)), kd_ = (1.f - __expf(g1[i + 1])) * __expf(fminf(bref.y - b1[i + 1], 80.f));
                kw0[i >> 1] = cvt_pk_bf16(ka, kb); kw1[i >> 1] = cvt_pk_bf16(kc_, kd_);
                vw0[i >> 1] = (vr_[i] & 0xffffu) | (vr_[i + 1] << 16); vw1[i >> 1] = (vr_[i] >> 16) | (vr_[i + 1] & 0xffff0000u);
            }
            *(LAS u32x4*)(KpT + (2 * cp) * HT_ROWB + sg * 16) = kw0; *(LAS u32x4*)(KpT + (2 * cp + 1) * HT_ROWB + sg * 16) = kw1;
            if (!d) { *(LAS u32x4*)(Vt + (2 * cp) * HT_ROWB + sg * 16) = vw0; *(LAS u32x4*)(Vt + (2 * cp + 1) * HT_ROWB + sg * 16) = vw1; }
            if (sg == 0) { *(LAS f32x2*)(SC + 2 * cp) = (f32x2){__expf(blast.x - bref.x), __expf(blast.y - bref.y)};
                *(GAS f32x2*)(DD + (size_t)item * 128 + kpos) = (f32x2){__expf(blast.x), __expf(blast.y)}; *(GAS f32x2*)(EE + (size_t)item * 128 + kpos) = (f32x2){__expf(bref.x), __expf(bref.y)}; }
        }
        { const int nsub = d ? sub - 1 + 2 * (int)gridDim.x : sub + 1; if (nsub < 2048) H1_FETCH(nsub); sub = nsub; }
        __syncthreads();
        {
            const int vt = w;
            bf16x8 bv[2];
#pragma unroll
            for (int ks = 0; ks < 2; ++ks) bv[ks] = *(const LAS bf16x8*)(Vt + (16 * vt + fr) * HT_ROWB + (32 * ks + 8 * fq) * 2);
            bf16_t* dst = LT + (size_t)item * 16384 + (size_t)(16 * vt + fr) * 128 + 32 * fq;
            u32x2 prev;
#pragma unroll
            for (int kt = 0; kt < 8; ++kt) {
                f32x4 acc = (f32x4){0.f, 0.f, 0.f, 0.f};
#pragma unroll
                for (int ks = 0; ks < 2; ++ks) { const bf16x8 af = *(const LAS bf16x8*)(KpT + (16 * kt + fr) * HT_ROWB + (32 * ks + 8 * fq) * 2);
                    acc = __builtin_amdgcn_mfma_f32_16x16x32_bf16(af, bv[ks], acc, 0, 0, 0); }
                const f32x4 sc = *(const LAS f32x4*)(SC + 16 * kt + 4 * fq);
                u32x2 ow; ow.x = cvt_pk_bf16(acc[0] * sc[0], acc[1] * sc[1]); ow.y = cvt_pk_bf16(acc[2] * sc[2], acc[3] * sc[3]);
                if (kt & 1) *(GAS u32x4*)(dst + 4 * (kt - 1)) = (u32x4){prev.x, prev.y, ow.x, ow.y}; else prev = ow;
            }
        }
    }
#undef H1_FETCH
}

__device__ __forceinline__ void h2_phase(const Args& a, LAS unsigned char* lds, int wid_s, int bid, int nb) {
    unsigned char* ws = opaque_ptr(a.ws);
    const int tid = opaque_tid(wid_s);
    const float* DD = (const float*)(ws + WS_DD); const float* EE = (const float*)(ws + WS_EE);
    bf16_t* SP = (bf16_t*)(ws + WS_SP);
    LAS float* DL = (LAS float*)lds; LAS float* EL = (LAS float*)(lds + 65536);
    for (int u = bid; u < 256; u += nb) {
        const int chain = u >> 4, sub = u & 15;
        const int v = 8 * sub + (tid >> 6), k = 2 * (tid & 63);
        const size_t ibase = (size_t)chain * 128;
        __syncthreads();
#pragma unroll
        for (int j = 0; j < 8; ++j) { const int idx = (tid + 512 * j) * 4; *(LAS f32x4*)(DL + idx) = ldgf4(DD + ibase * 128 + idx); *(LAS f32x4*)(EL + idx) = ldgf4(EE + ibase * 128 + idx); }
        __syncthreads();
        float s0 = 0.f, s1 = 0.f;
        unsigned ltA[32], ltB[32];
        const unsigned voff = (unsigned)(v * 128 + k) * 2u;
        GAS unsigned char* chbase = (GAS unsigned char*)SP + ibase * 32768;
#define H2_LOAD(L, c0_) do { _Pragma("unroll") for (int j = 0; j < 32; ++j) L[j] = ldg4_nt(chbase + (size_t)((c0_) + j) * 32768 + voff); } while (0)
#define H2_SCAN(L, c0_) do { _Pragma("unroll") for (int j = 0; j < 32; ++j) { const f32x2 dd = *(const LAS f32x2*)(DL + ((c0_) + j) * 128 + k), ee = *(const LAS f32x2*)(EL + ((c0_) + j) * 128 + k); \
            *(GAS unsigned*)(chbase + (size_t)((c0_) + j) * 32768 + voff) = cvt_pk_bf16(s0 * ee[0], s1 * ee[1]); \
            s0 = dd[0] * s0 + bflo(L[j]); s1 = dd[1] * s1 + bfhi(L[j]); } } while (0)
        H2_LOAD(ltA, 0); EPI_FENCE();
        H2_LOAD(ltB, 32); H2_SCAN(ltA, 0); EPI_FENCE();
        H2_LOAD(ltA, 64); H2_SCAN(ltB, 32); EPI_FENCE();
        H2_LOAD(ltB, 96); H2_SCAN(ltA, 64); EPI_FENCE();
        H2_SCAN(ltB, 96);
#undef H2_LOAD
#undef H2_SCAN
    }
    __syncthreads();
}

__device__ __forceinline__ void h3_phase(const Args& a, int layer, LAS unsigned char* lds, int wid_s) {
    unsigned char* ws = opaque_ptr(a.ws);
    const int tid = opaque_tid(wid_s), lane = tid & 63, w = __builtin_amdgcn_readfirstlane(tid >> 6), fr = lane & 15, fq = lane >> 4;
    const int cp = tid & 63, sg = w;
    const int kpos = ((((2 * cp) >> 2) & 3) << 5) + (((2 * cp) >> 4) << 2) + ((2 * cp) & 3);
    LAS float* SEGS = (LAS float*)lds; LAS float* SSQP = (LAS float*)(lds + 4096);
    LAS unsigned char* Qp = lds + 8192; LAS unsigned char* Kp = Qp + 64 * HP_ROWB; LAS unsigned char* Vt = Kp + 64 * HP_ROWB; LAS unsigned char* Ab = Vt + 128 * HT_ROWB; LAS unsigned char* SPs = Ab + 64 * HT_ROWB;
    const bf16_t* QH = (const bf16_t*)(ws + WS_QH); const bf16_t* VH = (const bf16_t*)(ws + WS_VH); const bf16_t* HG = (const bf16_t*)(ws + WS_HG);
    const bf16_t* SP = (const bf16_t*)(ws + WS_SP); bf16_t* OA = (bf16_t*)(ws + WS_OA);
    const float* onorm = a.in[5] + layer * 128;
    unsigned gr_[8], qr_[8], vr_[8]; u32x4 spr[4];
#define H3_FETCH(item_, d_) do { const int n_ = (item_) >> 3, h_ = (item_) & 7, cs_ = (d_) ? 127 - n_ : n_; \
        const size_t o_ = ((size_t)h_ * SEQ + 64 * n_ + 8 * sg) * 128 + 2 * cp; const bf16_t* G_ = (const bf16_t*)(ws + ((d_) ? WS_GB : WS_GF)) + o_; \
        const bf16_t* S_ = SP + (size_t)(((d_) * 8 + h_) * 128 + cs_) * 16384; \
        _Pragma("unroll") for (int i = 0; i < 8; ++i) { gr_[i] = ldg4_nt(G_ + (size_t)i * 128); \
            if ((d_) == 0) { qr_[i] = ldg4_nt(QH + o_ + (size_t)i * 128); vr_[i] = ldg4_nt(VH + o_ + (size_t)i * 128); } }   \
        _Pragma("unroll") for (int i = 0; i < 4; ++i) { const int q_ = tid + 512 * i; spr[i] = ldg16_nt(S_ + (q_ >> 4) * 128 + (q_ & 15) * 8); } } while (0)
    f32x4 onr[4];
#pragma unroll
    for (int j = 0; j < 4; ++j) onr[j] = ldgf4(onorm + 16 * (4 * (w >> 2) + j) + 4 * fq);
    int item = blockIdx.x;
    if (item < 1024) H3_FETCH(item, 0);
    for (; item < 1024; item += gridDim.x) {
        const int n = item >> 3, h = item & 7;
        const int tok0 = 64 * n;
        const int rt = w & 3, vg = w >> 2;
        f32x4 o[4];
#pragma unroll
        for (int j = 0; j < 4; ++j) o[j] = (f32x4){0.f, 0.f, 0.f, 0.f};
        u32x2 hgr[4];
        for (int d = 0; d < 2; ++d) {
            float b0[8], b1[8], g0[8], g1[8]; f32x2 bref, blast;
#pragma unroll
            for (int i = 0; i < 8; ++i) { g0[i] = f16_to_f32((unsigned short)(gr_[i] & 0xffffu)); g1[i] = f16_to_f32((unsigned short)(gr_[i] >> 16)); }
            hg_cumsum2(g0, g1, sg, cp, d, SEGS, b0, b1, bref, blast);
            {
                u32x4 vw0, vw1;
#pragma unroll
                for (int i = 0; i < 8; ++i) {
                    const float e0 = b0[i] - bref.x, e1 = b1[i] - bref.y;
                    const float q0 = bflo(qr_[i]) * __expf(fminf(e0, 80.f)), q1 = bfhi(qr_[i]) * __expf(fminf(e1, 80.f));
                    const float k0 = (1.f - __expf(g0[i])) * __expf(fminf(-e0, 80.f)), k1 = (1.f - __expf(g1[i])) * __expf(fminf(-e1, 80.f));
                    *(LAS unsigned*)(Qp + (8 * sg + i) * HP_ROWB + 2 * kpos) = cvt_pk_bf16(q0, q1);
                    *(LAS unsigned*)(Kp + (8 * sg + i) * HP_ROWB + 2 * kpos) = cvt_pk_bf16(k0, k1);
                }
#pragma unroll
                for (int i = 0; i < 8; i += 2) { vw0[i >> 1] = (vr_[i] & 0xffffu) | (vr_[i + 1] << 16); vw1[i >> 1] = (vr_[i] >> 16) | (vr_[i + 1] & 0xffff0000u); }
                if (d == 0) { *(LAS u32x4*)(Vt + (2 * cp) * HT_ROWB + sg * 16) = vw0; *(LAS u32x4*)(Vt + (2 * cp + 1) * HT_ROWB + sg * 16) = vw1; }
#pragma unroll
                for (int i = 0; i < 4; ++i) { const int q = tid + 512 * i; *(LAS u32x4*)(SPs + (q >> 4) * HP_ROWB + (q & 15) * 16) = spr[i]; }
            }
            if (d == 0) H3_FETCH(item, 1);
            else { if (item + (int)gridDim.x < 1024) H3_FETCH(item + (int)gridDim.x, 0);
#pragma unroll
                for (int j = 0; j < 4; ++j) hgr[j] = ldg8_nt(HG + ((size_t)h * SEQ + tok0 + 16 * rt + fr) * 128 + 16 * (4 * vg + j) + 4 * fq); }
            __syncthreads();
            {
                const int art = w >> 1;
#pragma unroll
                for (int tt = 0; tt < 2; ++tt) {
                    const int st = 2 * (w & 1) + tt;
                    const bool need = d ? (st >= art) : (st <= art);
                    f32x4 acc = (f32x4){0.f, 0.f, 0.f, 0.f};
                    if (need) {
#pragma unroll
                        for (int ks = 0; ks < 4; ++ks) {
                            const bf16x8 af = *(const LAS bf16x8*)(Qp + (16 * art + fr) * HP_ROWB + (32 * ks + 8 * fq) * 2);
                            const bf16x8 bfr = *(const LAS bf16x8*)(Kp + (16 * st + fr) * HP_ROWB + (32 * ks + 8 * fq) * 2);
                            acc = __builtin_amdgcn_mfma_f32_16x16x32_bf16(af, bfr, acc, 0, 0, 0);
                        }
                    }
                    const int s_ = 16 * st + fr;
#pragma unroll
                    for (int r = 0; r < 4; ++r) { const int r_ = 16 * art + 4 * fq + r; const bool ok = need && (d ? (s_ >= r_) : (s_ <= r_));
                        *(LAS unsigned short*)(Ab + r_ * HT_ROWB + s_ * 2) = f2bf1(ok ? acc[r] : 0.f); }
                }
            }
            __syncthreads();
            {
                bf16x8 ab[2], qb[4];
#pragma unroll
                for (int ks = 0; ks < 2; ++ks) ab[ks] = *(const LAS bf16x8*)(Ab + (16 * rt + fr) * HT_ROWB + (32 * ks + 8 * fq) * 2);
#pragma unroll
                for (int ks = 0; ks < 4; ++ks) qb[ks] = *(const LAS bf16x8*)(Qp + (16 * rt + fr) * HP_ROWB + (32 * ks + 8 * fq) * 2);
#pragma unroll
                for (int j = 0; j < 4; ++j) {
                    const int vt = 4 * vg + j;
#pragma unroll
                    for (int ks = 0; ks < 2; ++ks) { const bf16x8 af = *(const LAS bf16x8*)(Vt + (16 * vt + fr) * HT_ROWB + (32 * ks + 8 * fq) * 2);
                        o[j] = __builtin_amdgcn_mfma_f32_16x16x32_bf16(af, ab[ks], o[j], 0, 0, 0); }
#pragma unroll
                    for (int ks = 0; ks < 4; ++ks) { const bf16x8 af = *(const LAS bf16x8*)(SPs + (16 * vt + fr) * HP_ROWB + (32 * ks + 8 * fq) * 2);
                        o[j] = __builtin_amdgcn_mfma_f32_16x16x32_bf16(af, qb[ks], o[j], 0, 0, 0); }
                }
            }
        }
        {
            float s = 0.f;
#pragma unroll
            for (int j = 0; j < 4; ++j) s += o[j][0] * o[j][0] + o[j][1] * o[j][1] + o[j][2] * o[j][2] + o[j][3] * o[j][3];
            s += __shfl_xor(s, 16); s += __shfl_xor(s, 32);
            if (fq == 0) SSQP[vg * 64 + 16 * rt + fr] = s;
            __syncthreads();
            const int row = 16 * rt + fr; const float rs = rsqrtf((SSQP[row] + SSQP[64 + row]) * (1.0f / 128.f) + EPS);
#pragma unroll
            for (int j = 0; j < 4; ++j) { const int v0 = 16 * (4 * vg + j) + 4 * fq; const f32x4 on = onr[j];
                u32x2 ow; ow.x = cvt_pk_bf16(o[j][0] * rs * on[0] * bflo(hgr[j].x), o[j][1] * rs * on[1] * bfhi(hgr[j].x)); ow.y = cvt_pk_bf16(o[j][2] * rs * on[2] * bflo(hgr[j].y), o[j][3] * rs * on[3] * bfhi(hgr[j].y));
                *(GAS u32x2*)(OA + (size_t)(tok0 + row) * HW + h * 128 + v0) = ow; }
        }
    }
#undef H3_FETCH
}

constexpr int NAT_SLOT = 18432, NAT_RP_OFF = 3 * NAT_SLOT, NAT_RK_OFF = NAT_RP_OFF + 2048;
__device__ __forceinline__ void natten_phase(const Args& a, int layer, LAS unsigned char* lds, int wid_s) {
    unsigned char* ws = opaque_ptr(a.ws);
    const int tid = opaque_tid(wid_s), lane = tid & 63, w = __builtin_amdgcn_readfirstlane(tid >> 6), fr = lane & 15, fq = lane >> 4;
    LAS float* RP = (LAS float*)(lds + NAT_RP_OFF);
    LAS float* RKL = (LAS float*)(lds + NAT_RK_OFF);
    LAS float* GQK = (LAS float*)(lds + NAT_RK_OFF + 1024);
    const bf16_t* NQ = (const bf16_t*)(ws + WS_NQ); const bf16_t* NK = (const bf16_t*)(ws + WS_NK); const bf16_t* VT = (const bf16_t*)(ws + WS_VT);
    const bf16_t* NG = (const bf16_t*)(ws + WS_NG); bf16_t* OB = (bf16_t*)(ws + WS_OB); const float* RKS = (const float*)(ws + WS_RKS);
    const float* gq = a.in[6] + layer * 128; const float* gk = a.in[7] + layer * 128; const float* rpb = a.in[8] + (size_t)layer * 8 * 465;
    if (tid < 128) GQK[tid] = ldgf(gq + tid) * ldgf(gk + tid);
    const int rr = w >> 2, j = w & 3;
    const int c0k = (j == 0) ? 0 : (j == 1) ? 8 : (j == 2) ? 24 : 32;
    const int cq = 16 * j + fr;
    const int cstart = min(max(cq - 8, 0), 48);
    bool vmask[2][4]; int cob[2][4];
#pragma unroll
    for (int kt = 0; kt < 2; ++kt)
#pragma unroll
        for (int rg = 0; rg < 4; ++rg) { const int kcl = c0k + 16 * kt + 4 * fq + rg; vmask[kt][rg] = (kcl >= cstart) && (kcl < cstart + 16); cob[kt][rg] = min(max(kcl - cq + 15, 0), 30); }
    int ksoff[2], vsoff[2], kdst[2], vdst[2];
#pragma unroll
    for (int i = 0; i < 2; ++i) { const int q = tid + 512 * i;
        { const int key = q >> 4, ch = q & 15; ksoff[i] = key * 128 + ch * 8; kdst[i] = key * 272 + ch * 16; }
        vsoff[i] = ksoff[i]; vdst[i] = (q >> 4) * 288 + (q & 15) * 16; }
    u32x4 R0[2], R1[2], R2[2], qraw[4]; float K0 = 0.f, K1 = 0.f, K2 = 0.f;
#define NAT_LOAD(g, R, KS, rs0_, h_) do { const int gr_ = min((rs0_) + (((g) < 9) ? (g) : (g) - 9), 127); \
        _Pragma("unroll") for (int i = 0; i < 2; ++i) R[i] = ((g) < 9) ? ldg16(NK + ((size_t)(h_) * SEQ + gr_ * 64) * 128 + ksoff[i]) : ldg16(VT + ((size_t)(h_) * SEQ + gr_ * 64) * 128 + vsoff[i]); \
        if ((g) < 9 && w == 0) KS = ldgf(RKS + ((size_t)gr_ * 64 + (tid & 63)) * 8 + (h_)); } while (0)
#define NAT_WRITE(g, R, KS) do { _Pragma("unroll") for (int i = 0; i < 2; ++i) *(LAS u32x4*)(lds + ((g) % 3) * NAT_SLOT + (((g) < 9) ? kdst[i] : vdst[i])) = R[i]; \
        if ((g) < 9 && w == 0) RKL[((g) % 3) * 64 + (tid & 63)] = rsqrtf(KS * (1.0f / 128.f) + EPS); } while (0)
#define NAT_QLOAD(r0_, h_) do { const size_t tq_ = (size_t)(64 * ((r0_) + rr) + cq); _Pragma("unroll") for (int ks = 0; ks < 4; ++ks) qraw[ks] = ldg16_nt(NQ + ((size_t)(h_) * SEQ + tq_) * 128 + 32 * ks + 8 * fq); } while (0)
    int it = blockIdx.x, h_prev = -1;
    if (it < 512) { const int r0 = 2 * (it >> 3), h = it & 7, rs0 = min(max(r0 - 4, 0), 120);
        NAT_LOAD(0, R0, K0, rs0, h); NAT_LOAD(1, R1, K1, rs0, h); NAT_LOAD(2, R2, K2, rs0, h); NAT_QLOAD(r0, h); }
    for (; it < 512; it += gridDim.x) {
        const int r0 = 2 * (it >> 3), h = it & 7, r = r0 + rr;
        const int rs0 = min(max(r0 - 4, 0), 120), rs1 = min(max(r0 - 3, 0), 120), dsel = rr ? rs1 - rs0 : 0, my_rs = rs0 + dsel;
        const int itn = it + (int)gridDim.x; const bool has_next = itn < 512;
        const int r0n = 2 * (itn >> 3), hn = itn & 7, rs0n = min(max(r0n - 4, 0), 120);
        if (h != h_prev) { for (int i = tid; i < 465; i += 512) RP[i] = ldgf(rpb + (size_t)h * 465 + i); h_prev = h; }
        const int tq = 64 * r + cq;
        bf16x8 qf[4];
        {
            float qv[4][8]; float ss = 0.f;
#pragma unroll
            for (int ks = 0; ks < 4; ++ks) { cvt8_bf16(qraw[ks], qv[ks]);
#pragma unroll
                for (int e = 0; e < 8; ++e) ss += qv[ks][e] * qv[ks][e]; }
            ss += __shfl_xor(ss, 16); ss += __shfl_xor(ss, 32);
            const float rq = rsqrtf(ss * (1.0f / 128.f) + EPS) * 0.08838834764831845f;
            NAT_WRITE(0, R0, K0); NAT_WRITE(1, R1, K1);
            __syncthreads();
#pragma unroll
            for (int ks = 0; ks < 4; ++ks) { const f32x4 ga = *(const LAS f32x4*)(GQK + 32 * ks + 8 * fq), gb = *(const LAS f32x4*)(GQK + 32 * ks + 8 * fq + 4);
                u32x4 wv;
                wv.x = cvt_pk_bf16(qv[ks][0] * rq * ga[0], qv[ks][1] * rq * ga[1]); wv.y = cvt_pk_bf16(qv[ks][2] * rq * ga[2], qv[ks][3] * rq * ga[3]);
                wv.z = cvt_pk_bf16(qv[ks][4] * rq * gb[0], qv[ks][5] * rq * gb[1]); wv.w = cvt_pk_bf16(qv[ks][6] * rq * gb[2], qv[ks][7] * rq * gb[3]);
                qf[ks] = __builtin_bit_cast(bf16x8, wv); }
        }
        float s[8][2][4];
        float mx = -3.0e38f, l = 0.f;
        f32x4 o[8];
        u32x2 gw[8];
#pragma unroll
        for (int dt = 0; dt < 8; ++dt) o[dt] = (f32x4){0.f, 0.f, 0.f, 0.f};
#pragma unroll
        for (int t = 0; t < 17; ++t) {
            if (t + 3 < 18) { if (t % 3 == 0) NAT_LOAD(t + 3, R0, K0, rs0, h); else if (t % 3 == 1) NAT_LOAD(t + 3, R1, K1, rs0, h); else NAT_LOAD(t + 3, R2, K2, rs0, h); }
            if (t == 9) {
#pragma unroll
                for (int dt = 0; dt < 8; ++dt) gw[dt] = ldg8_nt(NG + ((size_t)h * SEQ + tq) * 128 + 16 * dt + 4 * fq); }
            if (has_next) {
                if (t == 13) NAT_QLOAD(r0n, hn);
                if (t == 14) NAT_LOAD(0, R0, K0, rs0n, hn);
                if (t == 15) NAT_LOAD(1, R1, K1, rs0n, hn);
                if (t == 16) NAT_LOAD(2, R2, K2, rs0n, hn);
            }
            const int slot = (t % 3 + dsel) % 3;
            const LAS unsigned char* buf = lds + slot * NAT_SLOT;
            if (t < 8) {
                const int aa = t, kr = my_rs + aa, row_off = kr - r + 7;
#pragma unroll
                for (int kt = 0; kt < 2; ++kt) {
                    bf16x8 kf[4];
#pragma unroll
                    for (int ks = 0; ks < 4; ++ks) kf[ks] = *(const LAS bf16x8*)(buf + (c0k + 16 * kt + fr) * 272 + (32 * ks + 8 * fq) * 2);
                    const f32x4 rk4 = *(const LAS f32x4*)(RKL + slot * 64 + c0k + 16 * kt + 4 * fq);
                    f32x4 acc = (f32x4){0.f, 0.f, 0.f, 0.f};
#pragma unroll
                    for (int ks = 0; ks < 4; ++ks) acc = __builtin_amdgcn_mfma_f32_16x16x32_bf16(kf[ks], qf[ks], acc, 0, 0, 0);
#pragma unroll
                    for (int rg = 0; rg < 4; ++rg) {
                        const float bias = RP[row_off * 31 + cob[kt][rg]];
                        const float sv = vmask[kt][rg] ? (acc[rg] * rk4[rg] + bias) : -1.0e30f;
                        s[aa][kt][rg] = sv; mx = fmaxf(mx, sv);
                    }
                }
                if (t == 7) {
                    mx = fmaxf(mx, __shfl_xor(mx, 16)); mx = fmaxf(mx, __shfl_xor(mx, 32));
#pragma unroll
                    for (int a2 = 0; a2 < 8; ++a2)
#pragma unroll
                        for (int kt = 0; kt < 2; ++kt)
#pragma unroll
                            for (int rg = 0; rg < 4; ++rg) { const float p = __expf(s[a2][kt][rg] - mx); s[a2][kt][rg] = p; l += p; }
                    l += __shfl_xor(l, 16); l += __shfl_xor(l, 32);
                }
            } else if (t > 8) {
                const int aa = t - 9;
                u32x4 pw; pw.x = cvt_pk_bf16(s[aa][0][0], s[aa][0][1]); pw.y = cvt_pk_bf16(s[aa][0][2], s[aa][0][3]); pw.z = cvt_pk_bf16(s[aa][1][0], s[aa][1][1]); pw.w = cvt_pk_bf16(s[aa][1][2], s[aa][1][3]);
                const bf16x8 pb = __builtin_bit_cast(bf16x8, pw);
#pragma unroll
                for (int dt = 0; dt < 8; ++dt) {
                    const LAS unsigned char* vp = buf + (c0k + 4 * fq + (fr >> 2)) * 288 + (16 * dt + 4 * (fr & 3)) * 2;
                    const u32x2 v0 = __builtin_bit_cast(u32x2, __builtin_amdgcn_ds_read_tr16_b64_v4i16((LAS v4i16_t*)vp)), v1 = __builtin_bit_cast(u32x2, __builtin_amdgcn_ds_read_tr16_b64_v4i16((LAS v4i16_t*)(vp + 16 * 288)));
                    const u32x4 vw = (u32x4){v0.x, v0.y, v1.x, v1.y};
                    o[dt] = __builtin_amdgcn_mfma_f32_16x16x32_bf16(__builtin_bit_cast(bf16x8, vw), pb, o[dt], 0, 0, 0);
                }
            }
            if (t + 2 < 18) { if ((t + 2) % 3 == 0) NAT_WRITE(t + 2, R0, K0); else if ((t + 2) % 3 == 1) NAT_WRITE(t + 2, R1, K1); else NAT_WRITE(t + 2, R2, K2); }
            __syncthreads();
        }
        const float inv = 1.0f / l;
#pragma unroll
        for (int dt = 0; dt < 8; ++dt) {
            const size_t off = (size_t)tq * HW + h * 128 + 16 * dt + 4 * fq;
            u32x2 ow; ow.x = cvt_pk_bf16(o[dt][0] * inv * bflo(gw[dt].x), o[dt][1] * inv * bfhi(gw[dt].x)); ow.y = cvt_pk_bf16(o[dt][2] * inv * bflo(gw[dt].y), o[dt][3] * inv * bfhi(gw[dt].y));
            *(GAS u32x2*)(OB + off) = ow;
        }
    }
#undef NAT_LOAD
#undef NAT_WRITE
#undef NAT_QLOAD
}

__global__ void __launch_bounds__(512, 2) mk_fwd(Args a) {
    extern __shared__ __attribute__((aligned(16))) unsigned char lds_raw[];
    LAS unsigned char* lds = (LAS unsigned char*)lds_raw;
    volatile LAS unsigned* MISC = (volatile LAS unsigned*)(lds + LDS_MISC_OFF);
    const int wid_s = __builtin_amdgcn_readfirstlane(threadIdx.x >> 6);
    if (threadIdx.x < 64) MISC[threadIdx.x] = 0u;
    __syncthreads();
    XcdBarrier bar; bar.bar = (unsigned*)(a.ws + WS_CTL) + 4096; bar.x = 0; bar.st = nullptr;
    const int lo = a.ph_lo, hi = a.ph_hi;
    if (hi - lo > 1) bar = xcd_barrier_post((unsigned*)(a.ws + WS_CTL) + 4096, MISC + 8);
#define IN(k) (lo <= (k) && (k) < hi)
#define SEAM(k) do { if (IN(k) && IN((k) + 1)) { xcd_arrive(bar, (k)); xcd_wait(bar, (k)); } } while (0)
    const int G = gridDim.x, c = blockIdx.x;

    const bool fill = IN(0) && IN(8);
#define FLAGK(k) (bar.bar + XB_KBASE + (k) * XB_KSTRIDE + 512)
#define NXV (bar.st[1])
#define SEAMF(k, on) do { if (IN(k) && IN((k) + 1)) { xcd_arrive(bar, (k)); if (on) conv_fill(a, lds, wid_s, FLAGK(k), NXV, MISC + 20); xcd_wait(bar, (k)); } } while (0)
    if (IN(0)) p0_prologue(a, lds, fill ? 1 : 2);
    SEAMF(0, fill);
    for (int l = 0; l < 2; ++l) {
        const int pb = 1 + 7 * l;
        if (IN(pb + 0)) {
            unsigned char* ws = opaque_ptr(a.ws); bf16_t* XGA = (bf16_t*)(ws + WS_XGA); float* SSQ = (float*)(ws + WS_SSQ);
            pg8::Gemm g{XGA, (const bf16_t*)(ws + WS_WIN) + (size_t)l * NIN * DM, SEQ, NIN - 1024, DM, nullptr, nullptr}; pg8::StaticOrder S; S.init(SEQ, NIN - 1024, G, c);
            EpiInProj E{SSQ + (2 * l) * SEQ, (const float*)(ws + WS_LOWER) + l * 2048, ws};
            pg8::gemm_phase<EpiInProj, pg8::StaticOrder>(lds, g, S, E, wid_s);
        }
        SEAMF(pb + 0, fill);
        if (IN(pb + 1)) h1_phase(a, lds, wid_s);
        if (fill && l == 0) conv_fill(a, lds, wid_s, nullptr, CONV_D_WP0, MISC + 20);
        if (IN(pb + 1) && IN(pb + 2)) { xcd_arrive(bar, pb + 1); if (c >= G / 2) { if (fill) conv_fill(a, lds, wid_s, FLAGK(pb + 1), NXV, MISC + 20); xcd_wait(bar, pb + 1); } }
        if (IN(pb + 2)) {
            const int ng = G / 2;
            if (c < ng) {
                unsigned char* ws = opaque_ptr(a.ws); float* SSQ = (float*)(ws + WS_SSQ);
                pg8::Gemm g{(const bf16_t*)(ws + WS_XGA), (const bf16_t*)(ws + WS_WIN) + (size_t)l * NIN * DM + (size_t)(NIN - 1024) * DM, SEQ, 1024, DM, nullptr, nullptr}; pg8::StaticOrder S; S.init(SEQ, 1024, ng, c);
                EpiMBTail E{SSQ + (2 * l) * SEQ, (unsigned char*)(ws + WS_MB)};
                pg8::gemm_phase<EpiMBTail, pg8::StaticOrder>(lds, g, S, E, wid_s);
            } else {
                h2_phase(a, lds, wid_s, c - ng, G - ng);
                unsigned char* ws = opaque_ptr(a.ws);
                int kple = PLE; asm volatile("" : "+s"(kple));
                pg8::Gemm g2{(const bf16_t*)(ws + WS_PB) + (size_t)l * SEQ * PLE, (const bf16_t*)(ws + WS_WP) + (size_t)l * DM * PLE, SEQ, DM, kple, nullptr, nullptr}; pg8::StaticOrder S2; S2.init(SEQ, DM, G - ng, c - ng);
                EpiPL E2{(bf16_t*)(ws + WS_PL)};
                pg8::gemm_phase<EpiPL, pg8::StaticOrder>(lds, g2, S2, E2, wid_s);
            }
        }
        if (fill) conv_fill(a, lds, wid_s, nullptr, l == 0 ? CONV_D_BR0 : CONV_NBATCH, MISC + 20);
        if (IN(pb + 2) && IN(pb + 3)) xcd_arrive(bar, pb + 2);
        if (IN(pb + 3)) { natten_phase(a, l, lds, wid_s); __syncthreads(); if (IN(pb + 4)) xcd_arrive(bar, 15 + l); }
        if (IN(pb + 2) && IN(pb + 3)) xcd_wait(bar, pb + 2);
        if (IN(pb + 3)) h3_phase(a, l, lds, wid_s);
        if (IN(pb + 3) && IN(pb + 4)) xcd_arrive(bar, pb + 3);
        if (IN(pb + 4)) {
            unsigned char* ws = opaque_ptr(a.ws);
            if (IN(pb + 3)) xcd_wait(bar, 15 + l);
            pg8::PairOrder S; S.init(SEQ, DM, G, c);
            S.flag = (IN(pb + 3)) ? FLAGK(pb + 3) : nullptr; S.nxv = NXV; S.lflag = MISC + 16; S.tag = (unsigned)(pb + 3) + 1u; S.wid = wid_s;
            pg8::Gemm g{(const bf16_t*)(ws + WS_OB), (const bf16_t*)(ws + WS_WB) + (size_t)l * DM * HW, SEQ, DM, HW, (const bf16_t*)(ws + WS_OA), (const bf16_t*)(ws + WS_WA) + (size_t)l * DM * HW};
            EpiBranch E{(const unsigned char*)(ws + WS_MA), (const unsigned char*)(ws + WS_MB), (bf16_t*)(ws + WS_Y)};
            pg8::gemm_phase<EpiBranch, pg8::PairOrder>(lds, g, S, E, wid_s);
        }
        if (fill && l == 0) conv_fill(a, lds, wid_s, nullptr, CONV_D_WO0, MISC + 20);
        SEAMF(pb + 4, fill && l == 0);
        if (IN(pb + 5)) {
            unsigned char* ws = opaque_ptr(a.ws); bf16_t* XGB = (bf16_t*)(ws + WS_XGB); float* SSQ = (float*)(ws + WS_SSQ);
            for (int i = c * 512 + opaque_tid(wid_s); i < SEQ * 8; i += G * 512) *(GAS float*)((float*)(ws + WS_RKS) + i) = 0.f;
            pg8::Gemm g{(const bf16_t*)(ws + WS_Y), (const bf16_t*)(ws + WS_WO) + (size_t)l * DM * DM, SEQ, DM, DM, nullptr, nullptr}; pg8::StaticOrder S; S.init(SEQ, DM, G, c);
            EpiWout E{(const bf16_t*)(ws + WS_XGA), XGB, SSQ + (2 * l + 1) * SEQ};
            pg8::gemm_phase<EpiWout, pg8::StaticOrder>(lds, g, S, E, wid_s);
        }
        if (fill && l == 0) conv_fill(a, lds, wid_s, nullptr, CONV_D_WG0, MISC + 20);
        SEAMF(pb + 5, fill && l == 0);
        if (IN(pb + 6)) {
            unsigned char* ws = opaque_ptr(a.ws); bf16_t* XGA = (bf16_t*)(ws + WS_XGA); bf16_t* XGB = (bf16_t*)(ws + WS_XGB); float* SSQ = (float*)(ws + WS_SSQ);
            pg8::StaticOrder S; S.init(SEQ, DM, G, c);
            pg8::Gemm g{XGB, (const bf16_t*)(ws + WS_WG) + (size_t)l * DM * DM, SEQ, DM, DM, nullptr, nullptr};
            EpiGate E{SSQ + (2 * l + 1) * SEQ, XGB, (const bf16_t*)(ws + WS_PL), a.out, XGA, SSQ + (2 * l + 2 < 4 ? 2 * l + 2 : 0) * SEQ, l == 0 ? 1 : 0};
            pg8::gemm_phase<EpiGate, pg8::StaticOrder>(lds, g, S, E, wid_s);
        }
        if (fill && l == 0) conv_fill(a, lds, wid_s, nullptr, CONV_D_IN1, MISC + 20);
        SEAMF(pb + 6, fill && l == 0);
    }
#undef IN
#undef SEAM
}

extern "C" void kernel_launch(void* const* d_in, const int* in_sizes, int n_in, void* d_out, int out_size, void* d_ws, size_t ws_size, hipStream_t stream) {
    static int grid = 0;
    if (grid == 0) {
        if (n_in != 15 || out_size != SEQ * DM || ws_size < WS_END) { fprintf(stderr, "kernel_launch: unexpected problem (n_in %d, out %d, ws %zu)\n", n_in, out_size, ws_size); grid = -1; return; }
        int dev = 0, cus = 0;
        if (hipGetDevice(&dev) != hipSuccess || hipDeviceGetAttribute(&cus, hipDeviceAttributeMultiprocessorCount, dev) != hipSuccess) { grid = -1; return; }
        if (hipFuncSetAttribute((const void*)mk_fwd, hipFuncAttributeMaxDynamicSharedMemorySize, LDS_BYTES) != hipSuccess) { fprintf(stderr, "kernel_launch: hipFuncSetAttribute failed\n"); grid = -1; return; }
        int per_cu = 0;
        if (hipOccupancyMaxActiveBlocksPerMultiprocessor(&per_cu, (const void*)mk_fwd, 512, LDS_BYTES) != hipSuccess || per_cu < 1) fprintf(stderr, "kernel_launch: occupancy query says %d\n", per_cu);
        (void)hipGetLastError();
        grid = cus;
    }
    if (grid < 0) return;
    (void)hipMemsetAsync((char*)d_ws + WS_CTL, 0, CTL_ZERO_BYTES, stream);
    Args a{};
    for (int i = 0; i < 15; ++i) a.in[i] = (const float*)d_in[i];
    a.out = (float*)d_out; a.ws = (unsigned char*)d_ws;
#if MK_MULTI
    for (int ph = 0; ph < NPHASE; ++ph) { a.ph_lo = ph; a.ph_hi = ph + 1; hipLaunchKernelGGL(mk_fwd, dim3(grid), dim3(512), LDS_BYTES, stream, a); }
#else
    a.ph_lo = 0; a.ph_hi = NPHASE; hipLaunchKernelGGL(mk_fwd, dim3(grid), dim3(512), LDS_BYTES, stream, a);
#endif
}
```
